# Optimizing an MI355X kernel written in HIP

```python
import jax, jax.numpy as jnp
from jax import lax
import numpy as np

D_MODEL = 2048
BATCH = 4
SEQ = 4096
DEPTH = 2

CHUNK = 64
N_META = 16
D_LRU = D_MODEL // 2
D_CONV = D_MODEL // 2
D_MIX = D_LRU + D_CONV
LRU_HEADS = 16
LRU_HEAD_DIM = D_LRU // LRU_HEADS
CONV_GROUPS = 16
LRU_CONV_W = 4
SHORT_CONV_W = 3
LRU_C = 8.0
RMS_EPS = 1e-6
SPLIT_SIZES = (D_LRU, D_LRU, D_CONV, D_CONV, D_CONV, D_CONV)
D_IN = sum(SPLIT_SIZES)
SPLIT_IDX = tuple(int(v) for v in np.cumsum(SPLIT_SIZES)[:-1])

kernel_name = "hymba_rglru_shortconv_trunk"


def rmsnorm(x, g):
    xf = x.astype(jnp.float32)
    y = xf * lax.rsqrt(jnp.mean(xf * xf, axis=-1, keepdims=True) + RMS_EPS)
    return (y * g.astype(jnp.float32)).astype(x.dtype)


def causal_depthwise_conv(x, w):
    k, c = w.shape
    return lax.conv_general_dilated(
        x, w[:, None, :].astype(x.dtype), window_strides=(1,),
        padding=((k - 1, 0),), dimension_numbers=("NWC", "WIO", "NWC"),
        feature_group_count=c)


def rg_lru(x, wr, br, wi, bi, lam):
    bsz, length, _ = x.shape
    xf = x.astype(jnp.float32)
    xh = xf.reshape(bsz, length, LRU_HEADS, LRU_HEAD_DIM)
    r = jax.nn.sigmoid(jnp.einsum("blhi,hij->blhj", xh, wr.astype(jnp.float32))
                       .reshape(bsz, length, D_LRU) + br.astype(jnp.float32))
    i = jax.nn.sigmoid(jnp.einsum("blhi,hij->blhj", xh, wi.astype(jnp.float32))
                       .reshape(bsz, length, D_LRU) + bi.astype(jnp.float32))
    log_a = -LRU_C * r * jax.nn.softplus(-lam.astype(jnp.float32))
    a = jnp.exp(log_a)
    b = jnp.sqrt(-jnp.expm1(2.0 * log_a)) * (i * xf)

    def combine(left, right):
        a1, b1 = left
        a2, b2 = right
        return a1 * a2, a2 * b1 + b2

    _, h = lax.associative_scan(combine, (a, b), axis=1)
    return h.astype(x.dtype)


def hybrid_layer(x, norm_g, w_in, conv_a_w, conv_a_b, lru_wr, lru_br, lru_wi,
                 lru_bi, lru_lambda, conv_b_w, w_out):
    h = rmsnorm(x, norm_g)
    u = jnp.einsum("bld,de->ble", h, w_in.astype(h.dtype))
    xa, ga, gate_b, gate_c, xb, gb = jnp.split(u, SPLIT_IDX, axis=-1)
    xa = causal_depthwise_conv(xa, conv_a_w) + conv_a_b.astype(xa.dtype)
    ya = rg_lru(xa, lru_wr, lru_br, lru_wi, lru_bi, lru_lambda) * jax.nn.silu(ga)
    yb = gate_b * causal_depthwise_conv(gate_c * xb, conv_b_w) * jax.nn.silu(gb)
    y = jnp.concatenate([ya, yb], axis=-1)
    return x + jnp.einsum("ble,ed->bld", y, w_out.astype(y.dtype))


def setup_inputs(seed: int = 0) -> dict:
    key = jax.random.key(seed)
    ks = jax.random.split(key, 16)
    f32 = jnp.float32
    x = jax.random.normal(ks[0], (BATCH, SEQ, D_MODEL), f32)
    meta = jax.random.normal(ks[1], (N_META, D_MODEL), f32)
    norm_g = 1.0 + 0.01 * jax.random.normal(ks[2], (DEPTH, D_MODEL), f32)
    w_in = jax.random.normal(ks[3], (DEPTH, D_MODEL, D_IN), f32) * D_MODEL ** -0.5
    conv_a_w = jax.random.normal(ks[4], (DEPTH, LRU_CONV_W, D_LRU), f32) * LRU_CONV_W ** -0.5
    conv_a_b = 0.01 * jax.random.normal(ks[5], (DEPTH, D_LRU), f32)
    lru_wr = jax.random.normal(ks[6], (DEPTH, LRU_HEADS, LRU_HEAD_DIM, LRU_HEAD_DIM), f32) * LRU_HEAD_DIM ** -0.5
    lru_br = 0.01 * jax.random.normal(ks[7], (DEPTH, D_LRU), f32)
    lru_wi = jax.random.normal(ks[8], (DEPTH, LRU_HEADS, LRU_HEAD_DIM, LRU_HEAD_DIM), f32) * LRU_HEAD_DIM ** -0.5
    lru_bi = 0.01 * jax.random.normal(ks[9], (DEPTH, D_LRU), f32)
    a_c = jax.random.uniform(ks[10], (DEPTH, D_LRU), f32, 0.9, 0.999)
    a0 = a_c ** (1.0 / LRU_C)
    lru_lambda = jnp.log(a0) - jnp.log1p(-a0)
    conv_b_w = jax.random.normal(ks[11], (DEPTH, SHORT_CONV_W, D_CONV), f32) * SHORT_CONV_W ** -0.5
    w_out = jax.random.normal(ks[12], (DEPTH, D_MIX, D_MODEL), f32) * D_MIX ** -0.5
    final_g = 1.0 + 0.01 * jax.random.normal(ks[13], (D_MODEL,), f32)
    return {"x": x, "meta": meta, "norm_g": norm_g, "w_in": w_in,
            "conv_a_w": conv_a_w, "conv_a_b": conv_a_b, "lru_wr": lru_wr,
            "lru_br": lru_br, "lru_wi": lru_wi, "lru_bi": lru_bi,
            "lru_lambda": lru_lambda, "conv_b_w": conv_b_w, "w_out": w_out,
            "final_g": final_g}


def reference(x, meta, norm_g, w_in, conv_a_w, conv_a_b, lru_wr, lru_br, lru_wi,
              lru_bi, lru_lambda, conv_b_w, w_out, final_g):
    bsz = x.shape[0]
    m = jnp.broadcast_to(meta.astype(x.dtype)[None], (bsz, N_META, D_MODEL))
    h = jnp.concatenate([m, x], axis=1)
    for layer in range(DEPTH):
        h = hybrid_layer(h, norm_g[layer], w_in[layer], conv_a_w[layer],
                         conv_a_b[layer], lru_wr[layer], lru_br[layer],
                         lru_wi[layer], lru_bi[layer], lru_lambda[layer],
                         conv_b_w[layer], w_out[layer])
    return rmsnorm(h[:, N_META:], final_g)
```

```cpp
#include <hip/hip_runtime.h>
#include <hip/hip_cooperative_groups.h>
#include <cstdio>
namespace cg = cooperative_groups;
namespace pg8 {
#define PG8_LAS __attribute__((address_space(3)))
typedef unsigned short bf16_t;
typedef short bf16x8 __attribute__((ext_vector_type(8)));
typedef float f32x4 __attribute__((ext_vector_type(4)));
typedef unsigned u32x4 __attribute__((ext_vector_type(4)));
constexpr int BM = 256, BK = 64, HALF = 128, HTB = HALF * BK * 2  , STAGE_BYTES = 8 * HTB, NXCD = 8, WGM = 8;

__host__ __device__ __forceinline__ int lds_byte(int r, int c) { const int st = (r >> 4) * 2 + (c >> 5), rr = r & 15, cc = c & 31, ob = rr * 64 + cc * 2; return st * 1024 + (ob ^ (((ob >> 9) & 1) << 5)); }
__host__ __device__ __forceinline__ void stage_rc(int b, int& R, int& C) { const int st = b / 1024, sb = b % 1024, swz = sb ^ (((sb >> 9) & 1) << 5); R = (st >> 1) * 16 + swz / 64; C = (st & 1) * 32 + (swz % 64) / 2; }
__host__ __device__ __forceinline__ int perm32(int rho) { const int n = rho >> 4, i = rho & 15; return 8 * (i >> 2) + 4 * n + (i & 3); }

struct Unit { int pm, pn; };
struct Gemm { const bf16_t* A; const bf16_t* Bt; int M, N, K; };

struct StaticOrder {
    int nM, nN, nwg, G, c;
    __host__ __device__ void init(int M, int N, int G_, int c_) { nM = M / BM; nN = N / BM; nwg = nM * nN; G = G_; c = c_; }
    __host__ __device__ bool next(int i, Unit& u) const {
        const long L = (long)i * G + c; if (L >= nwg) return false;
        int wgid = (int)L; { const int q = nwg / NXCD, r = nwg % NXCD, xcd = wgid % NXCD, off = wgid / NXCD; wgid = (xcd < r ? xcd * (q + 1) : r * (q + 1) + (xcd - r) * q) + off; }
        const int nig = WGM * nN, gid = wgid / nig, fm = gid * WGM, gsz = (nM - fm) < WGM ? (nM - fm) : WGM;
        u.pm = fm + ((wgid % nig) % gsz); u.pn = (wgid % nig) / gsz; return true;
    }
    __device__ __forceinline__ void a_ready(const Unit&) const {}
    __device__ __forceinline__ void done(const Unit&) const {}
};
__device__ __forceinline__ unsigned cvt_pk_bf16(float lo, float hi) { unsigned r; asm volatile("v_cvt_pk_bf16_f32 %0, %1, %2" : "=v"(r) : "v"(lo), "v"(hi)); return r; }
template <class Epi, class Sched, bool STAMP = false>
__device__ __forceinline__ void gemm_phase(PG8_LAS unsigned char* lds, const Gemm g, const Sched& S, const Epi& E, unsigned long long* stamps) {
    int tid_l = threadIdx.x; asm volatile("" : "+v"(tid_l));
    const int tid = tid_l, wid = __builtin_amdgcn_readfirstlane(tid >> 6), lane = tid & 63, wr = wid >> 2, wc = wid & 3, fr = lane & 15, fq = lane >> 4;
    const int K = g.K, nt = K / BK;
    int ts_lo = 0, ts_hi = 0, nts = 0; const unsigned long long rt_entry = STAMP ? (unsigned long long)wall_clock64() : 0ull;
#define PG8_STAMP() do { if (STAMP && wid == 0 && nts < 64) { const unsigned long long _c = (unsigned long long)clock64(); \
        ts_lo = (lane == nts) ? (int)(unsigned)_c : ts_lo; ts_hi = (lane == nts) ? (int)(unsigned)(_c >> 32) : ts_hi; ++nts; } } while (0)
    PG8_STAMP();
    unsigned voffA[2], voffB[2];
#pragma unroll
    for (int i = 0; i < 2; ++i) { int R, C; stage_rc(tid * 16 + i * 8192, R, C); const int Rb = Epi::PERM ? ((R & ~31) + perm32(R & 31)) : R;
        voffA[i] = (unsigned)(R * K + C) * 2u; voffB[i] = (unsigned)(Rb * K + C) * 2u; }
    const size_t kstep = (size_t)(BK * 2);
    const size_t hstep = (size_t)HALF * K * 2;
    const size_t tstep = 2 * hstep;
    const unsigned ldsw = (unsigned)wid * 1024u;
    const int aoff = lds_byte(wr * 64 + fr, fq * 8), boff = lds_byte(wc * 32 + fr, fq * 8);
#define PG8_SA(b, h) (((b) * 2 + (h)) * HTB)
#define PG8_SB(b, h) ((4 + (b) * 2 + (h)) * HTB)
#define PG8_STAGE(bufoff, gbase, voff) do { _Pragma("unroll") for (int _i = 0; _i < 2; ++_i) \
        __builtin_amdgcn_global_load_lds((const unsigned*)((const char*)(gbase) + (voff)[_i]), (PG8_LAS unsigned*)(lds + (bufoff) + ldsw + _i * 8192), 16, 0, 0); } while (0)
#define PG8_LDA(dst, b, h) do { _Pragma("unroll") for (int m = 0; m < 4; ++m) _Pragma("unroll") for (int k = 0; k < 2; ++k) dst[m][k] = *(const PG8_LAS bf16x8*)(lds + PG8_SA(b, h) + aoff + m * 2048 + k * 1024); } while (0)
#define PG8_LDB(dst, b, h) do { _Pragma("unroll") for (int n = 0; n < 2; ++n) _Pragma("unroll") for (int k = 0; k < 2; ++k) dst[n][k] = *(const PG8_LAS bf16x8*)(lds + PG8_SB(b, h) + boff + n * 2048 + k * 1024); } while (0)
#define PG8_MMA(ai, bj, At, Bt) do { __builtin_amdgcn_s_setprio(1); _Pragma("unroll") for (int m = 0; m < 4; ++m) _Pragma("unroll") for (int n = 0; n < 2; ++n) _Pragma("unroll") for (int k = 0; k < 2; ++k) \
        acc[ai][bj][m][n] = __builtin_amdgcn_mfma_f32_16x16x32_bf16(Bt[n][k], At[m][k], acc[ai][bj][m][n], 0, 0, 0); __builtin_amdgcn_s_setprio(0); } while (0)
#define PG8_WAIT_V(n) asm volatile("s_waitcnt vmcnt(" #n ")" ::: "memory")
#define PG8_WAIT_L(n) asm volatile("s_waitcnt lgkmcnt(" #n ")" ::: "memory")
#define PG8_BAR __builtin_amdgcn_s_barrier()
#define PG8_SCHED __builtin_amdgcn_sched_barrier(0)
    Unit cur, nxt; int ui = 0;
    if (!S.next(0, cur)) return;
    f32x4 acc[2][2][4][2];
#pragma unroll
    for (int a = 0; a < 2; ++a)
#pragma unroll
        for (int b = 0; b < 2; ++b)
#pragma unroll
            for (int m = 0; m < 4; ++m)
#pragma unroll
                for (int n = 0; n < 2; ++n) acc[a][b][m][n] = (f32x4){0.f, 0.f, 0.f, 0.f};
    bf16x8 At[4][2], B0[2][2], B1[2][2];
    const char* cA = (const char*)g.A + (size_t)cur.pm * tstep; const char* cB = (const char*)g.Bt + (size_t)cur.pn * tstep;
    S.a_ready(cur);
    PG8_STAGE(PG8_SB(0, 0), cB, voffB); PG8_STAGE(PG8_SA(0, 0), cA, voffA); PG8_STAGE(PG8_SB(0, 1), cB + hstep, voffB); PG8_STAGE(PG8_SA(0, 1), cA + hstep, voffA);
    if (wr == 1) PG8_BAR;
    PG8_WAIT_V(4); PG8_BAR;
    PG8_STAGE(PG8_SB(1, 0), cB + kstep, voffB); PG8_STAGE(PG8_SA(1, 0), cA + kstep, voffA); PG8_STAGE(PG8_SB(1, 1), cB + hstep + kstep, voffB);
    PG8_WAIT_V(6); PG8_BAR;
    PG8_STAMP();
    for (;;) {
        const bool has_next = S.next(ui + 1, nxt);
        const char* nA = has_next ? (const char*)g.A + (size_t)nxt.pm * tstep : cA; const char* nB = has_next ? (const char*)g.Bt + (size_t)nxt.pn * tstep : cB;
        for (int t = 0; t < nt; t += 2) {
            const bool last = (t == nt - 2);
            const char* a1 = cA + (size_t)(t + 1) * kstep;
            const char* a2 = last ? nA : cA + (size_t)(t + 2) * kstep; const char* b2 = last ? nB : cB + (size_t)(t + 2) * kstep;
            const char* a3 = a2 + kstep; const char* b3 = b2 + kstep;
            if (last && has_next) S.a_ready(nxt);
            PG8_LDB(B0, 0, 0); PG8_SCHED; PG8_LDA(At, 0, 0); PG8_STAGE(PG8_SA(1, 1), a1 + hstep, voffA);
            PG8_WAIT_L(8); PG8_BAR; PG8_WAIT_L(0); PG8_MMA(0, 0, At, B0); PG8_BAR; PG8_SCHED;
            PG8_LDB(B1, 0, 1); PG8_STAGE(PG8_SB(0, 0), b2, voffB);
            PG8_BAR; PG8_WAIT_L(0); PG8_MMA(0, 1, At, B1); PG8_BAR;
            PG8_LDA(At, 0, 1); PG8_STAGE(PG8_SA(0, 0), a2, voffA);
            PG8_BAR; PG8_WAIT_L(0); PG8_MMA(1, 0, At, B0); PG8_BAR; PG8_SCHED;
            PG8_STAGE(PG8_SB(0, 1), b2 + hstep, voffB);
            PG8_WAIT_V(6); PG8_BAR; PG8_MMA(1, 1, At, B1); PG8_BAR;
            PG8_LDB(B0, 1, 0); PG8_SCHED; PG8_LDA(At, 1, 0); PG8_STAGE(PG8_SA(0, 1), a2 + hstep, voffA);
            PG8_WAIT_L(8); PG8_BAR; PG8_WAIT_L(0); PG8_MMA(0, 0, At, B0); PG8_BAR; PG8_SCHED;
            PG8_LDB(B1, 1, 1); PG8_STAGE(PG8_SB(1, 0), b3, voffB);
            PG8_BAR; PG8_WAIT_L(0); PG8_MMA(0, 1, At, B1); PG8_BAR;
            PG8_LDA(At, 1, 1); PG8_STAGE(PG8_SA(1, 0), a3, voffA);
            PG8_BAR; PG8_WAIT_L(0); PG8_MMA(1, 0, At, B0); PG8_BAR; PG8_SCHED;
            PG8_STAGE(PG8_SB(1, 1), b3 + hstep, voffB);
            PG8_WAIT_V(6); PG8_BAR; PG8_MMA(1, 1, At, B1); PG8_BAR;
        }
        PG8_STAMP();
        if constexpr (!Epi::AFTER_DRAIN) { E(acc, cur, wr, wc, fr, fq); S.done(cur); }
        PG8_STAMP();
        if (!has_next) break;
#pragma unroll
        for (int a = 0; a < 2; ++a)
#pragma unroll
            for (int b = 0; b < 2; ++b)
#pragma unroll
                for (int m = 0; m < 4; ++m)
#pragma unroll
                    for (int n = 0; n < 2; ++n) acc[a][b][m][n] = (f32x4){0.f, 0.f, 0.f, 0.f};
        cur = nxt; cA = nA; cB = nB; ++ui;
    }
    PG8_WAIT_V(0);
    if (wr == 0) PG8_BAR;
    PG8_BAR;
    if constexpr (Epi::AFTER_DRAIN) { E.fused(acc, cur, wr, wc, fr, fq, lds, wid, lane); S.done(cur); }
    PG8_STAMP();
    if (STAMP && wid == 0) { stamps[lane] = lane < nts ? (((unsigned long long)(unsigned)ts_hi << 32) | (unsigned)ts_lo) : 0ull;
        if (lane == 62) stamps[62] = rt_entry; if (lane == 63) stamps[63] = (unsigned long long)wall_clock64(); }
#undef PG8_STAMP
#undef PG8_SA
#undef PG8_SB
#undef PG8_STAGE
#undef PG8_LDA
#undef PG8_LDB
#undef PG8_MMA
#undef PG8_WAIT_V
#undef PG8_WAIT_L
#undef PG8_BAR
#undef PG8_SCHED
}
}

#define LAS __attribute__((address_space(3)))
typedef unsigned short bf16_t;
typedef short bf16x8 __attribute__((ext_vector_type(8)));
typedef float f32x4 __attribute__((ext_vector_type(4)));
typedef float f32x2 __attribute__((ext_vector_type(2)));
typedef float f32x16 __attribute__((ext_vector_type(16)));
typedef unsigned u32x4 __attribute__((ext_vector_type(4)));
typedef unsigned u32x2 __attribute__((ext_vector_type(2)));

constexpr int DM = 2048, NBATCH = 4, SEQ = 4096, MROWS = NBATCH * SEQ, NMETA = 16, DIN = 6144, DLRU = 1024, NHEAD = 16;
constexpr int META0 = MROWS;
constexpr int RSTR = MROWS + 64;
constexpr float RMS_EPS = 1e-6f;
constexpr int NPHASE = 10;
constexpr int LDS_BYTES = 131072;

constexpr size_t MiB = 1u << 20;
constexpr size_t WS_WTIN = 0;
constexpr size_t WS_WTOUT = 48 * MiB;
constexpr size_t WS_GW = 64 * MiB;
constexpr size_t WS_ROWSS = 65 * MiB;
constexpr size_t WS_AGG = 66 * MiB;
constexpr size_t WS_XB = 70 * MiB;
constexpr size_t WS_Y = 135 * MiB;
constexpr size_t WS_HP = 200 * MiB;
constexpr size_t WS_U = 265 * MiB;
constexpr size_t WS_END = 460 * MiB;
static_assert(WS_U + (size_t)RSTR * DIN * 2 <= WS_END && WS_HP + (size_t)RSTR * DLRU * 4 <= WS_U && WS_Y + (size_t)RSTR * DM * 2 <= WS_HP && WS_XB + (size_t)RSTR * DM * 2 <= WS_Y, "ws map");
static_assert(WS_WTIN + (size_t)2 * DIN * DM * 2 <= WS_WTOUT && WS_WTOUT + (size_t)2 * DM * DM * 2 <= WS_GW && WS_AGG + (size_t)257 * 1024 * 8 <= WS_XB && WS_ROWSS + (size_t)3 * RSTR * 4 <= WS_AGG, "ws map 2");

struct Args { const float* in[14]; float* out; unsigned char* ws; int ph_lo, ph_hi, flags, pad; };

__device__ __forceinline__ unsigned f2bf(float f) { unsigned u = __builtin_bit_cast(unsigned, f); return (u + 0x7fffu + ((u >> 16) & 1u)) >> 16; }
__device__ __forceinline__ unsigned pk2(float lo, float hi) { return f2bf(lo) | (f2bf(hi) << 16); }
__device__ __forceinline__ float bflo(unsigned w) { return __builtin_bit_cast(float, w << 16); }
__device__ __forceinline__ float bfhi(unsigned w) { return __builtin_bit_cast(float, w & 0xffff0000u); }
__device__ __forceinline__ float bf1(bf16_t v) { return __builtin_bit_cast(float, ((unsigned)v) << 16); }
__device__ __forceinline__ float sigmoidf_(float z) { return __builtin_amdgcn_rcpf(1.0f + __expf(-z)); }
__device__ __forceinline__ float wave_sum(float v) {
#pragma unroll
    for (int o = 1; o < 64; o <<= 1) v += __shfl_xor(v, o);
    return v;
}
#define LDS_WAIT() asm volatile("s_waitcnt lgkmcnt(0)" ::: "memory")

struct EpiU {
    static constexpr bool PERM = true, AFTER_DRAIN = false;
    bf16_t* O; const float* rowss;
    __device__ __forceinline__ void operator()(const f32x4 (&acc)[2][2][4][2], const pg8::Unit& u, int wr, int wc, int fr, int fq) const {
        const int row0 = u.pm * 256 + wr * 64 + fr, col0 = u.pn * 256 + wc * 32 + 8 * fq;
#pragma unroll
        for (int ai = 0; ai < 2; ++ai)
#pragma unroll
            for (int m = 0; m < 4; ++m) {
                const int r = row0 + ai * 128 + m * 16;
                const float rs = rsqrtf(rowss[r] * (1.0f / DM) + RMS_EPS);
                bf16_t* rowp = O + (size_t)r * DIN + col0;
#pragma unroll
                for (int bj = 0; bj < 2; ++bj) {
                    const f32x4 v0 = acc[ai][bj][m][0] * rs, v1 = acc[ai][bj][m][1] * rs;
                    u32x4 w; w.x = pg8::cvt_pk_bf16(v0[0], v0[1]); w.y = pg8::cvt_pk_bf16(v0[2], v0[3]); w.z = pg8::cvt_pk_bf16(v1[0], v1[1]); w.w = pg8::cvt_pk_bf16(v1[2], v1[3]);
                    *(u32x4*)(rowp + bj * 128) = w;
                }
            }
    }
};
struct EpiRes {
    static constexpr bool PERM = true, AFTER_DRAIN = false;
    const float* res; float* out; bf16_t* xb; float* rowss;
    __device__ __forceinline__ void operator()(const f32x4 (&acc)[2][2][4][2], const pg8::Unit& u, int wr, int wc, int fr, int fq) const {
        const int row0 = u.pm * 256 + wr * 64 + fr, col0 = u.pn * 256 + wc * 32 + 8 * fq;
#pragma unroll
        for (int ai = 0; ai < 2; ++ai)
#pragma unroll
            for (int m = 0; m < 4; ++m) {
                const int r = row0 + ai * 128 + m * 16; const size_t off = (size_t)r * DM + col0; float ss = 0.f;
#pragma unroll
                for (int bj = 0; bj < 2; ++bj) {
                    const f32x4 r0 = *(const f32x4*)(res + off + bj * 128), r1 = *(const f32x4*)(res + off + bj * 128 + 4);
                    const f32x4 h0 = r0 + acc[ai][bj][m][0], h1 = r1 + acc[ai][bj][m][1];
                    *(f32x4*)(out + off + bj * 128) = h0; *(f32x4*)(out + off + bj * 128 + 4) = h1;
                    if (xb) { u32x4 w; w.x = pg8::cvt_pk_bf16(h0[0], h0[1]); w.y = pg8::cvt_pk_bf16(h0[2], h0[3]); w.z = pg8::cvt_pk_bf16(h1[0], h1[1]); w.w = pg8::cvt_pk_bf16(h1[2], h1[3]);
                        *(u32x4*)(xb + off + bj * 128) = w; }
                    ss += (h0[0] * h0[0] + h0[1] * h0[1]) + (h0[2] * h0[2] + h0[3] * h0[3]) + (h1[0] * h1[0] + h1[1] * h1[1]) + (h1[2] * h1[2] + h1[3] * h1[3]);
                }
                ss += __shfl_xor(ss, 16); ss += __shfl_xor(ss, 32);
                if (fq == 0) unsafeAtomicAdd(rowss + r, ss);
                asm volatile("" ::: "memory");
            }
    }
};

template <class F> __device__ __forceinline__ void meta_gemm(const bf16_t* A, const bf16_t* Bt, int ngroups, LAS unsigned char* lds, int wid, int lane, F epi) {
    const int fr = lane & 15, fq = lane >> 4;
    LAS f32x4* red = (LAS f32x4*)lds;
    for (int g = blockIdx.x; g < ngroups; g += gridDim.x) {
        f32x4 acc = {0.f, 0.f, 0.f, 0.f};
        const bf16_t* ap = A + (size_t)fr * DM + wid * 256 + fq * 8;
        const bf16_t* bp = Bt + (size_t)(g * 16 + fr) * DM + wid * 256 + fq * 8;
#pragma unroll
        for (int s = 0; s < 8; ++s) {
            const bf16x8 a = *(const bf16x8*)(ap + 32 * s), b = *(const bf16x8*)(bp + 32 * s);
            acc = __builtin_amdgcn_mfma_f32_16x16x32_bf16(b, a, acc, 0, 0, 0);
        }
        red[wid * 64 + lane] = acc;
        __syncthreads();
        if (wid == 0) {
            f32x4 s = red[lane];
#pragma unroll
            for (int w = 1; w < 8; ++w) s += red[w * 64 + lane];
            epi(fr, g * 16 + 4 * fq, s);
        }
        __syncthreads();
    }
}

__device__ __forceinline__ void tr_item(const float* W, int K, int N, bf16_t* WT, const float* sc, LAS float* scr, int item, int lane) {
    const int nblk = N / 32, kb = item / nblk, nb = item % nblk, k0 = 64 * kb, n0 = 32 * nb;
#pragma unroll 8
    for (int i = 0; i < 32; ++i) { const int kk = 2 * i + (lane >> 5); float v = W[(size_t)(k0 + kk) * N + n0 + (lane & 31)]; if (sc) v *= sc[k0 + kk]; scr[kk * 33 + (lane & 31)] = v; }
    LDS_WAIT();
    const int c = lane & 7;
#pragma unroll
    for (int j = 0; j < 4; ++j) { const int n = (lane >> 3) + 8 * j; const LAS float* s = scr + (8 * c) * 33 + n;
        u32x4 o; o.x = pk2(s[0 * 33], s[1 * 33]); o.y = pk2(s[2 * 33], s[3 * 33]); o.z = pk2(s[4 * 33], s[5 * 33]); o.w = pk2(s[6 * 33], s[7 * 33]);
        *(u32x4*)(WT + (size_t)(n0 + n) * K + k0 + 8 * c) = o; }
    LDS_WAIT();
}
__device__ __forceinline__ void cvt_row(const float* src, bf16_t* dst, float* ss, int lane) {
    const f32x4* xr = (const f32x4*)src + lane; f32x4 v[8]; float s = 0.f;
#pragma unroll
    for (int j = 0; j < 8; ++j) { v[j] = xr[64 * j]; s += (v[j].x * v[j].x + v[j].y * v[j].y) + (v[j].z * v[j].z + v[j].w * v[j].w); }
    s = wave_sum(s);
    u32x2* o8 = (u32x2*)dst + lane;
#pragma unroll
    for (int j = 0; j < 8; ++j) { u32x2 w; w.x = pk2(v[j].x, v[j].y); w.y = pk2(v[j].z, v[j].w); o8[64 * j] = w; }
    if (lane == 0) *ss = s;
}

struct Mix {
    const float *conv_a_w, *conv_a_b, *lru_br, *lru_bi, *lru_lambda, *conv_b_w;
    const bf16_t* gw;
    bf16_t* U; bf16_t* Y; unsigned* HP; f32x2* AGG;
};
struct ItemId { int hd, b, c, row0, ntok, agg; bool meta; };
__device__ __forceinline__ ItemId decode_item(int id) {
    ItemId I;
    if (id < 16) { I.meta = true; I.hd = id; I.b = 0; I.c = 0; I.row0 = META0; I.ntok = 16; I.agg = 256; }
    else { const int j = id - 16; I.meta = false; I.hd = j & 15; I.c = (j >> 4) & 63; I.b = j >> 10; I.row0 = I.b * SEQ + I.c * 64; I.ntok = 64; I.agg = I.b * 64 + I.c; }
    return I;
}
constexpr int N_ITEMS = 16 + NBATCH * NHEAD * 64;

__device__ __forceinline__ void s1_item(const Mix& X, int id, LAS unsigned char* xt, int lane) {
    const ItemId I = decode_item(id);
    const int ch = I.hd * 64 + lane;
    const float w0 = X.conv_a_w[ch], w1 = X.conv_a_w[1024 + ch], w2 = X.conv_a_w[2048 + ch], w3 = X.conv_a_w[3072 + ch], cb = X.conv_a_b[ch];
    const float br = X.lru_br[ch], bi = X.lru_bi[ch];
    const float nls = -8.0f * log1pf(__expf(-X.lru_lambda[ch]));
    const bf16_t* up = X.U + (size_t)I.row0 * DIN + ch;
    float xm3 = 0.f, xm2 = 0.f, xm1 = 0.f;
    if (!I.meta) { const bf16_t* hp = (I.c == 0) ? X.U + (size_t)(META0 + 13) * DIN + ch : up - 3 * DIN; xm3 = bf1(hp[0]); xm2 = bf1(hp[DIN]); xm1 = bf1(hp[2 * DIN]); }
    float xc[64];
#pragma unroll
    for (int t = 0; t < 64; ++t) { const float x0 = bf1(up[(size_t)t * DIN]); xc[t] = cb + w0 * xm3 + w1 * xm2 + w2 * xm1 + w3 * x0; xm3 = xm2; xm2 = xm1; xm1 = x0; }
#pragma unroll
    for (int t = 0; t < 64; ++t) *(LAS bf16_t*)(xt + t * 144 + lane * 2) = (bf16_t)f2bf(xc[t]);
    bf16x8 BfR0[4], BfR1[4], BfI0[4], BfI1[4];
    { const bf16_t* gr = X.gw + (size_t)(I.hd * 64 + (lane & 31)) * 64 + 8 * (lane >> 5); const bf16_t* gi = gr + 16 * 64 * 64;
#pragma unroll
      for (int s = 0; s < 4; ++s) { BfR0[s] = *(const bf16x8*)(gr + 16 * s); BfR1[s] = *(const bf16x8*)(gr + 32 * 64 + 16 * s); BfI0[s] = *(const bf16x8*)(gi + 16 * s); BfI1[s] = *(const bf16x8*)(gi + 32 * 64 + 16 * s); } }
    float h = 0.f, P = 1.f;
    unsigned* hpo = X.HP + (size_t)I.row0 * DLRU + ch;
#pragma unroll
    for (int tb = 0; tb < 2; ++tb) {
        f32x16 aR0, aR1, aI0, aI1;
#pragma unroll
        for (int e = 0; e < 16; ++e) { aR0[e] = 0.f; aR1[e] = 0.f; aI0[e] = 0.f; aI1[e] = 0.f; }
#pragma unroll
        for (int s = 0; s < 4; ++s) {
            const bf16x8 af = *(const LAS bf16x8*)(xt + (tb * 32 + (lane & 31)) * 144 + (16 * s + 8 * (lane >> 5)) * 2);
            aR0 = __builtin_amdgcn_mfma_f32_32x32x16_bf16(af, BfR0[s], aR0, 0, 0, 0);
            aR1 = __builtin_amdgcn_mfma_f32_32x32x16_bf16(af, BfR1[s], aR1, 0, 0, 0);
            aI0 = __builtin_amdgcn_mfma_f32_32x32x16_bf16(af, BfI0[s], aI0, 0, 0, 0);
            aI1 = __builtin_amdgcn_mfma_f32_32x32x16_bf16(af, BfI1[s], aI1, 0, 0, 0);
        }
#pragma unroll
        for (int q = 0; q < 4; ++q) {
            float Rv[2][4], Iv[2][4];
#pragma unroll
            for (int k = 0; k < 4; ++k) {
                const int reg = 4 * q + k;
                const float r0f = aR0[reg], r1f = aR1[reg], i0f = aI0[reg], i1f = aI1[reg];
                auto r = __builtin_amdgcn_permlane32_swap(__float_as_uint(r0f), __float_as_uint(r1f), false, false);
                Rv[0][k] = __uint_as_float(r[0]); Rv[1][k] = __uint_as_float(r[1]);
                auto i2 = __builtin_amdgcn_permlane32_swap(__float_as_uint(i0f), __float_as_uint(i1f), false, false);
                Iv[0][k] = __uint_as_float(i2[0]); Iv[1][k] = __uint_as_float(i2[1]);
            }
#pragma unroll
            for (int st = 0; st < 2; ++st)
#pragma unroll
                for (int k = 0; k < 4; ++k) {
                    const int t = tb * 32 + 8 * q + 4 * st + k;
                    const float rg = sigmoidf_(Rv[st][k] + br), ig = sigmoidf_(Iv[st][k] + bi);
                    const float la = nls * rg;
                    float a = __expf(la);
                    float bb = sqrtf(-expm1f(2.0f * la)) * (ig * xc[t]);
                    if (t >= I.ntok) { a = 1.f; bb = 0.f; }
                    h = a * h + bb; P = P * a;
                    if (t < I.ntok) hpo[(size_t)t * DLRU] = pg8::cvt_pk_bf16(h, P);
                }
        }
    }
    f32x2 ag; ag.x = P; ag.y = h;
    X.AGG[(size_t)I.agg * 1024 + ch] = ag;
}

__device__ __forceinline__ void s2_item(const Mix& X, int id, int lane) {
    const ItemId I = decode_item(id);
    const int ch = I.hd * 64 + lane;
    float hin = 0.f;
    if (!I.meta) {
        hin = X.AGG[(size_t)256 * 1024 + ch].y;
        const f32x2* ap = X.AGG + (size_t)(I.b * 64) * 1024 + ch;
#pragma unroll 8
        for (int j = 0; j < I.c; ++j) { const f32x2 v = ap[(size_t)j * 1024]; hin = v.x * hin + v.y; }
    }
    const unsigned* hp = X.HP + (size_t)I.row0 * DLRU + ch;
    const bf16_t* gp = X.U + (size_t)I.row0 * DIN + 1024 + ch;
    bf16_t* yp = X.Y + (size_t)I.row0 * DM + ch;
    for (int t0 = 0; t0 < I.ntok; t0 += 16) {
#pragma unroll
        for (int k = 0; k < 16; ++k) {
            const int t = t0 + k;
            const unsigned w = hp[(size_t)t * DLRU]; const float g = bf1(gp[(size_t)t * DIN]);
            const float hv = bflo(w) + bfhi(w) * hin;
            yp[(size_t)t * DM] = (bf16_t)f2bf(hv * g * sigmoidf_(g));
        }
    }
}

__device__ __forceinline__ void ld8(const bf16_t* p, float (&o)[8]) {
    const u32x4 w = *(const u32x4*)p;
    o[0] = bflo(w.x); o[1] = bfhi(w.x); o[2] = bflo(w.y); o[3] = bfhi(w.y); o[4] = bflo(w.z); o[5] = bfhi(w.z); o[6] = bflo(w.w); o[7] = bfhi(w.w);
}
__device__ __forceinline__ void partb(const Mix& X, int tid) {
    for (int it = blockIdx.x * 512 + tid; it < 1025 * 128; it += gridDim.x * 512) {
        const int c0 = (it & 127) * 8, run = it >> 7;
        int row0, hrow = -1;
        if (run == 1024) row0 = META0; else { row0 = run * 16; hrow = ((row0 & (SEQ - 1)) == 0) ? META0 + 14 : row0 - 2; }
        float w0[8], w1[8], w2[8], cm2[8], cm1[8];
        { const f32x4* p = (const f32x4*)(X.conv_b_w + c0); const f32x4 a0 = p[0], a1 = p[1], b0 = p[256], b1 = p[257], d0 = p[512], d1 = p[513];
#pragma unroll
          for (int e = 0; e < 4; ++e) { w0[e] = a0[e]; w0[4 + e] = a1[e]; w1[e] = b0[e]; w1[4 + e] = b1[e]; w2[e] = d0[e]; w2[4 + e] = d1[e]; } }
        if (hrow >= 0) {
            float c[8], x[8];
            ld8(X.U + (size_t)hrow * DIN + 3072 + c0, c); ld8(X.U + (size_t)hrow * DIN + 4096 + c0, x);
#pragma unroll
            for (int e = 0; e < 8; ++e) cm2[e] = c[e] * x[e];
            ld8(X.U + (size_t)(hrow + 1) * DIN + 3072 + c0, c); ld8(X.U + (size_t)(hrow + 1) * DIN + 4096 + c0, x);
#pragma unroll
            for (int e = 0; e < 8; ++e) cm1[e] = c[e] * x[e];
        } else {
#pragma unroll
            for (int e = 0; e < 8; ++e) { cm2[e] = 0.f; cm1[e] = 0.f; }
        }
        const bf16_t* up = X.U + (size_t)row0 * DIN + c0;
        bf16_t* yp = X.Y + (size_t)row0 * DM + 1024 + c0;
#pragma unroll 4
        for (int t = 0; t < 16; ++t) {
            float bv[8], cv[8], xv[8], gv[8];
            ld8(up + (size_t)t * DIN + 2048, bv); ld8(up + (size_t)t * DIN + 3072, cv); ld8(up + (size_t)t * DIN + 4096, xv); ld8(up + (size_t)t * DIN + 5120, gv);
            float o[8];
#pragma unroll
            for (int e = 0; e < 8; ++e) { const float cx = cv[e] * xv[e]; const float y = w0[e] * cm2[e] + w1[e] * cm1[e] + w2[e] * cx; o[e] = bv[e] * y * (gv[e] * sigmoidf_(gv[e])); cm2[e] = cm1[e]; cm1[e] = cx; }
            u32x4 w; w.x = pk2(o[0], o[1]); w.y = pk2(o[2], o[3]); w.z = pk2(o[4], o[5]); w.w = pk2(o[6], o[7]);
            *(u32x4*)(yp + (size_t)t * DM) = w;
        }
    }
}


#ifdef DEBUG_NAIVE_MIX
__global__ void __launch_bounds__(64) naive_mixA(Mix X, const float* wr, const float* wi) {
    const int b = blockIdx.x / 16, hd = blockIdx.x % 16, lane = threadIdx.x, ch = hd * 64 + lane;
    __shared__ float xs[64];
    const float w0 = X.conv_a_w[ch], w1 = X.conv_a_w[1024 + ch], w2 = X.conv_a_w[2048 + ch], w3 = X.conv_a_w[3072 + ch], cb = X.conv_a_b[ch];
    const float br = X.lru_br[ch], bi = X.lru_bi[ch];
    const float sp = log1pf(expf(-X.lru_lambda[ch]));
    const float* wrh = wr + (size_t)hd * 4096 + lane; const float* wih = wi + (size_t)hd * 4096 + lane;
    float h = 0.f, xm3 = 0.f, xm2 = 0.f, xm1 = 0.f;
    for (int p = 0; p < NMETA + SEQ; ++p) {
        const int row = p < NMETA ? META0 + p : b * SEQ + (p - NMETA);
        const float x0 = bf1(X.U[(size_t)row * DIN + ch]);
        const float xc = cb + w0 * xm3 + w1 * xm2 + w2 * xm1 + w3 * x0; xm3 = xm2; xm2 = xm1; xm1 = x0;
        xs[lane] = xc; __syncthreads();
        float rp = br, ip = bi;
#pragma unroll 4
        for (int i = 0; i < 64; ++i) { rp += xs[i] * wrh[i * 64]; ip += xs[i] * wih[i * 64]; }
        __syncthreads();
        const float r = 1.f / (1.f + expf(-rp)), ig = 1.f / (1.f + expf(-ip));
        const float la = -8.f * r * sp; const float a = expf(la); const float bb = sqrtf(-expm1f(2.f * la)) * (ig * xc);
        h = a * h + bb;
        const float g = bf1(X.U[(size_t)row * DIN + 1024 + ch]);
        const float y = h * g / (1.f + expf(-g));
        if (p >= NMETA || b == 0) X.Y[(size_t)row * DM + ch] = (bf16_t)f2bf(y);
    }
}
__global__ void naive_mixB(Mix X) {
    for (size_t idx = (size_t)blockIdx.x * blockDim.x + threadIdx.x; idx < (size_t)(MROWS + NMETA) * 1024; idx += (size_t)gridDim.x * blockDim.x) {
        const int row = (int)(idx >> 10), c = (int)(idx & 1023);
        int r1, r2;
        if (row >= META0) { const int p = row - META0; r1 = p >= 1 ? row - 1 : -1; r2 = p >= 2 ? row - 2 : -1; }
        else { const int t = row & (SEQ - 1); r1 = t >= 1 ? row - 1 : META0 + 15; r2 = t >= 2 ? row - 2 : META0 + 14 + t; }
        auto cx = [&](int r) -> float { return r < 0 ? 0.f : bf1(X.U[(size_t)r * DIN + 3072 + c]) * bf1(X.U[(size_t)r * DIN + 4096 + c]); };
        const float y = X.conv_b_w[c] * cx(r2) + X.conv_b_w[1024 + c] * cx(r1) + X.conv_b_w[2048 + c] * cx(row);
        const float bv = bf1(X.U[(size_t)row * DIN + 2048 + c]), g = bf1(X.U[(size_t)row * DIN + 5120 + c]);
        X.Y[(size_t)row * DM + 1024 + c] = (bf16_t)f2bf(bv * y * g / (1.f + expf(-g)));
    }
}
#endif
__global__ void __launch_bounds__(512, 2) hymba_fwd(Args a) {
    extern __shared__ __attribute__((aligned(16))) unsigned char lds_raw[];
    LAS unsigned char* lds = (LAS unsigned char*)lds_raw;
    cg::grid_group grid = cg::this_grid();
    const int NGW = gridDim.x * 8;
#define LAUNDER() int tid = threadIdx.x; asm volatile("" : "+v"(tid)); const int wid = __builtin_amdgcn_readfirstlane(tid >> 6), lane = tid & 63, gw = blockIdx.x * 8 + wid
    const int lo = a.ph_lo, hi = a.ph_hi;
#define IN(k) (lo <= (k) && (k) < hi)
#define SEAM(k) do { if (IN(k) && IN((k) + 1)) { asm volatile("s_waitcnt vmcnt(0)" ::: "memory"); grid.sync(); } } while (0)
    const float* x = a.in[0]; const float* meta = a.in[1]; const float* norm_g = a.in[2]; const float* w_in = a.in[3];
    const float* conv_a_w = a.in[4]; const float* conv_a_b = a.in[5]; const float* lru_wr = a.in[6]; const float* lru_br = a.in[7];
    const float* lru_wi = a.in[8]; const float* lru_bi = a.in[9]; const float* lru_lambda = a.in[10]; const float* conv_b_w = a.in[11];
    const float* w_out = a.in[12]; const float* final_g = a.in[13];
    unsigned char* ws = a.ws;
    bf16_t* WTIN = (bf16_t*)(ws + WS_WTIN); bf16_t* WTOUT = (bf16_t*)(ws + WS_WTOUT); bf16_t* GW = (bf16_t*)(ws + WS_GW);
    float* ROWSS = (float*)(ws + WS_ROWSS); f32x2* AGG = (f32x2*)(ws + WS_AGG);
    bf16_t* XB = (bf16_t*)(ws + WS_XB); bf16_t* Y = (bf16_t*)(ws + WS_Y); unsigned* HP = (unsigned*)(ws + WS_HP); bf16_t* U = (bf16_t*)(ws + WS_U);

    if (IN(0)) {
        LAUNDER();
        LAS float* scr = (LAS float*)(lds + wid * 16384);
        constexpr int I_IN = (DM / 64) * (DIN / 32), I_OUT = (DM / 64) * (DM / 32), I_G = 2;
        constexpr int NIT = 2 * I_IN + 2 * I_OUT + 64 * I_G;
        for (int it = gw; it < NIT; it += NGW) {
            int r = it;
            if (r < 2 * I_IN) { const int l = r / I_IN; tr_item(w_in + (size_t)l * DM * DIN, DM, DIN, WTIN + (size_t)l * DIN * DM, norm_g + l * DM, scr, r % I_IN, lane); continue; } r -= 2 * I_IN;
            if (r < 2 * I_OUT) { const int l = r / I_OUT; tr_item(w_out + (size_t)l * DM * DM, DM, DM, WTOUT + (size_t)l * DM * DM, nullptr, scr, r % I_OUT, lane); continue; } r -= 2 * I_OUT;
            { const int mtx = r >> 1, l = mtx >> 5, g = (mtx >> 4) & 1, hd = mtx & 15;
              const float* src = (g ? lru_wi : lru_wr) + (size_t)(l * 16 + hd) * 4096;
              tr_item(src, 64, 64, GW + (size_t)mtx * 4096, nullptr, scr, r & 1, lane); }
        }
        for (int m = gw; m < MROWS + NMETA; m += NGW) {
            const float* src = m < MROWS ? x + (size_t)m * DM : meta + (size_t)(m - MROWS) * DM;
            cvt_row(src, XB + (size_t)m * DM, ROWSS + m, lane);
        }
        for (int i = blockIdx.x * 512 + tid; i < 2 * RSTR; i += gridDim.x * 512) ROWSS[RSTR + i] = 0.f;
    }
    SEAM(0);

#pragma unroll 1
    for (int l = 0; l < 2; ++l) {
        const int pb = 1 + 4 * l;
        const bf16_t* wtin = WTIN + (size_t)l * DIN * DM; const bf16_t* wtout = WTOUT + (size_t)l * DM * DM;
        float* rss_in = ROWSS + (size_t)l * RSTR; float* rss_out = ROWSS + (size_t)(l + 1) * RSTR;
        Mix X; X.conv_a_w = conv_a_w + l * 4 * DLRU; X.conv_a_b = conv_a_b + l * DLRU; X.lru_br = lru_br + l * DLRU; X.lru_bi = lru_bi + l * DLRU; X.lru_lambda = lru_lambda + l * DLRU;
        X.conv_b_w = conv_b_w + l * 3 * DLRU; X.gw = GW + (size_t)l * 2 * 16 * 4096; X.U = U; X.Y = Y; X.HP = HP; X.AGG = AGG;

        if (IN(pb)) {
            LAUNDER();
            meta_gemm(XB + (size_t)META0 * DM, wtin, DIN / 16, lds, wid, lane, [&](int m, int n0, f32x4 s) {
                const float rs = rsqrtf(rss_in[META0 + m] * (1.0f / DM) + RMS_EPS);
                u32x2 w; w.x = pk2(s[0] * rs, s[1] * rs); w.y = pk2(s[2] * rs, s[3] * rs);
                *(u32x2*)(U + (size_t)(META0 + m) * DIN + n0) = w; });
            pg8::Gemm g{XB, wtin, MROWS, DIN, DM}; pg8::StaticOrder S; S.init(MROWS, DIN, (int)gridDim.x, (int)blockIdx.x);
            EpiU E{U, rss_in};
            pg8::gemm_phase<EpiU, pg8::StaticOrder, false>(lds, g, S, E, nullptr);
        }
        SEAM(pb);
        if (IN(pb + 1)) {
            LAUNDER();
            if (!(a.flags & 1)) for (int id = gw; id < N_ITEMS; id += NGW) s1_item(X, id, lds + wid * 9216, lane);
            if (!(a.flags & 2)) partb(X, tid);
        }
        SEAM(pb + 1);
        if (IN(pb + 2)) {
            LAUNDER();
            for (int id = gw; id < N_ITEMS; id += NGW) s2_item(X, id, lane);
        }
        SEAM(pb + 2);
        if (IN(pb + 3)) {
            LAUNDER();
            if (l == 0) {
                meta_gemm(Y + (size_t)META0 * DM, wtout, DM / 16, lds, wid, lane, [&](int m, int n0, f32x4 s) {
                    const f32x4 r = *(const f32x4*)(meta + (size_t)m * DM + n0); const f32x4 hh = r + s;
                    u32x2 w; w.x = pk2(hh[0], hh[1]); w.y = pk2(hh[2], hh[3]);
                    *(u32x2*)(XB + (size_t)(META0 + m) * DM + n0) = w;
                    unsafeAtomicAdd(rss_out + META0 + m, (hh[0] * hh[0] + hh[1] * hh[1]) + (hh[2] * hh[2] + hh[3] * hh[3])); });
            }
            pg8::Gemm g{Y, wtout, MROWS, DM, DM}; pg8::StaticOrder S; S.init(MROWS, DM, (int)gridDim.x, (int)blockIdx.x);
            EpiRes E{l == 0 ? x : a.out, a.out, l == 0 ? XB : nullptr, rss_out};
            pg8::gemm_phase<EpiRes, pg8::StaticOrder, false>(lds, g, S, E, nullptr);
        }
        SEAM(pb + 3);
    }

    if (IN(9)) {
        LAUNDER();
        const float* rss = ROWSS + (size_t)2 * RSTR;
        for (int m = gw; m < MROWS; m += NGW) {
            const float rs = rsqrtf(rss[m] * (1.0f / DM) + RMS_EPS);
            f32x4* p = (f32x4*)(a.out + (size_t)m * DM) + lane; const f32x4* gp = (const f32x4*)final_g + lane;
            f32x4 v[8];
#pragma unroll
            for (int j = 0; j < 8; ++j) v[j] = p[64 * j];
#pragma unroll
            for (int j = 0; j < 8; ++j) p[64 * j] = v[j] * rs * gp[64 * j];
        }
    }
#undef IN
#undef SEAM
}

#ifndef MK_LAUNCH_PER_PHASE
#define MK_LAUNCH_PER_PHASE 0
#endif
extern "C" void kernel_launch(void* const* d_in, const int* in_sizes, int n_in, void* d_out, int out_size, void* d_ws, size_t ws_size, hipStream_t stream) {
    static int grid = 0;
    if (grid == 0) {
        if (n_in != 14 || in_sizes[0] != MROWS * DM || out_size != MROWS * DM || ws_size < WS_END) { fprintf(stderr, "kernel_launch: unexpected shapes (n_in %d, in0 %d, out %d, ws %zu)\n", n_in, n_in > 0 ? in_sizes[0] : -1, out_size, ws_size); grid = -1; return; }
        int dev = 0, cus = 0, per_cu = 0;
        hipGetDevice(&dev); hipDeviceGetAttribute(&cus, hipDeviceAttributeMultiprocessorCount, dev);
        if (hipFuncSetAttribute((const void*)hymba_fwd, hipFuncAttributeMaxDynamicSharedMemorySize, LDS_BYTES) != hipSuccess) { fprintf(stderr, "kernel_launch: hipFuncSetAttribute failed\n"); grid = -1; return; }
        if (hipOccupancyMaxActiveBlocksPerMultiprocessor(&per_cu, (const void*)hymba_fwd, 512, LDS_BYTES) != hipSuccess || per_cu < 1) { fprintf(stderr, "kernel_launch: occupancy query gave %d\n", per_cu); per_cu = 1; }
        (void)hipGetLastError();
        grid = cus * per_cu;
    }
    if (grid < 0) return;
    Args a{};
    for (int i = 0; i < 14; ++i) a.in[i] = (const float*)d_in[i];
    a.out = (float*)d_out; a.ws = (unsigned char*)d_ws;
#if MK_LAUNCH_PER_PHASE
    for (int p = 0; p < NPHASE; ++p) {
#ifdef DEBUG_NAIVE_MIX
        if (p == 2 || p == 6) { const int l = p / 4; unsigned char* ws = (unsigned char*)d_ws;
            Mix X; X.conv_a_w = a.in[4] + l * 4 * DLRU; X.conv_a_b = a.in[5] + l * DLRU; X.lru_br = a.in[7] + l * DLRU; X.lru_bi = a.in[9] + l * DLRU; X.lru_lambda = a.in[10] + l * DLRU;
            X.conv_b_w = a.in[11] + l * 3 * DLRU; X.gw = nullptr; X.U = (bf16_t*)(ws + WS_U); X.Y = (bf16_t*)(ws + WS_Y); X.HP = nullptr; X.AGG = nullptr;
#if DEBUG_NAIVE_MIX == 1
            hipLaunchKernelGGL(naive_mixA, dim3(64), dim3(64), 0, stream, X, a.in[6] + (size_t)l * 16 * 4096, a.in[8] + (size_t)l * 16 * 4096);
            a.flags = 1;
#else
            hipLaunchKernelGGL(naive_mixB, dim3(2048), dim3(256), 0, stream, X);
            a.flags = 2;
#endif
            }
        else a.flags = 0;
#if DEBUG_NAIVE_MIX == 1
        if (p == 3 || p == 7) continue;
#endif
#endif
        a.ph_lo = p; a.ph_hi = p + 1; hipLaunchKernelGGL(hymba_fwd, dim3(grid), dim3(512), LDS_BYTES, stream, a); }
#else
    a.ph_lo = 0; a.ph_hi = NPHASE;
    void* args[] = {&a};
    const hipError_t e = hipLaunchCooperativeKernel((const void*)hymba_fwd, dim3(grid), dim3(512), args, LDS_BYTES, stream);
    if (e != hipSuccess) fprintf(stderr, "kernel_launch: cooperative launch failed: %s (grid %d)\n", hipGetErrorString(e), grid);
#endif
}
```

```cpp
#include <hip/hip_runtime.h>
#include <hip/hip_cooperative_groups.h>
#include <cstdio>
namespace cg = cooperative_groups;
namespace pg8 {
#define PG8_LAS __attribute__((address_space(3)))
typedef unsigned short bf16_t;
typedef short bf16x8 __attribute__((ext_vector_type(8)));
typedef float f32x4 __attribute__((ext_vector_type(4)));
typedef unsigned u32x4 __attribute__((ext_vector_type(4)));
constexpr int BM = 256, BK = 64, HALF = 128, HTB = HALF * BK * 2  , STAGE_BYTES = 8 * HTB, NXCD = 8, WGM = 8;

__host__ __device__ __forceinline__ int lds_byte(int r, int c) { const int st = (r >> 4) * 2 + (c >> 5), rr = r & 15, cc = c & 31, ob = rr * 64 + cc * 2; return st * 1024 + (ob ^ (((ob >> 9) & 1) << 5)); }
__host__ __device__ __forceinline__ void stage_rc(int b, int& R, int& C) { const int st = b / 1024, sb = b % 1024, swz = sb ^ (((sb >> 9) & 1) << 5); R = (st >> 1) * 16 + swz / 64; C = (st & 1) * 32 + (swz % 64) / 2; }
__host__ __device__ __forceinline__ int perm32(int rho) { const int n = rho >> 4, i = rho & 15; return 8 * (i >> 2) + 4 * n + (i & 3); }

struct Unit { int pm, pn; };
struct Gemm { const bf16_t* A; const bf16_t* Bt; int M, N, K; };

struct StaticOrder {
    int nM, nN, nwg, G, c;
    __host__ __device__ void init(int M, int N, int G_, int c_) { nM = M / BM; nN = N / BM; nwg = nM * nN; G = G_; c = c_; }
    __host__ __device__ bool next(int i, Unit& u) const {
        const long L = (long)i * G + c; if (L >= nwg) return false;
        int wgid = (int)L; { const int q = nwg / NXCD, r = nwg % NXCD, xcd = wgid % NXCD, off = wgid / NXCD; wgid = (xcd < r ? xcd * (q + 1) : r * (q + 1) + (xcd - r) * q) + off; }
        const int nig = WGM * nN, gid = wgid / nig, fm = gid * WGM, gsz = (nM - fm) < WGM ? (nM - fm) : WGM;
        u.pm = fm + ((wgid % nig) % gsz); u.pn = (wgid % nig) / gsz; return true;
    }
    __device__ __forceinline__ void a_ready(const Unit&) const {}
    __device__ __forceinline__ void done(const Unit&) const {}
};
__device__ __forceinline__ unsigned cvt_pk_bf16(float lo, float hi) { unsigned r; asm volatile("v_cvt_pk_bf16_f32 %0, %1, %2" : "=v"(r) : "v"(lo), "v"(hi)); return r; }
template <class Epi, class Sched, bool STAMP = false>
__device__ __forceinline__ void gemm_phase(PG8_LAS unsigned char* lds, const Gemm g, const Sched& S, const Epi& E, unsigned long long* stamps) {
    int tid_l = threadIdx.x; asm volatile("" : "+v"(tid_l));
    const int tid = tid_l, wid = __builtin_amdgcn_readfirstlane(tid >> 6), lane = tid & 63, wr = wid >> 2, wc = wid & 3, fr = lane & 15, fq = lane >> 4;
    const int K = g.K, nt = K / BK;
    int ts_lo = 0, ts_hi = 0, nts = 0; const unsigned long long rt_entry = STAMP ? (unsigned long long)wall_clock64() : 0ull;
#define PG8_STAMP() do { if (STAMP && wid == 0 && nts < 64) { const unsigned long long _c = (unsigned long long)clock64(); \
        ts_lo = (lane == nts) ? (int)(unsigned)_c : ts_lo; ts_hi = (lane == nts) ? (int)(unsigned)(_c >> 32) : ts_hi; ++nts; } } while (0)
    PG8_STAMP();
    unsigned voffA[2], voffB[2];
#pragma unroll
    for (int i = 0; i < 2; ++i) { int R, C; stage_rc(tid * 16 + i * 8192, R, C); const int Rb = Epi::PERM ? ((R & ~31) + perm32(R & 31)) : R;
        voffA[i] = (unsigned)(R * K + C) * 2u; voffB[i] = (unsigned)(Rb * K + C) * 2u; }
    const size_t kstep = (size_t)(BK * 2);
    const size_t hstep = (size_t)HALF * K * 2;
    const size_t tstep = 2 * hstep;
    const unsigned ldsw = (unsigned)wid * 1024u;
    const int aoff = lds_byte(wr * 64 + fr, fq * 8), boff = lds_byte(wc * 32 + fr, fq * 8);
#define PG8_SA(b, h) (((b) * 2 + (h)) * HTB)
#define PG8_SB(b, h) ((4 + (b) * 2 + (h)) * HTB)
#define PG8_STAGE(bufoff, gbase, voff) do { _Pragma("unroll") for (int _i = 0; _i < 2; ++_i) \
        __builtin_amdgcn_global_load_lds((const unsigned*)((const char*)(gbase) + (voff)[_i]), (PG8_LAS unsigned*)(lds + (bufoff) + ldsw + _i * 8192), 16, 0, 0); } while (0)
#define PG8_LDA(dst, b, h) do { _Pragma("unroll") for (int m = 0; m < 4; ++m) _Pragma("unroll") for (int k = 0; k < 2; ++k) dst[m][k] = *(const PG8_LAS bf16x8*)(lds + PG8_SA(b, h) + aoff + m * 2048 + k * 1024); } while (0)
#define PG8_LDB(dst, b, h) do { _Pragma("unroll") for (int n = 0; n < 2; ++n) _Pragma("unroll") for (int k = 0; k < 2; ++k) dst[n][k] = *(const PG8_LAS bf16x8*)(lds + PG8_SB(b, h) + boff + n * 2048 + k * 1024); } while (0)
#define PG8_MMA(ai, bj, At, Bt) do { __builtin_amdgcn_s_setprio(1); _Pragma("unroll") for (int m = 0; m < 4; ++m) _Pragma("unroll") for (int n = 0; n < 2; ++n) _Pragma("unroll") for (int k = 0; k < 2; ++k) \
        acc[ai][bj][m][n] = __builtin_amdgcn_mfma_f32_16x16x32_bf16(Bt[n][k], At[m][k], acc[ai][bj][m][n], 0, 0, 0); __builtin_amdgcn_s_setprio(0); } while (0)
#define PG8_WAIT_V(n) asm volatile("s_waitcnt vmcnt(" #n ")" ::: "memory")
#define PG8_WAIT_L(n) asm volatile("s_waitcnt lgkmcnt(" #n ")" ::: "memory")
#define PG8_BAR __builtin_amdgcn_s_barrier()
#define PG8_SCHED __builtin_amdgcn_sched_barrier(0)
    Unit cur, nxt; int ui = 0;
    if (!S.next(0, cur)) return;
    f32x4 acc[2][2][4][2];
#pragma unroll
    for (int a = 0; a < 2; ++a)
#pragma unroll
        for (int b = 0; b < 2; ++b)
#pragma unroll
            for (int m = 0; m < 4; ++m)
#pragma unroll
                for (int n = 0; n < 2; ++n) acc[a][b][m][n] = (f32x4){0.f, 0.f, 0.f, 0.f};
    bf16x8 At[4][2], B0[2][2], B1[2][2];
    const char* cA = (const char*)g.A + (size_t)cur.pm * tstep; const char* cB = (const char*)g.Bt + (size_t)cur.pn * tstep;
    S.a_ready(cur);
    PG8_STAGE(PG8_SB(0, 0), cB, voffB); PG8_STAGE(PG8_SA(0, 0), cA, voffA); PG8_STAGE(PG8_SB(0, 1), cB + hstep, voffB); PG8_STAGE(PG8_SA(0, 1), cA + hstep, voffA);
    if (wr == 1) PG8_BAR;
    PG8_WAIT_V(4); PG8_BAR;
    PG8_STAGE(PG8_SB(1, 0), cB + kstep, voffB); PG8_STAGE(PG8_SA(1, 0), cA + kstep, voffA); PG8_STAGE(PG8_SB(1, 1), cB + hstep + kstep, voffB);
    PG8_WAIT_V(6); PG8_BAR;
    PG8_STAMP();
    for (;;) {
        const bool has_next = S.next(ui + 1, nxt);
        const char* nA = has_next ? (const char*)g.A + (size_t)nxt.pm * tstep : cA; const char* nB = has_next ? (const char*)g.Bt + (size_t)nxt.pn * tstep : cB;
        for (int t = 0; t < nt; t += 2) {
            const bool last = (t == nt - 2);
            const char* a1 = cA + (size_t)(t + 1) * kstep;
            const char* a2 = last ? nA : cA + (size_t)(t + 2) * kstep; const char* b2 = last ? nB : cB + (size_t)(t + 2) * kstep;
            const char* a3 = a2 + kstep; const char* b3 = b2 + kstep;
            if (last && has_next) S.a_ready(nxt);
            PG8_LDB(B0, 0, 0); PG8_SCHED; PG8_LDA(At, 0, 0); PG8_STAGE(PG8_SA(1, 1), a1 + hstep, voffA);
            PG8_WAIT_L(8); PG8_BAR; PG8_WAIT_L(0); PG8_MMA(0, 0, At, B0); PG8_BAR; PG8_SCHED;
            PG8_LDB(B1, 0, 1); PG8_STAGE(PG8_SB(0, 0), b2, voffB);
            PG8_BAR; PG8_WAIT_L(0); PG8_MMA(0, 1, At, B1); PG8_BAR;
            PG8_LDA(At, 0, 1); PG8_STAGE(PG8_SA(0, 0), a2, voffA);
            PG8_BAR; PG8_WAIT_L(0); PG8_MMA(1, 0, At, B0); PG8_BAR; PG8_SCHED;
            PG8_STAGE(PG8_SB(0, 1), b2 + hstep, voffB);
            PG8_WAIT_V(6); PG8_BAR; PG8_MMA(1, 1, At, B1); PG8_BAR;
            PG8_LDB(B0, 1, 0); PG8_SCHED; PG8_LDA(At, 1, 0); PG8_STAGE(PG8_SA(0, 1), a2 + hstep, voffA);
            PG8_WAIT_L(8); PG8_BAR; PG8_WAIT_L(0); PG8_MMA(0, 0, At, B0); PG8_BAR; PG8_SCHED;
            PG8_LDB(B1, 1, 1); PG8_STAGE(PG8_SB(1, 0), b3, voffB);
            PG8_BAR; PG8_WAIT_L(0); PG8_MMA(0, 1, At, B1); PG8_BAR;
            PG8_LDA(At, 1, 1); PG8_STAGE(PG8_SA(1, 0), a3, voffA);
            PG8_BAR; PG8_WAIT_L(0); PG8_MMA(1, 0, At, B0); PG8_BAR; PG8_SCHED;
            PG8_STAGE(PG8_SB(1, 1), b3 + hstep, voffB);
            PG8_WAIT_V(6); PG8_BAR; PG8_MMA(1, 1, At, B1); PG8_BAR;
        }
        PG8_STAMP();
        if constexpr (!Epi::AFTER_DRAIN) { E(acc, cur, wr, wc, fr, fq); S.done(cur); }
        PG8_STAMP();
        if (!has_next) break;
#pragma unroll
        for (int a = 0; a < 2; ++a)
#pragma unroll
            for (int b = 0; b < 2; ++b)
#pragma unroll
                for (int m = 0; m < 4; ++m)
#pragma unroll
                    for (int n = 0; n < 2; ++n) acc[a][b][m][n] = (f32x4){0.f, 0.f, 0.f, 0.f};
        cur = nxt; cA = nA; cB = nB; ++ui;
    }
    PG8_WAIT_V(0);
    if (wr == 0) PG8_BAR;
    PG8_BAR;
    if constexpr (Epi::AFTER_DRAIN) { E.fused(acc, cur, wr, wc, fr, fq, lds, wid, lane); S.done(cur); }
    PG8_STAMP();
    if (STAMP && wid == 0) { stamps[lane] = lane < nts ? (((unsigned long long)(unsigned)ts_hi << 32) | (unsigned)ts_lo) : 0ull;
        if (lane == 62) stamps[62] = rt_entry; if (lane == 63) stamps[63] = (unsigned long long)wall_clock64(); }
#undef PG8_STAMP
#undef PG8_SA
#undef PG8_SB
#undef PG8_STAGE
#undef PG8_LDA
#undef PG8_LDB
#undef PG8_MMA
#undef PG8_WAIT_V
#undef PG8_WAIT_L
#undef PG8_BAR
#undef PG8_SCHED
}
}

#define LAS __attribute__((address_space(3)))
typedef unsigned short bf16_t;
typedef short bf16x8 __attribute__((ext_vector_type(8)));
typedef float f32x4 __attribute__((ext_vector_type(4)));
typedef float f32x2 __attribute__((ext_vector_type(2)));
typedef float f32x16 __attribute__((ext_vector_type(16)));
typedef unsigned u32x4 __attribute__((ext_vector_type(4)));
typedef unsigned u32x2 __attribute__((ext_vector_type(2)));

constexpr int DM = 2048, NBATCH = 4, SEQ = 4096, MROWS = NBATCH * SEQ, NMETA = 16, DIN = 6144, DLRU = 1024, NHEAD = 16;
constexpr int META0 = MROWS;
constexpr int RSTR = MROWS + 64;
constexpr float RMS_EPS = 1e-6f;
constexpr int NPHASE = 10;
#ifndef REP_MASK
#define REP_MASK 0
#endif
constexpr int LDS_BYTES = 131072 + 256;

constexpr size_t MiB = 1u << 20;
constexpr size_t WS_WTIN = 0;
constexpr size_t WS_WTOUT = 48 * MiB;
constexpr size_t WS_GW = 64 * MiB;
constexpr size_t WS_ROWSS = 65 * MiB;
constexpr size_t WS_BAR = 65 * MiB + 512 * 1024;
constexpr size_t WS_AGG = 66 * MiB;
constexpr size_t WS_XB = 70 * MiB;
constexpr size_t WS_Y = 135 * MiB;
constexpr size_t WS_HP = 200 * MiB;
constexpr size_t WS_U = 265 * MiB;
constexpr size_t WS_END = 460 * MiB;
static_assert(WS_U + (size_t)RSTR * DIN * 2 <= WS_END && WS_HP + (size_t)RSTR * DLRU * 4 <= WS_U && WS_Y + (size_t)RSTR * DM * 2 <= WS_HP && WS_XB + (size_t)RSTR * DM * 2 <= WS_Y, "ws map");
static_assert(WS_WTIN + (size_t)2 * DIN * DM * 2 <= WS_WTOUT && WS_WTOUT + (size_t)2 * DM * DM * 2 <= WS_GW && WS_AGG + (size_t)257 * 1024 * 8 <= WS_XB && WS_ROWSS + (size_t)3 * RSTR * 4 <= WS_AGG, "ws map 2");

struct Args { const float* in[14]; float* out; unsigned char* ws; int ph_lo, ph_hi, flags, pad; };

__device__ __forceinline__ unsigned f2bf(float f) { unsigned u = __builtin_bit_cast(unsigned, f); return (u + 0x7fffu + ((u >> 16) & 1u)) >> 16; }
__device__ __forceinline__ unsigned pk2(float lo, float hi) { return f2bf(lo) | (f2bf(hi) << 16); }
__device__ __forceinline__ float bflo(unsigned w) { return __builtin_bit_cast(float, w << 16); }
__device__ __forceinline__ float bfhi(unsigned w) { return __builtin_bit_cast(float, w & 0xffff0000u); }
__device__ __forceinline__ float bf1(bf16_t v) { return __builtin_bit_cast(float, ((unsigned)v) << 16); }
__device__ __forceinline__ float sigmoidf_(float z) { return __builtin_amdgcn_rcpf(1.0f + __expf(-z)); }
__device__ __forceinline__ float wave_sum(float v) {
#pragma unroll
    for (int o = 1; o < 64; o <<= 1) v += __shfl_xor(v, o);
    return v;
}
#define LDS_WAIT() asm volatile("s_waitcnt lgkmcnt(0)" ::: "memory")

struct EpiU {
    static constexpr bool PERM = true, AFTER_DRAIN = false;
    bf16_t* O; const float* rowss;
    __device__ __forceinline__ void operator()(const f32x4 (&acc)[2][2][4][2], const pg8::Unit& u, int wr, int wc, int fr, int fq) const {
        const int row0 = u.pm * 256 + wr * 64 + fr, col0 = u.pn * 256 + wc * 32 + 8 * fq;
#pragma unroll
        for (int ai = 0; ai < 2; ++ai)
#pragma unroll
            for (int m = 0; m < 4; ++m) {
                const int r = row0 + ai * 128 + m * 16;
                const float rs = rsqrtf(rowss[r] * (1.0f / DM) + RMS_EPS);
                bf16_t* rowp = O + (size_t)r * DIN + col0;
#pragma unroll
                for (int bj = 0; bj < 2; ++bj) {
                    const f32x4 v0 = acc[ai][bj][m][0] * rs, v1 = acc[ai][bj][m][1] * rs;
                    u32x4 w; w.x = pg8::cvt_pk_bf16(v0[0], v0[1]); w.y = pg8::cvt_pk_bf16(v0[2], v0[3]); w.z = pg8::cvt_pk_bf16(v1[0], v1[1]); w.w = pg8::cvt_pk_bf16(v1[2], v1[3]);
                    *(u32x4*)(rowp + bj * 128) = w;
                }
            }
    }
};
struct EpiRes {
    static constexpr bool PERM = true, AFTER_DRAIN = false;
    const float* res; float* out; bf16_t* xb; float* rowss;
    __device__ __forceinline__ void operator()(const f32x4 (&acc)[2][2][4][2], const pg8::Unit& u, int wr, int wc, int fr, int fq) const {
        const int row0 = u.pm * 256 + wr * 64 + fr, col0 = u.pn * 256 + wc * 32 + 8 * fq;
#pragma unroll
        for (int ai = 0; ai < 2; ++ai)
#pragma unroll
            for (int m = 0; m < 4; ++m) {
                const int r = row0 + ai * 128 + m * 16; const size_t off = (size_t)r * DM + col0; float ss = 0.f;
#pragma unroll
                for (int bj = 0; bj < 2; ++bj) {
                    const f32x4 r0 = *(const f32x4*)(res + off + bj * 128), r1 = *(const f32x4*)(res + off + bj * 128 + 4);
                    const f32x4 h0 = r0 + acc[ai][bj][m][0], h1 = r1 + acc[ai][bj][m][1];
                    *(f32x4*)(out + off + bj * 128) = h0; *(f32x4*)(out + off + bj * 128 + 4) = h1;
                    if (xb) { u32x4 w; w.x = pg8::cvt_pk_bf16(h0[0], h0[1]); w.y = pg8::cvt_pk_bf16(h0[2], h0[3]); w.z = pg8::cvt_pk_bf16(h1[0], h1[1]); w.w = pg8::cvt_pk_bf16(h1[2], h1[3]);
                        *(u32x4*)(xb + off + bj * 128) = w; }
                    ss += (h0[0] * h0[0] + h0[1] * h0[1]) + (h0[2] * h0[2] + h0[3] * h0[3]) + (h1[0] * h1[0] + h1[1] * h1[1]) + (h1[2] * h1[2] + h1[3] * h1[3]);
                }
                ss += __shfl_xor(ss, 16); ss += __shfl_xor(ss, 32);
                if (fq == 0) unsafeAtomicAdd(rowss + r, ss);
                asm volatile("" ::: "memory");
            }
    }
};

template <class F> __device__ __forceinline__ void meta_gemm(const bf16_t* A, const bf16_t* Bt, int ngroups, LAS unsigned char* lds, int wid, int lane, F epi) {
    const int fr = lane & 15, fq = lane >> 4;
    LAS f32x4* red = (LAS f32x4*)lds;
    for (int g = blockIdx.x; g < ngroups; g += gridDim.x) {
        f32x4 acc = {0.f, 0.f, 0.f, 0.f};
        const bf16_t* ap = A + (size_t)fr * DM + wid * 256 + fq * 8;
        const bf16_t* bp = Bt + (size_t)(g * 16 + fr) * DM + wid * 256 + fq * 8;
#pragma unroll
        for (int s = 0; s < 8; ++s) {
            const bf16x8 a = *(const bf16x8*)(ap + 32 * s), b = *(const bf16x8*)(bp + 32 * s);
            acc = __builtin_amdgcn_mfma_f32_16x16x32_bf16(b, a, acc, 0, 0, 0);
        }
        red[wid * 64 + lane] = acc;
        __syncthreads();
        if (wid == 0) {
            f32x4 s = red[lane];
#pragma unroll
            for (int w = 1; w < 8; ++w) s += red[w * 64 + lane];
            epi(fr, g * 16 + 4 * fq, s);
        }
        __syncthreads();
    }
}

__device__ __forceinline__ void tr_item(const float* W, int K, int N, bf16_t* WT, const float* sc, LAS float* scr, int item, int lane) {
    const int nblk = N / 32, kb = item / nblk, nb = item % nblk, k0 = 64 * kb, n0 = 32 * nb;
#pragma unroll 8
    for (int i = 0; i < 32; ++i) { const int kk = 2 * i + (lane >> 5); float v = W[(size_t)(k0 + kk) * N + n0 + (lane & 31)]; if (sc) v *= sc[k0 + kk]; scr[kk * 33 + (lane & 31)] = v; }
    LDS_WAIT();
    const int c = lane & 7;
#pragma unroll
    for (int j = 0; j < 4; ++j) { const int n = (lane >> 3) + 8 * j; const LAS float* s = scr + (8 * c) * 33 + n;
        u32x4 o; o.x = pk2(s[0 * 33], s[1 * 33]); o.y = pk2(s[2 * 33], s[3 * 33]); o.z = pk2(s[4 * 33], s[5 * 33]); o.w = pk2(s[6 * 33], s[7 * 33]);
        *(u32x4*)(WT + (size_t)(n0 + n) * K + k0 + 8 * c) = o; }
    LDS_WAIT();
}
__device__ __forceinline__ void cvt_row(const float* src, bf16_t* dst, float* ss, int lane) {
    const f32x4* xr = (const f32x4*)src + lane; f32x4 v[8]; float s = 0.f;
#pragma unroll
    for (int j = 0; j < 8; ++j) { v[j] = xr[64 * j]; s += (v[j].x * v[j].x + v[j].y * v[j].y) + (v[j].z * v[j].z + v[j].w * v[j].w); }
    s = wave_sum(s);
    u32x2* o8 = (u32x2*)dst + lane;
#pragma unroll
    for (int j = 0; j < 8; ++j) { u32x2 w; w.x = pk2(v[j].x, v[j].y); w.y = pk2(v[j].z, v[j].w); o8[64 * j] = w; }
    if (lane == 0) *ss = s;
}

struct Mix {
    const float *conv_a_w, *conv_a_b, *lru_br, *lru_bi, *lru_lambda, *conv_b_w;
    const bf16_t* gw;
    bf16_t* U; bf16_t* Y; unsigned* HP; f32x2* AGG;
};
struct ItemId { int hd, b, c, row0, ntok, agg; bool meta; };
__device__ __forceinline__ ItemId decode_item(int id) {
    ItemId I;
    if (id < 16) { I.meta = true; I.hd = id; I.b = 0; I.c = 0; I.row0 = META0; I.ntok = 16; I.agg = 256; }
    else { const int j = id - 16; I.meta = false; I.hd = j & 15; I.c = (j >> 4) & 63; I.b = j >> 10; I.row0 = I.b * SEQ + I.c * 64; I.ntok = 64; I.agg = I.b * 64 + I.c; }
    return I;
}
constexpr int N_ITEMS = 16 + NBATCH * NHEAD * 64;

__device__ __forceinline__ void s1_item(const Mix& X, int id, LAS unsigned char* xt, int lane) {
    const ItemId I = decode_item(id);
    const int ch = I.hd * 64 + lane;
    const float w0 = X.conv_a_w[ch], w1 = X.conv_a_w[1024 + ch], w2 = X.conv_a_w[2048 + ch], w3 = X.conv_a_w[3072 + ch], cb = X.conv_a_b[ch];
    const float br = X.lru_br[ch], bi = X.lru_bi[ch];
    const float nls = -8.0f * log1pf(__expf(-X.lru_lambda[ch]));
    const bf16_t* up = X.U + (size_t)I.row0 * DIN + ch;
    float xm3 = 0.f, xm2 = 0.f, xm1 = 0.f;
    if (!I.meta) { const bf16_t* hp = (I.c == 0) ? X.U + (size_t)(META0 + 13) * DIN + ch : up - 3 * DIN; xm3 = bf1(hp[0]); xm2 = bf1(hp[DIN]); xm1 = bf1(hp[2 * DIN]); }
    float xc[64];
#pragma unroll
    for (int t = 0; t < 64; ++t) { const float x0 = bf1(up[(size_t)t * DIN]); xc[t] = cb + w0 * xm3 + w1 * xm2 + w2 * xm1 + w3 * x0; xm3 = xm2; xm2 = xm1; xm1 = x0; }
#pragma unroll
    for (int t = 0; t < 64; ++t) *(LAS bf16_t*)(xt + t * 144 + lane * 2) = (bf16_t)f2bf(xc[t]);
    bf16x8 BfR0[4], BfR1[4], BfI0[4], BfI1[4];
    { const bf16_t* gr = X.gw + (size_t)(I.hd * 64 + (lane & 31)) * 64 + 8 * (lane >> 5); const bf16_t* gi = gr + 16 * 64 * 64;
#pragma unroll
      for (int s = 0; s < 4; ++s) { BfR0[s] = *(const bf16x8*)(gr + 16 * s); BfR1[s] = *(const bf16x8*)(gr + 32 * 64 + 16 * s); BfI0[s] = *(const bf16x8*)(gi + 16 * s); BfI1[s] = *(const bf16x8*)(gi + 32 * 64 + 16 * s); } }
    float h = 0.f, P = 1.f;
    unsigned* hpo = X.HP + (size_t)I.row0 * DLRU + ch;
#pragma unroll
    for (int tb = 0; tb < 2; ++tb) {
        f32x16 aR0, aR1, aI0, aI1;
#pragma unroll
        for (int e = 0; e < 16; ++e) { aR0[e] = 0.f; aR1[e] = 0.f; aI0[e] = 0.f; aI1[e] = 0.f; }
#pragma unroll
        for (int s = 0; s < 4; ++s) {
            const bf16x8 af = *(const LAS bf16x8*)(xt + (tb * 32 + (lane & 31)) * 144 + (16 * s + 8 * (lane >> 5)) * 2);
            aR0 = __builtin_amdgcn_mfma_f32_32x32x16_bf16(af, BfR0[s], aR0, 0, 0, 0);
            aR1 = __builtin_amdgcn_mfma_f32_32x32x16_bf16(af, BfR1[s], aR1, 0, 0, 0);
            aI0 = __builtin_amdgcn_mfma_f32_32x32x16_bf16(af, BfI0[s], aI0, 0, 0, 0);
            aI1 = __builtin_amdgcn_mfma_f32_32x32x16_bf16(af, BfI1[s], aI1, 0, 0, 0);
        }
#pragma unroll
        for (int q = 0; q < 4; ++q) {
            float Rv[2][4], Iv[2][4];
#pragma unroll
            for (int k = 0; k < 4; ++k) {
                const int reg = 4 * q + k;
                const float r0f = aR0[reg], r1f = aR1[reg], i0f = aI0[reg], i1f = aI1[reg];
                auto r = __builtin_amdgcn_permlane32_swap(__float_as_uint(r0f), __float_as_uint(r1f), false, false);
                Rv[0][k] = __uint_as_float(r[0]); Rv[1][k] = __uint_as_float(r[1]);
                auto i2 = __builtin_amdgcn_permlane32_swap(__float_as_uint(i0f), __float_as_uint(i1f), false, false);
                Iv[0][k] = __uint_as_float(i2[0]); Iv[1][k] = __uint_as_float(i2[1]);
            }
#pragma unroll
            for (int st = 0; st < 2; ++st)
#pragma unroll
                for (int k = 0; k < 4; ++k) {
                    const int t = tb * 32 + 8 * q + 4 * st + k;
                    const float rg = sigmoidf_(Rv[st][k] + br), ig = sigmoidf_(Iv[st][k] + bi);
                    const float la = nls * rg;
                    float a = __expf(la);
                    float bb = sqrtf(-expm1f(2.0f * la)) * (ig * xc[t]);
                    if (t >= I.ntok) { a = 1.f; bb = 0.f; }
                    h = a * h + bb; P = P * a;
                    if (t < I.ntok) hpo[(size_t)t * DLRU] = pg8::cvt_pk_bf16(h, P);
                }
        }
    }
    f32x2 ag; ag.x = P; ag.y = h;
    X.AGG[(size_t)I.agg * 1024 + ch] = ag;
}

__device__ __forceinline__ void s2_item(const Mix& X, int id, int lane) {
    const ItemId I = decode_item(id);
    const int ch = I.hd * 64 + lane;
    float hin = 0.f;
    if (!I.meta) {
        hin = X.AGG[(size_t)256 * 1024 + ch].y;
        const f32x2* ap = X.AGG + (size_t)(I.b * 64) * 1024 + ch;
#pragma unroll 8
        for (int j = 0; j < I.c; ++j) { const f32x2 v = ap[(size_t)j * 1024]; hin = v.x * hin + v.y; }
    }
    const unsigned* hp = X.HP + (size_t)I.row0 * DLRU + ch;
    const bf16_t* gp = X.U + (size_t)I.row0 * DIN + 1024 + ch;
    bf16_t* yp = X.Y + (size_t)I.row0 * DM + ch;
    for (int t0 = 0; t0 < I.ntok; t0 += 16) {
#pragma unroll
        for (int k = 0; k < 16; ++k) {
            const int t = t0 + k;
            const unsigned w = hp[(size_t)t * DLRU]; const float g = bf1(gp[(size_t)t * DIN]);
            const float hv = bflo(w) + bfhi(w) * hin;
            yp[(size_t)t * DM] = (bf16_t)f2bf(hv * g * sigmoidf_(g));
        }
    }
}

__device__ __forceinline__ void ld8(const bf16_t* p, float (&o)[8]) {
    const u32x4 w = *(const u32x4*)p;
    o[0] = bflo(w.x); o[1] = bfhi(w.x); o[2] = bflo(w.y); o[3] = bfhi(w.y); o[4] = bflo(w.z); o[5] = bfhi(w.z); o[6] = bflo(w.w); o[7] = bfhi(w.w);
}
__device__ __forceinline__ void partb(const Mix& X, int tid) {
    for (int it = blockIdx.x * 512 + tid; it < 1025 * 128; it += gridDim.x * 512) {
        const int c0 = (it & 127) * 8, run = it >> 7;
        int row0, hrow = -1;
        if (run == 1024) row0 = META0; else { row0 = run * 16; hrow = ((row0 & (SEQ - 1)) == 0) ? META0 + 14 : row0 - 2; }
        float w0[8], w1[8], w2[8], cm2[8], cm1[8];
        { const f32x4* p = (const f32x4*)(X.conv_b_w + c0); const f32x4 a0 = p[0], a1 = p[1], b0 = p[256], b1 = p[257], d0 = p[512], d1 = p[513];
#pragma unroll
          for (int e = 0; e < 4; ++e) { w0[e] = a0[e]; w0[4 + e] = a1[e]; w1[e] = b0[e]; w1[4 + e] = b1[e]; w2[e] = d0[e]; w2[4 + e] = d1[e]; } }
        if (hrow >= 0) {
            float c[8], x[8];
            ld8(X.U + (size_t)hrow * DIN + 3072 + c0, c); ld8(X.U + (size_t)hrow * DIN + 4096 + c0, x);
#pragma unroll
            for (int e = 0; e < 8; ++e) cm2[e] = c[e] * x[e];
            ld8(X.U + (size_t)(hrow + 1) * DIN + 3072 + c0, c); ld8(X.U + (size_t)(hrow + 1) * DIN + 4096 + c0, x);
#pragma unroll
            for (int e = 0; e < 8; ++e) cm1[e] = c[e] * x[e];
        } else {
#pragma unroll
            for (int e = 0; e < 8; ++e) { cm2[e] = 0.f; cm1[e] = 0.f; }
        }
        const bf16_t* up = X.U + (size_t)row0 * DIN + c0;
        bf16_t* yp = X.Y + (size_t)row0 * DM + 1024 + c0;
#pragma unroll 4
        for (int t = 0; t < 16; ++t) {
            float bv[8], cv[8], xv[8], gv[8];
            ld8(up + (size_t)t * DIN + 2048, bv); ld8(up + (size_t)t * DIN + 3072, cv); ld8(up + (size_t)t * DIN + 4096, xv); ld8(up + (size_t)t * DIN + 5120, gv);
            float o[8];
#pragma unroll
            for (int e = 0; e < 8; ++e) { const float cx = cv[e] * xv[e]; const float y = w0[e] * cm2[e] + w1[e] * cm1[e] + w2[e] * cx; o[e] = bv[e] * y * (gv[e] * sigmoidf_(gv[e])); cm2[e] = cm1[e]; cm1[e] = cx; }
            u32x4 w; w.x = pk2(o[0], o[1]); w.y = pk2(o[2], o[3]); w.z = pk2(o[4], o[5]); w.w = pk2(o[6], o[7]);
            *(u32x4*)(yp + (size_t)t * DM) = w;
        }
    }
}


#ifdef DEBUG_NAIVE_MIX
__global__ void __launch_bounds__(64) naive_mixA(Mix X, const float* wr, const float* wi) {
    const int b = blockIdx.x / 16, hd = blockIdx.x % 16, lane = threadIdx.x, ch = hd * 64 + lane;
    __shared__ float xs[64];
    const float w0 = X.conv_a_w[ch], w1 = X.conv_a_w[1024 + ch], w2 = X.conv_a_w[2048 + ch], w3 = X.conv_a_w[3072 + ch], cb = X.conv_a_b[ch];
    const float br = X.lru_br[ch], bi = X.lru_bi[ch];
    const float sp = log1pf(expf(-X.lru_lambda[ch]));
    const float* wrh = wr + (size_t)hd * 4096 + lane; const float* wih = wi + (size_t)hd * 4096 + lane;
    float h = 0.f, xm3 = 0.f, xm2 = 0.f, xm1 = 0.f;
    for (int p = 0; p < NMETA + SEQ; ++p) {
        const int row = p < NMETA ? META0 + p : b * SEQ + (p - NMETA);
        const float x0 = bf1(X.U[(size_t)row * DIN + ch]);
        const float xc = cb + w0 * xm3 + w1 * xm2 + w2 * xm1 + w3 * x0; xm3 = xm2; xm2 = xm1; xm1 = x0;
        xs[lane] = xc; __syncthreads();
        float rp = br, ip = bi;
#pragma unroll 4
        for (int i = 0; i < 64; ++i) { rp += xs[i] * wrh[i * 64]; ip += xs[i] * wih[i * 64]; }
        __syncthreads();
        const float r = 1.f / (1.f + expf(-rp)), ig = 1.f / (1.f + expf(-ip));
        const float la = -8.f * r * sp; const float a = expf(la); const float bb = sqrtf(-expm1f(2.f * la)) * (ig * xc);
        h = a * h + bb;
        const float g = bf1(X.U[(size_t)row * DIN + 1024 + ch]);
        const float y = h * g / (1.f + expf(-g));
        if (p >= NMETA || b == 0) X.Y[(size_t)row * DM + ch] = (bf16_t)f2bf(y);
    }
}
__global__ void naive_mixB(Mix X) {
    for (size_t idx = (size_t)blockIdx.x * blockDim.x + threadIdx.x; idx < (size_t)(MROWS + NMETA) * 1024; idx += (size_t)gridDim.x * blockDim.x) {
        const int row = (int)(idx >> 10), c = (int)(idx & 1023);
        int r1, r2;
        if (row >= META0) { const int p = row - META0; r1 = p >= 1 ? row - 1 : -1; r2 = p >= 2 ? row - 2 : -1; }
        else { const int t = row & (SEQ - 1); r1 = t >= 1 ? row - 1 : META0 + 15; r2 = t >= 2 ? row - 2 : META0 + 14 + t; }
        auto cx = [&](int r) -> float { return r < 0 ? 0.f : bf1(X.U[(size_t)r * DIN + 3072 + c]) * bf1(X.U[(size_t)r * DIN + 4096 + c]); };
        const float y = X.conv_b_w[c] * cx(r2) + X.conv_b_w[1024 + c] * cx(r1) + X.conv_b_w[2048 + c] * cx(row);
        const float bv = bf1(X.U[(size_t)row * DIN + 2048 + c]), g = bf1(X.U[(size_t)row * DIN + 5120 + c]);
        X.Y[(size_t)row * DM + 1024 + c] = (bf16_t)f2bf(bv * y * g / (1.f + expf(-g)));
    }
}
#endif
#define XB_TMO      128
#define XB_XCNT(j)  (256  + 64 * (j))
#define XB_XSUB(j)  (1280 + 64 * (j))
#define XB_XGEN(j)  (2304 + 64 * (j))
#define XB_TOP      3328
#define XB_TOPGEN   3392
#define XCD_BAR_WORDS 3456
#define XB_SPIN_CAP (1u << 18)

__device__ __forceinline__ unsigned xb_ld(unsigned* p)              { return __hip_atomic_load(p, __ATOMIC_RELAXED, __HIP_MEMORY_SCOPE_AGENT); }
__device__ __forceinline__ unsigned xb_add(unsigned* p, unsigned v) { return __hip_atomic_fetch_add(p, v, __ATOMIC_RELAXED, __HIP_MEMORY_SCOPE_AGENT); }
__device__ __forceinline__ unsigned xb_xcc_id() { return (unsigned)__builtin_amdgcn_s_getreg((3 << 11) | 20) & 0xFu; }
#define XB_SPIN(cond, bar) do { unsigned _sp = 0; while (cond) { __builtin_amdgcn_s_sleep(1); \
    if ((++_sp & 255u) == 0u) { if (xb_ld(&(bar)[XB_TMO])) break; if (_sp > XB_SPIN_CAP) { atomicAdd(&(bar)[XB_TMO], 1u); break; } } } } while (0)

struct XcdBarrier {
    unsigned* bar; unsigned x;
    volatile LAS unsigned* st;
};

__device__ __forceinline__ XcdBarrier xcd_barrier_post(unsigned* bar, volatile LAS unsigned* st) {
    XcdBarrier b; b.bar = bar; b.x = xb_xcc_id(); b.st = st;
    if (threadIdx.x == 0) (void)xb_add(&bar[XB_XCNT(b.x)], 1u);
    return b;
}
__device__ __forceinline__ void xcd_barrier_complete(unsigned* bar, unsigned x, unsigned& nloc, unsigned& nx) {
    const unsigned G = gridDim.x * gridDim.y * gridDim.z;
    unsigned sum, cnt, mine, sp = 0u;
    for (;;) {
        sum = 0u; cnt = 0u; mine = 0u;
#pragma unroll
        for (unsigned j = 0; j < 16; ++j) { const unsigned c = xb_ld(&bar[XB_XCNT(j)]); sum += c; cnt += (c > 0u) ? 1u : 0u; mine = (j == x) ? c : mine; }
        if (sum == G) break;
        __builtin_amdgcn_s_sleep(1);
        if ((++sp & 255u) == 0u) { if (xb_ld(&bar[XB_TMO])) break; if (sp > XB_SPIN_CAP) { atomicAdd(&bar[XB_TMO], 1u); break; } }
    }
    nloc = mine > 0u ? mine : 1u; nx = cnt > 0u ? cnt : 1u;
}

__device__ __forceinline__ void xcd_barrier(const XcdBarrier& b) {
    asm volatile("s_waitcnt vmcnt(0)" ::: "memory");
    __syncthreads();
    if (threadIdx.x == 0) {
        unsigned* bar = b.bar;
        __builtin_amdgcn_s_waitcnt(0);
        unsigned nloc = b.st[0], nx = b.st[1];
        if (nloc == 0u) { xcd_barrier_complete(bar, b.x, nloc, nx); b.st[0] = nloc; b.st[1] = nx; }
        const unsigned old = xb_add(&bar[XB_XSUB(b.x)], 1u);
        const unsigned gen = old / nloc;
        if (old + 1u == (gen + 1u) * nloc) {
            __builtin_amdgcn_fence(__ATOMIC_RELEASE, "agent");
            asm volatile("s_waitcnt vmcnt(0)" ::: "memory");
            const unsigned og = xb_add(&bar[XB_TOP], 1u);
            const unsigned tg = og / nx;
            if (og + 1u == (tg + 1u) * nx) xb_add(&bar[XB_TOPGEN], 1u);
            else XB_SPIN(xb_ld(&bar[XB_TOPGEN]) == tg, bar);
            __builtin_amdgcn_fence(__ATOMIC_ACQUIRE, "agent");
            xb_add(&bar[XB_XGEN(b.x)], 1u);
            asm volatile("s_waitcnt vmcnt(0)" ::: "memory");
        } else {
            XB_SPIN(xb_ld(&bar[XB_XGEN(b.x)]) == gen, bar);
            __builtin_amdgcn_fence(__ATOMIC_ACQUIRE, "agent");
            asm volatile("s_waitcnt vmcnt(0)" ::: "memory");
        }
    }
    __syncthreads();
}

__global__ void __launch_bounds__(512, 2) hymba_fwd(Args a) {
    extern __shared__ __attribute__((aligned(16))) unsigned char lds_raw[];
    LAS unsigned char* lds = (LAS unsigned char*)lds_raw;
    cg::grid_group grid = cg::this_grid();
    const int NGW = gridDim.x * 8;
    if (threadIdx.x < 64) ((LAS unsigned*)(lds + 131072))[threadIdx.x] = 0u;
    __syncthreads();
    XcdBarrier xbar; xbar.bar = (unsigned*)(a.ws + WS_BAR); xbar.x = 0; xbar.st = nullptr;
    if (a.ph_hi - a.ph_lo > 1) xbar = xcd_barrier_post((unsigned*)(a.ws + WS_BAR), (volatile LAS unsigned*)(lds + 131072));
    if (a.ph_lo < 0) grid.sync();
#define LAUNDER() int tid = threadIdx.x; asm volatile("" : "+v"(tid)); const int wid = __builtin_amdgcn_readfirstlane(tid >> 6), lane = tid & 63, gw = blockIdx.x * 8 + wid
    const int lo = a.ph_lo, hi = a.ph_hi;
#define IN(k) (lo <= (k) && (k) < hi)
#define SEAM(k) do { if (IN(k) && IN((k) + 1)) { xcd_barrier(xbar); if ((REP_MASK >> 10) & 1) { xcd_barrier(xbar); xcd_barrier(xbar); } } } while (0)
    const float* x = a.in[0]; const float* meta = a.in[1]; const float* norm_g = a.in[2]; const float* w_in = a.in[3];
    const float* conv_a_w = a.in[4]; const float* conv_a_b = a.in[5]; const float* lru_wr = a.in[6]; const float* lru_br = a.in[7];
    const float* lru_wi = a.in[8]; const float* lru_bi = a.in[9]; const float* lru_lambda = a.in[10]; const float* conv_b_w = a.in[11];
    const float* w_out = a.in[12]; const float* final_g = a.in[13];
    unsigned char* ws = a.ws;
    bf16_t* WTIN = (bf16_t*)(ws + WS_WTIN); bf16_t* WTOUT = (bf16_t*)(ws + WS_WTOUT); bf16_t* GW = (bf16_t*)(ws + WS_GW);
    float* ROWSS = (float*)(ws + WS_ROWSS); f32x2* AGG = (f32x2*)(ws + WS_AGG);
    bf16_t* XB = (bf16_t*)(ws + WS_XB); bf16_t* Y = (bf16_t*)(ws + WS_Y); unsigned* HP = (unsigned*)(ws + WS_HP); bf16_t* U = (bf16_t*)(ws + WS_U);

    if (IN(0)) for (int rep = 0; rep <= ((REP_MASK >> 0) & 1); ++rep) {
        LAUNDER();
        LAS float* scr = (LAS float*)(lds + wid * 16384);
        constexpr int I_IN = (DM / 64) * (DIN / 32), I_OUT = (DM / 64) * (DM / 32), I_G = 2;
        constexpr int NIT = 2 * I_IN + 2 * I_OUT + 64 * I_G;
        for (int it = gw; it < NIT; it += NGW) {
            int r = it;
            if (r < 2 * I_IN) { const int l = r / I_IN; tr_item(w_in + (size_t)l * DM * DIN, DM, DIN, WTIN + (size_t)l * DIN * DM, norm_g + l * DM, scr, r % I_IN, lane); continue; } r -= 2 * I_IN;
            if (r < 2 * I_OUT) { const int l = r / I_OUT; tr_item(w_out + (size_t)l * DM * DM, DM, DM, WTOUT + (size_t)l * DM * DM, nullptr, scr, r % I_OUT, lane); continue; } r -= 2 * I_OUT;
            { const int mtx = r >> 1, l = mtx >> 5, g = (mtx >> 4) & 1, hd = mtx & 15;
              const float* src = (g ? lru_wi : lru_wr) + (size_t)(l * 16 + hd) * 4096;
              tr_item(src, 64, 64, GW + (size_t)mtx * 4096, nullptr, scr, r & 1, lane); }
        }
        for (int m = gw; m < MROWS + NMETA; m += NGW) {
            const float* src = m < MROWS ? x + (size_t)m * DM : meta + (size_t)(m - MROWS) * DM;
            cvt_row(src, XB + (size_t)m * DM, ROWSS + m, lane);
        }
        for (int i = blockIdx.x * 512 + tid; i < 2 * RSTR; i += gridDim.x * 512) ROWSS[RSTR + i] = 0.f;
    }
    SEAM(0);

#pragma unroll 1
    for (int l = 0; l < 2; ++l) {
        const int pb = 1 + 4 * l;
        const bf16_t* wtin = WTIN + (size_t)l * DIN * DM; const bf16_t* wtout = WTOUT + (size_t)l * DM * DM;
        float* rss_in = ROWSS + (size_t)l * RSTR; float* rss_out = ROWSS + (size_t)(l + 1) * RSTR;
        Mix X; X.conv_a_w = conv_a_w + l * 4 * DLRU; X.conv_a_b = conv_a_b + l * DLRU; X.lru_br = lru_br + l * DLRU; X.lru_bi = lru_bi + l * DLRU; X.lru_lambda = lru_lambda + l * DLRU;
        X.conv_b_w = conv_b_w + l * 3 * DLRU; X.gw = GW + (size_t)l * 2 * 16 * 4096; X.U = U; X.Y = Y; X.HP = HP; X.AGG = AGG;

        if (IN(pb)) for (int rep = 0; rep <= ((REP_MASK >> pb) & 1); ++rep) {
            LAUNDER();
            meta_gemm(XB + (size_t)META0 * DM, wtin, DIN / 16, lds, wid, lane, [&](int m, int n0, f32x4 s) {
                const float rs = rsqrtf(rss_in[META0 + m] * (1.0f / DM) + RMS_EPS);
                u32x2 w; w.x = pk2(s[0] * rs, s[1] * rs); w.y = pk2(s[2] * rs, s[3] * rs);
                *(u32x2*)(U + (size_t)(META0 + m) * DIN + n0) = w; });
            pg8::Gemm g{XB, wtin, MROWS, DIN, DM}; pg8::StaticOrder S; S.init(MROWS, DIN, (int)gridDim.x, (int)blockIdx.x);
            EpiU E{U, rss_in};
            pg8::gemm_phase<EpiU, pg8::StaticOrder, false>(lds, g, S, E, nullptr);
        }
        SEAM(pb);
        if (IN(pb + 1)) for (int rep = 0; rep <= ((REP_MASK >> (pb + 1)) & 1); ++rep) {
            LAUNDER();
            if (!(a.flags & 1)) for (int id = gw; id < N_ITEMS; id += NGW) s1_item(X, id, lds + wid * 9216, lane);
            if (!(a.flags & 2)) partb(X, tid);
        }
        SEAM(pb + 1);
        if (IN(pb + 2)) for (int rep = 0; rep <= ((REP_MASK >> (pb + 2)) & 1); ++rep) {
            LAUNDER();
            for (int id = gw; id < N_ITEMS; id += NGW) s2_item(X, id, lane);
        }
        SEAM(pb + 2);
        if (IN(pb + 3)) {
            LAUNDER();
            if (l == 0) {
                meta_gemm(Y + (size_t)META0 * DM, wtout, DM / 16, lds, wid, lane, [&](int m, int n0, f32x4 s) {
                    const f32x4 r = *(const f32x4*)(meta + (size_t)m * DM + n0); const f32x4 hh = r + s;
                    u32x2 w; w.x = pk2(hh[0], hh[1]); w.y = pk2(hh[2], hh[3]);
                    *(u32x2*)(XB + (size_t)(META0 + m) * DM + n0) = w;
                    unsafeAtomicAdd(rss_out + META0 + m, (hh[0] * hh[0] + hh[1] * hh[1]) + (hh[2] * hh[2] + hh[3] * hh[3])); });
            }
            pg8::Gemm g{Y, wtout, MROWS, DM, DM}; pg8::StaticOrder S; S.init(MROWS, DM, (int)gridDim.x, (int)blockIdx.x);
            EpiRes E{l == 0 ? x : a.out, a.out, l == 0 ? XB : nullptr, rss_out};
            pg8::gemm_phase<EpiRes, pg8::StaticOrder, false>(lds, g, S, E, nullptr);
        }
        SEAM(pb + 3);
    }

    if (IN(9)) {
        LAUNDER();
        const float* rss = ROWSS + (size_t)2 * RSTR;
        for (int m = gw; m < MROWS; m += NGW) {
            const float rs = rsqrtf(rss[m] * (1.0f / DM) + RMS_EPS);
            f32x4* p = (f32x4*)(a.out + (size_t)m * DM) + lane; const f32x4* gp = (const f32x4*)final_g + lane;
            f32x4 v[8];
#pragma unroll
            for (int j = 0; j < 8; ++j) v[j] = p[64 * j];
#pragma unroll
            for (int j = 0; j < 8; ++j) p[64 * j] = v[j] * rs * gp[64 * j];
        }
    }
#undef IN
#undef SEAM
}

#ifndef MK_LAUNCH_PER_PHASE
#define MK_LAUNCH_PER_PHASE 0
#endif
extern "C" void kernel_launch(void* const* d_in, const int* in_sizes, int n_in, void* d_out, int out_size, void* d_ws, size_t ws_size, hipStream_t stream) {
    static int grid = 0;
    if (grid == 0) {
        if (n_in != 14 || in_sizes[0] != MROWS * DM || out_size != MROWS * DM || ws_size < WS_END) { fprintf(stderr, "kernel_launch: unexpected shapes (n_in %d, in0 %d, out %d, ws %zu)\n", n_in, n_in > 0 ? in_sizes[0] : -1, out_size, ws_size); grid = -1; return; }
        int dev = 0, cus = 0, per_cu = 0;
        hipGetDevice(&dev); hipDeviceGetAttribute(&cus, hipDeviceAttributeMultiprocessorCount, dev);
        if (hipFuncSetAttribute((const void*)hymba_fwd, hipFuncAttributeMaxDynamicSharedMemorySize, LDS_BYTES) != hipSuccess) { fprintf(stderr, "kernel_launch: hipFuncSetAttribute failed\n"); grid = -1; return; }
        if (hipOccupancyMaxActiveBlocksPerMultiprocessor(&per_cu, (const void*)hymba_fwd, 512, LDS_BYTES) != hipSuccess || per_cu < 1) { fprintf(stderr, "kernel_launch: occupancy query gave %d\n", per_cu); per_cu = 1; }
        (void)hipGetLastError();
        grid = cus * per_cu;
    }
    if (grid < 0) return;
    Args a{};
    for (int i = 0; i < 14; ++i) a.in[i] = (const float*)d_in[i];
    a.out = (float*)d_out; a.ws = (unsigned char*)d_ws;
#if MK_LAUNCH_PER_PHASE
    for (int p = 0; p < NPHASE; ++p) {
#ifdef DEBUG_NAIVE_MIX
        if (p == 2 || p == 6) { const int l = p / 4; unsigned char* ws = (unsigned char*)d_ws;
            Mix X; X.conv_a_w = a.in[4] + l * 4 * DLRU; X.conv_a_b = a.in[5] + l * DLRU; X.lru_br = a.in[7] + l * DLRU; X.lru_bi = a.in[9] + l * DLRU; X.lru_lambda = a.in[10] + l * DLRU;
            X.conv_b_w = a.in[11] + l * 3 * DLRU; X.gw = nullptr; X.U = (bf16_t*)(ws + WS_U); X.Y = (bf16_t*)(ws + WS_Y); X.HP = nullptr; X.AGG = nullptr;
#if DEBUG_NAIVE_MIX == 1
            hipLaunchKernelGGL(naive_mixA, dim3(64), dim3(64), 0, stream, X, a.in[6] + (size_t)l * 16 * 4096, a.in[8] + (size_t)l * 16 * 4096);
            a.flags = 1;
#else
            hipLaunchKernelGGL(naive_mixB, dim3(2048), dim3(256), 0, stream, X);
            a.flags = 2;
#endif
            }
        else a.flags = 0;
#if DEBUG_NAIVE_MIX == 1
        if (p == 3 || p == 7) continue;
#endif
#endif
        a.ph_lo = p; a.ph_hi = p + 1; hipLaunchKernelGGL(hymba_fwd, dim3(grid), dim3(512), LDS_BYTES, stream, a); }
#else
    a.ph_lo = 0; a.ph_hi = NPHASE;
    if (hipMemsetAsync((unsigned char*)d_ws + WS_BAR, 0, XCD_BAR_WORDS * 4, stream) != hipSuccess) { fprintf(stderr, "kernel_launch: memset of barrier words failed\n"); return; }
    void* args[] = {&a};
    const hipError_t e = hipLaunchCooperativeKernel((const void*)hymba_fwd, dim3(grid), dim3(512), args, LDS_BYTES, stream);
    if (e != hipSuccess) fprintf(stderr, "kernel_launch: cooperative launch failed: %s (grid %d)\n", hipGetErrorString(e), grid);
#endif
}
```

```cpp
#include <hip/hip_runtime.h>
#include <hip/hip_cooperative_groups.h>
#include <cstdio>
namespace cg = cooperative_groups;
namespace pg8 {
#define PG8_LAS __attribute__((address_space(3)))
typedef unsigned short bf16_t;
typedef short bf16x8 __attribute__((ext_vector_type(8)));
typedef float f32x4 __attribute__((ext_vector_type(4)));
typedef unsigned u32x4 __attribute__((ext_vector_type(4)));
constexpr int BM = 256, BK = 64, HALF = 128, HTB = HALF * BK * 2  , STAGE_BYTES = 8 * HTB, NXCD = 8, WGM = 8;

__host__ __device__ __forceinline__ int lds_byte(int r, int c) { const int st = (r >> 4) * 2 + (c >> 5), rr = r & 15, cc = c & 31, ob = rr * 64 + cc * 2; return st * 1024 + (ob ^ (((ob >> 9) & 1) << 5)); }
__host__ __device__ __forceinline__ void stage_rc(int b, int& R, int& C) { const int st = b / 1024, sb = b % 1024, swz = sb ^ (((sb >> 9) & 1) << 5); R = (st >> 1) * 16 + swz / 64; C = (st & 1) * 32 + (swz % 64) / 2; }
__host__ __device__ __forceinline__ int perm32(int rho) { const int n = rho >> 4, i = rho & 15; return 8 * (i >> 2) + 4 * n + (i & 3); }

struct Unit { int pm, pn; };
struct Gemm { const bf16_t* A; const bf16_t* Bt; int M, N, K; };

struct StaticOrder {
    int nM, nN, nwg, G, c;
    __host__ __device__ void init(int M, int N, int G_, int c_) { nM = M / BM; nN = N / BM; nwg = nM * nN; G = G_; c = c_; }
    __host__ __device__ bool next(int i, Unit& u) const {
        const long L = (long)i * G + c; if (L >= nwg) return false;
        int wgid = (int)L; { const int q = nwg / NXCD, r = nwg % NXCD, xcd = wgid % NXCD, off = wgid / NXCD; wgid = (xcd < r ? xcd * (q + 1) : r * (q + 1) + (xcd - r) * q) + off; }
        const int nig = WGM * nN, gid = wgid / nig, fm = gid * WGM, gsz = (nM - fm) < WGM ? (nM - fm) : WGM;
        u.pm = fm + ((wgid % nig) % gsz); u.pn = (wgid % nig) / gsz; return true;
    }
    __device__ __forceinline__ void a_ready(const Unit&) const {}
    __device__ __forceinline__ void done(const Unit&) const {}
};
__device__ __forceinline__ unsigned cvt_pk_bf16(float lo, float hi) { unsigned r; asm volatile("v_cvt_pk_bf16_f32 %0, %1, %2" : "=v"(r) : "v"(lo), "v"(hi)); return r; }
template <class Epi, class Sched, bool STAMP = false>
__device__ __forceinline__ void gemm_phase(PG8_LAS unsigned char* lds, const Gemm g, const Sched& S, const Epi& E, unsigned long long* stamps) {
    int tid_l = threadIdx.x; asm volatile("" : "+v"(tid_l));
    const int tid = tid_l, wid = __builtin_amdgcn_readfirstlane(tid >> 6), lane = tid & 63, wr = wid >> 2, wc = wid & 3, fr = lane & 15, fq = lane >> 4;
    const int K = g.K, nt = K / BK;
    int ts_lo = 0, ts_hi = 0, nts = 0; const unsigned long long rt_entry = STAMP ? (unsigned long long)wall_clock64() : 0ull;
#define PG8_STAMP() do { if (STAMP && wid == 0 && nts < 64) { const unsigned long long _c = (unsigned long long)clock64(); \
        ts_lo = (lane == nts) ? (int)(unsigned)_c : ts_lo; ts_hi = (lane == nts) ? (int)(unsigned)(_c >> 32) : ts_hi; ++nts; } } while (0)
    PG8_STAMP();
    unsigned voffA[2], voffB[2];
#pragma unroll
    for (int i = 0; i < 2; ++i) { int R, C; stage_rc(tid * 16 + i * 8192, R, C); const int Rb = Epi::PERM ? ((R & ~31) + perm32(R & 31)) : R;
        voffA[i] = (unsigned)(R * K + C) * 2u; voffB[i] = (unsigned)(Rb * K + C) * 2u; }
    const size_t kstep = (size_t)(BK * 2);
    const size_t hstep = (size_t)HALF * K * 2;
    const size_t tstep = 2 * hstep;
    const unsigned ldsw = (unsigned)wid * 1024u;
    const int aoff = lds_byte(wr * 64 + fr, fq * 8), boff = lds_byte(wc * 32 + fr, fq * 8);
#define PG8_SA(b, h) (((b) * 2 + (h)) * HTB)
#define PG8_SB(b, h) ((4 + (b) * 2 + (h)) * HTB)
#define PG8_STAGE(bufoff, gbase, voff) do { _Pragma("unroll") for (int _i = 0; _i < 2; ++_i) \
        __builtin_amdgcn_global_load_lds((const unsigned*)((const char*)(gbase) + (voff)[_i]), (PG8_LAS unsigned*)(lds + (bufoff) + ldsw + _i * 8192), 16, 0, 0); } while (0)
#define PG8_LDA(dst, b, h) do { _Pragma("unroll") for (int m = 0; m < 4; ++m) _Pragma("unroll") for (int k = 0; k < 2; ++k) dst[m][k] = *(const PG8_LAS bf16x8*)(lds + PG8_SA(b, h) + aoff + m * 2048 + k * 1024); } while (0)
#define PG8_LDB(dst, b, h) do { _Pragma("unroll") for (int n = 0; n < 2; ++n) _Pragma("unroll") for (int k = 0; k < 2; ++k) dst[n][k] = *(const PG8_LAS bf16x8*)(lds + PG8_SB(b, h) + boff + n * 2048 + k * 1024); } while (0)
#define PG8_MMA(ai, bj, At, Bt) do { __builtin_amdgcn_s_setprio(1); _Pragma("unroll") for (int m = 0; m < 4; ++m) _Pragma("unroll") for (int n = 0; n < 2; ++n) _Pragma("unroll") for (int k = 0; k < 2; ++k) \
        acc[ai][bj][m][n] = __builtin_amdgcn_mfma_f32_16x16x32_bf16(Bt[n][k], At[m][k], acc[ai][bj][m][n], 0, 0, 0); __builtin_amdgcn_s_setprio(0); } while (0)
#define PG8_WAIT_V(n) asm volatile("s_waitcnt vmcnt(" #n ")" ::: "memory")
#define PG8_WAIT_L(n) asm volatile("s_waitcnt lgkmcnt(" #n ")" ::: "memory")
#define PG8_BAR __builtin_amdgcn_s_barrier()
#define PG8_SCHED __builtin_amdgcn_sched_barrier(0)
    Unit cur, nxt; int ui = 0;
    if (!S.next(0, cur)) return;
    f32x4 acc[2][2][4][2];
#pragma unroll
    for (int a = 0; a < 2; ++a)
#pragma unroll
        for (int b = 0; b < 2; ++b)
#pragma unroll
            for (int m = 0; m < 4; ++m)
#pragma unroll
                for (int n = 0; n < 2; ++n) acc[a][b][m][n] = (f32x4){0.f, 0.f, 0.f, 0.f};
    bf16x8 At[4][2], B0[2][2], B1[2][2];
    const char* cA = (const char*)g.A + (size_t)cur.pm * tstep; const char* cB = (const char*)g.Bt + (size_t)cur.pn * tstep;
    S.a_ready(cur);
    PG8_STAGE(PG8_SB(0, 0), cB, voffB); PG8_STAGE(PG8_SA(0, 0), cA, voffA); PG8_STAGE(PG8_SB(0, 1), cB + hstep, voffB); PG8_STAGE(PG8_SA(0, 1), cA + hstep, voffA);
    if (wr == 1) PG8_BAR;
    PG8_WAIT_V(4); PG8_BAR;
    PG8_STAGE(PG8_SB(1, 0), cB + kstep, voffB); PG8_STAGE(PG8_SA(1, 0), cA + kstep, voffA); PG8_STAGE(PG8_SB(1, 1), cB + hstep + kstep, voffB);
    PG8_WAIT_V(6); PG8_BAR;
    PG8_STAMP();
    for (;;) {
        const bool has_next = S.next(ui + 1, nxt);
        const char* nA = has_next ? (const char*)g.A + (size_t)nxt.pm * tstep : cA; const char* nB = has_next ? (const char*)g.Bt + (size_t)nxt.pn * tstep : cB;
        for (int t = 0; t < nt; t += 2) {
            const bool last = (t == nt - 2);
            const char* a1 = cA + (size_t)(t + 1) * kstep;
            const char* a2 = last ? nA : cA + (size_t)(t + 2) * kstep; const char* b2 = last ? nB : cB + (size_t)(t + 2) * kstep;
            const char* a3 = a2 + kstep; const char* b3 = b2 + kstep;
            if (last && has_next) S.a_ready(nxt);
            PG8_LDB(B0, 0, 0); PG8_SCHED; PG8_LDA(At, 0, 0); PG8_STAGE(PG8_SA(1, 1), a1 + hstep, voffA);
            PG8_WAIT_L(8); PG8_BAR; PG8_WAIT_L(0); PG8_MMA(0, 0, At, B0); PG8_BAR; PG8_SCHED;
            PG8_LDB(B1, 0, 1); PG8_STAGE(PG8_SB(0, 0), b2, voffB);
            PG8_BAR; PG8_WAIT_L(0); PG8_MMA(0, 1, At, B1); PG8_BAR;
            PG8_LDA(At, 0, 1); PG8_STAGE(PG8_SA(0, 0), a2, voffA);
            PG8_BAR; PG8_WAIT_L(0); PG8_MMA(1, 0, At, B0); PG8_BAR; PG8_SCHED;
            PG8_STAGE(PG8_SB(0, 1), b2 + hstep, voffB);
            PG8_WAIT_V(6); PG8_BAR; PG8_MMA(1, 1, At, B1); PG8_BAR;
            PG8_LDB(B0, 1, 0); PG8_SCHED; PG8_LDA(At, 1, 0); PG8_STAGE(PG8_SA(0, 1), a2 + hstep, voffA);
            PG8_WAIT_L(8); PG8_BAR; PG8_WAIT_L(0); PG8_MMA(0, 0, At, B0); PG8_BAR; PG8_SCHED;
            PG8_LDB(B1, 1, 1); PG8_STAGE(PG8_SB(1, 0), b3, voffB);
            PG8_BAR; PG8_WAIT_L(0); PG8_MMA(0, 1, At, B1); PG8_BAR;
            PG8_LDA(At, 1, 1); PG8_STAGE(PG8_SA(1, 0), a3, voffA);
            PG8_BAR; PG8_WAIT_L(0); PG8_MMA(1, 0, At, B0); PG8_BAR; PG8_SCHED;
            PG8_STAGE(PG8_SB(1, 1), b3 + hstep, voffB);
            PG8_WAIT_V(6); PG8_BAR; PG8_MMA(1, 1, At, B1); PG8_BAR;
        }
        PG8_STAMP();
        if constexpr (!Epi::AFTER_DRAIN) { E(acc, cur, wr, wc, fr, fq); S.done(cur); }
        PG8_STAMP();
        if (!has_next) break;
#pragma unroll
        for (int a = 0; a < 2; ++a)
#pragma unroll
            for (int b = 0; b < 2; ++b)
#pragma unroll
                for (int m = 0; m < 4; ++m)
#pragma unroll
                    for (int n = 0; n < 2; ++n) acc[a][b][m][n] = (f32x4){0.f, 0.f, 0.f, 0.f};
        cur = nxt; cA = nA; cB = nB; ++ui;
    }
    PG8_WAIT_V(0);
    if (wr == 0) PG8_BAR;
    PG8_BAR;
    if constexpr (Epi::AFTER_DRAIN) { E.fused(acc, cur, wr, wc, fr, fq, lds, wid, lane); S.done(cur); }
    PG8_STAMP();
    if (STAMP && wid == 0) { stamps[lane] = lane < nts ? (((unsigned long long)(unsigned)ts_hi << 32) | (unsigned)ts_lo) : 0ull;
        if (lane == 62) stamps[62] = rt_entry; if (lane == 63) stamps[63] = (unsigned long long)wall_clock64(); }
#undef PG8_STAMP
#undef PG8_SA
#undef PG8_SB
#undef PG8_STAGE
#undef PG8_LDA
#undef PG8_LDB
#undef PG8_MMA
#undef PG8_WAIT_V
#undef PG8_WAIT_L
#undef PG8_BAR
#undef PG8_SCHED
}
}

#define LAS __attribute__((address_space(3)))
typedef unsigned short bf16_t;
typedef short bf16x8 __attribute__((ext_vector_type(8)));
typedef float f32x4 __attribute__((ext_vector_type(4)));
typedef float f32x2 __attribute__((ext_vector_type(2)));
typedef float f32x16 __attribute__((ext_vector_type(16)));
typedef unsigned u32x4 __attribute__((ext_vector_type(4)));
typedef unsigned u32x2 __attribute__((ext_vector_type(2)));

constexpr int DM = 2048, NBATCH = 4, SEQ = 4096, MROWS = NBATCH * SEQ, NMETA = 16, DIN = 6144, DLRU = 1024, NHEAD = 16;
constexpr int META0 = MROWS;
constexpr int RSTR = MROWS + 64;
constexpr float RMS_EPS = 1e-6f;
constexpr int NPHASE = 8;
#ifndef REP_MASK
#define REP_MASK 0
#endif
constexpr int LDS_BYTES = 131072 + 256;

constexpr size_t MiB = 1u << 20;
constexpr size_t WS_WTIN = 0;
constexpr size_t WS_WTOUT = 48 * MiB;
constexpr size_t WS_GW = 64 * MiB;
constexpr size_t WS_ROWSS = 65 * MiB;
constexpr size_t WS_BAR = 65 * MiB + 512 * 1024;
constexpr size_t WS_AGG = 66 * MiB;
constexpr size_t WS_XB = 71 * MiB;
constexpr size_t WS_Y = 136 * MiB;
constexpr size_t WS_U = 201 * MiB;
constexpr size_t WS_END = 396 * MiB;
constexpr int AGG_PER_LAYER = 257 * 1024;
static_assert(WS_U + (size_t)RSTR * DIN * 2 <= WS_END && WS_Y + (size_t)RSTR * DM * 2 <= WS_U && WS_XB + (size_t)RSTR * DM * 2 <= WS_Y, "ws map");
static_assert(WS_WTIN + (size_t)2 * DIN * DM * 2 <= WS_WTOUT && WS_WTOUT + (size_t)2 * DM * DM * 2 <= WS_GW && WS_AGG + (size_t)2 * AGG_PER_LAYER * 8 <= WS_XB && WS_ROWSS + (size_t)3 * RSTR * 4 <= WS_BAR, "ws map 2");

struct Args { const float* in[14]; float* out; unsigned char* ws; int ph_lo, ph_hi, flags, pad; };

__device__ __forceinline__ unsigned f2bf(float f) { unsigned u = __builtin_bit_cast(unsigned, f); return (u + 0x7fffu + ((u >> 16) & 1u)) >> 16; }
__device__ __forceinline__ unsigned pk2(float lo, float hi) { return f2bf(lo) | (f2bf(hi) << 16); }
__device__ __forceinline__ float bflo(unsigned w) { return __builtin_bit_cast(float, w << 16); }
__device__ __forceinline__ float bfhi(unsigned w) { return __builtin_bit_cast(float, w & 0xffff0000u); }
__device__ __forceinline__ float bf1(bf16_t v) { return __builtin_bit_cast(float, ((unsigned)v) << 16); }
__device__ __forceinline__ float sigmoidf_(float z) { return __builtin_amdgcn_rcpf(1.0f + __expf(-z)); }
__device__ __forceinline__ float wave_sum(float v) {
#pragma unroll
    for (int o = 1; o < 64; o <<= 1) v += __shfl_xor(v, o);
    return v;
}
#define LDS_WAIT() asm volatile("s_waitcnt lgkmcnt(0)" ::: "memory")

struct EpiU {
    static constexpr bool PERM = true, AFTER_DRAIN = false;
    bf16_t* O; const float* rowss;
    __device__ __forceinline__ void operator()(const f32x4 (&acc)[2][2][4][2], const pg8::Unit& u, int wr, int wc, int fr, int fq) const {
        const int row0 = u.pm * 256 + wr * 64 + fr, col0 = u.pn * 256 + wc * 32 + 8 * fq;
#pragma unroll
        for (int ai = 0; ai < 2; ++ai)
#pragma unroll
            for (int m = 0; m < 4; ++m) {
                const int r = row0 + ai * 128 + m * 16;
                const float rs = rsqrtf(rowss[r] * (1.0f / DM) + RMS_EPS);
                bf16_t* rowp = O + (size_t)r * DIN + col0;
#pragma unroll
                for (int bj = 0; bj < 2; ++bj) {
                    const f32x4 v0 = acc[ai][bj][m][0] * rs, v1 = acc[ai][bj][m][1] * rs;
                    u32x4 w; w.x = pg8::cvt_pk_bf16(v0[0], v0[1]); w.y = pg8::cvt_pk_bf16(v0[2], v0[3]); w.z = pg8::cvt_pk_bf16(v1[0], v1[1]); w.w = pg8::cvt_pk_bf16(v1[2], v1[3]);
                    *(u32x4*)(rowp + bj * 128) = w;
                }
            }
    }
};
struct EpiRes {
    static constexpr bool PERM = true, AFTER_DRAIN = false;
    const float* res; float* out; bf16_t* xb; float* rowss;
    __device__ __forceinline__ void operator()(const f32x4 (&acc)[2][2][4][2], const pg8::Unit& u, int wr, int wc, int fr, int fq) const {
        const int row0 = u.pm * 256 + wr * 64 + fr, col0 = u.pn * 256 + wc * 32 + 8 * fq;
#pragma unroll
        for (int ai = 0; ai < 2; ++ai)
#pragma unroll
            for (int m = 0; m < 4; ++m) {
                const int r = row0 + ai * 128 + m * 16; const size_t off = (size_t)r * DM + col0; float ss = 0.f;
#pragma unroll
                for (int bj = 0; bj < 2; ++bj) {
                    const f32x4 r0 = *(const f32x4*)(res + off + bj * 128), r1 = *(const f32x4*)(res + off + bj * 128 + 4);
                    const f32x4 h0 = r0 + acc[ai][bj][m][0], h1 = r1 + acc[ai][bj][m][1];
                    *(f32x4*)(out + off + bj * 128) = h0; *(f32x4*)(out + off + bj * 128 + 4) = h1;
                    if (xb) { u32x4 w; w.x = pg8::cvt_pk_bf16(h0[0], h0[1]); w.y = pg8::cvt_pk_bf16(h0[2], h0[3]); w.z = pg8::cvt_pk_bf16(h1[0], h1[1]); w.w = pg8::cvt_pk_bf16(h1[2], h1[3]);
                        *(u32x4*)(xb + off + bj * 128) = w; }
                    ss += (h0[0] * h0[0] + h0[1] * h0[1]) + (h0[2] * h0[2] + h0[3] * h0[3]) + (h1[0] * h1[0] + h1[1] * h1[1]) + (h1[2] * h1[2] + h1[3] * h1[3]);
                }
                ss += __shfl_xor(ss, 16); ss += __shfl_xor(ss, 32);
                if (fq == 0) unsafeAtomicAdd(rowss + r, ss);
                asm volatile("" ::: "memory");
            }
    }
};

template <class F> __device__ __forceinline__ void meta_gemm(const bf16_t* A, const bf16_t* Bt, int ngroups, LAS unsigned char* lds, int wid, int lane, F epi) {
    const int fr = lane & 15, fq = lane >> 4;
    LAS f32x4* red = (LAS f32x4*)lds;
    for (int g = blockIdx.x; g < ngroups; g += gridDim.x) {
        f32x4 acc = {0.f, 0.f, 0.f, 0.f};
        const bf16_t* ap = A + (size_t)fr * DM + wid * 256 + fq * 8;
        const bf16_t* bp = Bt + (size_t)(g * 16 + fr) * DM + wid * 256 + fq * 8;
#pragma unroll
        for (int s = 0; s < 8; ++s) {
            const bf16x8 a = *(const bf16x8*)(ap + 32 * s), b = *(const bf16x8*)(bp + 32 * s);
            acc = __builtin_amdgcn_mfma_f32_16x16x32_bf16(b, a, acc, 0, 0, 0);
        }
        red[wid * 64 + lane] = acc;
        __syncthreads();
        if (wid == 0) {
            f32x4 s = red[lane];
#pragma unroll
            for (int w = 1; w < 8; ++w) s += red[w * 64 + lane];
            epi(fr, g * 16 + 4 * fq, s);
        }
        __syncthreads();
    }
}

__device__ __forceinline__ void tr_item(const float* W, int K, int N, bf16_t* WT, const float* sc, LAS float* scr, int item, int lane) {
    const int nblk = N / 32, kb = item / nblk, nb = item % nblk, k0 = 64 * kb, n0 = 32 * nb;
#pragma unroll 8
    for (int i = 0; i < 32; ++i) { const int kk = 2 * i + (lane >> 5); float v = W[(size_t)(k0 + kk) * N + n0 + (lane & 31)]; if (sc) v *= sc[k0 + kk]; scr[kk * 33 + (lane & 31)] = v; }
    LDS_WAIT();
    const int c = lane & 7;
#pragma unroll
    for (int j = 0; j < 4; ++j) { const int n = (lane >> 3) + 8 * j; const LAS float* s = scr + (8 * c) * 33 + n;
        u32x4 o; o.x = pk2(s[0 * 33], s[1 * 33]); o.y = pk2(s[2 * 33], s[3 * 33]); o.z = pk2(s[4 * 33], s[5 * 33]); o.w = pk2(s[6 * 33], s[7 * 33]);
        *(u32x4*)(WT + (size_t)(n0 + n) * K + k0 + 8 * c) = o; }
    LDS_WAIT();
}
__device__ __forceinline__ void cvt_row(const float* src, bf16_t* dst, float* ss, int lane) {
    const f32x4* xr = (const f32x4*)src + lane; f32x4 v[8]; float s = 0.f;
#pragma unroll
    for (int j = 0; j < 8; ++j) { v[j] = xr[64 * j]; s += (v[j].x * v[j].x + v[j].y * v[j].y) + (v[j].z * v[j].z + v[j].w * v[j].w); }
    s = wave_sum(s);
    u32x2* o8 = (u32x2*)dst + lane;
#pragma unroll
    for (int j = 0; j < 8; ++j) { u32x2 w; w.x = pk2(v[j].x, v[j].y); w.y = pk2(v[j].z, v[j].w); o8[64 * j] = w; }
    if (lane == 0) *ss = s;
}

struct Mix {
    const float *conv_a_w, *conv_a_b, *lru_br, *lru_bi, *lru_lambda, *conv_b_w;
    const bf16_t* gw;
    bf16_t* U; bf16_t* Y; unsigned long long* AGG;
};
struct ItemId { int hd, b, c, row0, ntok, agg; bool meta; };
__device__ __forceinline__ ItemId decode_item(int id) {
    ItemId I;
    if (id < 16) { I.meta = true; I.hd = id; I.b = 0; I.c = 0; I.row0 = META0; I.ntok = 16; I.agg = 256; }
    else { const int j = id - 16; I.meta = false; I.hd = j & 15; I.c = (j >> 4) & 63; I.b = j >> 10; I.row0 = I.b * SEQ + I.c * 64; I.ntok = 64; I.agg = I.b * 64 + I.c; }
    return I;
}
constexpr int N_ITEMS = 16 + NBATCH * NHEAD * 64;

__device__ __forceinline__ bool agg_ok(unsigned long long v) { return (unsigned)v != 0u; }
__device__ __forceinline__ void mix_item(const Mix& X, int id, LAS unsigned char* xt, int lane) {
    const ItemId I = decode_item(id);
    const int ch = I.hd * 64 + lane;
    const float br = X.lru_br[ch], bi = X.lru_bi[ch];
    const float nls = -8.0f * log1pf(__expf(-X.lru_lambda[ch]));
    {
        const float w0 = X.conv_a_w[ch], w1 = X.conv_a_w[1024 + ch], w2 = X.conv_a_w[2048 + ch], w3 = X.conv_a_w[3072 + ch], cb = X.conv_a_b[ch];
        const bf16_t* up = X.U + (size_t)I.row0 * DIN + ch;
        float xm3 = 0.f, xm2 = 0.f, xm1 = 0.f;
        if (!I.meta) { const bf16_t* hp = (I.c == 0) ? X.U + (size_t)(META0 + 13) * DIN + ch : up - 3 * DIN; xm3 = bf1(hp[0]); xm2 = bf1(hp[DIN]); xm1 = bf1(hp[2 * DIN]); }
#pragma unroll
        for (int t = 0; t < 64; ++t) { const float x0 = bf1(up[(size_t)t * DIN]); const float xc = cb + w0 * xm3 + w1 * xm2 + w2 * xm1 + w3 * x0; xm3 = xm2; xm2 = xm1; xm1 = x0;
            *(LAS bf16_t*)(xt + t * 144 + lane * 2) = (bf16_t)f2bf(xc); }
    }
    bf16x8 BfR0[4], BfR1[4], BfI0[4], BfI1[4];
    { const bf16_t* gr = X.gw + (size_t)(I.hd * 64 + (lane & 31)) * 64 + 8 * (lane >> 5); const bf16_t* gi = gr + 16 * 64 * 64;
#pragma unroll
      for (int s = 0; s < 4; ++s) { BfR0[s] = *(const bf16x8*)(gr + 16 * s); BfR1[s] = *(const bf16x8*)(gr + 32 * 64 + 16 * s); BfI0[s] = *(const bf16x8*)(gi + 16 * s); BfI1[s] = *(const bf16x8*)(gi + 32 * 64 + 16 * s); } }
    float h = 0.f, P = 1.f;
    unsigned hp[64];
#pragma unroll
    for (int tb = 0; tb < 2; ++tb) {
        f32x16 aR0, aR1, aI0, aI1;
#pragma unroll
        for (int e = 0; e < 16; ++e) { aR0[e] = 0.f; aR1[e] = 0.f; aI0[e] = 0.f; aI1[e] = 0.f; }
#pragma unroll
        for (int s = 0; s < 4; ++s) {
            const bf16x8 af = *(const LAS bf16x8*)(xt + (tb * 32 + (lane & 31)) * 144 + (16 * s + 8 * (lane >> 5)) * 2);
            aR0 = __builtin_amdgcn_mfma_f32_32x32x16_bf16(af, BfR0[s], aR0, 0, 0, 0);
            aR1 = __builtin_amdgcn_mfma_f32_32x32x16_bf16(af, BfR1[s], aR1, 0, 0, 0);
            aI0 = __builtin_amdgcn_mfma_f32_32x32x16_bf16(af, BfI0[s], aI0, 0, 0, 0);
            aI1 = __builtin_amdgcn_mfma_f32_32x32x16_bf16(af, BfI1[s], aI1, 0, 0, 0);
        }
#pragma unroll
        for (int q = 0; q < 4; ++q) {
            float Rv[2][4], Iv[2][4];
#pragma unroll
            for (int k = 0; k < 4; ++k) {
                const int reg = 4 * q + k;
                const float r0f = aR0[reg], r1f = aR1[reg], i0f = aI0[reg], i1f = aI1[reg];
                auto r = __builtin_amdgcn_permlane32_swap(__float_as_uint(r0f), __float_as_uint(r1f), false, false);
                Rv[0][k] = __uint_as_float(r[0]); Rv[1][k] = __uint_as_float(r[1]);
                auto i2 = __builtin_amdgcn_permlane32_swap(__float_as_uint(i0f), __float_as_uint(i1f), false, false);
                Iv[0][k] = __uint_as_float(i2[0]); Iv[1][k] = __uint_as_float(i2[1]);
            }
#pragma unroll
            for (int st = 0; st < 2; ++st)
#pragma unroll
                for (int k = 0; k < 4; ++k) {
                    const int t = tb * 32 + 8 * q + 4 * st + k;
                    const float xc = bf1(*(const LAS bf16_t*)(xt + t * 144 + lane * 2));
                    const float rg = sigmoidf_(Rv[st][k] + br), ig = sigmoidf_(Iv[st][k] + bi);
                    const float la = nls * rg;
                    float a = __expf(la);
                    float bb = sqrtf(-expm1f(2.0f * la)) * (ig * xc);
                    if (t >= I.ntok) { a = 1.f; bb = 0.f; }
                    h = a * h + bb; P = P * a;
                    hp[t] = pg8::cvt_pk_bf16(h, P);
                }
        }
    }
    __hip_atomic_store(X.AGG + (size_t)I.agg * 1024 + ch, ((unsigned long long)__float_as_uint(h) << 32) | (unsigned long long)__float_as_uint(P), __ATOMIC_RELAXED, __HIP_MEMORY_SCOPE_AGENT);
    float hin = 0.f;
    if (!I.meta) {
        { const unsigned long long* mp = X.AGG + (size_t)256 * 1024 + ch; unsigned long long v;
          for (;;) { v = __hip_atomic_load(mp, __ATOMIC_RELAXED, __HIP_MEMORY_SCOPE_AGENT); if (!__any(!agg_ok(v))) break; __builtin_amdgcn_s_sleep(2); }
          hin = __uint_as_float((unsigned)(v >> 32)); }
        const unsigned long long* ap = X.AGG + (size_t)(I.b * 64) * 1024 + ch;
        for (int j0 = 0; j0 < I.c; j0 += 8) {
            unsigned long long v[8];
            for (;;) {
                bool bad = false;
#pragma unroll
                for (int k = 0; k < 8; ++k) { v[k] = (j0 + k < I.c) ? __hip_atomic_load(ap + (size_t)(j0 + k) * 1024, __ATOMIC_RELAXED, __HIP_MEMORY_SCOPE_AGENT) : 0x000000003f800000ull; }
#pragma unroll
                for (int k = 0; k < 8; ++k) bad |= !agg_ok(v[k]);
                if (!__any(bad)) break;
                __builtin_amdgcn_s_sleep(2);
            }
#pragma unroll
            for (int k = 0; k < 8; ++k) hin = __uint_as_float((unsigned)v[k]) * hin + __uint_as_float((unsigned)(v[k] >> 32));
        }
    }
    const bf16_t* gp = X.U + (size_t)I.row0 * DIN + 1024 + ch;
    bf16_t* yp = X.Y + (size_t)I.row0 * DM + ch;
#pragma unroll
    for (int t0 = 0; t0 < 64; t0 += 16) {
        if (t0 < I.ntok) {
            float g[16];
#pragma unroll
            for (int k = 0; k < 16; ++k) g[k] = bf1(gp[(size_t)(t0 + k) * DIN]);
#pragma unroll
            for (int k = 0; k < 16; ++k) { const unsigned w = hp[t0 + k]; const float hv = bflo(w) + bfhi(w) * hin;
                yp[(size_t)(t0 + k) * DM] = (bf16_t)f2bf(hv * g[k] * sigmoidf_(g[k])); }
        }
    }
}

__device__ __forceinline__ void ld8(const bf16_t* p, float (&o)[8]) {
    const u32x4 w = *(const u32x4*)p;
    o[0] = bflo(w.x); o[1] = bfhi(w.x); o[2] = bflo(w.y); o[3] = bfhi(w.y); o[4] = bflo(w.z); o[5] = bfhi(w.z); o[6] = bflo(w.w); o[7] = bfhi(w.w);
}
__device__ __forceinline__ void partb(const Mix& X, int tid) {
    for (int it = blockIdx.x * 512 + tid; it < 1025 * 128; it += gridDim.x * 512) {
        const int c0 = (it & 127) * 8, run = it >> 7;
        int row0, hrow = -1;
        if (run == 1024) row0 = META0; else { row0 = run * 16; hrow = ((row0 & (SEQ - 1)) == 0) ? META0 + 14 : row0 - 2; }
        float w0[8], w1[8], w2[8], cm2[8], cm1[8];
        { const f32x4* p = (const f32x4*)(X.conv_b_w + c0); const f32x4 a0 = p[0], a1 = p[1], b0 = p[256], b1 = p[257], d0 = p[512], d1 = p[513];
#pragma unroll
          for (int e = 0; e < 4; ++e) { w0[e] = a0[e]; w0[4 + e] = a1[e]; w1[e] = b0[e]; w1[4 + e] = b1[e]; w2[e] = d0[e]; w2[4 + e] = d1[e]; } }
        if (hrow >= 0) {
            float c[8], x[8];
            ld8(X.U + (size_t)hrow * DIN + 3072 + c0, c); ld8(X.U + (size_t)hrow * DIN + 4096 + c0, x);
#pragma unroll
            for (int e = 0; e < 8; ++e) cm2[e] = c[e] * x[e];
            ld8(X.U + (size_t)(hrow + 1) * DIN + 3072 + c0, c); ld8(X.U + (size_t)(hrow + 1) * DIN + 4096 + c0, x);
#pragma unroll
            for (int e = 0; e < 8; ++e) cm1[e] = c[e] * x[e];
        } else {
#pragma unroll
            for (int e = 0; e < 8; ++e) { cm2[e] = 0.f; cm1[e] = 0.f; }
        }
        const bf16_t* up = X.U + (size_t)row0 * DIN + c0;
        bf16_t* yp = X.Y + (size_t)row0 * DM + 1024 + c0;
#pragma unroll 4
        for (int t = 0; t < 16; ++t) {
            float bv[8], cv[8], xv[8], gv[8];
            ld8(up + (size_t)t * DIN + 2048, bv); ld8(up + (size_t)t * DIN + 3072, cv); ld8(up + (size_t)t * DIN + 4096, xv); ld8(up + (size_t)t * DIN + 5120, gv);
            float o[8];
#pragma unroll
            for (int e = 0; e < 8; ++e) { const float cx = cv[e] * xv[e]; const float y = w0[e] * cm2[e] + w1[e] * cm1[e] + w2[e] * cx; o[e] = bv[e] * y * (gv[e] * sigmoidf_(gv[e])); cm2[e] = cm1[e]; cm1[e] = cx; }
            u32x4 w; w.x = pk2(o[0], o[1]); w.y = pk2(o[2], o[3]); w.z = pk2(o[4], o[5]); w.w = pk2(o[6], o[7]);
            *(u32x4*)(yp + (size_t)t * DM) = w;
        }
    }
}


#ifdef DEBUG_NAIVE_MIX
__global__ void __launch_bounds__(64) naive_mixA(Mix X, const float* wr, const float* wi) {
    const int b = blockIdx.x / 16, hd = blockIdx.x % 16, lane = threadIdx.x, ch = hd * 64 + lane;
    __shared__ float xs[64];
    const float w0 = X.conv_a_w[ch], w1 = X.conv_a_w[1024 + ch], w2 = X.conv_a_w[2048 + ch], w3 = X.conv_a_w[3072 + ch], cb = X.conv_a_b[ch];
    const float br = X.lru_br[ch], bi = X.lru_bi[ch];
    const float sp = log1pf(expf(-X.lru_lambda[ch]));
    const float* wrh = wr + (size_t)hd * 4096 + lane; const float* wih = wi + (size_t)hd * 4096 + lane;
    float h = 0.f, xm3 = 0.f, xm2 = 0.f, xm1 = 0.f;
    for (int p = 0; p < NMETA + SEQ; ++p) {
        const int row = p < NMETA ? META0 + p : b * SEQ + (p - NMETA);
        const float x0 = bf1(X.U[(size_t)row * DIN + ch]);
        const float xc = cb + w0 * xm3 + w1 * xm2 + w2 * xm1 + w3 * x0; xm3 = xm2; xm2 = xm1; xm1 = x0;
        xs[lane] = xc; __syncthreads();
        float rp = br, ip = bi;
#pragma unroll 4
        for (int i = 0; i < 64; ++i) { rp += xs[i] * wrh[i * 64]; ip += xs[i] * wih[i * 64]; }
        __syncthreads();
        const float r = 1.f / (1.f + expf(-rp)), ig = 1.f / (1.f + expf(-ip));
        const float la = -8.f * r * sp; const float a = expf(la); const float bb = sqrtf(-expm1f(2.f * la)) * (ig * xc);
        h = a * h + bb;
        const float g = bf1(X.U[(size_t)row * DIN + 1024 + ch]);
        const float y = h * g / (1.f + expf(-g));
        if (p >= NMETA || b == 0) X.Y[(size_t)row * DM + ch] = (bf16_t)f2bf(y);
    }
}
__global__ void naive_mixB(Mix X) {
    for (size_t idx = (size_t)blockIdx.x * blockDim.x + threadIdx.x; idx < (size_t)(MROWS + NMETA) * 1024; idx += (size_t)gridDim.x * blockDim.x) {
        const int row = (int)(idx >> 10), c = (int)(idx & 1023);
        int r1, r2;
        if (row >= META0) { const int p = row - META0; r1 = p >= 1 ? row - 1 : -1; r2 = p >= 2 ? row - 2 : -1; }
        else { const int t = row & (SEQ - 1); r1 = t >= 1 ? row - 1 : META0 + 15; r2 = t >= 2 ? row - 2 : META0 + 14 + t; }
        auto cx = [&](int r) -> float { return r < 0 ? 0.f : bf1(X.U[(size_t)r * DIN + 3072 + c]) * bf1(X.U[(size_t)r * DIN + 4096 + c]); };
        const float y = X.conv_b_w[c] * cx(r2) + X.conv_b_w[1024 + c] * cx(r1) + X.conv_b_w[2048 + c] * cx(row);
        const float bv = bf1(X.U[(size_t)row * DIN + 2048 + c]), g = bf1(X.U[(size_t)row * DIN + 5120 + c]);
        X.Y[(size_t)row * DM + 1024 + c] = (bf16_t)f2bf(bv * y * g / (1.f + expf(-g)));
    }
}
#endif
#define XB_TMO      128
#define XB_XCNT(j)  (256  + 64 * (j))
#define XB_XSUB(j)  (1280 + 64 * (j))
#define XB_XGEN(j)  (2304 + 64 * (j))
#define XB_TOP      3328
#define XB_TOPGEN   3392
#define XCD_BAR_WORDS 3456
#define XB_SPIN_CAP (1u << 18)

__device__ __forceinline__ unsigned xb_ld(unsigned* p)              { return __hip_atomic_load(p, __ATOMIC_RELAXED, __HIP_MEMORY_SCOPE_AGENT); }
__device__ __forceinline__ unsigned xb_add(unsigned* p, unsigned v) { return __hip_atomic_fetch_add(p, v, __ATOMIC_RELAXED, __HIP_MEMORY_SCOPE_AGENT); }
__device__ __forceinline__ unsigned xb_xcc_id() { return (unsigned)__builtin_amdgcn_s_getreg((3 << 11) | 20) & 0xFu; }
#define XB_SPIN(cond, bar) do { unsigned _sp = 0; while (cond) { __builtin_amdgcn_s_sleep(1); \
    if ((++_sp & 255u) == 0u) { if (xb_ld(&(bar)[XB_TMO])) break; if (_sp > XB_SPIN_CAP) { atomicAdd(&(bar)[XB_TMO], 1u); break; } } } } while (0)

struct XcdBarrier {
    unsigned* bar; unsigned x;
    volatile LAS unsigned* st;
};

__device__ __forceinline__ XcdBarrier xcd_barrier_post(unsigned* bar, volatile LAS unsigned* st) {
    XcdBarrier b; b.bar = bar; b.x = xb_xcc_id(); b.st = st;
    if (threadIdx.x == 0) (void)xb_add(&bar[XB_XCNT(b.x)], 1u);
    return b;
}
__device__ __forceinline__ void xcd_barrier_complete(unsigned* bar, unsigned x, unsigned& nloc, unsigned& nx) {
    const unsigned G = gridDim.x * gridDim.y * gridDim.z;
    unsigned sum, cnt, mine, sp = 0u;
    for (;;) {
        sum = 0u; cnt = 0u; mine = 0u;
#pragma unroll
        for (unsigned j = 0; j < 16; ++j) { const unsigned c = xb_ld(&bar[XB_XCNT(j)]); sum += c; cnt += (c > 0u) ? 1u : 0u; mine = (j == x) ? c : mine; }
        if (sum == G) break;
        __builtin_amdgcn_s_sleep(1);
        if ((++sp & 255u) == 0u) { if (xb_ld(&bar[XB_TMO])) break; if (sp > XB_SPIN_CAP) { atomicAdd(&bar[XB_TMO], 1u); break; } }
    }
    nloc = mine > 0u ? mine : 1u; nx = cnt > 0u ? cnt : 1u;
}

__device__ __forceinline__ void xcd_barrier(const XcdBarrier& b) {
    asm volatile("s_waitcnt vmcnt(0)" ::: "memory");
    __syncthreads();
    if (threadIdx.x == 0) {
        unsigned* bar = b.bar;
        __builtin_amdgcn_s_waitcnt(0);
        unsigned nloc = b.st[0], nx = b.st[1];
        if (nloc == 0u) { xcd_barrier_complete(bar, b.x, nloc, nx); b.st[0] = nloc; b.st[1] = nx; }
        const unsigned old = xb_add(&bar[XB_XSUB(b.x)], 1u);
        const unsigned gen = old / nloc;
        if (old + 1u == (gen + 1u) * nloc) {
            __builtin_amdgcn_fence(__ATOMIC_RELEASE, "agent");
            asm volatile("s_waitcnt vmcnt(0)" ::: "memory");
            const unsigned og = xb_add(&bar[XB_TOP], 1u);
            const unsigned tg = og / nx;
            if (og + 1u == (tg + 1u) * nx) xb_add(&bar[XB_TOPGEN], 1u);
            else XB_SPIN(xb_ld(&bar[XB_TOPGEN]) == tg, bar);
            __builtin_amdgcn_fence(__ATOMIC_ACQUIRE, "agent");
            xb_add(&bar[XB_XGEN(b.x)], 1u);
            asm volatile("s_waitcnt vmcnt(0)" ::: "memory");
        } else {
            XB_SPIN(xb_ld(&bar[XB_XGEN(b.x)]) == gen, bar);
            __builtin_amdgcn_fence(__ATOMIC_ACQUIRE, "agent");
            asm volatile("s_waitcnt vmcnt(0)" ::: "memory");
        }
    }
    __syncthreads();
}

__global__ void __launch_bounds__(512, 2) hymba_fwd(Args a) {
    extern __shared__ __attribute__((aligned(16))) unsigned char lds_raw[];
    LAS unsigned char* lds = (LAS unsigned char*)lds_raw;
    cg::grid_group grid = cg::this_grid();
    const int NGW = gridDim.x * 8;
    if (threadIdx.x < 64) ((LAS unsigned*)(lds + 131072))[threadIdx.x] = 0u;
    __syncthreads();
    XcdBarrier xbar; xbar.bar = (unsigned*)(a.ws + WS_BAR); xbar.x = 0; xbar.st = nullptr;
    if (a.ph_hi - a.ph_lo > 1) xbar = xcd_barrier_post((unsigned*)(a.ws + WS_BAR), (volatile LAS unsigned*)(lds + 131072));
    if (a.ph_lo < 0) grid.sync();
#define LAUNDER() int tid = threadIdx.x; asm volatile("" : "+v"(tid)); const int wid = __builtin_amdgcn_readfirstlane(tid >> 6), lane = tid & 63, gw = blockIdx.x * 8 + wid
    const int lo = a.ph_lo, hi = a.ph_hi;
#define IN(k) (lo <= (k) && (k) < hi)
#define SEAM(k) do { if (IN(k) && IN((k) + 1)) { xcd_barrier(xbar); if ((REP_MASK >> 10) & 1) { xcd_barrier(xbar); xcd_barrier(xbar); } } } while (0)
    const float* x = a.in[0]; const float* meta = a.in[1]; const float* norm_g = a.in[2]; const float* w_in = a.in[3];
    const float* conv_a_w = a.in[4]; const float* conv_a_b = a.in[5]; const float* lru_wr = a.in[6]; const float* lru_br = a.in[7];
    const float* lru_wi = a.in[8]; const float* lru_bi = a.in[9]; const float* lru_lambda = a.in[10]; const float* conv_b_w = a.in[11];
    const float* w_out = a.in[12]; const float* final_g = a.in[13];
    unsigned char* ws = a.ws;
    bf16_t* WTIN = (bf16_t*)(ws + WS_WTIN); bf16_t* WTOUT = (bf16_t*)(ws + WS_WTOUT); bf16_t* GW = (bf16_t*)(ws + WS_GW);
    float* ROWSS = (float*)(ws + WS_ROWSS); unsigned long long* AGG = (unsigned long long*)(ws + WS_AGG);
    bf16_t* XB = (bf16_t*)(ws + WS_XB); bf16_t* Y = (bf16_t*)(ws + WS_Y); bf16_t* U = (bf16_t*)(ws + WS_U);

    if (IN(0)) for (int rep = 0; rep <= ((REP_MASK >> 0) & 1); ++rep) {
        LAUNDER();
        LAS float* scr = (LAS float*)(lds + wid * 16384);
        constexpr int I_IN = (DM / 64) * (DIN / 32), I_OUT = (DM / 64) * (DM / 32), I_G = 2;
        constexpr int NIT = 2 * I_IN + 2 * I_OUT + 64 * I_G;
        for (int it = gw; it < NIT; it += NGW) {
            int r = it;
            if (r < 2 * I_IN) { const int l = r / I_IN; tr_item(w_in + (size_t)l * DM * DIN, DM, DIN, WTIN + (size_t)l * DIN * DM, norm_g + l * DM, scr, r % I_IN, lane); continue; } r -= 2 * I_IN;
            if (r < 2 * I_OUT) { const int l = r / I_OUT; tr_item(w_out + (size_t)l * DM * DM, DM, DM, WTOUT + (size_t)l * DM * DM, nullptr, scr, r % I_OUT, lane); continue; } r -= 2 * I_OUT;
            { const int mtx = r >> 1, l = mtx >> 5, g = (mtx >> 4) & 1, hd = mtx & 15;
              const float* src = (g ? lru_wi : lru_wr) + (size_t)(l * 16 + hd) * 4096;
              tr_item(src, 64, 64, GW + (size_t)mtx * 4096, nullptr, scr, r & 1, lane); }
        }
        for (int m = gw; m < MROWS + NMETA; m += NGW) {
            const float* src = m < MROWS ? x + (size_t)m * DM : meta + (size_t)(m - MROWS) * DM;
            cvt_row(src, XB + (size_t)m * DM, ROWSS + m, lane);
        }
        for (int i = blockIdx.x * 512 + tid; i < 2 * RSTR; i += gridDim.x * 512) ROWSS[RSTR + i] = 0.f;
        for (int i = blockIdx.x * 512 + tid; i < AGG_PER_LAYER; i += gridDim.x * 512) ((u32x4*)AGG)[i] = (u32x4){0u, 0u, 0u, 0u};
    }
    SEAM(0);

#pragma unroll 1
    for (int l = 0; l < 2; ++l) {
        const int pb = 1 + 3 * l;
        const bf16_t* wtin = WTIN + (size_t)l * DIN * DM; const bf16_t* wtout = WTOUT + (size_t)l * DM * DM;
        float* rss_in = ROWSS + (size_t)l * RSTR; float* rss_out = ROWSS + (size_t)(l + 1) * RSTR;
        Mix X; X.conv_a_w = conv_a_w + l * 4 * DLRU; X.conv_a_b = conv_a_b + l * DLRU; X.lru_br = lru_br + l * DLRU; X.lru_bi = lru_bi + l * DLRU; X.lru_lambda = lru_lambda + l * DLRU;
        X.conv_b_w = conv_b_w + l * 3 * DLRU; X.gw = GW + (size_t)l * 2 * 16 * 4096; X.U = U; X.Y = Y; X.AGG = AGG + (size_t)l * AGG_PER_LAYER;

        if (IN(pb)) for (int rep = 0; rep <= ((REP_MASK >> pb) & 1); ++rep) {
            LAUNDER();
            meta_gemm(XB + (size_t)META0 * DM, wtin, DIN / 16, lds, wid, lane, [&](int m, int n0, f32x4 s) {
                const float rs = rsqrtf(rss_in[META0 + m] * (1.0f / DM) + RMS_EPS);
                u32x2 w; w.x = pk2(s[0] * rs, s[1] * rs); w.y = pk2(s[2] * rs, s[3] * rs);
                *(u32x2*)(U + (size_t)(META0 + m) * DIN + n0) = w; });
            pg8::Gemm g{XB, wtin, MROWS, DIN, DM}; pg8::StaticOrder S; S.init(MROWS, DIN, (int)gridDim.x, (int)blockIdx.x);
            EpiU E{U, rss_in};
            pg8::gemm_phase<EpiU, pg8::StaticOrder, false>(lds, g, S, E, nullptr);
        }
        SEAM(pb);
        if (IN(pb + 1)) for (int rep = 0; rep <= ((REP_MASK >> (pb + 1)) & 1); ++rep) {
            LAUNDER();
            if (!(a.flags & 1)) for (int id = gw; id < N_ITEMS; id += NGW) mix_item(X, id, lds + wid * 9216, lane);
            if (!(a.flags & 2)) partb(X, tid);
        }
        SEAM(pb + 1);
        if (IN(pb + 2)) {
            LAUNDER();
            if (l == 0) {
                meta_gemm(Y + (size_t)META0 * DM, wtout, DM / 16, lds, wid, lane, [&](int m, int n0, f32x4 s) {
                    const f32x4 r = *(const f32x4*)(meta + (size_t)m * DM + n0); const f32x4 hh = r + s;
                    u32x2 w; w.x = pk2(hh[0], hh[1]); w.y = pk2(hh[2], hh[3]);
                    *(u32x2*)(XB + (size_t)(META0 + m) * DM + n0) = w;
                    unsafeAtomicAdd(rss_out + META0 + m, (hh[0] * hh[0] + hh[1] * hh[1]) + (hh[2] * hh[2] + hh[3] * hh[3])); });
            }
            pg8::Gemm g{Y, wtout, MROWS, DM, DM}; pg8::StaticOrder S; S.init(MROWS, DM, (int)gridDim.x, (int)blockIdx.x);
            EpiRes E{l == 0 ? x : a.out, a.out, l == 0 ? XB : nullptr, rss_out};
            pg8::gemm_phase<EpiRes, pg8::StaticOrder, false>(lds, g, S, E, nullptr);
        }
        SEAM(pb + 2);
    }

    if (IN(7)) {
        LAUNDER();
        const float* rss = ROWSS + (size_t)2 * RSTR;
        for (int m = gw; m < MROWS; m += NGW) {
            const float rs = rsqrtf(rss[m] * (1.0f / DM) + RMS_EPS);
            f32x4* p = (f32x4*)(a.out + (size_t)m * DM) + lane; const f32x4* gp = (const f32x4*)final_g + lane;
            f32x4 v[8];
#pragma unroll
            for (int j = 0; j < 8; ++j) v[j] = p[64 * j];
#pragma unroll
            for (int j = 0; j < 8; ++j) p[64 * j] = v[j] * rs * gp[64 * j];
        }
    }
#undef IN
#undef SEAM
}

#ifndef MK_LAUNCH_PER_PHASE
#define MK_LAUNCH_PER_PHASE 0
#endif
extern "C" void kernel_launch(void* const* d_in, const int* in_sizes, int n_in, void* d_out, int out_size, void* d_ws, size_t ws_size, hipStream_t stream) {
    static int grid = 0;
    if (grid == 0) {
        if (n_in != 14 || in_sizes[0] != MROWS * DM || out_size != MROWS * DM || ws_size < WS_END) { fprintf(stderr, "kernel_launch: unexpected shapes (n_in %d, in0 %d, out %d, ws %zu)\n", n_in, n_in > 0 ? in_sizes[0] : -1, out_size, ws_size); grid = -1; return; }
        int dev = 0, cus = 0, per_cu = 0;
        hipGetDevice(&dev); hipDeviceGetAttribute(&cus, hipDeviceAttributeMultiprocessorCount, dev);
        if (hipFuncSetAttribute((const void*)hymba_fwd, hipFuncAttributeMaxDynamicSharedMemorySize, LDS_BYTES) != hipSuccess) { fprintf(stderr, "kernel_launch: hipFuncSetAttribute failed\n"); grid = -1; return; }
        if (hipOccupancyMaxActiveBlocksPerMultiprocessor(&per_cu, (const void*)hymba_fwd, 512, LDS_BYTES) != hipSuccess || per_cu < 1) { fprintf(stderr, "kernel_launch: occupancy query gave %d\n", per_cu); per_cu = 1; }
        (void)hipGetLastError();
        grid = cus * per_cu;
    }
    if (grid < 0) return;
    Args a{};
    for (int i = 0; i < 14; ++i) a.in[i] = (const float*)d_in[i];
    a.out = (float*)d_out; a.ws = (unsigned char*)d_ws;
#if MK_LAUNCH_PER_PHASE
    for (int p = 0; p < NPHASE; ++p) {
#ifdef DEBUG_NAIVE_MIX
        if (p == 2 || p == 6) { const int l = p / 4; unsigned char* ws = (unsigned char*)d_ws;
            Mix X; X.conv_a_w = a.in[4] + l * 4 * DLRU; X.conv_a_b = a.in[5] + l * DLRU; X.lru_br = a.in[7] + l * DLRU; X.lru_bi = a.in[9] + l * DLRU; X.lru_lambda = a.in[10] + l * DLRU;
            X.conv_b_w = a.in[11] + l * 3 * DLRU; X.gw = nullptr; X.U = (bf16_t*)(ws + WS_U); X.Y = (bf16_t*)(ws + WS_Y); X.HP = nullptr; X.AGG = nullptr;
#if DEBUG_NAIVE_MIX == 1
            hipLaunchKernelGGL(naive_mixA, dim3(64), dim3(64), 0, stream, X, a.in[6] + (size_t)l * 16 * 4096, a.in[8] + (size_t)l * 16 * 4096);
            a.flags = 1;
#else
            hipLaunchKernelGGL(naive_mixB, dim3(2048), dim3(256), 0, stream, X);
            a.flags = 2;
#endif
            }
        else a.flags = 0;
#if DEBUG_NAIVE_MIX == 1
        if (p == 3 || p == 7) continue;
#endif
#endif
        a.ph_lo = p; a.ph_hi = p + 1; hipLaunchKernelGGL(hymba_fwd, dim3(grid), dim3(512), LDS_BYTES, stream, a); }
#else
    a.ph_lo = 0; a.ph_hi = NPHASE;
    if (hipMemsetAsync((unsigned char*)d_ws + WS_BAR, 0, XCD_BAR_WORDS * 4, stream) != hipSuccess) { fprintf(stderr, "kernel_launch: memset of barrier words failed\n"); return; }
    void* args[] = {&a};
    const hipError_t e = hipLaunchCooperativeKernel((const void*)hymba_fwd, dim3(grid), dim3(512), args, LDS_BYTES, stream);
    if (e != hipSuccess) fprintf(stderr, "kernel_launch: cooperative launch failed: %s (grid %d)\n", hipGetErrorString(e), grid);
#endif
}
```

```cpp
#include <hip/hip_runtime.h>
#include <hip/hip_cooperative_groups.h>
#include <cstdio>
namespace cg = cooperative_groups;
namespace pg8 {
#define PG8_LAS __attribute__((address_space(3)))
typedef unsigned short bf16_t;
typedef short bf16x8 __attribute__((ext_vector_type(8)));
typedef float f32x4 __attribute__((ext_vector_type(4)));
typedef unsigned u32x4 __attribute__((ext_vector_type(4)));
constexpr int BM = 256, BK = 64, HALF = 128, HTB = HALF * BK * 2  , STAGE_BYTES = 8 * HTB, NXCD = 8, WGM = 8;

__host__ __device__ __forceinline__ int lds_byte(int r, int c) { const int st = (r >> 4) * 2 + (c >> 5), rr = r & 15, cc = c & 31, ob = rr * 64 + cc * 2; return st * 1024 + (ob ^ (((ob >> 9) & 1) << 5)); }
__host__ __device__ __forceinline__ void stage_rc(int b, int& R, int& C) { const int st = b / 1024, sb = b % 1024, swz = sb ^ (((sb >> 9) & 1) << 5); R = (st >> 1) * 16 + swz / 64; C = (st & 1) * 32 + (swz % 64) / 2; }
__host__ __device__ __forceinline__ int perm32(int rho) { const int n = rho >> 4, i = rho & 15; return 8 * (i >> 2) + 4 * n + (i & 3); }

struct Unit { int pm, pn; };
struct Gemm { const bf16_t* A; const bf16_t* Bt; int M, N, K; };

struct StaticOrder {
    int nM, nN, nwg, G, c;
    __host__ __device__ void init(int M, int N, int G_, int c_) { nM = M / BM; nN = N / BM; nwg = nM * nN; G = G_; c = c_; }
    __host__ __device__ bool next(int i, Unit& u) const {
        const long L = (long)i * G + c; if (L >= nwg) return false;
        int wgid = (int)L; { const int q = nwg / NXCD, r = nwg % NXCD, xcd = wgid % NXCD, off = wgid / NXCD; wgid = (xcd < r ? xcd * (q + 1) : r * (q + 1) + (xcd - r) * q) + off; }
        const int nig = WGM * nN, gid = wgid / nig, fm = gid * WGM, gsz = (nM - fm) < WGM ? (nM - fm) : WGM;
        u.pm = fm + ((wgid % nig) % gsz); u.pn = (wgid % nig) / gsz; return true;
    }
    __device__ __forceinline__ void a_ready(const Unit&) const {}
    __device__ __forceinline__ void done(const Unit&) const {}
};
__device__ __forceinline__ unsigned cvt_pk_bf16(float lo, float hi) { unsigned r; asm volatile("v_cvt_pk_bf16_f32 %0, %1, %2" : "=v"(r) : "v"(lo), "v"(hi)); return r; }
template <class Epi, class Sched, bool STAMP = false>
__device__ __forceinline__ void gemm_phase(PG8_LAS unsigned char* lds, const Gemm g, const Sched& S, const Epi& E, unsigned long long* stamps) {
    int tid_l = threadIdx.x; asm volatile("" : "+v"(tid_l));
    const int tid = tid_l, wid = __builtin_amdgcn_readfirstlane(tid >> 6), lane = tid & 63, wr = wid >> 2, wc = wid & 3, fr = lane & 15, fq = lane >> 4;
    const int K = g.K, nt = K / BK;
    int ts_lo = 0, ts_hi = 0, nts = 0; const unsigned long long rt_entry = STAMP ? (unsigned long long)wall_clock64() : 0ull;
#define PG8_STAMP() do { if (STAMP && wid == 0 && nts < 64) { const unsigned long long _c = (unsigned long long)clock64(); \
        ts_lo = (lane == nts) ? (int)(unsigned)_c : ts_lo; ts_hi = (lane == nts) ? (int)(unsigned)(_c >> 32) : ts_hi; ++nts; } } while (0)
    PG8_STAMP();
    unsigned voffA[2], voffB[2];
#pragma unroll
    for (int i = 0; i < 2; ++i) { int R, C; stage_rc(tid * 16 + i * 8192, R, C); const int Rb = Epi::PERM ? ((R & ~31) + perm32(R & 31)) : R;
        voffA[i] = (unsigned)(R * K + C) * 2u; voffB[i] = (unsigned)(Rb * K + C) * 2u; }
    const size_t kstep = (size_t)(BK * 2);
    const size_t hstep = (size_t)HALF * K * 2;
    const size_t tstep = 2 * hstep;
    const unsigned ldsw = (unsigned)wid * 1024u;
    const int aoff = lds_byte(wr * 64 + fr, fq * 8), boff = lds_byte(wc * 32 + fr, fq * 8);
#define PG8_SA(b, h) (((b) * 2 + (h)) * HTB)
#define PG8_SB(b, h) ((4 + (b) * 2 + (h)) * HTB)
#define PG8_STAGE(bufoff, gbase, voff) do { _Pragma("unroll") for (int _i = 0; _i < 2; ++_i) \
        __builtin_amdgcn_global_load_lds((const unsigned*)((const char*)(gbase) + (voff)[_i]), (PG8_LAS unsigned*)(lds + (bufoff) + ldsw + _i * 8192), 16, 0, 0); } while (0)
#define PG8_LDA(dst, b, h) do { _Pragma("unroll") for (int m = 0; m < 4; ++m) _Pragma("unroll") for (int k = 0; k < 2; ++k) dst[m][k] = *(const PG8_LAS bf16x8*)(lds + PG8_SA(b, h) + aoff + m * 2048 + k * 1024); } while (0)
#define PG8_LDB(dst, b, h) do { _Pragma("unroll") for (int n = 0; n < 2; ++n) _Pragma("unroll") for (int k = 0; k < 2; ++k) dst[n][k] = *(const PG8_LAS bf16x8*)(lds + PG8_SB(b, h) + boff + n * 2048 + k * 1024); } while (0)
#define PG8_MMA(ai, bj, At, Bt) do { __builtin_amdgcn_s_setprio(1); _Pragma("unroll") for (int m = 0; m < 4; ++m) _Pragma("unroll") for (int n = 0; n < 2; ++n) _Pragma("unroll") for (int k = 0; k < 2; ++k) \
        acc[ai][bj][m][n] = __builtin_amdgcn_mfma_f32_16x16x32_bf16(Bt[n][k], At[m][k], acc[ai][bj][m][n], 0, 0, 0); __builtin_amdgcn_s_setprio(0); } while (0)
#define PG8_WAIT_V(n) asm volatile("s_waitcnt vmcnt(" #n ")" ::: "memory")
#define PG8_WAIT_L(n) asm volatile("s_waitcnt lgkmcnt(" #n ")" ::: "memory")
#define PG8_BAR __builtin_amdgcn_s_barrier()
#define PG8_SCHED __builtin_amdgcn_sched_barrier(0)
    Unit cur, nxt; int ui = 0;
    if (!S.next(0, cur)) return;
    f32x4 acc[2][2][4][2];
#pragma unroll
    for (int a = 0; a < 2; ++a)
#pragma unroll
        for (int b = 0; b < 2; ++b)
#pragma unroll
            for (int m = 0; m < 4; ++m)
#pragma unroll
                for (int n = 0; n < 2; ++n) acc[a][b][m][n] = (f32x4){0.f, 0.f, 0.f, 0.f};
    bf16x8 At[4][2], B0[2][2], B1[2][2];
    const char* cA = (const char*)g.A + (size_t)cur.pm * tstep; const char* cB = (const char*)g.Bt + (size_t)cur.pn * tstep;
    S.a_ready(cur);
    PG8_STAGE(PG8_SB(0, 0), cB, voffB); PG8_STAGE(PG8_SA(0, 0), cA, voffA); PG8_STAGE(PG8_SB(0, 1), cB + hstep, voffB); PG8_STAGE(PG8_SA(0, 1), cA + hstep, voffA);
    if (wr == 1) PG8_BAR;
    PG8_WAIT_V(4); PG8_BAR;
    PG8_STAGE(PG8_SB(1, 0), cB + kstep, voffB); PG8_STAGE(PG8_SA(1, 0), cA + kstep, voffA); PG8_STAGE(PG8_SB(1, 1), cB + hstep + kstep, voffB);
    PG8_WAIT_V(6); PG8_BAR;
    PG8_STAMP();
    for (;;) {
        const bool has_next = S.next(ui + 1, nxt);
        const char* nA = has_next ? (const char*)g.A + (size_t)nxt.pm * tstep : cA; const char* nB = has_next ? (const char*)g.Bt + (size_t)nxt.pn * tstep : cB;
        for (int t = 0; t < nt; t += 2) {
            const bool last = (t == nt - 2);
            const char* a1 = cA + (size_t)(t + 1) * kstep;
            const char* a2 = last ? nA : cA + (size_t)(t + 2) * kstep; const char* b2 = last ? nB : cB + (size_t)(t + 2) * kstep;
            const char* a3 = a2 + kstep; const char* b3 = b2 + kstep;
            if (last && has_next) S.a_ready(nxt);
            PG8_LDB(B0, 0, 0); PG8_SCHED; PG8_LDA(At, 0, 0); PG8_STAGE(PG8_SA(1, 1), a1 + hstep, voffA);
            PG8_WAIT_L(8); PG8_BAR; PG8_WAIT_L(0); PG8_MMA(0, 0, At, B0); PG8_BAR; PG8_SCHED;
            PG8_LDB(B1, 0, 1); PG8_STAGE(PG8_SB(0, 0), b2, voffB);
            PG8_BAR; PG8_WAIT_L(0); PG8_MMA(0, 1, At, B1); PG8_BAR;
            PG8_LDA(At, 0, 1); PG8_STAGE(PG8_SA(0, 0), a2, voffA);
            PG8_BAR; PG8_WAIT_L(0); PG8_MMA(1, 0, At, B0); PG8_BAR; PG8_SCHED;
            PG8_STAGE(PG8_SB(0, 1), b2 + hstep, voffB);
            PG8_WAIT_V(6); PG8_BAR; PG8_MMA(1, 1, At, B1); PG8_BAR;
            PG8_LDB(B0, 1, 0); PG8_SCHED; PG8_LDA(At, 1, 0); PG8_STAGE(PG8_SA(0, 1), a2 + hstep, voffA);
            PG8_WAIT_L(8); PG8_BAR; PG8_WAIT_L(0); PG8_MMA(0, 0, At, B0); PG8_BAR; PG8_SCHED;
            PG8_LDB(B1, 1, 1); PG8_STAGE(PG8_SB(1, 0), b3, voffB);
            PG8_BAR; PG8_WAIT_L(0); PG8_MMA(0, 1, At, B1); PG8_BAR;
            PG8_LDA(At, 1, 1); PG8_STAGE(PG8_SA(1, 0), a3, voffA);
            PG8_BAR; PG8_WAIT_L(0); PG8_MMA(1, 0, At, B0); PG8_BAR; PG8_SCHED;
            PG8_STAGE(PG8_SB(1, 1), b3 + hstep, voffB);
            PG8_WAIT_V(6); PG8_BAR; PG8_MMA(1, 1, At, B1); PG8_BAR;
        }
        PG8_STAMP();
        if constexpr (!Epi::AFTER_DRAIN) { E(acc, cur, wr, wc, fr, fq); S.done(cur); }
        PG8_STAMP();
        if (!has_next) break;
#pragma unroll
        for (int a = 0; a < 2; ++a)
#pragma unroll
            for (int b = 0; b < 2; ++b)
#pragma unroll
                for (int m = 0; m < 4; ++m)
#pragma unroll
                    for (int n = 0; n < 2; ++n) acc[a][b][m][n] = (f32x4){0.f, 0.f, 0.f, 0.f};
        cur = nxt; cA = nA; cB = nB; ++ui;
    }
    PG8_WAIT_V(0);
    if (wr == 0) PG8_BAR;
    PG8_BAR;
    if constexpr (Epi::AFTER_DRAIN) { E.fused(acc, cur, wr, wc, fr, fq, lds, wid, lane); S.done(cur); }
    PG8_STAMP();
    if (STAMP && wid == 0) { stamps[lane] = lane < nts ? (((unsigned long long)(unsigned)ts_hi << 32) | (unsigned)ts_lo) : 0ull;
        if (lane == 62) stamps[62] = rt_entry; if (lane == 63) stamps[63] = (unsigned long long)wall_clock64(); }
#undef PG8_STAMP
#undef PG8_SA
#undef PG8_SB
#undef PG8_STAGE
#undef PG8_LDA
#undef PG8_LDB
#undef PG8_MMA
#undef PG8_WAIT_V
#undef PG8_WAIT_L
#undef PG8_BAR
#undef PG8_SCHED
}
}

#define LAS __attribute__((address_space(3)))
typedef unsigned short bf16_t;
typedef short bf16x8 __attribute__((ext_vector_type(8)));
typedef float f32x4 __attribute__((ext_vector_type(4)));
typedef float f32x2 __attribute__((ext_vector_type(2)));
typedef float f32x16 __attribute__((ext_vector_type(16)));
typedef unsigned u32x4 __attribute__((ext_vector_type(4)));
typedef unsigned u32x2 __attribute__((ext_vector_type(2)));

constexpr int DM = 2048, NBATCH = 4, SEQ = 4096, MROWS = NBATCH * SEQ, NMETA = 16, DIN = 6144, DLRU = 1024, NHEAD = 16;
constexpr int META0 = MROWS;
constexpr int RSTR = MROWS + 64;
constexpr float RMS_EPS = 1e-6f;
constexpr int NPHASE = 8;
#ifndef REP_MASK
#define REP_MASK 0
#endif
constexpr int LDS_BYTES = 131072 + 256;

constexpr size_t MiB = 1u << 20;
constexpr size_t WS_WTIN = 0;
constexpr size_t WS_WTOUT = 48 * MiB;
constexpr size_t WS_GW = 64 * MiB;
constexpr size_t WS_ROWSS = 65 * MiB;
constexpr size_t WS_BAR = 65 * MiB + 512 * 1024;
constexpr size_t WS_AGG = 66 * MiB;
constexpr size_t WS_XB = 71 * MiB;
constexpr size_t WS_Y = 136 * MiB;
constexpr size_t WS_U = 201 * MiB;
constexpr size_t WS_END = 396 * MiB;
constexpr int AGG_PER_LAYER = 257 * 1024;
static_assert(WS_U + (size_t)RSTR * DIN * 2 <= WS_END && WS_Y + (size_t)RSTR * DM * 2 <= WS_U && WS_XB + (size_t)RSTR * DM * 2 <= WS_Y, "ws map");
static_assert(WS_WTIN + (size_t)2 * DIN * DM * 2 <= WS_WTOUT && WS_WTOUT + (size_t)2 * DM * DM * 2 <= WS_GW && WS_AGG + (size_t)2 * AGG_PER_LAYER * 8 <= WS_XB && WS_ROWSS + (size_t)3 * RSTR * 4 <= WS_BAR, "ws map 2");

struct Args { const float* in[14]; float* out; unsigned char* ws; int ph_lo, ph_hi, flags, pad; };

__device__ __forceinline__ unsigned f2bf(float f) { unsigned u = __builtin_bit_cast(unsigned, f); return (u + 0x7fffu + ((u >> 16) & 1u)) >> 16; }
__device__ __forceinline__ unsigned pk2(float lo, float hi) { return f2bf(lo) | (f2bf(hi) << 16); }
__device__ __forceinline__ float bflo(unsigned w) { return __builtin_bit_cast(float, w << 16); }
__device__ __forceinline__ float bfhi(unsigned w) { return __builtin_bit_cast(float, w & 0xffff0000u); }
__device__ __forceinline__ float bf1(bf16_t v) { return __builtin_bit_cast(float, ((unsigned)v) << 16); }
__device__ __forceinline__ float sigmoidf_(float z) { return __builtin_amdgcn_rcpf(1.0f + __expf(-z)); }
__device__ __forceinline__ float wave_sum(float v) {
#pragma unroll
    for (int o = 1; o < 64; o <<= 1) v += __shfl_xor(v, o);
    return v;
}
#define LDS_WAIT() asm volatile("s_waitcnt lgkmcnt(0)" ::: "memory")

struct EpiU {
    static constexpr bool PERM = true, AFTER_DRAIN = false;
    bf16_t* O; const float* rowss;
    __device__ __forceinline__ void operator()(const f32x4 (&acc)[2][2][4][2], const pg8::Unit& u, int wr, int wc, int fr, int fq) const {
        const int row0 = u.pm * 256 + wr * 64 + fr, col0 = u.pn * 256 + wc * 32 + 8 * fq;
#pragma unroll
        for (int ai = 0; ai < 2; ++ai)
#pragma unroll
            for (int m = 0; m < 4; ++m) {
                const int r = row0 + ai * 128 + m * 16;
                const float rs = rsqrtf(rowss[r] * (1.0f / DM) + RMS_EPS);
                bf16_t* rowp = O + (size_t)r * DIN + col0;
#pragma unroll
                for (int bj = 0; bj < 2; ++bj) {
                    const f32x4 v0 = acc[ai][bj][m][0] * rs, v1 = acc[ai][bj][m][1] * rs;
                    u32x4 w; w.x = pg8::cvt_pk_bf16(v0[0], v0[1]); w.y = pg8::cvt_pk_bf16(v0[2], v0[3]); w.z = pg8::cvt_pk_bf16(v1[0], v1[1]); w.w = pg8::cvt_pk_bf16(v1[2], v1[3]);
                    *(u32x4*)(rowp + bj * 128) = w;
                }
            }
    }
};
struct EpiRes {
    static constexpr bool PERM = true, AFTER_DRAIN = false;
    const float* res; float* out; bf16_t* xb; float* rowss;
    __device__ __forceinline__ void operator()(const f32x4 (&acc)[2][2][4][2], const pg8::Unit& u, int wr, int wc, int fr, int fq) const {
        const int row0 = u.pm * 256 + wr * 64 + fr, col0 = u.pn * 256 + wc * 32 + 8 * fq;
#pragma unroll
        for (int ai = 0; ai < 2; ++ai)
#pragma unroll
            for (int m = 0; m < 4; ++m) {
                const int r = row0 + ai * 128 + m * 16; const size_t off = (size_t)r * DM + col0; float ss = 0.f;
#pragma unroll
                for (int bj = 0; bj < 2; ++bj) {
                    const f32x4 r0 = *(const f32x4*)(res + off + bj * 128), r1 = *(const f32x4*)(res + off + bj * 128 + 4);
                    const f32x4 h0 = r0 + acc[ai][bj][m][0], h1 = r1 + acc[ai][bj][m][1];
                    *(f32x4*)(out + off + bj * 128) = h0; *(f32x4*)(out + off + bj * 128 + 4) = h1;
                    if (xb) { u32x4 w; w.x = pg8::cvt_pk_bf16(h0[0], h0[1]); w.y = pg8::cvt_pk_bf16(h0[2], h0[3]); w.z = pg8::cvt_pk_bf16(h1[0], h1[1]); w.w = pg8::cvt_pk_bf16(h1[2], h1[3]);
                        *(u32x4*)(xb + off + bj * 128) = w; }
                    ss += (h0[0] * h0[0] + h0[1] * h0[1]) + (h0[2] * h0[2] + h0[3] * h0[3]) + (h1[0] * h1[0] + h1[1] * h1[1]) + (h1[2] * h1[2] + h1[3] * h1[3]);
                }
                ss += __shfl_xor(ss, 16); ss += __shfl_xor(ss, 32);
                if (fq == 0) unsafeAtomicAdd(rowss + r, ss);
                asm volatile("" ::: "memory");
            }
    }
};

template <class F> __device__ __forceinline__ void meta_gemm(const bf16_t* A, const bf16_t* Bt, int ngroups, LAS unsigned char* lds, int wid, int lane, F epi) {
    const int fr = lane & 15, fq = lane >> 4;
    LAS f32x4* red = (LAS f32x4*)lds;
    for (int g = blockIdx.x; g < ngroups; g += gridDim.x) {
        f32x4 acc = {0.f, 0.f, 0.f, 0.f};
        const bf16_t* ap = A + (size_t)fr * DM + wid * 256 + fq * 8;
        const bf16_t* bp = Bt + (size_t)(g * 16 + fr) * DM + wid * 256 + fq * 8;
#pragma unroll
        for (int s = 0; s < 8; ++s) {
            const bf16x8 a = *(const bf16x8*)(ap + 32 * s), b = *(const bf16x8*)(bp + 32 * s);
            acc = __builtin_amdgcn_mfma_f32_16x16x32_bf16(b, a, acc, 0, 0, 0);
        }
        red[wid * 64 + lane] = acc;
        __syncthreads();
        if (wid == 0) {
            f32x4 s = red[lane];
#pragma unroll
            for (int w = 1; w < 8; ++w) s += red[w * 64 + lane];
            epi(fr, g * 16 + 4 * fq, s);
        }
        __syncthreads();
    }
}

__device__ __forceinline__ void tr_item(const float* W, int K, int N, bf16_t* WT, const float* sc, LAS float* scr, int item, int lane) {
    const int nblk = N / 32, kb = item / nblk, nb = item % nblk, k0 = 64 * kb, n0 = 32 * nb;
#pragma unroll 8
    for (int i = 0; i < 32; ++i) { const int kk = 2 * i + (lane >> 5); float v = W[(size_t)(k0 + kk) * N + n0 + (lane & 31)]; if (sc) v *= sc[k0 + kk]; scr[kk * 33 + (lane & 31)] = v; }
    LDS_WAIT();
    const int c = lane & 7;
#pragma unroll
    for (int j = 0; j < 4; ++j) { const int n = (lane >> 3) + 8 * j; const LAS float* s = scr + (8 * c) * 33 + n;
        u32x4 o; o.x = pk2(s[0 * 33], s[1 * 33]); o.y = pk2(s[2 * 33], s[3 * 33]); o.z = pk2(s[4 * 33], s[5 * 33]); o.w = pk2(s[6 * 33], s[7 * 33]);
        *(u32x4*)(WT + (size_t)(n0 + n) * K + k0 + 8 * c) = o; }
    LDS_WAIT();
}
__device__ __forceinline__ void cvt_row(const float* src, bf16_t* dst, float* ss, int lane) {
    const f32x4* xr = (const f32x4*)src + lane; f32x4 v[8]; float s = 0.f;
#pragma unroll
    for (int j = 0; j < 8; ++j) { v[j] = xr[64 * j]; s += (v[j].x * v[j].x + v[j].y * v[j].y) + (v[j].z * v[j].z + v[j].w * v[j].w); }
    s = wave_sum(s);
    u32x2* o8 = (u32x2*)dst + lane;
#pragma unroll
    for (int j = 0; j < 8; ++j) { u32x2 w; w.x = pk2(v[j].x, v[j].y); w.y = pk2(v[j].z, v[j].w); o8[64 * j] = w; }
    if (lane == 0) *ss = s;
}

struct Mix {
    const float *conv_a_w, *conv_a_b, *lru_br, *lru_bi, *lru_lambda, *conv_b_w;
    const bf16_t* gw;
    bf16_t* U; bf16_t* Y; unsigned long long* AGG;
};
struct ItemId { int hd, b, c, row0, ntok, agg; bool meta; };
__device__ __forceinline__ ItemId decode_item(int id) {
    ItemId I;
    if (id < 16) { I.meta = true; I.hd = id; I.b = 0; I.c = 0; I.row0 = META0; I.ntok = 16; I.agg = 256; }
    else { const int j = id - 16; I.meta = false; I.hd = j & 15; I.c = (j >> 4) & 63; I.b = j >> 10; I.row0 = I.b * SEQ + I.c * 64; I.ntok = 64; I.agg = I.b * 64 + I.c; }
    return I;
}
constexpr int N_ITEMS = 16 + NBATCH * NHEAD * 64;

__device__ __forceinline__ bool agg_ok(unsigned long long v) { return (unsigned)v != 0u; }
__device__ __forceinline__ void mix_item(const Mix& X, int id, LAS unsigned char* xt, int lane) {
    constexpr float LOG2E = 1.4426950408889634f;
    const ItemId I = decode_item(id);
    const int ch = I.hd * 64 + lane;
    const float nls2 = -8.0f * LOG2E * log1pf(__expf(-X.lru_lambda[ch]));
    bf16_t raw[64], rh0 = 0, rh1 = 0, rh2 = 0;
    const float w0 = X.conv_a_w[ch], w1 = X.conv_a_w[1024 + ch], w2 = X.conv_a_w[2048 + ch], w3 = X.conv_a_w[3072 + ch], cb = X.conv_a_b[ch];
    {
        const bf16_t* up = X.U + (size_t)I.row0 * DIN + ch;
        if (!I.meta) { const bf16_t* hp0 = (I.c == 0) ? X.U + (size_t)(META0 + 13) * DIN + ch : up - 3 * DIN; rh0 = hp0[0]; rh1 = hp0[DIN]; rh2 = hp0[2 * DIN]; }
#pragma unroll
        for (int t = 0; t < 64; ++t) {
            const int tl = (t < 16) ? t : (I.meta ? 15 : t);
            raw[t] = up[(size_t)tl * DIN]; }
    }
    bf16x8 BfR0[4], BfR1[4], BfI0[4], BfI1[4];
    { const bf16_t* gr = X.gw + (size_t)(I.hd * 64 + (lane & 31)) * 64 + 8 * (lane >> 5); const bf16_t* gi = gr + 16 * 64 * 64;
#pragma unroll
      for (int s = 0; s < 4; ++s) { BfR0[s] = *(const bf16x8*)(gr + 16 * s); BfR1[s] = *(const bf16x8*)(gr + 32 * 64 + 16 * s); BfI0[s] = *(const bf16x8*)(gi + 16 * s); BfI1[s] = *(const bf16x8*)(gi + 32 * 64 + 16 * s); } }
    asm volatile("" ::: "memory");
    float xm3 = bf1(rh0), xm2 = bf1(rh1), xm1 = bf1(rh2);
#pragma unroll
    for (int t = 0; t < 64; ++t) { const float x0 = bf1(raw[t]); const float xc = cb + w0 * xm3 + w1 * xm2 + w2 * xm1 + w3 * x0; xm3 = xm2; xm2 = xm1; xm1 = x0;
        *(LAS bf16_t*)(xt + t * 144 + lane * 2) = (bf16_t)f2bf(xc); }
    const float brA = X.lru_br[I.hd * 64 + (lane & 31)], brB = X.lru_br[I.hd * 64 + 32 + (lane & 31)], biA = X.lru_bi[I.hd * 64 + (lane & 31)], biB = X.lru_bi[I.hd * 64 + 32 + (lane & 31)];
    float h = 0.f, P = 1.f, h15 = 0.f, P15 = 1.f;
    unsigned hp[64];
#pragma unroll
    for (int tb = 0; tb < 2; ++tb) {
        f32x16 aR0, aR1, aI0, aI1;
#pragma unroll
        for (int e = 0; e < 16; ++e) { aR0[e] = brA; aR1[e] = brB; aI0[e] = biA; aI1[e] = biB; }
#pragma unroll
        for (int s = 0; s < 4; ++s) {
            const bf16x8 af = *(const LAS bf16x8*)(xt + (tb * 32 + (lane & 31)) * 144 + (16 * s + 8 * (lane >> 5)) * 2);
            aR0 = __builtin_amdgcn_mfma_f32_32x32x16_bf16(af, BfR0[s], aR0, 0, 0, 0);
            aR1 = __builtin_amdgcn_mfma_f32_32x32x16_bf16(af, BfR1[s], aR1, 0, 0, 0);
            aI0 = __builtin_amdgcn_mfma_f32_32x32x16_bf16(af, BfI0[s], aI0, 0, 0, 0);
            aI1 = __builtin_amdgcn_mfma_f32_32x32x16_bf16(af, BfI1[s], aI1, 0, 0, 0);
        }
#pragma unroll
        for (int q = 0; q < 4; ++q) {
            float Rv[2][4], Iv[2][4];
#pragma unroll
            for (int k = 0; k < 4; ++k) {
                const int reg = 4 * q + k;
                const float r0f = aR0[reg], r1f = aR1[reg], i0f = aI0[reg], i1f = aI1[reg];
                auto r = __builtin_amdgcn_permlane32_swap(__float_as_uint(r0f), __float_as_uint(r1f), false, false);
                Rv[0][k] = __uint_as_float(r[0]); Rv[1][k] = __uint_as_float(r[1]);
                auto i2 = __builtin_amdgcn_permlane32_swap(__float_as_uint(i0f), __float_as_uint(i1f), false, false);
                Iv[0][k] = __uint_as_float(i2[0]); Iv[1][k] = __uint_as_float(i2[1]);
            }
#pragma unroll
            for (int st = 0; st < 2; ++st)
#pragma unroll
                for (int p = 0; p < 2; ++p) {
                    const int t = tb * 32 + 8 * q + 4 * st + 2 * p;
                    f32x2 er = (f32x2){Rv[st][2 * p], Rv[st][2 * p + 1]} * (-LOG2E), ei = (f32x2){Iv[st][2 * p], Iv[st][2 * p + 1]} * (-LOG2E);
                    er.x = __builtin_amdgcn_exp2f(er.x); er.y = __builtin_amdgcn_exp2f(er.y); ei.x = __builtin_amdgcn_exp2f(ei.x); ei.y = __builtin_amdgcn_exp2f(ei.y);
                    er = er + 1.0f; ei = ei + 1.0f;
                    f32x2 rg, ig; rg.x = __builtin_amdgcn_rcpf(er.x); rg.y = __builtin_amdgcn_rcpf(er.y); ig.x = __builtin_amdgcn_rcpf(ei.x); ig.y = __builtin_amdgcn_rcpf(ei.y);
                    const f32x2 l2 = rg * nls2;
                    f32x2 a; a.x = __builtin_amdgcn_exp2f(l2.x); a.y = __builtin_amdgcn_exp2f(l2.y);
                    f32x2 om = 1.0f - a * a; om.x = fmaxf(om.x, 0.f); om.y = fmaxf(om.y, 0.f);
                    f32x2 mu; mu.x = __builtin_amdgcn_sqrtf(om.x); mu.y = __builtin_amdgcn_sqrtf(om.y);
                    const f32x2 xc = (f32x2){bf1(*(const LAS bf16_t*)(xt + t * 144 + lane * 2)), bf1(*(const LAS bf16_t*)(xt + (t + 1) * 144 + lane * 2))};
                    const f32x2 bb = mu * ig * xc;
                    h = a.x * h + bb.x; P = P * a.x; hp[t] = pg8::cvt_pk_bf16(h, P);
                    h = a.y * h + bb.y; P = P * a.y; hp[t + 1] = pg8::cvt_pk_bf16(h, P);
                    if (t + 1 == 15) { h15 = h; P15 = P; }
                }
        }
    }
    if (I.meta) { h = h15; P = P15; }
    __hip_atomic_store(X.AGG + (size_t)I.agg * 1024 + ch, ((unsigned long long)__float_as_uint(h) << 32) | (unsigned long long)__float_as_uint(P), __ATOMIC_RELAXED, __HIP_MEMORY_SCOPE_AGENT);
    float hin = 0.f;
    if (!I.meta) {
        { const unsigned long long* mp = X.AGG + (size_t)256 * 1024 + ch; unsigned long long v;
          for (;;) { v = __hip_atomic_load(mp, __ATOMIC_RELAXED, __HIP_MEMORY_SCOPE_AGENT); if (!__any(!agg_ok(v))) break; __builtin_amdgcn_s_sleep(2); }
          hin = __uint_as_float((unsigned)(v >> 32)); }
        const unsigned long long* ap = X.AGG + (size_t)(I.b * 64) * 1024 + ch;
        for (int j0 = 0; j0 < I.c; j0 += 8) {
            unsigned long long v[8];
            for (;;) {
                bool bad = false;
#pragma unroll
                for (int k = 0; k < 8; ++k) { v[k] = (j0 + k < I.c) ? __hip_atomic_load(ap + (size_t)(j0 + k) * 1024, __ATOMIC_RELAXED, __HIP_MEMORY_SCOPE_AGENT) : 0x000000003f800000ull; }
#pragma unroll
                for (int k = 0; k < 8; ++k) bad |= !agg_ok(v[k]);
                if (!__any(bad)) break;
                __builtin_amdgcn_s_sleep(2);
            }
#pragma unroll
            for (int k = 0; k < 8; ++k) hin = __uint_as_float((unsigned)v[k]) * hin + __uint_as_float((unsigned)(v[k] >> 32));
        }
    }
    const bf16_t* gp = X.U + (size_t)I.row0 * DIN + 1024 + ch;
    bf16_t* yp = X.Y + (size_t)I.row0 * DM + ch;
#pragma unroll
    for (int t0 = 0; t0 < 64; t0 += 16) {
        if (t0 < I.ntok) {
            float g[16];
#pragma unroll
            for (int k = 0; k < 16; ++k) g[k] = bf1(gp[(size_t)(t0 + k) * DIN]);
            asm volatile("" ::: "memory");
#pragma unroll
            for (int k = 0; k < 16; k += 2) {
                const unsigned w0 = hp[t0 + k], w1 = hp[t0 + k + 1];
                const f32x2 gg = (f32x2){g[k], g[k + 1]};
                f32x2 e = gg * (-LOG2E); e.x = __builtin_amdgcn_exp2f(e.x); e.y = __builtin_amdgcn_exp2f(e.y); e = e + 1.0f;
                f32x2 sg; sg.x = __builtin_amdgcn_rcpf(e.x); sg.y = __builtin_amdgcn_rcpf(e.y);
                const f32x2 hv = (f32x2){bflo(w0), bflo(w1)} + (f32x2){bfhi(w0), bfhi(w1)} * hin;
                const f32x2 y = hv * gg * sg;
                const unsigned pk = pg8::cvt_pk_bf16(y.x, y.y);
                yp[(size_t)(t0 + k) * DM] = (bf16_t)(pk & 0xffffu); yp[(size_t)(t0 + k + 1) * DM] = (bf16_t)(pk >> 16);
            }
        }
    }
}

__device__ __forceinline__ void ld8(const bf16_t* p, float (&o)[8]) {
    const u32x4 w = *(const u32x4*)p;
    o[0] = bflo(w.x); o[1] = bfhi(w.x); o[2] = bflo(w.y); o[3] = bfhi(w.y); o[4] = bflo(w.z); o[5] = bfhi(w.z); o[6] = bflo(w.w); o[7] = bfhi(w.w);
}
__device__ __forceinline__ void partb(const Mix& X, int tid) {
    for (int it = blockIdx.x * 512 + tid; it < 1025 * 128; it += gridDim.x * 512) {
        const int c0 = (it & 127) * 8, run = it >> 7;
        int row0, hrow = -1;
        if (run == 1024) row0 = META0; else { row0 = run * 16; hrow = ((row0 & (SEQ - 1)) == 0) ? META0 + 14 : row0 - 2; }
        float w0[8], w1[8], w2[8], cm2[8], cm1[8];
        { const f32x4* p = (const f32x4*)(X.conv_b_w + c0); const f32x4 a0 = p[0], a1 = p[1], b0 = p[256], b1 = p[257], d0 = p[512], d1 = p[513];
#pragma unroll
          for (int e = 0; e < 4; ++e) { w0[e] = a0[e]; w0[4 + e] = a1[e]; w1[e] = b0[e]; w1[4 + e] = b1[e]; w2[e] = d0[e]; w2[4 + e] = d1[e]; } }
        if (hrow >= 0) {
            float c[8], x[8];
            ld8(X.U + (size_t)hrow * DIN + 3072 + c0, c); ld8(X.U + (size_t)hrow * DIN + 4096 + c0, x);
#pragma unroll
            for (int e = 0; e < 8; ++e) cm2[e] = c[e] * x[e];
            ld8(X.U + (size_t)(hrow + 1) * DIN + 3072 + c0, c); ld8(X.U + (size_t)(hrow + 1) * DIN + 4096 + c0, x);
#pragma unroll
            for (int e = 0; e < 8; ++e) cm1[e] = c[e] * x[e];
        } else {
#pragma unroll
            for (int e = 0; e < 8; ++e) { cm2[e] = 0.f; cm1[e] = 0.f; }
        }
        const bf16_t* up = X.U + (size_t)row0 * DIN + c0;
        bf16_t* yp = X.Y + (size_t)row0 * DM + 1024 + c0;
#pragma unroll 4
        for (int t = 0; t < 16; ++t) {
            float bv[8], cv[8], xv[8], gv[8];
            ld8(up + (size_t)t * DIN + 2048, bv); ld8(up + (size_t)t * DIN + 3072, cv); ld8(up + (size_t)t * DIN + 4096, xv); ld8(up + (size_t)t * DIN + 5120, gv);
            float o[8];
#pragma unroll
            for (int e = 0; e < 8; ++e) { const float cx = cv[e] * xv[e]; const float y = w0[e] * cm2[e] + w1[e] * cm1[e] + w2[e] * cx; o[e] = bv[e] * y * (gv[e] * sigmoidf_(gv[e])); cm2[e] = cm1[e]; cm1[e] = cx; }
            u32x4 w; w.x = pk2(o[0], o[1]); w.y = pk2(o[2], o[3]); w.z = pk2(o[4], o[5]); w.w = pk2(o[6], o[7]);
            *(u32x4*)(yp + (size_t)t * DM) = w;
        }
    }
}


#ifdef DEBUG_NAIVE_MIX
__global__ void __launch_bounds__(64) naive_mixA(Mix X, const float* wr, const float* wi) {
    const int b = blockIdx.x / 16, hd = blockIdx.x % 16, lane = threadIdx.x, ch = hd * 64 + lane;
    __shared__ float xs[64];
    const float w0 = X.conv_a_w[ch], w1 = X.conv_a_w[1024 + ch], w2 = X.conv_a_w[2048 + ch], w3 = X.conv_a_w[3072 + ch], cb = X.conv_a_b[ch];
    const float br = X.lru_br[ch], bi = X.lru_bi[ch];
    const float sp = log1pf(expf(-X.lru_lambda[ch]));
    const float* wrh = wr + (size_t)hd * 4096 + lane; const float* wih = wi + (size_t)hd * 4096 + lane;
    float h = 0.f, xm3 = 0.f, xm2 = 0.f, xm1 = 0.f;
    for (int p = 0; p < NMETA + SEQ; ++p) {
        const int row = p < NMETA ? META0 + p : b * SEQ + (p - NMETA);
        const float x0 = bf1(X.U[(size_t)row * DIN + ch]);
        const float xc = cb + w0 * xm3 + w1 * xm2 + w2 * xm1 + w3 * x0; xm3 = xm2; xm2 = xm1; xm1 = x0;
        xs[lane] = xc; __syncthreads();
        float rp = br, ip = bi;
#pragma unroll 4
        for (int i = 0; i < 64; ++i) { rp += xs[i] * wrh[i * 64]; ip += xs[i] * wih[i * 64]; }
        __syncthreads();
        const float r = 1.f / (1.f + expf(-rp)), ig = 1.f / (1.f + expf(-ip));
        const float la = -8.f * r * sp; const float a = expf(la); const float bb = sqrtf(-expm1f(2.f * la)) * (ig * xc);
        h = a * h + bb;
        const float g = bf1(X.U[(size_t)row * DIN + 1024 + ch]);
        const float y = h * g / (1.f + expf(-g));
        if (p >= NMETA || b == 0) X.Y[(size_t)row * DM + ch] = (bf16_t)f2bf(y);
    }
}
__global__ void naive_mixB(Mix X) {
    for (size_t idx = (size_t)blockIdx.x * blockDim.x + threadIdx.x; idx < (size_t)(MROWS + NMETA) * 1024; idx += (size_t)gridDim.x * blockDim.x) {
        const int row = (int)(idx >> 10), c = (int)(idx & 1023);
        int r1, r2;
        if (row >= META0) { const int p = row - META0; r1 = p >= 1 ? row - 1 : -1; r2 = p >= 2 ? row - 2 : -1; }
        else { const int t = row & (SEQ - 1); r1 = t >= 1 ? row - 1 : META0 + 15; r2 = t >= 2 ? row - 2 : META0 + 14 + t; }
        auto cx = [&](int r) -> float { return r < 0 ? 0.f : bf1(X.U[(size_t)r * DIN + 3072 + c]) * bf1(X.U[(size_t)r * DIN + 4096 + c]); };
        const float y = X.conv_b_w[c] * cx(r2) + X.conv_b_w[1024 + c] * cx(r1) + X.conv_b_w[2048 + c] * cx(row);
        const float bv = bf1(X.U[(size_t)row * DIN + 2048 + c]), g = bf1(X.U[(size_t)row * DIN + 5120 + c]);
        X.Y[(size_t)row * DM + 1024 + c] = (bf16_t)f2bf(bv * y * g / (1.f + expf(-g)));
    }
}
#endif
#define XB_TMO      128
#define XB_XCNT(j)  (256  + 64 * (j))
#define XB_XSUB(j)  (1280 + 64 * (j))
#define XB_XGEN(j)  (2304 + 64 * (j))
#define XB_TOP      3328
#define XB_TOPGEN   3392
#define XCD_BAR_WORDS 3456
#define XB_SPIN_CAP (1u << 18)

__device__ __forceinline__ unsigned xb_ld(unsigned* p)              { return __hip_atomic_load(p, __ATOMIC_RELAXED, __HIP_MEMORY_SCOPE_AGENT); }
__device__ __forceinline__ unsigned xb_add(unsigned* p, unsigned v) { return __hip_atomic_fetch_add(p, v, __ATOMIC_RELAXED, __HIP_MEMORY_SCOPE_AGENT); }
__device__ __forceinline__ unsigned xb_xcc_id() { return (unsigned)__builtin_amdgcn_s_getreg((3 << 11) | 20) & 0xFu; }
#define XB_SPIN(cond, bar) do { unsigned _sp = 0; while (cond) { __builtin_amdgcn_s_sleep(1); \
    if ((++_sp & 255u) == 0u) { if (xb_ld(&(bar)[XB_TMO])) break; if (_sp > XB_SPIN_CAP) { atomicAdd(&(bar)[XB_TMO], 1u); break; } } } } while (0)

struct XcdBarrier {
    unsigned* bar; unsigned x;
    volatile LAS unsigned* st;
};

__device__ __forceinline__ XcdBarrier xcd_barrier_post(unsigned* bar, volatile LAS unsigned* st) {
    XcdBarrier b; b.bar = bar; b.x = xb_xcc_id(); b.st = st;
    if (threadIdx.x == 0) (void)xb_add(&bar[XB_XCNT(b.x)], 1u);
    return b;
}
__device__ __forceinline__ void xcd_barrier_complete(unsigned* bar, unsigned x, unsigned& nloc, unsigned& nx) {
    const unsigned G = gridDim.x * gridDim.y * gridDim.z;
    unsigned sum, cnt, mine, sp = 0u;
    for (;;) {
        sum = 0u; cnt = 0u; mine = 0u;
#pragma unroll
        for (unsigned j = 0; j < 16; ++j) { const unsigned c = xb_ld(&bar[XB_XCNT(j)]); sum += c; cnt += (c > 0u) ? 1u : 0u; mine = (j == x) ? c : mine; }
        if (sum == G) break;
        __builtin_amdgcn_s_sleep(1);
        if ((++sp & 255u) == 0u) { if (xb_ld(&bar[XB_TMO])) break; if (sp > XB_SPIN_CAP) { atomicAdd(&bar[XB_TMO], 1u); break; } }
    }
    nloc = mine > 0u ? mine : 1u; nx = cnt > 0u ? cnt : 1u;
}

__device__ __forceinline__ void xcd_barrier(const XcdBarrier& b) {
    asm volatile("s_waitcnt vmcnt(0)" ::: "memory");
    __syncthreads();
    if (threadIdx.x == 0) {
        unsigned* bar = b.bar;
        __builtin_amdgcn_s_waitcnt(0);
        unsigned nloc = b.st[0], nx = b.st[1];
        if (nloc == 0u) { xcd_barrier_complete(bar, b.x, nloc, nx); b.st[0] = nloc; b.st[1] = nx; }
        const unsigned old = xb_add(&bar[XB_XSUB(b.x)], 1u);
        const unsigned gen = old / nloc;
        if (old + 1u == (gen + 1u) * nloc) {
            __builtin_amdgcn_fence(__ATOMIC_RELEASE, "agent");
            asm volatile("s_waitcnt vmcnt(0)" ::: "memory");
            const unsigned og = xb_add(&bar[XB_TOP], 1u);
            const unsigned tg = og / nx;
            if (og + 1u == (tg + 1u) * nx) xb_add(&bar[XB_TOPGEN], 1u);
            else XB_SPIN(xb_ld(&bar[XB_TOPGEN]) == tg, bar);
            __builtin_amdgcn_fence(__ATOMIC_ACQUIRE, "agent");
            xb_add(&bar[XB_XGEN(b.x)], 1u);
            asm volatile("s_waitcnt vmcnt(0)" ::: "memory");
        } else {
            XB_SPIN(xb_ld(&bar[XB_XGEN(b.x)]) == gen, bar);
            __builtin_amdgcn_fence(__ATOMIC_ACQUIRE, "agent");
            asm volatile("s_waitcnt vmcnt(0)" ::: "memory");
        }
    }
    __syncthreads();
}

__global__ void __launch_bounds__(512, 2) hymba_fwd(Args a) {
    extern __shared__ __attribute__((aligned(16))) unsigned char lds_raw[];
    LAS unsigned char* lds = (LAS unsigned char*)lds_raw;
    cg::grid_group grid = cg::this_grid();
    const int NGW = gridDim.x * 8;
    if (threadIdx.x < 64) ((LAS unsigned*)(lds + 131072))[threadIdx.x] = 0u;
    __syncthreads();
    XcdBarrier xbar; xbar.bar = (unsigned*)(a.ws + WS_BAR); xbar.x = 0; xbar.st = nullptr;
    if (a.ph_hi - a.ph_lo > 1) xbar = xcd_barrier_post((unsigned*)(a.ws + WS_BAR), (volatile LAS unsigned*)(lds + 131072));
    if (a.ph_lo < 0) grid.sync();
#define LAUNDER() int tid = threadIdx.x; asm volatile("" : "+v"(tid)); const int wid = __builtin_amdgcn_readfirstlane(tid >> 6), lane = tid & 63, gw = blockIdx.x * 8 + wid
    const int lo = a.ph_lo, hi = a.ph_hi;
#define IN(k) (lo <= (k) && (k) < hi)
#define SEAM(k) do { if (IN(k) && IN((k) + 1)) { xcd_barrier(xbar); if ((REP_MASK >> 10) & 1) { xcd_barrier(xbar); xcd_barrier(xbar); } } } while (0)
    const float* x = a.in[0]; const float* meta = a.in[1]; const float* norm_g = a.in[2]; const float* w_in = a.in[3];
    const float* conv_a_w = a.in[4]; const float* conv_a_b = a.in[5]; const float* lru_wr = a.in[6]; const float* lru_br = a.in[7];
    const float* lru_wi = a.in[8]; const float* lru_bi = a.in[9]; const float* lru_lambda = a.in[10]; const float* conv_b_w = a.in[11];
    const float* w_out = a.in[12]; const float* final_g = a.in[13];
    unsigned char* ws = a.ws;
    bf16_t* WTIN = (bf16_t*)(ws + WS_WTIN); bf16_t* WTOUT = (bf16_t*)(ws + WS_WTOUT); bf16_t* GW = (bf16_t*)(ws + WS_GW);
    float* ROWSS = (float*)(ws + WS_ROWSS); unsigned long long* AGG = (unsigned long long*)(ws + WS_AGG);
    bf16_t* XB = (bf16_t*)(ws + WS_XB); bf16_t* Y = (bf16_t*)(ws + WS_Y); bf16_t* U = (bf16_t*)(ws + WS_U);

    if (IN(0)) for (int rep = 0; rep <= ((REP_MASK >> 0) & 1); ++rep) {
        LAUNDER();
        LAS float* scr = (LAS float*)(lds + wid * 16384);
        constexpr int I_IN = (DM / 64) * (DIN / 32), I_OUT = (DM / 64) * (DM / 32), I_G = 2;
        constexpr int NIT = 2 * I_IN + 2 * I_OUT + 64 * I_G;
        for (int it = gw; it < NIT; it += NGW) {
            int r = it;
            if (r < 2 * I_IN) { const int l = r / I_IN; tr_item(w_in + (size_t)l * DM * DIN, DM, DIN, WTIN + (size_t)l * DIN * DM, norm_g + l * DM, scr, r % I_IN, lane); continue; } r -= 2 * I_IN;
            if (r < 2 * I_OUT) { const int l = r / I_OUT; tr_item(w_out + (size_t)l * DM * DM, DM, DM, WTOUT + (size_t)l * DM * DM, nullptr, scr, r % I_OUT, lane); continue; } r -= 2 * I_OUT;
            { const int mtx = r >> 1, l = mtx >> 5, g = (mtx >> 4) & 1, hd = mtx & 15;
              const float* src = (g ? lru_wi : lru_wr) + (size_t)(l * 16 + hd) * 4096;
              tr_item(src, 64, 64, GW + (size_t)mtx * 4096, nullptr, scr, r & 1, lane); }
        }
        for (int m = gw; m < MROWS + NMETA; m += NGW) {
            const float* src = m < MROWS ? x + (size_t)m * DM : meta + (size_t)(m - MROWS) * DM;
            cvt_row(src, XB + (size_t)m * DM, ROWSS + m, lane);
        }
        for (int i = blockIdx.x * 512 + tid; i < 2 * RSTR; i += gridDim.x * 512) ROWSS[RSTR + i] = 0.f;
        for (int i = blockIdx.x * 512 + tid; i < AGG_PER_LAYER; i += gridDim.x * 512) ((u32x4*)AGG)[i] = (u32x4){0u, 0u, 0u, 0u};
    }
    SEAM(0);

#pragma unroll 1
    for (int l = 0; l < 2; ++l) {
        const int pb = 1 + 3 * l;
        const bf16_t* wtin = WTIN + (size_t)l * DIN * DM; const bf16_t* wtout = WTOUT + (size_t)l * DM * DM;
        float* rss_in = ROWSS + (size_t)l * RSTR; float* rss_out = ROWSS + (size_t)(l + 1) * RSTR;
        Mix X; X.conv_a_w = conv_a_w + l * 4 * DLRU; X.conv_a_b = conv_a_b + l * DLRU; X.lru_br = lru_br + l * DLRU; X.lru_bi = lru_bi + l * DLRU; X.lru_lambda = lru_lambda + l * DLRU;
        X.conv_b_w = conv_b_w + l * 3 * DLRU; X.gw = GW + (size_t)l * 2 * 16 * 4096; X.U = U; X.Y = Y; X.AGG = AGG + (size_t)l * AGG_PER_LAYER;

        if (IN(pb)) for (int rep = 0; rep <= ((REP_MASK >> pb) & 1); ++rep) {
            LAUNDER();
            meta_gemm(XB + (size_t)META0 * DM, wtin, DIN / 16, lds, wid, lane, [&](int m, int n0, f32x4 s) {
                const float rs = rsqrtf(rss_in[META0 + m] * (1.0f / DM) + RMS_EPS);
                u32x2 w; w.x = pk2(s[0] * rs, s[1] * rs); w.y = pk2(s[2] * rs, s[3] * rs);
                *(u32x2*)(U + (size_t)(META0 + m) * DIN + n0) = w; });
            pg8::Gemm g{XB, wtin, MROWS, DIN, DM}; pg8::StaticOrder S; S.init(MROWS, DIN, (int)gridDim.x, (int)blockIdx.x);
            EpiU E{U, rss_in};
            pg8::gemm_phase<EpiU, pg8::StaticOrder, false>(lds, g, S, E, nullptr);
        }
        SEAM(pb);
        if (IN(pb + 1)) for (int rep = 0; rep <= ((REP_MASK >> (pb + 1)) & 1); ++rep) {
            LAUNDER();
#pragma unroll 1
            for (int step = 0; step < 2; ++step) {
                if ((step == 0) == (wid < 4)) {
                    if (rep == 1 && ((REP_MASK >> 13) & 1)) continue;
#pragma unroll 1
                    for (int id = gw; id < N_ITEMS; id += NGW) mix_item(X, id, lds + wid * 9216, lane);
                } else { if (rep == 1 && ((REP_MASK >> 12) & 1)) continue; partb(X, tid); }
            }
        }
        SEAM(pb + 1);
        if (IN(pb + 2)) {
            LAUNDER();
            if (l == 0) {
                meta_gemm(Y + (size_t)META0 * DM, wtout, DM / 16, lds, wid, lane, [&](int m, int n0, f32x4 s) {
                    const f32x4 r = *(const f32x4*)(meta + (size_t)m * DM + n0); const f32x4 hh = r + s;
                    u32x2 w; w.x = pk2(hh[0], hh[1]); w.y = pk2(hh[2], hh[3]);
                    *(u32x2*)(XB + (size_t)(META0 + m) * DM + n0) = w;
                    unsafeAtomicAdd(rss_out + META0 + m, (hh[0] * hh[0] + hh[1] * hh[1]) + (hh[2] * hh[2] + hh[3] * hh[3])); });
            }
            pg8::Gemm g{Y, wtout, MROWS, DM, DM}; pg8::StaticOrder S; S.init(MROWS, DM, (int)gridDim.x, (int)blockIdx.x);
            if ((REP_MASK >> 11) & 1) { EpiU Ed{U, rss_in}; pg8::gemm_phase<EpiU, pg8::StaticOrder, false>(lds, g, S, Ed, nullptr); }
            EpiRes E{l == 0 ? x : a.out, a.out, l == 0 ? XB : nullptr, rss_out};
            pg8::gemm_phase<EpiRes, pg8::StaticOrder, false>(lds, g, S, E, nullptr);
        }
        SEAM(pb + 2);
    }

    if (IN(7)) {
        LAUNDER();
        const float* rss = ROWSS + (size_t)2 * RSTR;
        for (int m = gw; m < MROWS; m += NGW) {
            const float rs = rsqrtf(rss[m] * (1.0f / DM) + RMS_EPS);
            f32x4* p = (f32x4*)(a.out + (size_t)m * DM) + lane; const f32x4* gp = (const f32x4*)final_g + lane;
            f32x4 v[8];
#pragma unroll
            for (int j = 0; j < 8; ++j) v[j] = p[64 * j];
#pragma unroll
            for (int j = 0; j < 8; ++j) p[64 * j] = v[j] * rs * gp[64 * j];
        }
    }
#undef IN
#undef SEAM
}

#ifndef MK_LAUNCH_PER_PHASE
#define MK_LAUNCH_PER_PHASE 0
#endif
extern "C" void kernel_launch(void* const* d_in, const int* in_sizes, int n_in, void* d_out, int out_size, void* d_ws, size_t ws_size, hipStream_t stream) {
    static int grid = 0;
    if (grid == 0) {
        if (n_in != 14 || in_sizes[0] != MROWS * DM || out_size != MROWS * DM || ws_size < WS_END) { fprintf(stderr, "kernel_launch: unexpected shapes (n_in %d, in0 %d, out %d, ws %zu)\n", n_in, n_in > 0 ? in_sizes[0] : -1, out_size, ws_size); grid = -1; return; }
        int dev = 0, cus = 0, per_cu = 0;
        hipGetDevice(&dev); hipDeviceGetAttribute(&cus, hipDeviceAttributeMultiprocessorCount, dev);
        if (hipFuncSetAttribute((const void*)hymba_fwd, hipFuncAttributeMaxDynamicSharedMemorySize, LDS_BYTES) != hipSuccess) { fprintf(stderr, "kernel_launch: hipFuncSetAttribute failed\n"); grid = -1; return; }
        if (hipOccupancyMaxActiveBlocksPerMultiprocessor(&per_cu, (const void*)hymba_fwd, 512, LDS_BYTES) != hipSuccess || per_cu < 1) { fprintf(stderr, "kernel_launch: occupancy query gave %d\n", per_cu); per_cu = 1; }
        (void)hipGetLastError();
        grid = cus * per_cu;
    }
    if (grid < 0) return;
    Args a{};
    for (int i = 0; i < 14; ++i) a.in[i] = (const float*)d_in[i];
    a.out = (float*)d_out; a.ws = (unsigned char*)d_ws;
#if MK_LAUNCH_PER_PHASE
    for (int p = 0; p < NPHASE; ++p) {
#ifdef DEBUG_NAIVE_MIX
        if (p == 2 || p == 6) { const int l = p / 4; unsigned char* ws = (unsigned char*)d_ws;
            Mix X; X.conv_a_w = a.in[4] + l * 4 * DLRU; X.conv_a_b = a.in[5] + l * DLRU; X.lru_br = a.in[7] + l * DLRU; X.lru_bi = a.in[9] + l * DLRU; X.lru_lambda = a.in[10] + l * DLRU;
            X.conv_b_w = a.in[11] + l * 3 * DLRU; X.gw = nullptr; X.U = (bf16_t*)(ws + WS_U); X.Y = (bf16_t*)(ws + WS_Y); X.HP = nullptr; X.AGG = nullptr;
#if DEBUG_NAIVE_MIX == 1
            hipLaunchKernelGGL(naive_mixA, dim3(64), dim3(64), 0, stream, X, a.in[6] + (size_t)l * 16 * 4096, a.in[8] + (size_t)l * 16 * 4096);
            a.flags = 1;
#else
            hipLaunchKernelGGL(naive_mixB, dim3(2048), dim3(256), 0, stream, X);
            a.flags = 2;
#endif
            }
        else a.flags = 0;
#if DEBUG_NAIVE_MIX == 1
        if (p == 3 || p == 7) continue;
#endif
#endif
        a.ph_lo = p; a.ph_hi = p + 1; hipLaunchKernelGGL(hymba_fwd, dim3(grid), dim3(512), LDS_BYTES, stream, a); }
#else
    a.ph_lo = 0; a.ph_hi = NPHASE;
    if (hipMemsetAsync((unsigned char*)d_ws + WS_BAR, 0, XCD_BAR_WORDS * 4, stream) != hipSuccess) { fprintf(stderr, "kernel_launch: memset of barrier words failed\n"); return; }
    void* args[] = {&a};
    const hipError_t e = hipLaunchCooperativeKernel((const void*)hymba_fwd, dim3(grid), dim3(512), args, LDS_BYTES, stream);
    if (e != hipSuccess) fprintf(stderr, "kernel_launch: cooperative launch failed: %s (grid %d)\n", hipGetErrorString(e), grid);
#endif
}
```

```cpp
#include <hip/hip_runtime.h>
#include <hip/hip_cooperative_groups.h>
#include <cstdio>
namespace cg = cooperative_groups;
namespace pg8 {
#define PG8_LAS __attribute__((address_space(3)))
typedef unsigned short bf16_t;
typedef short bf16x8 __attribute__((ext_vector_type(8)));
typedef float f32x4 __attribute__((ext_vector_type(4)));
typedef unsigned u32x4 __attribute__((ext_vector_type(4)));
constexpr int BM = 256, BK = 64, HALF = 128, HTB = HALF * BK * 2  , STAGE_BYTES = 8 * HTB, NXCD = 8, WGM = 8;

__host__ __device__ __forceinline__ int lds_byte(int r, int c) { const int st = (r >> 4) * 2 + (c >> 5), rr = r & 15, cc = c & 31, ob = rr * 64 + cc * 2; return st * 1024 + (ob ^ (((ob >> 9) & 1) << 5)); }
__host__ __device__ __forceinline__ void stage_rc(int b, int& R, int& C) { const int st = b / 1024, sb = b % 1024, swz = sb ^ (((sb >> 9) & 1) << 5); R = (st >> 1) * 16 + swz / 64; C = (st & 1) * 32 + (swz % 64) / 2; }
__host__ __device__ __forceinline__ int perm32(int rho) { const int n = rho >> 4, i = rho & 15; return 8 * (i >> 2) + 4 * n + (i & 3); }

struct Unit { int pm, pn; };
struct Gemm { const bf16_t* A; const bf16_t* Bt; int M, N, K; };

struct StaticOrder {
    int nM, nN, nwg, G, c;
    __host__ __device__ void init(int M, int N, int G_, int c_) { nM = M / BM; nN = N / BM; nwg = nM * nN; G = G_; c = c_; }
    __host__ __device__ bool next(int i, Unit& u) const {
        const long L = (long)i * G + c; if (L >= nwg) return false;
        int wgid = (int)L; { const int q = nwg / NXCD, r = nwg % NXCD, xcd = wgid % NXCD, off = wgid / NXCD; wgid = (xcd < r ? xcd * (q + 1) : r * (q + 1) + (xcd - r) * q) + off; }
        const int nig = WGM * nN, gid = wgid / nig, fm = gid * WGM, gsz = (nM - fm) < WGM ? (nM - fm) : WGM;
        u.pm = fm + ((wgid % nig) % gsz); u.pn = (wgid % nig) / gsz; return true;
    }
    __device__ __forceinline__ void a_ready(const Unit&) const {}
    __device__ __forceinline__ void done(const Unit&) const {}
};
__device__ __forceinline__ unsigned cvt_pk_bf16(float lo, float hi) { unsigned r; asm volatile("v_cvt_pk_bf16_f32 %0, %1, %2" : "=v"(r) : "v"(lo), "v"(hi)); return r; }
template <class Epi, class Sched, bool STAMP = false>
__device__ __forceinline__ void gemm_phase(PG8_LAS unsigned char* lds, const Gemm g, const Sched& S, const Epi& E, unsigned long long* stamps) {
    int tid_l = threadIdx.x; asm volatile("" : "+v"(tid_l));
    const int tid = tid_l, wid = __builtin_amdgcn_readfirstlane(tid >> 6), lane = tid & 63, wr = wid >> 2, wc = wid & 3, fr = lane & 15, fq = lane >> 4;
    const int K = g.K, nt = K / BK;
    int ts_lo = 0, ts_hi = 0, nts = 0; const unsigned long long rt_entry = STAMP ? (unsigned long long)wall_clock64() : 0ull;
#define PG8_STAMP() do { if (STAMP && wid == 0 && nts < 64) { const unsigned long long _c = (unsigned long long)clock64(); \
        ts_lo = (lane == nts) ? (int)(unsigned)_c : ts_lo; ts_hi = (lane == nts) ? (int)(unsigned)(_c >> 32) : ts_hi; ++nts; } } while (0)
    PG8_STAMP();
    unsigned voffA[2], voffB[2];
#pragma unroll
    for (int i = 0; i < 2; ++i) { int R, C; stage_rc(tid * 16 + i * 8192, R, C); const int Rb = Epi::PERM ? ((R & ~31) + perm32(R & 31)) : R;
        voffA[i] = (unsigned)(R * K + C) * 2u; voffB[i] = (unsigned)(Rb * K + C) * 2u; }
    const size_t kstep = (size_t)(BK * 2);
    const size_t hstep = (size_t)HALF * K * 2;
    const size_t tstep = 2 * hstep;
    const unsigned ldsw = (unsigned)wid * 1024u;
    const int aoff = lds_byte(wr * 64 + fr, fq * 8), boff = lds_byte(wc * 32 + fr, fq * 8);
#define PG8_SA(b, h) (((b) * 2 + (h)) * HTB)
#define PG8_SB(b, h) ((4 + (b) * 2 + (h)) * HTB)
#define PG8_STAGE(bufoff, gbase, voff) do { _Pragma("unroll") for (int _i = 0; _i < 2; ++_i) \
        __builtin_amdgcn_global_load_lds((const unsigned*)((const char*)(gbase) + (voff)[_i]), (PG8_LAS unsigned*)(lds + (bufoff) + ldsw + _i * 8192), 16, 0, 0); } while (0)
#define PG8_LDA(dst, b, h) do { _Pragma("unroll") for (int m = 0; m < 4; ++m) _Pragma("unroll") for (int k = 0; k < 2; ++k) dst[m][k] = *(const PG8_LAS bf16x8*)(lds + PG8_SA(b, h) + aoff + m * 2048 + k * 1024); } while (0)
#define PG8_LDB(dst, b, h) do { _Pragma("unroll") for (int n = 0; n < 2; ++n) _Pragma("unroll") for (int k = 0; k < 2; ++k) dst[n][k] = *(const PG8_LAS bf16x8*)(lds + PG8_SB(b, h) + boff + n * 2048 + k * 1024); } while (0)
#define PG8_MMA(ai, bj, At, Bt) do { __builtin_amdgcn_s_setprio(1); _Pragma("unroll") for (int m = 0; m < 4; ++m) _Pragma("unroll") for (int n = 0; n < 2; ++n) _Pragma("unroll") for (int k = 0; k < 2; ++k) \
        acc[ai][bj][m][n] = __builtin_amdgcn_mfma_f32_16x16x32_bf16(Bt[n][k], At[m][k], acc[ai][bj][m][n], 0, 0, 0); __builtin_amdgcn_s_setprio(0); } while (0)
#define PG8_WAIT_V(n) asm volatile("s_waitcnt vmcnt(" #n ")" ::: "memory")
#define PG8_WAIT_L(n) asm volatile("s_waitcnt lgkmcnt(" #n ")" ::: "memory")
#define PG8_BAR __builtin_amdgcn_s_barrier()
#define PG8_SCHED __builtin_amdgcn_sched_barrier(0)
    Unit cur, nxt; int ui = 0;
    if (!S.next(0, cur)) return;
    f32x4 acc[2][2][4][2];
#pragma unroll
    for (int a = 0; a < 2; ++a)
#pragma unroll
        for (int b = 0; b < 2; ++b)
#pragma unroll
            for (int m = 0; m < 4; ++m)
#pragma unroll
                for (int n = 0; n < 2; ++n) acc[a][b][m][n] = (f32x4){0.f, 0.f, 0.f, 0.f};
    bf16x8 At[4][2], B0[2][2], B1[2][2];
    const char* cA = (const char*)g.A + (size_t)cur.pm * tstep; const char* cB = (const char*)g.Bt + (size_t)cur.pn * tstep;
    S.a_ready(cur);
    PG8_STAGE(PG8_SB(0, 0), cB, voffB); PG8_STAGE(PG8_SA(0, 0), cA, voffA); PG8_STAGE(PG8_SB(0, 1), cB + hstep, voffB); PG8_STAGE(PG8_SA(0, 1), cA + hstep, voffA);
    if (wr == 1) PG8_BAR;
    PG8_WAIT_V(4); PG8_BAR;
    PG8_STAGE(PG8_SB(1, 0), cB + kstep, voffB); PG8_STAGE(PG8_SA(1, 0), cA + kstep, voffA); PG8_STAGE(PG8_SB(1, 1), cB + hstep + kstep, voffB);
    PG8_WAIT_V(6); PG8_BAR;
    PG8_STAMP();
    for (;;) {
        const bool has_next = S.next(ui + 1, nxt);
        const char* nA = has_next ? (const char*)g.A + (size_t)nxt.pm * tstep : cA; const char* nB = has_next ? (const char*)g.Bt + (size_t)nxt.pn * tstep : cB;
        for (int t = 0; t < nt; t += 2) {
            const bool last = (t == nt - 2);
            const char* a1 = cA + (size_t)(t + 1) * kstep;
            const char* a2 = last ? nA : cA + (size_t)(t + 2) * kstep; const char* b2 = last ? nB : cB + (size_t)(t + 2) * kstep;
            const char* a3 = a2 + kstep; const char* b3 = b2 + kstep;
            if (last && has_next) S.a_ready(nxt);
            PG8_LDB(B0, 0, 0); PG8_SCHED; PG8_LDA(At, 0, 0); PG8_STAGE(PG8_SA(1, 1), a1 + hstep, voffA);
            PG8_WAIT_L(8); PG8_BAR; PG8_WAIT_L(0); PG8_MMA(0, 0, At, B0); PG8_BAR; PG8_SCHED;
            PG8_LDB(B1, 0, 1); PG8_STAGE(PG8_SB(0, 0), b2, voffB);
            PG8_BAR; PG8_WAIT_L(0); PG8_MMA(0, 1, At, B1); PG8_BAR;
            PG8_LDA(At, 0, 1); PG8_STAGE(PG8_SA(0, 0), a2, voffA);
            PG8_BAR; PG8_WAIT_L(0); PG8_MMA(1, 0, At, B0); PG8_BAR; PG8_SCHED;
            PG8_STAGE(PG8_SB(0, 1), b2 + hstep, voffB);
            PG8_WAIT_V(6); PG8_BAR; PG8_MMA(1, 1, At, B1); PG8_BAR;
            PG8_LDB(B0, 1, 0); PG8_SCHED; PG8_LDA(At, 1, 0); PG8_STAGE(PG8_SA(0, 1), a2 + hstep, voffA);
            PG8_WAIT_L(8); PG8_BAR; PG8_WAIT_L(0); PG8_MMA(0, 0, At, B0); PG8_BAR; PG8_SCHED;
            PG8_LDB(B1, 1, 1); PG8_STAGE(PG8_SB(1, 0), b3, voffB);
            PG8_BAR; PG8_WAIT_L(0); PG8_MMA(0, 1, At, B1); PG8_BAR;
            PG8_LDA(At, 1, 1); PG8_STAGE(PG8_SA(1, 0), a3, voffA);
            PG8_BAR; PG8_WAIT_L(0); PG8_MMA(1, 0, At, B0); PG8_BAR; PG8_SCHED;
            PG8_STAGE(PG8_SB(1, 1), b3 + hstep, voffB);
            PG8_WAIT_V(6); PG8_BAR; PG8_MMA(1, 1, At, B1); PG8_BAR;
        }
        PG8_STAMP();
        if constexpr (!Epi::AFTER_DRAIN) { E(acc, cur, wr, wc, fr, fq); S.done(cur); }
        PG8_STAMP();
        if (!has_next) break;
#pragma unroll
        for (int a = 0; a < 2; ++a)
#pragma unroll
            for (int b = 0; b < 2; ++b)
#pragma unroll
                for (int m = 0; m < 4; ++m)
#pragma unroll
                    for (int n = 0; n < 2; ++n) acc[a][b][m][n] = (f32x4){0.f, 0.f, 0.f, 0.f};
        cur = nxt; cA = nA; cB = nB; ++ui;
    }
    PG8_WAIT_V(0);
    if (wr == 0) PG8_BAR;
    PG8_BAR;
    if constexpr (Epi::AFTER_DRAIN) { E.fused(acc, cur, wr, wc, fr, fq, lds, wid, lane); S.done(cur); }
    PG8_STAMP();
    if (STAMP && wid == 0) { stamps[lane] = lane < nts ? (((unsigned long long)(unsigned)ts_hi << 32) | (unsigned)ts_lo) : 0ull;
        if (lane == 62) stamps[62] = rt_entry; if (lane == 63) stamps[63] = (unsigned long long)wall_clock64(); }
#undef PG8_STAMP
#undef PG8_SA
#undef PG8_SB
#undef PG8_STAGE
#undef PG8_LDA
#undef PG8_LDB
#undef PG8_MMA
#undef PG8_WAIT_V
#undef PG8_WAIT_L
#undef PG8_BAR
#undef PG8_SCHED
}
}

#define LAS __attribute__((address_space(3)))
#define GAS __attribute__((address_space(1)))
typedef unsigned short bf16_t;
typedef short bf16x8 __attribute__((ext_vector_type(8)));
typedef float f32x4 __attribute__((ext_vector_type(4)));
typedef float f32x2 __attribute__((ext_vector_type(2)));
typedef float f32x16 __attribute__((ext_vector_type(16)));
typedef unsigned u32x4 __attribute__((ext_vector_type(4)));
typedef unsigned u32x2 __attribute__((ext_vector_type(2)));

constexpr int DM = 2048, NBATCH = 4, SEQ = 4096, MROWS = NBATCH * SEQ, NMETA = 16, DIN = 6144, DLRU = 1024, NHEAD = 16;
constexpr int META0 = MROWS;
constexpr int RSTR = MROWS + 64;
constexpr float RMS_EPS = 1e-6f;
constexpr int NPHASE = 8;
#ifndef REP_MASK
#define REP_MASK 0
#endif
constexpr int LDS_BYTES = 131072 + 256;

constexpr size_t MiB = 1u << 20;
constexpr size_t WS_WTIN = 0;
constexpr size_t WS_WTOUT = 48 * MiB;
constexpr size_t WS_GW = 64 * MiB;
constexpr size_t WS_ROWSS = 65 * MiB;
constexpr size_t WS_BAR = 65 * MiB + 512 * 1024;
constexpr size_t WS_AGG = 66 * MiB;
constexpr size_t WS_XB = 71 * MiB;
constexpr size_t WS_Y = 136 * MiB;
constexpr size_t WS_U = 201 * MiB;
constexpr size_t WS_END = 396 * MiB;
constexpr int AGG_PER_LAYER = 257 * 1024;
static_assert(WS_U + (size_t)RSTR * DIN * 2 <= WS_END && WS_Y + (size_t)RSTR * DM * 2 <= WS_U && WS_XB + (size_t)RSTR * DM * 2 <= WS_Y, "ws map");
static_assert(WS_WTIN + (size_t)2 * DIN * DM * 2 <= WS_WTOUT && WS_WTOUT + (size_t)2 * DM * DM * 2 <= WS_GW && WS_AGG + (size_t)2 * AGG_PER_LAYER * 8 <= WS_XB && WS_ROWSS + (size_t)3 * RSTR * 4 <= WS_BAR, "ws map 2");

struct Args { const float* in[14]; float* out; unsigned char* ws; int ph_lo, ph_hi, flags, pad; };

__device__ __forceinline__ unsigned f2bf(float f) { unsigned u = __builtin_bit_cast(unsigned, f); return (u + 0x7fffu + ((u >> 16) & 1u)) >> 16; }
__device__ __forceinline__ unsigned pk2(float lo, float hi) { return f2bf(lo) | (f2bf(hi) << 16); }
__device__ __forceinline__ float bflo(unsigned w) { return __builtin_bit_cast(float, w << 16); }
__device__ __forceinline__ float bfhi(unsigned w) { return __builtin_bit_cast(float, w & 0xffff0000u); }
__device__ __forceinline__ float bf1(bf16_t v) { return __builtin_bit_cast(float, ((unsigned)v) << 16); }
__device__ __forceinline__ float sigmoidf_(float z) { return __builtin_amdgcn_rcpf(1.0f + __expf(-z)); }
__device__ __forceinline__ float wave_sum(float v) {
#pragma unroll
    for (int o = 1; o < 64; o <<= 1) v += __shfl_xor(v, o);
    return v;
}
#define LDS_WAIT() asm volatile("s_waitcnt lgkmcnt(0)" ::: "memory")

struct EpiU {
    static constexpr bool PERM = true, AFTER_DRAIN = false;
    bf16_t* O; const float* rowss;
    __device__ __forceinline__ void operator()(const f32x4 (&acc)[2][2][4][2], const pg8::Unit& u, int wr, int wc, int fr, int fq) const {
        const int row0 = u.pm * 256 + wr * 64 + fr, col0 = u.pn * 256 + wc * 32 + 8 * fq;
#pragma unroll
        for (int ai = 0; ai < 2; ++ai)
#pragma unroll
            for (int m = 0; m < 4; ++m) {
                const int r = row0 + ai * 128 + m * 16;
                const float rs = rsqrtf(rowss[r] * (1.0f / DM) + RMS_EPS);
                bf16_t* rowp = O + (size_t)r * DIN + col0;
#pragma unroll
                for (int bj = 0; bj < 2; ++bj) {
                    const f32x4 v0 = acc[ai][bj][m][0] * rs, v1 = acc[ai][bj][m][1] * rs;
                    u32x4 w; w.x = pg8::cvt_pk_bf16(v0[0], v0[1]); w.y = pg8::cvt_pk_bf16(v0[2], v0[3]); w.z = pg8::cvt_pk_bf16(v1[0], v1[1]); w.w = pg8::cvt_pk_bf16(v1[2], v1[3]);
                    *(u32x4*)(rowp + bj * 128) = w;
                }
            }
    }
};
#ifndef EPI_MB
#define EPI_MB 2
#endif
struct EpiRes {
    static constexpr bool PERM = true, AFTER_DRAIN = false;
    const float* res; float* out; bf16_t* xb; float* rowss;
    __device__ __forceinline__ void operator()(const f32x4 (&acc)[2][2][4][2], const pg8::Unit& u, int wr, int wc, int fr, int fq) const {
        const int row0 = u.pm * 256 + wr * 64 + fr, col0 = u.pn * 256 + wc * 32 + 8 * fq;
#pragma unroll
        for (int ai = 0; ai < 2; ++ai) {
#pragma unroll
          for (int mh = 0; mh < 4; mh += EPI_MB) {
            f32x4 rv[4][2][2];
#pragma unroll
            for (int m = mh; m < mh + EPI_MB; ++m)
#pragma unroll
                for (int bj = 0; bj < 2; ++bj) { const float* p = res + (size_t)(row0 + ai * 128 + m * 16) * DM + col0 + bj * 128; rv[m][bj][0] = *(const f32x4*)p; rv[m][bj][1] = *(const f32x4*)(p + 4); }
            asm volatile("" ::: "memory");
#pragma unroll
            for (int m = mh; m < mh + EPI_MB; ++m) {
                const int r = row0 + ai * 128 + m * 16; const size_t off = (size_t)r * DM + col0; float ss = 0.f;
#pragma unroll
                for (int bj = 0; bj < 2; ++bj) {
                    const f32x4 h0 = rv[m][bj][0] + acc[ai][bj][m][0], h1 = rv[m][bj][1] + acc[ai][bj][m][1];
                    *(f32x4*)(out + off + bj * 128) = h0; *(f32x4*)(out + off + bj * 128 + 4) = h1;
                    if (xb) { u32x4 w; w.x = pg8::cvt_pk_bf16(h0[0], h0[1]); w.y = pg8::cvt_pk_bf16(h0[2], h0[3]); w.z = pg8::cvt_pk_bf16(h1[0], h1[1]); w.w = pg8::cvt_pk_bf16(h1[2], h1[3]);
                        *(u32x4*)(xb + off + bj * 128) = w; }
                    ss += (h0[0] * h0[0] + h0[1] * h0[1]) + (h0[2] * h0[2] + h0[3] * h0[3]) + (h1[0] * h1[0] + h1[1] * h1[1]) + (h1[2] * h1[2] + h1[3] * h1[3]);
                }
                ss += __shfl_xor(ss, 16); ss += __shfl_xor(ss, 32);
                if (fq == 0) unsafeAtomicAdd(rowss + r, ss);
            }
            asm volatile("" ::: "memory");
          }
        }
    }
};

template <class F> __device__ __forceinline__ void meta_gemm(const bf16_t* A, const bf16_t* Bt, int ngroups, LAS unsigned char* lds, int wid, int lane, F epi) {
    const int fr = lane & 15, fq = lane >> 4;
    LAS f32x4* red = (LAS f32x4*)lds;
    for (int g = blockIdx.x; g < ngroups; g += gridDim.x) {
        f32x4 acc = {0.f, 0.f, 0.f, 0.f};
        const bf16_t* ap = A + (size_t)fr * DM + wid * 256 + fq * 8;
        const bf16_t* bp = Bt + (size_t)(g * 16 + fr) * DM + wid * 256 + fq * 8;
#pragma unroll
        for (int s = 0; s < 8; ++s) {
            const bf16x8 a = *(const bf16x8*)(ap + 32 * s), b = *(const bf16x8*)(bp + 32 * s);
            acc = __builtin_amdgcn_mfma_f32_16x16x32_bf16(b, a, acc, 0, 0, 0);
        }
        red[wid * 64 + lane] = acc;
        __syncthreads();
        if (wid == 0) {
            f32x4 s = red[lane];
#pragma unroll
            for (int w = 1; w < 8; ++w) s += red[w * 64 + lane];
            epi(fr, g * 16 + 4 * fq, s);
        }
        __syncthreads();
    }
}

__device__ __forceinline__ void tr_item(const float* W, int K, int N, bf16_t* WT, const float* sc, LAS float* scr, int item, int lane) {
    const int nblk = N / 32, kb = item / nblk, nb = item % nblk, k0 = 64 * kb, n0 = 32 * nb;
#pragma unroll 8
    for (int i = 0; i < 32; ++i) { const int kk = 2 * i + (lane >> 5); float v = W[(size_t)(k0 + kk) * N + n0 + (lane & 31)]; if (sc) v *= sc[k0 + kk]; scr[kk * 33 + (lane & 31)] = v; }
    LDS_WAIT();
    const int c = lane & 7;
#pragma unroll
    for (int j = 0; j < 4; ++j) { const int n = (lane >> 3) + 8 * j; const LAS float* s = scr + (8 * c) * 33 + n;
        u32x4 o; o.x = pk2(s[0 * 33], s[1 * 33]); o.y = pk2(s[2 * 33], s[3 * 33]); o.z = pk2(s[4 * 33], s[5 * 33]); o.w = pk2(s[6 * 33], s[7 * 33]);
        *(u32x4*)(WT + (size_t)(n0 + n) * K + k0 + 8 * c) = o; }
    LDS_WAIT();
}
__device__ __forceinline__ void cvt_row(const float* src, bf16_t* dst, float* ss, int lane) {
    const f32x4* xr = (const f32x4*)src + lane; f32x4 v[8]; float s = 0.f;
#pragma unroll
    for (int j = 0; j < 8; ++j) { v[j] = xr[64 * j]; s += (v[j].x * v[j].x + v[j].y * v[j].y) + (v[j].z * v[j].z + v[j].w * v[j].w); }
    s = wave_sum(s);
    u32x2* o8 = (u32x2*)dst + lane;
#pragma unroll
    for (int j = 0; j < 8; ++j) { u32x2 w; w.x = pk2(v[j].x, v[j].y); w.y = pk2(v[j].z, v[j].w); o8[64 * j] = w; }
    if (lane == 0) *ss = s;
}

struct Mix {
    const float *conv_a_w, *conv_a_b, *lru_br, *lru_bi, *lru_lambda, *conv_b_w;
    const bf16_t* gw;
    bf16_t* U; bf16_t* Y; unsigned long long* AGG;
};
struct ItemId { int hd, b, c, row0, ntok, agg; bool meta; };
__device__ __forceinline__ ItemId decode_item(int id) {
    ItemId I;
    if (id < 16) { I.meta = true; I.hd = id; I.b = 0; I.c = 0; I.row0 = META0; I.ntok = 16; I.agg = 256; }
    else { const int j = id - 16; I.meta = false; I.hd = j & 15; I.c = (j >> 4) & 63; I.b = j >> 10; I.row0 = I.b * SEQ + I.c * 64; I.ntok = 64; I.agg = I.b * 64 + I.c; }
    return I;
}
constexpr int N_ITEMS = 16 + NBATCH * NHEAD * 64;

__device__ __forceinline__ bool agg_ok(unsigned long long v) { return (unsigned)v != 0u; }
__device__ __forceinline__ void mix_item(const Mix& X, int id, LAS unsigned char* xt, int lane) {
    constexpr float LOG2E = 1.4426950408889634f;
    const ItemId I = decode_item(id);
    const int ch = I.hd * 64 + lane;
    const float nls2 = -8.0f * LOG2E * log1pf(__expf(-X.lru_lambda[ch]));
    bf16_t raw[64], rh0 = 0, rh1 = 0, rh2 = 0;
    const float w0 = X.conv_a_w[ch], w1 = X.conv_a_w[1024 + ch], w2 = X.conv_a_w[2048 + ch], w3 = X.conv_a_w[3072 + ch], cb = X.conv_a_b[ch];
    {
        const GAS bf16_t* sb = (const GAS bf16_t*)(X.U + (size_t)I.row0 * DIN + I.hd * 64);
        if (!I.meta) { const GAS bf16_t* hp0 = (I.c == 0) ? (const GAS bf16_t*)(X.U + (size_t)(META0 + 13) * DIN + I.hd * 64) : sb - 3 * DIN; rh0 = hp0[lane]; rh1 = hp0[DIN + lane]; rh2 = hp0[2 * DIN + lane]; }
#pragma unroll
        for (int t = 0; t < 64; ++t) { raw[t] = sb[lane]; if (t < 15 || !I.meta) sb += DIN; asm volatile("" : "+s"(sb)); }
    }
    bf16x8 BfR0[4], BfR1[4], BfI0[4], BfI1[4];
    { const bf16_t* gr = X.gw + (size_t)(I.hd * 64 + (lane & 31)) * 64 + 8 * (lane >> 5); const bf16_t* gi = gr + 16 * 64 * 64;
#pragma unroll
      for (int s = 0; s < 4; ++s) { BfR0[s] = *(const bf16x8*)(gr + 16 * s); BfR1[s] = *(const bf16x8*)(gr + 32 * 64 + 16 * s); BfI0[s] = *(const bf16x8*)(gi + 16 * s); BfI1[s] = *(const bf16x8*)(gi + 32 * 64 + 16 * s); } }
    asm volatile("" ::: "memory");
    float xm3 = bf1(rh0), xm2 = bf1(rh1), xm1 = bf1(rh2);
#pragma unroll
    for (int t = 0; t < 64; ++t) { const float x0 = bf1(raw[t]); const float xc = cb + w0 * xm3 + w1 * xm2 + w2 * xm1 + w3 * x0; xm3 = xm2; xm2 = xm1; xm1 = x0;
        *(LAS bf16_t*)(xt + t * 144 + lane * 2) = (bf16_t)f2bf(xc); }
    const float brA = X.lru_br[I.hd * 64 + (lane & 31)], brB = X.lru_br[I.hd * 64 + 32 + (lane & 31)], biA = X.lru_bi[I.hd * 64 + (lane & 31)], biB = X.lru_bi[I.hd * 64 + 32 + (lane & 31)];
    float h = 0.f, P = 1.f, h15 = 0.f, P15 = 1.f;
    unsigned hp[64];
#pragma unroll
    for (int tb = 0; tb < 2; ++tb) {
        f32x16 aR0, aR1, aI0, aI1;
#pragma unroll
        for (int e = 0; e < 16; ++e) { aR0[e] = brA; aR1[e] = brB; aI0[e] = biA; aI1[e] = biB; }
#pragma unroll
        for (int s = 0; s < 4; ++s) {
            const bf16x8 af = *(const LAS bf16x8*)(xt + (tb * 32 + (lane & 31)) * 144 + (16 * s + 8 * (lane >> 5)) * 2);
            aR0 = __builtin_amdgcn_mfma_f32_32x32x16_bf16(af, BfR0[s], aR0, 0, 0, 0);
            aR1 = __builtin_amdgcn_mfma_f32_32x32x16_bf16(af, BfR1[s], aR1, 0, 0, 0);
            aI0 = __builtin_amdgcn_mfma_f32_32x32x16_bf16(af, BfI0[s], aI0, 0, 0, 0);
            aI1 = __builtin_amdgcn_mfma_f32_32x32x16_bf16(af, BfI1[s], aI1, 0, 0, 0);
        }
#pragma unroll
        for (int q = 0; q < 4; ++q) {
            float Rv[2][4], Iv[2][4];
#pragma unroll
            for (int k = 0; k < 4; ++k) {
                const int reg = 4 * q + k;
                const float r0f = aR0[reg], r1f = aR1[reg], i0f = aI0[reg], i1f = aI1[reg];
                auto r = __builtin_amdgcn_permlane32_swap(__float_as_uint(r0f), __float_as_uint(r1f), false, false);
                Rv[0][k] = __uint_as_float(r[0]); Rv[1][k] = __uint_as_float(r[1]);
                auto i2 = __builtin_amdgcn_permlane32_swap(__float_as_uint(i0f), __float_as_uint(i1f), false, false);
                Iv[0][k] = __uint_as_float(i2[0]); Iv[1][k] = __uint_as_float(i2[1]);
            }
#pragma unroll
            for (int st = 0; st < 2; ++st)
#pragma unroll
                for (int p = 0; p < 2; ++p) {
                    const int t = tb * 32 + 8 * q + 4 * st + 2 * p;
                    f32x2 er = (f32x2){Rv[st][2 * p], Rv[st][2 * p + 1]} * (-LOG2E), ei = (f32x2){Iv[st][2 * p], Iv[st][2 * p + 1]} * (-LOG2E);
                    er.x = __builtin_amdgcn_exp2f(er.x); er.y = __builtin_amdgcn_exp2f(er.y); ei.x = __builtin_amdgcn_exp2f(ei.x); ei.y = __builtin_amdgcn_exp2f(ei.y);
                    er = er + 1.0f; ei = ei + 1.0f;
                    f32x2 rg, ig; rg.x = __builtin_amdgcn_rcpf(er.x); rg.y = __builtin_amdgcn_rcpf(er.y); ig.x = __builtin_amdgcn_rcpf(ei.x); ig.y = __builtin_amdgcn_rcpf(ei.y);
                    const f32x2 l2 = rg * nls2;
                    f32x2 a; a.x = __builtin_amdgcn_exp2f(l2.x); a.y = __builtin_amdgcn_exp2f(l2.y);
                    f32x2 om = 1.0f - a * a; om.x = fmaxf(om.x, 0.f); om.y = fmaxf(om.y, 0.f);
                    f32x2 mu; mu.x = __builtin_amdgcn_sqrtf(om.x); mu.y = __builtin_amdgcn_sqrtf(om.y);
                    const f32x2 xc = (f32x2){bf1(*(const LAS bf16_t*)(xt + t * 144 + lane * 2)), bf1(*(const LAS bf16_t*)(xt + (t + 1) * 144 + lane * 2))};
                    const f32x2 bb = mu * ig * xc;
                    h = a.x * h + bb.x; P = P * a.x; hp[t] = pg8::cvt_pk_bf16(h, P);
                    h = a.y * h + bb.y; P = P * a.y; hp[t + 1] = pg8::cvt_pk_bf16(h, P);
                    if (t + 1 == 15) { h15 = h; P15 = P; }
                }
        }
    }
    if (I.meta) { h = h15; P = P15; }
    __hip_atomic_store(X.AGG + (size_t)I.agg * 1024 + ch, ((unsigned long long)__float_as_uint(h) << 32) | (unsigned long long)__float_as_uint(P), __ATOMIC_RELAXED, __HIP_MEMORY_SCOPE_AGENT);
    asm volatile("" ::: "memory");
    bf16_t graw[64];
    { const GAS bf16_t* sb = (const GAS bf16_t*)(X.U + (size_t)I.row0 * DIN + 1024 + I.hd * 64);
#pragma unroll
      for (int t = 0; t < 64; ++t) { graw[t] = sb[lane]; if (t < 15 || !I.meta) sb += DIN; asm volatile("" : "+s"(sb)); } }
    float hin = 0.f;
    if (!I.meta) {
        { const unsigned long long* mp = X.AGG + (size_t)256 * 1024 + ch; unsigned long long v;
          for (;;) { v = __hip_atomic_load(mp, __ATOMIC_RELAXED, __HIP_MEMORY_SCOPE_AGENT); if (!__any(!agg_ok(v))) break; __builtin_amdgcn_s_sleep(2); }
          hin = __uint_as_float((unsigned)(v >> 32)); }
        const unsigned long long* ap = X.AGG + (size_t)(I.b * 64) * 1024 + ch;
        for (int j0 = 0; j0 < I.c; j0 += 16) {
            unsigned long long v[16];
            for (;;) {
                bool bad = false;
#pragma unroll
                for (int k = 0; k < 16; ++k) { v[k] = (j0 + k < I.c) ? __hip_atomic_load(ap + (size_t)(j0 + k) * 1024, __ATOMIC_RELAXED, __HIP_MEMORY_SCOPE_AGENT) : 0x000000003f800000ull; }
#pragma unroll
                for (int k = 0; k < 16; ++k) bad |= !agg_ok(v[k]);
                if (!__any(bad)) break;
                __builtin_amdgcn_s_sleep(2);
            }
#pragma unroll
            for (int k = 0; k < 16; ++k) hin = __uint_as_float((unsigned)v[k]) * hin + __uint_as_float((unsigned)(v[k] >> 32));
        }
    }
    asm volatile("" ::: "memory");
    GAS bf16_t* yp = (GAS bf16_t*)(X.Y + (size_t)I.row0 * DM + I.hd * 64);
#pragma unroll
    for (int t0 = 0; t0 < 64; t0 += 16) {
        if (t0 < I.ntok) {
#pragma unroll
            for (int k = 0; k < 16; k += 2) {
                const unsigned w0 = hp[t0 + k], w1 = hp[t0 + k + 1];
                const f32x2 gg = (f32x2){bf1(graw[t0 + k]), bf1(graw[t0 + k + 1])};
                f32x2 e = gg * (-LOG2E); e.x = __builtin_amdgcn_exp2f(e.x); e.y = __builtin_amdgcn_exp2f(e.y); e = e + 1.0f;
                f32x2 sg; sg.x = __builtin_amdgcn_rcpf(e.x); sg.y = __builtin_amdgcn_rcpf(e.y);
                const f32x2 hv = (f32x2){bflo(w0), bflo(w1)} + (f32x2){bfhi(w0), bfhi(w1)} * hin;
                const f32x2 y = hv * gg * sg;
                const unsigned pk = pg8::cvt_pk_bf16(y.x, y.y);
                yp[lane] = (bf16_t)(pk & 0xffffu); yp[DM + lane] = (bf16_t)(pk >> 16); yp += 2 * DM; asm volatile("" : "+s"(yp));
            }
        }
    }
}

__device__ __forceinline__ void ld8(const bf16_t* p, float (&o)[8]) {
    const u32x4 w = *(const u32x4*)p;
    o[0] = bflo(w.x); o[1] = bfhi(w.x); o[2] = bflo(w.y); o[3] = bfhi(w.y); o[4] = bflo(w.z); o[5] = bfhi(w.z); o[6] = bflo(w.w); o[7] = bfhi(w.w);
}
__device__ __forceinline__ void partb(const Mix& X, int tid) {
    for (int it = blockIdx.x * 512 + tid; it < 1025 * 128; it += gridDim.x * 512) {
        const int c0 = (it & 127) * 8, run = it >> 7;
        int row0, hrow = -1;
        if (run == 1024) row0 = META0; else { row0 = run * 16; hrow = ((row0 & (SEQ - 1)) == 0) ? META0 + 14 : row0 - 2; }
        float w0[8], w1[8], w2[8], cm2[8], cm1[8];
        { const f32x4* p = (const f32x4*)(X.conv_b_w + c0); const f32x4 a0 = p[0], a1 = p[1], b0 = p[256], b1 = p[257], d0 = p[512], d1 = p[513];
#pragma unroll
          for (int e = 0; e < 4; ++e) { w0[e] = a0[e]; w0[4 + e] = a1[e]; w1[e] = b0[e]; w1[4 + e] = b1[e]; w2[e] = d0[e]; w2[4 + e] = d1[e]; } }
        if (hrow >= 0) {
            float c[8], x[8];
            ld8(X.U + (size_t)hrow * DIN + 3072 + c0, c); ld8(X.U + (size_t)hrow * DIN + 4096 + c0, x);
#pragma unroll
            for (int e = 0; e < 8; ++e) cm2[e] = c[e] * x[e];
            ld8(X.U + (size_t)(hrow + 1) * DIN + 3072 + c0, c); ld8(X.U + (size_t)(hrow + 1) * DIN + 4096 + c0, x);
#pragma unroll
            for (int e = 0; e < 8; ++e) cm1[e] = c[e] * x[e];
        } else {
#pragma unroll
            for (int e = 0; e < 8; ++e) { cm2[e] = 0.f; cm1[e] = 0.f; }
        }
        const bf16_t* up = X.U + (size_t)row0 * DIN + c0;
        bf16_t* yp = X.Y + (size_t)row0 * DM + 1024 + c0;
#pragma unroll 4
        for (int t = 0; t < 16; ++t) {
            float bv[8], cv[8], xv[8], gv[8];
            ld8(up + (size_t)t * DIN + 2048, bv); ld8(up + (size_t)t * DIN + 3072, cv); ld8(up + (size_t)t * DIN + 4096, xv); ld8(up + (size_t)t * DIN + 5120, gv);
            float o[8];
#pragma unroll
            for (int e = 0; e < 8; ++e) { const float cx = cv[e] * xv[e]; const float y = w0[e] * cm2[e] + w1[e] * cm1[e] + w2[e] * cx; o[e] = bv[e] * y * (gv[e] * sigmoidf_(gv[e])); cm2[e] = cm1[e]; cm1[e] = cx; }
            u32x4 w; w.x = pk2(o[0], o[1]); w.y = pk2(o[2], o[3]); w.z = pk2(o[4], o[5]); w.w = pk2(o[6], o[7]);
            *(u32x4*)(yp + (size_t)t * DM) = w;
        }
    }
}


#ifdef DEBUG_NAIVE_MIX
__global__ void __launch_bounds__(64) naive_mixA(Mix X, const float* wr, const float* wi) {
    const int b = blockIdx.x / 16, hd = blockIdx.x % 16, lane = threadIdx.x, ch = hd * 64 + lane;
    __shared__ float xs[64];
    const float w0 = X.conv_a_w[ch], w1 = X.conv_a_w[1024 + ch], w2 = X.conv_a_w[2048 + ch], w3 = X.conv_a_w[3072 + ch], cb = X.conv_a_b[ch];
    const float br = X.lru_br[ch], bi = X.lru_bi[ch];
    const float sp = log1pf(expf(-X.lru_lambda[ch]));
    const float* wrh = wr + (size_t)hd * 4096 + lane; const float* wih = wi + (size_t)hd * 4096 + lane;
    float h = 0.f, xm3 = 0.f, xm2 = 0.f, xm1 = 0.f;
    for (int p = 0; p < NMETA + SEQ; ++p) {
        const int row = p < NMETA ? META0 + p : b * SEQ + (p - NMETA);
        const float x0 = bf1(X.U[(size_t)row * DIN + ch]);
        const float xc = cb + w0 * xm3 + w1 * xm2 + w2 * xm1 + w3 * x0; xm3 = xm2; xm2 = xm1; xm1 = x0;
        xs[lane] = xc; __syncthreads();
        float rp = br, ip = bi;
#pragma unroll 4
        for (int i = 0; i < 64; ++i) { rp += xs[i] * wrh[i * 64]; ip += xs[i] * wih[i * 64]; }
        __syncthreads();
        const float r = 1.f / (1.f + expf(-rp)), ig = 1.f / (1.f + expf(-ip));
        const float la = -8.f * r * sp; const float a = expf(la); const float bb = sqrtf(-expm1f(2.f * la)) * (ig * xc);
        h = a * h + bb;
        const float g = bf1(X.U[(size_t)row * DIN + 1024 + ch]);
        const float y = h * g / (1.f + expf(-g));
        if (p >= NMETA || b == 0) X.Y[(size_t)row * DM + ch] = (bf16_t)f2bf(y);
    }
}
__global__ void naive_mixB(Mix X) {
    for (size_t idx = (size_t)blockIdx.x * blockDim.x + threadIdx.x; idx < (size_t)(MROWS + NMETA) * 1024; idx += (size_t)gridDim.x * blockDim.x) {
        const int row = (int)(idx >> 10), c = (int)(idx & 1023);
        int r1, r2;
        if (row >= META0) { const int p = row - META0; r1 = p >= 1 ? row - 1 : -1; r2 = p >= 2 ? row - 2 : -1; }
        else { const int t = row & (SEQ - 1); r1 = t >= 1 ? row - 1 : META0 + 15; r2 = t >= 2 ? row - 2 : META0 + 14 + t; }
        auto cx = [&](int r) -> float { return r < 0 ? 0.f : bf1(X.U[(size_t)r * DIN + 3072 + c]) * bf1(X.U[(size_t)r * DIN + 4096 + c]); };
        const float y = X.conv_b_w[c] * cx(r2) + X.conv_b_w[1024 + c] * cx(r1) + X.conv_b_w[2048 + c] * cx(row);
        const float bv = bf1(X.U[(size_t)row * DIN + 2048 + c]), g = bf1(X.U[(size_t)row * DIN + 5120 + c]);
        X.Y[(size_t)row * DM + 1024 + c] = (bf16_t)f2bf(bv * y * g / (1.f + expf(-g)));
    }
}
#endif
#define XB_TMO      128
#define XB_XCNT(j)  (256  + 64 * (j))
#define XB_XSUB(j)  (1280 + 64 * (j))
#define XB_XGEN(j)  (2304 + 64 * (j))
#define XB_TOP      3328
#define XB_TOPGEN   3392
#define XCD_BAR_WORDS 3456
#define XB_SPIN_CAP (1u << 18)

__device__ __forceinline__ unsigned xb_ld(unsigned* p)              { return __hip_atomic_load(p, __ATOMIC_RELAXED, __HIP_MEMORY_SCOPE_AGENT); }
__device__ __forceinline__ unsigned xb_add(unsigned* p, unsigned v) { return __hip_atomic_fetch_add(p, v, __ATOMIC_RELAXED, __HIP_MEMORY_SCOPE_AGENT); }
__device__ __forceinline__ unsigned xb_xcc_id() { return (unsigned)__builtin_amdgcn_s_getreg((3 << 11) | 20) & 0xFu; }
#define XB_SPIN(cond, bar) do { unsigned _sp = 0; while (cond) { __builtin_amdgcn_s_sleep(1); \
    if ((++_sp & 255u) == 0u) { if (xb_ld(&(bar)[XB_TMO])) break; if (_sp > XB_SPIN_CAP) { atomicAdd(&(bar)[XB_TMO], 1u); break; } } } } while (0)

struct XcdBarrier {
    unsigned* bar; unsigned x;
    volatile LAS unsigned* st;
};

__device__ __forceinline__ XcdBarrier xcd_barrier_post(unsigned* bar, volatile LAS unsigned* st) {
    XcdBarrier b; b.bar = bar; b.x = xb_xcc_id(); b.st = st;
    if (threadIdx.x == 0) (void)xb_add(&bar[XB_XCNT(b.x)], 1u);
    return b;
}
__device__ __forceinline__ void xcd_barrier_complete(unsigned* bar, unsigned x, unsigned& nloc, unsigned& nx) {
    const unsigned G = gridDim.x * gridDim.y * gridDim.z;
    unsigned sum, cnt, mine, sp = 0u;
    for (;;) {
        sum = 0u; cnt = 0u; mine = 0u;
#pragma unroll
        for (unsigned j = 0; j < 16; ++j) { const unsigned c = xb_ld(&bar[XB_XCNT(j)]); sum += c; cnt += (c > 0u) ? 1u : 0u; mine = (j == x) ? c : mine; }
        if (sum == G) break;
        __builtin_amdgcn_s_sleep(1);
        if ((++sp & 255u) == 0u) { if (xb_ld(&bar[XB_TMO])) break; if (sp > XB_SPIN_CAP) { atomicAdd(&bar[XB_TMO], 1u); break; } }
    }
    nloc = mine > 0u ? mine : 1u; nx = cnt > 0u ? cnt : 1u;
}

__device__ __forceinline__ void xcd_barrier(const XcdBarrier& b) {
    asm volatile("s_waitcnt vmcnt(0)" ::: "memory");
    __syncthreads();
    if (threadIdx.x == 0) {
        unsigned* bar = b.bar;
        __builtin_amdgcn_s_waitcnt(0);
        unsigned nloc = b.st[0], nx = b.st[1];
        if (nloc == 0u) { xcd_barrier_complete(bar, b.x, nloc, nx); b.st[0] = nloc; b.st[1] = nx; }
        const unsigned old = xb_add(&bar[XB_XSUB(b.x)], 1u);
        const unsigned gen = old / nloc;
        if (old + 1u == (gen + 1u) * nloc) {
            __builtin_amdgcn_fence(__ATOMIC_RELEASE, "agent");
            asm volatile("s_waitcnt vmcnt(0)" ::: "memory");
            const unsigned og = xb_add(&bar[XB_TOP], 1u);
            const unsigned tg = og / nx;
            if (og + 1u == (tg + 1u) * nx) xb_add(&bar[XB_TOPGEN], 1u);
            else XB_SPIN(xb_ld(&bar[XB_TOPGEN]) == tg, bar);
            __builtin_amdgcn_fence(__ATOMIC_ACQUIRE, "agent");
            xb_add(&bar[XB_XGEN(b.x)], 1u);
            asm volatile("s_waitcnt vmcnt(0)" ::: "memory");
        } else {
            XB_SPIN(xb_ld(&bar[XB_XGEN(b.x)]) == gen, bar);
            __builtin_amdgcn_fence(__ATOMIC_ACQUIRE, "agent");
            asm volatile("s_waitcnt vmcnt(0)" ::: "memory");
        }
    }
    __syncthreads();
}

__global__ void __launch_bounds__(512, 2) hymba_fwd(Args a) {
    extern __shared__ __attribute__((aligned(16))) unsigned char lds_raw[];
    LAS unsigned char* lds = (LAS unsigned char*)lds_raw;
    cg::grid_group grid = cg::this_grid();
    const int NGW = gridDim.x * 8;
    if (threadIdx.x < 64) ((LAS unsigned*)(lds + 131072))[threadIdx.x] = 0u;
    __syncthreads();
    XcdBarrier xbar; xbar.bar = (unsigned*)(a.ws + WS_BAR); xbar.x = 0; xbar.st = nullptr;
    if (a.ph_hi - a.ph_lo > 1) xbar = xcd_barrier_post((unsigned*)(a.ws + WS_BAR), (volatile LAS unsigned*)(lds + 131072));
    if (a.ph_lo < 0) grid.sync();
#define LAUNDER() int tid = threadIdx.x; asm volatile("" : "+v"(tid)); const int wid = __builtin_amdgcn_readfirstlane(tid >> 6), lane = tid & 63, gw = blockIdx.x * 8 + wid
    const int lo = a.ph_lo, hi = a.ph_hi;
#define IN(k) (lo <= (k) && (k) < hi)
#define SEAM(k) do { if (IN(k) && IN((k) + 1)) { xcd_barrier(xbar); if ((REP_MASK >> 10) & 1) { xcd_barrier(xbar); xcd_barrier(xbar); } } } while (0)
    const float* x = a.in[0]; const float* meta = a.in[1]; const float* norm_g = a.in[2]; const float* w_in = a.in[3];
    const float* conv_a_w = a.in[4]; const float* conv_a_b = a.in[5]; const float* lru_wr = a.in[6]; const float* lru_br = a.in[7];
    const float* lru_wi = a.in[8]; const float* lru_bi = a.in[9]; const float* lru_lambda = a.in[10]; const float* conv_b_w = a.in[11];
    const float* w_out = a.in[12]; const float* final_g = a.in[13];
    unsigned char* ws = a.ws;
    bf16_t* WTIN = (bf16_t*)(ws + WS_WTIN); bf16_t* WTOUT = (bf16_t*)(ws + WS_WTOUT); bf16_t* GW = (bf16_t*)(ws + WS_GW);
    float* ROWSS = (float*)(ws + WS_ROWSS); unsigned long long* AGG = (unsigned long long*)(ws + WS_AGG);
    bf16_t* XB = (bf16_t*)(ws + WS_XB); bf16_t* Y = (bf16_t*)(ws + WS_Y); bf16_t* U = (bf16_t*)(ws + WS_U);

    if (IN(0)) for (int rep = 0; rep <= ((REP_MASK >> 0) & 1); ++rep) {
        LAUNDER();
        LAS float* scr = (LAS float*)(lds + wid * 16384);
        constexpr int I_IN = (DM / 64) * (DIN / 32), I_OUT = (DM / 64) * (DM / 32), I_G = 2;
        constexpr int NIT = 2 * I_IN + 2 * I_OUT + 64 * I_G;
        for (int it = gw; it < NIT; it += NGW) {
            int r = it;
            if (r < 2 * I_IN) { const int l = r / I_IN; tr_item(w_in + (size_t)l * DM * DIN, DM, DIN, WTIN + (size_t)l * DIN * DM, norm_g + l * DM, scr, r % I_IN, lane); continue; } r -= 2 * I_IN;
            if (r < 2 * I_OUT) { const int l = r / I_OUT; tr_item(w_out + (size_t)l * DM * DM, DM, DM, WTOUT + (size_t)l * DM * DM, nullptr, scr, r % I_OUT, lane); continue; } r -= 2 * I_OUT;
            { const int mtx = r >> 1, l = mtx >> 5, g = (mtx >> 4) & 1, hd = mtx & 15;
              const float* src = (g ? lru_wi : lru_wr) + (size_t)(l * 16 + hd) * 4096;
              tr_item(src, 64, 64, GW + (size_t)mtx * 4096, nullptr, scr, r & 1, lane); }
        }
        for (int m = gw; m < MROWS + NMETA; m += NGW) {
            const float* src = m < MROWS ? x + (size_t)m * DM : meta + (size_t)(m - MROWS) * DM;
            cvt_row(src, XB + (size_t)m * DM, ROWSS + m, lane);
        }
        for (int i = blockIdx.x * 512 + tid; i < 2 * RSTR; i += gridDim.x * 512) ROWSS[RSTR + i] = 0.f;
        for (int i = blockIdx.x * 512 + tid; i < AGG_PER_LAYER; i += gridDim.x * 512) ((u32x4*)AGG)[i] = (u32x4){0u, 0u, 0u, 0u};
    }
    SEAM(0);

#pragma unroll 1
    for (int l = 0; l < 2; ++l) {
        const int pb = 1 + 3 * l;
        const bf16_t* wtin = WTIN + (size_t)l * DIN * DM; const bf16_t* wtout = WTOUT + (size_t)l * DM * DM;
        float* rss_in = ROWSS + (size_t)l * RSTR; float* rss_out = ROWSS + (size_t)(l + 1) * RSTR;
        Mix X; X.conv_a_w = conv_a_w + l * 4 * DLRU; X.conv_a_b = conv_a_b + l * DLRU; X.lru_br = lru_br + l * DLRU; X.lru_bi = lru_bi + l * DLRU; X.lru_lambda = lru_lambda + l * DLRU;
        X.conv_b_w = conv_b_w + l * 3 * DLRU; X.gw = GW + (size_t)l * 2 * 16 * 4096; X.U = U; X.Y = Y; X.AGG = AGG + (size_t)l * AGG_PER_LAYER;

        if (IN(pb)) for (int rep = 0; rep <= ((REP_MASK >> pb) & 1); ++rep) {
            LAUNDER();
            meta_gemm(XB + (size_t)META0 * DM, wtin, DIN / 16, lds, wid, lane, [&](int m, int n0, f32x4 s) {
                const float rs = rsqrtf(rss_in[META0 + m] * (1.0f / DM) + RMS_EPS);
                u32x2 w; w.x = pk2(s[0] * rs, s[1] * rs); w.y = pk2(s[2] * rs, s[3] * rs);
                *(u32x2*)(U + (size_t)(META0 + m) * DIN + n0) = w; });
            pg8::Gemm g{XB, wtin, MROWS, DIN, DM}; pg8::StaticOrder S; S.init(MROWS, DIN, (int)gridDim.x, (int)blockIdx.x);
            EpiU E{U, rss_in};
            pg8::gemm_phase<EpiU, pg8::StaticOrder, false>(lds, g, S, E, nullptr);
        }
        SEAM(pb);
        if (IN(pb + 1)) for (int rep = 0; rep <= ((REP_MASK >> (pb + 1)) & 1); ++rep) {
            LAUNDER();
#pragma unroll 1
            for (int step = 0; step < 2; ++step) {
                if ((step == 0) == (wid < 4)) {
                    if (rep == 1 && ((REP_MASK >> 13) & 1)) continue;
#pragma unroll 1
                    for (int id = gw; id < N_ITEMS; id += NGW) mix_item(X, id, lds + wid * 9216, lane);
                } else { if (rep == 1 && ((REP_MASK >> 12) & 1)) continue; partb(X, tid); }
            }
        }
        SEAM(pb + 1);
        if (IN(pb + 2)) {
            LAUNDER();
            if (l == 0) {
                meta_gemm(Y + (size_t)META0 * DM, wtout, DM / 16, lds, wid, lane, [&](int m, int n0, f32x4 s) {
                    const f32x4 r = *(const f32x4*)(meta + (size_t)m * DM + n0); const f32x4 hh = r + s;
                    u32x2 w; w.x = pk2(hh[0], hh[1]); w.y = pk2(hh[2], hh[3]);
                    *(u32x2*)(XB + (size_t)(META0 + m) * DM + n0) = w;
                    unsafeAtomicAdd(rss_out + META0 + m, (hh[0] * hh[0] + hh[1] * hh[1]) + (hh[2] * hh[2] + hh[3] * hh[3])); });
            }
            pg8::Gemm g{Y, wtout, MROWS, DM, DM}; pg8::StaticOrder S; S.init(MROWS, DM, (int)gridDim.x, (int)blockIdx.x);
            if ((REP_MASK >> 11) & 1) { EpiU Ed{U, rss_in}; pg8::gemm_phase<EpiU, pg8::StaticOrder, false>(lds, g, S, Ed, nullptr); }
            EpiRes E{l == 0 ? x : a.out, a.out, l == 0 ? XB : nullptr, rss_out};
            pg8::gemm_phase<EpiRes, pg8::StaticOrder, false>(lds, g, S, E, nullptr);
        }
        SEAM(pb + 2);
    }

    if (IN(7)) {
        LAUNDER();
        const float* rss = ROWSS + (size_t)2 * RSTR;
        for (int m = gw; m < MROWS; m += NGW) {
            const float rs = rsqrtf(rss[m] * (1.0f / DM) + RMS_EPS);
            f32x4* p = (f32x4*)(a.out + (size_t)m * DM) + lane; const f32x4* gp = (const f32x4*)final_g + lane;
            f32x4 v[8];
#pragma unroll
            for (int j = 0; j < 8; ++j) v[j] = p[64 * j];
#pragma unroll
            for (int j = 0; j < 8; ++j) p[64 * j] = v[j] * rs * gp[64 * j];
        }
    }
#undef IN
#undef SEAM
}

#ifndef MK_LAUNCH_PER_PHASE
#define MK_LAUNCH_PER_PHASE 0
#endif
extern "C" void kernel_launch(void* const* d_in, const int* in_sizes, int n_in, void* d_out, int out_size, void* d_ws, size_t ws_size, hipStream_t stream) {
    static int grid = 0;
    if (grid == 0) {
        if (n_in != 14 || in_sizes[0] != MROWS * DM || out_size != MROWS * DM || ws_size < WS_END) { fprintf(stderr, "kernel_launch: unexpected shapes (n_in %d, in0 %d, out %d, ws %zu)\n", n_in, n_in > 0 ? in_sizes[0] : -1, out_size, ws_size); grid = -1; return; }
        int dev = 0, cus = 0, per_cu = 0;
        hipGetDevice(&dev); hipDeviceGetAttribute(&cus, hipDeviceAttributeMultiprocessorCount, dev);
        if (hipFuncSetAttribute((const void*)hymba_fwd, hipFuncAttributeMaxDynamicSharedMemorySize, LDS_BYTES) != hipSuccess) { fprintf(stderr, "kernel_launch: hipFuncSetAttribute failed\n"); grid = -1; return; }
        if (hipOccupancyMaxActiveBlocksPerMultiprocessor(&per_cu, (const void*)hymba_fwd, 512, LDS_BYTES) != hipSuccess || per_cu < 1) { fprintf(stderr, "kernel_launch: occupancy query gave %d\n", per_cu); per_cu = 1; }
        (void)hipGetLastError();
        grid = cus * per_cu;
    }
    if (grid < 0) return;
    Args a{};
    for (int i = 0; i < 14; ++i) a.in[i] = (const float*)d_in[i];
    a.out = (float*)d_out; a.ws = (unsigned char*)d_ws;
#if MK_LAUNCH_PER_PHASE
    for (int p = 0; p < NPHASE; ++p) {
#ifdef DEBUG_NAIVE_MIX
        if (p == 2 || p == 6) { const int l = p / 4; unsigned char* ws = (unsigned char*)d_ws;
            Mix X; X.conv_a_w = a.in[4] + l * 4 * DLRU; X.conv_a_b = a.in[5] + l * DLRU; X.lru_br = a.in[7] + l * DLRU; X.lru_bi = a.in[9] + l * DLRU; X.lru_lambda = a.in[10] + l * DLRU;
            X.conv_b_w = a.in[11] + l * 3 * DLRU; X.gw = nullptr; X.U = (bf16_t*)(ws + WS_U); X.Y = (bf16_t*)(ws + WS_Y); X.HP = nullptr; X.AGG = nullptr;
#if DEBUG_NAIVE_MIX == 1
            hipLaunchKernelGGL(naive_mixA, dim3(64), dim3(64), 0, stream, X, a.in[6] + (size_t)l * 16 * 4096, a.in[8] + (size_t)l * 16 * 4096);
            a.flags = 1;
#else
            hipLaunchKernelGGL(naive_mixB, dim3(2048), dim3(256), 0, stream, X);
            a.flags = 2;
#endif
            }
        else a.flags = 0;
#if DEBUG_NAIVE_MIX == 1
        if (p == 3 || p == 7) continue;
#endif
#endif
        a.ph_lo = p; a.ph_hi = p + 1; hipLaunchKernelGGL(hymba_fwd, dim3(grid), dim3(512), LDS_BYTES, stream, a); }
#else
    a.ph_lo = 0; a.ph_hi = NPHASE;
    if (hipMemsetAsync((unsigned char*)d_ws + WS_BAR, 0, XCD_BAR_WORDS * 4, stream) != hipSuccess) { fprintf(stderr, "kernel_launch: memset of barrier words failed\n"); return; }
    void* args[] = {&a};
    const hipError_t e = hipLaunchCooperativeKernel((const void*)hymba_fwd, dim3(grid), dim3(512), args, LDS_BYTES, stream);
    if (e != hipSuccess) fprintf(stderr, "kernel_launch: cooperative launch failed: %s (grid %d)\n", hipGetErrorString(e), grid);
#endif
}
```

```cpp
#include <hip/hip_runtime.h>
#include <hip/hip_cooperative_groups.h>
#include <cstdio>
namespace cg = cooperative_groups;
namespace pg8 {
#define PG8_LAS __attribute__((address_space(3)))
typedef unsigned short bf16_t;
typedef short bf16x8 __attribute__((ext_vector_type(8)));
typedef float f32x4 __attribute__((ext_vector_type(4)));
typedef unsigned u32x4 __attribute__((ext_vector_type(4)));
constexpr int BM = 256, BK = 64, HALF = 128, HTB = HALF * BK * 2  , STAGE_BYTES = 8 * HTB, NXCD = 8, WGM = 8;

__host__ __device__ __forceinline__ int lds_byte(int r, int c) { const int st = (r >> 4) * 2 + (c >> 5), rr = r & 15, cc = c & 31, ob = rr * 64 + cc * 2; return st * 1024 + (ob ^ (((ob >> 9) & 1) << 5)); }
__host__ __device__ __forceinline__ void stage_rc(int b, int& R, int& C) { const int st = b / 1024, sb = b % 1024, swz = sb ^ (((sb >> 9) & 1) << 5); R = (st >> 1) * 16 + swz / 64; C = (st & 1) * 32 + (swz % 64) / 2; }
__host__ __device__ __forceinline__ int perm32(int rho) { const int n = rho >> 4, i = rho & 15; return 8 * (i >> 2) + 4 * n + (i & 3); }

struct Unit { int pm, pn; };
struct Gemm { const bf16_t* A; const bf16_t* Bt; int M, N, K; };

struct StaticOrder {
    int nM, nN, nwg, G, c;
    __host__ __device__ void init(int M, int N, int G_, int c_) { nM = M / BM; nN = N / BM; nwg = nM * nN; G = G_; c = c_; }
    __host__ __device__ bool next(int i, Unit& u) const {
        const long L = (long)i * G + c; if (L >= nwg) return false;
        int wgid = (int)L; { const int q = nwg / NXCD, r = nwg % NXCD, xcd = wgid % NXCD, off = wgid / NXCD; wgid = (xcd < r ? xcd * (q + 1) : r * (q + 1) + (xcd - r) * q) + off; }
        const int nig = WGM * nN, gid = wgid / nig, fm = gid * WGM, gsz = (nM - fm) < WGM ? (nM - fm) : WGM;
        u.pm = fm + ((wgid % nig) % gsz); u.pn = (wgid % nig) / gsz; return true;
    }
    __device__ __forceinline__ void a_ready(const Unit&) const {}
    __device__ __forceinline__ void done(const Unit&) const {}
};
__device__ __forceinline__ unsigned cvt_pk_bf16(float lo, float hi) { unsigned r; asm volatile("v_cvt_pk_bf16_f32 %0, %1, %2" : "=v"(r) : "v"(lo), "v"(hi)); return r; }
template <class Epi, class Sched, bool STAMP = false>
__device__ __forceinline__ void gemm_phase(PG8_LAS unsigned char* lds, const Gemm g, const Sched& S, const Epi& E, unsigned long long* stamps) {
    int tid_l = threadIdx.x; asm volatile("" : "+v"(tid_l));
    const int tid = tid_l, wid = __builtin_amdgcn_readfirstlane(tid >> 6), lane = tid & 63, wr = wid >> 2, wc = wid & 3, fr = lane & 15, fq = lane >> 4;
    const int K = g.K, nt = K / BK;
    int ts_lo = 0, ts_hi = 0, nts = 0; const unsigned long long rt_entry = STAMP ? (unsigned long long)wall_clock64() : 0ull;
#define PG8_STAMP() do { if (STAMP && wid == 0 && nts < 64) { const unsigned long long _c = (unsigned long long)clock64(); \
        ts_lo = (lane == nts) ? (int)(unsigned)_c : ts_lo; ts_hi = (lane == nts) ? (int)(unsigned)(_c >> 32) : ts_hi; ++nts; } } while (0)
    PG8_STAMP();
    unsigned voffA[2], voffB[2];
#pragma unroll
    for (int i = 0; i < 2; ++i) { int R, C; stage_rc(tid * 16 + i * 8192, R, C); const int Rb = Epi::PERM ? ((R & ~31) + perm32(R & 31)) : R;
        voffA[i] = (unsigned)(R * K + C) * 2u; voffB[i] = (unsigned)(Rb * K + C) * 2u; }
    const size_t kstep = (size_t)(BK * 2);
    const size_t hstep = (size_t)HALF * K * 2;
    const size_t tstep = 2 * hstep;
    const unsigned ldsw = (unsigned)wid * 1024u;
    const int aoff = lds_byte(wr * 64 + fr, fq * 8), boff = lds_byte(wc * 32 + fr, fq * 8);
#define PG8_SA(b, h) (((b) * 2 + (h)) * HTB)
#define PG8_SB(b, h) ((4 + (b) * 2 + (h)) * HTB)
#define PG8_STAGE(bufoff, gbase, voff) do { _Pragma("unroll") for (int _i = 0; _i < 2; ++_i) \
        __builtin_amdgcn_global_load_lds((const unsigned*)((const char*)(gbase) + (voff)[_i]), (PG8_LAS unsigned*)(lds + (bufoff) + ldsw + _i * 8192), 16, 0, 0); } while (0)
#define PG8_LDA(dst, b, h) do { _Pragma("unroll") for (int m = 0; m < 4; ++m) _Pragma("unroll") for (int k = 0; k < 2; ++k) dst[m][k] = *(const PG8_LAS bf16x8*)(lds + PG8_SA(b, h) + aoff + m * 2048 + k * 1024); } while (0)
#define PG8_LDB(dst, b, h) do { _Pragma("unroll") for (int n = 0; n < 2; ++n) _Pragma("unroll") for (int k = 0; k < 2; ++k) dst[n][k] = *(const PG8_LAS bf16x8*)(lds + PG8_SB(b, h) + boff + n * 2048 + k * 1024); } while (0)
#define PG8_MMA(ai, bj, At, Bt) do { __builtin_amdgcn_s_setprio(1); _Pragma("unroll") for (int m = 0; m < 4; ++m) _Pragma("unroll") for (int n = 0; n < 2; ++n) _Pragma("unroll") for (int k = 0; k < 2; ++k) \
        acc[ai][bj][m][n] = __builtin_amdgcn_mfma_f32_16x16x32_bf16(Bt[n][k], At[m][k], acc[ai][bj][m][n], 0, 0, 0); __builtin_amdgcn_s_setprio(0); } while (0)
#define PG8_WAIT_V(n) asm volatile("s_waitcnt vmcnt(" #n ")" ::: "memory")
#define PG8_WAIT_L(n) asm volatile("s_waitcnt lgkmcnt(" #n ")" ::: "memory")
#define PG8_BAR __builtin_amdgcn_s_barrier()
#define PG8_SCHED __builtin_amdgcn_sched_barrier(0)
    Unit cur, nxt; int ui = 0;
    if (!S.next(0, cur)) return;
    f32x4 acc[2][2][4][2];
#pragma unroll
    for (int a = 0; a < 2; ++a)
#pragma unroll
        for (int b = 0; b < 2; ++b)
#pragma unroll
            for (int m = 0; m < 4; ++m)
#pragma unroll
                for (int n = 0; n < 2; ++n) acc[a][b][m][n] = (f32x4){0.f, 0.f, 0.f, 0.f};
    bf16x8 At[4][2], B0[2][2], B1[2][2];
    const char* cA = (const char*)g.A + (size_t)cur.pm * tstep; const char* cB = (const char*)g.Bt + (size_t)cur.pn * tstep;
    S.a_ready(cur);
    PG8_STAGE(PG8_SB(0, 0), cB, voffB); PG8_STAGE(PG8_SA(0, 0), cA, voffA); PG8_STAGE(PG8_SB(0, 1), cB + hstep, voffB); PG8_STAGE(PG8_SA(0, 1), cA + hstep, voffA);
    if (wr == 1) PG8_BAR;
    PG8_WAIT_V(4); PG8_BAR;
    PG8_STAGE(PG8_SB(1, 0), cB + kstep, voffB); PG8_STAGE(PG8_SA(1, 0), cA + kstep, voffA); PG8_STAGE(PG8_SB(1, 1), cB + hstep + kstep, voffB);
    PG8_WAIT_V(6); PG8_BAR;
    PG8_STAMP();
    for (;;) {
        const bool has_next = S.next(ui + 1, nxt);
        const char* nA = has_next ? (const char*)g.A + (size_t)nxt.pm * tstep : cA; const char* nB = has_next ? (const char*)g.Bt + (size_t)nxt.pn * tstep : cB;
        for (int t = 0; t < nt; t += 2) {
            const bool last = (t == nt - 2);
            const char* a1 = cA + (size_t)(t + 1) * kstep;
            const char* a2 = last ? nA : cA + (size_t)(t + 2) * kstep; const char* b2 = last ? nB : cB + (size_t)(t + 2) * kstep;
            const char* a3 = a2 + kstep; const char* b3 = b2 + kstep;
            if (last && has_next) S.a_ready(nxt);
            PG8_LDB(B0, 0, 0); PG8_SCHED; PG8_LDA(At, 0, 0); PG8_STAGE(PG8_SA(1, 1), a1 + hstep, voffA);
            PG8_WAIT_L(8); PG8_BAR; PG8_WAIT_L(0); PG8_MMA(0, 0, At, B0); PG8_BAR; PG8_SCHED;
            PG8_LDB(B1, 0, 1); PG8_STAGE(PG8_SB(0, 0), b2, voffB);
            PG8_BAR; PG8_WAIT_L(0); PG8_MMA(0, 1, At, B1); PG8_BAR;
            PG8_LDA(At, 0, 1); PG8_STAGE(PG8_SA(0, 0), a2, voffA);
            PG8_BAR; PG8_WAIT_L(0); PG8_MMA(1, 0, At, B0); PG8_BAR; PG8_SCHED;
            PG8_STAGE(PG8_SB(0, 1), b2 + hstep, voffB);
            PG8_WAIT_V(6); PG8_BAR; PG8_MMA(1, 1, At, B1); PG8_BAR;
            PG8_LDB(B0, 1, 0); PG8_SCHED; PG8_LDA(At, 1, 0); PG8_STAGE(PG8_SA(0, 1), a2 + hstep, voffA);
            PG8_WAIT_L(8); PG8_BAR; PG8_WAIT_L(0); PG8_MMA(0, 0, At, B0); PG8_BAR; PG8_SCHED;
            PG8_LDB(B1, 1, 1); PG8_STAGE(PG8_SB(1, 0), b3, voffB);
            PG8_BAR; PG8_WAIT_L(0); PG8_MMA(0, 1, At, B1); PG8_BAR;
            PG8_LDA(At, 1, 1); PG8_STAGE(PG8_SA(1, 0), a3, voffA);
            PG8_BAR; PG8_WAIT_L(0); PG8_MMA(1, 0, At, B0); PG8_BAR; PG8_SCHED;
            PG8_STAGE(PG8_SB(1, 1), b3 + hstep, voffB);
            PG8_WAIT_V(6); PG8_BAR; PG8_MMA(1, 1, At, B1); PG8_BAR;
        }
        PG8_STAMP();
        if constexpr (!Epi::AFTER_DRAIN) { E(acc, cur, wr, wc, fr, fq); S.done(cur); }
        PG8_STAMP();
        if (!has_next) break;
#pragma unroll
        for (int a = 0; a < 2; ++a)
#pragma unroll
            for (int b = 0; b < 2; ++b)
#pragma unroll
                for (int m = 0; m < 4; ++m)
#pragma unroll
                    for (int n = 0; n < 2; ++n) acc[a][b][m][n] = (f32x4){0.f, 0.f, 0.f, 0.f};
        cur = nxt; cA = nA; cB = nB; ++ui;
    }
    PG8_WAIT_V(0);
    if (wr == 0) PG8_BAR;
    PG8_BAR;
    if constexpr (Epi::AFTER_DRAIN) { E.fused(acc, cur, wr, wc, fr, fq, lds, wid, lane); S.done(cur); }
    PG8_STAMP();
    if (STAMP && wid == 0) { stamps[lane] = lane < nts ? (((unsigned long long)(unsigned)ts_hi << 32) | (unsigned)ts_lo) : 0ull;
        if (lane == 62) stamps[62] = rt_entry; if (lane == 63) stamps[63] = (unsigned long long)wall_clock64(); }
#undef PG8_STAMP
#undef PG8_SA
#undef PG8_SB
#undef PG8_STAGE
#undef PG8_LDA
#undef PG8_LDB
#undef PG8_MMA
#undef PG8_WAIT_V
#undef PG8_WAIT_L
#undef PG8_BAR
#undef PG8_SCHED
}
}

#define LAS __attribute__((address_space(3)))
#define GAS __attribute__((address_space(1)))
typedef unsigned short bf16_t;
typedef short bf16x8 __attribute__((ext_vector_type(8)));
typedef float f32x4 __attribute__((ext_vector_type(4)));
typedef float f32x2 __attribute__((ext_vector_type(2)));
typedef float f32x16 __attribute__((ext_vector_type(16)));
typedef unsigned u32x4 __attribute__((ext_vector_type(4)));
typedef unsigned u32x2 __attribute__((ext_vector_type(2)));

constexpr int DM = 2048, NBATCH = 4, SEQ = 4096, MROWS = NBATCH * SEQ, NMETA = 16, DIN = 6144, DLRU = 1024, NHEAD = 16;
constexpr int META0 = MROWS;
constexpr int RSTR = MROWS + 64;
constexpr float RMS_EPS = 1e-6f;
constexpr int NPHASE = 8;
#ifndef REP_MASK
#define REP_MASK 0
#endif
constexpr int LDS_BYTES = 131072 + 256;

constexpr size_t MiB = 1u << 20;
constexpr size_t WS_WTIN = 0;
constexpr size_t WS_WTOUT = 48 * MiB;
constexpr size_t WS_GW = 64 * MiB;
constexpr size_t WS_ROWSS = 65 * MiB;
constexpr size_t WS_BAR = 65 * MiB + 512 * 1024;
constexpr size_t WS_AGG = 66 * MiB;
constexpr size_t WS_XB = 71 * MiB;
constexpr size_t WS_Y = 136 * MiB;
constexpr size_t WS_U = 201 * MiB;
constexpr size_t WS_END = 396 * MiB;
constexpr int AGG_PER_LAYER = 257 * 1024;
static_assert(WS_U + (size_t)RSTR * DIN * 2 <= WS_END && WS_Y + (size_t)RSTR * DM * 2 <= WS_U && WS_XB + (size_t)RSTR * DM * 2 <= WS_Y, "ws map");
static_assert(WS_WTIN + (size_t)2 * DIN * DM * 2 <= WS_WTOUT && WS_WTOUT + (size_t)2 * DM * DM * 2 <= WS_GW && WS_AGG + (size_t)2 * AGG_PER_LAYER * 8 <= WS_XB && WS_ROWSS + (size_t)3 * RSTR * 4 <= WS_BAR, "ws map 2");

struct Args { const float* in[14]; float* out; unsigned char* ws; int ph_lo, ph_hi, flags, pad; };

__device__ __forceinline__ unsigned f2bf(float f) { unsigned u = __builtin_bit_cast(unsigned, f); return (u + 0x7fffu + ((u >> 16) & 1u)) >> 16; }
__device__ __forceinline__ unsigned pk2(float lo, float hi) { return f2bf(lo) | (f2bf(hi) << 16); }
__device__ __forceinline__ float bflo(unsigned w) { return __builtin_bit_cast(float, w << 16); }
__device__ __forceinline__ float bfhi(unsigned w) { return __builtin_bit_cast(float, w & 0xffff0000u); }
__device__ __forceinline__ float bf1(bf16_t v) { return __builtin_bit_cast(float, ((unsigned)v) << 16); }
__device__ __forceinline__ float sigmoidf_(float z) { return __builtin_amdgcn_rcpf(1.0f + __expf(-z)); }
__device__ __forceinline__ float wave_sum(float v) {
#pragma unroll
    for (int o = 1; o < 64; o <<= 1) v += __shfl_xor(v, o);
    return v;
}
#define LDS_WAIT() asm volatile("s_waitcnt lgkmcnt(0)" ::: "memory")

struct EpiU {
    static constexpr bool PERM = true, AFTER_DRAIN = false;
    bf16_t* O; const float* rowss;
    __device__ __forceinline__ void operator()(const f32x4 (&acc)[2][2][4][2], const pg8::Unit& u, int wr, int wc, int fr, int fq) const {
        const int row0 = u.pm * 256 + wr * 64 + fr, col0 = u.pn * 256 + wc * 32 + 8 * fq;
#pragma unroll
        for (int ai = 0; ai < 2; ++ai)
#pragma unroll
            for (int m = 0; m < 4; ++m) {
                const int r = row0 + ai * 128 + m * 16;
                const float rs = rsqrtf(rowss[r] * (1.0f / DM) + RMS_EPS);
                bf16_t* rowp = O + (size_t)r * DIN + col0;
#pragma unroll
                for (int bj = 0; bj < 2; ++bj) {
                    const f32x4 v0 = acc[ai][bj][m][0] * rs, v1 = acc[ai][bj][m][1] * rs;
                    u32x4 w; w.x = pg8::cvt_pk_bf16(v0[0], v0[1]); w.y = pg8::cvt_pk_bf16(v0[2], v0[3]); w.z = pg8::cvt_pk_bf16(v1[0], v1[1]); w.w = pg8::cvt_pk_bf16(v1[2], v1[3]);
                    *(u32x4*)(rowp + bj * 128) = w;
                }
            }
    }
};
#ifndef EPI_MB
#define EPI_MB 2
#endif
struct EpiRes {
    static constexpr bool PERM = true, AFTER_DRAIN = false;
    const float* res; float* out; bf16_t* xb; float* rowss;
    __device__ __forceinline__ void operator()(const f32x4 (&acc)[2][2][4][2], const pg8::Unit& u, int wr, int wc, int fr, int fq) const {
        const int row0 = u.pm * 256 + wr * 64 + fr, col0 = u.pn * 256 + wc * 32 + 8 * fq;
#pragma unroll
        for (int ai = 0; ai < 2; ++ai) {
#pragma unroll
          for (int mh = 0; mh < 4; mh += EPI_MB) {
            f32x4 rv[4][2][2];
#pragma unroll
            for (int m = mh; m < mh + EPI_MB; ++m)
#pragma unroll
                for (int bj = 0; bj < 2; ++bj) { const float* p = res + (size_t)(row0 + ai * 128 + m * 16) * DM + col0 + bj * 128; rv[m][bj][0] = *(const f32x4*)p; rv[m][bj][1] = *(const f32x4*)(p + 4); }
            asm volatile("" ::: "memory");
#pragma unroll
            for (int m = mh; m < mh + EPI_MB; ++m) {
                const int r = row0 + ai * 128 + m * 16; const size_t off = (size_t)r * DM + col0; float ss = 0.f;
#pragma unroll
                for (int bj = 0; bj < 2; ++bj) {
                    const f32x4 h0 = rv[m][bj][0] + acc[ai][bj][m][0], h1 = rv[m][bj][1] + acc[ai][bj][m][1];
                    *(f32x4*)(out + off + bj * 128) = h0; *(f32x4*)(out + off + bj * 128 + 4) = h1;
                    if (xb) { u32x4 w; w.x = pg8::cvt_pk_bf16(h0[0], h0[1]); w.y = pg8::cvt_pk_bf16(h0[2], h0[3]); w.z = pg8::cvt_pk_bf16(h1[0], h1[1]); w.w = pg8::cvt_pk_bf16(h1[2], h1[3]);
                        *(u32x4*)(xb + off + bj * 128) = w; }
                    ss += (h0[0] * h0[0] + h0[1] * h0[1]) + (h0[2] * h0[2] + h0[3] * h0[3]) + (h1[0] * h1[0] + h1[1] * h1[1]) + (h1[2] * h1[2] + h1[3] * h1[3]);
                }
                ss += __shfl_xor(ss, 16); ss += __shfl_xor(ss, 32);
                if (fq == 0) unsafeAtomicAdd(rowss + r, ss);
            }
            asm volatile("" ::: "memory");
          }
        }
    }
};

template <class F> __device__ __forceinline__ void meta_gemm(const bf16_t* A, const bf16_t* Bt, int ngroups, LAS unsigned char* lds, int wid, int lane, F epi) {
    const int fr = lane & 15, fq = lane >> 4;
    LAS f32x4* red = (LAS f32x4*)lds;
    for (int g = blockIdx.x; g < ngroups; g += gridDim.x) {
        f32x4 acc = {0.f, 0.f, 0.f, 0.f};
        const bf16_t* ap = A + (size_t)fr * DM + wid * 256 + fq * 8;
        const bf16_t* bp = Bt + (size_t)(g * 16 + fr) * DM + wid * 256 + fq * 8;
#pragma unroll
        for (int s = 0; s < 8; ++s) {
            const bf16x8 a = *(const bf16x8*)(ap + 32 * s), b = *(const bf16x8*)(bp + 32 * s);
            acc = __builtin_amdgcn_mfma_f32_16x16x32_bf16(b, a, acc, 0, 0, 0);
        }
        red[wid * 64 + lane] = acc;
        __syncthreads();
        if (wid == 0) {
            f32x4 s = red[lane];
#pragma unroll
            for (int w = 1; w < 8; ++w) s += red[w * 64 + lane];
            epi(fr, g * 16 + 4 * fq, s);
        }
        __syncthreads();
    }
}

__device__ __forceinline__ void tr_item(const float* W, int K, int N, bf16_t* WT, const float* sc, LAS unsigned char* scr, int item, int lane) {
    const int nblk = N / 64, kb = item / nblk, nb = item % nblk, k0 = 64 * kb, n0 = 64 * nb;
    const int kr = lane >> 4, nc = (lane & 15) * 4;
    f32x4 v[16]; float g[16];
    { const float* p = W + (size_t)(k0 + kr) * N + n0 + nc;
#pragma unroll
      for (int i = 0; i < 16; ++i) { v[i] = *(const f32x4*)p; p += (size_t)4 * N; }
#pragma unroll
      for (int i = 0; i < 16; ++i) g[i] = sc ? sc[k0 + kr + 4 * i] : 1.0f; }
    asm volatile("" ::: "memory");
#pragma unroll
    for (int i = 0; i < 16; ++i) { const f32x4 s = v[i] * g[i]; u32x2 w; w.x = pg8::cvt_pk_bf16(s[0], s[1]); w.y = pg8::cvt_pk_bf16(s[2], s[3]);
        *(LAS u32x2*)(scr + (kr + 4 * i) * 136 + nc * 2) = w; }
    LDS_WAIT();
    const int c = lane & 7;
#pragma unroll
    for (int j = 0; j < 8; ++j) { const int n = (lane >> 3) + 8 * j; const LAS bf16_t* s = (const LAS bf16_t*)(scr + (8 * c) * 136 + n * 2);
        u32x4 o; o.x = (unsigned)s[0] | ((unsigned)s[68] << 16); o.y = (unsigned)s[2 * 68] | ((unsigned)s[3 * 68] << 16); o.z = (unsigned)s[4 * 68] | ((unsigned)s[5 * 68] << 16); o.w = (unsigned)s[6 * 68] | ((unsigned)s[7 * 68] << 16);
        *(u32x4*)(WT + (size_t)(n0 + n) * K + k0 + 8 * c) = o; }
    LDS_WAIT();
}
__device__ __forceinline__ void cvt_row(const float* src, bf16_t* dst, float* ss, int lane) {
    const f32x4* xr = (const f32x4*)src + lane; f32x4 v[8]; float s = 0.f;
#pragma unroll
    for (int j = 0; j < 8; ++j) { v[j] = xr[64 * j]; s += (v[j].x * v[j].x + v[j].y * v[j].y) + (v[j].z * v[j].z + v[j].w * v[j].w); }
    s = wave_sum(s);
    u32x2* o8 = (u32x2*)dst + lane;
#pragma unroll
    for (int j = 0; j < 8; ++j) { u32x2 w; w.x = pk2(v[j].x, v[j].y); w.y = pk2(v[j].z, v[j].w); o8[64 * j] = w; }
    if (lane == 0) *ss = s;
}

struct Mix {
    const float *conv_a_w, *conv_a_b, *lru_br, *lru_bi, *lru_lambda, *conv_b_w;
    const bf16_t* gw;
    bf16_t* U; bf16_t* Y; unsigned long long* AGG;
};
struct ItemId { int hd, b, c, row0, ntok, agg; bool meta; };
__device__ __forceinline__ ItemId decode_item(int id) {
    ItemId I;
    if (id < 16) { I.meta = true; I.hd = id; I.b = 0; I.c = 0; I.row0 = META0; I.ntok = 16; I.agg = 256; }
    else { const int j = id - 16; I.meta = false; I.hd = j & 15; I.c = (j >> 4) & 63; I.b = j >> 10; I.row0 = I.b * SEQ + I.c * 64; I.ntok = 64; I.agg = I.b * 64 + I.c; }
    return I;
}
constexpr int N_ITEMS = 16 + NBATCH * NHEAD * 64;

__device__ __forceinline__ bool agg_ok(unsigned long long v) { return (unsigned)v != 0u; }
__device__ __forceinline__ void mix_item(const Mix& X, int id, LAS unsigned char* xt, int lane) {
    constexpr float LOG2E = 1.4426950408889634f;
    const ItemId I = decode_item(id);
    const int ch = I.hd * 64 + lane;
    const float nls2 = -8.0f * LOG2E * log1pf(__expf(-X.lru_lambda[ch]));
    bf16_t raw[64], rh0 = 0, rh1 = 0, rh2 = 0;
    const float w0 = X.conv_a_w[ch], w1 = X.conv_a_w[1024 + ch], w2 = X.conv_a_w[2048 + ch], w3 = X.conv_a_w[3072 + ch], cb = X.conv_a_b[ch];
    {
        const GAS bf16_t* sb = (const GAS bf16_t*)(X.U + (size_t)I.row0 * DIN + I.hd * 64);
        if (!I.meta) { const GAS bf16_t* hp0 = (I.c == 0) ? (const GAS bf16_t*)(X.U + (size_t)(META0 + 13) * DIN + I.hd * 64) : sb - 3 * DIN; rh0 = hp0[lane]; rh1 = hp0[DIN + lane]; rh2 = hp0[2 * DIN + lane]; }
#pragma unroll
        for (int t = 0; t < 64; ++t) { raw[t] = sb[lane]; if (t < 15 || !I.meta) sb += DIN; asm volatile("" : "+s"(sb)); }
    }
    bf16x8 BfR0[4], BfR1[4], BfI0[4], BfI1[4];
    { const bf16_t* gr = X.gw + (size_t)(I.hd * 64 + (lane & 31)) * 64 + 8 * (lane >> 5); const bf16_t* gi = gr + 16 * 64 * 64;
#pragma unroll
      for (int s = 0; s < 4; ++s) { BfR0[s] = *(const bf16x8*)(gr + 16 * s); BfR1[s] = *(const bf16x8*)(gr + 32 * 64 + 16 * s); BfI0[s] = *(const bf16x8*)(gi + 16 * s); BfI1[s] = *(const bf16x8*)(gi + 32 * 64 + 16 * s); } }
    asm volatile("" ::: "memory");
    float xm3 = bf1(rh0), xm2 = bf1(rh1), xm1 = bf1(rh2);
#pragma unroll
    for (int t = 0; t < 64; ++t) { const float x0 = bf1(raw[t]); const float xc = cb + w0 * xm3 + w1 * xm2 + w2 * xm1 + w3 * x0; xm3 = xm2; xm2 = xm1; xm1 = x0;
        *(LAS bf16_t*)(xt + t * 144 + lane * 2) = (bf16_t)f2bf(xc); }
    const float brA = X.lru_br[I.hd * 64 + (lane & 31)], brB = X.lru_br[I.hd * 64 + 32 + (lane & 31)], biA = X.lru_bi[I.hd * 64 + (lane & 31)], biB = X.lru_bi[I.hd * 64 + 32 + (lane & 31)];
    float h = 0.f, P = 1.f, h15 = 0.f, P15 = 1.f;
    unsigned hp[64];
#pragma unroll
    for (int tb = 0; tb < 2; ++tb) {
        f32x16 aR0, aR1, aI0, aI1;
#pragma unroll
        for (int e = 0; e < 16; ++e) { aR0[e] = brA; aR1[e] = brB; aI0[e] = biA; aI1[e] = biB; }
#pragma unroll
        for (int s = 0; s < 4; ++s) {
            const bf16x8 af = *(const LAS bf16x8*)(xt + (tb * 32 + (lane & 31)) * 144 + (16 * s + 8 * (lane >> 5)) * 2);
            aR0 = __builtin_amdgcn_mfma_f32_32x32x16_bf16(af, BfR0[s], aR0, 0, 0, 0);
            aR1 = __builtin_amdgcn_mfma_f32_32x32x16_bf16(af, BfR1[s], aR1, 0, 0, 0);
            aI0 = __builtin_amdgcn_mfma_f32_32x32x16_bf16(af, BfI0[s], aI0, 0, 0, 0);
            aI1 = __builtin_amdgcn_mfma_f32_32x32x16_bf16(af, BfI1[s], aI1, 0, 0, 0);
        }
#pragma unroll
        for (int q = 0; q < 4; ++q) {
            float Rv[2][4], Iv[2][4];
#pragma unroll
            for (int k = 0; k < 4; ++k) {
                const int reg = 4 * q + k;
                const float r0f = aR0[reg], r1f = aR1[reg], i0f = aI0[reg], i1f = aI1[reg];
                auto r = __builtin_amdgcn_permlane32_swap(__float_as_uint(r0f), __float_as_uint(r1f), false, false);
                Rv[0][k] = __uint_as_float(r[0]); Rv[1][k] = __uint_as_float(r[1]);
                auto i2 = __builtin_amdgcn_permlane32_swap(__float_as_uint(i0f), __float_as_uint(i1f), false, false);
                Iv[0][k] = __uint_as_float(i2[0]); Iv[1][k] = __uint_as_float(i2[1]);
            }
#pragma unroll
            for (int st = 0; st < 2; ++st)
#pragma unroll
                for (int p = 0; p < 2; ++p) {
                    const int t = tb * 32 + 8 * q + 4 * st + 2 * p;
                    f32x2 er = (f32x2){Rv[st][2 * p], Rv[st][2 * p + 1]} * (-LOG2E), ei = (f32x2){Iv[st][2 * p], Iv[st][2 * p + 1]} * (-LOG2E);
                    er.x = __builtin_amdgcn_exp2f(er.x); er.y = __builtin_amdgcn_exp2f(er.y); ei.x = __builtin_amdgcn_exp2f(ei.x); ei.y = __builtin_amdgcn_exp2f(ei.y);
                    er = er + 1.0f; ei = ei + 1.0f;
                    f32x2 rg, ig; rg.x = __builtin_amdgcn_rcpf(er.x); rg.y = __builtin_amdgcn_rcpf(er.y); ig.x = __builtin_amdgcn_rcpf(ei.x); ig.y = __builtin_amdgcn_rcpf(ei.y);
                    const f32x2 l2 = rg * nls2;
                    f32x2 a; a.x = __builtin_amdgcn_exp2f(l2.x); a.y = __builtin_amdgcn_exp2f(l2.y);
                    f32x2 om = 1.0f - a * a; om.x = fmaxf(om.x, 0.f); om.y = fmaxf(om.y, 0.f);
                    f32x2 mu; mu.x = __builtin_amdgcn_sqrtf(om.x); mu.y = __builtin_amdgcn_sqrtf(om.y);
                    const f32x2 xc = (f32x2){bf1(*(const LAS bf16_t*)(xt + t * 144 + lane * 2)), bf1(*(const LAS bf16_t*)(xt + (t + 1) * 144 + lane * 2))};
                    const f32x2 bb = mu * ig * xc;
                    h = a.x * h + bb.x; P = P * a.x; hp[t] = pg8::cvt_pk_bf16(h, P);
                    h = a.y * h + bb.y; P = P * a.y; hp[t + 1] = pg8::cvt_pk_bf16(h, P);
                    if (t + 1 == 15) { h15 = h; P15 = P; }
                }
        }
    }
    if (I.meta) { h = h15; P = P15; }
    __hip_atomic_store(X.AGG + (size_t)I.agg * 1024 + ch, ((unsigned long long)__float_as_uint(h) << 32) | (unsigned long long)__float_as_uint(P), __ATOMIC_RELAXED, __HIP_MEMORY_SCOPE_AGENT);
    asm volatile("" ::: "memory");
    bf16_t graw[64];
    { const GAS bf16_t* sb = (const GAS bf16_t*)(X.U + (size_t)I.row0 * DIN + 1024 + I.hd * 64);
#pragma unroll
      for (int t = 0; t < 64; ++t) { graw[t] = sb[lane]; if (t < 15 || !I.meta) sb += DIN; asm volatile("" : "+s"(sb)); } }
    float hin = 0.f;
    if (!I.meta) {
        { const unsigned long long* mp = X.AGG + (size_t)256 * 1024 + ch; unsigned long long v;
          for (;;) { v = __hip_atomic_load(mp, __ATOMIC_RELAXED, __HIP_MEMORY_SCOPE_AGENT); if (!__any(!agg_ok(v))) break; __builtin_amdgcn_s_sleep(2); }
          hin = __uint_as_float((unsigned)(v >> 32)); }
        const unsigned long long* ap = X.AGG + (size_t)(I.b * 64) * 1024 + ch;
        for (int j0 = 0; j0 < I.c; j0 += 16) {
            unsigned long long v[16];
            for (;;) {
                bool bad = false;
#pragma unroll
                for (int k = 0; k < 16; ++k) { v[k] = (j0 + k < I.c) ? __hip_atomic_load(ap + (size_t)(j0 + k) * 1024, __ATOMIC_RELAXED, __HIP_MEMORY_SCOPE_AGENT) : 0x000000003f800000ull; }
#pragma unroll
                for (int k = 0; k < 16; ++k) bad |= !agg_ok(v[k]);
                if (!__any(bad)) break;
                __builtin_amdgcn_s_sleep(2);
            }
#pragma unroll
            for (int k = 0; k < 16; ++k) hin = __uint_as_float((unsigned)v[k]) * hin + __uint_as_float((unsigned)(v[k] >> 32));
        }
    }
    asm volatile("" ::: "memory");
    GAS bf16_t* yp = (GAS bf16_t*)(X.Y + (size_t)I.row0 * DM + I.hd * 64);
#pragma unroll
    for (int t0 = 0; t0 < 64; t0 += 16) {
        if (t0 < I.ntok) {
#pragma unroll
            for (int k = 0; k < 16; k += 2) {
                const unsigned w0 = hp[t0 + k], w1 = hp[t0 + k + 1];
                const f32x2 gg = (f32x2){bf1(graw[t0 + k]), bf1(graw[t0 + k + 1])};
                f32x2 e = gg * (-LOG2E); e.x = __builtin_amdgcn_exp2f(e.x); e.y = __builtin_amdgcn_exp2f(e.y); e = e + 1.0f;
                f32x2 sg; sg.x = __builtin_amdgcn_rcpf(e.x); sg.y = __builtin_amdgcn_rcpf(e.y);
                const f32x2 hv = (f32x2){bflo(w0), bflo(w1)} + (f32x2){bfhi(w0), bfhi(w1)} * hin;
                const f32x2 y = hv * gg * sg;
                const unsigned pk = pg8::cvt_pk_bf16(y.x, y.y);
                yp[lane] = (bf16_t)(pk & 0xffffu); yp[DM + lane] = (bf16_t)(pk >> 16); yp += 2 * DM; asm volatile("" : "+s"(yp));
            }
        }
    }
}

__device__ __forceinline__ void ld8(const bf16_t* p, float (&o)[8]) {
    const u32x4 w = *(const u32x4*)p;
    o[0] = bflo(w.x); o[1] = bfhi(w.x); o[2] = bflo(w.y); o[3] = bfhi(w.y); o[4] = bflo(w.z); o[5] = bfhi(w.z); o[6] = bflo(w.w); o[7] = bfhi(w.w);
}
__device__ __forceinline__ void partb(const Mix& X, int tid) {
    for (int it = blockIdx.x * 512 + tid; it < 1025 * 128; it += gridDim.x * 512) {
        const int c0 = (it & 127) * 8, run = it >> 7;
        int row0, hrow = -1;
        if (run == 1024) row0 = META0; else { row0 = run * 16; hrow = ((row0 & (SEQ - 1)) == 0) ? META0 + 14 : row0 - 2; }
        float w0[8], w1[8], w2[8], cm2[8], cm1[8];
        { const f32x4* p = (const f32x4*)(X.conv_b_w + c0); const f32x4 a0 = p[0], a1 = p[1], b0 = p[256], b1 = p[257], d0 = p[512], d1 = p[513];
#pragma unroll
          for (int e = 0; e < 4; ++e) { w0[e] = a0[e]; w0[4 + e] = a1[e]; w1[e] = b0[e]; w1[4 + e] = b1[e]; w2[e] = d0[e]; w2[4 + e] = d1[e]; } }
        if (hrow >= 0) {
            float c[8], x[8];
            ld8(X.U + (size_t)hrow * DIN + 3072 + c0, c); ld8(X.U + (size_t)hrow * DIN + 4096 + c0, x);
#pragma unroll
            for (int e = 0; e < 8; ++e) cm2[e] = c[e] * x[e];
            ld8(X.U + (size_t)(hrow + 1) * DIN + 3072 + c0, c); ld8(X.U + (size_t)(hrow + 1) * DIN + 4096 + c0, x);
#pragma unroll
            for (int e = 0; e < 8; ++e) cm1[e] = c[e] * x[e];
        } else {
#pragma unroll
            for (int e = 0; e < 8; ++e) { cm2[e] = 0.f; cm1[e] = 0.f; }
        }
        const bf16_t* up = X.U + (size_t)row0 * DIN + c0;
        bf16_t* yp = X.Y + (size_t)row0 * DM + 1024 + c0;
#pragma unroll 4
        for (int t = 0; t < 16; ++t) {
            float bv[8], cv[8], xv[8], gv[8];
            ld8(up + (size_t)t * DIN + 2048, bv); ld8(up + (size_t)t * DIN + 3072, cv); ld8(up + (size_t)t * DIN + 4096, xv); ld8(up + (size_t)t * DIN + 5120, gv);
            float o[8];
#pragma unroll
            for (int e = 0; e < 8; ++e) { const float cx = cv[e] * xv[e]; const float y = w0[e] * cm2[e] + w1[e] * cm1[e] + w2[e] * cx; o[e] = bv[e] * y * (gv[e] * sigmoidf_(gv[e])); cm2[e] = cm1[e]; cm1[e] = cx; }
            u32x4 w; w.x = pk2(o[0], o[1]); w.y = pk2(o[2], o[3]); w.z = pk2(o[4], o[5]); w.w = pk2(o[6], o[7]);
            *(u32x4*)(yp + (size_t)t * DM) = w;
        }
    }
}


#ifdef DEBUG_NAIVE_MIX
__global__ void __launch_bounds__(64) naive_mixA(Mix X, const float* wr, const float* wi) {
    const int b = blockIdx.x / 16, hd = blockIdx.x % 16, lane = threadIdx.x, ch = hd * 64 + lane;
    __shared__ float xs[64];
    const float w0 = X.conv_a_w[ch], w1 = X.conv_a_w[1024 + ch], w2 = X.conv_a_w[2048 + ch], w3 = X.conv_a_w[3072 + ch], cb = X.conv_a_b[ch];
    const float br = X.lru_br[ch], bi = X.lru_bi[ch];
    const float sp = log1pf(expf(-X.lru_lambda[ch]));
    const float* wrh = wr + (size_t)hd * 4096 + lane; const float* wih = wi + (size_t)hd * 4096 + lane;
    float h = 0.f, xm3 = 0.f, xm2 = 0.f, xm1 = 0.f;
    for (int p = 0; p < NMETA + SEQ; ++p) {
        const int row = p < NMETA ? META0 + p : b * SEQ + (p - NMETA);
        const float x0 = bf1(X.U[(size_t)row * DIN + ch]);
        const float xc = cb + w0 * xm3 + w1 * xm2 + w2 * xm1 + w3 * x0; xm3 = xm2; xm2 = xm1; xm1 = x0;
        xs[lane] = xc; __syncthreads();
        float rp = br, ip = bi;
#pragma unroll 4
        for (int i = 0; i < 64; ++i) { rp += xs[i] * wrh[i * 64]; ip += xs[i] * wih[i * 64]; }
        __syncthreads();
        const float r = 1.f / (1.f + expf(-rp)), ig = 1.f / (1.f + expf(-ip));
        const float la = -8.f * r * sp; const float a = expf(la); const float bb = sqrtf(-expm1f(2.f * la)) * (ig * xc);
        h = a * h + bb;
        const float g = bf1(X.U[(size_t)row * DIN + 1024 + ch]);
        const float y = h * g / (1.f + expf(-g));
        if (p >= NMETA || b == 0) X.Y[(size_t)row * DM + ch] = (bf16_t)f2bf(y);
    }
}
__global__ void naive_mixB(Mix X) {
    for (size_t idx = (size_t)blockIdx.x * blockDim.x + threadIdx.x; idx < (size_t)(MROWS + NMETA) * 1024; idx += (size_t)gridDim.x * blockDim.x) {
        const int row = (int)(idx >> 10), c = (int)(idx & 1023);
        int r1, r2;
        if (row >= META0) { const int p = row - META0; r1 = p >= 1 ? row - 1 : -1; r2 = p >= 2 ? row - 2 : -1; }
        else { const int t = row & (SEQ - 1); r1 = t >= 1 ? row - 1 : META0 + 15; r2 = t >= 2 ? row - 2 : META0 + 14 + t; }
        auto cx = [&](int r) -> float { return r < 0 ? 0.f : bf1(X.U[(size_t)r * DIN + 3072 + c]) * bf1(X.U[(size_t)r * DIN + 4096 + c]); };
        const float y = X.conv_b_w[c] * cx(r2) + X.conv_b_w[1024 + c] * cx(r1) + X.conv_b_w[2048 + c] * cx(row);
        const float bv = bf1(X.U[(size_t)row * DIN + 2048 + c]), g = bf1(X.U[(size_t)row * DIN + 5120 + c]);
        X.Y[(size_t)row * DM + 1024 + c] = (bf16_t)f2bf(bv * y * g / (1.f + expf(-g)));
    }
}
#endif
#define XB_TMO      128
#define XB_XCNT(j)  (256  + 64 * (j))
#define XB_XSUB(j)  (1280 + 64 * (j))
#define XB_XGEN(j)  (2304 + 64 * (j))
#define XB_TOP      3328
#define XB_TOPGEN   3392
#define XCD_BAR_WORDS 3456
#define XB_SPIN_CAP (1u << 18)

__device__ __forceinline__ unsigned xb_ld(unsigned* p)              { return __hip_atomic_load(p, __ATOMIC_RELAXED, __HIP_MEMORY_SCOPE_AGENT); }
__device__ __forceinline__ unsigned xb_add(unsigned* p, unsigned v) { return __hip_atomic_fetch_add(p, v, __ATOMIC_RELAXED, __HIP_MEMORY_SCOPE_AGENT); }
__device__ __forceinline__ unsigned xb_xcc_id() { return (unsigned)__builtin_amdgcn_s_getreg((3 << 11) | 20) & 0xFu; }
#define XB_SPIN(cond, bar) do { unsigned _sp = 0; while (cond) { __builtin_amdgcn_s_sleep(1); \
    if ((++_sp & 255u) == 0u) { if (xb_ld(&(bar)[XB_TMO])) break; if (_sp > XB_SPIN_CAP) { atomicAdd(&(bar)[XB_TMO], 1u); break; } } } } while (0)

struct XcdBarrier {
    unsigned* bar; unsigned x;
    volatile LAS unsigned* st;
};

__device__ __forceinline__ XcdBarrier xcd_barrier_post(unsigned* bar, volatile LAS unsigned* st) {
    XcdBarrier b; b.bar = bar; b.x = xb_xcc_id(); b.st = st;
    if (threadIdx.x == 0) (void)xb_add(&bar[XB_XCNT(b.x)], 1u);
    return b;
}
__device__ __forceinline__ void xcd_barrier_complete(unsigned* bar, unsigned x, unsigned& nloc, unsigned& nx) {
    const unsigned G = gridDim.x * gridDim.y * gridDim.z;
    unsigned sum, cnt, mine, sp = 0u;
    for (;;) {
        sum = 0u; cnt = 0u; mine = 0u;
#pragma unroll
        for (unsigned j = 0; j < 16; ++j) { const unsigned c = xb_ld(&bar[XB_XCNT(j)]); sum += c; cnt += (c > 0u) ? 1u : 0u; mine = (j == x) ? c : mine; }
        if (sum == G) break;
        __builtin_amdgcn_s_sleep(1);
        if ((++sp & 255u) == 0u) { if (xb_ld(&bar[XB_TMO])) break; if (sp > XB_SPIN_CAP) { atomicAdd(&bar[XB_TMO], 1u); break; } }
    }
    nloc = mine > 0u ? mine : 1u; nx = cnt > 0u ? cnt : 1u;
}

__device__ __forceinline__ void xcd_barrier(const XcdBarrier& b) {
    asm volatile("s_waitcnt vmcnt(0)" ::: "memory");
    __syncthreads();
    if (threadIdx.x == 0) {
        unsigned* bar = b.bar;
        __builtin_amdgcn_s_waitcnt(0);
        unsigned nloc = b.st[0], nx = b.st[1];
        if (nloc == 0u) { xcd_barrier_complete(bar, b.x, nloc, nx); b.st[0] = nloc; b.st[1] = nx; }
        const unsigned old = xb_add(&bar[XB_XSUB(b.x)], 1u);
        const unsigned gen = old / nloc;
        if (old + 1u == (gen + 1u) * nloc) {
            __builtin_amdgcn_fence(__ATOMIC_RELEASE, "agent");
            asm volatile("s_waitcnt vmcnt(0)" ::: "memory");
            const unsigned og = xb_add(&bar[XB_TOP], 1u);
            const unsigned tg = og / nx;
            if (og + 1u == (tg + 1u) * nx) xb_add(&bar[XB_TOPGEN], 1u);
            else XB_SPIN(xb_ld(&bar[XB_TOPGEN]) == tg, bar);
            __builtin_amdgcn_fence(__ATOMIC_ACQUIRE, "agent");
            xb_add(&bar[XB_XGEN(b.x)], 1u);
            asm volatile("s_waitcnt vmcnt(0)" ::: "memory");
        } else {
            XB_SPIN(xb_ld(&bar[XB_XGEN(b.x)]) == gen, bar);
            __builtin_amdgcn_fence(__ATOMIC_ACQUIRE, "agent");
            asm volatile("s_waitcnt vmcnt(0)" ::: "memory");
        }
    }
    __syncthreads();
}

__global__ void __launch_bounds__(512, 2) hymba_fwd(Args a) {
    extern __shared__ __attribute__((aligned(16))) unsigned char lds_raw[];
    LAS unsigned char* lds = (LAS unsigned char*)lds_raw;
    cg::grid_group grid = cg::this_grid();
    const int NGW = gridDim.x * 8;
    if (threadIdx.x < 64) ((LAS unsigned*)(lds + 131072))[threadIdx.x] = 0u;
    __syncthreads();
    XcdBarrier xbar; xbar.bar = (unsigned*)(a.ws + WS_BAR); xbar.x = 0; xbar.st = nullptr;
    if (a.ph_hi - a.ph_lo > 1) xbar = xcd_barrier_post((unsigned*)(a.ws + WS_BAR), (volatile LAS unsigned*)(lds + 131072));
    if (a.ph_lo < 0) grid.sync();
#define LAUNDER() int tid = threadIdx.x; asm volatile("" : "+v"(tid)); const int wid = __builtin_amdgcn_readfirstlane(tid >> 6), lane = tid & 63, gw = blockIdx.x * 8 + wid
    const int lo = a.ph_lo, hi = a.ph_hi;
#define IN(k) (lo <= (k) && (k) < hi)
#define SEAM(k) do { if (IN(k) && IN((k) + 1)) { xcd_barrier(xbar); if ((REP_MASK >> 10) & 1) { xcd_barrier(xbar); xcd_barrier(xbar); } } } while (0)
    const float* x = a.in[0]; const float* meta = a.in[1]; const float* norm_g = a.in[2]; const float* w_in = a.in[3];
    const float* conv_a_w = a.in[4]; const float* conv_a_b = a.in[5]; const float* lru_wr = a.in[6]; const float* lru_br = a.in[7];
    const float* lru_wi = a.in[8]; const float* lru_bi = a.in[9]; const float* lru_lambda = a.in[10]; const float* conv_b_w = a.in[11];
    const float* w_out = a.in[12]; const float* final_g = a.in[13];
    unsigned char* ws = a.ws;
    bf16_t* WTIN = (bf16_t*)(ws + WS_WTIN); bf16_t* WTOUT = (bf16_t*)(ws + WS_WTOUT); bf16_t* GW = (bf16_t*)(ws + WS_GW);
    float* ROWSS = (float*)(ws + WS_ROWSS); unsigned long long* AGG = (unsigned long long*)(ws + WS_AGG);
    bf16_t* XB = (bf16_t*)(ws + WS_XB); bf16_t* Y = (bf16_t*)(ws + WS_Y); bf16_t* U = (bf16_t*)(ws + WS_U);

    if (IN(0)) for (int rep = 0; rep <= ((REP_MASK >> 0) & 1); ++rep) {
        LAUNDER();
        LAS unsigned char* scr = lds + wid * 16384;
        constexpr int I_IN = (DM / 64) * (DIN / 64), I_OUT = (DM / 64) * (DM / 64);
        constexpr int NIT = 2 * I_IN + 2 * I_OUT + 64;
        for (int it = gw; it < NIT; it += NGW) {
            int r = it;
            if (r < 2 * I_IN) { const int l = r / I_IN; tr_item(w_in + (size_t)l * DM * DIN, DM, DIN, WTIN + (size_t)l * DIN * DM, norm_g + l * DM, scr, r % I_IN, lane); continue; } r -= 2 * I_IN;
            if (r < 2 * I_OUT) { const int l = r / I_OUT; tr_item(w_out + (size_t)l * DM * DM, DM, DM, WTOUT + (size_t)l * DM * DM, nullptr, scr, r % I_OUT, lane); continue; } r -= 2 * I_OUT;
            { const int mtx = r, l = mtx >> 5, g = (mtx >> 4) & 1, hd = mtx & 15;
              const float* src = (g ? lru_wi : lru_wr) + (size_t)(l * 16 + hd) * 4096;
              tr_item(src, 64, 64, GW + (size_t)mtx * 4096, nullptr, scr, 0, lane); }
        }
        for (int m = gw; m < MROWS + NMETA; m += NGW) {
            const float* src = m < MROWS ? x + (size_t)m * DM : meta + (size_t)(m - MROWS) * DM;
            cvt_row(src, XB + (size_t)m * DM, ROWSS + m, lane);
        }
        for (int i = blockIdx.x * 512 + tid; i < 2 * RSTR; i += gridDim.x * 512) ROWSS[RSTR + i] = 0.f;
        for (int i = blockIdx.x * 512 + tid; i < AGG_PER_LAYER; i += gridDim.x * 512) ((u32x4*)AGG)[i] = (u32x4){0u, 0u, 0u, 0u};
    }
    SEAM(0);

#pragma unroll 1
    for (int l = 0; l < 2; ++l) {
        const int pb = 1 + 3 * l;
        const bf16_t* wtin = WTIN + (size_t)l * DIN * DM; const bf16_t* wtout = WTOUT + (size_t)l * DM * DM;
        float* rss_in = ROWSS + (size_t)l * RSTR; float* rss_out = ROWSS + (size_t)(l + 1) * RSTR;
        Mix X; X.conv_a_w = conv_a_w + l * 4 * DLRU; X.conv_a_b = conv_a_b + l * DLRU; X.lru_br = lru_br + l * DLRU; X.lru_bi = lru_bi + l * DLRU; X.lru_lambda = lru_lambda + l * DLRU;
        X.conv_b_w = conv_b_w + l * 3 * DLRU; X.gw = GW + (size_t)l * 2 * 16 * 4096; X.U = U; X.Y = Y; X.AGG = AGG + (size_t)l * AGG_PER_LAYER;

        if (IN(pb)) for (int rep = 0; rep <= ((REP_MASK >> pb) & 1); ++rep) {
            LAUNDER();
            meta_gemm(XB + (size_t)META0 * DM, wtin, DIN / 16, lds, wid, lane, [&](int m, int n0, f32x4 s) {
                const float rs = rsqrtf(rss_in[META0 + m] * (1.0f / DM) + RMS_EPS);
                u32x2 w; w.x = pk2(s[0] * rs, s[1] * rs); w.y = pk2(s[2] * rs, s[3] * rs);
                *(u32x2*)(U + (size_t)(META0 + m) * DIN + n0) = w; });
            pg8::Gemm g{XB, wtin, MROWS, DIN, DM}; pg8::StaticOrder S; S.init(MROWS, DIN, (int)gridDim.x, (int)blockIdx.x);
            EpiU E{U, rss_in};
            pg8::gemm_phase<EpiU, pg8::StaticOrder, false>(lds, g, S, E, nullptr);
        }
        SEAM(pb);
        if (IN(pb + 1)) for (int rep = 0; rep <= ((REP_MASK >> (pb + 1)) & 1); ++rep) {
            LAUNDER();
#pragma unroll 1
            for (int step = 0; step < 2; ++step) {
                if ((step == 0) == (wid < 4)) {
                    if (rep == 1 && ((REP_MASK >> 13) & 1)) continue;
#pragma unroll 1
                    for (int id = gw; id < N_ITEMS; id += NGW) mix_item(X, id, lds + wid * 9216, lane);
                } else { if (rep == 1 && ((REP_MASK >> 12) & 1)) continue; partb(X, tid); }
            }
        }
        SEAM(pb + 1);
        if (IN(pb + 2)) {
            LAUNDER();
            if (l == 0) {
                meta_gemm(Y + (size_t)META0 * DM, wtout, DM / 16, lds, wid, lane, [&](int m, int n0, f32x4 s) {
                    const f32x4 r = *(const f32x4*)(meta + (size_t)m * DM + n0); const f32x4 hh = r + s;
                    u32x2 w; w.x = pk2(hh[0], hh[1]); w.y = pk2(hh[2], hh[3]);
                    *(u32x2*)(XB + (size_t)(META0 + m) * DM + n0) = w;
                    unsafeAtomicAdd(rss_out + META0 + m, (hh[0] * hh[0] + hh[1] * hh[1]) + (hh[2] * hh[2] + hh[3] * hh[3])); });
            }
            pg8::Gemm g{Y, wtout, MROWS, DM, DM}; pg8::StaticOrder S; S.init(MROWS, DM, (int)gridDim.x, (int)blockIdx.x);
            if ((REP_MASK >> 11) & 1) { EpiU Ed{U, rss_in}; pg8::gemm_phase<EpiU, pg8::StaticOrder, false>(lds, g, S, Ed, nullptr); }
            EpiRes E{l == 0 ? x : a.out, a.out, l == 0 ? XB : nullptr, rss_out};
            pg8::gemm_phase<EpiRes, pg8::StaticOrder, false>(lds, g, S, E, nullptr);
        }
        SEAM(pb + 2);
    }

    if (IN(7)) {
        LAUNDER();
        const float* rss = ROWSS + (size_t)2 * RSTR;
        for (int m = gw; m < MROWS; m += NGW) {
            const float rs = rsqrtf(rss[m] * (1.0f / DM) + RMS_EPS);
            f32x4* p = (f32x4*)(a.out + (size_t)m * DM) + lane; const f32x4* gp = (const f32x4*)final_g + lane;
            f32x4 v[8];
#pragma unroll
            for (int j = 0; j < 8; ++j) v[j] = p[64 * j];
#pragma unroll
            for (int j = 0; j < 8; ++j) p[64 * j] = v[j] * rs * gp[64 * j];
        }
    }
#undef IN
#undef SEAM
}

#ifndef MK_LAUNCH_PER_PHASE
#define MK_LAUNCH_PER_PHASE 0
#endif
extern "C" void kernel_launch(void* const* d_in, const int* in_sizes, int n_in, void* d_out, int out_size, void* d_ws, size_t ws_size, hipStream_t stream) {
    static int grid = 0;
    if (grid == 0) {
        if (n_in != 14 || in_sizes[0] != MROWS * DM || out_size != MROWS * DM || ws_size < WS_END) { fprintf(stderr, "kernel_launch: unexpected shapes (n_in %d, in0 %d, out %d, ws %zu)\n", n_in, n_in > 0 ? in_sizes[0] : -1, out_size, ws_size); grid = -1; return; }
        int dev = 0, cus = 0, per_cu = 0;
        hipGetDevice(&dev); hipDeviceGetAttribute(&cus, hipDeviceAttributeMultiprocessorCount, dev);
        if (hipFuncSetAttribute((const void*)hymba_fwd, hipFuncAttributeMaxDynamicSharedMemorySize, LDS_BYTES) != hipSuccess) { fprintf(stderr, "kernel_launch: hipFuncSetAttribute failed\n"); grid = -1; return; }
        if (hipOccupancyMaxActiveBlocksPerMultiprocessor(&per_cu, (const void*)hymba_fwd, 512, LDS_BYTES) != hipSuccess || per_cu < 1) { fprintf(stderr, "kernel_launch: occupancy query gave %d\n", per_cu); per_cu = 1; }
        (void)hipGetLastError();
        grid = cus * per_cu;
    }
    if (grid < 0) return;
    Args a{};
    for (int i = 0; i < 14; ++i) a.in[i] = (const float*)d_in[i];
    a.out = (float*)d_out; a.ws = (unsigned char*)d_ws;
#if MK_LAUNCH_PER_PHASE
    for (int p = 0; p < NPHASE; ++p) {
#ifdef DEBUG_NAIVE_MIX
        if (p == 2 || p == 6) { const int l = p / 4; unsigned char* ws = (unsigned char*)d_ws;
            Mix X; X.conv_a_w = a.in[4] + l * 4 * DLRU; X.conv_a_b = a.in[5] + l * DLRU; X.lru_br = a.in[7] + l * DLRU; X.lru_bi = a.in[9] + l * DLRU; X.lru_lambda = a.in[10] + l * DLRU;
            X.conv_b_w = a.in[11] + l * 3 * DLRU; X.gw = nullptr; X.U = (bf16_t*)(ws + WS_U); X.Y = (bf16_t*)(ws + WS_Y); X.HP = nullptr; X.AGG = nullptr;
#if DEBUG_NAIVE_MIX == 1
            hipLaunchKernelGGL(naive_mixA, dim3(64), dim3(64), 0, stream, X, a.in[6] + (size_t)l * 16 * 4096, a.in[8] + (size_t)l * 16 * 4096);
            a.flags = 1;
#else
            hipLaunchKernelGGL(naive_mixB, dim3(2048), dim3(256), 0, stream, X);
            a.flags = 2;
#endif
            }
        else a.flags = 0;
#if DEBUG_NAIVE_MIX == 1
        if (p == 3 || p == 7) continue;
#endif
#endif
        a.ph_lo = p; a.ph_hi = p + 1; hipLaunchKernelGGL(hymba_fwd, dim3(grid), dim3(512), LDS_BYTES, stream, a); }
#else
    a.ph_lo = 0; a.ph_hi = NPHASE;
    if (hipMemsetAsync((unsigned char*)d_ws + WS_BAR, 0, XCD_BAR_WORDS * 4, stream) != hipSuccess) { fprintf(stderr, "kernel_launch: memset of barrier words failed\n"); return; }
    void* args[] = {&a};
    const hipError_t e = hipLaunchCooperativeKernel((const void*)hymba_fwd, dim3(grid), dim3(512), args, LDS_BYTES, stream);
    if (e != hipSuccess) fprintf(stderr, "kernel_launch: cooperative launch failed: %s (grid %d)\n", hipGetErrorString(e), grid);
#endif
}
```

```cpp
#include <hip/hip_runtime.h>
#include <hip/hip_cooperative_groups.h>
#include <cstdio>
namespace cg = cooperative_groups;
namespace pg8 {
#define PG8_LAS __attribute__((address_space(3)))
typedef unsigned short bf16_t;
typedef short bf16x8 __attribute__((ext_vector_type(8)));
typedef float f32x4 __attribute__((ext_vector_type(4)));
typedef unsigned u32x4 __attribute__((ext_vector_type(4)));
constexpr int BM = 256, BK = 64, HALF = 128, HTB = HALF * BK * 2  , STAGE_BYTES = 8 * HTB, NXCD = 8, WGM = 8;

__host__ __device__ __forceinline__ int lds_byte(int r, int c) { const int st = (r >> 4) * 2 + (c >> 5), rr = r & 15, cc = c & 31, ob = rr * 64 + cc * 2; return st * 1024 + (ob ^ (((ob >> 9) & 1) << 5)); }
__host__ __device__ __forceinline__ void stage_rc(int b, int& R, int& C) { const int st = b / 1024, sb = b % 1024, swz = sb ^ (((sb >> 9) & 1) << 5); R = (st >> 1) * 16 + swz / 64; C = (st & 1) * 32 + (swz % 64) / 2; }
__host__ __device__ __forceinline__ int perm32(int rho) { const int n = rho >> 4, i = rho & 15; return 8 * (i >> 2) + 4 * n + (i & 3); }

struct Unit { int pm, pn; };
struct Gemm { const bf16_t* A; const bf16_t* Bt; int M, N, K; };

struct StaticOrder {
    int nM, nN, nwg, G, c;
    __host__ __device__ void init(int M, int N, int G_, int c_) { nM = M / BM; nN = N / BM; nwg = nM * nN; G = G_; c = c_; }
    __host__ __device__ bool next(int i, Unit& u) const {
        const long L = (long)i * G + c; if (L >= nwg) return false;
        int wgid = (int)L; { const int q = nwg / NXCD, r = nwg % NXCD, xcd = wgid % NXCD, off = wgid / NXCD; wgid = (xcd < r ? xcd * (q + 1) : r * (q + 1) + (xcd - r) * q) + off; }
        const int nig = WGM * nN, gid = wgid / nig, fm = gid * WGM, gsz = (nM - fm) < WGM ? (nM - fm) : WGM;
        u.pm = fm + ((wgid % nig) % gsz); u.pn = (wgid % nig) / gsz; return true;
    }
    __device__ __forceinline__ void a_ready(const Unit&) const {}
    __device__ __forceinline__ void done(const Unit&) const {}
};
__device__ __forceinline__ unsigned cvt_pk_bf16(float lo, float hi) { unsigned r; asm volatile("v_cvt_pk_bf16_f32 %0, %1, %2" : "=v"(r) : "v"(lo), "v"(hi)); return r; }
template <class Epi, class Sched, bool STAMP = false>
__device__ __forceinline__ void gemm_phase(PG8_LAS unsigned char* lds, const Gemm g, const Sched& S, const Epi& E, unsigned long long* stamps) {
    int tid_l = threadIdx.x; asm volatile("" : "+v"(tid_l));
    const int tid = tid_l, wid = __builtin_amdgcn_readfirstlane(tid >> 6), lane = tid & 63, wr = wid >> 2, wc = wid & 3, fr = lane & 15, fq = lane >> 4;
    const int K = g.K, nt = K / BK;
    int ts_lo = 0, ts_hi = 0, nts = 0; const unsigned long long rt_entry = STAMP ? (unsigned long long)wall_clock64() : 0ull;
#define PG8_STAMP() do { if (STAMP && wid == 0 && nts < 64) { const unsigned long long _c = (unsigned long long)clock64(); \
        ts_lo = (lane == nts) ? (int)(unsigned)_c : ts_lo; ts_hi = (lane == nts) ? (int)(unsigned)(_c >> 32) : ts_hi; ++nts; } } while (0)
    PG8_STAMP();
    unsigned voffA[2], voffB[2];
#pragma unroll
    for (int i = 0; i < 2; ++i) { int R, C; stage_rc(tid * 16 + i * 8192, R, C); const int Rb = Epi::PERM ? ((R & ~31) + perm32(R & 31)) : R;
        voffA[i] = (unsigned)(R * K + C) * 2u; voffB[i] = (unsigned)(Rb * K + C) * 2u; }
    const size_t kstep = (size_t)(BK * 2);
    const size_t hstep = (size_t)HALF * K * 2;
    const size_t tstep = 2 * hstep;
    const unsigned ldsw = (unsigned)wid * 1024u;
    const int aoff = lds_byte(wr * 64 + fr, fq * 8), boff = lds_byte(wc * 32 + fr, fq * 8);
#define PG8_SA(b, h) (((b) * 2 + (h)) * HTB)
#define PG8_SB(b, h) ((4 + (b) * 2 + (h)) * HTB)
#define PG8_STAGE(bufoff, gbase, voff) do { _Pragma("unroll") for (int _i = 0; _i < 2; ++_i) \
        __builtin_amdgcn_global_load_lds((const unsigned*)((const char*)(gbase) + (voff)[_i]), (PG8_LAS unsigned*)(lds + (bufoff) + ldsw + _i * 8192), 16, 0, 0); } while (0)
#define PG8_LDA(dst, b, h) do { _Pragma("unroll") for (int m = 0; m < 4; ++m) _Pragma("unroll") for (int k = 0; k < 2; ++k) dst[m][k] = *(const PG8_LAS bf16x8*)(lds + PG8_SA(b, h) + aoff + m * 2048 + k * 1024); } while (0)
#define PG8_LDB(dst, b, h) do { _Pragma("unroll") for (int n = 0; n < 2; ++n) _Pragma("unroll") for (int k = 0; k < 2; ++k) dst[n][k] = *(const PG8_LAS bf16x8*)(lds + PG8_SB(b, h) + boff + n * 2048 + k * 1024); } while (0)
#define PG8_MMA(ai, bj, At, Bt) do { __builtin_amdgcn_s_setprio(1); _Pragma("unroll") for (int m = 0; m < 4; ++m) _Pragma("unroll") for (int n = 0; n < 2; ++n) _Pragma("unroll") for (int k = 0; k < 2; ++k) \
        acc[ai][bj][m][n] = __builtin_amdgcn_mfma_f32_16x16x32_bf16(Bt[n][k], At[m][k], acc[ai][bj][m][n], 0, 0, 0); __builtin_amdgcn_s_setprio(0); } while (0)
#define PG8_WAIT_V(n) asm volatile("s_waitcnt vmcnt(" #n ")" ::: "memory")
#define PG8_WAIT_L(n) asm volatile("s_waitcnt lgkmcnt(" #n ")" ::: "memory")
#define PG8_BAR __builtin_amdgcn_s_barrier()
#define PG8_SCHED __builtin_amdgcn_sched_barrier(0)
    Unit cur, nxt; int ui = 0;
    if (!S.next(0, cur)) return;
    f32x4 acc[2][2][4][2];
#pragma unroll
    for (int a = 0; a < 2; ++a)
#pragma unroll
        for (int b = 0; b < 2; ++b)
#pragma unroll
            for (int m = 0; m < 4; ++m)
#pragma unroll
                for (int n = 0; n < 2; ++n) acc[a][b][m][n] = (f32x4){0.f, 0.f, 0.f, 0.f};
    bf16x8 At[4][2], B0[2][2], B1[2][2];
    const char* cA = (const char*)g.A + (size_t)cur.pm * tstep; const char* cB = (const char*)g.Bt + (size_t)cur.pn * tstep;
    S.a_ready(cur);
    PG8_STAGE(PG8_SB(0, 0), cB, voffB); PG8_STAGE(PG8_SA(0, 0), cA, voffA); PG8_STAGE(PG8_SB(0, 1), cB + hstep, voffB); PG8_STAGE(PG8_SA(0, 1), cA + hstep, voffA);
    if (wr == 1) PG8_BAR;
    PG8_WAIT_V(4); PG8_BAR;
    PG8_STAGE(PG8_SB(1, 0), cB + kstep, voffB); PG8_STAGE(PG8_SA(1, 0), cA + kstep, voffA); PG8_STAGE(PG8_SB(1, 1), cB + hstep + kstep, voffB);
    PG8_WAIT_V(6); PG8_BAR;
    PG8_STAMP();
    for (;;) {
        const bool has_next = S.next(ui + 1, nxt);
        const char* nA = has_next ? (const char*)g.A + (size_t)nxt.pm * tstep : cA; const char* nB = has_next ? (const char*)g.Bt + (size_t)nxt.pn * tstep : cB;
        for (int t = 0; t < nt; t += 2) {
            const bool last = (t == nt - 2);
            const char* a1 = cA + (size_t)(t + 1) * kstep;
            const char* a2 = last ? nA : cA + (size_t)(t + 2) * kstep; const char* b2 = last ? nB : cB + (size_t)(t + 2) * kstep;
            const char* a3 = a2 + kstep; const char* b3 = b2 + kstep;
            if (last && has_next) S.a_ready(nxt);
            PG8_LDB(B0, 0, 0); PG8_SCHED; PG8_LDA(At, 0, 0); PG8_STAGE(PG8_SA(1, 1), a1 + hstep, voffA);
            PG8_WAIT_L(8); PG8_BAR; PG8_WAIT_L(0); PG8_MMA(0, 0, At, B0); PG8_BAR; PG8_SCHED;
            PG8_LDB(B1, 0, 1); PG8_STAGE(PG8_SB(0, 0), b2, voffB);
            PG8_BAR; PG8_WAIT_L(0); PG8_MMA(0, 1, At, B1); PG8_BAR;
            PG8_LDA(At, 0, 1); PG8_STAGE(PG8_SA(0, 0), a2, voffA);
            PG8_BAR; PG8_WAIT_L(0); PG8_MMA(1, 0, At, B0); PG8_BAR; PG8_SCHED;
            PG8_STAGE(PG8_SB(0, 1), b2 + hstep, voffB);
            PG8_WAIT_V(6); PG8_BAR; PG8_MMA(1, 1, At, B1); PG8_BAR;
            PG8_LDB(B0, 1, 0); PG8_SCHED; PG8_LDA(At, 1, 0); PG8_STAGE(PG8_SA(0, 1), a2 + hstep, voffA);
            PG8_WAIT_L(8); PG8_BAR; PG8_WAIT_L(0); PG8_MMA(0, 0, At, B0); PG8_BAR; PG8_SCHED;
            PG8_LDB(B1, 1, 1); PG8_STAGE(PG8_SB(1, 0), b3, voffB);
            PG8_BAR; PG8_WAIT_L(0); PG8_MMA(0, 1, At, B1); PG8_BAR;
            PG8_LDA(At, 1, 1); PG8_STAGE(PG8_SA(1, 0), a3, voffA);
            PG8_BAR; PG8_WAIT_L(0); PG8_MMA(1, 0, At, B0); PG8_BAR; PG8_SCHED;
            PG8_STAGE(PG8_SB(1, 1), b3 + hstep, voffB);
            PG8_WAIT_V(6); PG8_BAR; PG8_MMA(1, 1, At, B1); PG8_BAR;
        }
        PG8_STAMP();
        if constexpr (!Epi::AFTER_DRAIN) { E(acc, cur, wr, wc, fr, fq); S.done(cur); }
        PG8_STAMP();
        if (!has_next) break;
#pragma unroll
        for (int a = 0; a < 2; ++a)
#pragma unroll
            for (int b = 0; b < 2; ++b)
#pragma unroll
                for (int m = 0; m < 4; ++m)
#pragma unroll
                    for (int n = 0; n < 2; ++n) acc[a][b][m][n] = (f32x4){0.f, 0.f, 0.f, 0.f};
        cur = nxt; cA = nA; cB = nB; ++ui;
    }
    PG8_WAIT_V(0);
    if (wr == 0) PG8_BAR;
    PG8_BAR;
    if constexpr (Epi::AFTER_DRAIN) { E.fused(acc, cur, wr, wc, fr, fq, lds, wid, lane); S.done(cur); }
    PG8_STAMP();
    if (STAMP && wid == 0) { stamps[lane] = lane < nts ? (((unsigned long long)(unsigned)ts_hi << 32) | (unsigned)ts_lo) : 0ull;
        if (lane == 62) stamps[62] = rt_entry; if (lane == 63) stamps[63] = (unsigned long long)wall_clock64(); }
#undef PG8_STAMP
#undef PG8_SA
#undef PG8_SB
#undef PG8_STAGE
#undef PG8_LDA
#undef PG8_LDB
#undef PG8_MMA
#undef PG8_WAIT_V
#undef PG8_WAIT_L
#undef PG8_BAR
#undef PG8_SCHED
}
}

#define LAS __attribute__((address_space(3)))
#define GAS __attribute__((address_space(1)))
typedef unsigned short bf16_t;
typedef short bf16x8 __attribute__((ext_vector_type(8)));
typedef float f32x4 __attribute__((ext_vector_type(4)));
typedef float f32x2 __attribute__((ext_vector_type(2)));
typedef float f32x16 __attribute__((ext_vector_type(16)));
typedef unsigned u32x4 __attribute__((ext_vector_type(4)));
typedef unsigned u32x2 __attribute__((ext_vector_type(2)));

constexpr int DM = 2048, NBATCH = 4, SEQ = 4096, MROWS = NBATCH * SEQ, NMETA = 16, DIN = 6144, DLRU = 1024, NHEAD = 16;
constexpr int META0 = MROWS;
constexpr int RSTR = MROWS + 64;
constexpr float RMS_EPS = 1e-6f;
constexpr int NPHASE = 7;
#ifndef REP_MASK
#define REP_MASK 0
#endif
constexpr int LDS_BYTES = 131072 + 256;

constexpr size_t MiB = 1u << 20;
constexpr size_t WS_WTIN = 0;
constexpr size_t WS_WTOUT = 48 * MiB;
constexpr size_t WS_GW = 64 * MiB;
constexpr size_t WS_ROWSS = 65 * MiB;
constexpr size_t WS_BAR = 65 * MiB + 512 * 1024;
constexpr size_t WS_PCNT = WS_BAR + 16384;
constexpr size_t WS_AGG = 66 * MiB;
constexpr size_t WS_XB = 71 * MiB;
constexpr size_t WS_Y = 136 * MiB;
constexpr size_t WS_U = 201 * MiB;
constexpr size_t WS_END = 396 * MiB;
constexpr int AGG_PER_LAYER = 257 * 1024;
static_assert(WS_U + (size_t)RSTR * DIN * 2 <= WS_END && WS_Y + (size_t)RSTR * DM * 2 <= WS_U && WS_XB + (size_t)RSTR * DM * 2 <= WS_Y, "ws map");
static_assert(WS_WTIN + (size_t)2 * DIN * DM * 2 <= WS_WTOUT && WS_WTOUT + (size_t)2 * DM * DM * 2 <= WS_GW && WS_AGG + (size_t)2 * AGG_PER_LAYER * 8 <= WS_XB && WS_ROWSS + (size_t)3 * RSTR * 4 <= WS_BAR, "ws map 2");

struct Args { const float* in[14]; float* out; unsigned char* ws; int ph_lo, ph_hi, flags, pad; };

__device__ __forceinline__ unsigned f2bf(float f) { unsigned u = __builtin_bit_cast(unsigned, f); return (u + 0x7fffu + ((u >> 16) & 1u)) >> 16; }
__device__ __forceinline__ unsigned pk2(float lo, float hi) { return f2bf(lo) | (f2bf(hi) << 16); }
__device__ __forceinline__ float bflo(unsigned w) { return __builtin_bit_cast(float, w << 16); }
__device__ __forceinline__ float bfhi(unsigned w) { return __builtin_bit_cast(float, w & 0xffff0000u); }
__device__ __forceinline__ float bf1(bf16_t v) { return __builtin_bit_cast(float, ((unsigned)v) << 16); }
__device__ __forceinline__ float sigmoidf_(float z) { return __builtin_amdgcn_rcpf(1.0f + __expf(-z)); }
__device__ __forceinline__ float wave_sum(float v) {
#pragma unroll
    for (int o = 1; o < 64; o <<= 1) v += __shfl_xor(v, o);
    return v;
}
#define LDS_WAIT() asm volatile("s_waitcnt lgkmcnt(0)" ::: "memory")

struct EpiU {
    static constexpr bool PERM = true, AFTER_DRAIN = false;
    bf16_t* O; const float* rowss;
    __device__ __forceinline__ void operator()(const f32x4 (&acc)[2][2][4][2], const pg8::Unit& u, int wr, int wc, int fr, int fq) const {
        const int row0 = u.pm * 256 + wr * 64 + fr, col0 = u.pn * 256 + wc * 32 + 8 * fq;
#pragma unroll
        for (int ai = 0; ai < 2; ++ai)
#pragma unroll
            for (int m = 0; m < 4; ++m) {
                const int r = row0 + ai * 128 + m * 16;
                const float rs = rsqrtf(rowss[r] * (1.0f / DM) + RMS_EPS);
                bf16_t* rowp = O + (size_t)r * DIN + col0;
#pragma unroll
                for (int bj = 0; bj < 2; ++bj) {
                    const f32x4 v0 = acc[ai][bj][m][0] * rs, v1 = acc[ai][bj][m][1] * rs;
                    u32x4 w; w.x = pg8::cvt_pk_bf16(v0[0], v0[1]); w.y = pg8::cvt_pk_bf16(v0[2], v0[3]); w.z = pg8::cvt_pk_bf16(v1[0], v1[1]); w.w = pg8::cvt_pk_bf16(v1[2], v1[3]);
                    *(u32x4*)(rowp + bj * 128) = w;
                }
            }
    }
};
#ifndef EPI_MB
#define EPI_MB 2
#endif
struct EpiRes {
    static constexpr bool PERM = true, AFTER_DRAIN = false;
    const float* res; float* out; bf16_t* xb; float* rowss;
    __device__ __forceinline__ void operator()(const f32x4 (&acc)[2][2][4][2], const pg8::Unit& u, int wr, int wc, int fr, int fq) const {
        const int row0 = u.pm * 256 + wr * 64 + fr, col0 = u.pn * 256 + wc * 32 + 8 * fq;
#pragma unroll
        for (int ai = 0; ai < 2; ++ai) {
#pragma unroll
          for (int mh = 0; mh < 4; mh += EPI_MB) {
            f32x4 rv[4][2][2];
#pragma unroll
            for (int m = mh; m < mh + EPI_MB; ++m)
#pragma unroll
                for (int bj = 0; bj < 2; ++bj) { const float* p = res + (size_t)(row0 + ai * 128 + m * 16) * DM + col0 + bj * 128; rv[m][bj][0] = *(const f32x4*)p; rv[m][bj][1] = *(const f32x4*)(p + 4); }
            asm volatile("" ::: "memory");
#pragma unroll
            for (int m = mh; m < mh + EPI_MB; ++m) {
                const int r = row0 + ai * 128 + m * 16; const size_t off = (size_t)r * DM + col0; float ss = 0.f;
#pragma unroll
                for (int bj = 0; bj < 2; ++bj) {
                    const f32x4 h0 = rv[m][bj][0] + acc[ai][bj][m][0], h1 = rv[m][bj][1] + acc[ai][bj][m][1];
                    *(f32x4*)(out + off + bj * 128) = h0; *(f32x4*)(out + off + bj * 128 + 4) = h1;
                    if (xb) { u32x4 w; w.x = pg8::cvt_pk_bf16(h0[0], h0[1]); w.y = pg8::cvt_pk_bf16(h0[2], h0[3]); w.z = pg8::cvt_pk_bf16(h1[0], h1[1]); w.w = pg8::cvt_pk_bf16(h1[2], h1[3]);
                        *(u32x4*)(xb + off + bj * 128) = w; }
                    ss += (h0[0] * h0[0] + h0[1] * h0[1]) + (h0[2] * h0[2] + h0[3] * h0[3]) + (h1[0] * h1[0] + h1[1] * h1[1]) + (h1[2] * h1[2] + h1[3] * h1[3]);
                }
                ss += __shfl_xor(ss, 16); ss += __shfl_xor(ss, 32);
                if (fq == 0) unsafeAtomicAdd(rowss + r, ss);
            }
            asm volatile("" ::: "memory");
          }
        }
    }
};

struct EpiResNorm {
    static constexpr bool PERM = true, AFTER_DRAIN = false;
    const float* res; float* out; float* rowss; unsigned* cnt; const float* fg;
    __device__ __forceinline__ void operator()(f32x4 (&acc)[2][2][4][2], const pg8::Unit& u, int wr, int wc, int fr, int fq) const {
        const int row0 = u.pm * 256 + wr * 64 + fr, col0 = u.pn * 256 + wc * 32 + 8 * fq;
#pragma unroll
        for (int ai = 0; ai < 2; ++ai) {
#pragma unroll
          for (int mh = 0; mh < 4; mh += EPI_MB) {
            f32x4 rv[4][2][2];
#pragma unroll
            for (int m = mh; m < mh + EPI_MB; ++m)
#pragma unroll
                for (int bj = 0; bj < 2; ++bj) { const float* p = res + (size_t)(row0 + ai * 128 + m * 16) * DM + col0 + bj * 128; rv[m][bj][0] = *(const f32x4*)p; rv[m][bj][1] = *(const f32x4*)(p + 4); }
            asm volatile("" ::: "memory");
#pragma unroll
            for (int m = mh; m < mh + EPI_MB; ++m) {
                float ss = 0.f;
#pragma unroll
                for (int bj = 0; bj < 2; ++bj) {
                    const f32x4 h0 = rv[m][bj][0] + acc[ai][bj][m][0], h1 = rv[m][bj][1] + acc[ai][bj][m][1];
                    acc[ai][bj][m][0] = h0; acc[ai][bj][m][1] = h1;
                    ss += (h0[0] * h0[0] + h0[1] * h0[1]) + (h0[2] * h0[2] + h0[3] * h0[3]) + (h1[0] * h1[0] + h1[1] * h1[1]) + (h1[2] * h1[2] + h1[3] * h1[3]);
                }
                ss += __shfl_xor(ss, 16); ss += __shfl_xor(ss, 32);
                if (fq == 0) unsafeAtomicAdd(rowss + row0 + ai * 128 + m * 16, ss);
            }
            asm volatile("" ::: "memory");
          }
        }
        asm volatile("s_waitcnt vmcnt(0)" ::: "memory");
        unsigned* cw = cnt + 64 * (2 * u.pm + wr);
        if (fr == 0 && fq == 0) __hip_atomic_fetch_add(cw, 1u, __ATOMIC_RELAXED, __HIP_MEMORY_SCOPE_AGENT);
        f32x4 gv[2][2];
#pragma unroll
        for (int bj = 0; bj < 2; ++bj) { gv[bj][0] = *(const f32x4*)(fg + col0 + bj * 128); gv[bj][1] = *(const f32x4*)(fg + col0 + bj * 128 + 4); }
        { unsigned sp = 0;
          while ((unsigned)__builtin_amdgcn_readfirstlane(__hip_atomic_load(cw, __ATOMIC_RELAXED, __HIP_MEMORY_SCOPE_AGENT)) < 32u) { __builtin_amdgcn_s_sleep(1); if (++sp > (1u << 16)) break; } }
        asm volatile("" ::: "memory");
#pragma unroll
        for (int ai = 0; ai < 2; ++ai)
#pragma unroll
            for (int m = 0; m < 4; ++m) {
                const int r = row0 + ai * 128 + m * 16;
                const float rs = rsqrtf(__hip_atomic_load(rowss + r, __ATOMIC_RELAXED, __HIP_MEMORY_SCOPE_AGENT) * (1.0f / DM) + RMS_EPS);
                float* op = out + (size_t)r * DM + col0;
#pragma unroll
                for (int bj = 0; bj < 2; ++bj) { *(f32x4*)(op + bj * 128) = acc[ai][bj][m][0] * rs * gv[bj][0]; *(f32x4*)(op + bj * 128 + 4) = acc[ai][bj][m][1] * rs * gv[bj][1]; }
            }
    }
};
struct PanelOrder {
    int Gp, v;
    __device__ void init(int G, int c) { Gp = G & ~7; v = c; if ((Gp & 63) == 0) v = (c & 7) * (Gp >> 3) + (c >> 3); if (c >= Gp) v = -1; }
    __device__ bool next(int i, pg8::Unit& u) const { if (v < 0) return false; const long L = (long)i * Gp + v; if (L >= 64 * 8) return false; u.pm = (int)(L >> 3); u.pn = (int)(L & 7); return true; }
    __device__ __forceinline__ void a_ready(const pg8::Unit&) const {}
    __device__ __forceinline__ void done(const pg8::Unit&) const {}
};

template <class F> __device__ __forceinline__ void meta_gemm(const bf16_t* A, const bf16_t* Bt, int ngroups, LAS unsigned char* lds, int wid, int lane, F epi) {
    const int fr = lane & 15, fq = lane >> 4;
    LAS f32x4* red = (LAS f32x4*)lds;
    for (int g = blockIdx.x; g < ngroups; g += gridDim.x) {
        f32x4 acc = {0.f, 0.f, 0.f, 0.f};
        const bf16_t* ap = A + (size_t)fr * DM + wid * 256 + fq * 8;
        const bf16_t* bp = Bt + (size_t)(g * 16 + fr) * DM + wid * 256 + fq * 8;
#pragma unroll
        for (int s = 0; s < 8; ++s) {
            const bf16x8 a = *(const bf16x8*)(ap + 32 * s), b = *(const bf16x8*)(bp + 32 * s);
            acc = __builtin_amdgcn_mfma_f32_16x16x32_bf16(b, a, acc, 0, 0, 0);
        }
        red[wid * 64 + lane] = acc;
        __syncthreads();
        if (wid == 0) {
            f32x4 s = red[lane];
#pragma unroll
            for (int w = 1; w < 8; ++w) s += red[w * 64 + lane];
            epi(fr, g * 16 + 4 * fq, s);
        }
        __syncthreads();
    }
}

__device__ __forceinline__ void tr_item(const float* W, int K, int N, bf16_t* WT, const float* sc, LAS unsigned char* scr, int item, int lane) {
    const int nblk = N / 64, kb = item / nblk, nb = item % nblk, k0 = 64 * kb, n0 = 64 * nb;
    const int kr = lane >> 4, nc = (lane & 15) * 4;
    f32x4 v[16]; float g[16];
    { const float* p = W + (size_t)(k0 + kr) * N + n0 + nc;
#pragma unroll
      for (int i = 0; i < 16; ++i) { v[i] = *(const f32x4*)p; p += (size_t)4 * N; }
#pragma unroll
      for (int i = 0; i < 16; ++i) g[i] = sc ? sc[k0 + kr + 4 * i] : 1.0f; }
    asm volatile("" ::: "memory");
#pragma unroll
    for (int i = 0; i < 16; ++i) { const f32x4 s = v[i] * g[i]; u32x2 w; w.x = pg8::cvt_pk_bf16(s[0], s[1]); w.y = pg8::cvt_pk_bf16(s[2], s[3]);
        *(LAS u32x2*)(scr + (kr + 4 * i) * 136 + nc * 2) = w; }
    LDS_WAIT();
    const int c = lane & 7;
#pragma unroll
    for (int j = 0; j < 8; ++j) { const int n = (lane >> 3) + 8 * j; const LAS bf16_t* s = (const LAS bf16_t*)(scr + (8 * c) * 136 + n * 2);
        u32x4 o; o.x = (unsigned)s[0] | ((unsigned)s[68] << 16); o.y = (unsigned)s[2 * 68] | ((unsigned)s[3 * 68] << 16); o.z = (unsigned)s[4 * 68] | ((unsigned)s[5 * 68] << 16); o.w = (unsigned)s[6 * 68] | ((unsigned)s[7 * 68] << 16);
        *(u32x4*)(WT + (size_t)(n0 + n) * K + k0 + 8 * c) = o; }
    LDS_WAIT();
}
__device__ __forceinline__ void cvt_row(const float* src, bf16_t* dst, float* ss, int lane) {
    const f32x4* xr = (const f32x4*)src + lane; f32x4 v[8]; float s = 0.f;
#pragma unroll
    for (int j = 0; j < 8; ++j) { v[j] = xr[64 * j]; s += (v[j].x * v[j].x + v[j].y * v[j].y) + (v[j].z * v[j].z + v[j].w * v[j].w); }
    s = wave_sum(s);
    u32x2* o8 = (u32x2*)dst + lane;
#pragma unroll
    for (int j = 0; j < 8; ++j) { u32x2 w; w.x = pk2(v[j].x, v[j].y); w.y = pk2(v[j].z, v[j].w); o8[64 * j] = w; }
    if (lane == 0) *ss = s;
}

struct Mix {
    const float *conv_a_w, *conv_a_b, *lru_br, *lru_bi, *lru_lambda, *conv_b_w;
    const bf16_t* gw;
    bf16_t* U; bf16_t* Y; unsigned long long* AGG;
};
struct ItemId { int hd, b, c, row0, ntok, agg; bool meta; };
__device__ __forceinline__ ItemId decode_item(int id) {
    ItemId I;
    if (id < 16) { I.meta = true; I.hd = id; I.b = 0; I.c = 0; I.row0 = META0; I.ntok = 16; I.agg = 256; }
    else { const int j = id - 16; I.meta = false; I.hd = j & 15; I.c = (j >> 4) & 63; I.b = j >> 10; I.row0 = I.b * SEQ + I.c * 64; I.ntok = 64; I.agg = I.b * 64 + I.c; }
    return I;
}
constexpr int N_ITEMS = 16 + NBATCH * NHEAD * 64;

__device__ __forceinline__ bool agg_ok(unsigned long long v) { return (unsigned)v != 0u; }
__device__ __forceinline__ void mix_item(const Mix& X, int id, LAS unsigned char* xt, int lane) {
    constexpr float LOG2E = 1.4426950408889634f;
    const ItemId I = decode_item(id);
    const int ch = I.hd * 64 + lane;
    const float nls2 = -8.0f * LOG2E * log1pf(__expf(-X.lru_lambda[ch]));
    bf16_t raw[64], rh0 = 0, rh1 = 0, rh2 = 0;
    const float w0 = X.conv_a_w[ch], w1 = X.conv_a_w[1024 + ch], w2 = X.conv_a_w[2048 + ch], w3 = X.conv_a_w[3072 + ch], cb = X.conv_a_b[ch];
    {
        const GAS bf16_t* sb = (const GAS bf16_t*)(X.U + (size_t)I.row0 * DIN + I.hd * 64);
        if (!I.meta) { const GAS bf16_t* hp0 = (I.c == 0) ? (const GAS bf16_t*)(X.U + (size_t)(META0 + 13) * DIN + I.hd * 64) : sb - 3 * DIN; rh0 = hp0[lane]; rh1 = hp0[DIN + lane]; rh2 = hp0[2 * DIN + lane]; }
#pragma unroll
        for (int t = 0; t < 64; ++t) { raw[t] = sb[lane]; if (t < 15 || !I.meta) sb += DIN; asm volatile("" : "+s"(sb)); }
    }
    bf16x8 BfR0[4], BfR1[4], BfI0[4], BfI1[4];
    { const bf16_t* gr = X.gw + (size_t)(I.hd * 64 + (lane & 31)) * 64 + 8 * (lane >> 5); const bf16_t* gi = gr + 16 * 64 * 64;
#pragma unroll
      for (int s = 0; s < 4; ++s) { BfR0[s] = *(const bf16x8*)(gr + 16 * s); BfR1[s] = *(const bf16x8*)(gr + 32 * 64 + 16 * s); BfI0[s] = *(const bf16x8*)(gi + 16 * s); BfI1[s] = *(const bf16x8*)(gi + 32 * 64 + 16 * s); } }
    asm volatile("" ::: "memory");
    float xm3 = bf1(rh0), xm2 = bf1(rh1), xm1 = bf1(rh2);
#pragma unroll
    for (int t = 0; t < 64; ++t) { const float x0 = bf1(raw[t]); const float xc = cb + w0 * xm3 + w1 * xm2 + w2 * xm1 + w3 * x0; xm3 = xm2; xm2 = xm1; xm1 = x0;
        *(LAS bf16_t*)(xt + t * 144 + lane * 2) = (bf16_t)f2bf(xc); }
    const float brA = X.lru_br[I.hd * 64 + (lane & 31)], brB = X.lru_br[I.hd * 64 + 32 + (lane & 31)], biA = X.lru_bi[I.hd * 64 + (lane & 31)], biB = X.lru_bi[I.hd * 64 + 32 + (lane & 31)];
    float h = 0.f, P = 1.f, h15 = 0.f, P15 = 1.f;
    unsigned hp[64];
#pragma unroll
    for (int tb = 0; tb < 2; ++tb) {
        f32x16 aR0, aR1, aI0, aI1;
#pragma unroll
        for (int e = 0; e < 16; ++e) { aR0[e] = brA; aR1[e] = brB; aI0[e] = biA; aI1[e] = biB; }
#pragma unroll
        for (int s = 0; s < 4; ++s) {
            const bf16x8 af = *(const LAS bf16x8*)(xt + (tb * 32 + (lane & 31)) * 144 + (16 * s + 8 * (lane >> 5)) * 2);
            aR0 = __builtin_amdgcn_mfma_f32_32x32x16_bf16(af, BfR0[s], aR0, 0, 0, 0);
            aR1 = __builtin_amdgcn_mfma_f32_32x32x16_bf16(af, BfR1[s], aR1, 0, 0, 0);
            aI0 = __builtin_amdgcn_mfma_f32_32x32x16_bf16(af, BfI0[s], aI0, 0, 0, 0);
            aI1 = __builtin_amdgcn_mfma_f32_32x32x16_bf16(af, BfI1[s], aI1, 0, 0, 0);
        }
#pragma unroll
        for (int q = 0; q < 4; ++q) {
            float Rv[2][4], Iv[2][4];
#pragma unroll
            for (int k = 0; k < 4; ++k) {
                const int reg = 4 * q + k;
                const float r0f = aR0[reg], r1f = aR1[reg], i0f = aI0[reg], i1f = aI1[reg];
                auto r = __builtin_amdgcn_permlane32_swap(__float_as_uint(r0f), __float_as_uint(r1f), false, false);
                Rv[0][k] = __uint_as_float(r[0]); Rv[1][k] = __uint_as_float(r[1]);
                auto i2 = __builtin_amdgcn_permlane32_swap(__float_as_uint(i0f), __float_as_uint(i1f), false, false);
                Iv[0][k] = __uint_as_float(i2[0]); Iv[1][k] = __uint_as_float(i2[1]);
            }
#pragma unroll
            for (int st = 0; st < 2; ++st)
#pragma unroll
                for (int p = 0; p < 2; ++p) {
                    const int t = tb * 32 + 8 * q + 4 * st + 2 * p;
                    f32x2 er = (f32x2){Rv[st][2 * p], Rv[st][2 * p + 1]} * (-LOG2E), ei = (f32x2){Iv[st][2 * p], Iv[st][2 * p + 1]} * (-LOG2E);
                    er.x = __builtin_amdgcn_exp2f(er.x); er.y = __builtin_amdgcn_exp2f(er.y); ei.x = __builtin_amdgcn_exp2f(ei.x); ei.y = __builtin_amdgcn_exp2f(ei.y);
                    er = er + 1.0f; ei = ei + 1.0f;
                    f32x2 rg, ig; rg.x = __builtin_amdgcn_rcpf(er.x); rg.y = __builtin_amdgcn_rcpf(er.y); ig.x = __builtin_amdgcn_rcpf(ei.x); ig.y = __builtin_amdgcn_rcpf(ei.y);
                    const f32x2 l2 = rg * nls2;
                    f32x2 a; a.x = __builtin_amdgcn_exp2f(l2.x); a.y = __builtin_amdgcn_exp2f(l2.y);
                    f32x2 om = 1.0f - a * a; om.x = fmaxf(om.x, 0.f); om.y = fmaxf(om.y, 0.f);
                    f32x2 mu; mu.x = __builtin_amdgcn_sqrtf(om.x); mu.y = __builtin_amdgcn_sqrtf(om.y);
                    const f32x2 xc = (f32x2){bf1(*(const LAS bf16_t*)(xt + t * 144 + lane * 2)), bf1(*(const LAS bf16_t*)(xt + (t + 1) * 144 + lane * 2))};
                    const f32x2 bb = mu * ig * xc;
                    h = a.x * h + bb.x; P = P * a.x; hp[t] = pg8::cvt_pk_bf16(h, P);
                    h = a.y * h + bb.y; P = P * a.y; hp[t + 1] = pg8::cvt_pk_bf16(h, P);
                    if (t + 1 == 15) { h15 = h; P15 = P; }
                }
        }
    }
    if (I.meta) { h = h15; P = P15; }
    __hip_atomic_store(X.AGG + (size_t)I.agg * 1024 + ch, ((unsigned long long)__float_as_uint(h) << 32) | (unsigned long long)__float_as_uint(P), __ATOMIC_RELAXED, __HIP_MEMORY_SCOPE_AGENT);
    asm volatile("" ::: "memory");
    bf16_t graw[64];
    { const GAS bf16_t* sb = (const GAS bf16_t*)(X.U + (size_t)I.row0 * DIN + 1024 + I.hd * 64);
#pragma unroll
      for (int t = 0; t < 64; ++t) { graw[t] = sb[lane]; if (t < 15 || !I.meta) sb += DIN; asm volatile("" : "+s"(sb)); } }
    float hin = 0.f;
    if (!I.meta) {
        { const unsigned long long* mp = X.AGG + (size_t)256 * 1024 + ch; unsigned long long v;
          for (;;) { v = __hip_atomic_load(mp, __ATOMIC_RELAXED, __HIP_MEMORY_SCOPE_AGENT); if (!__any(!agg_ok(v))) break; __builtin_amdgcn_s_sleep(2); }
          hin = __uint_as_float((unsigned)(v >> 32)); }
        const unsigned long long* ap = X.AGG + (size_t)(I.b * 64) * 1024 + ch;
        for (int j0 = 0; j0 < I.c; j0 += 16) {
            unsigned long long v[16];
            for (;;) {
                bool bad = false;
#pragma unroll
                for (int k = 0; k < 16; ++k) { v[k] = (j0 + k < I.c) ? __hip_atomic_load(ap + (size_t)(j0 + k) * 1024, __ATOMIC_RELAXED, __HIP_MEMORY_SCOPE_AGENT) : 0x000000003f800000ull; }
#pragma unroll
                for (int k = 0; k < 16; ++k) bad |= !agg_ok(v[k]);
                if (!__any(bad)) break;
                __builtin_amdgcn_s_sleep(2);
            }
#pragma unroll
            for (int k = 0; k < 16; ++k) hin = __uint_as_float((unsigned)v[k]) * hin + __uint_as_float((unsigned)(v[k] >> 32));
        }
    }
    asm volatile("" ::: "memory");
    GAS bf16_t* yp = (GAS bf16_t*)(X.Y + (size_t)I.row0 * DM + I.hd * 64);
#pragma unroll
    for (int t0 = 0; t0 < 64; t0 += 16) {
        if (t0 < I.ntok) {
#pragma unroll
            for (int k = 0; k < 16; k += 2) {
                const unsigned w0 = hp[t0 + k], w1 = hp[t0 + k + 1];
                const f32x2 gg = (f32x2){bf1(graw[t0 + k]), bf1(graw[t0 + k + 1])};
                f32x2 e = gg * (-LOG2E); e.x = __builtin_amdgcn_exp2f(e.x); e.y = __builtin_amdgcn_exp2f(e.y); e = e + 1.0f;
                f32x2 sg; sg.x = __builtin_amdgcn_rcpf(e.x); sg.y = __builtin_amdgcn_rcpf(e.y);
                const f32x2 hv = (f32x2){bflo(w0), bflo(w1)} + (f32x2){bfhi(w0), bfhi(w1)} * hin;
                const f32x2 y = hv * gg * sg;
                const unsigned pk = pg8::cvt_pk_bf16(y.x, y.y);
                yp[lane] = (bf16_t)(pk & 0xffffu); yp[DM + lane] = (bf16_t)(pk >> 16); yp += 2 * DM; asm volatile("" : "+s"(yp));
            }
        }
    }
}

__device__ __forceinline__ void ld8(const bf16_t* p, float (&o)[8]) {
    const u32x4 w = *(const u32x4*)p;
    o[0] = bflo(w.x); o[1] = bfhi(w.x); o[2] = bflo(w.y); o[3] = bfhi(w.y); o[4] = bflo(w.z); o[5] = bfhi(w.z); o[6] = bflo(w.w); o[7] = bfhi(w.w);
}
__device__ __forceinline__ void partb(const Mix& X, int tid) {
    for (int it = blockIdx.x * 512 + tid; it < 1025 * 128; it += gridDim.x * 512) {
        const int c0 = (it & 127) * 8, run = it >> 7;
        int row0, hrow = -1;
        if (run == 1024) row0 = META0; else { row0 = run * 16; hrow = ((row0 & (SEQ - 1)) == 0) ? META0 + 14 : row0 - 2; }
        float w0[8], w1[8], w2[8], cm2[8], cm1[8];
        { const f32x4* p = (const f32x4*)(X.conv_b_w + c0); const f32x4 a0 = p[0], a1 = p[1], b0 = p[256], b1 = p[257], d0 = p[512], d1 = p[513];
#pragma unroll
          for (int e = 0; e < 4; ++e) { w0[e] = a0[e]; w0[4 + e] = a1[e]; w1[e] = b0[e]; w1[4 + e] = b1[e]; w2[e] = d0[e]; w2[4 + e] = d1[e]; } }
        if (hrow >= 0) {
            float c[8], x[8];
            ld8(X.U + (size_t)hrow * DIN + 3072 + c0, c); ld8(X.U + (size_t)hrow * DIN + 4096 + c0, x);
#pragma unroll
            for (int e = 0; e < 8; ++e) cm2[e] = c[e] * x[e];
            ld8(X.U + (size_t)(hrow + 1) * DIN + 3072 + c0, c); ld8(X.U + (size_t)(hrow + 1) * DIN + 4096 + c0, x);
#pragma unroll
            for (int e = 0; e < 8; ++e) cm1[e] = c[e] * x[e];
        } else {
#pragma unroll
            for (int e = 0; e < 8; ++e) { cm2[e] = 0.f; cm1[e] = 0.f; }
        }
        const bf16_t* up = X.U + (size_t)row0 * DIN + c0;
        bf16_t* yp = X.Y + (size_t)row0 * DM + 1024 + c0;
#pragma unroll 4
        for (int t = 0; t < 16; ++t) {
            float bv[8], cv[8], xv[8], gv[8];
            ld8(up + (size_t)t * DIN + 2048, bv); ld8(up + (size_t)t * DIN + 3072, cv); ld8(up + (size_t)t * DIN + 4096, xv); ld8(up + (size_t)t * DIN + 5120, gv);
            float o[8];
#pragma unroll
            for (int e = 0; e < 8; ++e) { const float cx = cv[e] * xv[e]; const float y = w0[e] * cm2[e] + w1[e] * cm1[e] + w2[e] * cx; o[e] = bv[e] * y * (gv[e] * sigmoidf_(gv[e])); cm2[e] = cm1[e]; cm1[e] = cx; }
            u32x4 w; w.x = pk2(o[0], o[1]); w.y = pk2(o[2], o[3]); w.z = pk2(o[4], o[5]); w.w = pk2(o[6], o[7]);
            *(u32x4*)(yp + (size_t)t * DM) = w;
        }
    }
}


#ifdef DEBUG_NAIVE_MIX
__global__ void __launch_bounds__(64) naive_mixA(Mix X, const float* wr, const float* wi) {
    const int b = blockIdx.x / 16, hd = blockIdx.x % 16, lane = threadIdx.x, ch = hd * 64 + lane;
    __shared__ float xs[64];
    const float w0 = X.conv_a_w[ch], w1 = X.conv_a_w[1024 + ch], w2 = X.conv_a_w[2048 + ch], w3 = X.conv_a_w[3072 + ch], cb = X.conv_a_b[ch];
    const float br = X.lru_br[ch], bi = X.lru_bi[ch];
    const float sp = log1pf(expf(-X.lru_lambda[ch]));
    const float* wrh = wr + (size_t)hd * 4096 + lane; const float* wih = wi + (size_t)hd * 4096 + lane;
    float h = 0.f, xm3 = 0.f, xm2 = 0.f, xm1 = 0.f;
    for (int p = 0; p < NMETA + SEQ; ++p) {
        const int row = p < NMETA ? META0 + p : b * SEQ + (p - NMETA);
        const float x0 = bf1(X.U[(size_t)row * DIN + ch]);
        const float xc = cb + w0 * xm3 + w1 * xm2 + w2 * xm1 + w3 * x0; xm3 = xm2; xm2 = xm1; xm1 = x0;
        xs[lane] = xc; __syncthreads();
        float rp = br, ip = bi;
#pragma unroll 4
        for (int i = 0; i < 64; ++i) { rp += xs[i] * wrh[i * 64]; ip += xs[i] * wih[i * 64]; }
        __syncthreads();
        const float r = 1.f / (1.f + expf(-rp)), ig = 1.f / (1.f + expf(-ip));
        const float la = -8.f * r * sp; const float a = expf(la); const float bb = sqrtf(-expm1f(2.f * la)) * (ig * xc);
        h = a * h + bb;
        const float g = bf1(X.U[(size_t)row * DIN + 1024 + ch]);
        const float y = h * g / (1.f + expf(-g));
        if (p >= NMETA || b == 0) X.Y[(size_t)row * DM + ch] = (bf16_t)f2bf(y);
    }
}
__global__ void naive_mixB(Mix X) {
    for (size_t idx = (size_t)blockIdx.x * blockDim.x + threadIdx.x; idx < (size_t)(MROWS + NMETA) * 1024; idx += (size_t)gridDim.x * blockDim.x) {
        const int row = (int)(idx >> 10), c = (int)(idx & 1023);
        int r1, r2;
        if (row >= META0) { const int p = row - META0; r1 = p >= 1 ? row - 1 : -1; r2 = p >= 2 ? row - 2 : -1; }
        else { const int t = row & (SEQ - 1); r1 = t >= 1 ? row - 1 : META0 + 15; r2 = t >= 2 ? row - 2 : META0 + 14 + t; }
        auto cx = [&](int r) -> float { return r < 0 ? 0.f : bf1(X.U[(size_t)r * DIN + 3072 + c]) * bf1(X.U[(size_t)r * DIN + 4096 + c]); };
        const float y = X.conv_b_w[c] * cx(r2) + X.conv_b_w[1024 + c] * cx(r1) + X.conv_b_w[2048 + c] * cx(row);
        const float bv = bf1(X.U[(size_t)row * DIN + 2048 + c]), g = bf1(X.U[(size_t)row * DIN + 5120 + c]);
        X.Y[(size_t)row * DM + 1024 + c] = (bf16_t)f2bf(bv * y * g / (1.f + expf(-g)));
    }
}
#endif
#define XB_TMO      128
#define XB_XCNT(j)  (256  + 64 * (j))
#define XB_XSUB(j)  (1280 + 64 * (j))
#define XB_XGEN(j)  (2304 + 64 * (j))
#define XB_TOP      3328
#define XB_TOPGEN   3392
#define XCD_BAR_WORDS 3456
#define XB_SPIN_CAP (1u << 18)

__device__ __forceinline__ unsigned xb_ld(unsigned* p)              { return __hip_atomic_load(p, __ATOMIC_RELAXED, __HIP_MEMORY_SCOPE_AGENT); }
__device__ __forceinline__ unsigned xb_add(unsigned* p, unsigned v) { return __hip_atomic_fetch_add(p, v, __ATOMIC_RELAXED, __HIP_MEMORY_SCOPE_AGENT); }
__device__ __forceinline__ unsigned xb_xcc_id() { return (unsigned)__builtin_amdgcn_s_getreg((3 << 11) | 20) & 0xFu; }
#define XB_SPIN(cond, bar) do { unsigned _sp = 0; while (cond) { __builtin_amdgcn_s_sleep(1); \
    if ((++_sp & 255u) == 0u) { if (xb_ld(&(bar)[XB_TMO])) break; if (_sp > XB_SPIN_CAP) { atomicAdd(&(bar)[XB_TMO], 1u); break; } } } } while (0)

struct XcdBarrier {
    unsigned* bar; unsigned x;
    volatile LAS unsigned* st;
};

__device__ __forceinline__ XcdBarrier xcd_barrier_post(unsigned* bar, volatile LAS unsigned* st) {
    XcdBarrier b; b.bar = bar; b.x = xb_xcc_id(); b.st = st;
    if (threadIdx.x == 0) (void)xb_add(&bar[XB_XCNT(b.x)], 1u);
    return b;
}
__device__ __forceinline__ void xcd_barrier_complete(unsigned* bar, unsigned x, unsigned& nloc, unsigned& nx) {
    const unsigned G = gridDim.x * gridDim.y * gridDim.z;
    unsigned sum, cnt, mine, sp = 0u;
    for (;;) {
        sum = 0u; cnt = 0u; mine = 0u;
#pragma unroll
        for (unsigned j = 0; j < 16; ++j) { const unsigned c = xb_ld(&bar[XB_XCNT(j)]); sum += c; cnt += (c > 0u) ? 1u : 0u; mine = (j == x) ? c : mine; }
        if (sum == G) break;
        __builtin_amdgcn_s_sleep(1);
        if ((++sp & 255u) == 0u) { if (xb_ld(&bar[XB_TMO])) break; if (sp > XB_SPIN_CAP) { atomicAdd(&bar[XB_TMO], 1u); break; } }
    }
    nloc = mine > 0u ? mine : 1u; nx = cnt > 0u ? cnt : 1u;
}

__device__ __forceinline__ void xcd_barrier(const XcdBarrier& b) {
    asm volatile("s_waitcnt vmcnt(0)" ::: "memory");
    __syncthreads();
    if (threadIdx.x == 0) {
        unsigned* bar = b.bar;
        __builtin_amdgcn_s_waitcnt(0);
        unsigned nloc = b.st[0], nx = b.st[1];
        if (nloc == 0u) { xcd_barrier_complete(bar, b.x, nloc, nx); b.st[0] = nloc; b.st[1] = nx; }
        const unsigned old = xb_add(&bar[XB_XSUB(b.x)], 1u);
        const unsigned gen = old / nloc;
        if (old + 1u == (gen + 1u) * nloc) {
            __builtin_amdgcn_fence(__ATOMIC_RELEASE, "agent");
            asm volatile("s_waitcnt vmcnt(0)" ::: "memory");
            const unsigned og = xb_add(&bar[XB_TOP], 1u);
            const unsigned tg = og / nx;
            if (og + 1u == (tg + 1u) * nx) xb_add(&bar[XB_TOPGEN], 1u);
            else XB_SPIN(xb_ld(&bar[XB_TOPGEN]) == tg, bar);
            __builtin_amdgcn_fence(__ATOMIC_ACQUIRE, "agent");
            xb_add(&bar[XB_XGEN(b.x)], 1u);
            asm volatile("s_waitcnt vmcnt(0)" ::: "memory");
        } else {
            XB_SPIN(xb_ld(&bar[XB_XGEN(b.x)]) == gen, bar);
            __builtin_amdgcn_fence(__ATOMIC_ACQUIRE, "agent");
            asm volatile("s_waitcnt vmcnt(0)" ::: "memory");
        }
    }
    __syncthreads();
}

__global__ void __launch_bounds__(512, 2) hymba_fwd(Args a) {
    extern __shared__ __attribute__((aligned(16))) unsigned char lds_raw[];
    LAS unsigned char* lds = (LAS unsigned char*)lds_raw;
    cg::grid_group grid = cg::this_grid();
    const int NGW = gridDim.x * 8;
    if (threadIdx.x < 64) ((LAS unsigned*)(lds + 131072))[threadIdx.x] = 0u;
    __syncthreads();
    XcdBarrier xbar; xbar.bar = (unsigned*)(a.ws + WS_BAR); xbar.x = 0; xbar.st = nullptr;
    if (a.ph_hi - a.ph_lo > 1) xbar = xcd_barrier_post((unsigned*)(a.ws + WS_BAR), (volatile LAS unsigned*)(lds + 131072));
    if (a.ph_lo < 0) grid.sync();
#define LAUNDER() int tid = threadIdx.x; asm volatile("" : "+v"(tid)); const int wid = __builtin_amdgcn_readfirstlane(tid >> 6), lane = tid & 63, gw = blockIdx.x * 8 + wid
    const int lo = a.ph_lo, hi = a.ph_hi;
#define IN(k) (lo <= (k) && (k) < hi)
#define SEAM(k) do { if (IN(k) && IN((k) + 1)) { xcd_barrier(xbar); if ((REP_MASK >> 10) & 1) { xcd_barrier(xbar); xcd_barrier(xbar); } } } while (0)
    const float* x = a.in[0]; const float* meta = a.in[1]; const float* norm_g = a.in[2]; const float* w_in = a.in[3];
    const float* conv_a_w = a.in[4]; const float* conv_a_b = a.in[5]; const float* lru_wr = a.in[6]; const float* lru_br = a.in[7];
    const float* lru_wi = a.in[8]; const float* lru_bi = a.in[9]; const float* lru_lambda = a.in[10]; const float* conv_b_w = a.in[11];
    const float* w_out = a.in[12]; const float* final_g = a.in[13];
    unsigned char* ws = a.ws;
    bf16_t* WTIN = (bf16_t*)(ws + WS_WTIN); bf16_t* WTOUT = (bf16_t*)(ws + WS_WTOUT); bf16_t* GW = (bf16_t*)(ws + WS_GW);
    float* ROWSS = (float*)(ws + WS_ROWSS); unsigned long long* AGG = (unsigned long long*)(ws + WS_AGG);
    bf16_t* XB = (bf16_t*)(ws + WS_XB); bf16_t* Y = (bf16_t*)(ws + WS_Y); bf16_t* U = (bf16_t*)(ws + WS_U);

    if (IN(0)) for (int rep = 0; rep <= ((REP_MASK >> 0) & 1); ++rep) {
        LAUNDER();
        LAS unsigned char* scr = lds + wid * 16384;
        constexpr int I_IN = (DM / 64) * (DIN / 64), I_OUT = (DM / 64) * (DM / 64);
        constexpr int NIT = 2 * I_IN + 2 * I_OUT + 64;
        for (int it = gw; it < NIT; it += NGW) {
            int r = it;
            if (r < 2 * I_IN) { const int l = r / I_IN; tr_item(w_in + (size_t)l * DM * DIN, DM, DIN, WTIN + (size_t)l * DIN * DM, norm_g + l * DM, scr, r % I_IN, lane); continue; } r -= 2 * I_IN;
            if (r < 2 * I_OUT) { const int l = r / I_OUT; tr_item(w_out + (size_t)l * DM * DM, DM, DM, WTOUT + (size_t)l * DM * DM, nullptr, scr, r % I_OUT, lane); continue; } r -= 2 * I_OUT;
            { const int mtx = r, l = mtx >> 5, g = (mtx >> 4) & 1, hd = mtx & 15;
              const float* src = (g ? lru_wi : lru_wr) + (size_t)(l * 16 + hd) * 4096;
              tr_item(src, 64, 64, GW + (size_t)mtx * 4096, nullptr, scr, 0, lane); }
        }
        for (int m = gw; m < MROWS + NMETA; m += NGW) {
            const float* src = m < MROWS ? x + (size_t)m * DM : meta + (size_t)(m - MROWS) * DM;
            cvt_row(src, XB + (size_t)m * DM, ROWSS + m, lane);
        }
        for (int i = blockIdx.x * 512 + tid; i < 2 * RSTR; i += gridDim.x * 512) ROWSS[RSTR + i] = 0.f;
        for (int i = blockIdx.x * 512 + tid; i < AGG_PER_LAYER; i += gridDim.x * 512) ((u32x4*)AGG)[i] = (u32x4){0u, 0u, 0u, 0u};
    }
    SEAM(0);

#pragma unroll 1
    for (int l = 0; l < 2; ++l) {
        const int pb = 1 + 3 * l;
        const bf16_t* wtin = WTIN + (size_t)l * DIN * DM; const bf16_t* wtout = WTOUT + (size_t)l * DM * DM;
        float* rss_in = ROWSS + (size_t)l * RSTR; float* rss_out = ROWSS + (size_t)(l + 1) * RSTR;
        Mix X; X.conv_a_w = conv_a_w + l * 4 * DLRU; X.conv_a_b = conv_a_b + l * DLRU; X.lru_br = lru_br + l * DLRU; X.lru_bi = lru_bi + l * DLRU; X.lru_lambda = lru_lambda + l * DLRU;
        X.conv_b_w = conv_b_w + l * 3 * DLRU; X.gw = GW + (size_t)l * 2 * 16 * 4096; X.U = U; X.Y = Y; X.AGG = AGG + (size_t)l * AGG_PER_LAYER;

        if (IN(pb)) for (int rep = 0; rep <= ((REP_MASK >> pb) & 1); ++rep) {
            LAUNDER();
            meta_gemm(XB + (size_t)META0 * DM, wtin, DIN / 16, lds, wid, lane, [&](int m, int n0, f32x4 s) {
                const float rs = rsqrtf(rss_in[META0 + m] * (1.0f / DM) + RMS_EPS);
                u32x2 w; w.x = pk2(s[0] * rs, s[1] * rs); w.y = pk2(s[2] * rs, s[3] * rs);
                *(u32x2*)(U + (size_t)(META0 + m) * DIN + n0) = w; });
            pg8::Gemm g{XB, wtin, MROWS, DIN, DM}; pg8::StaticOrder S; S.init(MROWS, DIN, (int)gridDim.x, (int)blockIdx.x);
            EpiU E{U, rss_in};
            pg8::gemm_phase<EpiU, pg8::StaticOrder, false>(lds, g, S, E, nullptr);
        }
        SEAM(pb);
        if (IN(pb + 1)) for (int rep = 0; rep <= ((REP_MASK >> (pb + 1)) & 1); ++rep) {
            LAUNDER();
#pragma unroll 1
            for (int step = 0; step < 2; ++step) {
                if ((step == 0) == (wid < 4)) {
                    if (rep == 1 && ((REP_MASK >> 13) & 1)) continue;
#pragma unroll 1
                    for (int id = gw; id < N_ITEMS; id += NGW) mix_item(X, id, lds + wid * 9216, lane);
                } else { if (rep == 1 && ((REP_MASK >> 12) & 1)) continue; partb(X, tid); }
            }
        }
        SEAM(pb + 1);
        if (IN(pb + 2)) {
            LAUNDER();
            if (l == 0) {
                meta_gemm(Y + (size_t)META0 * DM, wtout, DM / 16, lds, wid, lane, [&](int m, int n0, f32x4 s) {
                    const f32x4 r = *(const f32x4*)(meta + (size_t)m * DM + n0); const f32x4 hh = r + s;
                    u32x2 w; w.x = pk2(hh[0], hh[1]); w.y = pk2(hh[2], hh[3]);
                    *(u32x2*)(XB + (size_t)(META0 + m) * DM + n0) = w;
                    unsafeAtomicAdd(rss_out + META0 + m, (hh[0] * hh[0] + hh[1] * hh[1]) + (hh[2] * hh[2] + hh[3] * hh[3])); });
            }
            pg8::Gemm g{Y, wtout, MROWS, DM, DM};
            if (l == 0) {
                pg8::StaticOrder S; S.init(MROWS, DM, (int)gridDim.x, (int)blockIdx.x);
                if ((REP_MASK >> 11) & 1) { EpiU Ed{U, rss_in}; pg8::gemm_phase<EpiU, pg8::StaticOrder, false>(lds, g, S, Ed, nullptr); }
                if ((REP_MASK >> 14) & 1) { EpiRes Ed{x, a.out, XB, ROWSS + (size_t)3 * RSTR}; pg8::gemm_phase<EpiRes, pg8::StaticOrder, false>(lds, g, S, Ed, nullptr); }
                EpiRes E{x, a.out, XB, rss_out};
                pg8::gemm_phase<EpiRes, pg8::StaticOrder, false>(lds, g, S, E, nullptr);
            } else {
                PanelOrder S; S.init((int)gridDim.x, (int)blockIdx.x);
                EpiResNorm E{a.out, a.out, rss_out, (unsigned*)(ws + WS_PCNT), final_g};
                pg8::gemm_phase<EpiResNorm, PanelOrder, false>(lds, g, S, E, nullptr);
            }
        }
        SEAM(pb + 2);
    }

#undef IN
#undef SEAM
}

#ifndef MK_LAUNCH_PER_PHASE
#define MK_LAUNCH_PER_PHASE 0
#endif
extern "C" void kernel_launch(void* const* d_in, const int* in_sizes, int n_in, void* d_out, int out_size, void* d_ws, size_t ws_size, hipStream_t stream) {
    static int grid = 0;
    if (grid == 0) {
        if (n_in != 14 || in_sizes[0] != MROWS * DM || out_size != MROWS * DM || ws_size < WS_END) { fprintf(stderr, "kernel_launch: unexpected shapes (n_in %d, in0 %d, out %d, ws %zu)\n", n_in, n_in > 0 ? in_sizes[0] : -1, out_size, ws_size); grid = -1; return; }
        int dev = 0, cus = 0, per_cu = 0;
        hipGetDevice(&dev); hipDeviceGetAttribute(&cus, hipDeviceAttributeMultiprocessorCount, dev);
        if (hipFuncSetAttribute((const void*)hymba_fwd, hipFuncAttributeMaxDynamicSharedMemorySize, LDS_BYTES) != hipSuccess) { fprintf(stderr, "kernel_launch: hipFuncSetAttribute failed\n"); grid = -1; return; }
        if (hipOccupancyMaxActiveBlocksPerMultiprocessor(&per_cu, (const void*)hymba_fwd, 512, LDS_BYTES) != hipSuccess || per_cu < 1) { fprintf(stderr, "kernel_launch: occupancy query gave %d\n", per_cu); per_cu = 1; }
        (void)hipGetLastError();
        grid = cus * per_cu;
    }
    if (grid < 0) return;
    Args a{};
    for (int i = 0; i < 14; ++i) a.in[i] = (const float*)d_in[i];
    a.out = (float*)d_out; a.ws = (unsigned char*)d_ws;
#if MK_LAUNCH_PER_PHASE
    for (int p = 0; p < NPHASE; ++p) {
#ifdef DEBUG_NAIVE_MIX
        if (p == 2 || p == 6) { const int l = p / 4; unsigned char* ws = (unsigned char*)d_ws;
            Mix X; X.conv_a_w = a.in[4] + l * 4 * DLRU; X.conv_a_b = a.in[5] + l * DLRU; X.lru_br = a.in[7] + l * DLRU; X.lru_bi = a.in[9] + l * DLRU; X.lru_lambda = a.in[10] + l * DLRU;
            X.conv_b_w = a.in[11] + l * 3 * DLRU; X.gw = nullptr; X.U = (bf16_t*)(ws + WS_U); X.Y = (bf16_t*)(ws + WS_Y); X.HP = nullptr; X.AGG = nullptr;
#if DEBUG_NAIVE_MIX == 1
            hipLaunchKernelGGL(naive_mixA, dim3(64), dim3(64), 0, stream, X, a.in[6] + (size_t)l * 16 * 4096, a.in[8] + (size_t)l * 16 * 4096);
            a.flags = 1;
#else
            hipLaunchKernelGGL(naive_mixB, dim3(2048), dim3(256), 0, stream, X);
            a.flags = 2;
#endif
            }
        else a.flags = 0;
#if DEBUG_NAIVE_MIX == 1
        if (p == 3 || p == 7) continue;
#endif
#endif
        a.ph_lo = p; a.ph_hi = p + 1; hipLaunchKernelGGL(hymba_fwd, dim3(grid), dim3(512), LDS_BYTES, stream, a); }
#else
    a.ph_lo = 0; a.ph_hi = NPHASE;
    if (hipMemsetAsync((unsigned char*)d_ws + WS_BAR, 0, 16384 + 32768, stream) != hipSuccess) { fprintf(stderr, "kernel_launch: memset of barrier words failed\n"); return; }
    void* args[] = {&a};
    const hipError_t e = hipLaunchCooperativeKernel((const void*)hymba_fwd, dim3(grid), dim3(512), args, LDS_BYTES, stream);
    if (e != hipSuccess) fprintf(stderr, "kernel_launch: cooperative launch failed: %s (grid %d)\n", hipGetErrorString(e), grid);
#endif
}
```

```cpp
#include <hip/hip_runtime.h>
#include <hip/hip_cooperative_groups.h>
#include <cstdio>
namespace cg = cooperative_groups;
namespace pg8 {
#define PG8_LAS __attribute__((address_space(3)))
typedef unsigned short bf16_t;
typedef short bf16x8 __attribute__((ext_vector_type(8)));
typedef float f32x4 __attribute__((ext_vector_type(4)));
typedef unsigned u32x4 __attribute__((ext_vector_type(4)));
constexpr int BM = 256, BK = 64, HALF = 128, HTB = HALF * BK * 2  , STAGE_BYTES = 8 * HTB, NXCD = 8, WGM = 8;

__host__ __device__ __forceinline__ int lds_byte(int r, int c) { const int st = (r >> 4) * 2 + (c >> 5), rr = r & 15, cc = c & 31, ob = rr * 64 + cc * 2; return st * 1024 + (ob ^ (((ob >> 9) & 1) << 5)); }
__host__ __device__ __forceinline__ void stage_rc(int b, int& R, int& C) { const int st = b / 1024, sb = b % 1024, swz = sb ^ (((sb >> 9) & 1) << 5); R = (st >> 1) * 16 + swz / 64; C = (st & 1) * 32 + (swz % 64) / 2; }
__host__ __device__ __forceinline__ int perm32(int rho) { const int n = rho >> 4, i = rho & 15; return 8 * (i >> 2) + 4 * n + (i & 3); }

struct Unit { int pm, pn; };
struct Gemm { const bf16_t* A; const bf16_t* Bt; int M, N, K; };

struct StaticOrder {
    int nM, nN, nwg, G, c;
    __host__ __device__ void init(int M, int N, int G_, int c_) { nM = M / BM; nN = N / BM; nwg = nM * nN; G = G_; c = c_; }
    __host__ __device__ bool next(int i, Unit& u) const {
        const long L = (long)i * G + c; if (L >= nwg) return false;
        int wgid = (int)L; { const int q = nwg / NXCD, r = nwg % NXCD, xcd = wgid % NXCD, off = wgid / NXCD; wgid = (xcd < r ? xcd * (q + 1) : r * (q + 1) + (xcd - r) * q) + off; }
        const int nig = WGM * nN, gid = wgid / nig, fm = gid * WGM, gsz = (nM - fm) < WGM ? (nM - fm) : WGM;
        u.pm = fm + ((wgid % nig) % gsz); u.pn = (wgid % nig) / gsz; return true;
    }
    __device__ __forceinline__ void a_ready(const Unit&) const {}
    __device__ __forceinline__ void done(const Unit&) const {}
};
__device__ __forceinline__ unsigned cvt_pk_bf16(float lo, float hi) { unsigned r; asm volatile("v_cvt_pk_bf16_f32 %0, %1, %2" : "=v"(r) : "v"(lo), "v"(hi)); return r; }
template <class Epi, class Sched, bool STAMP = false>
__device__ __forceinline__ void gemm_phase(PG8_LAS unsigned char* lds, const Gemm g, const Sched& S, const Epi& E, unsigned long long* stamps) {
    int tid_l = threadIdx.x; asm volatile("" : "+v"(tid_l));
    const int tid = tid_l, wid = __builtin_amdgcn_readfirstlane(tid >> 6), lane = tid & 63, wr = wid >> 2, wc = wid & 3, fr = lane & 15, fq = lane >> 4;
    const int K = g.K, nt = K / BK;
    int ts_lo = 0, ts_hi = 0, nts = 0; const unsigned long long rt_entry = STAMP ? (unsigned long long)wall_clock64() : 0ull;
#define PG8_STAMP() do { if (STAMP && wid == 0 && nts < 64) { const unsigned long long _c = (unsigned long long)clock64(); \
        ts_lo = (lane == nts) ? (int)(unsigned)_c : ts_lo; ts_hi = (lane == nts) ? (int)(unsigned)(_c >> 32) : ts_hi; ++nts; } } while (0)
    PG8_STAMP();
    unsigned voffA[2], voffB[2];
#pragma unroll
    for (int i = 0; i < 2; ++i) { int R, C; stage_rc(tid * 16 + i * 8192, R, C); const int Rb = Epi::PERM ? ((R & ~31) + perm32(R & 31)) : R;
        voffA[i] = (unsigned)(R * K + C) * 2u; voffB[i] = (unsigned)(Rb * K + C) * 2u; }
    const size_t kstep = (size_t)(BK * 2);
    const size_t hstep = (size_t)HALF * K * 2;
    const size_t tstep = 2 * hstep;
    const unsigned ldsw = (unsigned)wid * 1024u;
    const int aoff = lds_byte(wr * 64 + fr, fq * 8), boff = lds_byte(wc * 32 + fr, fq * 8);
#define PG8_SA(b, h) (((b) * 2 + (h)) * HTB)
#define PG8_SB(b, h) ((4 + (b) * 2 + (h)) * HTB)
#define PG8_STAGE(bufoff, gbase, voff) do { _Pragma("unroll") for (int _i = 0; _i < 2; ++_i) \
        __builtin_amdgcn_global_load_lds((const unsigned*)((const char*)(gbase) + (voff)[_i]), (PG8_LAS unsigned*)(lds + (bufoff) + ldsw + _i * 8192), 16, 0, 0); } while (0)
#define PG8_LDA(dst, b, h) do { _Pragma("unroll") for (int m = 0; m < 4; ++m) _Pragma("unroll") for (int k = 0; k < 2; ++k) dst[m][k] = *(const PG8_LAS bf16x8*)(lds + PG8_SA(b, h) + aoff + m * 2048 + k * 1024); } while (0)
#define PG8_LDB(dst, b, h) do { _Pragma("unroll") for (int n = 0; n < 2; ++n) _Pragma("unroll") for (int k = 0; k < 2; ++k) dst[n][k] = *(const PG8_LAS bf16x8*)(lds + PG8_SB(b, h) + boff + n * 2048 + k * 1024); } while (0)
#define PG8_MMA(ai, bj, At, Bt) do { __builtin_amdgcn_s_setprio(1); _Pragma("unroll") for (int m = 0; m < 4; ++m) _Pragma("unroll") for (int n = 0; n < 2; ++n) _Pragma("unroll") for (int k = 0; k < 2; ++k) \
        acc[ai][bj][m][n] = __builtin_amdgcn_mfma_f32_16x16x32_bf16(Bt[n][k], At[m][k], acc[ai][bj][m][n], 0, 0, 0); __builtin_amdgcn_s_setprio(0); } while (0)
#define PG8_WAIT_V(n) asm volatile("s_waitcnt vmcnt(" #n ")" ::: "memory")
#define PG8_WAIT_L(n) asm volatile("s_waitcnt lgkmcnt(" #n ")" ::: "memory")
#define PG8_BAR __builtin_amdgcn_s_barrier()
#define PG8_SCHED __builtin_amdgcn_sched_barrier(0)
    Unit cur, nxt; int ui = 0;
    if (!S.next(0, cur)) return;
    f32x4 acc[2][2][4][2];
#pragma unroll
    for (int a = 0; a < 2; ++a)
#pragma unroll
        for (int b = 0; b < 2; ++b)
#pragma unroll
            for (int m = 0; m < 4; ++m)
#pragma unroll
                for (int n = 0; n < 2; ++n) acc[a][b][m][n] = (f32x4){0.f, 0.f, 0.f, 0.f};
    bf16x8 At[4][2], B0[2][2], B1[2][2];
    const char* cA = (const char*)g.A + (size_t)cur.pm * tstep; const char* cB = (const char*)g.Bt + (size_t)cur.pn * tstep;
    S.a_ready(cur);
    PG8_STAGE(PG8_SB(0, 0), cB, voffB); PG8_STAGE(PG8_SA(0, 0), cA, voffA); PG8_STAGE(PG8_SB(0, 1), cB + hstep, voffB); PG8_STAGE(PG8_SA(0, 1), cA + hstep, voffA);
    if (wr == 1) PG8_BAR;
    PG8_WAIT_V(4); PG8_BAR;
    PG8_STAGE(PG8_SB(1, 0), cB + kstep, voffB); PG8_STAGE(PG8_SA(1, 0), cA + kstep, voffA); PG8_STAGE(PG8_SB(1, 1), cB + hstep + kstep, voffB);
    PG8_WAIT_V(6); PG8_BAR;
    PG8_STAMP();
    for (;;) {
        const bool has_next = S.next(ui + 1, nxt);
        const char* nA = has_next ? (const char*)g.A + (size_t)nxt.pm * tstep : cA; const char* nB = has_next ? (const char*)g.Bt + (size_t)nxt.pn * tstep : cB;
        for (int t = 0; t < nt; t += 2) {
            const bool last = (t == nt - 2);
            const char* a1 = cA + (size_t)(t + 1) * kstep;
            const char* a2 = last ? nA : cA + (size_t)(t + 2) * kstep; const char* b2 = last ? nB : cB + (size_t)(t + 2) * kstep;
            const char* a3 = a2 + kstep; const char* b3 = b2 + kstep;
            if (last && has_next) S.a_ready(nxt);
            PG8_LDB(B0, 0, 0); PG8_SCHED; PG8_LDA(At, 0, 0); PG8_STAGE(PG8_SA(1, 1), a1 + hstep, voffA);
            PG8_WAIT_L(8); PG8_BAR; PG8_WAIT_L(0); PG8_MMA(0, 0, At, B0); PG8_BAR; PG8_SCHED;
            PG8_LDB(B1, 0, 1); PG8_STAGE(PG8_SB(0, 0), b2, voffB);
            PG8_BAR; PG8_WAIT_L(0); PG8_MMA(0, 1, At, B1); PG8_BAR;
            PG8_LDA(At, 0, 1); PG8_STAGE(PG8_SA(0, 0), a2, voffA);
            PG8_BAR; PG8_WAIT_L(0); PG8_MMA(1, 0, At, B0); PG8_BAR; PG8_SCHED;
            PG8_STAGE(PG8_SB(0, 1), b2 + hstep, voffB);
            PG8_WAIT_V(6); PG8_BAR; PG8_MMA(1, 1, At, B1); PG8_BAR;
            PG8_LDB(B0, 1, 0); PG8_SCHED; PG8_LDA(At, 1, 0); PG8_STAGE(PG8_SA(0, 1), a2 + hstep, voffA);
            PG8_WAIT_L(8); PG8_BAR; PG8_WAIT_L(0); PG8_MMA(0, 0, At, B0); PG8_BAR; PG8_SCHED;
            PG8_LDB(B1, 1, 1); PG8_STAGE(PG8_SB(1, 0), b3, voffB);
            PG8_BAR; PG8_WAIT_L(0); PG8_MMA(0, 1, At, B1); PG8_BAR;
            PG8_LDA(At, 1, 1); PG8_STAGE(PG8_SA(1, 0), a3, voffA);
            PG8_BAR; PG8_WAIT_L(0); PG8_MMA(1, 0, At, B0); PG8_BAR; PG8_SCHED;
            PG8_STAGE(PG8_SB(1, 1), b3 + hstep, voffB);
            PG8_WAIT_V(6); PG8_BAR; PG8_MMA(1, 1, At, B1); PG8_BAR;
        }
        PG8_STAMP();
        if constexpr (!Epi::AFTER_DRAIN) { E(acc, cur, wr, wc, fr, fq); S.done(cur); }
        PG8_STAMP();
        if (!has_next) break;
#pragma unroll
        for (int a = 0; a < 2; ++a)
#pragma unroll
            for (int b = 0; b < 2; ++b)
#pragma unroll
                for (int m = 0; m < 4; ++m)
#pragma unroll
                    for (int n = 0; n < 2; ++n) acc[a][b][m][n] = (f32x4){0.f, 0.f, 0.f, 0.f};
        cur = nxt; cA = nA; cB = nB; ++ui;
    }
    PG8_WAIT_V(0);
    if (wr == 0) PG8_BAR;
    PG8_BAR;
    if constexpr (Epi::AFTER_DRAIN) { E.fused(acc, cur, wr, wc, fr, fq, lds, wid, lane); S.done(cur); }
    PG8_STAMP();
    if (STAMP && wid == 0) { stamps[lane] = lane < nts ? (((unsigned long long)(unsigned)ts_hi << 32) | (unsigned)ts_lo) : 0ull;
        if (lane == 62) stamps[62] = rt_entry; if (lane == 63) stamps[63] = (unsigned long long)wall_clock64(); }
#undef PG8_STAMP
#undef PG8_SA
#undef PG8_SB
#undef PG8_STAGE
#undef PG8_LDA
#undef PG8_LDB
#undef PG8_MMA
#undef PG8_WAIT_V
#undef PG8_WAIT_L
#undef PG8_BAR
#undef PG8_SCHED
}
}

#define LAS __attribute__((address_space(3)))
#define GAS __attribute__((address_space(1)))
typedef unsigned short bf16_t;
typedef short bf16x8 __attribute__((ext_vector_type(8)));
typedef float f32x4 __attribute__((ext_vector_type(4)));
typedef float f32x2 __attribute__((ext_vector_type(2)));
typedef float f32x16 __attribute__((ext_vector_type(16)));
typedef unsigned u32x4 __attribute__((ext_vector_type(4)));
typedef unsigned u32x2 __attribute__((ext_vector_type(2)));

constexpr int DM = 2048, NBATCH = 4, SEQ = 4096, MROWS = NBATCH * SEQ, NMETA = 16, DIN = 6144, DLRU = 1024, NHEAD = 16;
constexpr int META0 = MROWS;
constexpr int RSTR = MROWS + 64;
constexpr float RMS_EPS = 1e-6f;
constexpr int NPHASE = 7;
#ifndef REP_MASK
#define REP_MASK 0
#endif
constexpr int LDS_BYTES = 131072 + 256;

constexpr size_t MiB = 1u << 20;
constexpr size_t WS_WTIN = 0;
constexpr size_t WS_WTOUT = 48 * MiB;
constexpr size_t WS_GW = 64 * MiB;
constexpr size_t WS_ROWSS = 65 * MiB;
constexpr size_t WS_BAR = 65 * MiB + 512 * 1024;
constexpr size_t WS_PCNT = WS_BAR + 16384;
constexpr size_t WS_AGG = 66 * MiB;
constexpr size_t WS_XB = 71 * MiB;
constexpr size_t WS_Y = 136 * MiB;
constexpr size_t WS_U = 201 * MiB;
constexpr size_t WS_END = 396 * MiB;
constexpr int AGG_PER_LAYER = 257 * 1024;
static_assert(WS_U + (size_t)RSTR * DIN * 2 <= WS_END && WS_Y + (size_t)RSTR * DM * 2 <= WS_U && WS_XB + (size_t)RSTR * DM * 2 <= WS_Y, "ws map");
static_assert(WS_WTIN + (size_t)2 * DIN * DM * 2 <= WS_WTOUT && WS_WTOUT + (size_t)2 * DM * DM * 2 <= WS_GW && WS_AGG + (size_t)2 * AGG_PER_LAYER * 8 <= WS_XB && WS_ROWSS + (size_t)3 * RSTR * 4 <= WS_BAR, "ws map 2");

struct Args { const float* in[14]; float* out; unsigned char* ws; int ph_lo, ph_hi, flags, pad; };

__device__ __forceinline__ unsigned f2bf(float f) { unsigned u = __builtin_bit_cast(unsigned, f); return (u + 0x7fffu + ((u >> 16) & 1u)) >> 16; }
__device__ __forceinline__ unsigned pk2(float lo, float hi) { return f2bf(lo) | (f2bf(hi) << 16); }
__device__ __forceinline__ float bflo(unsigned w) { return __builtin_bit_cast(float, w << 16); }
__device__ __forceinline__ float bfhi(unsigned w) { return __builtin_bit_cast(float, w & 0xffff0000u); }
__device__ __forceinline__ float bf1(bf16_t v) { return __builtin_bit_cast(float, ((unsigned)v) << 16); }
__device__ __forceinline__ float sigmoidf_(float z) { return __builtin_amdgcn_rcpf(1.0f + __expf(-z)); }
__device__ __forceinline__ float wave_sum(float v) {
#pragma unroll
    for (int o = 1; o < 64; o <<= 1) v += __shfl_xor(v, o);
    return v;
}
#define LDS_WAIT() asm volatile("s_waitcnt lgkmcnt(0)" ::: "memory")

template <bool NORS> struct EpiUT {
    static constexpr bool PERM = true, AFTER_DRAIN = false;
    bf16_t* O; const float* rowss;
    __device__ __forceinline__ void operator()(const f32x4 (&acc)[2][2][4][2], const pg8::Unit& u, int wr, int wc, int fr, int fq) const {
        const int row0 = u.pm * 256 + wr * 64 + fr, col0 = u.pn * 256 + wc * 32 + 8 * fq;
#pragma unroll
        for (int ai = 0; ai < 2; ++ai)
#pragma unroll
            for (int m = 0; m < 4; ++m) {
                const int r = row0 + ai * 128 + m * 16;
                const float rs = NORS ? 1.0f : rsqrtf(rowss[r] * (1.0f / DM) + RMS_EPS);
                bf16_t* rowp = O + (size_t)r * DIN + col0;
#pragma unroll
                for (int bj = 0; bj < 2; ++bj) {
                    const f32x4 v0 = acc[ai][bj][m][0] * rs, v1 = acc[ai][bj][m][1] * rs;
                    u32x4 w; w.x = pg8::cvt_pk_bf16(v0[0], v0[1]); w.y = pg8::cvt_pk_bf16(v0[2], v0[3]); w.z = pg8::cvt_pk_bf16(v1[0], v1[1]); w.w = pg8::cvt_pk_bf16(v1[2], v1[3]);
                    *(u32x4*)(rowp + bj * 128) = w;
                }
            }
    }
};
struct EpiNull {
    static constexpr bool PERM = true, AFTER_DRAIN = false;
    float* sink;
    __device__ __forceinline__ void operator()(const f32x4 (&acc)[2][2][4][2], const pg8::Unit& u, int wr, int wc, int fr, int fq) const {
        f32x4 s = {0.f, 0.f, 0.f, 0.f};
#pragma unroll
        for (int ai = 0; ai < 2; ++ai)
#pragma unroll
            for (int bj = 0; bj < 2; ++bj)
#pragma unroll
                for (int m = 0; m < 4; ++m) { s += acc[ai][bj][m][0]; s += acc[ai][bj][m][1]; }
        if (s[0] + s[1] + s[2] + s[3] == 1.2345678e33f) sink[u.pm] = s[0];
    }
};
typedef EpiUT<false> EpiU;
#ifndef EPI_MB
#define EPI_MB 2
#endif
struct EpiRes {
    static constexpr bool PERM = true, AFTER_DRAIN = false;
    const float* res; float* out; bf16_t* xb; float* rowss;
    __device__ __forceinline__ void operator()(const f32x4 (&acc)[2][2][4][2], const pg8::Unit& u, int wr, int wc, int fr, int fq) const {
        const int row0 = u.pm * 256 + wr * 64 + fr, col0 = u.pn * 256 + wc * 32 + 8 * fq;
#pragma unroll
        for (int ai = 0; ai < 2; ++ai) {
#pragma unroll
          for (int mh = 0; mh < 4; mh += EPI_MB) {
            f32x4 rv[4][2][2];
#pragma unroll
            for (int m = mh; m < mh + EPI_MB; ++m)
#pragma unroll
                for (int bj = 0; bj < 2; ++bj) { const float* p = res + (size_t)(row0 + ai * 128 + m * 16) * DM + col0 + bj * 128; rv[m][bj][0] = *(const f32x4*)p; rv[m][bj][1] = *(const f32x4*)(p + 4); }
            asm volatile("" ::: "memory");
#pragma unroll
            for (int m = mh; m < mh + EPI_MB; ++m) {
                const int r = row0 + ai * 128 + m * 16; const size_t off = (size_t)r * DM + col0; float ss = 0.f;
#pragma unroll
                for (int bj = 0; bj < 2; ++bj) {
                    const f32x4 h0 = rv[m][bj][0] + acc[ai][bj][m][0], h1 = rv[m][bj][1] + acc[ai][bj][m][1];
                    *(f32x4*)(out + off + bj * 128) = h0; *(f32x4*)(out + off + bj * 128 + 4) = h1;
                    if (xb) { u32x4 w; w.x = pg8::cvt_pk_bf16(h0[0], h0[1]); w.y = pg8::cvt_pk_bf16(h0[2], h0[3]); w.z = pg8::cvt_pk_bf16(h1[0], h1[1]); w.w = pg8::cvt_pk_bf16(h1[2], h1[3]);
                        *(u32x4*)(xb + off + bj * 128) = w; }
                    ss += (h0[0] * h0[0] + h0[1] * h0[1]) + (h0[2] * h0[2] + h0[3] * h0[3]) + (h1[0] * h1[0] + h1[1] * h1[1]) + (h1[2] * h1[2] + h1[3] * h1[3]);
                }
                ss += __shfl_xor(ss, 16); ss += __shfl_xor(ss, 32);
                if (fq == 0) unsafeAtomicAdd(rowss + r, ss);
            }
            asm volatile("" ::: "memory");
          }
        }
    }
};

struct EpiResNorm {
    static constexpr bool PERM = true, AFTER_DRAIN = false;
    const float* res; float* out; float* rowss; unsigned* cnt; const float* fg;
    __device__ __forceinline__ void operator()(f32x4 (&acc)[2][2][4][2], const pg8::Unit& u, int wr, int wc, int fr, int fq) const {
        const int row0 = u.pm * 256 + wr * 64 + fr, col0 = u.pn * 256 + wc * 32 + 8 * fq;
#pragma unroll
        for (int ai = 0; ai < 2; ++ai) {
#pragma unroll
          for (int mh = 0; mh < 4; mh += EPI_MB) {
            f32x4 rv[4][2][2];
#pragma unroll
            for (int m = mh; m < mh + EPI_MB; ++m)
#pragma unroll
                for (int bj = 0; bj < 2; ++bj) { const float* p = res + (size_t)(row0 + ai * 128 + m * 16) * DM + col0 + bj * 128; rv[m][bj][0] = *(const f32x4*)p; rv[m][bj][1] = *(const f32x4*)(p + 4); }
            asm volatile("" ::: "memory");
#pragma unroll
            for (int m = mh; m < mh + EPI_MB; ++m) {
                float ss = 0.f;
#pragma unroll
                for (int bj = 0; bj < 2; ++bj) {
                    const f32x4 h0 = rv[m][bj][0] + acc[ai][bj][m][0], h1 = rv[m][bj][1] + acc[ai][bj][m][1];
                    acc[ai][bj][m][0] = h0; acc[ai][bj][m][1] = h1;
                    ss += (h0[0] * h0[0] + h0[1] * h0[1]) + (h0[2] * h0[2] + h0[3] * h0[3]) + (h1[0] * h1[0] + h1[1] * h1[1]) + (h1[2] * h1[2] + h1[3] * h1[3]);
                }
                ss += __shfl_xor(ss, 16); ss += __shfl_xor(ss, 32);
                if (fq == 0) unsafeAtomicAdd(rowss + row0 + ai * 128 + m * 16, ss);
            }
            asm volatile("" ::: "memory");
          }
        }
        asm volatile("s_waitcnt vmcnt(0)" ::: "memory");
        unsigned* cw = cnt + 64 * (2 * u.pm + wr);
        if (fr == 0 && fq == 0) __hip_atomic_fetch_add(cw, 1u, __ATOMIC_RELAXED, __HIP_MEMORY_SCOPE_AGENT);
        f32x4 gv[2][2];
#pragma unroll
        for (int bj = 0; bj < 2; ++bj) { gv[bj][0] = *(const f32x4*)(fg + col0 + bj * 128); gv[bj][1] = *(const f32x4*)(fg + col0 + bj * 128 + 4); }
        { unsigned sp = 0;
          while ((unsigned)__builtin_amdgcn_readfirstlane(__hip_atomic_load(cw, __ATOMIC_RELAXED, __HIP_MEMORY_SCOPE_AGENT)) < 32u) { __builtin_amdgcn_s_sleep(1); if (++sp > (1u << 16)) break; } }
        asm volatile("" ::: "memory");
#pragma unroll
        for (int ai = 0; ai < 2; ++ai)
#pragma unroll
            for (int m = 0; m < 4; ++m) {
                const int r = row0 + ai * 128 + m * 16;
                const float rs = rsqrtf(__hip_atomic_load(rowss + r, __ATOMIC_RELAXED, __HIP_MEMORY_SCOPE_AGENT) * (1.0f / DM) + RMS_EPS);
                float* op = out + (size_t)r * DM + col0;
#pragma unroll
                for (int bj = 0; bj < 2; ++bj) { *(f32x4*)(op + bj * 128) = acc[ai][bj][m][0] * rs * gv[bj][0]; *(f32x4*)(op + bj * 128 + 4) = acc[ai][bj][m][1] * rs * gv[bj][1]; }
            }
    }
};
struct PanelOrder {
    int Gp, v;
    __device__ void init(int G, int c) { Gp = G & ~7; v = c; if ((Gp & 63) == 0) v = (c & 7) * (Gp >> 3) + (c >> 3); if (c >= Gp) v = -1; }
    __device__ bool next(int i, pg8::Unit& u) const { if (v < 0) return false; const long L = (long)i * Gp + v; if (L >= 64 * 8) return false; u.pm = (int)(L >> 3); u.pn = (int)(L & 7); return true; }
    __device__ __forceinline__ void a_ready(const pg8::Unit&) const {}
    __device__ __forceinline__ void done(const pg8::Unit&) const {}
};

template <class F> __device__ __forceinline__ void meta_gemm(const bf16_t* A, const bf16_t* Bt, int ngroups, LAS unsigned char* lds, int wid, int lane, F epi) {
    const int fr = lane & 15, fq = lane >> 4, half = wid >> 2, wq = wid & 3;
    LAS f32x4* red = (LAS f32x4*)lds;
    for (int p = blockIdx.x; 2 * p < ngroups; p += gridDim.x) {
        const int g = 2 * p + half;
        f32x4 acc = {0.f, 0.f, 0.f, 0.f};
        if (g < ngroups) {
            const bf16_t* ap = A + (size_t)fr * DM + wq * 512 + fq * 8;
            const bf16_t* bp = Bt + (size_t)(g * 16 + fr) * DM + wq * 512 + fq * 8;
            bf16x8 av[16], bv[16];
#pragma unroll
            for (int s = 0; s < 16; ++s) { av[s] = *(const bf16x8*)(ap + 32 * s); bv[s] = *(const bf16x8*)(bp + 32 * s); }
#pragma unroll
            for (int s = 0; s < 16; ++s) acc = __builtin_amdgcn_mfma_f32_16x16x32_bf16(bv[s], av[s], acc, 0, 0, 0);
        }
        red[wid * 64 + lane] = acc;
        __syncthreads();
        if (wq == 0 && g < ngroups) {
            f32x4 s = red[wid * 64 + lane];
#pragma unroll
            for (int w = 1; w < 4; ++w) s += red[(wid + w) * 64 + lane];
            epi(fr, g * 16 + 4 * fq, s);
        }
        __syncthreads();
    }
}

__device__ __forceinline__ void tr_item(const float* W, int K, int N, bf16_t* WT, const float* sc, LAS unsigned char* scr, int item, int lane) {
    const int nblk = N / 64, kb = item / nblk, nb = item % nblk, k0 = 64 * kb, n0 = 64 * nb;
    const int kr = lane >> 4, nc = (lane & 15) * 4;
    f32x4 v[16]; float g[16];
    { const float* p = W + (size_t)(k0 + kr) * N + n0 + nc;
#pragma unroll
      for (int i = 0; i < 16; ++i) { v[i] = *(const f32x4*)p; p += (size_t)4 * N; }
#pragma unroll
      for (int i = 0; i < 16; ++i) g[i] = sc ? sc[k0 + kr + 4 * i] : 1.0f; }
    asm volatile("" ::: "memory");
#pragma unroll
    for (int i = 0; i < 16; ++i) { const f32x4 s = v[i] * g[i]; u32x2 w; w.x = pg8::cvt_pk_bf16(s[0], s[1]); w.y = pg8::cvt_pk_bf16(s[2], s[3]);
        *(LAS u32x2*)(scr + (kr + 4 * i) * 136 + nc * 2) = w; }
    LDS_WAIT();
    const int c = lane & 7;
#pragma unroll
    for (int j = 0; j < 8; ++j) { const int n = (lane >> 3) + 8 * j; const LAS bf16_t* s = (const LAS bf16_t*)(scr + (8 * c) * 136 + n * 2);
        u32x4 o; o.x = (unsigned)s[0] | ((unsigned)s[68] << 16); o.y = (unsigned)s[2 * 68] | ((unsigned)s[3 * 68] << 16); o.z = (unsigned)s[4 * 68] | ((unsigned)s[5 * 68] << 16); o.w = (unsigned)s[6 * 68] | ((unsigned)s[7 * 68] << 16);
        *(u32x4*)(WT + (size_t)(n0 + n) * K + k0 + 8 * c) = o; }
    LDS_WAIT();
}
__device__ __forceinline__ void cvt_row(const float* src, bf16_t* dst, float* ss, int lane) {
    const f32x4* xr = (const f32x4*)src + lane; f32x4 v[8]; float s = 0.f;
#pragma unroll
    for (int j = 0; j < 8; ++j) { v[j] = xr[64 * j]; s += (v[j].x * v[j].x + v[j].y * v[j].y) + (v[j].z * v[j].z + v[j].w * v[j].w); }
    s = wave_sum(s);
    u32x2* o8 = (u32x2*)dst + lane;
#pragma unroll
    for (int j = 0; j < 8; ++j) { u32x2 w; w.x = pk2(v[j].x, v[j].y); w.y = pk2(v[j].z, v[j].w); o8[64 * j] = w; }
    if (lane == 0) *ss = s;
}

struct Mix {
    const float *conv_a_w, *conv_a_b, *lru_br, *lru_bi, *lru_lambda, *conv_b_w;
    const bf16_t* gw;
    bf16_t* U; bf16_t* Y; unsigned long long* AGG;
};
struct ItemId { int hd, b, c, row0, ntok, agg; bool meta; };
__device__ __forceinline__ ItemId decode_item(int id) {
    ItemId I;
    if (id < 16) { I.meta = true; I.hd = id; I.b = 0; I.c = 0; I.row0 = META0; I.ntok = 16; I.agg = 256; }
    else { const int j = id - 16; I.meta = false; I.hd = j & 15; I.c = (j >> 4) & 63; I.b = j >> 10; I.row0 = I.b * SEQ + I.c * 64; I.ntok = 64; I.agg = I.b * 64 + I.c; }
    return I;
}
constexpr int N_ITEMS = 16 + NBATCH * NHEAD * 64;

__device__ __forceinline__ bool agg_ok(unsigned long long v) { return (unsigned)v != 0u; }
template <bool META> __device__ __forceinline__ void mix_item(const Mix& X, int id, LAS unsigned char* xt, int lane) {
    constexpr int NT = META ? 16 : 64, NTB = META ? 1 : 2, NQ = META ? 2 : 4;
    constexpr float LOG2E = 1.4426950408889634f;
    const ItemId I = decode_item(id);
    const int ch = I.hd * 64 + lane;
    const float nls2 = -8.0f * LOG2E * log1pf(__expf(-X.lru_lambda[ch]));
    bf16_t raw[NT], rh0 = 0, rh1 = 0, rh2 = 0;
    const float w0 = X.conv_a_w[ch], w1 = X.conv_a_w[1024 + ch], w2 = X.conv_a_w[2048 + ch], w3 = X.conv_a_w[3072 + ch], cb = X.conv_a_b[ch];
    {
        const GAS bf16_t* sb = (const GAS bf16_t*)(X.U + (size_t)I.row0 * DIN + I.hd * 64);
        if (!META) { const GAS bf16_t* hp0 = (I.c == 0) ? (const GAS bf16_t*)(X.U + (size_t)(META0 + 13) * DIN + I.hd * 64) : sb - 3 * DIN; rh0 = hp0[lane]; rh1 = hp0[DIN + lane]; rh2 = hp0[2 * DIN + lane]; }
#pragma unroll
        for (int t = 0; t < NT; ++t) { raw[t] = sb[lane]; sb += DIN; asm volatile("" : "+s"(sb)); }
    }
    bf16x8 BfR0[4], BfR1[4], BfI0[4], BfI1[4];
    { const bf16_t* gr = X.gw + (size_t)(I.hd * 64 + (lane & 31)) * 64 + 8 * (lane >> 5); const bf16_t* gi = gr + 16 * 64 * 64;
#pragma unroll
      for (int s = 0; s < 4; ++s) { BfR0[s] = *(const bf16x8*)(gr + 16 * s); BfR1[s] = *(const bf16x8*)(gr + 32 * 64 + 16 * s); BfI0[s] = *(const bf16x8*)(gi + 16 * s); BfI1[s] = *(const bf16x8*)(gi + 32 * 64 + 16 * s); } }
    asm volatile("" ::: "memory");
    float xm3 = bf1(rh0), xm2 = bf1(rh1), xm1 = bf1(rh2);
#pragma unroll
    for (int t = 0; t < NT; ++t) { const float x0 = bf1(raw[t]); const float xc = cb + w0 * xm3 + w1 * xm2 + w2 * xm1 + w3 * x0; xm3 = xm2; xm2 = xm1; xm1 = x0;
        *(LAS bf16_t*)(xt + t * 144 + lane * 2) = (bf16_t)f2bf(xc); }
    const float brA = X.lru_br[I.hd * 64 + (lane & 31)], brB = X.lru_br[I.hd * 64 + 32 + (lane & 31)], biA = X.lru_bi[I.hd * 64 + (lane & 31)], biB = X.lru_bi[I.hd * 64 + 32 + (lane & 31)];
    float h = 0.f, P = 1.f;
    unsigned hp[NT];
#pragma unroll
    for (int tb = 0; tb < NTB; ++tb) {
        f32x16 aR0, aR1, aI0, aI1;
#pragma unroll
        for (int e = 0; e < 16; ++e) { aR0[e] = brA; aR1[e] = brB; aI0[e] = biA; aI1[e] = biB; }
#pragma unroll
        for (int s = 0; s < 4; ++s) {
            const bf16x8 af = *(const LAS bf16x8*)(xt + (tb * 32 + (lane & 31)) * 144 + (16 * s + 8 * (lane >> 5)) * 2);
            aR0 = __builtin_amdgcn_mfma_f32_32x32x16_bf16(af, BfR0[s], aR0, 0, 0, 0);
            aR1 = __builtin_amdgcn_mfma_f32_32x32x16_bf16(af, BfR1[s], aR1, 0, 0, 0);
            aI0 = __builtin_amdgcn_mfma_f32_32x32x16_bf16(af, BfI0[s], aI0, 0, 0, 0);
            aI1 = __builtin_amdgcn_mfma_f32_32x32x16_bf16(af, BfI1[s], aI1, 0, 0, 0);
        }
#pragma unroll
        for (int q = 0; q < NQ; ++q) {
            float Rv[2][4], Iv[2][4];
#pragma unroll
            for (int k = 0; k < 4; ++k) {
                const int reg = 4 * q + k;
                const float r0f = aR0[reg], r1f = aR1[reg], i0f = aI0[reg], i1f = aI1[reg];
                auto r = __builtin_amdgcn_permlane32_swap(__float_as_uint(r0f), __float_as_uint(r1f), false, false);
                Rv[0][k] = __uint_as_float(r[0]); Rv[1][k] = __uint_as_float(r[1]);
                auto i2 = __builtin_amdgcn_permlane32_swap(__float_as_uint(i0f), __float_as_uint(i1f), false, false);
                Iv[0][k] = __uint_as_float(i2[0]); Iv[1][k] = __uint_as_float(i2[1]);
            }
#pragma unroll
            for (int st = 0; st < 2; ++st)
#pragma unroll
                for (int p = 0; p < 2; ++p) {
                    const int t = tb * 32 + 8 * q + 4 * st + 2 * p;
                    f32x2 er = (f32x2){Rv[st][2 * p], Rv[st][2 * p + 1]} * (-LOG2E), ei = (f32x2){Iv[st][2 * p], Iv[st][2 * p + 1]} * (-LOG2E);
                    er.x = __builtin_amdgcn_exp2f(er.x); er.y = __builtin_amdgcn_exp2f(er.y); ei.x = __builtin_amdgcn_exp2f(ei.x); ei.y = __builtin_amdgcn_exp2f(ei.y);
                    er = er + 1.0f; ei = ei + 1.0f;
                    f32x2 rg, ig; rg.x = __builtin_amdgcn_rcpf(er.x); rg.y = __builtin_amdgcn_rcpf(er.y); ig.x = __builtin_amdgcn_rcpf(ei.x); ig.y = __builtin_amdgcn_rcpf(ei.y);
                    const f32x2 l2 = rg * nls2;
                    f32x2 a; a.x = __builtin_amdgcn_exp2f(l2.x); a.y = __builtin_amdgcn_exp2f(l2.y);
                    f32x2 om = 1.0f - a * a; om.x = fmaxf(om.x, 0.f); om.y = fmaxf(om.y, 0.f);
                    f32x2 mu; mu.x = __builtin_amdgcn_sqrtf(om.x); mu.y = __builtin_amdgcn_sqrtf(om.y);
                    const f32x2 xc = (f32x2){bf1(*(const LAS bf16_t*)(xt + t * 144 + lane * 2)), bf1(*(const LAS bf16_t*)(xt + (t + 1) * 144 + lane * 2))};
                    const f32x2 bb = mu * ig * xc;
                    h = a.x * h + bb.x; P = P * a.x; hp[t] = pg8::cvt_pk_bf16(h, P);
                    h = a.y * h + bb.y; P = P * a.y; hp[t + 1] = pg8::cvt_pk_bf16(h, P);
                }
        }
    }
    __hip_atomic_store(X.AGG + (size_t)I.agg * 1024 + ch, ((unsigned long long)__float_as_uint(h) << 32) | (unsigned long long)__float_as_uint(P), __ATOMIC_RELAXED, __HIP_MEMORY_SCOPE_AGENT);
    asm volatile("" ::: "memory");
    bf16_t graw[NT];
    { const GAS bf16_t* sb = (const GAS bf16_t*)(X.U + (size_t)I.row0 * DIN + 1024 + I.hd * 64);
#pragma unroll
      for (int t = 0; t < NT; ++t) { graw[t] = sb[lane]; sb += DIN; asm volatile("" : "+s"(sb)); } }
    float hin = 0.f;
    if (!META) {
        { const unsigned long long* mp = X.AGG + (size_t)256 * 1024 + ch; unsigned long long v;
          for (;;) { v = __hip_atomic_load(mp, __ATOMIC_RELAXED, __HIP_MEMORY_SCOPE_AGENT); if (!__any(!agg_ok(v))) break; __builtin_amdgcn_s_sleep(2); }
          hin = __uint_as_float((unsigned)(v >> 32)); }
        const unsigned long long* ap = X.AGG + (size_t)(I.b * 64) * 1024 + ch;
        for (int j0 = 0; j0 < I.c; j0 += 16) {
            unsigned long long v[16];
            for (;;) {
                bool bad = false;
#pragma unroll
                for (int k = 0; k < 16; ++k) { v[k] = (j0 + k < I.c) ? __hip_atomic_load(ap + (size_t)(j0 + k) * 1024, __ATOMIC_RELAXED, __HIP_MEMORY_SCOPE_AGENT) : 0x000000003f800000ull; }
#pragma unroll
                for (int k = 0; k < 16; ++k) bad |= !agg_ok(v[k]);
                if (!__any(bad)) break;
                __builtin_amdgcn_s_sleep(2);
            }
#pragma unroll
            for (int k = 0; k < 16; ++k) hin = __uint_as_float((unsigned)v[k]) * hin + __uint_as_float((unsigned)(v[k] >> 32));
        }
    }
    asm volatile("" ::: "memory");
    GAS bf16_t* yp = (GAS bf16_t*)(X.Y + (size_t)I.row0 * DM + I.hd * 64);
#pragma unroll
    for (int t0 = 0; t0 < NT; t0 += 16) {
        {
#pragma unroll
            for (int k = 0; k < 16; k += 2) {
                const unsigned w0 = hp[t0 + k], w1 = hp[t0 + k + 1];
                const f32x2 gg = (f32x2){bf1(graw[t0 + k]), bf1(graw[t0 + k + 1])};
                f32x2 e = gg * (-LOG2E); e.x = __builtin_amdgcn_exp2f(e.x); e.y = __builtin_amdgcn_exp2f(e.y); e = e + 1.0f;
                f32x2 sg; sg.x = __builtin_amdgcn_rcpf(e.x); sg.y = __builtin_amdgcn_rcpf(e.y);
                const f32x2 hv = (f32x2){bflo(w0), bflo(w1)} + (f32x2){bfhi(w0), bfhi(w1)} * hin;
                const f32x2 y = hv * gg * sg;
                const unsigned pk = pg8::cvt_pk_bf16(y.x, y.y);
                yp[lane] = (bf16_t)(pk & 0xffffu); yp[DM + lane] = (bf16_t)(pk >> 16); yp += 2 * DM; asm volatile("" : "+s"(yp));
            }
        }
    }
}

__device__ __forceinline__ void ld8(const bf16_t* p, float (&o)[8]) {
    const u32x4 w = *(const u32x4*)p;
    o[0] = bflo(w.x); o[1] = bfhi(w.x); o[2] = bflo(w.y); o[3] = bfhi(w.y); o[4] = bflo(w.z); o[5] = bfhi(w.z); o[6] = bflo(w.w); o[7] = bfhi(w.w);
}
__device__ __forceinline__ void partb(const Mix& X, int tid) {
    for (int it = blockIdx.x * 512 + tid; it < 1025 * 128; it += gridDim.x * 512) {
        const int c0 = (it & 127) * 8, run = it >> 7;
        int row0, hrow = -1;
        if (run == 1024) row0 = META0; else { row0 = run * 16; hrow = ((row0 & (SEQ - 1)) == 0) ? META0 + 14 : row0 - 2; }
        float w0[8], w1[8], w2[8], cm2[8], cm1[8];
        { const f32x4* p = (const f32x4*)(X.conv_b_w + c0); const f32x4 a0 = p[0], a1 = p[1], b0 = p[256], b1 = p[257], d0 = p[512], d1 = p[513];
#pragma unroll
          for (int e = 0; e < 4; ++e) { w0[e] = a0[e]; w0[4 + e] = a1[e]; w1[e] = b0[e]; w1[4 + e] = b1[e]; w2[e] = d0[e]; w2[4 + e] = d1[e]; } }
        if (hrow >= 0) {
            float c[8], x[8];
            ld8(X.U + (size_t)hrow * DIN + 3072 + c0, c); ld8(X.U + (size_t)hrow * DIN + 4096 + c0, x);
#pragma unroll
            for (int e = 0; e < 8; ++e) cm2[e] = c[e] * x[e];
            ld8(X.U + (size_t)(hrow + 1) * DIN + 3072 + c0, c); ld8(X.U + (size_t)(hrow + 1) * DIN + 4096 + c0, x);
#pragma unroll
            for (int e = 0; e < 8; ++e) cm1[e] = c[e] * x[e];
        } else {
#pragma unroll
            for (int e = 0; e < 8; ++e) { cm2[e] = 0.f; cm1[e] = 0.f; }
        }
        const bf16_t* up = X.U + (size_t)row0 * DIN + c0;
        bf16_t* yp = X.Y + (size_t)row0 * DM + 1024 + c0;
#pragma unroll 8
        for (int t = 0; t < 16; ++t) {
            float bv[8], cv[8], xv[8], gv[8];
            ld8(up + (size_t)t * DIN + 2048, bv); ld8(up + (size_t)t * DIN + 3072, cv); ld8(up + (size_t)t * DIN + 4096, xv); ld8(up + (size_t)t * DIN + 5120, gv);
            float o[8];
#pragma unroll
            for (int e = 0; e < 8; ++e) { const float cx = cv[e] * xv[e]; const float y = w0[e] * cm2[e] + w1[e] * cm1[e] + w2[e] * cx; o[e] = bv[e] * y * (gv[e] * sigmoidf_(gv[e])); cm2[e] = cm1[e]; cm1[e] = cx; }
            u32x4 w; w.x = pk2(o[0], o[1]); w.y = pk2(o[2], o[3]); w.z = pk2(o[4], o[5]); w.w = pk2(o[6], o[7]);
            *(u32x4*)(yp + (size_t)t * DM) = w;
        }
    }
}


#ifdef DEBUG_NAIVE_MIX
__global__ void __launch_bounds__(64) naive_mixA(Mix X, const float* wr, const float* wi) {
    const int b = blockIdx.x / 16, hd = blockIdx.x % 16, lane = threadIdx.x, ch = hd * 64 + lane;
    __shared__ float xs[64];
    const float w0 = X.conv_a_w[ch], w1 = X.conv_a_w[1024 + ch], w2 = X.conv_a_w[2048 + ch], w3 = X.conv_a_w[3072 + ch], cb = X.conv_a_b[ch];
    const float br = X.lru_br[ch], bi = X.lru_bi[ch];
    const float sp = log1pf(expf(-X.lru_lambda[ch]));
    const float* wrh = wr + (size_t)hd * 4096 + lane; const float* wih = wi + (size_t)hd * 4096 + lane;
    float h = 0.f, xm3 = 0.f, xm2 = 0.f, xm1 = 0.f;
    for (int p = 0; p < NMETA + SEQ; ++p) {
        const int row = p < NMETA ? META0 + p : b * SEQ + (p - NMETA);
        const float x0 = bf1(X.U[(size_t)row * DIN + ch]);
        const float xc = cb + w0 * xm3 + w1 * xm2 + w2 * xm1 + w3 * x0; xm3 = xm2; xm2 = xm1; xm1 = x0;
        xs[lane] = xc; __syncthreads();
        float rp = br, ip = bi;
#pragma unroll 4
        for (int i = 0; i < 64; ++i) { rp += xs[i] * wrh[i * 64]; ip += xs[i] * wih[i * 64]; }
        __syncthreads();
        const float r = 1.f / (1.f + expf(-rp)), ig = 1.f / (1.f + expf(-ip));
        const float la = -8.f * r * sp; const float a = expf(la); const float bb = sqrtf(-expm1f(2.f * la)) * (ig * xc);
        h = a * h + bb;
        const float g = bf1(X.U[(size_t)row * DIN + 1024 + ch]);
        const float y = h * g / (1.f + expf(-g));
        if (p >= NMETA || b == 0) X.Y[(size_t)row * DM + ch] = (bf16_t)f2bf(y);
    }
}
__global__ void naive_mixB(Mix X) {
    for (size_t idx = (size_t)blockIdx.x * blockDim.x + threadIdx.x; idx < (size_t)(MROWS + NMETA) * 1024; idx += (size_t)gridDim.x * blockDim.x) {
        const int row = (int)(idx >> 10), c = (int)(idx & 1023);
        int r1, r2;
        if (row >= META0) { const int p = row - META0; r1 = p >= 1 ? row - 1 : -1; r2 = p >= 2 ? row - 2 : -1; }
        else { const int t = row & (SEQ - 1); r1 = t >= 1 ? row - 1 : META0 + 15; r2 = t >= 2 ? row - 2 : META0 + 14 + t; }
        auto cx = [&](int r) -> float { return r < 0 ? 0.f : bf1(X.U[(size_t)r * DIN + 3072 + c]) * bf1(X.U[(size_t)r * DIN + 4096 + c]); };
        const float y = X.conv_b_w[c] * cx(r2) + X.conv_b_w[1024 + c] * cx(r1) + X.conv_b_w[2048 + c] * cx(row);
        const float bv = bf1(X.U[(size_t)row * DIN + 2048 + c]), g = bf1(X.U[(size_t)row * DIN + 5120 + c]);
        X.Y[(size_t)row * DM + 1024 + c] = (bf16_t)f2bf(bv * y * g / (1.f + expf(-g)));
    }
}
#endif
#define XB_TMO      128
#define XB_XCNT(j)  (256  + 64 * (j))
#define XB_XSUB(j)  (1280 + 64 * (j))
#define XB_XGEN(j)  (2304 + 64 * (j))
#define XB_TOP      3328
#define XB_TOPGEN   3392
#define XCD_BAR_WORDS 3456
#define XB_SPIN_CAP (1u << 18)

__device__ __forceinline__ unsigned xb_ld(unsigned* p)              { return __hip_atomic_load(p, __ATOMIC_RELAXED, __HIP_MEMORY_SCOPE_AGENT); }
__device__ __forceinline__ unsigned xb_add(unsigned* p, unsigned v) { return __hip_atomic_fetch_add(p, v, __ATOMIC_RELAXED, __HIP_MEMORY_SCOPE_AGENT); }
__device__ __forceinline__ unsigned xb_xcc_id() { return (unsigned)__builtin_amdgcn_s_getreg((3 << 11) | 20) & 0xFu; }
#define XB_SPIN(cond, bar) do { unsigned _sp = 0; while (cond) { __builtin_amdgcn_s_sleep(1); \
    if ((++_sp & 255u) == 0u) { if (xb_ld(&(bar)[XB_TMO])) break; if (_sp > XB_SPIN_CAP) { atomicAdd(&(bar)[XB_TMO], 1u); break; } } } } while (0)

struct XcdBarrier {
    unsigned* bar; unsigned x;
    volatile LAS unsigned* st;
};

__device__ __forceinline__ XcdBarrier xcd_barrier_post(unsigned* bar, volatile LAS unsigned* st) {
    XcdBarrier b; b.bar = bar; b.x = xb_xcc_id(); b.st = st;
    if (threadIdx.x == 0) (void)xb_add(&bar[XB_XCNT(b.x)], 1u);
    return b;
}
__device__ __forceinline__ void xcd_barrier_complete(unsigned* bar, unsigned x, unsigned& nloc, unsigned& nx) {
    const unsigned G = gridDim.x * gridDim.y * gridDim.z;
    unsigned sum, cnt, mine, sp = 0u;
    for (;;) {
        sum = 0u; cnt = 0u; mine = 0u;
#pragma unroll
        for (unsigned j = 0; j < 16; ++j) { const unsigned c = xb_ld(&bar[XB_XCNT(j)]); sum += c; cnt += (c > 0u) ? 1u : 0u; mine = (j == x) ? c : mine; }
        if (sum == G) break;
        __builtin_amdgcn_s_sleep(1);
        if ((++sp & 255u) == 0u) { if (xb_ld(&bar[XB_TMO])) break; if (sp > XB_SPIN_CAP) { atomicAdd(&bar[XB_TMO], 1u); break; } }
    }
    nloc = mine > 0u ? mine : 1u; nx = cnt > 0u ? cnt : 1u;
}

__device__ __forceinline__ void xcd_barrier(const XcdBarrier& b) {
    asm volatile("s_waitcnt vmcnt(0)" ::: "memory");
    __syncthreads();
    if (threadIdx.x == 0) {
        unsigned* bar = b.bar;
        __builtin_amdgcn_s_waitcnt(0);
        unsigned nloc = b.st[0], nx = b.st[1];
        if (nloc == 0u) { xcd_barrier_complete(bar, b.x, nloc, nx); b.st[0] = nloc; b.st[1] = nx; }
        const unsigned old = xb_add(&bar[XB_XSUB(b.x)], 1u);
        const unsigned gen = old / nloc;
        if (old + 1u == (gen + 1u) * nloc) {
            __builtin_amdgcn_fence(__ATOMIC_RELEASE, "agent");
            asm volatile("s_waitcnt vmcnt(0)" ::: "memory");
            const unsigned og = xb_add(&bar[XB_TOP], 1u);
            const unsigned tg = og / nx;
            if (og + 1u == (tg + 1u) * nx) xb_add(&bar[XB_TOPGEN], 1u);
            else XB_SPIN(xb_ld(&bar[XB_TOPGEN]) == tg, bar);
            __builtin_amdgcn_fence(__ATOMIC_ACQUIRE, "agent");
            xb_add(&bar[XB_XGEN(b.x)], 1u);
            asm volatile("s_waitcnt vmcnt(0)" ::: "memory");
        } else {
            XB_SPIN(xb_ld(&bar[XB_XGEN(b.x)]) == gen, bar);
            __builtin_amdgcn_fence(__ATOMIC_ACQUIRE, "agent");
            asm volatile("s_waitcnt vmcnt(0)" ::: "memory");
        }
    }
    __syncthreads();
}

__global__ void __launch_bounds__(512, 2) hymba_fwd(Args a) {
    extern __shared__ __attribute__((aligned(16))) unsigned char lds_raw[];
    LAS unsigned char* lds = (LAS unsigned char*)lds_raw;
    cg::grid_group grid = cg::this_grid();
    const int NGW = gridDim.x * 8;
    if (threadIdx.x < 64) ((LAS unsigned*)(lds + 131072))[threadIdx.x] = 0u;
    __syncthreads();
    XcdBarrier xbar; xbar.bar = (unsigned*)(a.ws + WS_BAR); xbar.x = 0; xbar.st = nullptr;
    if (a.ph_hi - a.ph_lo > 1) xbar = xcd_barrier_post((unsigned*)(a.ws + WS_BAR), (volatile LAS unsigned*)(lds + 131072));
    if (a.ph_lo < 0) grid.sync();
#define LAUNDER() int tid = threadIdx.x; asm volatile("" : "+v"(tid)); const int wid = __builtin_amdgcn_readfirstlane(tid >> 6), lane = tid & 63, gw = blockIdx.x * 8 + wid
    const int lo = a.ph_lo, hi = a.ph_hi;
#define IN(k) (lo <= (k) && (k) < hi)
#ifndef STAGGER_N
#define STAGGER_N 0
#endif
#define STAGGER() do { if (STAGGER_N) for (int _k = 0; _k < (int)(blockIdx.x & 7); ++_k) __builtin_amdgcn_s_sleep(STAGGER_N); } while (0)
#define SEAM(k) do { if (IN(k) && IN((k) + 1)) { xcd_barrier(xbar); if ((REP_MASK >> 10) & 1) { xcd_barrier(xbar); xcd_barrier(xbar); } } } while (0)
    const float* x = a.in[0]; const float* meta = a.in[1]; const float* norm_g = a.in[2]; const float* w_in = a.in[3];
    const float* conv_a_w = a.in[4]; const float* conv_a_b = a.in[5]; const float* lru_wr = a.in[6]; const float* lru_br = a.in[7];
    const float* lru_wi = a.in[8]; const float* lru_bi = a.in[9]; const float* lru_lambda = a.in[10]; const float* conv_b_w = a.in[11];
    const float* w_out = a.in[12]; const float* final_g = a.in[13];
    unsigned char* ws = a.ws;
    bf16_t* WTIN = (bf16_t*)(ws + WS_WTIN); bf16_t* WTOUT = (bf16_t*)(ws + WS_WTOUT); bf16_t* GW = (bf16_t*)(ws + WS_GW);
    float* ROWSS = (float*)(ws + WS_ROWSS); unsigned long long* AGG = (unsigned long long*)(ws + WS_AGG);
    bf16_t* XB = (bf16_t*)(ws + WS_XB); bf16_t* Y = (bf16_t*)(ws + WS_Y); bf16_t* U = (bf16_t*)(ws + WS_U);

    if (IN(0)) for (int rep = 0; rep <= ((REP_MASK >> 0) & 1); ++rep) {
        LAUNDER();
        LAS unsigned char* scr = lds + wid * 16384;
        constexpr int I_IN = (DM / 64) * (DIN / 64), I_OUT = (DM / 64) * (DM / 64);
        constexpr int NIT = 2 * I_IN + 2 * I_OUT + 64;
        for (int it = gw; it < NIT; it += NGW) {
            int r = it;
            if (r < 2 * I_IN) { const int l = r / I_IN; tr_item(w_in + (size_t)l * DM * DIN, DM, DIN, WTIN + (size_t)l * DIN * DM, norm_g + l * DM, scr, r % I_IN, lane); continue; } r -= 2 * I_IN;
            if (r < 2 * I_OUT) { const int l = r / I_OUT; tr_item(w_out + (size_t)l * DM * DM, DM, DM, WTOUT + (size_t)l * DM * DM, nullptr, scr, r % I_OUT, lane); continue; } r -= 2 * I_OUT;
            { const int mtx = r, l = mtx >> 5, g = (mtx >> 4) & 1, hd = mtx & 15;
              const float* src = (g ? lru_wi : lru_wr) + (size_t)(l * 16 + hd) * 4096;
              tr_item(src, 64, 64, GW + (size_t)mtx * 4096, nullptr, scr, 0, lane); }
        }
        for (int m = gw; m < MROWS + NMETA; m += NGW) {
            const float* src = m < MROWS ? x + (size_t)m * DM : meta + (size_t)(m - MROWS) * DM;
            cvt_row(src, XB + (size_t)m * DM, ROWSS + m, lane);
        }
        for (int i = blockIdx.x * 512 + tid; i < 2 * RSTR; i += gridDim.x * 512) ROWSS[RSTR + i] = 0.f;
        for (int i = blockIdx.x * 512 + tid; i < AGG_PER_LAYER; i += gridDim.x * 512) ((u32x4*)AGG)[i] = (u32x4){0u, 0u, 0u, 0u};
    }
    SEAM(0);

#pragma unroll 1
    for (int l = 0; l < 2; ++l) {
        const int pb = 1 + 3 * l;
        const bf16_t* wtin = WTIN + (size_t)l * DIN * DM; const bf16_t* wtout = WTOUT + (size_t)l * DM * DM;
        float* rss_in = ROWSS + (size_t)l * RSTR; float* rss_out = ROWSS + (size_t)(l + 1) * RSTR;
        Mix X; X.conv_a_w = conv_a_w + l * 4 * DLRU; X.conv_a_b = conv_a_b + l * DLRU; X.lru_br = lru_br + l * DLRU; X.lru_bi = lru_bi + l * DLRU; X.lru_lambda = lru_lambda + l * DLRU;
        X.conv_b_w = conv_b_w + l * 3 * DLRU; X.gw = GW + (size_t)l * 2 * 16 * 4096; X.U = U; X.Y = Y; X.AGG = AGG + (size_t)l * AGG_PER_LAYER;

        if (IN(pb)) for (int rep = 0; rep <= ((REP_MASK >> pb) & 1); ++rep) {
            LAUNDER();
            STAGGER();
            for (int mrep = 0; mrep <= ((REP_MASK >> 16) & 1); ++mrep)
            meta_gemm(XB + (size_t)META0 * DM, wtin, DIN / 16, lds, wid, lane, [&](int m, int n0, f32x4 s) {
                const float rs = rsqrtf(rss_in[META0 + m] * (1.0f / DM) + RMS_EPS);
                u32x2 w; w.x = pk2(s[0] * rs, s[1] * rs); w.y = pk2(s[2] * rs, s[3] * rs);
                *(u32x2*)(U + (size_t)(META0 + m) * DIN + n0) = w; });
            pg8::Gemm g{XB, wtin, MROWS, DIN, DM}; pg8::StaticOrder S; S.init(MROWS, DIN, (int)gridDim.x, (int)blockIdx.x);
            if ((REP_MASK >> 17) & 1) { EpiUT<true> En{U, rss_in}; pg8::gemm_phase<EpiUT<true>, pg8::StaticOrder, false>(lds, g, S, En, nullptr); }
            if ((REP_MASK >> 15) & 1) { EpiNull En{ROWSS + (size_t)3 * RSTR}; pg8::gemm_phase<EpiNull, pg8::StaticOrder, false>(lds, g, S, En, nullptr); }
            EpiU E{U, rss_in};
            pg8::gemm_phase<EpiU, pg8::StaticOrder, false>(lds, g, S, E, nullptr);
        }
        SEAM(pb);
        if (IN(pb + 1)) for (int rep = 0; rep <= ((REP_MASK >> (pb + 1)) & 1); ++rep) {
            LAUNDER();
#pragma unroll 1
            for (int step = 0; step < 2; ++step) {
                if ((step == 0) == (wid < 4)) {
                    if (rep == 1 && ((REP_MASK >> 13) & 1)) continue;
#pragma unroll 1
                    for (int id = gw; id < N_ITEMS; id += NGW) { if (id < 16) mix_item<true>(X, id, lds + wid * 9216, lane); else mix_item<false>(X, id, lds + wid * 9216, lane); }
                } else { if (rep == 1 && ((REP_MASK >> 12) & 1)) continue; partb(X, tid); }
            }
        }
        SEAM(pb + 1);
        if (IN(pb + 2)) {
            LAUNDER();
            STAGGER();
            if (l == 0) {
                meta_gemm(Y + (size_t)META0 * DM, wtout, DM / 16, lds, wid, lane, [&](int m, int n0, f32x4 s) {
                    const f32x4 r = *(const f32x4*)(meta + (size_t)m * DM + n0); const f32x4 hh = r + s;
                    u32x2 w; w.x = pk2(hh[0], hh[1]); w.y = pk2(hh[2], hh[3]);
                    *(u32x2*)(XB + (size_t)(META0 + m) * DM + n0) = w;
                    unsafeAtomicAdd(rss_out + META0 + m, (hh[0] * hh[0] + hh[1] * hh[1]) + (hh[2] * hh[2] + hh[3] * hh[3])); });
            }
            pg8::Gemm g{Y, wtout, MROWS, DM, DM};
            if (l == 0) {
                pg8::StaticOrder S; S.init(MROWS, DM, (int)gridDim.x, (int)blockIdx.x);
                if ((REP_MASK >> 11) & 1) { EpiU Ed{U, rss_in}; pg8::gemm_phase<EpiU, pg8::StaticOrder, false>(lds, g, S, Ed, nullptr); }
                if ((REP_MASK >> 14) & 1) { EpiRes Ed{x, a.out, XB, ROWSS + (size_t)3 * RSTR}; pg8::gemm_phase<EpiRes, pg8::StaticOrder, false>(lds, g, S, Ed, nullptr); }
                EpiRes E{x, a.out, XB, rss_out};
                pg8::gemm_phase<EpiRes, pg8::StaticOrder, false>(lds, g, S, E, nullptr);
            } else {
                PanelOrder S; S.init((int)gridDim.x, (int)blockIdx.x);
                EpiResNorm E{a.out, a.out, rss_out, (unsigned*)(ws + WS_PCNT), final_g};
                pg8::gemm_phase<EpiResNorm, PanelOrder, false>(lds, g, S, E, nullptr);
            }
        }
        SEAM(pb + 2);
    }

#undef IN
#undef SEAM
}

#ifndef MK_LAUNCH_PER_PHASE
#define MK_LAUNCH_PER_PHASE 0
#endif
extern "C" void kernel_launch(void* const* d_in, const int* in_sizes, int n_in, void* d_out, int out_size, void* d_ws, size_t ws_size, hipStream_t stream) {
    static int grid = 0;
    if (grid == 0) {
        if (n_in != 14 || in_sizes[0] != MROWS * DM || out_size != MROWS * DM || ws_size < WS_END) { fprintf(stderr, "kernel_launch: unexpected shapes (n_in %d, in0 %d, out %d, ws %zu)\n", n_in, n_in > 0 ? in_sizes[0] : -1, out_size, ws_size); grid = -1; return; }
        int dev = 0, cus = 0, per_cu = 0;
        hipGetDevice(&dev); hipDeviceGetAttribute(&cus, hipDeviceAttributeMultiprocessorCount, dev);
        if (hipFuncSetAttribute((const void*)hymba_fwd, hipFuncAttributeMaxDynamicSharedMemorySize, LDS_BYTES) != hipSuccess) { fprintf(stderr, "kernel_launch: hipFuncSetAttribute failed\n"); grid = -1; return; }
        if (hipOccupancyMaxActiveBlocksPerMultiprocessor(&per_cu, (const void*)hymba_fwd, 512, LDS_BYTES) != hipSuccess || per_cu < 1) { fprintf(stderr, "kernel_launch: occupancy query gave %d\n", per_cu); per_cu = 1; }
        (void)hipGetLastError();
        grid = cus * per_cu;
    }
    if (grid < 0) return;
    Args a{};
    for (int i = 0; i < 14; ++i) a.in[i] = (const float*)d_in[i];
    a.out = (float*)d_out; a.ws = (unsigned char*)d_ws;
#if MK_LAUNCH_PER_PHASE
    for (int p = 0; p < NPHASE; ++p) {
#ifdef DEBUG_NAIVE_MIX
        if (p == 2 || p == 6) { const int l = p / 4; unsigned char* ws = (unsigned char*)d_ws;
            Mix X; X.conv_a_w = a.in[4] + l * 4 * DLRU; X.conv_a_b = a.in[5] + l * DLRU; X.lru_br = a.in[7] + l * DLRU; X.lru_bi = a.in[9] + l * DLRU; X.lru_lambda = a.in[10] + l * DLRU;
            X.conv_b_w = a.in[11] + l * 3 * DLRU; X.gw = nullptr; X.U = (bf16_t*)(ws + WS_U); X.Y = (bf16_t*)(ws + WS_Y); X.HP = nullptr; X.AGG = nullptr;
#if DEBUG_NAIVE_MIX == 1
            hipLaunchKernelGGL(naive_mixA, dim3(64), dim3(64), 0, stream, X, a.in[6] + (size_t)l * 16 * 4096, a.in[8] + (size_t)l * 16 * 4096);
            a.flags = 1;
#else
            hipLaunchKernelGGL(naive_mixB, dim3(2048), dim3(256), 0, stream, X);
            a.flags = 2;
#endif
            }
        else a.flags = 0;
#if DEBUG_NAIVE_MIX == 1
        if (p == 3 || p == 7) continue;
#endif
#endif
        a.ph_lo = p; a.ph_hi = p + 1; hipLaunchKernelGGL(hymba_fwd, dim3(grid), dim3(512), LDS_BYTES, stream, a); }
#else
    a.ph_lo = 0; a.ph_hi = NPHASE;
    if (hipMemsetAsync((unsigned char*)d_ws + WS_BAR, 0, 16384 + 32768, stream) != hipSuccess) { fprintf(stderr, "kernel_launch: memset of barrier words failed\n"); return; }
    void* args[] = {&a};
    const hipError_t e = hipLaunchCooperativeKernel((const void*)hymba_fwd, dim3(grid), dim3(512), args, LDS_BYTES, stream);
    if (e != hipSuccess) fprintf(stderr, "kernel_launch: cooperative launch failed: %s (grid %d)\n", hipGetErrorString(e), grid);
#endif
}
```

```cpp
#include <hip/hip_runtime.h>
#include <hip/hip_cooperative_groups.h>
#include <cstdio>
namespace cg = cooperative_groups;
namespace pg8 {
#define PG8_LAS __attribute__((address_space(3)))
typedef unsigned short bf16_t;
typedef short bf16x8 __attribute__((ext_vector_type(8)));
typedef float f32x4 __attribute__((ext_vector_type(4)));
typedef unsigned u32x4 __attribute__((ext_vector_type(4)));
constexpr int BM = 256, BK = 64, HALF = 128, HTB = HALF * BK * 2  , STAGE_BYTES = 8 * HTB, NXCD = 8, WGM = 8;

__host__ __device__ __forceinline__ int lds_byte(int r, int c) { const int st = (r >> 4) * 2 + (c >> 5), rr = r & 15, cc = c & 31, ob = rr * 64 + cc * 2; return st * 1024 + (ob ^ (((ob >> 9) & 1) << 5)); }
__host__ __device__ __forceinline__ void stage_rc(int b, int& R, int& C) { const int st = b / 1024, sb = b % 1024, swz = sb ^ (((sb >> 9) & 1) << 5); R = (st >> 1) * 16 + swz / 64; C = (st & 1) * 32 + (swz % 64) / 2; }
__host__ __device__ __forceinline__ int perm32(int rho) { const int n = rho >> 4, i = rho & 15; return 8 * (i >> 2) + 4 * n + (i & 3); }

struct Unit { int pm, pn; };
struct Gemm { const bf16_t* A; const bf16_t* Bt; int M, N, K; };

struct StaticOrder {
    int nM, nN, nwg, G, c;
    __host__ __device__ void init(int M, int N, int G_, int c_) { nM = M / BM; nN = N / BM; nwg = nM * nN; G = G_; c = c_; }
    __host__ __device__ bool next(int i, Unit& u) const {
        const long L = (long)i * G + c; if (L >= nwg) return false;
        int wgid = (int)L; { const int q = nwg / NXCD, r = nwg % NXCD, xcd = wgid % NXCD, off = wgid / NXCD; wgid = (xcd < r ? xcd * (q + 1) : r * (q + 1) + (xcd - r) * q) + off; }
        const int nig = WGM * nN, gid = wgid / nig, fm = gid * WGM, gsz = (nM - fm) < WGM ? (nM - fm) : WGM;
        u.pm = fm + ((wgid % nig) % gsz); u.pn = (wgid % nig) / gsz; return true;
    }
    __device__ __forceinline__ void a_ready(const Unit&) const {}
    __device__ __forceinline__ void done(const Unit&) const {}
};
__device__ __forceinline__ unsigned cvt_pk_bf16(float lo, float hi) { unsigned r; asm volatile("v_cvt_pk_bf16_f32 %0, %1, %2" : "=v"(r) : "v"(lo), "v"(hi)); return r; }
template <class Epi, class Sched, bool STAMP = false>
__device__ __forceinline__ void gemm_phase(PG8_LAS unsigned char* lds, const Gemm g, const Sched& S, const Epi& E, unsigned long long* stamps) {
    int tid_l = threadIdx.x; asm volatile("" : "+v"(tid_l));
    const int tid = tid_l, wid = __builtin_amdgcn_readfirstlane(tid >> 6), lane = tid & 63, wr = wid >> 2, wc = wid & 3, fr = lane & 15, fq = lane >> 4;
    const int K = g.K, nt = K / BK;
    int ts_lo = 0, ts_hi = 0, nts = 0; const unsigned long long rt_entry = STAMP ? (unsigned long long)wall_clock64() : 0ull;
#define PG8_STAMP() do { if (STAMP && wid == 0 && nts < 64) { const unsigned long long _c = (unsigned long long)clock64(); \
        ts_lo = (lane == nts) ? (int)(unsigned)_c : ts_lo; ts_hi = (lane == nts) ? (int)(unsigned)(_c >> 32) : ts_hi; ++nts; } } while (0)
    PG8_STAMP();
    unsigned voffA[2], voffB[2];
#pragma unroll
    for (int i = 0; i < 2; ++i) { int R, C; stage_rc(tid * 16 + i * 8192, R, C); const int Rb = Epi::PERM ? ((R & ~31) + perm32(R & 31)) : R;
        voffA[i] = (unsigned)(R * K + C) * 2u; voffB[i] = (unsigned)(Rb * K + C) * 2u; }
    const size_t kstep = (size_t)(BK * 2);
    const size_t hstep = (size_t)HALF * K * 2;
    const size_t tstep = 2 * hstep;
    const unsigned ldsw = (unsigned)wid * 1024u;
    const int aoff = lds_byte(wr * 64 + fr, fq * 8), boff = lds_byte(wc * 32 + fr, fq * 8);
#define PG8_SA(b, h) (((b) * 2 + (h)) * HTB)
#define PG8_SB(b, h) ((4 + (b) * 2 + (h)) * HTB)
#define PG8_STAGE(bufoff, gbase, voff) do { _Pragma("unroll") for (int _i = 0; _i < 2; ++_i) \
        __builtin_amdgcn_global_load_lds((const unsigned*)((const char*)(gbase) + (voff)[_i]), (PG8_LAS unsigned*)(lds + (bufoff) + ldsw + _i * 8192), 16, 0, 0); } while (0)
#define PG8_LDA(dst, b, h) do { _Pragma("unroll") for (int m = 0; m < 4; ++m) _Pragma("unroll") for (int k = 0; k < 2; ++k) dst[m][k] = *(const PG8_LAS bf16x8*)(lds + PG8_SA(b, h) + aoff + m * 2048 + k * 1024); } while (0)
#define PG8_LDB(dst, b, h) do { _Pragma("unroll") for (int n = 0; n < 2; ++n) _Pragma("unroll") for (int k = 0; k < 2; ++k) dst[n][k] = *(const PG8_LAS bf16x8*)(lds + PG8_SB(b, h) + boff + n * 2048 + k * 1024); } while (0)
#define PG8_MMA(ai, bj, At, Bt) do { __builtin_amdgcn_s_setprio(1); _Pragma("unroll") for (int m = 0; m < 4; ++m) _Pragma("unroll") for (int n = 0; n < 2; ++n) _Pragma("unroll") for (int k = 0; k < 2; ++k) \
        acc[ai][bj][m][n] = __builtin_amdgcn_mfma_f32_16x16x32_bf16(Bt[n][k], At[m][k], acc[ai][bj][m][n], 0, 0, 0); __builtin_amdgcn_s_setprio(0); } while (0)
#define PG8_WAIT_V(n) asm volatile("s_waitcnt vmcnt(" #n ")" ::: "memory")
#define PG8_WAIT_L(n) asm volatile("s_waitcnt lgkmcnt(" #n ")" ::: "memory")
#define PG8_BAR __builtin_amdgcn_s_barrier()
#define PG8_SCHED __builtin_amdgcn_sched_barrier(0)
    Unit cur, nxt; int ui = 0;
    if (!S.next(0, cur)) return;
    f32x4 acc[2][2][4][2];
#pragma unroll
    for (int a = 0; a < 2; ++a)
#pragma unroll
        for (int b = 0; b < 2; ++b)
#pragma unroll
            for (int m = 0; m < 4; ++m)
#pragma unroll
                for (int n = 0; n < 2; ++n) acc[a][b][m][n] = (f32x4){0.f, 0.f, 0.f, 0.f};
    bf16x8 At[4][2], B0[2][2], B1[2][2];
    const char* cA = (const char*)g.A + (size_t)cur.pm * tstep; const char* cB = (const char*)g.Bt + (size_t)cur.pn * tstep;
    S.a_ready(cur);
    PG8_STAGE(PG8_SB(0, 0), cB, voffB); PG8_STAGE(PG8_SA(0, 0), cA, voffA); PG8_STAGE(PG8_SB(0, 1), cB + hstep, voffB); PG8_STAGE(PG8_SA(0, 1), cA + hstep, voffA);
    if (wr == 1) PG8_BAR;
    PG8_WAIT_V(4); PG8_BAR;
    PG8_STAGE(PG8_SB(1, 0), cB + kstep, voffB); PG8_STAGE(PG8_SA(1, 0), cA + kstep, voffA); PG8_STAGE(PG8_SB(1, 1), cB + hstep + kstep, voffB);
    PG8_WAIT_V(6); PG8_BAR;
    PG8_STAMP();
    for (;;) {
        const bool has_next = S.next(ui + 1, nxt);
        const char* nA = has_next ? (const char*)g.A + (size_t)nxt.pm * tstep : cA; const char* nB = has_next ? (const char*)g.Bt + (size_t)nxt.pn * tstep : cB;
        for (int t = 0; t < nt; t += 2) {
            const bool last = (t == nt - 2);
            const char* a1 = cA + (size_t)(t + 1) * kstep;
            const char* a2 = last ? nA : cA + (size_t)(t + 2) * kstep; const char* b2 = last ? nB : cB + (size_t)(t + 2) * kstep;
            const char* a3 = a2 + kstep; const char* b3 = b2 + kstep;
            if (last && has_next) S.a_ready(nxt);
            PG8_LDB(B0, 0, 0); PG8_SCHED; PG8_LDA(At, 0, 0); PG8_STAGE(PG8_SA(1, 1), a1 + hstep, voffA);
            PG8_WAIT_L(8); PG8_BAR; PG8_WAIT_L(0); PG8_MMA(0, 0, At, B0); PG8_BAR; PG8_SCHED;
            PG8_LDB(B1, 0, 1); PG8_STAGE(PG8_SB(0, 0), b2, voffB);
            PG8_BAR; PG8_WAIT_L(0); PG8_MMA(0, 1, At, B1); PG8_BAR;
            PG8_LDA(At, 0, 1); PG8_STAGE(PG8_SA(0, 0), a2, voffA);
            PG8_BAR; PG8_WAIT_L(0); PG8_MMA(1, 0, At, B0); PG8_BAR; PG8_SCHED;
            PG8_STAGE(PG8_SB(0, 1), b2 + hstep, voffB);
            PG8_WAIT_V(6); PG8_BAR; PG8_MMA(1, 1, At, B1); PG8_BAR;
            PG8_LDB(B0, 1, 0); PG8_SCHED; PG8_LDA(At, 1, 0); PG8_STAGE(PG8_SA(0, 1), a2 + hstep, voffA);
            PG8_WAIT_L(8); PG8_BAR; PG8_WAIT_L(0); PG8_MMA(0, 0, At, B0); PG8_BAR; PG8_SCHED;
            PG8_LDB(B1, 1, 1); PG8_STAGE(PG8_SB(1, 0), b3, voffB);
            PG8_BAR; PG8_WAIT_L(0); PG8_MMA(0, 1, At, B1); PG8_BAR;
            PG8_LDA(At, 1, 1); PG8_STAGE(PG8_SA(1, 0), a3, voffA);
            PG8_BAR; PG8_WAIT_L(0); PG8_MMA(1, 0, At, B0); PG8_BAR; PG8_SCHED;
            PG8_STAGE(PG8_SB(1, 1), b3 + hstep, voffB);
            PG8_WAIT_V(6); PG8_BAR; PG8_MMA(1, 1, At, B1); PG8_BAR;
        }
        PG8_STAMP();
        if constexpr (!Epi::AFTER_DRAIN) { E(acc, cur, wr, wc, fr, fq); S.done(cur); }
        PG8_STAMP();
        if (!has_next) break;
#pragma unroll
        for (int a = 0; a < 2; ++a)
#pragma unroll
            for (int b = 0; b < 2; ++b)
#pragma unroll
                for (int m = 0; m < 4; ++m)
#pragma unroll
                    for (int n = 0; n < 2; ++n) acc[a][b][m][n] = (f32x4){0.f, 0.f, 0.f, 0.f};
        cur = nxt; cA = nA; cB = nB; ++ui;
    }
    PG8_WAIT_V(0);
    if (wr == 0) PG8_BAR;
    PG8_BAR;
    if constexpr (Epi::AFTER_DRAIN) { E.fused(acc, cur, wr, wc, fr, fq, lds, wid, lane); S.done(cur); }
    PG8_STAMP();
    if (STAMP && wid == 0) { stamps[lane] = lane < nts ? (((unsigned long long)(unsigned)ts_hi << 32) | (unsigned)ts_lo) : 0ull;
        if (lane == 62) stamps[62] = rt_entry; if (lane == 63) stamps[63] = (unsigned long long)wall_clock64(); }
#undef PG8_STAMP
#undef PG8_SA
#undef PG8_SB
#undef PG8_STAGE
#undef PG8_LDA
#undef PG8_LDB
#undef PG8_MMA
#undef PG8_WAIT_V
#undef PG8_WAIT_L
#undef PG8_BAR
#undef PG8_SCHED
}
}

#define LAS __attribute__((address_space(3)))
#define GAS __attribute__((address_space(1)))
typedef unsigned short bf16_t;
typedef short bf16x8 __attribute__((ext_vector_type(8)));
typedef float f32x4 __attribute__((ext_vector_type(4)));
typedef float f32x2 __attribute__((ext_vector_type(2)));
typedef float f32x16 __attribute__((ext_vector_type(16)));
typedef unsigned u32x4 __attribute__((ext_vector_type(4)));
typedef unsigned u32x2 __attribute__((ext_vector_type(2)));

constexpr int DM = 2048, NBATCH = 4, SEQ = 4096, MROWS = NBATCH * SEQ, NMETA = 16, DIN = 6144, DLRU = 1024, NHEAD = 16;
constexpr int META0 = MROWS;
constexpr int RSTR = MROWS + 64;
constexpr float RMS_EPS = 1e-6f;
constexpr int NPHASE = 7;
#ifndef REP_MASK
#define REP_MASK 0
#endif
constexpr int LDS_BYTES = 131072 + 256;

constexpr size_t MiB = 1u << 20;
constexpr size_t WS_WTIN = 0;
constexpr size_t WS_WTOUT = 48 * MiB;
constexpr size_t WS_GW = 64 * MiB;
constexpr size_t WS_ROWSS = 65 * MiB;
constexpr size_t WS_BAR = 65 * MiB + 512 * 1024;
constexpr size_t WS_PCNT = WS_BAR + 16384;
constexpr size_t WS_AGG = 66 * MiB;
constexpr size_t WS_XB = 71 * MiB;
constexpr size_t WS_Y = 136 * MiB;
constexpr size_t WS_U = 201 * MiB;
constexpr size_t WS_END = 396 * MiB;
constexpr int AGG_PER_LAYER = 257 * 1024;
static_assert(WS_U + (size_t)RSTR * DIN * 2 <= WS_END && WS_Y + (size_t)RSTR * DM * 2 <= WS_U && WS_XB + (size_t)RSTR * DM * 2 <= WS_Y, "ws map");
static_assert(WS_WTIN + (size_t)2 * DIN * DM * 2 <= WS_WTOUT && WS_WTOUT + (size_t)2 * DM * DM * 2 <= WS_GW && WS_AGG + (size_t)2 * AGG_PER_LAYER * 8 <= WS_XB && WS_ROWSS + (size_t)3 * RSTR * 4 <= WS_BAR, "ws map 2");

struct Args { const float* in[14]; float* out; unsigned char* ws; int ph_lo, ph_hi, flags, pad; };

__device__ __forceinline__ unsigned f2bf(float f) { unsigned u = __builtin_bit_cast(unsigned, f); return (u + 0x7fffu + ((u >> 16) & 1u)) >> 16; }
__device__ __forceinline__ unsigned pk2(float lo, float hi) { return f2bf(lo) | (f2bf(hi) << 16); }
__device__ __forceinline__ float bflo(unsigned w) { return __builtin_bit_cast(float, w << 16); }
__device__ __forceinline__ float bfhi(unsigned w) { return __builtin_bit_cast(float, w & 0xffff0000u); }
__device__ __forceinline__ float bf1(bf16_t v) { return __builtin_bit_cast(float, ((unsigned)v) << 16); }
__device__ __forceinline__ float sigmoidf_(float z) { return __builtin_amdgcn_rcpf(1.0f + __expf(-z)); }
__device__ __forceinline__ float wave_sum(float v) {
#pragma unroll
    for (int o = 1; o < 64; o <<= 1) v += __shfl_xor(v, o);
    return v;
}
#define LDS_WAIT() asm volatile("s_waitcnt lgkmcnt(0)" ::: "memory")

template <bool NORS> struct EpiUT {
    static constexpr bool PERM = true, AFTER_DRAIN = false;
    bf16_t* O; const float* rowss;
    __device__ __forceinline__ void operator()(const f32x4 (&acc)[2][2][4][2], const pg8::Unit& u, int wr, int wc, int fr, int fq) const {
        const int row0 = u.pm * 256 + wr * 64 + fr, col0 = u.pn * 256 + wc * 32 + 8 * fq;
#pragma unroll
        for (int ai = 0; ai < 2; ++ai)
#pragma unroll
            for (int m = 0; m < 4; ++m) {
                const int r = row0 + ai * 128 + m * 16;
                const float rs = NORS ? 1.0f : rsqrtf(rowss[r] * (1.0f / DM) + RMS_EPS);
                bf16_t* rowp = O + (size_t)r * DIN + col0;
#pragma unroll
                for (int bj = 0; bj < 2; ++bj) {
                    const f32x4 v0 = acc[ai][bj][m][0] * rs, v1 = acc[ai][bj][m][1] * rs;
                    u32x4 w; w.x = pg8::cvt_pk_bf16(v0[0], v0[1]); w.y = pg8::cvt_pk_bf16(v0[2], v0[3]); w.z = pg8::cvt_pk_bf16(v1[0], v1[1]); w.w = pg8::cvt_pk_bf16(v1[2], v1[3]);
                    *(u32x4*)(rowp + bj * 128) = w;
                }
            }
    }
};
struct EpiNull {
    static constexpr bool PERM = true, AFTER_DRAIN = false;
    float* sink;
    __device__ __forceinline__ void operator()(const f32x4 (&acc)[2][2][4][2], const pg8::Unit& u, int wr, int wc, int fr, int fq) const {
        f32x4 s = {0.f, 0.f, 0.f, 0.f};
#pragma unroll
        for (int ai = 0; ai < 2; ++ai)
#pragma unroll
            for (int bj = 0; bj < 2; ++bj)
#pragma unroll
                for (int m = 0; m < 4; ++m) { s += acc[ai][bj][m][0]; s += acc[ai][bj][m][1]; }
        if (s[0] + s[1] + s[2] + s[3] == 1.2345678e33f) sink[u.pm] = s[0];
    }
};
typedef EpiUT<false> EpiU;
#ifndef EPI_MB
#define EPI_MB 2
#endif
struct EpiRes {
    static constexpr bool PERM = true, AFTER_DRAIN = false;
    const float* res; float* out; bf16_t* xb; float* rowss;
    __device__ __forceinline__ void operator()(const f32x4 (&acc)[2][2][4][2], const pg8::Unit& u, int wr, int wc, int fr, int fq) const {
        const int row0 = u.pm * 256 + wr * 64 + fr, col0 = u.pn * 256 + wc * 32 + 8 * fq;
#pragma unroll
        for (int ai = 0; ai < 2; ++ai) {
#pragma unroll
          for (int mh = 0; mh < 4; mh += EPI_MB) {
            f32x4 rv[4][2][2];
#pragma unroll
            for (int m = mh; m < mh + EPI_MB; ++m)
#pragma unroll
                for (int bj = 0; bj < 2; ++bj) { const float* p = res + (size_t)(row0 + ai * 128 + m * 16) * DM + col0 + bj * 128; rv[m][bj][0] = *(const f32x4*)p; rv[m][bj][1] = *(const f32x4*)(p + 4); }
            asm volatile("" ::: "memory");
#pragma unroll
            for (int m = mh; m < mh + EPI_MB; ++m) {
                const int r = row0 + ai * 128 + m * 16; const size_t off = (size_t)r * DM + col0; float ss = 0.f;
#pragma unroll
                for (int bj = 0; bj < 2; ++bj) {
                    const f32x4 h0 = rv[m][bj][0] + acc[ai][bj][m][0], h1 = rv[m][bj][1] + acc[ai][bj][m][1];
                    if (out) { *(f32x4*)(out + off + bj * 128) = h0; *(f32x4*)(out + off + bj * 128 + 4) = h1; }
                    if (xb) { u32x4 w; w.x = pg8::cvt_pk_bf16(h0[0], h0[1]); w.y = pg8::cvt_pk_bf16(h0[2], h0[3]); w.z = pg8::cvt_pk_bf16(h1[0], h1[1]); w.w = pg8::cvt_pk_bf16(h1[2], h1[3]);
                        *(u32x4*)(xb + off + bj * 128) = w; }
                    ss += (h0[0] * h0[0] + h0[1] * h0[1]) + (h0[2] * h0[2] + h0[3] * h0[3]) + (h1[0] * h1[0] + h1[1] * h1[1]) + (h1[2] * h1[2] + h1[3] * h1[3]);
                }
                ss += __shfl_xor(ss, 16); ss += __shfl_xor(ss, 32);
                if (fq == 0) unsafeAtomicAdd(rowss + r, ss);
            }
            asm volatile("" ::: "memory");
          }
        }
    }
};

struct EpiResNorm {
    static constexpr bool PERM = true, AFTER_DRAIN = false;
    const bf16_t* res; float* out; float* rowss; unsigned* cnt; const float* fg;
    __device__ __forceinline__ void operator()(f32x4 (&acc)[2][2][4][2], const pg8::Unit& u, int wr, int wc, int fr, int fq) const {
        const int row0 = u.pm * 256 + wr * 64 + fr, col0 = u.pn * 256 + wc * 32 + 8 * fq;
#pragma unroll
        for (int ai = 0; ai < 2; ++ai) {
#pragma unroll
          for (int mh = 0; mh < 4; mh += EPI_MB) {
            u32x4 rw[4][2];
#pragma unroll
            for (int m = mh; m < mh + EPI_MB; ++m)
#pragma unroll
                for (int bj = 0; bj < 2; ++bj) rw[m][bj] = *(const u32x4*)(res + (size_t)(row0 + ai * 128 + m * 16) * DM + col0 + bj * 128);
            asm volatile("" ::: "memory");
#pragma unroll
            for (int m = mh; m < mh + EPI_MB; ++m) {
                float ss = 0.f;
#pragma unroll
                for (int bj = 0; bj < 2; ++bj) {
                    const u32x4 w = rw[m][bj];
                    const f32x4 h0 = (f32x4){bflo(w.x), bfhi(w.x), bflo(w.y), bfhi(w.y)} + acc[ai][bj][m][0], h1 = (f32x4){bflo(w.z), bfhi(w.z), bflo(w.w), bfhi(w.w)} + acc[ai][bj][m][1];
                    acc[ai][bj][m][0] = h0; acc[ai][bj][m][1] = h1;
                    ss += (h0[0] * h0[0] + h0[1] * h0[1]) + (h0[2] * h0[2] + h0[3] * h0[3]) + (h1[0] * h1[0] + h1[1] * h1[1]) + (h1[2] * h1[2] + h1[3] * h1[3]);
                }
                ss += __shfl_xor(ss, 16); ss += __shfl_xor(ss, 32);
                if (fq == 0) unsafeAtomicAdd(rowss + row0 + ai * 128 + m * 16, ss);
            }
            asm volatile("" ::: "memory");
          }
        }
        asm volatile("s_waitcnt vmcnt(0)" ::: "memory");
        unsigned* cw = cnt + 64 * (2 * u.pm + wr);
        if (fr == 0 && fq == 0) __hip_atomic_fetch_add(cw, 1u, __ATOMIC_RELAXED, __HIP_MEMORY_SCOPE_AGENT);
        f32x4 gv[2][2];
#pragma unroll
        for (int bj = 0; bj < 2; ++bj) { gv[bj][0] = *(const f32x4*)(fg + col0 + bj * 128); gv[bj][1] = *(const f32x4*)(fg + col0 + bj * 128 + 4); }
        { unsigned sp = 0;
          while ((unsigned)__builtin_amdgcn_readfirstlane(__hip_atomic_load(cw, __ATOMIC_RELAXED, __HIP_MEMORY_SCOPE_AGENT)) < 32u) { __builtin_amdgcn_s_sleep(1); if (++sp > (1u << 16)) break; } }
        asm volatile("" ::: "memory");
#pragma unroll
        for (int ai = 0; ai < 2; ++ai)
#pragma unroll
            for (int m = 0; m < 4; ++m) {
                const int r = row0 + ai * 128 + m * 16;
                const float rs = rsqrtf(__hip_atomic_load(rowss + r, __ATOMIC_RELAXED, __HIP_MEMORY_SCOPE_AGENT) * (1.0f / DM) + RMS_EPS);
                float* op = out + (size_t)r * DM + col0;
#pragma unroll
                for (int bj = 0; bj < 2; ++bj) { *(f32x4*)(op + bj * 128) = acc[ai][bj][m][0] * rs * gv[bj][0]; *(f32x4*)(op + bj * 128 + 4) = acc[ai][bj][m][1] * rs * gv[bj][1]; }
            }
    }
};
struct PanelOrder {
    int Gp, v;
    __device__ void init(int G, int c) { Gp = G & ~7; v = c; if ((Gp & 63) == 0) v = (c & 7) * (Gp >> 3) + (c >> 3); if (c >= Gp) v = -1; }
    __device__ bool next(int i, pg8::Unit& u) const { if (v < 0) return false; const long L = (long)i * Gp + v; if (L >= 64 * 8) return false; u.pm = (int)(L >> 3); u.pn = (int)(L & 7); return true; }
    __device__ __forceinline__ void a_ready(const pg8::Unit&) const {}
    __device__ __forceinline__ void done(const pg8::Unit&) const {}
};

template <class F> __device__ __forceinline__ void meta_gemm(const bf16_t* A, const bf16_t* Bt, int ngroups, LAS unsigned char* lds, int wid, int lane, F epi) {
    const int fr = lane & 15, fq = lane >> 4, half = wid >> 2, wq = wid & 3;
    LAS f32x4* red = (LAS f32x4*)lds;
    for (int p = blockIdx.x; 2 * p < ngroups; p += gridDim.x) {
        const int g = 2 * p + half;
        f32x4 acc = {0.f, 0.f, 0.f, 0.f};
        if (g < ngroups) {
            const bf16_t* ap = A + (size_t)fr * DM + wq * 512 + fq * 8;
            const bf16_t* bp = Bt + (size_t)(g * 16 + fr) * DM + wq * 512 + fq * 8;
            bf16x8 av[16], bv[16];
#pragma unroll
            for (int s = 0; s < 16; ++s) { av[s] = *(const bf16x8*)(ap + 32 * s); bv[s] = *(const bf16x8*)(bp + 32 * s); }
#pragma unroll
            for (int s = 0; s < 16; ++s) acc = __builtin_amdgcn_mfma_f32_16x16x32_bf16(bv[s], av[s], acc, 0, 0, 0);
        }
        red[wid * 64 + lane] = acc;
        __syncthreads();
        if (wq == 0 && g < ngroups) {
            f32x4 s = red[wid * 64 + lane];
#pragma unroll
            for (int w = 1; w < 4; ++w) s += red[(wid + w) * 64 + lane];
            epi(fr, g * 16 + 4 * fq, s);
        }
        __syncthreads();
    }
}

__device__ __forceinline__ void tr_item(const float* W, int K, int N, bf16_t* WT, const float* sc, LAS unsigned char* scr, int item, int lane) {
    const int nblk = N / 64, kb = item / nblk, nb = item % nblk, k0 = 64 * kb, n0 = 64 * nb;
    const int kr = lane >> 4, nc = (lane & 15) * 4;
    f32x4 v[16]; float g[16];
    { const float* p = W + (size_t)(k0 + kr) * N + n0 + nc;
#pragma unroll
      for (int i = 0; i < 16; ++i) { v[i] = *(const f32x4*)p; p += (size_t)4 * N; }
#pragma unroll
      for (int i = 0; i < 16; ++i) g[i] = sc ? sc[k0 + kr + 4 * i] : 1.0f; }
    asm volatile("" ::: "memory");
#pragma unroll
    for (int i = 0; i < 16; ++i) { const f32x4 s = v[i] * g[i]; u32x2 w; w.x = pg8::cvt_pk_bf16(s[0], s[1]); w.y = pg8::cvt_pk_bf16(s[2], s[3]);
        *(LAS u32x2*)(scr + (kr + 4 * i) * 136 + nc * 2) = w; }
    LDS_WAIT();
    const int c = lane & 7;
#pragma unroll
    for (int j = 0; j < 8; ++j) { const int n = (lane >> 3) + 8 * j; const LAS bf16_t* s = (const LAS bf16_t*)(scr + (8 * c) * 136 + n * 2);
        u32x4 o; o.x = (unsigned)s[0] | ((unsigned)s[68] << 16); o.y = (unsigned)s[2 * 68] | ((unsigned)s[3 * 68] << 16); o.z = (unsigned)s[4 * 68] | ((unsigned)s[5 * 68] << 16); o.w = (unsigned)s[6 * 68] | ((unsigned)s[7 * 68] << 16);
        *(u32x4*)(WT + (size_t)(n0 + n) * K + k0 + 8 * c) = o; }
    LDS_WAIT();
}
__device__ __forceinline__ void cvt_row(const float* src, bf16_t* dst, float* ss, int lane) {
    const f32x4* xr = (const f32x4*)src + lane; f32x4 v[8]; float s = 0.f;
#pragma unroll
    for (int j = 0; j < 8; ++j) { v[j] = xr[64 * j]; s += (v[j].x * v[j].x + v[j].y * v[j].y) + (v[j].z * v[j].z + v[j].w * v[j].w); }
    s = wave_sum(s);
    u32x2* o8 = (u32x2*)dst + lane;
#pragma unroll
    for (int j = 0; j < 8; ++j) { u32x2 w; w.x = pk2(v[j].x, v[j].y); w.y = pk2(v[j].z, v[j].w); o8[64 * j] = w; }
    if (lane == 0) *ss = s;
}

struct Mix {
    const float *conv_a_w, *conv_a_b, *lru_br, *lru_bi, *lru_lambda, *conv_b_w;
    const bf16_t* gw;
    bf16_t* U; bf16_t* Y; unsigned long long* AGG;
};
struct ItemId { int hd, b, c, row0, ntok, agg; bool meta; };
__device__ __forceinline__ ItemId decode_item(int id) {
    ItemId I;
    if (id < 16) { I.meta = true; I.hd = id; I.b = 0; I.c = 0; I.row0 = META0; I.ntok = 16; I.agg = 256; }
    else { const int j = id - 16; I.meta = false; I.hd = j & 15; I.c = (j >> 4) & 63; I.b = j >> 10; I.row0 = I.b * SEQ + I.c * 64; I.ntok = 64; I.agg = I.b * 64 + I.c; }
    return I;
}
constexpr int N_ITEMS = 16 + NBATCH * NHEAD * 64;

__device__ __forceinline__ bool agg_ok(unsigned long long v) { return (unsigned)v != 0u; }
template <bool META> __device__ __forceinline__ void mix_item(const Mix& X, int id, LAS unsigned char* xt, int lane) {
    constexpr int NT = META ? 16 : 64, NTB = META ? 1 : 2, NQ = META ? 2 : 4;
    constexpr float LOG2E = 1.4426950408889634f;
    const ItemId I = decode_item(id);
    const int ch = I.hd * 64 + lane;
    const float nls2 = -8.0f * LOG2E * log1pf(__expf(-X.lru_lambda[ch]));
    bf16_t raw[NT], rh0 = 0, rh1 = 0, rh2 = 0;
    const float w0 = X.conv_a_w[ch], w1 = X.conv_a_w[1024 + ch], w2 = X.conv_a_w[2048 + ch], w3 = X.conv_a_w[3072 + ch], cb = X.conv_a_b[ch];
    {
        const GAS bf16_t* sb = (const GAS bf16_t*)(X.U + (size_t)I.row0 * DIN + I.hd * 64);
        if (!META) { const GAS bf16_t* hp0 = (I.c == 0) ? (const GAS bf16_t*)(X.U + (size_t)(META0 + 13) * DIN + I.hd * 64) : sb - 3 * DIN; rh0 = hp0[lane]; rh1 = hp0[DIN + lane]; rh2 = hp0[2 * DIN + lane]; }
#pragma unroll
        for (int t = 0; t < NT; ++t) { raw[t] = sb[lane]; sb += DIN; asm volatile("" : "+s"(sb)); }
    }
    bf16x8 BfR0[4], BfR1[4], BfI0[4], BfI1[4];
    { const bf16_t* gr = X.gw + (size_t)(I.hd * 64 + (lane & 31)) * 64 + 8 * (lane >> 5); const bf16_t* gi = gr + 16 * 64 * 64;
#pragma unroll
      for (int s = 0; s < 4; ++s) { BfR0[s] = *(const bf16x8*)(gr + 16 * s); BfR1[s] = *(const bf16x8*)(gr + 32 * 64 + 16 * s); BfI0[s] = *(const bf16x8*)(gi + 16 * s); BfI1[s] = *(const bf16x8*)(gi + 32 * 64 + 16 * s); } }
    asm volatile("" ::: "memory");
    float xm3 = bf1(rh0), xm2 = bf1(rh1), xm1 = bf1(rh2);
#pragma unroll
    for (int t = 0; t < NT; ++t) { const float x0 = bf1(raw[t]); const float xc = cb + w0 * xm3 + w1 * xm2 + w2 * xm1 + w3 * x0; xm3 = xm2; xm2 = xm1; xm1 = x0;
        *(LAS bf16_t*)(xt + t * 144 + lane * 2) = (bf16_t)f2bf(xc); }
    const float brA = X.lru_br[I.hd * 64 + (lane & 31)], brB = X.lru_br[I.hd * 64 + 32 + (lane & 31)], biA = X.lru_bi[I.hd * 64 + (lane & 31)], biB = X.lru_bi[I.hd * 64 + 32 + (lane & 31)];
    float h = 0.f, P = 1.f;
    unsigned hp[NT];
#pragma unroll
    for (int tb = 0; tb < NTB; ++tb) {
        f32x16 aR0, aR1, aI0, aI1;
#pragma unroll
        for (int e = 0; e < 16; ++e) { aR0[e] = brA; aR1[e] = brB; aI0[e] = biA; aI1[e] = biB; }
#pragma unroll
        for (int s = 0; s < 4; ++s) {
            const bf16x8 af = *(const LAS bf16x8*)(xt + (tb * 32 + (lane & 31)) * 144 + (16 * s + 8 * (lane >> 5)) * 2);
            aR0 = __builtin_amdgcn_mfma_f32_32x32x16_bf16(af, BfR0[s], aR0, 0, 0, 0);
            aR1 = __builtin_amdgcn_mfma_f32_32x32x16_bf16(af, BfR1[s], aR1, 0, 0, 0);
            aI0 = __builtin_amdgcn_mfma_f32_32x32x16_bf16(af, BfI0[s], aI0, 0, 0, 0);
            aI1 = __builtin_amdgcn_mfma_f32_32x32x16_bf16(af, BfI1[s], aI1, 0, 0, 0);
        }
#pragma unroll
        for (int q = 0; q < NQ; ++q) {
            float Rv[2][4], Iv[2][4];
#pragma unroll
            for (int k = 0; k < 4; ++k) {
                const int reg = 4 * q + k;
                const float r0f = aR0[reg], r1f = aR1[reg], i0f = aI0[reg], i1f = aI1[reg];
                auto r = __builtin_amdgcn_permlane32_swap(__float_as_uint(r0f), __float_as_uint(r1f), false, false);
                Rv[0][k] = __uint_as_float(r[0]); Rv[1][k] = __uint_as_float(r[1]);
                auto i2 = __builtin_amdgcn_permlane32_swap(__float_as_uint(i0f), __float_as_uint(i1f), false, false);
                Iv[0][k] = __uint_as_float(i2[0]); Iv[1][k] = __uint_as_float(i2[1]);
            }
#pragma unroll
            for (int st = 0; st < 2; ++st)
#pragma unroll
                for (int p = 0; p < 2; ++p) {
                    const int t = tb * 32 + 8 * q + 4 * st + 2 * p;
                    f32x2 er = (f32x2){Rv[st][2 * p], Rv[st][2 * p + 1]} * (-LOG2E), ei = (f32x2){Iv[st][2 * p], Iv[st][2 * p + 1]} * (-LOG2E);
                    er.x = __builtin_amdgcn_exp2f(er.x); er.y = __builtin_amdgcn_exp2f(er.y); ei.x = __builtin_amdgcn_exp2f(ei.x); ei.y = __builtin_amdgcn_exp2f(ei.y);
                    er = er + 1.0f; ei = ei + 1.0f;
                    f32x2 rg, ig; rg.x = __builtin_amdgcn_rcpf(er.x); rg.y = __builtin_amdgcn_rcpf(er.y); ig.x = __builtin_amdgcn_rcpf(ei.x); ig.y = __builtin_amdgcn_rcpf(ei.y);
                    const f32x2 l2 = rg * nls2;
                    f32x2 a; a.x = __builtin_amdgcn_exp2f(l2.x); a.y = __builtin_amdgcn_exp2f(l2.y);
                    f32x2 om = 1.0f - a * a; om.x = fmaxf(om.x, 0.f); om.y = fmaxf(om.y, 0.f);
                    f32x2 mu; mu.x = __builtin_amdgcn_sqrtf(om.x); mu.y = __builtin_amdgcn_sqrtf(om.y);
                    const f32x2 xc = (f32x2){bf1(*(const LAS bf16_t*)(xt + t * 144 + lane * 2)), bf1(*(const LAS bf16_t*)(xt + (t + 1) * 144 + lane * 2))};
                    const f32x2 bb = mu * ig * xc;
                    h = a.x * h + bb.x; P = P * a.x; hp[t] = pg8::cvt_pk_bf16(h, P);
                    h = a.y * h + bb.y; P = P * a.y; hp[t + 1] = pg8::cvt_pk_bf16(h, P);
                }
        }
    }
    __hip_atomic_store(X.AGG + (size_t)I.agg * 1024 + ch, ((unsigned long long)__float_as_uint(h) << 32) | (unsigned long long)__float_as_uint(P), __ATOMIC_RELAXED, __HIP_MEMORY_SCOPE_AGENT);
    asm volatile("" ::: "memory");
    bf16_t graw[NT];
    { const GAS bf16_t* sb = (const GAS bf16_t*)(X.U + (size_t)I.row0 * DIN + 1024 + I.hd * 64);
#pragma unroll
      for (int t = 0; t < NT; ++t) { graw[t] = sb[lane]; sb += DIN; asm volatile("" : "+s"(sb)); } }
    float hin = 0.f;
    if (!META) {
        { const unsigned long long* mp = X.AGG + (size_t)256 * 1024 + ch; unsigned long long v;
          for (;;) { v = __hip_atomic_load(mp, __ATOMIC_RELAXED, __HIP_MEMORY_SCOPE_AGENT); if (!__any(!agg_ok(v))) break; __builtin_amdgcn_s_sleep(2); }
          hin = __uint_as_float((unsigned)(v >> 32)); }
        const unsigned long long* ap = X.AGG + (size_t)(I.b * 64) * 1024 + ch;
        for (int j0 = 0; j0 < I.c; j0 += 16) {
            unsigned long long v[16];
            for (;;) {
                bool bad = false;
#pragma unroll
                for (int k = 0; k < 16; ++k) { v[k] = (j0 + k < I.c) ? __hip_atomic_load(ap + (size_t)(j0 + k) * 1024, __ATOMIC_RELAXED, __HIP_MEMORY_SCOPE_AGENT) : 0x000000003f800000ull; }
#pragma unroll
                for (int k = 0; k < 16; ++k) bad |= !agg_ok(v[k]);
                if (!__any(bad)) break;
                __builtin_amdgcn_s_sleep(2);
            }
#pragma unroll
            for (int k = 0; k < 16; ++k) hin = __uint_as_float((unsigned)v[k]) * hin + __uint_as_float((unsigned)(v[k] >> 32));
        }
    }
    asm volatile("" ::: "memory");
    GAS bf16_t* yp = (GAS bf16_t*)(X.Y + (size_t)I.row0 * DM + I.hd * 64);
#pragma unroll
    for (int t0 = 0; t0 < NT; t0 += 16) {
        {
#pragma unroll
            for (int k = 0; k < 16; k += 2) {
                const unsigned w0 = hp[t0 + k], w1 = hp[t0 + k + 1];
                const f32x2 gg = (f32x2){bf1(graw[t0 + k]), bf1(graw[t0 + k + 1])};
                f32x2 e = gg * (-LOG2E); e.x = __builtin_amdgcn_exp2f(e.x); e.y = __builtin_amdgcn_exp2f(e.y); e = e + 1.0f;
                f32x2 sg; sg.x = __builtin_amdgcn_rcpf(e.x); sg.y = __builtin_amdgcn_rcpf(e.y);
                const f32x2 hv = (f32x2){bflo(w0), bflo(w1)} + (f32x2){bfhi(w0), bfhi(w1)} * hin;
                const f32x2 y = hv * gg * sg;
                const unsigned pk = pg8::cvt_pk_bf16(y.x, y.y);
                yp[lane] = (bf16_t)(pk & 0xffffu); yp[DM + lane] = (bf16_t)(pk >> 16); yp += 2 * DM; asm volatile("" : "+s"(yp));
            }
        }
    }
}

__device__ __forceinline__ void ld8(const bf16_t* p, float (&o)[8]) {
    const u32x4 w = *(const u32x4*)p;
    o[0] = bflo(w.x); o[1] = bfhi(w.x); o[2] = bflo(w.y); o[3] = bfhi(w.y); o[4] = bflo(w.z); o[5] = bfhi(w.z); o[6] = bflo(w.w); o[7] = bfhi(w.w);
}
__device__ __forceinline__ void partb(const Mix& X, int tid) {
    for (int it = blockIdx.x * 512 + tid; it < 1025 * 128; it += gridDim.x * 512) {
        const int c0 = (it & 127) * 8, run = it >> 7;
        int row0, hrow = -1;
        if (run == 1024) row0 = META0; else { row0 = run * 16; hrow = ((row0 & (SEQ - 1)) == 0) ? META0 + 14 : row0 - 2; }
        float w0[8], w1[8], w2[8], cm2[8], cm1[8];
        { const f32x4* p = (const f32x4*)(X.conv_b_w + c0); const f32x4 a0 = p[0], a1 = p[1], b0 = p[256], b1 = p[257], d0 = p[512], d1 = p[513];
#pragma unroll
          for (int e = 0; e < 4; ++e) { w0[e] = a0[e]; w0[4 + e] = a1[e]; w1[e] = b0[e]; w1[4 + e] = b1[e]; w2[e] = d0[e]; w2[4 + e] = d1[e]; } }
        if (hrow >= 0) {
            float c[8], x[8];
            ld8(X.U + (size_t)hrow * DIN + 3072 + c0, c); ld8(X.U + (size_t)hrow * DIN + 4096 + c0, x);
#pragma unroll
            for (int e = 0; e < 8; ++e) cm2[e] = c[e] * x[e];
            ld8(X.U + (size_t)(hrow + 1) * DIN + 3072 + c0, c); ld8(X.U + (size_t)(hrow + 1) * DIN + 4096 + c0, x);
#pragma unroll
            for (int e = 0; e < 8; ++e) cm1[e] = c[e] * x[e];
        } else {
#pragma unroll
            for (int e = 0; e < 8; ++e) { cm2[e] = 0.f; cm1[e] = 0.f; }
        }
        const bf16_t* up = X.U + (size_t)row0 * DIN + c0;
        bf16_t* yp = X.Y + (size_t)row0 * DM + 1024 + c0;
#pragma unroll 8
        for (int t = 0; t < 16; ++t) {
            float bv[8], cv[8], xv[8], gv[8];
            ld8(up + (size_t)t * DIN + 2048, bv); ld8(up + (size_t)t * DIN + 3072, cv); ld8(up + (size_t)t * DIN + 4096, xv); ld8(up + (size_t)t * DIN + 5120, gv);
            float o[8];
#pragma unroll
            for (int e = 0; e < 8; ++e) { const float cx = cv[e] * xv[e]; const float y = w0[e] * cm2[e] + w1[e] * cm1[e] + w2[e] * cx; o[e] = bv[e] * y * (gv[e] * sigmoidf_(gv[e])); cm2[e] = cm1[e]; cm1[e] = cx; }
            u32x4 w; w.x = pk2(o[0], o[1]); w.y = pk2(o[2], o[3]); w.z = pk2(o[4], o[5]); w.w = pk2(o[6], o[7]);
            *(u32x4*)(yp + (size_t)t * DM) = w;
        }
    }
}


#ifdef DEBUG_NAIVE_MIX
__global__ void __launch_bounds__(64) naive_mixA(Mix X, const float* wr, const float* wi) {
    const int b = blockIdx.x / 16, hd = blockIdx.x % 16, lane = threadIdx.x, ch = hd * 64 + lane;
    __shared__ float xs[64];
    const float w0 = X.conv_a_w[ch], w1 = X.conv_a_w[1024 + ch], w2 = X.conv_a_w[2048 + ch], w3 = X.conv_a_w[3072 + ch], cb = X.conv_a_b[ch];
    const float br = X.lru_br[ch], bi = X.lru_bi[ch];
    const float sp = log1pf(expf(-X.lru_lambda[ch]));
    const float* wrh = wr + (size_t)hd * 4096 + lane; const float* wih = wi + (size_t)hd * 4096 + lane;
    float h = 0.f, xm3 = 0.f, xm2 = 0.f, xm1 = 0.f;
    for (int p = 0; p < NMETA + SEQ; ++p) {
        const int row = p < NMETA ? META0 + p : b * SEQ + (p - NMETA);
        const float x0 = bf1(X.U[(size_t)row * DIN + ch]);
        const float xc = cb + w0 * xm3 + w1 * xm2 + w2 * xm1 + w3 * x0; xm3 = xm2; xm2 = xm1; xm1 = x0;
        xs[lane] = xc; __syncthreads();
        float rp = br, ip = bi;
#pragma unroll 4
        for (int i = 0; i < 64; ++i) { rp += xs[i] * wrh[i * 64]; ip += xs[i] * wih[i * 64]; }
        __syncthreads();
        const float r = 1.f / (1.f + expf(-rp)), ig = 1.f / (1.f + expf(-ip));
        const float la = -8.f * r * sp; const float a = expf(la); const float bb = sqrtf(-expm1f(2.f * la)) * (ig * xc);
        h = a * h + bb;
        const float g = bf1(X.U[(size_t)row * DIN + 1024 + ch]);
        const float y = h * g / (1.f + expf(-g));
        if (p >= NMETA || b == 0) X.Y[(size_t)row * DM + ch] = (bf16_t)f2bf(y);
    }
}
__global__ void naive_mixB(Mix X) {
    for (size_t idx = (size_t)blockIdx.x * blockDim.x + threadIdx.x; idx < (size_t)(MROWS + NMETA) * 1024; idx += (size_t)gridDim.x * blockDim.x) {
        const int row = (int)(idx >> 10), c = (int)(idx & 1023);
        int r1, r2;
        if (row >= META0) { const int p = row - META0; r1 = p >= 1 ? row - 1 : -1; r2 = p >= 2 ? row - 2 : -1; }
        else { const int t = row & (SEQ - 1); r1 = t >= 1 ? row - 1 : META0 + 15; r2 = t >= 2 ? row - 2 : META0 + 14 + t; }
        auto cx = [&](int r) -> float { return r < 0 ? 0.f : bf1(X.U[(size_t)r * DIN + 3072 + c]) * bf1(X.U[(size_t)r * DIN + 4096 + c]); };
        const float y = X.conv_b_w[c] * cx(r2) + X.conv_b_w[1024 + c] * cx(r1) + X.conv_b_w[2048 + c] * cx(row);
        const float bv = bf1(X.U[(size_t)row * DIN + 2048 + c]), g = bf1(X.U[(size_t)row * DIN + 5120 + c]);
        X.Y[(size_t)row * DM + 1024 + c] = (bf16_t)f2bf(bv * y * g / (1.f + expf(-g)));
    }
}
#endif
#define XB_TMO      128
#define XB_XCNT(j)  (256  + 64 * (j))
#define XB_XSUB(j)  (1280 + 64 * (j))
#define XB_XGEN(j)  (2304 + 64 * (j))
#define XB_TOP      3328
#define XB_TOPGEN   3392
#define XCD_BAR_WORDS 3456
#define XB_SPIN_CAP (1u << 18)

__device__ __forceinline__ unsigned xb_ld(unsigned* p)              { return __hip_atomic_load(p, __ATOMIC_RELAXED, __HIP_MEMORY_SCOPE_AGENT); }
__device__ __forceinline__ unsigned xb_add(unsigned* p, unsigned v) { return __hip_atomic_fetch_add(p, v, __ATOMIC_RELAXED, __HIP_MEMORY_SCOPE_AGENT); }
__device__ __forceinline__ unsigned xb_xcc_id() { return (unsigned)__builtin_amdgcn_s_getreg((3 << 11) | 20) & 0xFu; }
#define XB_SPIN(cond, bar) do { unsigned _sp = 0; while (cond) { __builtin_amdgcn_s_sleep(1); \
    if ((++_sp & 255u) == 0u) { if (xb_ld(&(bar)[XB_TMO])) break; if (_sp > XB_SPIN_CAP) { atomicAdd(&(bar)[XB_TMO], 1u); break; } } } } while (0)

struct XcdBarrier {
    unsigned* bar; unsigned x;
    volatile LAS unsigned* st;
};

__device__ __forceinline__ XcdBarrier xcd_barrier_post(unsigned* bar, volatile LAS unsigned* st) {
    XcdBarrier b; b.bar = bar; b.x = xb_xcc_id(); b.st = st;
    if (threadIdx.x == 0) (void)xb_add(&bar[XB_XCNT(b.x)], 1u);
    return b;
}
__device__ __forceinline__ void xcd_barrier_complete(unsigned* bar, unsigned x, unsigned& nloc, unsigned& nx) {
    const unsigned G = gridDim.x * gridDim.y * gridDim.z;
    unsigned sum, cnt, mine, sp = 0u;
    for (;;) {
        sum = 0u; cnt = 0u; mine = 0u;
#pragma unroll
        for (unsigned j = 0; j < 16; ++j) { const unsigned c = xb_ld(&bar[XB_XCNT(j)]); sum += c; cnt += (c > 0u) ? 1u : 0u; mine = (j == x) ? c : mine; }
        if (sum == G) break;
        __builtin_amdgcn_s_sleep(1);
        if ((++sp & 255u) == 0u) { if (xb_ld(&bar[XB_TMO])) break; if (sp > XB_SPIN_CAP) { atomicAdd(&bar[XB_TMO], 1u); break; } }
    }
    nloc = mine > 0u ? mine : 1u; nx = cnt > 0u ? cnt : 1u;
}

__device__ __forceinline__ void xcd_barrier(const XcdBarrier& b) {
    asm volatile("s_waitcnt vmcnt(0)" ::: "memory");
    __syncthreads();
    if (threadIdx.x == 0) {
        unsigned* bar = b.bar;
        __builtin_amdgcn_s_waitcnt(0);
        unsigned nloc = b.st[0], nx = b.st[1];
        if (nloc == 0u) { xcd_barrier_complete(bar, b.x, nloc, nx); b.st[0] = nloc; b.st[1] = nx; }
        const unsigned old = xb_add(&bar[XB_XSUB(b.x)], 1u);
        const unsigned gen = old / nloc;
        if (old + 1u == (gen + 1u) * nloc) {
            __builtin_amdgcn_fence(__ATOMIC_RELEASE, "agent");
            asm volatile("s_waitcnt vmcnt(0)" ::: "memory");
            const unsigned og = xb_add(&bar[XB_TOP], 1u);
            const unsigned tg = og / nx;
            if (og + 1u == (tg + 1u) * nx) xb_add(&bar[XB_TOPGEN], 1u);
            else XB_SPIN(xb_ld(&bar[XB_TOPGEN]) == tg, bar);
            __builtin_amdgcn_fence(__ATOMIC_ACQUIRE, "agent");
            xb_add(&bar[XB_XGEN(b.x)], 1u);
            asm volatile("s_waitcnt vmcnt(0)" ::: "memory");
        } else {
            XB_SPIN(xb_ld(&bar[XB_XGEN(b.x)]) == gen, bar);
            __builtin_amdgcn_fence(__ATOMIC_ACQUIRE, "agent");
            asm volatile("s_waitcnt vmcnt(0)" ::: "memory");
        }
    }
    __syncthreads();
}

__global__ void __launch_bounds__(512, 2) hymba_fwd(Args a) {
    extern __shared__ __attribute__((aligned(16))) unsigned char lds_raw[];
    LAS unsigned char* lds = (LAS unsigned char*)lds_raw;
    cg::grid_group grid = cg::this_grid();
    const int NGW = gridDim.x * 8;
    if (threadIdx.x < 64) ((LAS unsigned*)(lds + 131072))[threadIdx.x] = 0u;
    __syncthreads();
    XcdBarrier xbar; xbar.bar = (unsigned*)(a.ws + WS_BAR); xbar.x = 0; xbar.st = nullptr;
    if (a.ph_hi - a.ph_lo > 1) xbar = xcd_barrier_post((unsigned*)(a.ws + WS_BAR), (volatile LAS unsigned*)(lds + 131072));
    if (a.ph_lo < 0) grid.sync();
#define LAUNDER() int tid = threadIdx.x; asm volatile("" : "+v"(tid)); const int wid = __builtin_amdgcn_readfirstlane(tid >> 6), lane = tid & 63, gw = blockIdx.x * 8 + wid
    const int lo = a.ph_lo, hi = a.ph_hi;
#define IN(k) (lo <= (k) && (k) < hi)
#ifndef STAGGER_N
#define STAGGER_N 0
#endif
#define STAGGER() do { if (STAGGER_N) for (int _k = 0; _k < (int)(blockIdx.x & 7); ++_k) __builtin_amdgcn_s_sleep(STAGGER_N); } while (0)
#define SEAM(k) do { if (IN(k) && IN((k) + 1)) { xcd_barrier(xbar); if ((REP_MASK >> 10) & 1) { xcd_barrier(xbar); xcd_barrier(xbar); } } } while (0)
    const float* x = a.in[0]; const float* meta = a.in[1]; const float* norm_g = a.in[2]; const float* w_in = a.in[3];
    const float* conv_a_w = a.in[4]; const float* conv_a_b = a.in[5]; const float* lru_wr = a.in[6]; const float* lru_br = a.in[7];
    const float* lru_wi = a.in[8]; const float* lru_bi = a.in[9]; const float* lru_lambda = a.in[10]; const float* conv_b_w = a.in[11];
    const float* w_out = a.in[12]; const float* final_g = a.in[13];
    unsigned char* ws = a.ws;
    bf16_t* WTIN = (bf16_t*)(ws + WS_WTIN); bf16_t* WTOUT = (bf16_t*)(ws + WS_WTOUT); bf16_t* GW = (bf16_t*)(ws + WS_GW);
    float* ROWSS = (float*)(ws + WS_ROWSS); unsigned long long* AGG = (unsigned long long*)(ws + WS_AGG);
    bf16_t* XB = (bf16_t*)(ws + WS_XB); bf16_t* Y = (bf16_t*)(ws + WS_Y); bf16_t* U = (bf16_t*)(ws + WS_U);

    if (IN(0)) for (int rep = 0; rep <= ((REP_MASK >> 0) & 1); ++rep) {
        LAUNDER();
        LAS unsigned char* scr = lds + wid * 16384;
        constexpr int I_IN = (DM / 64) * (DIN / 64), I_OUT = (DM / 64) * (DM / 64);
        constexpr int NIT = 2 * I_IN + 2 * I_OUT + 64;
        for (int it = gw; it < NIT; it += NGW) {
            int r = it;
            if (r < 2 * I_IN) { const int l = r / I_IN; tr_item(w_in + (size_t)l * DM * DIN, DM, DIN, WTIN + (size_t)l * DIN * DM, norm_g + l * DM, scr, r % I_IN, lane); continue; } r -= 2 * I_IN;
            if (r < 2 * I_OUT) { const int l = r / I_OUT; tr_item(w_out + (size_t)l * DM * DM, DM, DM, WTOUT + (size_t)l * DM * DM, nullptr, scr, r % I_OUT, lane); continue; } r -= 2 * I_OUT;
            { const int mtx = r, l = mtx >> 5, g = (mtx >> 4) & 1, hd = mtx & 15;
              const float* src = (g ? lru_wi : lru_wr) + (size_t)(l * 16 + hd) * 4096;
              tr_item(src, 64, 64, GW + (size_t)mtx * 4096, nullptr, scr, 0, lane); }
        }
        for (int m = gw; m < MROWS + NMETA; m += NGW) {
            const float* src = m < MROWS ? x + (size_t)m * DM : meta + (size_t)(m - MROWS) * DM;
            cvt_row(src, XB + (size_t)m * DM, ROWSS + m, lane);
        }
        for (int i = blockIdx.x * 512 + tid; i < 2 * RSTR; i += gridDim.x * 512) ROWSS[RSTR + i] = 0.f;
        for (int i = blockIdx.x * 512 + tid; i < AGG_PER_LAYER; i += gridDim.x * 512) ((u32x4*)AGG)[i] = (u32x4){0u, 0u, 0u, 0u};
    }
    SEAM(0);

#pragma unroll 1
    for (int l = 0; l < 2; ++l) {
        const int pb = 1 + 3 * l;
        const bf16_t* wtin = WTIN + (size_t)l * DIN * DM; const bf16_t* wtout = WTOUT + (size_t)l * DM * DM;
        float* rss_in = ROWSS + (size_t)l * RSTR; float* rss_out = ROWSS + (size_t)(l + 1) * RSTR;
        Mix X; X.conv_a_w = conv_a_w + l * 4 * DLRU; X.conv_a_b = conv_a_b + l * DLRU; X.lru_br = lru_br + l * DLRU; X.lru_bi = lru_bi + l * DLRU; X.lru_lambda = lru_lambda + l * DLRU;
        X.conv_b_w = conv_b_w + l * 3 * DLRU; X.gw = GW + (size_t)l * 2 * 16 * 4096; X.U = U; X.Y = Y; X.AGG = AGG + (size_t)l * AGG_PER_LAYER;

        if (IN(pb)) for (int rep = 0; rep <= ((REP_MASK >> pb) & 1); ++rep) {
            LAUNDER();
            STAGGER();
            for (int mrep = 0; mrep <= ((REP_MASK >> 16) & 1); ++mrep)
            meta_gemm(XB + (size_t)META0 * DM, wtin, DIN / 16, lds, wid, lane, [&](int m, int n0, f32x4 s) {
                const float rs = rsqrtf(rss_in[META0 + m] * (1.0f / DM) + RMS_EPS);
                u32x2 w; w.x = pk2(s[0] * rs, s[1] * rs); w.y = pk2(s[2] * rs, s[3] * rs);
                *(u32x2*)(U + (size_t)(META0 + m) * DIN + n0) = w; });
            pg8::Gemm g{XB, wtin, MROWS, DIN, DM}; pg8::StaticOrder S; S.init(MROWS, DIN, (int)gridDim.x, (int)blockIdx.x);
            if ((REP_MASK >> 17) & 1) { EpiUT<true> En{U, rss_in}; pg8::gemm_phase<EpiUT<true>, pg8::StaticOrder, false>(lds, g, S, En, nullptr); }
            if ((REP_MASK >> 15) & 1) { EpiNull En{ROWSS + (size_t)3 * RSTR}; pg8::gemm_phase<EpiNull, pg8::StaticOrder, false>(lds, g, S, En, nullptr); }
            EpiU E{U, rss_in};
            pg8::gemm_phase<EpiU, pg8::StaticOrder, false>(lds, g, S, E, nullptr);
        }
        SEAM(pb);
        if (IN(pb + 1)) for (int rep = 0; rep <= ((REP_MASK >> (pb + 1)) & 1); ++rep) {
            LAUNDER();
#pragma unroll 1
            for (int step = 0; step < 2; ++step) {
                if ((step == 0) == (wid < 4)) {
                    if (rep == 1 && ((REP_MASK >> 13) & 1)) continue;
#pragma unroll 1
                    for (int id = gw; id < N_ITEMS; id += NGW) { if (id < 16) mix_item<true>(X, id, lds + wid * 9216, lane); else mix_item<false>(X, id, lds + wid * 9216, lane); }
                } else { if (rep == 1 && ((REP_MASK >> 12) & 1)) continue; partb(X, tid); }
            }
        }
        SEAM(pb + 1);
        if (IN(pb + 2)) {
            LAUNDER();
            STAGGER();
            if (l == 0) {
                meta_gemm(Y + (size_t)META0 * DM, wtout, DM / 16, lds, wid, lane, [&](int m, int n0, f32x4 s) {
                    const f32x4 r = *(const f32x4*)(meta + (size_t)m * DM + n0); const f32x4 hh = r + s;
                    u32x2 w; w.x = pk2(hh[0], hh[1]); w.y = pk2(hh[2], hh[3]);
                    *(u32x2*)(XB + (size_t)(META0 + m) * DM + n0) = w;
                    unsafeAtomicAdd(rss_out + META0 + m, (hh[0] * hh[0] + hh[1] * hh[1]) + (hh[2] * hh[2] + hh[3] * hh[3])); });
            }
            pg8::Gemm g{Y, wtout, MROWS, DM, DM};
            if (l == 0) {
                pg8::StaticOrder S; S.init(MROWS, DM, (int)gridDim.x, (int)blockIdx.x);
                if ((REP_MASK >> 11) & 1) { EpiU Ed{U, rss_in}; pg8::gemm_phase<EpiU, pg8::StaticOrder, false>(lds, g, S, Ed, nullptr); }
                if ((REP_MASK >> 14) & 1) { EpiRes Ed{x, nullptr, XB, ROWSS + (size_t)3 * RSTR}; pg8::gemm_phase<EpiRes, pg8::StaticOrder, false>(lds, g, S, Ed, nullptr); }
                EpiRes E{x, nullptr, XB, rss_out};
                pg8::gemm_phase<EpiRes, pg8::StaticOrder, false>(lds, g, S, E, nullptr);
            } else {
                PanelOrder S; S.init((int)gridDim.x, (int)blockIdx.x);
                EpiResNorm E{XB, a.out, rss_out, (unsigned*)(ws + WS_PCNT), final_g};
                pg8::gemm_phase<EpiResNorm, PanelOrder, false>(lds, g, S, E, nullptr);
            }
        }
        SEAM(pb + 2);
    }

#undef IN
#undef SEAM
}

#ifndef MK_LAUNCH_PER_PHASE
#define MK_LAUNCH_PER_PHASE 0
#endif
extern "C" void kernel_launch(void* const* d_in, const int* in_sizes, int n_in, void* d_out, int out_size, void* d_ws, size_t ws_size, hipStream_t stream) {
    static int grid = 0;
    if (grid == 0) {
        if (n_in != 14 || in_sizes[0] != MROWS * DM || out_size != MROWS * DM || ws_size < WS_END) { fprintf(stderr, "kernel_launch: unexpected shapes (n_in %d, in0 %d, out %d, ws %zu)\n", n_in, n_in > 0 ? in_sizes[0] : -1, out_size, ws_size); grid = -1; return; }
        int dev = 0, cus = 0, per_cu = 0;
        hipGetDevice(&dev); hipDeviceGetAttribute(&cus, hipDeviceAttributeMultiprocessorCount, dev);
        if (hipFuncSetAttribute((const void*)hymba_fwd, hipFuncAttributeMaxDynamicSharedMemorySize, LDS_BYTES) != hipSuccess) { fprintf(stderr, "kernel_launch: hipFuncSetAttribute failed\n"); grid = -1; return; }
        if (hipOccupancyMaxActiveBlocksPerMultiprocessor(&per_cu, (const void*)hymba_fwd, 512, LDS_BYTES) != hipSuccess || per_cu < 1) { fprintf(stderr, "kernel_launch: occupancy query gave %d\n", per_cu); per_cu = 1; }
        (void)hipGetLastError();
        grid = cus * per_cu;
    }
    if (grid < 0) return;
    Args a{};
    for (int i = 0; i < 14; ++i) a.in[i] = (const float*)d_in[i];
    a.out = (float*)d_out; a.ws = (unsigned char*)d_ws;
#if MK_LAUNCH_PER_PHASE
    for (int p = 0; p < NPHASE; ++p) {
#ifdef DEBUG_NAIVE_MIX
        if (p == 2 || p == 6) { const int l = p / 4; unsigned char* ws = (unsigned char*)d_ws;
            Mix X; X.conv_a_w = a.in[4] + l * 4 * DLRU; X.conv_a_b = a.in[5] + l * DLRU; X.lru_br = a.in[7] + l * DLRU; X.lru_bi = a.in[9] + l * DLRU; X.lru_lambda = a.in[10] + l * DLRU;
            X.conv_b_w = a.in[11] + l * 3 * DLRU; X.gw = nullptr; X.U = (bf16_t*)(ws + WS_U); X.Y = (bf16_t*)(ws + WS_Y); X.HP = nullptr; X.AGG = nullptr;
#if DEBUG_NAIVE_MIX == 1
            hipLaunchKernelGGL(naive_mixA, dim3(64), dim3(64), 0, stream, X, a.in[6] + (size_t)l * 16 * 4096, a.in[8] + (size_t)l * 16 * 4096);
            a.flags = 1;
#else
            hipLaunchKernelGGL(naive_mixB, dim3(2048), dim3(256), 0, stream, X);
            a.flags = 2;
#endif
            }
        else a.flags = 0;
#if DEBUG_NAIVE_MIX == 1
        if (p == 3 || p == 7) continue;
#endif
#endif
        a.ph_lo = p; a.ph_hi = p + 1; hipLaunchKernelGGL(hymba_fwd, dim3(grid), dim3(512), LDS_BYTES, stream, a); }
#else
    a.ph_lo = 0; a.ph_hi = NPHASE;
    if (hipMemsetAsync((unsigned char*)d_ws + WS_BAR, 0, 16384 + 32768, stream) != hipSuccess) { fprintf(stderr, "kernel_launch: memset of barrier words failed\n"); return; }
    void* args[] = {&a};
    const hipError_t e = hipLaunchCooperativeKernel((const void*)hymba_fwd, dim3(grid), dim3(512), args, LDS_BYTES, stream);
    if (e != hipSuccess) fprintf(stderr, "kernel_launch: cooperative launch failed: %s (grid %d)\n", hipGetErrorString(e), grid);
#endif
}
```

```cpp
#include <hip/hip_runtime.h>
#include <hip/hip_cooperative_groups.h>
#include <cstdio>
namespace cg = cooperative_groups;
namespace pg8 {
#define PG8_LAS __attribute__((address_space(3)))
typedef unsigned short bf16_t;
typedef short bf16x8 __attribute__((ext_vector_type(8)));
typedef float f32x4 __attribute__((ext_vector_type(4)));
typedef unsigned u32x4 __attribute__((ext_vector_type(4)));
constexpr int BM = 256, BK = 64, HALF = 128, HTB = HALF * BK * 2  , STAGE_BYTES = 8 * HTB, NXCD = 8, WGM = 8;

__host__ __device__ __forceinline__ int lds_byte(int r, int c) { const int st = (r >> 4) * 2 + (c >> 5), rr = r & 15, cc = c & 31, ob = rr * 64 + cc * 2; return st * 1024 + (ob ^ (((ob >> 9) & 1) << 5)); }
__host__ __device__ __forceinline__ void stage_rc(int b, int& R, int& C) { const int st = b / 1024, sb = b % 1024, swz = sb ^ (((sb >> 9) & 1) << 5); R = (st >> 1) * 16 + swz / 64; C = (st & 1) * 32 + (swz % 64) / 2; }
__host__ __device__ __forceinline__ int perm32(int rho) { const int n = rho >> 4, i = rho & 15; return 8 * (i >> 2) + 4 * n + (i & 3); }

struct Unit { int pm, pn; };
struct Gemm { const bf16_t* A; const bf16_t* Bt; int M, N, K; };

struct StaticOrder {
    int nM, nN, nwg, G, c;
    __host__ __device__ void init(int M, int N, int G_, int c_) { nM = M / BM; nN = N / BM; nwg = nM * nN; G = G_; c = c_; }
    __host__ __device__ bool next(int i, Unit& u) const {
        const long L = (long)i * G + c; if (L >= nwg) return false;
        int wgid = (int)L; { const int q = nwg / NXCD, r = nwg % NXCD, xcd = wgid % NXCD, off = wgid / NXCD; wgid = (xcd < r ? xcd * (q + 1) : r * (q + 1) + (xcd - r) * q) + off; }
        const int nig = WGM * nN, gid = wgid / nig, fm = gid * WGM, gsz = (nM - fm) < WGM ? (nM - fm) : WGM;
        u.pm = fm + ((wgid % nig) % gsz); u.pn = (wgid % nig) / gsz; return true;
    }
    __device__ __forceinline__ void a_ready(const Unit&) const {}
    __device__ __forceinline__ void done(const Unit&) const {}
};
__device__ __forceinline__ unsigned cvt_pk_bf16(float lo, float hi) { unsigned r; asm volatile("v_cvt_pk_bf16_f32 %0, %1, %2" : "=v"(r) : "v"(lo), "v"(hi)); return r; }
template <class Epi, class Sched, bool STAMP = false>
__device__ __forceinline__ void gemm_phase(PG8_LAS unsigned char* lds, const Gemm g, const Sched& S, const Epi& E, unsigned long long* stamps) {
    int tid_l = threadIdx.x; asm volatile("" : "+v"(tid_l));
    const int tid = tid_l, wid = __builtin_amdgcn_readfirstlane(tid >> 6), lane = tid & 63, wr = wid >> 2, wc = wid & 3, fr = lane & 15, fq = lane >> 4;
    const int K = g.K, nt = K / BK;
    int ts_lo = 0, ts_hi = 0, nts = 0; const unsigned long long rt_entry = STAMP ? (unsigned long long)wall_clock64() : 0ull;
#define PG8_STAMP() do { if (STAMP && wid == 0 && nts < 64) { const unsigned long long _c = (unsigned long long)clock64(); \
        ts_lo = (lane == nts) ? (int)(unsigned)_c : ts_lo; ts_hi = (lane == nts) ? (int)(unsigned)(_c >> 32) : ts_hi; ++nts; } } while (0)
    PG8_STAMP();
    unsigned voffA[2], voffB[2];
#pragma unroll
    for (int i = 0; i < 2; ++i) { int R, C; stage_rc(tid * 16 + i * 8192, R, C); const int Rb = Epi::PERM ? ((R & ~31) + perm32(R & 31)) : R;
        voffA[i] = (unsigned)(R * K + C) * 2u; voffB[i] = (unsigned)(Rb * K + C) * 2u; }
    const size_t kstep = (size_t)(BK * 2);
    const size_t hstep = (size_t)HALF * K * 2;
    const size_t tstep = 2 * hstep;
    const unsigned ldsw = (unsigned)wid * 1024u;
    const int aoff = lds_byte(wr * 64 + fr, fq * 8), boff = lds_byte(wc * 32 + fr, fq * 8);
#define PG8_SA(b, h) (((b) * 2 + (h)) * HTB)
#define PG8_SB(b, h) ((4 + (b) * 2 + (h)) * HTB)
#define PG8_STAGE(bufoff, gbase, voff) do { _Pragma("unroll") for (int _i = 0; _i < 2; ++_i) \
        __builtin_amdgcn_global_load_lds((const unsigned*)((const char*)(gbase) + (voff)[_i]), (PG8_LAS unsigned*)(lds + (bufoff) + ldsw + _i * 8192), 16, 0, 0); } while (0)
#define PG8_LDA(dst, b, h) do { _Pragma("unroll") for (int m = 0; m < 4; ++m) _Pragma("unroll") for (int k = 0; k < 2; ++k) dst[m][k] = *(const PG8_LAS bf16x8*)(lds + PG8_SA(b, h) + aoff + m * 2048 + k * 1024); } while (0)
#define PG8_LDB(dst, b, h) do { _Pragma("unroll") for (int n = 0; n < 2; ++n) _Pragma("unroll") for (int k = 0; k < 2; ++k) dst[n][k] = *(const PG8_LAS bf16x8*)(lds + PG8_SB(b, h) + boff + n * 2048 + k * 1024); } while (0)
#define PG8_MMA(ai, bj, At, Bt) do { __builtin_amdgcn_s_setprio(1); _Pragma("unroll") for (int m = 0; m < 4; ++m) _Pragma("unroll") for (int n = 0; n < 2; ++n) _Pragma("unroll") for (int k = 0; k < 2; ++k) \
        acc[ai][bj][m][n] = __builtin_amdgcn_mfma_f32_16x16x32_bf16(Bt[n][k], At[m][k], acc[ai][bj][m][n], 0, 0, 0); __builtin_amdgcn_s_setprio(0); } while (0)
#define PG8_WAIT_V(n) asm volatile("s_waitcnt vmcnt(" #n ")" ::: "memory")
#define PG8_WAIT_L(n) asm volatile("s_waitcnt lgkmcnt(" #n ")" ::: "memory")
#define PG8_BAR __builtin_amdgcn_s_barrier()
#define PG8_SCHED __builtin_amdgcn_sched_barrier(0)
    Unit cur, nxt; int ui = 0;
    if (!S.next(0, cur)) return;
    f32x4 acc[2][2][4][2];
#pragma unroll
    for (int a = 0; a < 2; ++a)
#pragma unroll
        for (int b = 0; b < 2; ++b)
#pragma unroll
            for (int m = 0; m < 4; ++m)
#pragma unroll
                for (int n = 0; n < 2; ++n) acc[a][b][m][n] = (f32x4){0.f, 0.f, 0.f, 0.f};
    bf16x8 At[4][2], B0[2][2], B1[2][2];
    const char* cA = (const char*)g.A + (size_t)cur.pm * tstep; const char* cB = (const char*)g.Bt + (size_t)cur.pn * tstep;
    S.a_ready(cur);
    PG8_STAGE(PG8_SB(0, 0), cB, voffB); PG8_STAGE(PG8_SA(0, 0), cA, voffA); PG8_STAGE(PG8_SB(0, 1), cB + hstep, voffB); PG8_STAGE(PG8_SA(0, 1), cA + hstep, voffA);
    if (wr == 1) PG8_BAR;
    PG8_WAIT_V(4); PG8_BAR;
    PG8_STAGE(PG8_SB(1, 0), cB + kstep, voffB); PG8_STAGE(PG8_SA(1, 0), cA + kstep, voffA); PG8_STAGE(PG8_SB(1, 1), cB + hstep + kstep, voffB);
    PG8_WAIT_V(6); PG8_BAR;
    PG8_STAMP();
    for (;;) {
        const bool has_next = S.next(ui + 1, nxt);
        const char* nA = has_next ? (const char*)g.A + (size_t)nxt.pm * tstep : cA; const char* nB = has_next ? (const char*)g.Bt + (size_t)nxt.pn * tstep : cB;
        for (int t = 0; t < nt; t += 2) {
            const bool last = (t == nt - 2);
            const char* a1 = cA + (size_t)(t + 1) * kstep;
            const char* a2 = last ? nA : cA + (size_t)(t + 2) * kstep; const char* b2 = last ? nB : cB + (size_t)(t + 2) * kstep;
            const char* a3 = a2 + kstep; const char* b3 = b2 + kstep;
            if (last && has_next) S.a_ready(nxt);
            PG8_LDB(B0, 0, 0); PG8_SCHED; PG8_LDA(At, 0, 0); PG8_STAGE(PG8_SA(1, 1), a1 + hstep, voffA);
            PG8_WAIT_L(8); PG8_BAR; PG8_WAIT_L(0); PG8_MMA(0, 0, At, B0); PG8_BAR; PG8_SCHED;
            PG8_LDB(B1, 0, 1); PG8_STAGE(PG8_SB(0, 0), b2, voffB);
            PG8_BAR; PG8_WAIT_L(0); PG8_MMA(0, 1, At, B1); PG8_BAR;
            PG8_LDA(At, 0, 1); PG8_STAGE(PG8_SA(0, 0), a2, voffA);
            PG8_BAR; PG8_WAIT_L(0); PG8_MMA(1, 0, At, B0); PG8_BAR; PG8_SCHED;
            PG8_STAGE(PG8_SB(0, 1), b2 + hstep, voffB);
            PG8_WAIT_V(6); PG8_BAR; PG8_MMA(1, 1, At, B1); PG8_BAR;
            PG8_LDB(B0, 1, 0); PG8_SCHED; PG8_LDA(At, 1, 0); PG8_STAGE(PG8_SA(0, 1), a2 + hstep, voffA);
            PG8_WAIT_L(8); PG8_BAR; PG8_WAIT_L(0); PG8_MMA(0, 0, At, B0); PG8_BAR; PG8_SCHED;
            PG8_LDB(B1, 1, 1); PG8_STAGE(PG8_SB(1, 0), b3, voffB);
            PG8_BAR; PG8_WAIT_L(0); PG8_MMA(0, 1, At, B1); PG8_BAR;
            PG8_LDA(At, 1, 1); PG8_STAGE(PG8_SA(1, 0), a3, voffA);
            PG8_BAR; PG8_WAIT_L(0); PG8_MMA(1, 0, At, B0); PG8_BAR; PG8_SCHED;
            PG8_STAGE(PG8_SB(1, 1), b3 + hstep, voffB);
            PG8_WAIT_V(6); PG8_BAR; PG8_MMA(1, 1, At, B1); PG8_BAR;
        }
        PG8_STAMP();
        if constexpr (!Epi::AFTER_DRAIN) { E(acc, cur, wr, wc, fr, fq); S.done(cur); }
        PG8_STAMP();
        if (!has_next) break;
#pragma unroll
        for (int a = 0; a < 2; ++a)
#pragma unroll
            for (int b = 0; b < 2; ++b)
#pragma unroll
                for (int m = 0; m < 4; ++m)
#pragma unroll
                    for (int n = 0; n < 2; ++n) acc[a][b][m][n] = (f32x4){0.f, 0.f, 0.f, 0.f};
        cur = nxt; cA = nA; cB = nB; ++ui;
    }
    PG8_WAIT_V(0);
    if (wr == 0) PG8_BAR;
    PG8_BAR;
    if constexpr (Epi::AFTER_DRAIN) { E.fused(acc, cur, wr, wc, fr, fq, lds, wid, lane); S.done(cur); }
    PG8_STAMP();
    if (STAMP && wid == 0) { stamps[lane] = lane < nts ? (((unsigned long long)(unsigned)ts_hi << 32) | (unsigned)ts_lo) : 0ull;
        if (lane == 62) stamps[62] = rt_entry; if (lane == 63) stamps[63] = (unsigned long long)wall_clock64(); }
#undef PG8_STAMP
#undef PG8_SA
#undef PG8_SB
#undef PG8_STAGE
#undef PG8_LDA
#undef PG8_LDB
#undef PG8_MMA
#undef PG8_WAIT_V
#undef PG8_WAIT_L
#undef PG8_BAR
#undef PG8_SCHED
}
}

#define LAS __attribute__((address_space(3)))
#define GAS __attribute__((address_space(1)))
typedef unsigned short bf16_t;
typedef short bf16x8 __attribute__((ext_vector_type(8)));
typedef float f32x4 __attribute__((ext_vector_type(4)));
typedef float f32x2 __attribute__((ext_vector_type(2)));
typedef float f32x16 __attribute__((ext_vector_type(16)));
typedef unsigned u32x4 __attribute__((ext_vector_type(4)));
typedef unsigned u32x2 __attribute__((ext_vector_type(2)));

constexpr int DM = 2048, NBATCH = 4, SEQ = 4096, MROWS = NBATCH * SEQ, NMETA = 16, DIN = 6144, DLRU = 1024, NHEAD = 16;
constexpr int META0 = MROWS;
constexpr int RSTR = MROWS + 64;
constexpr float RMS_EPS = 1e-6f;
constexpr int NPHASE = 7;
#ifndef REP_MASK
#define REP_MASK 0
#endif
constexpr int LDS_BYTES = 131072 + 256;

constexpr size_t MiB = 1u << 20;
constexpr size_t WS_WTIN = 0;
constexpr size_t WS_WTOUT = 48 * MiB;
constexpr size_t WS_GW = 64 * MiB;
constexpr size_t WS_ROWSS = 65 * MiB;
constexpr size_t WS_BAR = 65 * MiB + 512 * 1024;
constexpr size_t WS_PCNT = WS_BAR + 16384;
constexpr size_t WS_AGG = 66 * MiB;
constexpr size_t WS_XB = 71 * MiB;
constexpr size_t WS_Y = 136 * MiB;
constexpr size_t WS_U = 201 * MiB;
constexpr size_t WS_END = 396 * MiB;
constexpr int AGG_PER_LAYER = 257 * 1024;
static_assert(WS_U + (size_t)RSTR * DIN * 2 <= WS_END && WS_Y + (size_t)RSTR * DM * 2 <= WS_U && WS_XB + (size_t)RSTR * DM * 2 <= WS_Y, "ws map");
static_assert(WS_WTIN + (size_t)2 * DIN * DM * 2 <= WS_WTOUT && WS_WTOUT + (size_t)2 * DM * DM * 2 <= WS_GW && WS_AGG + (size_t)2 * AGG_PER_LAYER * 8 <= WS_XB && WS_ROWSS + (size_t)3 * RSTR * 4 <= WS_BAR, "ws map 2");

struct Args { const float* in[14]; float* out; unsigned char* ws; int ph_lo, ph_hi, flags, pad; };

__device__ __forceinline__ unsigned f2bf(float f) { unsigned u = __builtin_bit_cast(unsigned, f); return (u + 0x7fffu + ((u >> 16) & 1u)) >> 16; }
__device__ __forceinline__ unsigned pk2(float lo, float hi) { return f2bf(lo) | (f2bf(hi) << 16); }
__device__ __forceinline__ float bflo(unsigned w) { return __builtin_bit_cast(float, w << 16); }
__device__ __forceinline__ float bfhi(unsigned w) { return __builtin_bit_cast(float, w & 0xffff0000u); }
__device__ __forceinline__ float bf1(bf16_t v) { return __builtin_bit_cast(float, ((unsigned)v) << 16); }
__device__ __forceinline__ float sigmoidf_(float z) { return __builtin_amdgcn_rcpf(1.0f + __expf(-z)); }
__device__ __forceinline__ float wave_sum(float v) {
#pragma unroll
    for (int o = 1; o < 64; o <<= 1) v += __shfl_xor(v, o);
    return v;
}
#define LDS_WAIT() asm volatile("s_waitcnt lgkmcnt(0)" ::: "memory")

template <bool NORS> struct EpiUT {
    static constexpr bool PERM = true, AFTER_DRAIN = false;
    bf16_t* O; const float* rowss;
    __device__ __forceinline__ void operator()(const f32x4 (&acc)[2][2][4][2], const pg8::Unit& u, int wr, int wc, int fr, int fq) const {
        const int row0 = u.pm * 256 + wr * 64 + fr, col0 = u.pn * 256 + wc * 32 + 8 * fq;
        if (u.pn >= 8) {
            const int ch0 = 64 * (u.pn - 8) + 16 * wc + 4 * fq;
#pragma unroll
            for (int ai = 0; ai < 2; ++ai)
#pragma unroll
                for (int m = 0; m < 4; ++m) {
                    const int r = row0 + ai * 128 + m * 16;
                    const float rs = NORS ? 1.0f : rsqrtf(rowss[r] * (1.0f / DM) + RMS_EPS);
                    const f32x4 bv = acc[ai][0][m][0] * rs, cv = acc[ai][0][m][1] * rs, xv = acc[ai][1][m][0] * rs, gv = acc[ai][1][m][1] * rs;
                    u32x4 w;
#pragma unroll
                    for (int i = 0; i < 4; ++i) w[i] = pg8::cvt_pk_bf16(bv[i] * gv[i] * sigmoidf_(gv[i]), cv[i] * xv[i]);
                    *(u32x4*)(O + (size_t)r * DIN + 2048 + 2 * ch0) = w;
                }
            return;
        }
#pragma unroll
        for (int ai = 0; ai < 2; ++ai)
#pragma unroll
            for (int m = 0; m < 4; ++m) {
                const int r = row0 + ai * 128 + m * 16;
                const float rs = NORS ? 1.0f : rsqrtf(rowss[r] * (1.0f / DM) + RMS_EPS);
                bf16_t* rowp = O + (size_t)r * DIN + col0;
#pragma unroll
                for (int bj = 0; bj < 2; ++bj) {
                    const f32x4 v0 = acc[ai][bj][m][0] * rs, v1 = acc[ai][bj][m][1] * rs;
                    u32x4 w; w.x = pg8::cvt_pk_bf16(v0[0], v0[1]); w.y = pg8::cvt_pk_bf16(v0[2], v0[3]); w.z = pg8::cvt_pk_bf16(v1[0], v1[1]); w.w = pg8::cvt_pk_bf16(v1[2], v1[3]);
                    *(u32x4*)(rowp + bj * 128) = w;
                }
            }
    }
};
struct EpiNull {
    static constexpr bool PERM = true, AFTER_DRAIN = false;
    float* sink;
    __device__ __forceinline__ void operator()(const f32x4 (&acc)[2][2][4][2], const pg8::Unit& u, int wr, int wc, int fr, int fq) const {
        f32x4 s = {0.f, 0.f, 0.f, 0.f};
#pragma unroll
        for (int ai = 0; ai < 2; ++ai)
#pragma unroll
            for (int bj = 0; bj < 2; ++bj)
#pragma unroll
                for (int m = 0; m < 4; ++m) { s += acc[ai][bj][m][0]; s += acc[ai][bj][m][1]; }
        if (s[0] + s[1] + s[2] + s[3] == 1.2345678e33f) sink[u.pm] = s[0];
    }
};
typedef EpiUT<false> EpiU;
#ifndef EPI_MB
#define EPI_MB 2
#endif
struct EpiRes {
    static constexpr bool PERM = true, AFTER_DRAIN = false;
    const float* res; float* out; bf16_t* xb; float* rowss;
    __device__ __forceinline__ void operator()(const f32x4 (&acc)[2][2][4][2], const pg8::Unit& u, int wr, int wc, int fr, int fq) const {
        const int row0 = u.pm * 256 + wr * 64 + fr, col0 = u.pn * 256 + wc * 32 + 8 * fq;
#pragma unroll
        for (int ai = 0; ai < 2; ++ai) {
#pragma unroll
          for (int mh = 0; mh < 4; mh += EPI_MB) {
            f32x4 rv[4][2][2];
#pragma unroll
            for (int m = mh; m < mh + EPI_MB; ++m)
#pragma unroll
                for (int bj = 0; bj < 2; ++bj) { const float* p = res + (size_t)(row0 + ai * 128 + m * 16) * DM + col0 + bj * 128; rv[m][bj][0] = *(const f32x4*)p; rv[m][bj][1] = *(const f32x4*)(p + 4); }
            asm volatile("" ::: "memory");
#pragma unroll
            for (int m = mh; m < mh + EPI_MB; ++m) {
                const int r = row0 + ai * 128 + m * 16; const size_t off = (size_t)r * DM + col0; float ss = 0.f;
#pragma unroll
                for (int bj = 0; bj < 2; ++bj) {
                    const f32x4 h0 = rv[m][bj][0] + acc[ai][bj][m][0], h1 = rv[m][bj][1] + acc[ai][bj][m][1];
                    if (out) { *(f32x4*)(out + off + bj * 128) = h0; *(f32x4*)(out + off + bj * 128 + 4) = h1; }
                    if (xb) { u32x4 w; w.x = pg8::cvt_pk_bf16(h0[0], h0[1]); w.y = pg8::cvt_pk_bf16(h0[2], h0[3]); w.z = pg8::cvt_pk_bf16(h1[0], h1[1]); w.w = pg8::cvt_pk_bf16(h1[2], h1[3]);
                        *(u32x4*)(xb + off + bj * 128) = w; }
                    ss += (h0[0] * h0[0] + h0[1] * h0[1]) + (h0[2] * h0[2] + h0[3] * h0[3]) + (h1[0] * h1[0] + h1[1] * h1[1]) + (h1[2] * h1[2] + h1[3] * h1[3]);
                }
                ss += __shfl_xor(ss, 16); ss += __shfl_xor(ss, 32);
                if (fq == 0) unsafeAtomicAdd(rowss + r, ss);
            }
            asm volatile("" ::: "memory");
          }
        }
    }
};

struct EpiResNorm {
    static constexpr bool PERM = true, AFTER_DRAIN = false;
    const bf16_t* res; float* out; float* rowss; unsigned* cnt; const float* fg;
    __device__ __forceinline__ void operator()(f32x4 (&acc)[2][2][4][2], const pg8::Unit& u, int wr, int wc, int fr, int fq) const {
        const int row0 = u.pm * 256 + wr * 64 + fr, col0 = u.pn * 256 + wc * 32 + 8 * fq;
#pragma unroll
        for (int ai = 0; ai < 2; ++ai) {
#pragma unroll
          for (int mh = 0; mh < 4; mh += EPI_MB) {
            u32x4 rw[4][2];
#pragma unroll
            for (int m = mh; m < mh + EPI_MB; ++m)
#pragma unroll
                for (int bj = 0; bj < 2; ++bj) rw[m][bj] = *(const u32x4*)(res + (size_t)(row0 + ai * 128 + m * 16) * DM + col0 + bj * 128);
            asm volatile("" ::: "memory");
#pragma unroll
            for (int m = mh; m < mh + EPI_MB; ++m) {
                float ss = 0.f;
#pragma unroll
                for (int bj = 0; bj < 2; ++bj) {
                    const u32x4 w = rw[m][bj];
                    const f32x4 h0 = (f32x4){bflo(w.x), bfhi(w.x), bflo(w.y), bfhi(w.y)} + acc[ai][bj][m][0], h1 = (f32x4){bflo(w.z), bfhi(w.z), bflo(w.w), bfhi(w.w)} + acc[ai][bj][m][1];
                    acc[ai][bj][m][0] = h0; acc[ai][bj][m][1] = h1;
                    ss += (h0[0] * h0[0] + h0[1] * h0[1]) + (h0[2] * h0[2] + h0[3] * h0[3]) + (h1[0] * h1[0] + h1[1] * h1[1]) + (h1[2] * h1[2] + h1[3] * h1[3]);
                }
                ss += __shfl_xor(ss, 16); ss += __shfl_xor(ss, 32);
                if (fq == 0) unsafeAtomicAdd(rowss + row0 + ai * 128 + m * 16, ss);
            }
            asm volatile("" ::: "memory");
          }
        }
        asm volatile("s_waitcnt vmcnt(0)" ::: "memory");
        unsigned* cw = cnt + 64 * (2 * u.pm + wr);
        if (fr == 0 && fq == 0) __hip_atomic_fetch_add(cw, 1u, __ATOMIC_RELAXED, __HIP_MEMORY_SCOPE_AGENT);
        f32x4 gv[2][2];
#pragma unroll
        for (int bj = 0; bj < 2; ++bj) { gv[bj][0] = *(const f32x4*)(fg + col0 + bj * 128); gv[bj][1] = *(const f32x4*)(fg + col0 + bj * 128 + 4); }
        { unsigned sp = 0;
          while ((unsigned)__builtin_amdgcn_readfirstlane(__hip_atomic_load(cw, __ATOMIC_RELAXED, __HIP_MEMORY_SCOPE_AGENT)) < 32u) { __builtin_amdgcn_s_sleep(1); if (++sp > (1u << 16)) break; } }
        asm volatile("" ::: "memory");
#pragma unroll
        for (int ai = 0; ai < 2; ++ai)
#pragma unroll
            for (int m = 0; m < 4; ++m) {
                const int r = row0 + ai * 128 + m * 16;
                const float rs = rsqrtf(__hip_atomic_load(rowss + r, __ATOMIC_RELAXED, __HIP_MEMORY_SCOPE_AGENT) * (1.0f / DM) + RMS_EPS);
                float* op = out + (size_t)r * DM + col0;
#pragma unroll
                for (int bj = 0; bj < 2; ++bj) { *(f32x4*)(op + bj * 128) = acc[ai][bj][m][0] * rs * gv[bj][0]; *(f32x4*)(op + bj * 128 + 4) = acc[ai][bj][m][1] * rs * gv[bj][1]; }
            }
    }
};
struct PanelOrder {
    int Gp, v;
    __device__ void init(int G, int c) { Gp = G & ~7; v = c; if ((Gp & 63) == 0) v = (c & 7) * (Gp >> 3) + (c >> 3); if (c >= Gp) v = -1; }
    __device__ bool next(int i, pg8::Unit& u) const { if (v < 0) return false; const long L = (long)i * Gp + v; if (L >= 64 * 8) return false; u.pm = (int)(L >> 3); u.pn = (int)(L & 7); return true; }
    __device__ __forceinline__ void a_ready(const pg8::Unit&) const {}
    __device__ __forceinline__ void done(const pg8::Unit&) const {}
};

template <class F> __device__ __forceinline__ void meta_gemm(const bf16_t* A, const bf16_t* Bt, int ngroups, LAS unsigned char* lds, int wid, int lane, F epi) {
    const int fr = lane & 15, fq = lane >> 4, half = wid >> 2, wq = wid & 3;
    LAS f32x4* red = (LAS f32x4*)lds;
    for (int p = blockIdx.x; 2 * p < ngroups; p += gridDim.x) {
        const int g = 2 * p + half;
        f32x4 acc = {0.f, 0.f, 0.f, 0.f};
        if (g < ngroups) {
            const bf16_t* ap = A + (size_t)fr * DM + wq * 512 + fq * 8;
            const bf16_t* bp = Bt + (size_t)(g * 16 + fr) * DM + wq * 512 + fq * 8;
            bf16x8 av[16], bv[16];
#pragma unroll
            for (int s = 0; s < 16; ++s) { av[s] = *(const bf16x8*)(ap + 32 * s); bv[s] = *(const bf16x8*)(bp + 32 * s); }
#pragma unroll
            for (int s = 0; s < 16; ++s) acc = __builtin_amdgcn_mfma_f32_16x16x32_bf16(bv[s], av[s], acc, 0, 0, 0);
        }
        red[wid * 64 + lane] = acc;
        __syncthreads();
        if (wq == 0 && g < ngroups) {
            f32x4 s = red[wid * 64 + lane];
#pragma unroll
            for (int w = 1; w < 4; ++w) s += red[(wid + w) * 64 + lane];
            epi(fr, g * 16 + 4 * fq, s);
        }
        __syncthreads();
    }
}

__host__ __device__ __forceinline__ int in_col(int p) {
    if (p < 2048) return p;
    const int c = p & 255, j = (p >> 8) - 8, g = 2 * (c >> 7) + ((c >> 2) & 1), k = 16 * ((c >> 5) & 3) + 4 * ((c >> 3) & 3) + (c & 3);
    return 2048 + 1024 * g + 64 * j + k;
}
template <bool COLMAP> __device__ __forceinline__ void tr_item(const float* W, int K, int N, bf16_t* WT, const float* sc, LAS unsigned char* scr, int item, int lane) {
    const int nblk = N / 64, kb = item / nblk, nb = item % nblk, k0 = 64 * kb, n0 = 64 * nb;
    const int kr = lane >> 4, nc = (lane & 15) * 4;
    f32x4 v[16]; float g[16];
    { const float* p = W + (size_t)(k0 + kr) * N + (COLMAP ? in_col(n0 + nc) : n0 + nc);
#pragma unroll
      for (int i = 0; i < 16; ++i) { v[i] = *(const f32x4*)p; p += (size_t)4 * N; }
#pragma unroll
      for (int i = 0; i < 16; ++i) g[i] = sc ? sc[k0 + kr + 4 * i] : 1.0f; }
    asm volatile("" ::: "memory");
#pragma unroll
    for (int i = 0; i < 16; ++i) { const f32x4 s = v[i] * g[i]; u32x2 w; w.x = pg8::cvt_pk_bf16(s[0], s[1]); w.y = pg8::cvt_pk_bf16(s[2], s[3]);
        *(LAS u32x2*)(scr + (kr + 4 * i) * 136 + nc * 2) = w; }
    LDS_WAIT();
    const int c = lane & 7;
#pragma unroll
    for (int j = 0; j < 8; ++j) { const int n = (lane >> 3) + 8 * j; const LAS bf16_t* s = (const LAS bf16_t*)(scr + (8 * c) * 136 + n * 2);
        u32x4 o; o.x = (unsigned)s[0] | ((unsigned)s[68] << 16); o.y = (unsigned)s[2 * 68] | ((unsigned)s[3 * 68] << 16); o.z = (unsigned)s[4 * 68] | ((unsigned)s[5 * 68] << 16); o.w = (unsigned)s[6 * 68] | ((unsigned)s[7 * 68] << 16);
        *(u32x4*)(WT + (size_t)(n0 + n) * K + k0 + 8 * c) = o; }
    LDS_WAIT();
}
__device__ __forceinline__ void cvt_row(const float* src, bf16_t* dst, float* ss, int lane) {
    const f32x4* xr = (const f32x4*)src + lane; f32x4 v[8]; float s = 0.f;
#pragma unroll
    for (int j = 0; j < 8; ++j) { v[j] = xr[64 * j]; s += (v[j].x * v[j].x + v[j].y * v[j].y) + (v[j].z * v[j].z + v[j].w * v[j].w); }
    s = wave_sum(s);
    u32x2* o8 = (u32x2*)dst + lane;
#pragma unroll
    for (int j = 0; j < 8; ++j) { u32x2 w; w.x = pk2(v[j].x, v[j].y); w.y = pk2(v[j].z, v[j].w); o8[64 * j] = w; }
    if (lane == 0) *ss = s;
}

struct Mix {
    const float *conv_a_w, *conv_a_b, *lru_br, *lru_bi, *lru_lambda, *conv_b_w;
    const bf16_t* gw;
    bf16_t* U; bf16_t* Y; unsigned long long* AGG;
};
struct ItemId { int hd, b, c, row0, ntok, agg; bool meta; };
__device__ __forceinline__ ItemId decode_item(int id) {
    ItemId I;
    if (id < 16) { I.meta = true; I.hd = id; I.b = 0; I.c = 0; I.row0 = META0; I.ntok = 16; I.agg = 256; }
    else { const int j = id - 16; I.meta = false; I.hd = j & 15; I.c = (j >> 4) & 63; I.b = j >> 10; I.row0 = I.b * SEQ + I.c * 64; I.ntok = 64; I.agg = I.b * 64 + I.c; }
    return I;
}
constexpr int N_ITEMS = 16 + NBATCH * NHEAD * 64;

__device__ __forceinline__ bool agg_ok(unsigned long long v) { return (unsigned)v != 0u; }
template <bool META> __device__ __forceinline__ void mix_item(const Mix& X, int id, LAS unsigned char* xt, int lane) {
    constexpr int NT = META ? 16 : 64, NTB = META ? 1 : 2, NQ = META ? 2 : 4;
    constexpr float LOG2E = 1.4426950408889634f;
    const ItemId I = decode_item(id);
    const int ch = I.hd * 64 + lane;
    const float nls2 = -8.0f * LOG2E * log1pf(__expf(-X.lru_lambda[ch]));
    bf16_t raw[NT], rh0 = 0, rh1 = 0, rh2 = 0;
    const float w0 = X.conv_a_w[ch], w1 = X.conv_a_w[1024 + ch], w2 = X.conv_a_w[2048 + ch], w3 = X.conv_a_w[3072 + ch], cb = X.conv_a_b[ch];
    {
        const GAS bf16_t* sb = (const GAS bf16_t*)(X.U + (size_t)I.row0 * DIN + I.hd * 64);
        if (!META) { const GAS bf16_t* hp0 = (I.c == 0) ? (const GAS bf16_t*)(X.U + (size_t)(META0 + 13) * DIN + I.hd * 64) : sb - 3 * DIN; rh0 = hp0[lane]; rh1 = hp0[DIN + lane]; rh2 = hp0[2 * DIN + lane]; }
#pragma unroll
        for (int t = 0; t < NT; ++t) { raw[t] = sb[lane]; sb += DIN; asm volatile("" : "+s"(sb)); }
    }
    bf16x8 BfR0[4], BfR1[4], BfI0[4], BfI1[4];
    { const bf16_t* gr = X.gw + (size_t)(I.hd * 64 + (lane & 31)) * 64 + 8 * (lane >> 5); const bf16_t* gi = gr + 16 * 64 * 64;
#pragma unroll
      for (int s = 0; s < 4; ++s) { BfR0[s] = *(const bf16x8*)(gr + 16 * s); BfR1[s] = *(const bf16x8*)(gr + 32 * 64 + 16 * s); BfI0[s] = *(const bf16x8*)(gi + 16 * s); BfI1[s] = *(const bf16x8*)(gi + 32 * 64 + 16 * s); } }
    asm volatile("" ::: "memory");
    float xm3 = bf1(rh0), xm2 = bf1(rh1), xm1 = bf1(rh2);
#pragma unroll
    for (int t = 0; t < NT; ++t) { const float x0 = bf1(raw[t]); const float xc = cb + w0 * xm3 + w1 * xm2 + w2 * xm1 + w3 * x0; xm3 = xm2; xm2 = xm1; xm1 = x0;
        *(LAS bf16_t*)(xt + t * 144 + lane * 2) = (bf16_t)f2bf(xc); }
    const float brA = X.lru_br[I.hd * 64 + (lane & 31)], brB = X.lru_br[I.hd * 64 + 32 + (lane & 31)], biA = X.lru_bi[I.hd * 64 + (lane & 31)], biB = X.lru_bi[I.hd * 64 + 32 + (lane & 31)];
    float h = 0.f, P = 1.f;
    unsigned hp[NT];
#pragma unroll
    for (int tb = 0; tb < NTB; ++tb) {
        f32x16 aR0, aR1, aI0, aI1;
#pragma unroll
        for (int e = 0; e < 16; ++e) { aR0[e] = brA; aR1[e] = brB; aI0[e] = biA; aI1[e] = biB; }
#pragma unroll
        for (int s = 0; s < 4; ++s) {
            const bf16x8 af = *(const LAS bf16x8*)(xt + (tb * 32 + (lane & 31)) * 144 + (16 * s + 8 * (lane >> 5)) * 2);
            aR0 = __builtin_amdgcn_mfma_f32_32x32x16_bf16(af, BfR0[s], aR0, 0, 0, 0);
            aR1 = __builtin_amdgcn_mfma_f32_32x32x16_bf16(af, BfR1[s], aR1, 0, 0, 0);
            aI0 = __builtin_amdgcn_mfma_f32_32x32x16_bf16(af, BfI0[s], aI0, 0, 0, 0);
            aI1 = __builtin_amdgcn_mfma_f32_32x32x16_bf16(af, BfI1[s], aI1, 0, 0, 0);
        }
#pragma unroll
        for (int q = 0; q < NQ; ++q) {
            float Rv[2][4], Iv[2][4];
#pragma unroll
            for (int k = 0; k < 4; ++k) {
                const int reg = 4 * q + k;
                const float r0f = aR0[reg], r1f = aR1[reg], i0f = aI0[reg], i1f = aI1[reg];
                auto r = __builtin_amdgcn_permlane32_swap(__float_as_uint(r0f), __float_as_uint(r1f), false, false);
                Rv[0][k] = __uint_as_float(r[0]); Rv[1][k] = __uint_as_float(r[1]);
                auto i2 = __builtin_amdgcn_permlane32_swap(__float_as_uint(i0f), __float_as_uint(i1f), false, false);
                Iv[0][k] = __uint_as_float(i2[0]); Iv[1][k] = __uint_as_float(i2[1]);
            }
#pragma unroll
            for (int st = 0; st < 2; ++st)
#pragma unroll
                for (int p = 0; p < 2; ++p) {
                    const int t = tb * 32 + 8 * q + 4 * st + 2 * p;
                    f32x2 er = (f32x2){Rv[st][2 * p], Rv[st][2 * p + 1]} * (-LOG2E), ei = (f32x2){Iv[st][2 * p], Iv[st][2 * p + 1]} * (-LOG2E);
                    er.x = __builtin_amdgcn_exp2f(er.x); er.y = __builtin_amdgcn_exp2f(er.y); ei.x = __builtin_amdgcn_exp2f(ei.x); ei.y = __builtin_amdgcn_exp2f(ei.y);
                    er = er + 1.0f; ei = ei + 1.0f;
                    f32x2 rg, ig; rg.x = __builtin_amdgcn_rcpf(er.x); rg.y = __builtin_amdgcn_rcpf(er.y); ig.x = __builtin_amdgcn_rcpf(ei.x); ig.y = __builtin_amdgcn_rcpf(ei.y);
                    const f32x2 l2 = rg * nls2;
                    f32x2 a; a.x = __builtin_amdgcn_exp2f(l2.x); a.y = __builtin_amdgcn_exp2f(l2.y);
                    f32x2 om = 1.0f - a * a; om.x = fmaxf(om.x, 0.f); om.y = fmaxf(om.y, 0.f);
                    f32x2 mu; mu.x = __builtin_amdgcn_sqrtf(om.x); mu.y = __builtin_amdgcn_sqrtf(om.y);
                    const f32x2 xc = (f32x2){bf1(*(const LAS bf16_t*)(xt + t * 144 + lane * 2)), bf1(*(const LAS bf16_t*)(xt + (t + 1) * 144 + lane * 2))};
                    const f32x2 bb = mu * ig * xc;
                    h = a.x * h + bb.x; P = P * a.x; hp[t] = pg8::cvt_pk_bf16(h, P);
                    h = a.y * h + bb.y; P = P * a.y; hp[t + 1] = pg8::cvt_pk_bf16(h, P);
                }
        }
    }
    __hip_atomic_store(X.AGG + (size_t)I.agg * 1024 + ch, ((unsigned long long)__float_as_uint(h) << 32) | (unsigned long long)__float_as_uint(P), __ATOMIC_RELAXED, __HIP_MEMORY_SCOPE_AGENT);
    asm volatile("" ::: "memory");
    bf16_t graw[NT];
    { const GAS bf16_t* sb = (const GAS bf16_t*)(X.U + (size_t)I.row0 * DIN + 1024 + I.hd * 64);
#pragma unroll
      for (int t = 0; t < NT; ++t) { graw[t] = sb[lane]; sb += DIN; asm volatile("" : "+s"(sb)); } }
    float hin = 0.f;
    if (!META) {
        { const unsigned long long* mp = X.AGG + (size_t)256 * 1024 + ch; unsigned long long v;
          for (;;) { v = __hip_atomic_load(mp, __ATOMIC_RELAXED, __HIP_MEMORY_SCOPE_AGENT); if (!__any(!agg_ok(v))) break; __builtin_amdgcn_s_sleep(2); }
          hin = __uint_as_float((unsigned)(v >> 32)); }
        const unsigned long long* ap = X.AGG + (size_t)(I.b * 64) * 1024 + ch;
        for (int j0 = 0; j0 < I.c; j0 += 16) {
            unsigned long long v[16];
            for (;;) {
                bool bad = false;
#pragma unroll
                for (int k = 0; k < 16; ++k) { v[k] = (j0 + k < I.c) ? __hip_atomic_load(ap + (size_t)(j0 + k) * 1024, __ATOMIC_RELAXED, __HIP_MEMORY_SCOPE_AGENT) : 0x000000003f800000ull; }
#pragma unroll
                for (int k = 0; k < 16; ++k) bad |= !agg_ok(v[k]);
                if (!__any(bad)) break;
                __builtin_amdgcn_s_sleep(2);
            }
#pragma unroll
            for (int k = 0; k < 16; ++k) hin = __uint_as_float((unsigned)v[k]) * hin + __uint_as_float((unsigned)(v[k] >> 32));
        }
    }
    asm volatile("" ::: "memory");
    GAS bf16_t* yp = (GAS bf16_t*)(X.Y + (size_t)I.row0 * DM + I.hd * 64);
#pragma unroll
    for (int t0 = 0; t0 < NT; t0 += 16) {
        {
#pragma unroll
            for (int k = 0; k < 16; k += 2) {
                const unsigned w0 = hp[t0 + k], w1 = hp[t0 + k + 1];
                const f32x2 gg = (f32x2){bf1(graw[t0 + k]), bf1(graw[t0 + k + 1])};
                f32x2 e = gg * (-LOG2E); e.x = __builtin_amdgcn_exp2f(e.x); e.y = __builtin_amdgcn_exp2f(e.y); e = e + 1.0f;
                f32x2 sg; sg.x = __builtin_amdgcn_rcpf(e.x); sg.y = __builtin_amdgcn_rcpf(e.y);
                const f32x2 hv = (f32x2){bflo(w0), bflo(w1)} + (f32x2){bfhi(w0), bfhi(w1)} * hin;
                const f32x2 y = hv * gg * sg;
                const unsigned pk = pg8::cvt_pk_bf16(y.x, y.y);
                yp[lane] = (bf16_t)(pk & 0xffffu); yp[DM + lane] = (bf16_t)(pk >> 16); yp += 2 * DM; asm volatile("" : "+s"(yp));
            }
        }
    }
}

__device__ __forceinline__ void ld8(const bf16_t* p, float (&o)[8]) {
    const u32x4 w = *(const u32x4*)p;
    o[0] = bflo(w.x); o[1] = bfhi(w.x); o[2] = bflo(w.y); o[3] = bfhi(w.y); o[4] = bflo(w.z); o[5] = bfhi(w.z); o[6] = bflo(w.w); o[7] = bfhi(w.w);
}
__device__ __forceinline__ void partb(const Mix& X, int tid) {
    for (int it = blockIdx.x * 512 + tid; it < 1025 * 128; it += gridDim.x * 512) {
        const int c0 = (it & 127) * 8, run = it >> 7;
        float w0[8], w1[8], w2[8], cm2[8], cm1[8];
        { const f32x4* p = (const f32x4*)(X.conv_b_w + c0); const f32x4 a0 = p[0], a1 = p[1], b0 = p[256], b1 = p[257], d0 = p[512], d1 = p[513];
#pragma unroll
          for (int e = 0; e < 4; ++e) { w0[e] = a0[e]; w0[4 + e] = a1[e]; w1[e] = b0[e]; w1[4 + e] = b1[e]; w2[e] = d0[e]; w2[4 + e] = d1[e]; } }
        if (run == 1024) {
#pragma unroll
            for (int e = 0; e < 8; ++e) { cm2[e] = 0.f; cm1[e] = 0.f; }
            const bf16_t* up = X.U + (size_t)META0 * DIN + c0; bf16_t* yp = X.Y + (size_t)META0 * DM + 1024 + c0;
#pragma unroll 4
            for (int t = 0; t < 16; ++t) {
                float bv[8], cv[8], xv[8], gv[8];
                ld8(up + (size_t)t * DIN + 2048, bv); ld8(up + (size_t)t * DIN + 3072, cv); ld8(up + (size_t)t * DIN + 4096, xv); ld8(up + (size_t)t * DIN + 5120, gv);
                float o[8];
#pragma unroll
                for (int e = 0; e < 8; ++e) { const float cx = cv[e] * xv[e]; const float y = w0[e] * cm2[e] + w1[e] * cm1[e] + w2[e] * cx; o[e] = bv[e] * y * (gv[e] * sigmoidf_(gv[e])); cm2[e] = cm1[e]; cm1[e] = cx; }
                u32x4 w; w.x = pk2(o[0], o[1]); w.y = pk2(o[2], o[3]); w.z = pk2(o[4], o[5]); w.w = pk2(o[6], o[7]);
                *(u32x4*)(yp + (size_t)t * DM) = w;
            }
            continue;
        }
        const int row0 = run * 16;
        if ((row0 & (SEQ - 1)) == 0) {
            float c[8], x[8];
            ld8(X.U + (size_t)(META0 + 14) * DIN + 3072 + c0, c); ld8(X.U + (size_t)(META0 + 14) * DIN + 4096 + c0, x);
#pragma unroll
            for (int e = 0; e < 8; ++e) cm2[e] = c[e] * x[e];
            ld8(X.U + (size_t)(META0 + 15) * DIN + 3072 + c0, c); ld8(X.U + (size_t)(META0 + 15) * DIN + 4096 + c0, x);
#pragma unroll
            for (int e = 0; e < 8; ++e) cm1[e] = c[e] * x[e];
        } else {
            const u32x4* p2 = (const u32x4*)(X.U + (size_t)(row0 - 2) * DIN + 2048 + 2 * c0); const u32x4* p1 = (const u32x4*)(X.U + (size_t)(row0 - 1) * DIN + 2048 + 2 * c0);
            const u32x4 a0 = p2[0], a1 = p2[1], b0 = p1[0], b1 = p1[1];
#pragma unroll
            for (int e = 0; e < 4; ++e) { cm2[e] = bfhi(a0[e]); cm2[4 + e] = bfhi(a1[e]); cm1[e] = bfhi(b0[e]); cm1[4 + e] = bfhi(b1[e]); }
        }
        const bf16_t* vp = X.U + (size_t)row0 * DIN + 2048 + 2 * c0;
        bf16_t* yp = X.Y + (size_t)row0 * DM + 1024 + c0;
#pragma unroll 8
        for (int t = 0; t < 16; ++t) {
            const u32x4 q0 = *(const u32x4*)(vp + (size_t)t * DIN), q1 = *(const u32x4*)(vp + (size_t)t * DIN + 8);
            float o[8];
#pragma unroll
            for (int e = 0; e < 8; ++e) { const unsigned q = e < 4 ? q0[e & 3] : q1[e & 3]; const float bg = bflo(q), cx = bfhi(q);
                o[e] = bg * (w0[e] * cm2[e] + w1[e] * cm1[e] + w2[e] * cx); cm2[e] = cm1[e]; cm1[e] = cx; }
            u32x4 w; w.x = pk2(o[0], o[1]); w.y = pk2(o[2], o[3]); w.z = pk2(o[4], o[5]); w.w = pk2(o[6], o[7]);
            *(u32x4*)(yp + (size_t)t * DM) = w;
        }
    }
}


#ifdef DEBUG_NAIVE_MIX
__global__ void __launch_bounds__(64) naive_mixA(Mix X, const float* wr, const float* wi) {
    const int b = blockIdx.x / 16, hd = blockIdx.x % 16, lane = threadIdx.x, ch = hd * 64 + lane;
    __shared__ float xs[64];
    const float w0 = X.conv_a_w[ch], w1 = X.conv_a_w[1024 + ch], w2 = X.conv_a_w[2048 + ch], w3 = X.conv_a_w[3072 + ch], cb = X.conv_a_b[ch];
    const float br = X.lru_br[ch], bi = X.lru_bi[ch];
    const float sp = log1pf(expf(-X.lru_lambda[ch]));
    const float* wrh = wr + (size_t)hd * 4096 + lane; const float* wih = wi + (size_t)hd * 4096 + lane;
    float h = 0.f, xm3 = 0.f, xm2 = 0.f, xm1 = 0.f;
    for (int p = 0; p < NMETA + SEQ; ++p) {
        const int row = p < NMETA ? META0 + p : b * SEQ + (p - NMETA);
        const float x0 = bf1(X.U[(size_t)row * DIN + ch]);
        const float xc = cb + w0 * xm3 + w1 * xm2 + w2 * xm1 + w3 * x0; xm3 = xm2; xm2 = xm1; xm1 = x0;
        xs[lane] = xc; __syncthreads();
        float rp = br, ip = bi;
#pragma unroll 4
        for (int i = 0; i < 64; ++i) { rp += xs[i] * wrh[i * 64]; ip += xs[i] * wih[i * 64]; }
        __syncthreads();
        const float r = 1.f / (1.f + expf(-rp)), ig = 1.f / (1.f + expf(-ip));
        const float la = -8.f * r * sp; const float a = expf(la); const float bb = sqrtf(-expm1f(2.f * la)) * (ig * xc);
        h = a * h + bb;
        const float g = bf1(X.U[(size_t)row * DIN + 1024 + ch]);
        const float y = h * g / (1.f + expf(-g));
        if (p >= NMETA || b == 0) X.Y[(size_t)row * DM + ch] = (bf16_t)f2bf(y);
    }
}
__global__ void naive_mixB(Mix X) {
    for (size_t idx = (size_t)blockIdx.x * blockDim.x + threadIdx.x; idx < (size_t)(MROWS + NMETA) * 1024; idx += (size_t)gridDim.x * blockDim.x) {
        const int row = (int)(idx >> 10), c = (int)(idx & 1023);
        int r1, r2;
        if (row >= META0) { const int p = row - META0; r1 = p >= 1 ? row - 1 : -1; r2 = p >= 2 ? row - 2 : -1; }
        else { const int t = row & (SEQ - 1); r1 = t >= 1 ? row - 1 : META0 + 15; r2 = t >= 2 ? row - 2 : META0 + 14 + t; }
        auto cx = [&](int r) -> float { return r < 0 ? 0.f : bf1(X.U[(size_t)r * DIN + 3072 + c]) * bf1(X.U[(size_t)r * DIN + 4096 + c]); };
        const float y = X.conv_b_w[c] * cx(r2) + X.conv_b_w[1024 + c] * cx(r1) + X.conv_b_w[2048 + c] * cx(row);
        const float bv = bf1(X.U[(size_t)row * DIN + 2048 + c]), g = bf1(X.U[(size_t)row * DIN + 5120 + c]);
        X.Y[(size_t)row * DM + 1024 + c] = (bf16_t)f2bf(bv * y * g / (1.f + expf(-g)));
    }
}
#endif
#define XB_TMO      128
#define XB_XCNT(j)  (256  + 64 * (j))
#define XB_XSUB(j)  (1280 + 64 * (j))
#define XB_XGEN(j)  (2304 + 64 * (j))
#define XB_TOP      3328
#define XB_TOPGEN   3392
#define XCD_BAR_WORDS 3456
#define XB_SPIN_CAP (1u << 18)

__device__ __forceinline__ unsigned xb_ld(unsigned* p)              { return __hip_atomic_load(p, __ATOMIC_RELAXED, __HIP_MEMORY_SCOPE_AGENT); }
__device__ __forceinline__ unsigned xb_add(unsigned* p, unsigned v) { return __hip_atomic_fetch_add(p, v, __ATOMIC_RELAXED, __HIP_MEMORY_SCOPE_AGENT); }
__device__ __forceinline__ unsigned xb_xcc_id() { return (unsigned)__builtin_amdgcn_s_getreg((3 << 11) | 20) & 0xFu; }
#define XB_SPIN(cond, bar) do { unsigned _sp = 0; while (cond) { __builtin_amdgcn_s_sleep(1); \
    if ((++_sp & 255u) == 0u) { if (xb_ld(&(bar)[XB_TMO])) break; if (_sp > XB_SPIN_CAP) { atomicAdd(&(bar)[XB_TMO], 1u); break; } } } } while (0)

struct XcdBarrier {
    unsigned* bar; unsigned x;
    volatile LAS unsigned* st;
};

__device__ __forceinline__ XcdBarrier xcd_barrier_post(unsigned* bar, volatile LAS unsigned* st) {
    XcdBarrier b; b.bar = bar; b.x = xb_xcc_id(); b.st = st;
    if (threadIdx.x == 0) (void)xb_add(&bar[XB_XCNT(b.x)], 1u);
    return b;
}
__device__ __forceinline__ void xcd_barrier_complete(unsigned* bar, unsigned x, unsigned& nloc, unsigned& nx) {
    const unsigned G = gridDim.x * gridDim.y * gridDim.z;
    unsigned sum, cnt, mine, sp = 0u;
    for (;;) {
        sum = 0u; cnt = 0u; mine = 0u;
#pragma unroll
        for (unsigned j = 0; j < 16; ++j) { const unsigned c = xb_ld(&bar[XB_XCNT(j)]); sum += c; cnt += (c > 0u) ? 1u : 0u; mine = (j == x) ? c : mine; }
        if (sum == G) break;
        __builtin_amdgcn_s_sleep(1);
        if ((++sp & 255u) == 0u) { if (xb_ld(&bar[XB_TMO])) break; if (sp > XB_SPIN_CAP) { atomicAdd(&bar[XB_TMO], 1u); break; } }
    }
    nloc = mine > 0u ? mine : 1u; nx = cnt > 0u ? cnt : 1u;
}

__device__ __forceinline__ void xcd_barrier(const XcdBarrier& b) {
    asm volatile("s_waitcnt vmcnt(0)" ::: "memory");
    __syncthreads();
    if (threadIdx.x == 0) {
        unsigned* bar = b.bar;
        __builtin_amdgcn_s_waitcnt(0);
        unsigned nloc = b.st[0], nx = b.st[1];
        if (nloc == 0u) { xcd_barrier_complete(bar, b.x, nloc, nx); b.st[0] = nloc; b.st[1] = nx; }
        const unsigned old = xb_add(&bar[XB_XSUB(b.x)], 1u);
        const unsigned gen = old / nloc;
        if (old + 1u == (gen + 1u) * nloc) {
            __builtin_amdgcn_fence(__ATOMIC_RELEASE, "agent");
            asm volatile("s_waitcnt vmcnt(0)" ::: "memory");
            const unsigned og = xb_add(&bar[XB_TOP], 1u);
            const unsigned tg = og / nx;
            if (og + 1u == (tg + 1u) * nx) xb_add(&bar[XB_TOPGEN], 1u);
            else XB_SPIN(xb_ld(&bar[XB_TOPGEN]) == tg, bar);
            __builtin_amdgcn_fence(__ATOMIC_ACQUIRE, "agent");
            xb_add(&bar[XB_XGEN(b.x)], 1u);
            asm volatile("s_waitcnt vmcnt(0)" ::: "memory");
        } else {
            XB_SPIN(xb_ld(&bar[XB_XGEN(b.x)]) == gen, bar);
            __builtin_amdgcn_fence(__ATOMIC_ACQUIRE, "agent");
            asm volatile("s_waitcnt vmcnt(0)" ::: "memory");
        }
    }
    __syncthreads();
}

__global__ void __launch_bounds__(512, 2) hymba_fwd(Args a) {
    extern __shared__ __attribute__((aligned(16))) unsigned char lds_raw[];
    LAS unsigned char* lds = (LAS unsigned char*)lds_raw;
    cg::grid_group grid = cg::this_grid();
    const int NGW = gridDim.x * 8;
    if (threadIdx.x < 64) ((LAS unsigned*)(lds + 131072))[threadIdx.x] = 0u;
    __syncthreads();
    XcdBarrier xbar; xbar.bar = (unsigned*)(a.ws + WS_BAR); xbar.x = 0; xbar.st = nullptr;
    if (a.ph_hi - a.ph_lo > 1) xbar = xcd_barrier_post((unsigned*)(a.ws + WS_BAR), (volatile LAS unsigned*)(lds + 131072));
    if (a.ph_lo < 0) grid.sync();
#define LAUNDER() int tid = threadIdx.x; asm volatile("" : "+v"(tid)); const int wid = __builtin_amdgcn_readfirstlane(tid >> 6), lane = tid & 63, gw = blockIdx.x * 8 + wid
    const int lo = a.ph_lo, hi = a.ph_hi;
#define IN(k) (lo <= (k) && (k) < hi)
#ifndef STAGGER_N
#define STAGGER_N 0
#endif
#define STAGGER() do { if (STAGGER_N) for (int _k = 0; _k < (int)(blockIdx.x & 7); ++_k) __builtin_amdgcn_s_sleep(STAGGER_N); } while (0)
#define SEAM(k) do { if (IN(k) && IN((k) + 1)) { xcd_barrier(xbar); if ((REP_MASK >> 10) & 1) { xcd_barrier(xbar); xcd_barrier(xbar); } } } while (0)
    const float* x = a.in[0]; const float* meta = a.in[1]; const float* norm_g = a.in[2]; const float* w_in = a.in[3];
    const float* conv_a_w = a.in[4]; const float* conv_a_b = a.in[5]; const float* lru_wr = a.in[6]; const float* lru_br = a.in[7];
    const float* lru_wi = a.in[8]; const float* lru_bi = a.in[9]; const float* lru_lambda = a.in[10]; const float* conv_b_w = a.in[11];
    const float* w_out = a.in[12]; const float* final_g = a.in[13];
    unsigned char* ws = a.ws;
    bf16_t* WTIN = (bf16_t*)(ws + WS_WTIN); bf16_t* WTOUT = (bf16_t*)(ws + WS_WTOUT); bf16_t* GW = (bf16_t*)(ws + WS_GW);
    float* ROWSS = (float*)(ws + WS_ROWSS); unsigned long long* AGG = (unsigned long long*)(ws + WS_AGG);
    bf16_t* XB = (bf16_t*)(ws + WS_XB); bf16_t* Y = (bf16_t*)(ws + WS_Y); bf16_t* U = (bf16_t*)(ws + WS_U);

    if (IN(0)) for (int rep = 0; rep <= ((REP_MASK >> 0) & 1); ++rep) {
        LAUNDER();
        LAS unsigned char* scr = lds + wid * 16384;
        constexpr int I_IN = (DM / 64) * (DIN / 64), I_OUT = (DM / 64) * (DM / 64);
        constexpr int NIT = 2 * I_IN + 2 * I_OUT + 64;
        for (int it = gw; it < NIT; it += NGW) {
            int r = it;
            if (r < 2 * I_IN) { const int l = r / I_IN; tr_item<true>(w_in + (size_t)l * DM * DIN, DM, DIN, WTIN + (size_t)l * DIN * DM, norm_g + l * DM, scr, r % I_IN, lane); continue; } r -= 2 * I_IN;
            if (r < 2 * I_OUT) { const int l = r / I_OUT; tr_item<false>(w_out + (size_t)l * DM * DM, DM, DM, WTOUT + (size_t)l * DM * DM, nullptr, scr, r % I_OUT, lane); continue; } r -= 2 * I_OUT;
            { const int mtx = r, l = mtx >> 5, g = (mtx >> 4) & 1, hd = mtx & 15;
              const float* src = (g ? lru_wi : lru_wr) + (size_t)(l * 16 + hd) * 4096;
              tr_item<false>(src, 64, 64, GW + (size_t)mtx * 4096, nullptr, scr, 0, lane); }
        }
        for (int m = gw; m < MROWS + NMETA; m += NGW) {
            const float* src = m < MROWS ? x + (size_t)m * DM : meta + (size_t)(m - MROWS) * DM;
            cvt_row(src, XB + (size_t)m * DM, ROWSS + m, lane);
        }
        for (int i = blockIdx.x * 512 + tid; i < 2 * RSTR; i += gridDim.x * 512) ROWSS[RSTR + i] = 0.f;
        for (int i = blockIdx.x * 512 + tid; i < AGG_PER_LAYER; i += gridDim.x * 512) ((u32x4*)AGG)[i] = (u32x4){0u, 0u, 0u, 0u};
    }
    SEAM(0);

#pragma unroll 1
    for (int l = 0; l < 2; ++l) {
        const int pb = 1 + 3 * l;
        const bf16_t* wtin = WTIN + (size_t)l * DIN * DM; const bf16_t* wtout = WTOUT + (size_t)l * DM * DM;
        float* rss_in = ROWSS + (size_t)l * RSTR; float* rss_out = ROWSS + (size_t)(l + 1) * RSTR;
        Mix X; X.conv_a_w = conv_a_w + l * 4 * DLRU; X.conv_a_b = conv_a_b + l * DLRU; X.lru_br = lru_br + l * DLRU; X.lru_bi = lru_bi + l * DLRU; X.lru_lambda = lru_lambda + l * DLRU;
        X.conv_b_w = conv_b_w + l * 3 * DLRU; X.gw = GW + (size_t)l * 2 * 16 * 4096; X.U = U; X.Y = Y; X.AGG = AGG + (size_t)l * AGG_PER_LAYER;

        if (IN(pb)) for (int rep = 0; rep <= ((REP_MASK >> pb) & 1); ++rep) {
            LAUNDER();
            STAGGER();
            for (int mrep = 0; mrep <= ((REP_MASK >> 16) & 1); ++mrep)
            meta_gemm(XB + (size_t)META0 * DM, wtin, DIN / 16, lds, wid, lane, [&](int m, int n0, f32x4 s) {
                const float rs = rsqrtf(rss_in[META0 + m] * (1.0f / DM) + RMS_EPS);
                u32x2 w; w.x = pk2(s[0] * rs, s[1] * rs); w.y = pk2(s[2] * rs, s[3] * rs);
                *(u32x2*)(U + (size_t)(META0 + m) * DIN + in_col(n0)) = w; });
            pg8::Gemm g{XB, wtin, MROWS, DIN, DM}; pg8::StaticOrder S; S.init(MROWS, DIN, (int)gridDim.x, (int)blockIdx.x);
            if ((REP_MASK >> 17) & 1) { EpiUT<true> En{U, rss_in}; pg8::gemm_phase<EpiUT<true>, pg8::StaticOrder, false>(lds, g, S, En, nullptr); }
            if ((REP_MASK >> 15) & 1) { EpiNull En{ROWSS + (size_t)3 * RSTR}; pg8::gemm_phase<EpiNull, pg8::StaticOrder, false>(lds, g, S, En, nullptr); }
            EpiU E{U, rss_in};
            pg8::gemm_phase<EpiU, pg8::StaticOrder, false>(lds, g, S, E, nullptr);
        }
        SEAM(pb);
        if (IN(pb + 1)) for (int rep = 0; rep <= ((REP_MASK >> (pb + 1)) & 1); ++rep) {
            LAUNDER();
#pragma unroll 1
            for (int step = 0; step < 2; ++step) {
                if ((step == 0) == (wid < 4)) {
                    if (rep == 1 && ((REP_MASK >> 13) & 1)) continue;
#pragma unroll 1
                    for (int id = gw; id < N_ITEMS; id += NGW) { if (id < 16) mix_item<true>(X, id, lds + wid * 9216, lane); else mix_item<false>(X, id, lds + wid * 9216, lane); }
                } else { if (rep == 1 && ((REP_MASK >> 12) & 1)) continue; partb(X, tid); }
            }
        }
        SEAM(pb + 1);
        if (IN(pb + 2)) {
            LAUNDER();
            STAGGER();
            if (l == 0) {
                meta_gemm(Y + (size_t)META0 * DM, wtout, DM / 16, lds, wid, lane, [&](int m, int n0, f32x4 s) {
                    const f32x4 r = *(const f32x4*)(meta + (size_t)m * DM + n0); const f32x4 hh = r + s;
                    u32x2 w; w.x = pk2(hh[0], hh[1]); w.y = pk2(hh[2], hh[3]);
                    *(u32x2*)(XB + (size_t)(META0 + m) * DM + n0) = w;
                    unsafeAtomicAdd(rss_out + META0 + m, (hh[0] * hh[0] + hh[1] * hh[1]) + (hh[2] * hh[2] + hh[3] * hh[3])); });
            }
            pg8::Gemm g{Y, wtout, MROWS, DM, DM};
            if (l == 0) {
                pg8::StaticOrder S; S.init(MROWS, DM, (int)gridDim.x, (int)blockIdx.x);
                if ((REP_MASK >> 11) & 1) { EpiU Ed{U, rss_in}; pg8::gemm_phase<EpiU, pg8::StaticOrder, false>(lds, g, S, Ed, nullptr); }
                if ((REP_MASK >> 14) & 1) { EpiRes Ed{x, nullptr, XB, ROWSS + (size_t)3 * RSTR}; pg8::gemm_phase<EpiRes, pg8::StaticOrder, false>(lds, g, S, Ed, nullptr); }
                EpiRes E{x, nullptr, XB, rss_out};
                pg8::gemm_phase<EpiRes, pg8::StaticOrder, false>(lds, g, S, E, nullptr);
            } else {
                PanelOrder S; S.init((int)gridDim.x, (int)blockIdx.x);
                EpiResNorm E{XB, a.out, rss_out, (unsigned*)(ws + WS_PCNT), final_g};
                pg8::gemm_phase<EpiResNorm, PanelOrder, false>(lds, g, S, E, nullptr);
            }
        }
        SEAM(pb + 2);
    }

#undef IN
#undef SEAM
}

#ifndef MK_LAUNCH_PER_PHASE
#define MK_LAUNCH_PER_PHASE 0
#endif
extern "C" void kernel_launch(void* const* d_in, const int* in_sizes, int n_in, void* d_out, int out_size, void* d_ws, size_t ws_size, hipStream_t stream) {
    static int grid = 0;
    if (grid == 0) {
        if (n_in != 14 || in_sizes[0] != MROWS * DM || out_size != MROWS * DM || ws_size < WS_END) { fprintf(stderr, "kernel_launch: unexpected shapes (n_in %d, in0 %d, out %d, ws %zu)\n", n_in, n_in > 0 ? in_sizes[0] : -1, out_size, ws_size); grid = -1; return; }
        int dev = 0, cus = 0, per_cu = 0;
        hipGetDevice(&dev); hipDeviceGetAttribute(&cus, hipDeviceAttributeMultiprocessorCount, dev);
        if (hipFuncSetAttribute((const void*)hymba_fwd, hipFuncAttributeMaxDynamicSharedMemorySize, LDS_BYTES) != hipSuccess) { fprintf(stderr, "kernel_launch: hipFuncSetAttribute failed\n"); grid = -1; return; }
        if (hipOccupancyMaxActiveBlocksPerMultiprocessor(&per_cu, (const void*)hymba_fwd, 512, LDS_BYTES) != hipSuccess || per_cu < 1) { fprintf(stderr, "kernel_launch: occupancy query gave %d\n", per_cu); per_cu = 1; }
        (void)hipGetLastError();
        grid = cus * per_cu;
    }
    if (grid < 0) return;
    Args a{};
    for (int i = 0; i < 14; ++i) a.in[i] = (const float*)d_in[i];
    a.out = (float*)d_out; a.ws = (unsigned char*)d_ws;
#if MK_LAUNCH_PER_PHASE
    for (int p = 0; p < NPHASE; ++p) {
#ifdef DEBUG_NAIVE_MIX
        if (p == 2 || p == 6) { const int l = p / 4; unsigned char* ws = (unsigned char*)d_ws;
            Mix X; X.conv_a_w = a.in[4] + l * 4 * DLRU; X.conv_a_b = a.in[5] + l * DLRU; X.lru_br = a.in[7] + l * DLRU; X.lru_bi = a.in[9] + l * DLRU; X.lru_lambda = a.in[10] + l * DLRU;
            X.conv_b_w = a.in[11] + l * 3 * DLRU; X.gw = nullptr; X.U = (bf16_t*)(ws + WS_U); X.Y = (bf16_t*)(ws + WS_Y); X.HP = nullptr; X.AGG = nullptr;
#if DEBUG_NAIVE_MIX == 1
            hipLaunchKernelGGL(naive_mixA, dim3(64), dim3(64), 0, stream, X, a.in[6] + (size_t)l * 16 * 4096, a.in[8] + (size_t)l * 16 * 4096);
            a.flags = 1;
#else
            hipLaunchKernelGGL(naive_mixB, dim3(2048), dim3(256), 0, stream, X);
            a.flags = 2;
#endif
            }
        else a.flags = 0;
#if DEBUG_NAIVE_MIX == 1
        if (p == 3 || p == 7) continue;
#endif
#endif
        a.ph_lo = p; a.ph_hi = p + 1; hipLaunchKernelGGL(hymba_fwd, dim3(grid), dim3(512), LDS_BYTES, stream, a); }
#else
    a.ph_lo = 0; a.ph_hi = NPHASE;
    if (hipMemsetAsync((unsigned char*)d_ws + WS_BAR, 0, 16384 + 32768, stream) != hipSuccess) { fprintf(stderr, "kernel_launch: memset of barrier words failed\n"); return; }
    void* args[] = {&a};
    const hipError_t e = hipLaunchCooperativeKernel((const void*)hymba_fwd, dim3(grid), dim3(512), args, LDS_BYTES, stream);
    if (e != hipSuccess) fprintf(stderr, "kernel_launch: cooperative launch failed: %s (grid %d)\n", hipGetErrorString(e), grid);
#endif
}
```

```cpp
#include <hip/hip_runtime.h>
#include <hip/hip_cooperative_groups.h>
#include <cstdio>
namespace cg = cooperative_groups;
namespace pg8 {
#define PG8_LAS __attribute__((address_space(3)))
typedef unsigned short bf16_t;
typedef short bf16x8 __attribute__((ext_vector_type(8)));
typedef float f32x4 __attribute__((ext_vector_type(4)));
typedef unsigned u32x4 __attribute__((ext_vector_type(4)));
constexpr int BM = 256, BK = 64, HALF = 128, HTB = HALF * BK * 2  , STAGE_BYTES = 8 * HTB, NXCD = 8, WGM = 8;

__host__ __device__ __forceinline__ int lds_byte(int r, int c) { const int st = (r >> 4) * 2 + (c >> 5), rr = r & 15, cc = c & 31, ob = rr * 64 + cc * 2; return st * 1024 + (ob ^ (((ob >> 9) & 1) << 5)); }
__host__ __device__ __forceinline__ void stage_rc(int b, int& R, int& C) { const int st = b / 1024, sb = b % 1024, swz = sb ^ (((sb >> 9) & 1) << 5); R = (st >> 1) * 16 + swz / 64; C = (st & 1) * 32 + (swz % 64) / 2; }
__host__ __device__ __forceinline__ int perm32(int rho) { const int n = rho >> 4, i = rho & 15; return 8 * (i >> 2) + 4 * n + (i & 3); }

struct Unit { int pm, pn; };
struct Gemm { const bf16_t* A; const bf16_t* Bt; int M, N, K; };

struct StaticOrder {
    int nM, nN, nwg, G, c;
    __host__ __device__ void init(int M, int N, int G_, int c_) { nM = M / BM; nN = N / BM; nwg = nM * nN; G = G_; c = c_; }
    __host__ __device__ bool next(int i, Unit& u) const {
        const long L = (long)i * G + c; if (L >= nwg) return false;
        int wgid = (int)L; { const int q = nwg / NXCD, r = nwg % NXCD, xcd = wgid % NXCD, off = wgid / NXCD; wgid = (xcd < r ? xcd * (q + 1) : r * (q + 1) + (xcd - r) * q) + off; }
        const int nig = WGM * nN, gid = wgid / nig, fm = gid * WGM, gsz = (nM - fm) < WGM ? (nM - fm) : WGM;
        u.pm = fm + ((wgid % nig) % gsz); u.pn = (wgid % nig) / gsz; return true;
    }
    __device__ __forceinline__ void a_ready(const Unit&) const {}
    __device__ __forceinline__ void done(const Unit&) const {}
};
__device__ __forceinline__ unsigned cvt_pk_bf16(float lo, float hi) { unsigned r; asm volatile("v_cvt_pk_bf16_f32 %0, %1, %2" : "=v"(r) : "v"(lo), "v"(hi)); return r; }
template <class Epi, class Sched, bool STAMP = false>
__device__ __forceinline__ void gemm_phase(PG8_LAS unsigned char* lds, const Gemm g, const Sched& S, const Epi& E, unsigned long long* stamps) {
    int tid_l = threadIdx.x; asm volatile("" : "+v"(tid_l));
    const int tid = tid_l, wid = __builtin_amdgcn_readfirstlane(tid >> 6), lane = tid & 63, wr = wid >> 2, wc = wid & 3, fr = lane & 15, fq = lane >> 4;
    const int K = g.K, nt = K / BK;
    int ts_lo = 0, ts_hi = 0, nts = 0; const unsigned long long rt_entry = STAMP ? (unsigned long long)wall_clock64() : 0ull;
#define PG8_STAMP() do { if (STAMP && wid == 0 && nts < 64) { const unsigned long long _c = (unsigned long long)clock64(); \
        ts_lo = (lane == nts) ? (int)(unsigned)_c : ts_lo; ts_hi = (lane == nts) ? (int)(unsigned)(_c >> 32) : ts_hi; ++nts; } } while (0)
    PG8_STAMP();
    unsigned voffA[2], voffB[2];
#pragma unroll
    for (int i = 0; i < 2; ++i) { int R, C; stage_rc(tid * 16 + i * 8192, R, C); const int Rb = Epi::PERM ? ((R & ~31) + perm32(R & 31)) : R;
        voffA[i] = (unsigned)(R * K + C) * 2u; voffB[i] = (unsigned)(Rb * K + C) * 2u; }
    const size_t kstep = (size_t)(BK * 2);
    const size_t hstep = (size_t)HALF * K * 2;
    const size_t tstep = 2 * hstep;
    const unsigned ldsw = (unsigned)wid * 1024u;
    const int aoff = lds_byte(wr * 64 + fr, fq * 8), boff = lds_byte(wc * 32 + fr, fq * 8);
#define PG8_SA(b, h) (((b) * 2 + (h)) * HTB)
#define PG8_SB(b, h) ((4 + (b) * 2 + (h)) * HTB)
#define PG8_STAGE(bufoff, gbase, voff) do { _Pragma("unroll") for (int _i = 0; _i < 2; ++_i) \
        __builtin_amdgcn_global_load_lds((const unsigned*)((const char*)(gbase) + (voff)[_i]), (PG8_LAS unsigned*)(lds + (bufoff) + ldsw + _i * 8192), 16, 0, 0); } while (0)
#define PG8_LDA(dst, b, h) do { _Pragma("unroll") for (int m = 0; m < 4; ++m) _Pragma("unroll") for (int k = 0; k < 2; ++k) dst[m][k] = *(const PG8_LAS bf16x8*)(lds + PG8_SA(b, h) + aoff + m * 2048 + k * 1024); } while (0)
#define PG8_LDB(dst, b, h) do { _Pragma("unroll") for (int n = 0; n < 2; ++n) _Pragma("unroll") for (int k = 0; k < 2; ++k) dst[n][k] = *(const PG8_LAS bf16x8*)(lds + PG8_SB(b, h) + boff + n * 2048 + k * 1024); } while (0)
#define PG8_MMA(ai, bj, At, Bt) do { __builtin_amdgcn_s_setprio(1); _Pragma("unroll") for (int m = 0; m < 4; ++m) _Pragma("unroll") for (int n = 0; n < 2; ++n) _Pragma("unroll") for (int k = 0; k < 2; ++k) \
        acc[ai][bj][m][n] = __builtin_amdgcn_mfma_f32_16x16x32_bf16(Bt[n][k], At[m][k], acc[ai][bj][m][n], 0, 0, 0); __builtin_amdgcn_s_setprio(0); } while (0)
#define PG8_WAIT_V(n) asm volatile("s_waitcnt vmcnt(" #n ")" ::: "memory")
#define PG8_WAIT_L(n) asm volatile("s_waitcnt lgkmcnt(" #n ")" ::: "memory")
#define PG8_BAR __builtin_amdgcn_s_barrier()
#define PG8_SCHED __builtin_amdgcn_sched_barrier(0)
    Unit cur, nxt; int ui = 0;
    if (!S.next(0, cur)) return;
    f32x4 acc[2][2][4][2];
#pragma unroll
    for (int a = 0; a < 2; ++a)
#pragma unroll
        for (int b = 0; b < 2; ++b)
#pragma unroll
            for (int m = 0; m < 4; ++m)
#pragma unroll
                for (int n = 0; n < 2; ++n) acc[a][b][m][n] = (f32x4){0.f, 0.f, 0.f, 0.f};
    bf16x8 At[4][2], B0[2][2], B1[2][2];
    const char* cA = (const char*)g.A + (size_t)cur.pm * tstep; const char* cB = (const char*)g.Bt + (size_t)cur.pn * tstep;
    S.a_ready(cur);
    PG8_STAGE(PG8_SB(0, 0), cB, voffB); PG8_STAGE(PG8_SA(0, 0), cA, voffA); PG8_STAGE(PG8_SB(0, 1), cB + hstep, voffB); PG8_STAGE(PG8_SA(0, 1), cA + hstep, voffA);
    if (wr == 1) PG8_BAR;
    PG8_WAIT_V(4); PG8_BAR;
    PG8_STAGE(PG8_SB(1, 0), cB + kstep, voffB); PG8_STAGE(PG8_SA(1, 0), cA + kstep, voffA); PG8_STAGE(PG8_SB(1, 1), cB + hstep + kstep, voffB);
    PG8_WAIT_V(6); PG8_BAR;
    PG8_STAMP();
    for (;;) {
        const bool has_next = S.next(ui + 1, nxt);
        const char* nA = has_next ? (const char*)g.A + (size_t)nxt.pm * tstep : cA; const char* nB = has_next ? (const char*)g.Bt + (size_t)nxt.pn * tstep : cB;
        for (int t = 0; t < nt; t += 2) {
            const bool last = (t == nt - 2);
            const char* a1 = cA + (size_t)(t + 1) * kstep;
            const char* a2 = last ? nA : cA + (size_t)(t + 2) * kstep; const char* b2 = last ? nB : cB + (size_t)(t + 2) * kstep;
            const char* a3 = a2 + kstep; const char* b3 = b2 + kstep;
            if (last && has_next) S.a_ready(nxt);
            PG8_LDB(B0, 0, 0); PG8_SCHED; PG8_LDA(At, 0, 0); PG8_STAGE(PG8_SA(1, 1), a1 + hstep, voffA);
            PG8_WAIT_L(8); PG8_BAR; PG8_WAIT_L(0); PG8_MMA(0, 0, At, B0); PG8_BAR; PG8_SCHED;
            PG8_LDB(B1, 0, 1); PG8_STAGE(PG8_SB(0, 0), b2, voffB);
            PG8_BAR; PG8_WAIT_L(0); PG8_MMA(0, 1, At, B1); PG8_BAR;
            PG8_LDA(At, 0, 1); PG8_STAGE(PG8_SA(0, 0), a2, voffA);
            PG8_BAR; PG8_WAIT_L(0); PG8_MMA(1, 0, At, B0); PG8_BAR; PG8_SCHED;
            PG8_STAGE(PG8_SB(0, 1), b2 + hstep, voffB);
            PG8_WAIT_V(6); PG8_BAR; PG8_MMA(1, 1, At, B1); PG8_BAR;
            PG8_LDB(B0, 1, 0); PG8_SCHED; PG8_LDA(At, 1, 0); PG8_STAGE(PG8_SA(0, 1), a2 + hstep, voffA);
            PG8_WAIT_L(8); PG8_BAR; PG8_WAIT_L(0); PG8_MMA(0, 0, At, B0); PG8_BAR; PG8_SCHED;
            PG8_LDB(B1, 1, 1); PG8_STAGE(PG8_SB(1, 0), b3, voffB);
            PG8_BAR; PG8_WAIT_L(0); PG8_MMA(0, 1, At, B1); PG8_BAR;
            PG8_LDA(At, 1, 1); PG8_STAGE(PG8_SA(1, 0), a3, voffA);
            PG8_BAR; PG8_WAIT_L(0); PG8_MMA(1, 0, At, B0); PG8_BAR; PG8_SCHED;
            PG8_STAGE(PG8_SB(1, 1), b3 + hstep, voffB);
            PG8_WAIT_V(6); PG8_BAR; PG8_MMA(1, 1, At, B1); PG8_BAR;
        }
        PG8_STAMP();
        if constexpr (!Epi::AFTER_DRAIN) { if (wr == 0) PG8_BAR; E(acc, cur, wr, wc, fr, fq); S.done(cur); if (has_next) { if (wr == 1) PG8_BAR; } }
        PG8_STAMP();
        if (!has_next) break;
#pragma unroll
        for (int a = 0; a < 2; ++a)
#pragma unroll
            for (int b = 0; b < 2; ++b)
#pragma unroll
                for (int m = 0; m < 4; ++m)
#pragma unroll
                    for (int n = 0; n < 2; ++n) acc[a][b][m][n] = (f32x4){0.f, 0.f, 0.f, 0.f};
        cur = nxt; cA = nA; cB = nB; ++ui;
    }
    PG8_WAIT_V(0);
    if constexpr (Epi::AFTER_DRAIN) { if (wr == 0) PG8_BAR; }
    PG8_BAR;
    if constexpr (Epi::AFTER_DRAIN) { E.fused(acc, cur, wr, wc, fr, fq, lds, wid, lane); S.done(cur); }
    PG8_STAMP();
    if (STAMP && wid == 0) { stamps[lane] = lane < nts ? (((unsigned long long)(unsigned)ts_hi << 32) | (unsigned)ts_lo) : 0ull;
        if (lane == 62) stamps[62] = rt_entry; if (lane == 63) stamps[63] = (unsigned long long)wall_clock64(); }
#undef PG8_STAMP
#undef PG8_SA
#undef PG8_SB
#undef PG8_STAGE
#undef PG8_LDA
#undef PG8_LDB
#undef PG8_MMA
#undef PG8_WAIT_V
#undef PG8_WAIT_L
#undef PG8_BAR
#undef PG8_SCHED
}
}

#define LAS __attribute__((address_space(3)))
#define GAS __attribute__((address_space(1)))
typedef unsigned short bf16_t;
typedef short bf16x8 __attribute__((ext_vector_type(8)));
typedef float f32x4 __attribute__((ext_vector_type(4)));
typedef float f32x2 __attribute__((ext_vector_type(2)));
typedef float f32x16 __attribute__((ext_vector_type(16)));
typedef unsigned u32x4 __attribute__((ext_vector_type(4)));
typedef unsigned u32x2 __attribute__((ext_vector_type(2)));

constexpr int DM = 2048, NBATCH = 4, SEQ = 4096, MROWS = NBATCH * SEQ, NMETA = 16, DIN = 6144, DLRU = 1024, NHEAD = 16;
constexpr int META0 = MROWS;
constexpr int RSTR = MROWS + 64;
constexpr float RMS_EPS = 1e-6f;
constexpr int NPHASE = 7;
#ifndef REP_MASK
#define REP_MASK 0
#endif
constexpr int LDS_BYTES = 131072 + 256;

constexpr size_t MiB = 1u << 20;
constexpr size_t WS_WTIN = 0;
constexpr size_t WS_WTOUT = 48 * MiB;
constexpr size_t WS_GW = 64 * MiB;
constexpr size_t WS_ROWSS = 65 * MiB;
constexpr size_t WS_BAR = 65 * MiB + 512 * 1024;
constexpr size_t WS_PCNT = WS_BAR + 16384;
constexpr size_t WS_AGG = 66 * MiB;
constexpr size_t WS_XB = 71 * MiB;
constexpr size_t WS_Y = 136 * MiB;
constexpr size_t WS_U = 201 * MiB;
constexpr size_t WS_END = 396 * MiB;
constexpr int AGG_PER_LAYER = 257 * 1024;
static_assert(WS_U + (size_t)RSTR * DIN * 2 <= WS_END && WS_Y + (size_t)RSTR * DM * 2 <= WS_U && WS_XB + (size_t)RSTR * DM * 2 <= WS_Y, "ws map");
static_assert(WS_WTIN + (size_t)2 * DIN * DM * 2 <= WS_WTOUT && WS_WTOUT + (size_t)2 * DM * DM * 2 <= WS_GW && WS_AGG + (size_t)2 * AGG_PER_LAYER * 8 <= WS_XB && WS_ROWSS + (size_t)3 * RSTR * 4 <= WS_BAR, "ws map 2");

struct Args { const float* in[14]; float* out; unsigned char* ws; int ph_lo, ph_hi, flags, pad; };

__device__ __forceinline__ unsigned f2bf(float f) { unsigned u = __builtin_bit_cast(unsigned, f); return (u + 0x7fffu + ((u >> 16) & 1u)) >> 16; }
__device__ __forceinline__ unsigned pk2(float lo, float hi) { return f2bf(lo) | (f2bf(hi) << 16); }
__device__ __forceinline__ float bflo(unsigned w) { return __builtin_bit_cast(float, w << 16); }
__device__ __forceinline__ float bfhi(unsigned w) { return __builtin_bit_cast(float, w & 0xffff0000u); }
__device__ __forceinline__ float bf1(bf16_t v) { return __builtin_bit_cast(float, ((unsigned)v) << 16); }
__device__ __forceinline__ float sigmoidf_(float z) { return __builtin_amdgcn_rcpf(1.0f + __expf(-z)); }
__device__ __forceinline__ float wave_sum(float v) {
#pragma unroll
    for (int o = 1; o < 64; o <<= 1) v += __shfl_xor(v, o);
    return v;
}
#define LDS_WAIT() asm volatile("s_waitcnt lgkmcnt(0)" ::: "memory")

template <bool NORS> struct EpiUT {
    static constexpr bool PERM = true, AFTER_DRAIN = false;
    bf16_t* O; const float* rowss;
    __device__ __forceinline__ void operator()(const f32x4 (&acc)[2][2][4][2], const pg8::Unit& u, int wr, int wc, int fr, int fq) const {
        const int row0 = u.pm * 256 + wr * 64 + fr, col0 = u.pn * 256 + wc * 32 + 8 * fq;
        if (u.pn >= 8) {
            const int ch0 = 64 * (u.pn - 8) + 16 * wc + 4 * fq;
#pragma unroll
            for (int ai = 0; ai < 2; ++ai)
#pragma unroll
                for (int m = 0; m < 4; ++m) {
                    const int r = row0 + ai * 128 + m * 16;
                    const float rs = NORS ? 1.0f : rsqrtf(rowss[r] * (1.0f / DM) + RMS_EPS);
                    const f32x4 bv = acc[ai][0][m][0] * rs, cv = acc[ai][0][m][1] * rs, xv = acc[ai][1][m][0] * rs, gv = acc[ai][1][m][1] * rs;
                    u32x4 w;
#pragma unroll
                    for (int i = 0; i < 4; ++i) w[i] = pg8::cvt_pk_bf16(bv[i] * gv[i] * sigmoidf_(gv[i]), cv[i] * xv[i]);
                    *(u32x4*)(O + (size_t)r * DIN + 2048 + 2 * ch0) = w;
                }
            return;
        }
#pragma unroll
        for (int ai = 0; ai < 2; ++ai)
#pragma unroll
            for (int m = 0; m < 4; ++m) {
                const int r = row0 + ai * 128 + m * 16;
                const float rs = NORS ? 1.0f : rsqrtf(rowss[r] * (1.0f / DM) + RMS_EPS);
                bf16_t* rowp = O + (size_t)r * DIN + col0;
#pragma unroll
                for (int bj = 0; bj < 2; ++bj) {
                    const f32x4 v0 = acc[ai][bj][m][0] * rs, v1 = acc[ai][bj][m][1] * rs;
                    u32x4 w; w.x = pg8::cvt_pk_bf16(v0[0], v0[1]); w.y = pg8::cvt_pk_bf16(v0[2], v0[3]); w.z = pg8::cvt_pk_bf16(v1[0], v1[1]); w.w = pg8::cvt_pk_bf16(v1[2], v1[3]);
                    *(u32x4*)(rowp + bj * 128) = w;
                }
            }
    }
};
struct EpiNull {
    static constexpr bool PERM = true, AFTER_DRAIN = false;
    float* sink;
    __device__ __forceinline__ void operator()(const f32x4 (&acc)[2][2][4][2], const pg8::Unit& u, int wr, int wc, int fr, int fq) const {
        f32x4 s = {0.f, 0.f, 0.f, 0.f};
#pragma unroll
        for (int ai = 0; ai < 2; ++ai)
#pragma unroll
            for (int bj = 0; bj < 2; ++bj)
#pragma unroll
                for (int m = 0; m < 4; ++m) { s += acc[ai][bj][m][0]; s += acc[ai][bj][m][1]; }
        if (s[0] + s[1] + s[2] + s[3] == 1.2345678e33f) sink[u.pm] = s[0];
    }
};
typedef EpiUT<false> EpiU;
#ifndef EPI_MB
#define EPI_MB 2
#endif
struct EpiRes {
    static constexpr bool PERM = true, AFTER_DRAIN = false;
    const float* res; float* out; bf16_t* xb; float* rowss;
    __device__ __forceinline__ void operator()(const f32x4 (&acc)[2][2][4][2], const pg8::Unit& u, int wr, int wc, int fr, int fq) const {
        const int row0 = u.pm * 256 + wr * 64 + fr, col0 = u.pn * 256 + wc * 32 + 8 * fq;
#pragma unroll
        for (int ai = 0; ai < 2; ++ai) {
#pragma unroll
          for (int mh = 0; mh < 4; mh += EPI_MB) {
            f32x4 rv[4][2][2];
#pragma unroll
            for (int m = mh; m < mh + EPI_MB; ++m)
#pragma unroll
                for (int bj = 0; bj < 2; ++bj) { const float* p = res + (size_t)(row0 + ai * 128 + m * 16) * DM + col0 + bj * 128; rv[m][bj][0] = *(const f32x4*)p; rv[m][bj][1] = *(const f32x4*)(p + 4); }
            asm volatile("" ::: "memory");
#pragma unroll
            for (int m = mh; m < mh + EPI_MB; ++m) {
                const int r = row0 + ai * 128 + m * 16; const size_t off = (size_t)r * DM + col0; float ss = 0.f;
#pragma unroll
                for (int bj = 0; bj < 2; ++bj) {
                    const f32x4 h0 = rv[m][bj][0] + acc[ai][bj][m][0], h1 = rv[m][bj][1] + acc[ai][bj][m][1];
                    if (out) { *(f32x4*)(out + off + bj * 128) = h0; *(f32x4*)(out + off + bj * 128 + 4) = h1; }
                    if (xb) { u32x4 w; w.x = pg8::cvt_pk_bf16(h0[0], h0[1]); w.y = pg8::cvt_pk_bf16(h0[2], h0[3]); w.z = pg8::cvt_pk_bf16(h1[0], h1[1]); w.w = pg8::cvt_pk_bf16(h1[2], h1[3]);
                        *(u32x4*)(xb + off + bj * 128) = w; }
                    ss += (h0[0] * h0[0] + h0[1] * h0[1]) + (h0[2] * h0[2] + h0[3] * h0[3]) + (h1[0] * h1[0] + h1[1] * h1[1]) + (h1[2] * h1[2] + h1[3] * h1[3]);
                }
                ss += __shfl_xor(ss, 16); ss += __shfl_xor(ss, 32);
                if (fq == 0) unsafeAtomicAdd(rowss + r, ss);
            }
            asm volatile("" ::: "memory");
          }
        }
    }
};

struct EpiResNorm {
    static constexpr bool PERM = true, AFTER_DRAIN = false;
    const bf16_t* res; float* out; float* rowss; unsigned* cnt; const float* fg;
    __device__ __forceinline__ void operator()(f32x4 (&acc)[2][2][4][2], const pg8::Unit& u, int wr, int wc, int fr, int fq) const {
        const int row0 = u.pm * 256 + wr * 64 + fr, col0 = u.pn * 256 + wc * 32 + 8 * fq;
#pragma unroll
        for (int ai = 0; ai < 2; ++ai) {
#pragma unroll
          for (int mh = 0; mh < 4; mh += EPI_MB) {
            u32x4 rw[4][2];
#pragma unroll
            for (int m = mh; m < mh + EPI_MB; ++m)
#pragma unroll
                for (int bj = 0; bj < 2; ++bj) rw[m][bj] = *(const u32x4*)(res + (size_t)(row0 + ai * 128 + m * 16) * DM + col0 + bj * 128);
            asm volatile("" ::: "memory");
#pragma unroll
            for (int m = mh; m < mh + EPI_MB; ++m) {
                float ss = 0.f;
#pragma unroll
                for (int bj = 0; bj < 2; ++bj) {
                    const u32x4 w = rw[m][bj];
                    const f32x4 h0 = (f32x4){bflo(w.x), bfhi(w.x), bflo(w.y), bfhi(w.y)} + acc[ai][bj][m][0], h1 = (f32x4){bflo(w.z), bfhi(w.z), bflo(w.w), bfhi(w.w)} + acc[ai][bj][m][1];
                    acc[ai][bj][m][0] = h0; acc[ai][bj][m][1] = h1;
                    ss += (h0[0] * h0[0] + h0[1] * h0[1]) + (h0[2] * h0[2] + h0[3] * h0[3]) + (h1[0] * h1[0] + h1[1] * h1[1]) + (h1[2] * h1[2] + h1[3] * h1[3]);
                }
                ss += __shfl_xor(ss, 16); ss += __shfl_xor(ss, 32);
                if (fq == 0) unsafeAtomicAdd(rowss + row0 + ai * 128 + m * 16, ss);
            }
            asm volatile("" ::: "memory");
          }
        }
        asm volatile("s_waitcnt vmcnt(0)" ::: "memory");
        unsigned* cw = cnt + 64 * (2 * u.pm + wr);
        if (fr == 0 && fq == 0) __hip_atomic_fetch_add(cw, 1u, __ATOMIC_RELAXED, __HIP_MEMORY_SCOPE_AGENT);
        f32x4 gv[2][2];
#pragma unroll
        for (int bj = 0; bj < 2; ++bj) { gv[bj][0] = *(const f32x4*)(fg + col0 + bj * 128); gv[bj][1] = *(const f32x4*)(fg + col0 + bj * 128 + 4); }
        { unsigned sp = 0;
          while ((unsigned)__builtin_amdgcn_readfirstlane(__hip_atomic_load(cw, __ATOMIC_RELAXED, __HIP_MEMORY_SCOPE_AGENT)) < 32u) { __builtin_amdgcn_s_sleep(1); if (++sp > (1u << 16)) break; } }
        asm volatile("" ::: "memory");
#pragma unroll
        for (int ai = 0; ai < 2; ++ai)
#pragma unroll
            for (int m = 0; m < 4; ++m) {
                const int r = row0 + ai * 128 + m * 16;
                const float rs = rsqrtf(__hip_atomic_load(rowss + r, __ATOMIC_RELAXED, __HIP_MEMORY_SCOPE_AGENT) * (1.0f / DM) + RMS_EPS);
                float* op = out + (size_t)r * DM + col0;
#pragma unroll
                for (int bj = 0; bj < 2; ++bj) { *(f32x4*)(op + bj * 128) = acc[ai][bj][m][0] * rs * gv[bj][0]; *(f32x4*)(op + bj * 128 + 4) = acc[ai][bj][m][1] * rs * gv[bj][1]; }
            }
    }
};
struct PanelOrder {
    int Gp, v;
    __device__ void init(int G, int c) { Gp = G & ~7; v = c; if ((Gp & 63) == 0) v = (c & 7) * (Gp >> 3) + (c >> 3); if (c >= Gp) v = -1; }
    __device__ bool next(int i, pg8::Unit& u) const { if (v < 0) return false; const long L = (long)i * Gp + v; if (L >= 64 * 8) return false; u.pm = (int)(L >> 3); u.pn = (int)(L & 7); return true; }
    __device__ __forceinline__ void a_ready(const pg8::Unit&) const {}
    __device__ __forceinline__ void done(const pg8::Unit&) const {}
};

template <class F> __device__ __forceinline__ void meta_gemm(const bf16_t* A, const bf16_t* Bt, int ngroups, LAS unsigned char* lds, int wid, int lane, F epi) {
    const int fr = lane & 15, fq = lane >> 4, half = wid >> 2, wq = wid & 3;
    LAS f32x4* red = (LAS f32x4*)lds;
    for (int p = blockIdx.x; 2 * p < ngroups; p += gridDim.x) {
        const int g = 2 * p + half;
        f32x4 acc = {0.f, 0.f, 0.f, 0.f};
        if (g < ngroups) {
            const bf16_t* ap = A + (size_t)fr * DM + wq * 512 + fq * 8;
            const bf16_t* bp = Bt + (size_t)(g * 16 + fr) * DM + wq * 512 + fq * 8;
            bf16x8 av[16], bv[16];
#pragma unroll
            for (int s = 0; s < 16; ++s) { av[s] = *(const bf16x8*)(ap + 32 * s); bv[s] = *(const bf16x8*)(bp + 32 * s); }
#pragma unroll
            for (int s = 0; s < 16; ++s) acc = __builtin_amdgcn_mfma_f32_16x16x32_bf16(bv[s], av[s], acc, 0, 0, 0);
        }
        red[wid * 64 + lane] = acc;
        __syncthreads();
        if (wq == 0 && g < ngroups) {
            f32x4 s = red[wid * 64 + lane];
#pragma unroll
            for (int w = 1; w < 4; ++w) s += red[(wid + w) * 64 + lane];
            epi(fr, g * 16 + 4 * fq, s);
        }
        __syncthreads();
    }
}

__host__ __device__ __forceinline__ int in_col(int p) {
    if (p < 2048) return p;
    const int c = p & 255, j = (p >> 8) - 8, g = 2 * (c >> 7) + ((c >> 2) & 1), k = 16 * ((c >> 5) & 3) + 4 * ((c >> 3) & 3) + (c & 3);
    return 2048 + 1024 * g + 64 * j + k;
}
template <bool COLMAP> __device__ __forceinline__ void tr_item(const float* W, int K, int N, bf16_t* WT, const float* sc, LAS unsigned char* scr, int item, int lane) {
    const int nblk = N / 64, kb = item / nblk, nb = item % nblk, k0 = 64 * kb, n0 = 64 * nb;
    const int kr = lane >> 4, nc = (lane & 15) * 4;
    f32x4 v[16]; float g[16];
    { const float* p = W + (size_t)(k0 + kr) * N + (COLMAP ? in_col(n0 + nc) : n0 + nc);
#pragma unroll
      for (int i = 0; i < 16; ++i) { v[i] = *(const f32x4*)p; p += (size_t)4 * N; }
#pragma unroll
      for (int i = 0; i < 16; ++i) g[i] = sc ? sc[k0 + kr + 4 * i] : 1.0f; }
    asm volatile("" ::: "memory");
#pragma unroll
    for (int i = 0; i < 16; ++i) { const f32x4 s = v[i] * g[i]; u32x2 w; w.x = pg8::cvt_pk_bf16(s[0], s[1]); w.y = pg8::cvt_pk_bf16(s[2], s[3]);
        *(LAS u32x2*)(scr + (kr + 4 * i) * 136 + nc * 2) = w; }
    LDS_WAIT();
    const int c = lane & 7;
#pragma unroll
    for (int j = 0; j < 8; ++j) { const int n = (lane >> 3) + 8 * j; const LAS bf16_t* s = (const LAS bf16_t*)(scr + (8 * c) * 136 + n * 2);
        u32x4 o; o.x = (unsigned)s[0] | ((unsigned)s[68] << 16); o.y = (unsigned)s[2 * 68] | ((unsigned)s[3 * 68] << 16); o.z = (unsigned)s[4 * 68] | ((unsigned)s[5 * 68] << 16); o.w = (unsigned)s[6 * 68] | ((unsigned)s[7 * 68] << 16);
        *(u32x4*)(WT + (size_t)(n0 + n) * K + k0 + 8 * c) = o; }
    LDS_WAIT();
}
__device__ __forceinline__ void cvt_row(const float* src, bf16_t* dst, float* ss, int lane) {
    const f32x4* xr = (const f32x4*)src + lane; f32x4 v[8]; float s = 0.f;
#pragma unroll
    for (int j = 0; j < 8; ++j) { v[j] = xr[64 * j]; s += (v[j].x * v[j].x + v[j].y * v[j].y) + (v[j].z * v[j].z + v[j].w * v[j].w); }
    s = wave_sum(s);
    u32x2* o8 = (u32x2*)dst + lane;
#pragma unroll
    for (int j = 0; j < 8; ++j) { u32x2 w; w.x = pk2(v[j].x, v[j].y); w.y = pk2(v[j].z, v[j].w); o8[64 * j] = w; }
    if (lane == 0) *ss = s;
}

struct Mix {
    const float *conv_a_w, *conv_a_b, *lru_br, *lru_bi, *lru_lambda, *conv_b_w;
    const bf16_t* gw;
    bf16_t* U; bf16_t* Y; unsigned long long* AGG;
};
struct ItemId { int hd, b, c, row0, ntok, agg; bool meta; };
__device__ __forceinline__ ItemId decode_item(int id) {
    ItemId I;
    if (id < 16) { I.meta = true; I.hd = id; I.b = 0; I.c = 0; I.row0 = META0; I.ntok = 16; I.agg = 256; }
    else { const int j = id - 16; I.meta = false; I.hd = j & 15; I.c = (j >> 4) & 63; I.b = j >> 10; I.row0 = I.b * SEQ + I.c * 64; I.ntok = 64; I.agg = I.b * 64 + I.c; }
    return I;
}
constexpr int N_ITEMS = 16 + NBATCH * NHEAD * 64;

__device__ __forceinline__ bool agg_ok(unsigned long long v) { return (unsigned)v != 0u; }
template <bool META> __device__ __forceinline__ void mix_item(const Mix& X, int id, LAS unsigned char* xt, int lane) {
    constexpr int NT = META ? 16 : 64, NTB = META ? 1 : 2, NQ = META ? 2 : 4;
    constexpr float LOG2E = 1.4426950408889634f;
    const ItemId I = decode_item(id);
    const int ch = I.hd * 64 + lane;
    const float nls2 = -8.0f * LOG2E * log1pf(__expf(-X.lru_lambda[ch]));
    bf16_t raw[NT], rh0 = 0, rh1 = 0, rh2 = 0;
    const float w0 = X.conv_a_w[ch], w1 = X.conv_a_w[1024 + ch], w2 = X.conv_a_w[2048 + ch], w3 = X.conv_a_w[3072 + ch], cb = X.conv_a_b[ch];
    {
        const GAS bf16_t* sb = (const GAS bf16_t*)(X.U + (size_t)I.row0 * DIN + I.hd * 64);
        if (!META) { const GAS bf16_t* hp0 = (I.c == 0) ? (const GAS bf16_t*)(X.U + (size_t)(META0 + 13) * DIN + I.hd * 64) : sb - 3 * DIN; rh0 = hp0[lane]; rh1 = hp0[DIN + lane]; rh2 = hp0[2 * DIN + lane]; }
#pragma unroll
        for (int t = 0; t < NT; ++t) { raw[t] = sb[lane]; sb += DIN; asm volatile("" : "+s"(sb)); }
    }
    bf16x8 BfR0[4], BfR1[4], BfI0[4], BfI1[4];
    { const bf16_t* gr = X.gw + (size_t)(I.hd * 64 + (lane & 31)) * 64 + 8 * (lane >> 5); const bf16_t* gi = gr + 16 * 64 * 64;
#pragma unroll
      for (int s = 0; s < 4; ++s) { BfR0[s] = *(const bf16x8*)(gr + 16 * s); BfR1[s] = *(const bf16x8*)(gr + 32 * 64 + 16 * s); BfI0[s] = *(const bf16x8*)(gi + 16 * s); BfI1[s] = *(const bf16x8*)(gi + 32 * 64 + 16 * s); } }
    asm volatile("" ::: "memory");
    float xm3 = bf1(rh0), xm2 = bf1(rh1), xm1 = bf1(rh2);
#pragma unroll
    for (int t = 0; t < NT; ++t) { const float x0 = bf1(raw[t]); const float xc = cb + w0 * xm3 + w1 * xm2 + w2 * xm1 + w3 * x0; xm3 = xm2; xm2 = xm1; xm1 = x0;
        *(LAS bf16_t*)(xt + t * 144 + lane * 2) = (bf16_t)f2bf(xc); }
    const float brA = X.lru_br[I.hd * 64 + (lane & 31)], brB = X.lru_br[I.hd * 64 + 32 + (lane & 31)], biA = X.lru_bi[I.hd * 64 + (lane & 31)], biB = X.lru_bi[I.hd * 64 + 32 + (lane & 31)];
    float h = 0.f, P = 1.f;
    unsigned hp[NT];
#pragma unroll
    for (int tb = 0; tb < NTB; ++tb) {
        f32x16 aR0, aR1, aI0, aI1;
#pragma unroll
        for (int e = 0; e < 16; ++e) { aR0[e] = brA; aR1[e] = brB; aI0[e] = biA; aI1[e] = biB; }
#pragma unroll
        for (int s = 0; s < 4; ++s) {
            const bf16x8 af = *(const LAS bf16x8*)(xt + (tb * 32 + (lane & 31)) * 144 + (16 * s + 8 * (lane >> 5)) * 2);
            aR0 = __builtin_amdgcn_mfma_f32_32x32x16_bf16(af, BfR0[s], aR0, 0, 0, 0);
            aR1 = __builtin_amdgcn_mfma_f32_32x32x16_bf16(af, BfR1[s], aR1, 0, 0, 0);
            aI0 = __builtin_amdgcn_mfma_f32_32x32x16_bf16(af, BfI0[s], aI0, 0, 0, 0);
            aI1 = __builtin_amdgcn_mfma_f32_32x32x16_bf16(af, BfI1[s], aI1, 0, 0, 0);
        }
#pragma unroll
        for (int q = 0; q < NQ; ++q) {
            float Rv[2][4], Iv[2][4];
#pragma unroll
            for (int k = 0; k < 4; ++k) {
                const int reg = 4 * q + k;
                const float r0f = aR0[reg], r1f = aR1[reg], i0f = aI0[reg], i1f = aI1[reg];
                auto r = __builtin_amdgcn_permlane32_swap(__float_as_uint(r0f), __float_as_uint(r1f), false, false);
                Rv[0][k] = __uint_as_float(r[0]); Rv[1][k] = __uint_as_float(r[1]);
                auto i2 = __builtin_amdgcn_permlane32_swap(__float_as_uint(i0f), __float_as_uint(i1f), false, false);
                Iv[0][k] = __uint_as_float(i2[0]); Iv[1][k] = __uint_as_float(i2[1]);
            }
#pragma unroll
            for (int st = 0; st < 2; ++st)
#pragma unroll
                for (int p = 0; p < 2; ++p) {
                    const int t = tb * 32 + 8 * q + 4 * st + 2 * p;
                    f32x2 er = (f32x2){Rv[st][2 * p], Rv[st][2 * p + 1]} * (-LOG2E), ei = (f32x2){Iv[st][2 * p], Iv[st][2 * p + 1]} * (-LOG2E);
                    er.x = __builtin_amdgcn_exp2f(er.x); er.y = __builtin_amdgcn_exp2f(er.y); ei.x = __builtin_amdgcn_exp2f(ei.x); ei.y = __builtin_amdgcn_exp2f(ei.y);
                    er = er + 1.0f; ei = ei + 1.0f;
                    f32x2 rg, ig; rg.x = __builtin_amdgcn_rcpf(er.x); rg.y = __builtin_amdgcn_rcpf(er.y); ig.x = __builtin_amdgcn_rcpf(ei.x); ig.y = __builtin_amdgcn_rcpf(ei.y);
                    const f32x2 l2 = rg * nls2;
                    f32x2 a; a.x = __builtin_amdgcn_exp2f(l2.x); a.y = __builtin_amdgcn_exp2f(l2.y);
                    f32x2 om = 1.0f - a * a; om.x = fmaxf(om.x, 0.f); om.y = fmaxf(om.y, 0.f);
                    f32x2 mu; mu.x = __builtin_amdgcn_sqrtf(om.x); mu.y = __builtin_amdgcn_sqrtf(om.y);
                    const f32x2 xc = (f32x2){bf1(*(const LAS bf16_t*)(xt + t * 144 + lane * 2)), bf1(*(const LAS bf16_t*)(xt + (t + 1) * 144 + lane * 2))};
                    const f32x2 bb = mu * ig * xc;
                    h = a.x * h + bb.x; P = P * a.x; hp[t] = pg8::cvt_pk_bf16(h, P);
                    h = a.y * h + bb.y; P = P * a.y; hp[t + 1] = pg8::cvt_pk_bf16(h, P);
                }
        }
    }
    __hip_atomic_store(X.AGG + (size_t)I.agg * 1024 + ch, ((unsigned long long)__float_as_uint(h) << 32) | (unsigned long long)__float_as_uint(P), __ATOMIC_RELAXED, __HIP_MEMORY_SCOPE_AGENT);
    asm volatile("" ::: "memory");
    bf16_t graw[NT];
    { const GAS bf16_t* sb = (const GAS bf16_t*)(X.U + (size_t)I.row0 * DIN + 1024 + I.hd * 64);
#pragma unroll
      for (int t = 0; t < NT; ++t) { graw[t] = sb[lane]; sb += DIN; asm volatile("" : "+s"(sb)); } }
    float hin = 0.f;
    if (!META) {
        { const unsigned long long* mp = X.AGG + (size_t)256 * 1024 + ch; unsigned long long v;
          for (;;) { v = __hip_atomic_load(mp, __ATOMIC_RELAXED, __HIP_MEMORY_SCOPE_AGENT); if (!__any(!agg_ok(v))) break; __builtin_amdgcn_s_sleep(2); }
          hin = __uint_as_float((unsigned)(v >> 32)); }
        const unsigned long long* ap = X.AGG + (size_t)(I.b * 64) * 1024 + ch;
        for (int j0 = 0; j0 < I.c; j0 += 16) {
            unsigned long long v[16];
            for (;;) {
                bool bad = false;
#pragma unroll
                for (int k = 0; k < 16; ++k) { v[k] = (j0 + k < I.c) ? __hip_atomic_load(ap + (size_t)(j0 + k) * 1024, __ATOMIC_RELAXED, __HIP_MEMORY_SCOPE_AGENT) : 0x000000003f800000ull; }
#pragma unroll
                for (int k = 0; k < 16; ++k) bad |= !agg_ok(v[k]);
                if (!__any(bad)) break;
                __builtin_amdgcn_s_sleep(2);
            }
#pragma unroll
            for (int k = 0; k < 16; ++k) hin = __uint_as_float((unsigned)v[k]) * hin + __uint_as_float((unsigned)(v[k] >> 32));
        }
    }
    asm volatile("" ::: "memory");
    GAS bf16_t* yp = (GAS bf16_t*)(X.Y + (size_t)I.row0 * DM + I.hd * 64);
#pragma unroll
    for (int t0 = 0; t0 < NT; t0 += 16) {
        {
#pragma unroll
            for (int k = 0; k < 16; k += 2) {
                const unsigned w0 = hp[t0 + k], w1 = hp[t0 + k + 1];
                const f32x2 gg = (f32x2){bf1(graw[t0 + k]), bf1(graw[t0 + k + 1])};
                f32x2 e = gg * (-LOG2E); e.x = __builtin_amdgcn_exp2f(e.x); e.y = __builtin_amdgcn_exp2f(e.y); e = e + 1.0f;
                f32x2 sg; sg.x = __builtin_amdgcn_rcpf(e.x); sg.y = __builtin_amdgcn_rcpf(e.y);
                const f32x2 hv = (f32x2){bflo(w0), bflo(w1)} + (f32x2){bfhi(w0), bfhi(w1)} * hin;
                const f32x2 y = hv * gg * sg;
                const unsigned pk = pg8::cvt_pk_bf16(y.x, y.y);
                yp[lane] = (bf16_t)(pk & 0xffffu); yp[DM + lane] = (bf16_t)(pk >> 16); yp += 2 * DM; asm volatile("" : "+s"(yp));
            }
        }
    }
}

__device__ __forceinline__ void ld8(const bf16_t* p, float (&o)[8]) {
    const u32x4 w = *(const u32x4*)p;
    o[0] = bflo(w.x); o[1] = bfhi(w.x); o[2] = bflo(w.y); o[3] = bfhi(w.y); o[4] = bflo(w.z); o[5] = bfhi(w.z); o[6] = bflo(w.w); o[7] = bfhi(w.w);
}
__device__ __forceinline__ void partb(const Mix& X, int tid) {
    for (int it = blockIdx.x * 512 + tid; it < 1025 * 128; it += gridDim.x * 512) {
        const int c0 = (it & 127) * 8, run = it >> 7;
        float w0[8], w1[8], w2[8], cm2[8], cm1[8];
        { const f32x4* p = (const f32x4*)(X.conv_b_w + c0); const f32x4 a0 = p[0], a1 = p[1], b0 = p[256], b1 = p[257], d0 = p[512], d1 = p[513];
#pragma unroll
          for (int e = 0; e < 4; ++e) { w0[e] = a0[e]; w0[4 + e] = a1[e]; w1[e] = b0[e]; w1[4 + e] = b1[e]; w2[e] = d0[e]; w2[4 + e] = d1[e]; } }
        if (run == 1024) {
#pragma unroll
            for (int e = 0; e < 8; ++e) { cm2[e] = 0.f; cm1[e] = 0.f; }
            const bf16_t* up = X.U + (size_t)META0 * DIN + c0; bf16_t* yp = X.Y + (size_t)META0 * DM + 1024 + c0;
#pragma unroll 4
            for (int t = 0; t < 16; ++t) {
                float bv[8], cv[8], xv[8], gv[8];
                ld8(up + (size_t)t * DIN + 2048, bv); ld8(up + (size_t)t * DIN + 3072, cv); ld8(up + (size_t)t * DIN + 4096, xv); ld8(up + (size_t)t * DIN + 5120, gv);
                float o[8];
#pragma unroll
                for (int e = 0; e < 8; ++e) { const float cx = cv[e] * xv[e]; const float y = w0[e] * cm2[e] + w1[e] * cm1[e] + w2[e] * cx; o[e] = bv[e] * y * (gv[e] * sigmoidf_(gv[e])); cm2[e] = cm1[e]; cm1[e] = cx; }
                u32x4 w; w.x = pk2(o[0], o[1]); w.y = pk2(o[2], o[3]); w.z = pk2(o[4], o[5]); w.w = pk2(o[6], o[7]);
                *(u32x4*)(yp + (size_t)t * DM) = w;
            }
            continue;
        }
        const int row0 = run * 16;
        if ((row0 & (SEQ - 1)) == 0) {
            float c[8], x[8];
            ld8(X.U + (size_t)(META0 + 14) * DIN + 3072 + c0, c); ld8(X.U + (size_t)(META0 + 14) * DIN + 4096 + c0, x);
#pragma unroll
            for (int e = 0; e < 8; ++e) cm2[e] = c[e] * x[e];
            ld8(X.U + (size_t)(META0 + 15) * DIN + 3072 + c0, c); ld8(X.U + (size_t)(META0 + 15) * DIN + 4096 + c0, x);
#pragma unroll
            for (int e = 0; e < 8; ++e) cm1[e] = c[e] * x[e];
        } else {
            const u32x4* p2 = (const u32x4*)(X.U + (size_t)(row0 - 2) * DIN + 2048 + 2 * c0); const u32x4* p1 = (const u32x4*)(X.U + (size_t)(row0 - 1) * DIN + 2048 + 2 * c0);
            const u32x4 a0 = p2[0], a1 = p2[1], b0 = p1[0], b1 = p1[1];
#pragma unroll
            for (int e = 0; e < 4; ++e) { cm2[e] = bfhi(a0[e]); cm2[4 + e] = bfhi(a1[e]); cm1[e] = bfhi(b0[e]); cm1[4 + e] = bfhi(b1[e]); }
        }
        const bf16_t* vp = X.U + (size_t)row0 * DIN + 2048 + 2 * c0;
        bf16_t* yp = X.Y + (size_t)row0 * DM + 1024 + c0;
#pragma unroll 8
        for (int t = 0; t < 16; ++t) {
            const u32x4 q0 = *(const u32x4*)(vp + (size_t)t * DIN), q1 = *(const u32x4*)(vp + (size_t)t * DIN + 8);
            float o[8];
#pragma unroll
            for (int e = 0; e < 8; ++e) { const unsigned q = e < 4 ? q0[e & 3] : q1[e & 3]; const float bg = bflo(q), cx = bfhi(q);
                o[e] = bg * (w0[e] * cm2[e] + w1[e] * cm1[e] + w2[e] * cx); cm2[e] = cm1[e]; cm1[e] = cx; }
            u32x4 w; w.x = pk2(o[0], o[1]); w.y = pk2(o[2], o[3]); w.z = pk2(o[4], o[5]); w.w = pk2(o[6], o[7]);
            *(u32x4*)(yp + (size_t)t * DM) = w;
        }
    }
}


#ifdef DEBUG_NAIVE_MIX
__global__ void __launch_bounds__(64) naive_mixA(Mix X, const float* wr, const float* wi) {
    const int b = blockIdx.x / 16, hd = blockIdx.x % 16, lane = threadIdx.x, ch = hd * 64 + lane;
    __shared__ float xs[64];
    const float w0 = X.conv_a_w[ch], w1 = X.conv_a_w[1024 + ch], w2 = X.conv_a_w[2048 + ch], w3 = X.conv_a_w[3072 + ch], cb = X.conv_a_b[ch];
    const float br = X.lru_br[ch], bi = X.lru_bi[ch];
    const float sp = log1pf(expf(-X.lru_lambda[ch]));
    const float* wrh = wr + (size_t)hd * 4096 + lane; const float* wih = wi + (size_t)hd * 4096 + lane;
    float h = 0.f, xm3 = 0.f, xm2 = 0.f, xm1 = 0.f;
    for (int p = 0; p < NMETA + SEQ; ++p) {
        const int row = p < NMETA ? META0 + p : b * SEQ + (p - NMETA);
        const float x0 = bf1(X.U[(size_t)row * DIN + ch]);
        const float xc = cb + w0 * xm3 + w1 * xm2 + w2 * xm1 + w3 * x0; xm3 = xm2; xm2 = xm1; xm1 = x0;
        xs[lane] = xc; __syncthreads();
        float rp = br, ip = bi;
#pragma unroll 4
        for (int i = 0; i < 64; ++i) { rp += xs[i] * wrh[i * 64]; ip += xs[i] * wih[i * 64]; }
        __syncthreads();
        const float r = 1.f / (1.f + expf(-rp)), ig = 1.f / (1.f + expf(-ip));
        const float la = -8.f * r * sp; const float a = expf(la); const float bb = sqrtf(-expm1f(2.f * la)) * (ig * xc);
        h = a * h + bb;
        const float g = bf1(X.U[(size_t)row * DIN + 1024 + ch]);
        const float y = h * g / (1.f + expf(-g));
        if (p >= NMETA || b == 0) X.Y[(size_t)row * DM + ch] = (bf16_t)f2bf(y);
    }
}
__global__ void naive_mixB(Mix X) {
    for (size_t idx = (size_t)blockIdx.x * blockDim.x + threadIdx.x; idx < (size_t)(MROWS + NMETA) * 1024; idx += (size_t)gridDim.x * blockDim.x) {
        const int row = (int)(idx >> 10), c = (int)(idx & 1023);
        int r1, r2;
        if (row >= META0) { const int p = row - META0; r1 = p >= 1 ? row - 1 : -1; r2 = p >= 2 ? row - 2 : -1; }
        else { const int t = row & (SEQ - 1); r1 = t >= 1 ? row - 1 : META0 + 15; r2 = t >= 2 ? row - 2 : META0 + 14 + t; }
        auto cx = [&](int r) -> float { return r < 0 ? 0.f : bf1(X.U[(size_t)r * DIN + 3072 + c]) * bf1(X.U[(size_t)r * DIN + 4096 + c]); };
        const float y = X.conv_b_w[c] * cx(r2) + X.conv_b_w[1024 + c] * cx(r1) + X.conv_b_w[2048 + c] * cx(row);
        const float bv = bf1(X.U[(size_t)row * DIN + 2048 + c]), g = bf1(X.U[(size_t)row * DIN + 5120 + c]);
        X.Y[(size_t)row * DM + 1024 + c] = (bf16_t)f2bf(bv * y * g / (1.f + expf(-g)));
    }
}
#endif
#define XB_TMO      128
#define XB_XCNT(j)  (256  + 64 * (j))
#define XB_XSUB(j)  (1280 + 64 * (j))
#define XB_XGEN(j)  (2304 + 64 * (j))
#define XB_TOP      3328
#define XB_TOPGEN   3392
#define XCD_BAR_WORDS 3456
#define XB_SPIN_CAP (1u << 18)

__device__ __forceinline__ unsigned xb_ld(unsigned* p)              { return __hip_atomic_load(p, __ATOMIC_RELAXED, __HIP_MEMORY_SCOPE_AGENT); }
__device__ __forceinline__ unsigned xb_add(unsigned* p, unsigned v) { return __hip_atomic_fetch_add(p, v, __ATOMIC_RELAXED, __HIP_MEMORY_SCOPE_AGENT); }
__device__ __forceinline__ unsigned xb_xcc_id() { return (unsigned)__builtin_amdgcn_s_getreg((3 << 11) | 20) & 0xFu; }
#define XB_SPIN(cond, bar) do { unsigned _sp = 0; while (cond) { __builtin_amdgcn_s_sleep(1); \
    if ((++_sp & 255u) == 0u) { if (xb_ld(&(bar)[XB_TMO])) break; if (_sp > XB_SPIN_CAP) { atomicAdd(&(bar)[XB_TMO], 1u); break; } } } } while (0)

struct XcdBarrier {
    unsigned* bar; unsigned x;
    volatile LAS unsigned* st;
};

__device__ __forceinline__ XcdBarrier xcd_barrier_post(unsigned* bar, volatile LAS unsigned* st) {
    XcdBarrier b; b.bar = bar; b.x = xb_xcc_id(); b.st = st;
    if (threadIdx.x == 0) (void)xb_add(&bar[XB_XCNT(b.x)], 1u);
    return b;
}
__device__ __forceinline__ void xcd_barrier_complete(unsigned* bar, unsigned x, unsigned& nloc, unsigned& nx) {
    const unsigned G = gridDim.x * gridDim.y * gridDim.z;
    unsigned sum, cnt, mine, sp = 0u;
    for (;;) {
        sum = 0u; cnt = 0u; mine = 0u;
#pragma unroll
        for (unsigned j = 0; j < 16; ++j) { const unsigned c = xb_ld(&bar[XB_XCNT(j)]); sum += c; cnt += (c > 0u) ? 1u : 0u; mine = (j == x) ? c : mine; }
        if (sum == G) break;
        __builtin_amdgcn_s_sleep(1);
        if ((++sp & 255u) == 0u) { if (xb_ld(&bar[XB_TMO])) break; if (sp > XB_SPIN_CAP) { atomicAdd(&bar[XB_TMO], 1u); break; } }
    }
    nloc = mine > 0u ? mine : 1u; nx = cnt > 0u ? cnt : 1u;
}

__device__ __forceinline__ void xcd_barrier(const XcdBarrier& b) {
    asm volatile("s_waitcnt vmcnt(0)" ::: "memory");
    __syncthreads();
    if (threadIdx.x == 0) {
        unsigned* bar = b.bar;
        __builtin_amdgcn_s_waitcnt(0);
        unsigned nloc = b.st[0], nx = b.st[1];
        if (nloc == 0u) { xcd_barrier_complete(bar, b.x, nloc, nx); b.st[0] = nloc; b.st[1] = nx; }
        const unsigned old = xb_add(&bar[XB_XSUB(b.x)], 1u);
        const unsigned gen = old / nloc;
        if (old + 1u == (gen + 1u) * nloc) {
            __builtin_amdgcn_fence(__ATOMIC_RELEASE, "agent");
            asm volatile("s_waitcnt vmcnt(0)" ::: "memory");
            const unsigned og = xb_add(&bar[XB_TOP], 1u);
            const unsigned tg = og / nx;
            if (og + 1u == (tg + 1u) * nx) xb_add(&bar[XB_TOPGEN], 1u);
            else XB_SPIN(xb_ld(&bar[XB_TOPGEN]) == tg, bar);
            __builtin_amdgcn_fence(__ATOMIC_ACQUIRE, "agent");
            xb_add(&bar[XB_XGEN(b.x)], 1u);
            asm volatile("s_waitcnt vmcnt(0)" ::: "memory");
        } else {
            XB_SPIN(xb_ld(&bar[XB_XGEN(b.x)]) == gen, bar);
            __builtin_amdgcn_fence(__ATOMIC_ACQUIRE, "agent");
            asm volatile("s_waitcnt vmcnt(0)" ::: "memory");
        }
    }
    __syncthreads();
}

__global__ void __launch_bounds__(512, 2) hymba_fwd(Args a) {
    extern __shared__ __attribute__((aligned(16))) unsigned char lds_raw[];
    LAS unsigned char* lds = (LAS unsigned char*)lds_raw;
    cg::grid_group grid = cg::this_grid();
    const int NGW = gridDim.x * 8;
    if (threadIdx.x < 64) ((LAS unsigned*)(lds + 131072))[threadIdx.x] = 0u;
    __syncthreads();
    XcdBarrier xbar; xbar.bar = (unsigned*)(a.ws + WS_BAR); xbar.x = 0; xbar.st = nullptr;
    if (a.ph_hi - a.ph_lo > 1) xbar = xcd_barrier_post((unsigned*)(a.ws + WS_BAR), (volatile LAS unsigned*)(lds + 131072));
    if (a.ph_lo < 0) grid.sync();
#define LAUNDER() int tid = threadIdx.x; asm volatile("" : "+v"(tid)); const int wid = __builtin_amdgcn_readfirstlane(tid >> 6), lane = tid & 63, gw = blockIdx.x * 8 + wid
    const int lo = a.ph_lo, hi = a.ph_hi;
#define IN(k) (lo <= (k) && (k) < hi)
#ifndef STAGGER_N
#define STAGGER_N 0
#endif
#define STAGGER() do { if (STAGGER_N) for (int _k = 0; _k < (int)(blockIdx.x & 7); ++_k) __builtin_amdgcn_s_sleep(STAGGER_N); } while (0)
#define SEAM(k) do { if (IN(k) && IN((k) + 1)) { xcd_barrier(xbar); if ((REP_MASK >> 10) & 1) { xcd_barrier(xbar); xcd_barrier(xbar); } } } while (0)
    const float* x = a.in[0]; const float* meta = a.in[1]; const float* norm_g = a.in[2]; const float* w_in = a.in[3];
    const float* conv_a_w = a.in[4]; const float* conv_a_b = a.in[5]; const float* lru_wr = a.in[6]; const float* lru_br = a.in[7];
    const float* lru_wi = a.in[8]; const float* lru_bi = a.in[9]; const float* lru_lambda = a.in[10]; const float* conv_b_w = a.in[11];
    const float* w_out = a.in[12]; const float* final_g = a.in[13];
    unsigned char* ws = a.ws;
    bf16_t* WTIN = (bf16_t*)(ws + WS_WTIN); bf16_t* WTOUT = (bf16_t*)(ws + WS_WTOUT); bf16_t* GW = (bf16_t*)(ws + WS_GW);
    float* ROWSS = (float*)(ws + WS_ROWSS); unsigned long long* AGG = (unsigned long long*)(ws + WS_AGG);
    bf16_t* XB = (bf16_t*)(ws + WS_XB); bf16_t* Y = (bf16_t*)(ws + WS_Y); bf16_t* U = (bf16_t*)(ws + WS_U);

    if (IN(0)) for (int rep = 0; rep <= ((REP_MASK >> 0) & 1); ++rep) {
        LAUNDER();
        LAS unsigned char* scr = lds + wid * 16384;
        constexpr int I_IN = (DM / 64) * (DIN / 64), I_OUT = (DM / 64) * (DM / 64);
        constexpr int NIT = 2 * I_IN + 2 * I_OUT + 64;
        for (int it = gw; it < NIT; it += NGW) {
            int r = it;
            if (r < 2 * I_IN) { const int l = r / I_IN; tr_item<true>(w_in + (size_t)l * DM * DIN, DM, DIN, WTIN + (size_t)l * DIN * DM, norm_g + l * DM, scr, r % I_IN, lane); continue; } r -= 2 * I_IN;
            if (r < 2 * I_OUT) { const int l = r / I_OUT; tr_item<false>(w_out + (size_t)l * DM * DM, DM, DM, WTOUT + (size_t)l * DM * DM, nullptr, scr, r % I_OUT, lane); continue; } r -= 2 * I_OUT;
            { const int mtx = r, l = mtx >> 5, g = (mtx >> 4) & 1, hd = mtx & 15;
              const float* src = (g ? lru_wi : lru_wr) + (size_t)(l * 16 + hd) * 4096;
              tr_item<false>(src, 64, 64, GW + (size_t)mtx * 4096, nullptr, scr, 0, lane); }
        }
        for (int m = gw; m < MROWS + NMETA; m += NGW) {
            const float* src = m < MROWS ? x + (size_t)m * DM : meta + (size_t)(m - MROWS) * DM;
            cvt_row(src, XB + (size_t)m * DM, ROWSS + m, lane);
        }
        for (int i = blockIdx.x * 512 + tid; i < 2 * RSTR; i += gridDim.x * 512) ROWSS[RSTR + i] = 0.f;
        for (int i = blockIdx.x * 512 + tid; i < AGG_PER_LAYER; i += gridDim.x * 512) ((u32x4*)AGG)[i] = (u32x4){0u, 0u, 0u, 0u};
    }
    SEAM(0);

#pragma unroll 1
    for (int l = 0; l < 2; ++l) {
        const int pb = 1 + 3 * l;
        const bf16_t* wtin = WTIN + (size_t)l * DIN * DM; const bf16_t* wtout = WTOUT + (size_t)l * DM * DM;
        float* rss_in = ROWSS + (size_t)l * RSTR; float* rss_out = ROWSS + (size_t)(l + 1) * RSTR;
        Mix X; X.conv_a_w = conv_a_w + l * 4 * DLRU; X.conv_a_b = conv_a_b + l * DLRU; X.lru_br = lru_br + l * DLRU; X.lru_bi = lru_bi + l * DLRU; X.lru_lambda = lru_lambda + l * DLRU;
        X.conv_b_w = conv_b_w + l * 3 * DLRU; X.gw = GW + (size_t)l * 2 * 16 * 4096; X.U = U; X.Y = Y; X.AGG = AGG + (size_t)l * AGG_PER_LAYER;

        if (IN(pb)) for (int rep = 0; rep <= ((REP_MASK >> pb) & 1); ++rep) {
            LAUNDER();
            STAGGER();
            for (int mrep = 0; mrep <= ((REP_MASK >> 16) & 1); ++mrep)
            meta_gemm(XB + (size_t)META0 * DM, wtin, DIN / 16, lds, wid, lane, [&](int m, int n0, f32x4 s) {
                const float rs = rsqrtf(rss_in[META0 + m] * (1.0f / DM) + RMS_EPS);
                u32x2 w; w.x = pk2(s[0] * rs, s[1] * rs); w.y = pk2(s[2] * rs, s[3] * rs);
                *(u32x2*)(U + (size_t)(META0 + m) * DIN + in_col(n0)) = w; });
            pg8::Gemm g{XB, wtin, MROWS, DIN, DM}; pg8::StaticOrder S; S.init(MROWS, DIN, (int)gridDim.x, (int)blockIdx.x);
            if ((REP_MASK >> 17) & 1) { EpiUT<true> En{U, rss_in}; pg8::gemm_phase<EpiUT<true>, pg8::StaticOrder, false>(lds, g, S, En, nullptr); }
            if ((REP_MASK >> 15) & 1) { EpiNull En{ROWSS + (size_t)3 * RSTR}; pg8::gemm_phase<EpiNull, pg8::StaticOrder, false>(lds, g, S, En, nullptr); }
            EpiU E{U, rss_in};
            pg8::gemm_phase<EpiU, pg8::StaticOrder, false>(lds, g, S, E, nullptr);
        }
        SEAM(pb);
        if (IN(pb + 1)) for (int rep = 0; rep <= ((REP_MASK >> (pb + 1)) & 1); ++rep) {
            LAUNDER();
#pragma unroll 1
            for (int step = 0; step < 2; ++step) {
                if ((step == 0) == (wid < 4)) {
                    if (rep == 1 && ((REP_MASK >> 13) & 1)) continue;
#pragma unroll 1
                    for (int id = gw; id < N_ITEMS; id += NGW) { if (id < 16) mix_item<true>(X, id, lds + wid * 9216, lane); else mix_item<false>(X, id, lds + wid * 9216, lane); }
                } else { if (rep == 1 && ((REP_MASK >> 12) & 1)) continue; partb(X, tid); }
            }
        }
        SEAM(pb + 1);
        if (IN(pb + 2)) {
            LAUNDER();
            STAGGER();
            if (l == 0) {
                meta_gemm(Y + (size_t)META0 * DM, wtout, DM / 16, lds, wid, lane, [&](int m, int n0, f32x4 s) {
                    const f32x4 r = *(const f32x4*)(meta + (size_t)m * DM + n0); const f32x4 hh = r + s;
                    u32x2 w; w.x = pk2(hh[0], hh[1]); w.y = pk2(hh[2], hh[3]);
                    *(u32x2*)(XB + (size_t)(META0 + m) * DM + n0) = w;
                    unsafeAtomicAdd(rss_out + META0 + m, (hh[0] * hh[0] + hh[1] * hh[1]) + (hh[2] * hh[2] + hh[3] * hh[3])); });
            }
            pg8::Gemm g{Y, wtout, MROWS, DM, DM};
            if (l == 0) {
                pg8::StaticOrder S; S.init(MROWS, DM, (int)gridDim.x, (int)blockIdx.x);
                if ((REP_MASK >> 11) & 1) { EpiU Ed{U, rss_in}; pg8::gemm_phase<EpiU, pg8::StaticOrder, false>(lds, g, S, Ed, nullptr); }
                if ((REP_MASK >> 14) & 1) { EpiRes Ed{x, nullptr, XB, ROWSS + (size_t)3 * RSTR}; pg8::gemm_phase<EpiRes, pg8::StaticOrder, false>(lds, g, S, Ed, nullptr); }
                EpiRes E{x, nullptr, XB, rss_out};
                pg8::gemm_phase<EpiRes, pg8::StaticOrder, false>(lds, g, S, E, nullptr);
            } else {
                PanelOrder S; S.init((int)gridDim.x, (int)blockIdx.x);
                EpiResNorm E{XB, a.out, rss_out, (unsigned*)(ws + WS_PCNT), final_g};
                pg8::gemm_phase<EpiResNorm, PanelOrder, false>(lds, g, S, E, nullptr);
            }
        }
        SEAM(pb + 2);
    }

#undef IN
#undef SEAM
}

#ifndef MK_LAUNCH_PER_PHASE
#define MK_LAUNCH_PER_PHASE 0
#endif
extern "C" void kernel_launch(void* const* d_in, const int* in_sizes, int n_in, void* d_out, int out_size, void* d_ws, size_t ws_size, hipStream_t stream) {
    static int grid = 0;
    if (grid == 0) {
        if (n_in != 14 || in_sizes[0] != MROWS * DM || out_size != MROWS * DM || ws_size < WS_END) { fprintf(stderr, "kernel_launch: unexpected shapes (n_in %d, in0 %d, out %d, ws %zu)\n", n_in, n_in > 0 ? in_sizes[0] : -1, out_size, ws_size); grid = -1; return; }
        int dev = 0, cus = 0, per_cu = 0;
        hipGetDevice(&dev); hipDeviceGetAttribute(&cus, hipDeviceAttributeMultiprocessorCount, dev);
        if (hipFuncSetAttribute((const void*)hymba_fwd, hipFuncAttributeMaxDynamicSharedMemorySize, LDS_BYTES) != hipSuccess) { fprintf(stderr, "kernel_launch: hipFuncSetAttribute failed\n"); grid = -1; return; }
        if (hipOccupancyMaxActiveBlocksPerMultiprocessor(&per_cu, (const void*)hymba_fwd, 512, LDS_BYTES) != hipSuccess || per_cu < 1) { fprintf(stderr, "kernel_launch: occupancy query gave %d\n", per_cu); per_cu = 1; }
        (void)hipGetLastError();
        grid = cus * per_cu;
    }
    if (grid < 0) return;
    Args a{};
    for (int i = 0; i < 14; ++i) a.in[i] = (const float*)d_in[i];
    a.out = (float*)d_out; a.ws = (unsigned char*)d_ws;
#if MK_LAUNCH_PER_PHASE
    for (int p = 0; p < NPHASE; ++p) {
#ifdef DEBUG_NAIVE_MIX
        if (p == 2 || p == 6) { const int l = p / 4; unsigned char* ws = (unsigned char*)d_ws;
            Mix X; X.conv_a_w = a.in[4] + l * 4 * DLRU; X.conv_a_b = a.in[5] + l * DLRU; X.lru_br = a.in[7] + l * DLRU; X.lru_bi = a.in[9] + l * DLRU; X.lru_lambda = a.in[10] + l * DLRU;
            X.conv_b_w = a.in[11] + l * 3 * DLRU; X.gw = nullptr; X.U = (bf16_t*)(ws + WS_U); X.Y = (bf16_t*)(ws + WS_Y); X.HP = nullptr; X.AGG = nullptr;
#if DEBUG_NAIVE_MIX == 1
            hipLaunchKernelGGL(naive_mixA, dim3(64), dim3(64), 0, stream, X, a.in[6] + (size_t)l * 16 * 4096, a.in[8] + (size_t)l * 16 * 4096);
            a.flags = 1;
#else
            hipLaunchKernelGGL(naive_mixB, dim3(2048), dim3(256), 0, stream, X);
            a.flags = 2;
#endif
            }
        else a.flags = 0;
#if DEBUG_NAIVE_MIX == 1
        if (p == 3 || p == 7) continue;
#endif
#endif
        a.ph_lo = p; a.ph_hi = p + 1; hipLaunchKernelGGL(hymba_fwd, dim3(grid), dim3(512), LDS_BYTES, stream, a); }
#else
    a.ph_lo = 0; a.ph_hi = NPHASE;
    if (hipMemsetAsync((unsigned char*)d_ws + WS_BAR, 0, 16384 + 32768, stream) != hipSuccess) { fprintf(stderr, "kernel_launch: memset of barrier words failed\n"); return; }
    void* args[] = {&a};
    const hipError_t e = hipLaunchCooperativeKernel((const void*)hymba_fwd, dim3(grid), dim3(512), args, LDS_BYTES, stream);
    if (e != hipSuccess) fprintf(stderr, "kernel_launch: cooperative launch failed: %s (grid %d)\n", hipGetErrorString(e), grid);
#endif
}
```

```cpp
#include <hip/hip_runtime.h>
#include <hip/hip_cooperative_groups.h>
#include <cstdio>
namespace cg = cooperative_groups;
namespace pg8 {
#define PG8_LAS __attribute__((address_space(3)))
typedef unsigned short bf16_t;
typedef short bf16x8 __attribute__((ext_vector_type(8)));
typedef float f32x4 __attribute__((ext_vector_type(4)));
typedef unsigned u32x4 __attribute__((ext_vector_type(4)));
constexpr int BM = 256, BK = 64, HALF = 128, HTB = HALF * BK * 2  , STAGE_BYTES = 8 * HTB, NXCD = 8, WGM = 8;

__host__ __device__ __forceinline__ int lds_byte(int r, int c) { const int st = (r >> 4) * 2 + (c >> 5), rr = r & 15, cc = c & 31, ob = rr * 64 + cc * 2; return st * 1024 + (ob ^ (((ob >> 9) & 1) << 5)); }
__host__ __device__ __forceinline__ void stage_rc(int b, int& R, int& C) { const int st = b / 1024, sb = b % 1024, swz = sb ^ (((sb >> 9) & 1) << 5); R = (st >> 1) * 16 + swz / 64; C = (st & 1) * 32 + (swz % 64) / 2; }
__host__ __device__ __forceinline__ int perm32(int rho) { const int n = rho >> 4, i = rho & 15; return 8 * (i >> 2) + 4 * n + (i & 3); }

struct Unit { int pm, pn; };
struct Gemm { const bf16_t* A; const bf16_t* Bt; int M, N, K; };

struct StaticOrder {
    int nM, nN, nwg, G, c;
    __host__ __device__ void init(int M, int N, int G_, int c_) { nM = M / BM; nN = N / BM; nwg = nM * nN; G = G_; c = c_; }
    __host__ __device__ bool next(int i, Unit& u) const {
        const long L = (long)i * G + c; if (L >= nwg) return false;
        int wgid = (int)L; { const int q = nwg / NXCD, r = nwg % NXCD, xcd = wgid % NXCD, off = wgid / NXCD; wgid = (xcd < r ? xcd * (q + 1) : r * (q + 1) + (xcd - r) * q) + off; }
        const int nig = WGM * nN, gid = wgid / nig, fm = gid * WGM, gsz = (nM - fm) < WGM ? (nM - fm) : WGM;
        u.pm = fm + ((wgid % nig) % gsz); u.pn = (wgid % nig) / gsz; return true;
    }
    __device__ __forceinline__ void a_ready(const Unit&) const {}
    __device__ __forceinline__ void done(const Unit&) const {}
};
__device__ __forceinline__ unsigned cvt_pk_bf16(float lo, float hi) { unsigned r; asm volatile("v_cvt_pk_bf16_f32 %0, %1, %2" : "=v"(r) : "v"(lo), "v"(hi)); return r; }
template <class Epi, class Sched, bool STAMP = false>
__device__ __forceinline__ void gemm_phase(PG8_LAS unsigned char* lds, const Gemm g, const Sched& S, const Epi& E, unsigned long long* stamps) {
    int tid_l = threadIdx.x; asm volatile("" : "+v"(tid_l));
    const int tid = tid_l, wid = __builtin_amdgcn_readfirstlane(tid >> 6), lane = tid & 63, wr = wid >> 2, wc = wid & 3, fr = lane & 15, fq = lane >> 4;
    const int K = g.K, nt = K / BK;
    int ts_lo = 0, ts_hi = 0, nts = 0; const unsigned long long rt_entry = STAMP ? (unsigned long long)wall_clock64() : 0ull;
#define PG8_STAMP() do { if (STAMP && wid == 0 && nts < 64) { const unsigned long long _c = (unsigned long long)clock64(); \
        ts_lo = (lane == nts) ? (int)(unsigned)_c : ts_lo; ts_hi = (lane == nts) ? (int)(unsigned)(_c >> 32) : ts_hi; ++nts; } } while (0)
    PG8_STAMP();
    unsigned voffA[2], voffB[2];
#pragma unroll
    for (int i = 0; i < 2; ++i) { int R, C; stage_rc(tid * 16 + i * 8192, R, C); const int Rb = Epi::PERM ? ((R & ~31) + perm32(R & 31)) : R;
        voffA[i] = (unsigned)(R * K + C) * 2u; voffB[i] = (unsigned)(Rb * K + C) * 2u; }
    const size_t kstep = (size_t)(BK * 2);
    const size_t hstep = (size_t)HALF * K * 2;
    const size_t tstep = 2 * hstep;
    const unsigned ldsw = (unsigned)wid * 1024u;
    const int aoff = lds_byte(wr * 64 + fr, fq * 8), boff = lds_byte(wc * 32 + fr, fq * 8);
#define PG8_SA(b, h) (((b) * 2 + (h)) * HTB)
#define PG8_SB(b, h) ((4 + (b) * 2 + (h)) * HTB)
#define PG8_STAGE(bufoff, gbase, voff) do { _Pragma("unroll") for (int _i = 0; _i < 2; ++_i) \
        __builtin_amdgcn_global_load_lds((const unsigned*)((const char*)(gbase) + (voff)[_i]), (PG8_LAS unsigned*)(lds + (bufoff) + ldsw + _i * 8192), 16, 0, 0); } while (0)
#define PG8_LDA(dst, b, h) do { _Pragma("unroll") for (int m = 0; m < 4; ++m) _Pragma("unroll") for (int k = 0; k < 2; ++k) dst[m][k] = *(const PG8_LAS bf16x8*)(lds + PG8_SA(b, h) + aoff + m * 2048 + k * 1024); } while (0)
#define PG8_LDB(dst, b, h) do { _Pragma("unroll") for (int n = 0; n < 2; ++n) _Pragma("unroll") for (int k = 0; k < 2; ++k) dst[n][k] = *(const PG8_LAS bf16x8*)(lds + PG8_SB(b, h) + boff + n * 2048 + k * 1024); } while (0)
#define PG8_MMA(ai, bj, At, Bt) do { __builtin_amdgcn_s_setprio(1); _Pragma("unroll") for (int m = 0; m < 4; ++m) _Pragma("unroll") for (int n = 0; n < 2; ++n) _Pragma("unroll") for (int k = 0; k < 2; ++k) \
        acc[ai][bj][m][n] = __builtin_amdgcn_mfma_f32_16x16x32_bf16(Bt[n][k], At[m][k], acc[ai][bj][m][n], 0, 0, 0); __builtin_amdgcn_s_setprio(0); } while (0)
#define PG8_WAIT_V(n) asm volatile("s_waitcnt vmcnt(" #n ")" ::: "memory")
#define PG8_WAIT_L(n) asm volatile("s_waitcnt lgkmcnt(" #n ")" ::: "memory")
#define PG8_BAR __builtin_amdgcn_s_barrier()
#define PG8_SCHED __builtin_amdgcn_sched_barrier(0)
    Unit cur, nxt; int ui = 0;
    if (!S.next(0, cur)) return;
    f32x4 acc[2][2][4][2];
#pragma unroll
    for (int a = 0; a < 2; ++a)
#pragma unroll
        for (int b = 0; b < 2; ++b)
#pragma unroll
            for (int m = 0; m < 4; ++m)
#pragma unroll
                for (int n = 0; n < 2; ++n) acc[a][b][m][n] = (f32x4){0.f, 0.f, 0.f, 0.f};
    bf16x8 At[4][2], B0[2][2], B1[2][2];
    const char* cA = (const char*)g.A + (size_t)cur.pm * tstep; const char* cB = (const char*)g.Bt + (size_t)cur.pn * tstep;
    S.a_ready(cur);
    PG8_STAGE(PG8_SB(0, 0), cB, voffB); PG8_STAGE(PG8_SA(0, 0), cA, voffA); PG8_STAGE(PG8_SB(0, 1), cB + hstep, voffB); PG8_STAGE(PG8_SA(0, 1), cA + hstep, voffA);
    if (wr == 1) PG8_BAR;
    PG8_WAIT_V(4); PG8_BAR;
    PG8_STAGE(PG8_SB(1, 0), cB + kstep, voffB); PG8_STAGE(PG8_SA(1, 0), cA + kstep, voffA); PG8_STAGE(PG8_SB(1, 1), cB + hstep + kstep, voffB);
    PG8_WAIT_V(6); PG8_BAR;
    PG8_STAMP();
    for (;;) {
        const bool has_next = S.next(ui + 1, nxt);
        const char* nA = has_next ? (const char*)g.A + (size_t)nxt.pm * tstep : cA; const char* nB = has_next ? (const char*)g.Bt + (size_t)nxt.pn * tstep : cB;
        for (int t = 0; t < nt; t += 2) {
            const bool last = (t == nt - 2);
            const char* a1 = cA + (size_t)(t + 1) * kstep;
            const char* a2 = last ? nA : cA + (size_t)(t + 2) * kstep; const char* b2 = last ? nB : cB + (size_t)(t + 2) * kstep;
            const char* a3 = a2 + kstep; const char* b3 = b2 + kstep;
            if (last && has_next) S.a_ready(nxt);
            PG8_LDB(B0, 0, 0); PG8_SCHED; PG8_LDA(At, 0, 0); PG8_STAGE(PG8_SA(1, 1), a1 + hstep, voffA);
            PG8_WAIT_L(8); PG8_BAR; PG8_WAIT_L(0); PG8_MMA(0, 0, At, B0); PG8_BAR; PG8_SCHED;
            PG8_LDB(B1, 0, 1); PG8_STAGE(PG8_SB(0, 0), b2, voffB);
            PG8_BAR; PG8_WAIT_L(0); PG8_MMA(0, 1, At, B1); PG8_BAR;
            PG8_LDA(At, 0, 1); PG8_STAGE(PG8_SA(0, 0), a2, voffA);
            PG8_BAR; PG8_WAIT_L(0); PG8_MMA(1, 0, At, B0); PG8_BAR; PG8_SCHED;
            PG8_STAGE(PG8_SB(0, 1), b2 + hstep, voffB);
            PG8_WAIT_V(6); PG8_BAR; PG8_MMA(1, 1, At, B1); PG8_BAR;
            PG8_LDB(B0, 1, 0); PG8_SCHED; PG8_LDA(At, 1, 0); PG8_STAGE(PG8_SA(0, 1), a2 + hstep, voffA);
            PG8_WAIT_L(8); PG8_BAR; PG8_WAIT_L(0); PG8_MMA(0, 0, At, B0); PG8_BAR; PG8_SCHED;
            PG8_LDB(B1, 1, 1); PG8_STAGE(PG8_SB(1, 0), b3, voffB);
            PG8_BAR; PG8_WAIT_L(0); PG8_MMA(0, 1, At, B1); PG8_BAR;
            PG8_LDA(At, 1, 1); PG8_STAGE(PG8_SA(1, 0), a3, voffA);
            PG8_BAR; PG8_WAIT_L(0); PG8_MMA(1, 0, At, B0); PG8_BAR; PG8_SCHED;
            PG8_STAGE(PG8_SB(1, 1), b3 + hstep, voffB);
            PG8_WAIT_V(6); PG8_BAR; PG8_MMA(1, 1, At, B1); PG8_BAR;
        }
        PG8_STAMP();
        if constexpr (!Epi::AFTER_DRAIN) { if (wr == 0) PG8_BAR; E(acc, cur, wr, wc, fr, fq); S.done(cur); if (has_next) { if (wr == 1) PG8_BAR; } }
        PG8_STAMP();
        if (!has_next) break;
#pragma unroll
        for (int a = 0; a < 2; ++a)
#pragma unroll
            for (int b = 0; b < 2; ++b)
#pragma unroll
                for (int m = 0; m < 4; ++m)
#pragma unroll
                    for (int n = 0; n < 2; ++n) acc[a][b][m][n] = (f32x4){0.f, 0.f, 0.f, 0.f};
        cur = nxt; cA = nA; cB = nB; ++ui;
    }
    PG8_WAIT_V(0);
    if constexpr (Epi::AFTER_DRAIN) { if (wr == 0) PG8_BAR; }
    PG8_BAR;
    if constexpr (Epi::AFTER_DRAIN) { E.fused(acc, cur, wr, wc, fr, fq, lds, wid, lane); S.done(cur); }
    PG8_STAMP();
    if (STAMP && wid == 0) { stamps[lane] = lane < nts ? (((unsigned long long)(unsigned)ts_hi << 32) | (unsigned)ts_lo) : 0ull;
        if (lane == 62) stamps[62] = rt_entry; if (lane == 63) stamps[63] = (unsigned long long)wall_clock64(); }
#undef PG8_STAMP
#undef PG8_SA
#undef PG8_SB
#undef PG8_STAGE
#undef PG8_LDA
#undef PG8_LDB
#undef PG8_MMA
#undef PG8_WAIT_V
#undef PG8_WAIT_L
#undef PG8_BAR
#undef PG8_SCHED
}
}

#define LAS __attribute__((address_space(3)))
#define GAS __attribute__((address_space(1)))
typedef unsigned short bf16_t;
typedef short bf16x8 __attribute__((ext_vector_type(8)));
typedef float f32x4 __attribute__((ext_vector_type(4)));
typedef float f32x2 __attribute__((ext_vector_type(2)));
typedef float f32x16 __attribute__((ext_vector_type(16)));
typedef unsigned u32x4 __attribute__((ext_vector_type(4)));
typedef unsigned u32x2 __attribute__((ext_vector_type(2)));

constexpr int DM = 2048, NBATCH = 4, SEQ = 4096, MROWS = NBATCH * SEQ, NMETA = 16, DIN = 6144, DLRU = 1024, NHEAD = 16;
constexpr int META0 = MROWS;
constexpr int RSTR = MROWS + 64;
constexpr float RMS_EPS = 1e-6f;
constexpr int NPHASE = 7;
#ifndef REP_MASK
#define REP_MASK 0
#endif
constexpr int LDS_BYTES = 131072 + 256;

constexpr size_t MiB = 1u << 20;
constexpr size_t WS_WTIN = 0;
constexpr size_t WS_WTOUT = 48 * MiB;
constexpr size_t WS_GW = 64 * MiB;
constexpr size_t WS_ROWSS = 65 * MiB;
constexpr size_t WS_BAR = 65 * MiB + 512 * 1024;
constexpr size_t WS_PCNT = WS_BAR + 16384;
constexpr size_t WS_AGG = 66 * MiB;
constexpr size_t WS_XB = 71 * MiB;
constexpr size_t WS_Y = 136 * MiB;
constexpr size_t WS_U = 201 * MiB;
constexpr size_t WS_END = 396 * MiB;
constexpr int AGG_PER_LAYER = 257 * 1024;
static_assert(WS_U + (size_t)RSTR * DIN * 2 <= WS_END && WS_Y + (size_t)RSTR * DM * 2 <= WS_U && WS_XB + (size_t)RSTR * DM * 2 <= WS_Y, "ws map");
static_assert(WS_WTIN + (size_t)2 * DIN * DM * 2 <= WS_WTOUT && WS_WTOUT + (size_t)2 * DM * DM * 2 <= WS_GW && WS_AGG + (size_t)2 * AGG_PER_LAYER * 8 <= WS_XB && WS_ROWSS + (size_t)3 * RSTR * 4 <= WS_BAR, "ws map 2");

struct Args { const float* in[14]; float* out; unsigned char* ws; int ph_lo, ph_hi, flags, pad; };

__device__ __forceinline__ unsigned f2bf(float f) { unsigned u = __builtin_bit_cast(unsigned, f); return (u + 0x7fffu + ((u >> 16) & 1u)) >> 16; }
__device__ __forceinline__ unsigned pk2(float lo, float hi) { return f2bf(lo) | (f2bf(hi) << 16); }
__device__ __forceinline__ float bflo(unsigned w) { return __builtin_bit_cast(float, w << 16); }
__device__ __forceinline__ float bfhi(unsigned w) { return __builtin_bit_cast(float, w & 0xffff0000u); }
__device__ __forceinline__ float bf1(bf16_t v) { return __builtin_bit_cast(float, ((unsigned)v) << 16); }
__device__ __forceinline__ float sigmoidf_(float z) { return __builtin_amdgcn_rcpf(1.0f + __expf(-z)); }
__device__ __forceinline__ float wave_sum(float v) {
#pragma unroll
    for (int o = 1; o < 64; o <<= 1) v += __shfl_xor(v, o);
    return v;
}
#define LDS_WAIT() asm volatile("s_waitcnt lgkmcnt(0)" ::: "memory")

template <bool NORS> struct EpiUT {
    static constexpr bool PERM = true, AFTER_DRAIN = false;
    bf16_t* O; const float* rowss;
    __device__ __forceinline__ void operator()(const f32x4 (&acc)[2][2][4][2], const pg8::Unit& u, int wr, int wc, int fr, int fq) const {
        const int row0 = u.pm * 256 + wr * 64 + fr, col0 = u.pn * 256 + wc * 32 + 8 * fq;
        if (u.pn >= 8) {
            const int ch0 = 64 * (u.pn - 8) + 16 * wc + 4 * fq;
#pragma unroll
            for (int ai = 0; ai < 2; ++ai)
#pragma unroll
                for (int m = 0; m < 4; ++m) {
                    const int r = row0 + ai * 128 + m * 16;
                    const float rs = NORS ? 1.0f : rsqrtf(rowss[r] * (1.0f / DM) + RMS_EPS);
                    const f32x4 bv = acc[ai][0][m][0] * rs, cv = acc[ai][0][m][1] * rs, xv = acc[ai][1][m][0] * rs, gv = acc[ai][1][m][1] * rs;
                    u32x4 w;
#pragma unroll
                    for (int i = 0; i < 4; ++i) w[i] = pg8::cvt_pk_bf16(bv[i] * gv[i] * sigmoidf_(gv[i]), cv[i] * xv[i]);
                    *(u32x4*)(O + (size_t)r * DIN + 2048 + 2 * ch0) = w;
                }
            return;
        }
#pragma unroll
        for (int ai = 0; ai < 2; ++ai)
#pragma unroll
            for (int m = 0; m < 4; ++m) {
                const int r = row0 + ai * 128 + m * 16;
                const float rs = NORS ? 1.0f : rsqrtf(rowss[r] * (1.0f / DM) + RMS_EPS);
                bf16_t* rowp = O + (size_t)r * DIN + col0;
#pragma unroll
                for (int bj = 0; bj < 2; ++bj) {
                    const f32x4 v0 = acc[ai][bj][m][0] * rs, v1 = acc[ai][bj][m][1] * rs;
                    u32x4 w; w.x = pg8::cvt_pk_bf16(v0[0], v0[1]); w.y = pg8::cvt_pk_bf16(v0[2], v0[3]); w.z = pg8::cvt_pk_bf16(v1[0], v1[1]); w.w = pg8::cvt_pk_bf16(v1[2], v1[3]);
                    *(u32x4*)(rowp + bj * 128) = w;
                }
            }
    }
};
struct EpiNull {
    static constexpr bool PERM = true, AFTER_DRAIN = false;
    float* sink;
    __device__ __forceinline__ void operator()(const f32x4 (&acc)[2][2][4][2], const pg8::Unit& u, int wr, int wc, int fr, int fq) const {
        f32x4 s = {0.f, 0.f, 0.f, 0.f};
#pragma unroll
        for (int ai = 0; ai < 2; ++ai)
#pragma unroll
            for (int bj = 0; bj < 2; ++bj)
#pragma unroll
                for (int m = 0; m < 4; ++m) { s += acc[ai][bj][m][0]; s += acc[ai][bj][m][1]; }
        if (s[0] + s[1] + s[2] + s[3] == 1.2345678e33f) sink[u.pm] = s[0];
    }
};
typedef EpiUT<false> EpiU;
#ifndef EPI_MB
#define EPI_MB 2
#endif
struct EpiRes {
    static constexpr bool PERM = true, AFTER_DRAIN = false;
    const float* res; float* out; bf16_t* xb; float* rowss;
    __device__ __forceinline__ void operator()(const f32x4 (&acc)[2][2][4][2], const pg8::Unit& u, int wr, int wc, int fr, int fq) const {
        const int row0 = u.pm * 256 + wr * 64 + fr, col0 = u.pn * 256 + wc * 32 + 8 * fq;
#pragma unroll
        for (int ai = 0; ai < 2; ++ai) {
#pragma unroll
          for (int mh = 0; mh < 4; mh += EPI_MB) {
            f32x4 rv[4][2][2];
#pragma unroll
            for (int m = mh; m < mh + EPI_MB; ++m)
#pragma unroll
                for (int bj = 0; bj < 2; ++bj) { const float* p = res + (size_t)(row0 + ai * 128 + m * 16) * DM + col0 + bj * 128; rv[m][bj][0] = *(const f32x4*)p; rv[m][bj][1] = *(const f32x4*)(p + 4); }
            asm volatile("" ::: "memory");
#pragma unroll
            for (int m = mh; m < mh + EPI_MB; ++m) {
                const int r = row0 + ai * 128 + m * 16; const size_t off = (size_t)r * DM + col0; float ss = 0.f;
#pragma unroll
                for (int bj = 0; bj < 2; ++bj) {
                    const f32x4 h0 = rv[m][bj][0] + acc[ai][bj][m][0], h1 = rv[m][bj][1] + acc[ai][bj][m][1];
                    if (out) { *(f32x4*)(out + off + bj * 128) = h0; *(f32x4*)(out + off + bj * 128 + 4) = h1; }
                    if (xb) { u32x4 w; w.x = pg8::cvt_pk_bf16(h0[0], h0[1]); w.y = pg8::cvt_pk_bf16(h0[2], h0[3]); w.z = pg8::cvt_pk_bf16(h1[0], h1[1]); w.w = pg8::cvt_pk_bf16(h1[2], h1[3]);
                        *(u32x4*)(xb + off + bj * 128) = w; }
                    ss += (h0[0] * h0[0] + h0[1] * h0[1]) + (h0[2] * h0[2] + h0[3] * h0[3]) + (h1[0] * h1[0] + h1[1] * h1[1]) + (h1[2] * h1[2] + h1[3] * h1[3]);
                }
                ss += __shfl_xor(ss, 16); ss += __shfl_xor(ss, 32);
                if (fq == 0) unsafeAtomicAdd(rowss + r, ss);
            }
            asm volatile("" ::: "memory");
          }
        }
    }
};

struct EpiResNorm {
    static constexpr bool PERM = true, AFTER_DRAIN = false;
    const bf16_t* res; float* out; float* rowss; unsigned* cnt; const float* fg;
    __device__ __forceinline__ void operator()(f32x4 (&acc)[2][2][4][2], const pg8::Unit& u, int wr, int wc, int fr, int fq) const {
        const int row0 = u.pm * 256 + wr * 64 + fr, col0 = u.pn * 256 + wc * 32 + 8 * fq;
#pragma unroll
        for (int ai = 0; ai < 2; ++ai) {
#pragma unroll
          for (int mh = 0; mh < 4; mh += EPI_MB) {
            u32x4 rw[4][2];
#pragma unroll
            for (int m = mh; m < mh + EPI_MB; ++m)
#pragma unroll
                for (int bj = 0; bj < 2; ++bj) rw[m][bj] = *(const u32x4*)(res + (size_t)(row0 + ai * 128 + m * 16) * DM + col0 + bj * 128);
            asm volatile("" ::: "memory");
#pragma unroll
            for (int m = mh; m < mh + EPI_MB; ++m) {
                float ss = 0.f;
#pragma unroll
                for (int bj = 0; bj < 2; ++bj) {
                    const u32x4 w = rw[m][bj];
                    const f32x4 h0 = (f32x4){bflo(w.x), bfhi(w.x), bflo(w.y), bfhi(w.y)} + acc[ai][bj][m][0], h1 = (f32x4){bflo(w.z), bfhi(w.z), bflo(w.w), bfhi(w.w)} + acc[ai][bj][m][1];
                    acc[ai][bj][m][0] = h0; acc[ai][bj][m][1] = h1;
                    ss += (h0[0] * h0[0] + h0[1] * h0[1]) + (h0[2] * h0[2] + h0[3] * h0[3]) + (h1[0] * h1[0] + h1[1] * h1[1]) + (h1[2] * h1[2] + h1[3] * h1[3]);
                }
                ss += __shfl_xor(ss, 16); ss += __shfl_xor(ss, 32);
                if (fq == 0) unsafeAtomicAdd(rowss + row0 + ai * 128 + m * 16, ss);
            }
            asm volatile("" ::: "memory");
          }
        }
        asm volatile("s_waitcnt vmcnt(0)" ::: "memory");
        unsigned* cw = cnt + 64 * (2 * u.pm + wr);
        if (fr == 0 && fq == 0) __hip_atomic_fetch_add(cw, 1u, __ATOMIC_RELAXED, __HIP_MEMORY_SCOPE_AGENT);
        f32x4 gv[2][2];
#pragma unroll
        for (int bj = 0; bj < 2; ++bj) { gv[bj][0] = *(const f32x4*)(fg + col0 + bj * 128); gv[bj][1] = *(const f32x4*)(fg + col0 + bj * 128 + 4); }
        { unsigned sp = 0;
          while ((unsigned)__builtin_amdgcn_readfirstlane(__hip_atomic_load(cw, __ATOMIC_RELAXED, __HIP_MEMORY_SCOPE_AGENT)) < 32u) { __builtin_amdgcn_s_sleep(1); if (++sp > (1u << 16)) break; } }
        asm volatile("" ::: "memory");
#pragma unroll
        for (int ai = 0; ai < 2; ++ai)
#pragma unroll
            for (int m = 0; m < 4; ++m) {
                const int r = row0 + ai * 128 + m * 16;
                const float rs = rsqrtf(__hip_atomic_load(rowss + r, __ATOMIC_RELAXED, __HIP_MEMORY_SCOPE_AGENT) * (1.0f / DM) + RMS_EPS);
                float* op = out + (size_t)r * DM + col0;
#pragma unroll
                for (int bj = 0; bj < 2; ++bj) { *(f32x4*)(op + bj * 128) = acc[ai][bj][m][0] * rs * gv[bj][0]; *(f32x4*)(op + bj * 128 + 4) = acc[ai][bj][m][1] * rs * gv[bj][1]; }
            }
    }
};
struct PanelOrder {
    int Gp, v;
    __device__ void init(int G, int c) { Gp = G & ~7; v = c; if ((Gp & 63) == 0) v = (c & 7) * (Gp >> 3) + (c >> 3); if (c >= Gp) v = -1; }
    __device__ bool next(int i, pg8::Unit& u) const { if (v < 0) return false; const long L = (long)i * Gp + v; if (L >= 64 * 8) return false; u.pm = (int)(L >> 3); u.pn = (int)(L & 7); return true; }
    __device__ __forceinline__ void a_ready(const pg8::Unit&) const {}
    __device__ __forceinline__ void done(const pg8::Unit&) const {}
};

template <class F> __device__ __forceinline__ void meta_gemm(const bf16_t* A, const bf16_t* Bt, int ngroups, LAS unsigned char* lds, int wid, int lane, F epi) {
    const int fr = lane & 15, fq = lane >> 4, half = wid >> 2, wq = wid & 3;
    LAS f32x4* red = (LAS f32x4*)lds;
    for (int p = blockIdx.x; 2 * p < ngroups; p += gridDim.x) {
        const int g = 2 * p + half;
        f32x4 acc = {0.f, 0.f, 0.f, 0.f};
        if (g < ngroups) {
            const bf16_t* ap = A + (size_t)fr * DM + wq * 512 + fq * 8;
            const bf16_t* bp = Bt + (size_t)(g * 16 + fr) * DM + wq * 512 + fq * 8;
            bf16x8 av[16], bv[16];
#pragma unroll
            for (int s = 0; s < 16; ++s) { av[s] = *(const bf16x8*)(ap + 32 * s); bv[s] = *(const bf16x8*)(bp + 32 * s); }
#pragma unroll
            for (int s = 0; s < 16; ++s) acc = __builtin_amdgcn_mfma_f32_16x16x32_bf16(bv[s], av[s], acc, 0, 0, 0);
        }
        red[wid * 64 + lane] = acc;
        __syncthreads();
        if (wq == 0 && g < ngroups) {
            f32x4 s = red[wid * 64 + lane];
#pragma unroll
            for (int w = 1; w < 4; ++w) s += red[(wid + w) * 64 + lane];
            epi(fr, g * 16 + 4 * fq, s);
        }
        __syncthreads();
    }
}

__host__ __device__ __forceinline__ int in_col(int p) {
    if (p < 2048) return p;
    const int c = p & 255, j = (p >> 8) - 8, g = 2 * (c >> 7) + ((c >> 2) & 1), k = 16 * ((c >> 5) & 3) + 4 * ((c >> 3) & 3) + (c & 3);
    return 2048 + 1024 * g + 64 * j + k;
}
template <bool COLMAP> __device__ __forceinline__ void tr_item(const float* W, int K, int N, bf16_t* WT, const float* sc, LAS unsigned char* scr, int item, int lane) {
    const int nblk = N / 64, kb = item / nblk, nb = item % nblk, k0 = 64 * kb, n0 = 64 * nb;
    const int kr = lane >> 4, nc = (lane & 15) * 4;
    f32x4 v[16]; float g[16];
    { const float* p = W + (size_t)(k0 + kr) * N + (COLMAP ? in_col(n0 + nc) : n0 + nc);
#pragma unroll
      for (int i = 0; i < 16; ++i) { v[i] = *(const f32x4*)p; p += (size_t)4 * N; }
#pragma unroll
      for (int i = 0; i < 16; ++i) g[i] = sc ? sc[k0 + kr + 4 * i] : 1.0f; }
    asm volatile("" ::: "memory");
#pragma unroll
    for (int i = 0; i < 16; ++i) { const f32x4 s = v[i] * g[i]; u32x2 w; w.x = pg8::cvt_pk_bf16(s[0], s[1]); w.y = pg8::cvt_pk_bf16(s[2], s[3]);
        *(LAS u32x2*)(scr + (kr + 4 * i) * 136 + nc * 2) = w; }
    LDS_WAIT();
    const int c = lane & 7;
#pragma unroll
    for (int j = 0; j < 8; ++j) { const int n = (lane >> 3) + 8 * j; const LAS bf16_t* s = (const LAS bf16_t*)(scr + (8 * c) * 136 + n * 2);
        u32x4 o; o.x = (unsigned)s[0] | ((unsigned)s[68] << 16); o.y = (unsigned)s[2 * 68] | ((unsigned)s[3 * 68] << 16); o.z = (unsigned)s[4 * 68] | ((unsigned)s[5 * 68] << 16); o.w = (unsigned)s[6 * 68] | ((unsigned)s[7 * 68] << 16);
        *(u32x4*)(WT + (size_t)(n0 + n) * K + k0 + 8 * c) = o; }
    LDS_WAIT();
}
__device__ __forceinline__ void cvt_row(const float* src, bf16_t* dst, float* ss, int lane) {
    const f32x4* xr = (const f32x4*)src + lane; f32x4 v[8]; float s = 0.f;
#pragma unroll
    for (int j = 0; j < 8; ++j) { v[j] = xr[64 * j]; s += (v[j].x * v[j].x + v[j].y * v[j].y) + (v[j].z * v[j].z + v[j].w * v[j].w); }
    s = wave_sum(s);
    u32x2* o8 = (u32x2*)dst + lane;
#pragma unroll
    for (int j = 0; j < 8; ++j) { u32x2 w; w.x = pk2(v[j].x, v[j].y); w.y = pk2(v[j].z, v[j].w); o8[64 * j] = w; }
    if (lane == 0) *ss = s;
}

struct Mix {
    const float *conv_a_w, *conv_a_b, *lru_br, *lru_bi, *lru_lambda, *conv_b_w;
    const bf16_t* gw;
    bf16_t* U; bf16_t* Y; unsigned long long* AGG;
};
struct ItemId { int hd, b, c, row0, ntok, agg; bool meta; };
__device__ __forceinline__ ItemId decode_item(int id) {
    ItemId I;
    if (id < 16) { I.meta = true; I.hd = id; I.b = 0; I.c = 0; I.row0 = META0; I.ntok = 16; I.agg = 256; }
    else { const int j = id - 16; I.meta = false; I.hd = j & 15; I.c = (j >> 4) & 63; I.b = j >> 10; I.row0 = I.b * SEQ + I.c * 64; I.ntok = 64; I.agg = I.b * 64 + I.c; }
    return I;
}
constexpr int N_ITEMS = 16 + NBATCH * NHEAD * 64;

__device__ __forceinline__ bool agg_ok(unsigned long long v) { return (unsigned)v != 0u; }
template <bool META> __device__ __forceinline__ void mix_item(const Mix& X, int id, LAS unsigned char* xt, int lane) {
    constexpr int NT = META ? 16 : 64, NTB = META ? 1 : 2, NQ = META ? 2 : 4;
    constexpr float LOG2E = 1.4426950408889634f;
    const ItemId I = decode_item(id);
    const int ch = I.hd * 64 + lane;
    const float nls2 = -8.0f * LOG2E * log1pf(__expf(-X.lru_lambda[ch]));
    bf16_t raw[NT], rh0 = 0, rh1 = 0, rh2 = 0;
    const float w0 = X.conv_a_w[ch], w1 = X.conv_a_w[1024 + ch], w2 = X.conv_a_w[2048 + ch], w3 = X.conv_a_w[3072 + ch], cb = X.conv_a_b[ch];
    {
        const GAS bf16_t* sb = (const GAS bf16_t*)(X.U + (size_t)I.row0 * DIN + I.hd * 64);
        if (!META) { const GAS bf16_t* hp0 = (I.c == 0) ? (const GAS bf16_t*)(X.U + (size_t)(META0 + 13) * DIN + I.hd * 64) : sb - 3 * DIN; rh0 = hp0[lane]; rh1 = hp0[DIN + lane]; rh2 = hp0[2 * DIN + lane]; }
#pragma unroll
        for (int t = 0; t < NT; ++t) { raw[t] = sb[lane]; sb += DIN; asm volatile("" : "+s"(sb)); }
    }
    bf16x8 BfR0[4], BfR1[4], BfI0[4], BfI1[4];
    { const bf16_t* gr = X.gw + (size_t)(I.hd * 64 + (lane & 31)) * 64 + 8 * (lane >> 5); const bf16_t* gi = gr + 16 * 64 * 64;
#pragma unroll
      for (int s = 0; s < 4; ++s) { BfR0[s] = *(const bf16x8*)(gr + 16 * s); BfR1[s] = *(const bf16x8*)(gr + 32 * 64 + 16 * s); BfI0[s] = *(const bf16x8*)(gi + 16 * s); BfI1[s] = *(const bf16x8*)(gi + 32 * 64 + 16 * s); } }
    asm volatile("" ::: "memory");
    float xm3 = bf1(rh0), xm2 = bf1(rh1), xm1 = bf1(rh2);
#pragma unroll
    for (int t = 0; t < NT; ++t) { const float x0 = bf1(raw[t]); const float xc = cb + w0 * xm3 + w1 * xm2 + w2 * xm1 + w3 * x0; xm3 = xm2; xm2 = xm1; xm1 = x0;
        *(LAS bf16_t*)(xt + t * 144 + lane * 2) = (bf16_t)f2bf(xc); }
    const float brA = X.lru_br[I.hd * 64 + (lane & 31)], brB = X.lru_br[I.hd * 64 + 32 + (lane & 31)], biA = X.lru_bi[I.hd * 64 + (lane & 31)], biB = X.lru_bi[I.hd * 64 + 32 + (lane & 31)];
    float h = 0.f, P = 1.f;
    unsigned hp[NT];
#pragma unroll
    for (int tb = 0; tb < NTB; ++tb) {
        f32x16 aR0, aR1, aI0, aI1;
#pragma unroll
        for (int e = 0; e < 16; ++e) { aR0[e] = brA; aR1[e] = brB; aI0[e] = biA; aI1[e] = biB; }
#pragma unroll
        for (int s = 0; s < 4; ++s) {
            const bf16x8 af = *(const LAS bf16x8*)(xt + (tb * 32 + (lane & 31)) * 144 + (16 * s + 8 * (lane >> 5)) * 2);
            aR0 = __builtin_amdgcn_mfma_f32_32x32x16_bf16(af, BfR0[s], aR0, 0, 0, 0);
            aR1 = __builtin_amdgcn_mfma_f32_32x32x16_bf16(af, BfR1[s], aR1, 0, 0, 0);
            aI0 = __builtin_amdgcn_mfma_f32_32x32x16_bf16(af, BfI0[s], aI0, 0, 0, 0);
            aI1 = __builtin_amdgcn_mfma_f32_32x32x16_bf16(af, BfI1[s], aI1, 0, 0, 0);
        }
#pragma unroll
        for (int q = 0; q < NQ; ++q) {
            float Rv[2][4], Iv[2][4];
#pragma unroll
            for (int k = 0; k < 4; ++k) {
                const int reg = 4 * q + k;
                const float r0f = aR0[reg], r1f = aR1[reg], i0f = aI0[reg], i1f = aI1[reg];
                auto r = __builtin_amdgcn_permlane32_swap(__float_as_uint(r0f), __float_as_uint(r1f), false, false);
                Rv[0][k] = __uint_as_float(r[0]); Rv[1][k] = __uint_as_float(r[1]);
                auto i2 = __builtin_amdgcn_permlane32_swap(__float_as_uint(i0f), __float_as_uint(i1f), false, false);
                Iv[0][k] = __uint_as_float(i2[0]); Iv[1][k] = __uint_as_float(i2[1]);
            }
#pragma unroll
            for (int st = 0; st < 2; ++st)
#pragma unroll
                for (int p = 0; p < 2; ++p) {
                    const int t = tb * 32 + 8 * q + 4 * st + 2 * p;
                    f32x2 er = (f32x2){Rv[st][2 * p], Rv[st][2 * p + 1]} * (-LOG2E), ei = (f32x2){Iv[st][2 * p], Iv[st][2 * p + 1]} * (-LOG2E);
                    er.x = __builtin_amdgcn_exp2f(er.x); er.y = __builtin_amdgcn_exp2f(er.y); ei.x = __builtin_amdgcn_exp2f(ei.x); ei.y = __builtin_amdgcn_exp2f(ei.y);
                    er = er + 1.0f; ei = ei + 1.0f;
                    f32x2 rg, ig; rg.x = __builtin_amdgcn_rcpf(er.x); rg.y = __builtin_amdgcn_rcpf(er.y); ig.x = __builtin_amdgcn_rcpf(ei.x); ig.y = __builtin_amdgcn_rcpf(ei.y);
                    const f32x2 l2 = rg * nls2;
                    f32x2 a; a.x = __builtin_amdgcn_exp2f(l2.x); a.y = __builtin_amdgcn_exp2f(l2.y);
                    f32x2 om = 1.0f - a * a; om.x = fmaxf(om.x, 0.f); om.y = fmaxf(om.y, 0.f);
                    f32x2 mu; mu.x = __builtin_amdgcn_sqrtf(om.x); mu.y = __builtin_amdgcn_sqrtf(om.y);
                    const f32x2 xc = (f32x2){bf1(*(const LAS bf16_t*)(xt + t * 144 + lane * 2)), bf1(*(const LAS bf16_t*)(xt + (t + 1) * 144 + lane * 2))};
                    const f32x2 bb = mu * ig * xc;
                    h = a.x * h + bb.x; P = P * a.x; hp[t] = pg8::cvt_pk_bf16(h, P);
                    h = a.y * h + bb.y; P = P * a.y; hp[t + 1] = pg8::cvt_pk_bf16(h, P);
                }
        }
    }
    __hip_atomic_store(X.AGG + (size_t)I.agg * 1024 + ch, ((unsigned long long)__float_as_uint(h) << 32) | (unsigned long long)__float_as_uint(P), __ATOMIC_RELAXED, __HIP_MEMORY_SCOPE_AGENT);
    asm volatile("" ::: "memory");
    bf16_t graw[NT];
    { const GAS bf16_t* sb = (const GAS bf16_t*)(X.U + (size_t)I.row0 * DIN + 1024 + I.hd * 64);
#pragma unroll
      for (int t = 0; t < NT; ++t) { graw[t] = sb[lane]; sb += DIN; asm volatile("" : "+s"(sb)); } }
    float hin = 0.f;
    if (!META) {
        { const unsigned long long* mp = X.AGG + (size_t)256 * 1024 + ch; unsigned long long v;
          for (;;) { v = __hip_atomic_load(mp, __ATOMIC_RELAXED, __HIP_MEMORY_SCOPE_AGENT); if (!__any(!agg_ok(v))) break; __builtin_amdgcn_s_sleep(2); }
          hin = __uint_as_float((unsigned)(v >> 32)); }
        const unsigned long long* ap = X.AGG + (size_t)(I.b * 64) * 1024 + ch;
        for (int j0 = 0; j0 < I.c; j0 += 16) {
            unsigned long long v[16];
            for (;;) {
                bool bad = false;
#pragma unroll
                for (int k = 0; k < 16; ++k) { v[k] = (j0 + k < I.c) ? __hip_atomic_load(ap + (size_t)(j0 + k) * 1024, __ATOMIC_RELAXED, __HIP_MEMORY_SCOPE_AGENT) : 0x000000003f800000ull; }
#pragma unroll
                for (int k = 0; k < 16; ++k) bad |= !agg_ok(v[k]);
                if (!__any(bad)) break;
                __builtin_amdgcn_s_sleep(2);
            }
#pragma unroll
            for (int k = 0; k < 16; ++k) hin = __uint_as_float((unsigned)v[k]) * hin + __uint_as_float((unsigned)(v[k] >> 32));
        }
    }
    asm volatile("" ::: "memory");
    GAS bf16_t* yp = (GAS bf16_t*)(X.Y + (size_t)I.row0 * DM + I.hd * 64);
#pragma unroll
    for (int t0 = 0; t0 < NT; t0 += 16) {
        {
#pragma unroll
            for (int k = 0; k < 16; k += 2) {
                const unsigned w0 = hp[t0 + k], w1 = hp[t0 + k + 1];
                const f32x2 gg = (f32x2){bf1(graw[t0 + k]), bf1(graw[t0 + k + 1])};
                f32x2 e = gg * (-LOG2E); e.x = __builtin_amdgcn_exp2f(e.x); e.y = __builtin_amdgcn_exp2f(e.y); e = e + 1.0f;
                f32x2 sg; sg.x = __builtin_amdgcn_rcpf(e.x); sg.y = __builtin_amdgcn_rcpf(e.y);
                const f32x2 hv = (f32x2){bflo(w0), bflo(w1)} + (f32x2){bfhi(w0), bfhi(w1)} * hin;
                const f32x2 y = hv * gg * sg;
                const unsigned pk = pg8::cvt_pk_bf16(y.x, y.y);
                yp[lane] = (bf16_t)(pk & 0xffffu); yp[DM + lane] = (bf16_t)(pk >> 16); yp += 2 * DM; asm volatile("" : "+s"(yp));
            }
        }
    }
}

__device__ __forceinline__ void ld8(const bf16_t* p, float (&o)[8]) {
    const u32x4 w = *(const u32x4*)p;
    o[0] = bflo(w.x); o[1] = bfhi(w.x); o[2] = bflo(w.y); o[3] = bfhi(w.y); o[4] = bflo(w.z); o[5] = bfhi(w.z); o[6] = bflo(w.w); o[7] = bfhi(w.w);
}
__device__ __forceinline__ void partb(const Mix& X, int tid) {
    for (int it = blockIdx.x * 512 + tid; it < 1025 * 128; it += gridDim.x * 512) {
        const int c0 = (it & 127) * 8, run = it >> 7;
        float w0[8], w1[8], w2[8], cm2[8], cm1[8];
        { const f32x4* p = (const f32x4*)(X.conv_b_w + c0); const f32x4 a0 = p[0], a1 = p[1], b0 = p[256], b1 = p[257], d0 = p[512], d1 = p[513];
#pragma unroll
          for (int e = 0; e < 4; ++e) { w0[e] = a0[e]; w0[4 + e] = a1[e]; w1[e] = b0[e]; w1[4 + e] = b1[e]; w2[e] = d0[e]; w2[4 + e] = d1[e]; } }
        if (run == 1024) {
#pragma unroll
            for (int e = 0; e < 8; ++e) { cm2[e] = 0.f; cm1[e] = 0.f; }
            const bf16_t* up = X.U + (size_t)META0 * DIN + c0; bf16_t* yp = X.Y + (size_t)META0 * DM + 1024 + c0;
#pragma unroll 4
            for (int t = 0; t < 16; ++t) {
                float bv[8], cv[8], xv[8], gv[8];
                ld8(up + (size_t)t * DIN + 2048, bv); ld8(up + (size_t)t * DIN + 3072, cv); ld8(up + (size_t)t * DIN + 4096, xv); ld8(up + (size_t)t * DIN + 5120, gv);
                float o[8];
#pragma unroll
                for (int e = 0; e < 8; ++e) { const float cx = cv[e] * xv[e]; const float y = w0[e] * cm2[e] + w1[e] * cm1[e] + w2[e] * cx; o[e] = bv[e] * y * (gv[e] * sigmoidf_(gv[e])); cm2[e] = cm1[e]; cm1[e] = cx; }
                u32x4 w; w.x = pk2(o[0], o[1]); w.y = pk2(o[2], o[3]); w.z = pk2(o[4], o[5]); w.w = pk2(o[6], o[7]);
                *(u32x4*)(yp + (size_t)t * DM) = w;
            }
            continue;
        }
        const int row0 = run * 16;
        if ((row0 & (SEQ - 1)) == 0) {
            float c[8], x[8];
            ld8(X.U + (size_t)(META0 + 14) * DIN + 3072 + c0, c); ld8(X.U + (size_t)(META0 + 14) * DIN + 4096 + c0, x);
#pragma unroll
            for (int e = 0; e < 8; ++e) cm2[e] = c[e] * x[e];
            ld8(X.U + (size_t)(META0 + 15) * DIN + 3072 + c0, c); ld8(X.U + (size_t)(META0 + 15) * DIN + 4096 + c0, x);
#pragma unroll
            for (int e = 0; e < 8; ++e) cm1[e] = c[e] * x[e];
        } else {
            const u32x4* p2 = (const u32x4*)(X.U + (size_t)(row0 - 2) * DIN + 2048 + 2 * c0); const u32x4* p1 = (const u32x4*)(X.U + (size_t)(row0 - 1) * DIN + 2048 + 2 * c0);
            const u32x4 a0 = p2[0], a1 = p2[1], b0 = p1[0], b1 = p1[1];
#pragma unroll
            for (int e = 0; e < 4; ++e) { cm2[e] = bfhi(a0[e]); cm2[4 + e] = bfhi(a1[e]); cm1[e] = bfhi(b0[e]); cm1[4 + e] = bfhi(b1[e]); }
        }
        const bf16_t* vp = X.U + (size_t)row0 * DIN + 2048 + 2 * c0;
        bf16_t* yp = X.Y + (size_t)row0 * DM + 1024 + c0;
#pragma unroll 8
        for (int t = 0; t < 16; ++t) {
            const u32x4 q0 = *(const u32x4*)(vp + (size_t)t * DIN), q1 = *(const u32x4*)(vp + (size_t)t * DIN + 8);
            float o[8];
#pragma unroll
            for (int e = 0; e < 8; ++e) { const unsigned q = e < 4 ? q0[e & 3] : q1[e & 3]; const float bg = bflo(q), cx = bfhi(q);
                o[e] = bg * (w0[e] * cm2[e] + w1[e] * cm1[e] + w2[e] * cx); cm2[e] = cm1[e]; cm1[e] = cx; }
            u32x4 w; w.x = pk2(o[0], o[1]); w.y = pk2(o[2], o[3]); w.z = pk2(o[4], o[5]); w.w = pk2(o[6], o[7]);
            *(u32x4*)(yp + (size_t)t * DM) = w;
        }
    }
}


#ifdef DEBUG_NAIVE_MIX
__global__ void __launch_bounds__(64) naive_mixA(Mix X, const float* wr, const float* wi) {
    const int b = blockIdx.x / 16, hd = blockIdx.x % 16, lane = threadIdx.x, ch = hd * 64 + lane;
    __shared__ float xs[64];
    const float w0 = X.conv_a_w[ch], w1 = X.conv_a_w[1024 + ch], w2 = X.conv_a_w[2048 + ch], w3 = X.conv_a_w[3072 + ch], cb = X.conv_a_b[ch];
    const float br = X.lru_br[ch], bi = X.lru_bi[ch];
    const float sp = log1pf(expf(-X.lru_lambda[ch]));
    const float* wrh = wr + (size_t)hd * 4096 + lane; const float* wih = wi + (size_t)hd * 4096 + lane;
    float h = 0.f, xm3 = 0.f, xm2 = 0.f, xm1 = 0.f;
    for (int p = 0; p < NMETA + SEQ; ++p) {
        const int row = p < NMETA ? META0 + p : b * SEQ + (p - NMETA);
        const float x0 = bf1(X.U[(size_t)row * DIN + ch]);
        const float xc = cb + w0 * xm3 + w1 * xm2 + w2 * xm1 + w3 * x0; xm3 = xm2; xm2 = xm1; xm1 = x0;
        xs[lane] = xc; __syncthreads();
        float rp = br, ip = bi;
#pragma unroll 4
        for (int i = 0; i < 64; ++i) { rp += xs[i] * wrh[i * 64]; ip += xs[i] * wih[i * 64]; }
        __syncthreads();
        const float r = 1.f / (1.f + expf(-rp)), ig = 1.f / (1.f + expf(-ip));
        const float la = -8.f * r * sp; const float a = expf(la); const float bb = sqrtf(-expm1f(2.f * la)) * (ig * xc);
        h = a * h + bb;
        const float g = bf1(X.U[(size_t)row * DIN + 1024 + ch]);
        const float y = h * g / (1.f + expf(-g));
        if (p >= NMETA || b == 0) X.Y[(size_t)row * DM + ch] = (bf16_t)f2bf(y);
    }
}
__global__ void naive_mixB(Mix X) {
    for (size_t idx = (size_t)blockIdx.x * blockDim.x + threadIdx.x; idx < (size_t)(MROWS + NMETA) * 1024; idx += (size_t)gridDim.x * blockDim.x) {
        const int row = (int)(idx >> 10), c = (int)(idx & 1023);
        int r1, r2;
        if (row >= META0) { const int p = row - META0; r1 = p >= 1 ? row - 1 : -1; r2 = p >= 2 ? row - 2 : -1; }
        else { const int t = row & (SEQ - 1); r1 = t >= 1 ? row - 1 : META0 + 15; r2 = t >= 2 ? row - 2 : META0 + 14 + t; }
        auto cx = [&](int r) -> float { return r < 0 ? 0.f : bf1(X.U[(size_t)r * DIN + 3072 + c]) * bf1(X.U[(size_t)r * DIN + 4096 + c]); };
        const float y = X.conv_b_w[c] * cx(r2) + X.conv_b_w[1024 + c] * cx(r1) + X.conv_b_w[2048 + c] * cx(row);
        const float bv = bf1(X.U[(size_t)row * DIN + 2048 + c]), g = bf1(X.U[(size_t)row * DIN + 5120 + c]);
        X.Y[(size_t)row * DM + 1024 + c] = (bf16_t)f2bf(bv * y * g / (1.f + expf(-g)));
    }
}
#endif
#define XB_TMO      128
#define XB_XCNT(j)  (256  + 64 * (j))
#define XB_XSUB(j)  (1280 + 64 * (j))
#define XB_XGEN(j)  (2304 + 64 * (j))
#define XB_TOP      3328
#define XB_TOPGEN   3392
#define XCD_BAR_WORDS 3456
#define XB_SPIN_CAP (1u << 18)

__device__ __forceinline__ unsigned xb_ld(unsigned* p)              { return __hip_atomic_load(p, __ATOMIC_RELAXED, __HIP_MEMORY_SCOPE_AGENT); }
__device__ __forceinline__ unsigned xb_add(unsigned* p, unsigned v) { return __hip_atomic_fetch_add(p, v, __ATOMIC_RELAXED, __HIP_MEMORY_SCOPE_AGENT); }
__device__ __forceinline__ unsigned xb_xcc_id() { return (unsigned)__builtin_amdgcn_s_getreg((3 << 11) | 20) & 0xFu; }
#define XB_SPIN(cond, bar) do { unsigned _sp = 0; while (cond) { __builtin_amdgcn_s_sleep(1); \
    if ((++_sp & 255u) == 0u) { if (xb_ld(&(bar)[XB_TMO])) break; if (_sp > XB_SPIN_CAP) { atomicAdd(&(bar)[XB_TMO], 1u); break; } } } } while (0)

struct XcdBarrier {
    unsigned* bar; unsigned x;
    volatile LAS unsigned* st;
};

__device__ __forceinline__ XcdBarrier xcd_barrier_post(unsigned* bar, volatile LAS unsigned* st) {
    XcdBarrier b; b.bar = bar; b.x = xb_xcc_id(); b.st = st;
    if (threadIdx.x == 0) (void)xb_add(&bar[XB_XCNT(b.x)], 1u);
    return b;
}
__device__ __forceinline__ void xcd_barrier_complete(unsigned* bar, unsigned x, unsigned& nloc, unsigned& nx) {
    const unsigned G = gridDim.x * gridDim.y * gridDim.z;
    unsigned sum, cnt, mine, sp = 0u;
    for (;;) {
        sum = 0u; cnt = 0u; mine = 0u;
#pragma unroll
        for (unsigned j = 0; j < 16; ++j) { const unsigned c = xb_ld(&bar[XB_XCNT(j)]); sum += c; cnt += (c > 0u) ? 1u : 0u; mine = (j == x) ? c : mine; }
        if (sum == G) break;
        __builtin_amdgcn_s_sleep(1);
        if ((++sp & 255u) == 0u) { if (xb_ld(&bar[XB_TMO])) break; if (sp > XB_SPIN_CAP) { atomicAdd(&bar[XB_TMO], 1u); break; } }
    }
    nloc = mine > 0u ? mine : 1u; nx = cnt > 0u ? cnt : 1u;
}

__device__ __forceinline__ void xcd_barrier(const XcdBarrier& b) {
    asm volatile("s_waitcnt vmcnt(0)" ::: "memory");
    __syncthreads();
    if (threadIdx.x == 0) {
        unsigned* bar = b.bar;
        __builtin_amdgcn_s_waitcnt(0);
        unsigned nloc = b.st[0], nx = b.st[1];
        if (nloc == 0u) { xcd_barrier_complete(bar, b.x, nloc, nx); b.st[0] = nloc; b.st[1] = nx; }
        const unsigned old = xb_add(&bar[XB_XSUB(b.x)], 1u);
        const unsigned gen = old / nloc;
        if (old + 1u == (gen + 1u) * nloc) {
            __builtin_amdgcn_fence(__ATOMIC_RELEASE, "agent");
            asm volatile("s_waitcnt vmcnt(0)" ::: "memory");
            const unsigned og = xb_add(&bar[XB_TOP], 1u);
            const unsigned tg = og / nx;
            if (og + 1u == (tg + 1u) * nx) xb_add(&bar[XB_TOPGEN], 1u);
            else XB_SPIN(xb_ld(&bar[XB_TOPGEN]) == tg, bar);
            __builtin_amdgcn_fence(__ATOMIC_ACQUIRE, "agent");
            xb_add(&bar[XB_XGEN(b.x)], 1u);
            asm volatile("s_waitcnt vmcnt(0)" ::: "memory");
        } else {
            XB_SPIN(xb_ld(&bar[XB_XGEN(b.x)]) == gen, bar);
            __builtin_amdgcn_fence(__ATOMIC_ACQUIRE, "agent");
            asm volatile("s_waitcnt vmcnt(0)" ::: "memory");
        }
    }
    __syncthreads();
}

__global__ void __launch_bounds__(512, 2) hymba_fwd(Args a) {
    extern __shared__ __attribute__((aligned(16))) unsigned char lds_raw[];
    LAS unsigned char* lds = (LAS unsigned char*)lds_raw;
    cg::grid_group grid = cg::this_grid();
    const int NGW = gridDim.x * 8;
    if (threadIdx.x < 64) ((LAS unsigned*)(lds + 131072))[threadIdx.x] = 0u;
    __syncthreads();
    XcdBarrier xbar; xbar.bar = (unsigned*)(a.ws + WS_BAR); xbar.x = 0; xbar.st = nullptr;
    if (a.ph_hi - a.ph_lo > 1) xbar = xcd_barrier_post((unsigned*)(a.ws + WS_BAR), (volatile LAS unsigned*)(lds + 131072));
    if (a.ph_lo < 0) grid.sync();
#define LAUNDER() int tid = threadIdx.x; asm volatile("" : "+v"(tid)); const int wid = __builtin_amdgcn_readfirstlane(tid >> 6), lane = tid & 63, gw = blockIdx.x * 8 + wid
    const int lo = a.ph_lo, hi = a.ph_hi;
#define IN(k) (lo <= (k) && (k) < hi)
#ifndef STAGGER_N
#define STAGGER_N 0
#endif
#define STAGGER() do { if (STAGGER_N) for (int _k = 0; _k < (int)(blockIdx.x & 7); ++_k) __builtin_amdgcn_s_sleep(STAGGER_N); } while (0)
#define SEAM(k) do { if (IN(k) && IN((k) + 1)) { xcd_barrier(xbar); if ((REP_MASK >> 10) & 1) { xcd_barrier(xbar); xcd_barrier(xbar); } } } while (0)
    const float* x = a.in[0]; const float* meta = a.in[1]; const float* norm_g = a.in[2]; const float* w_in = a.in[3];
    const float* conv_a_w = a.in[4]; const float* conv_a_b = a.in[5]; const float* lru_wr = a.in[6]; const float* lru_br = a.in[7];
    const float* lru_wi = a.in[8]; const float* lru_bi = a.in[9]; const float* lru_lambda = a.in[10]; const float* conv_b_w = a.in[11];
    const float* w_out = a.in[12]; const float* final_g = a.in[13];
    unsigned char* ws = a.ws;
    bf16_t* WTIN = (bf16_t*)(ws + WS_WTIN); bf16_t* WTOUT = (bf16_t*)(ws + WS_WTOUT); bf16_t* GW = (bf16_t*)(ws + WS_GW);
    float* ROWSS = (float*)(ws + WS_ROWSS); unsigned long long* AGG = (unsigned long long*)(ws + WS_AGG);
    bf16_t* XB = (bf16_t*)(ws + WS_XB); bf16_t* Y = (bf16_t*)(ws + WS_Y); bf16_t* U = (bf16_t*)(ws + WS_U);

    if (IN(0)) for (int rep = 0; rep <= ((REP_MASK >> 0) & 1); ++rep) {
        LAUNDER();
        LAS unsigned char* scr = lds + wid * 16384;
        constexpr int I_IN = (DM / 64) * (DIN / 64);
        constexpr int NIT = I_IN + 64;
        for (int it = gw; it < NIT; it += NGW) {
            int r = it;
            if (r < I_IN) { tr_item<true>(w_in, DM, DIN, WTIN, norm_g, scr, r, lane); continue; } r -= I_IN;
            { const int mtx = r, l = mtx >> 5, g = (mtx >> 4) & 1, hd = mtx & 15;
              const float* src = (g ? lru_wi : lru_wr) + (size_t)(l * 16 + hd) * 4096;
              tr_item<false>(src, 64, 64, GW + (size_t)mtx * 4096, nullptr, scr, 0, lane); }
        }
        for (int m = gw; m < MROWS + NMETA; m += NGW) {
            const float* src = m < MROWS ? x + (size_t)m * DM : meta + (size_t)(m - MROWS) * DM;
            cvt_row(src, XB + (size_t)m * DM, ROWSS + m, lane);
        }
        for (int i = blockIdx.x * 512 + tid; i < 2 * RSTR; i += gridDim.x * 512) ROWSS[RSTR + i] = 0.f;
        for (int i = blockIdx.x * 512 + tid; i < AGG_PER_LAYER; i += gridDim.x * 512) ((u32x4*)AGG)[i] = (u32x4){0u, 0u, 0u, 0u};
    }
    SEAM(0);

#pragma unroll 1
    for (int l = 0; l < 2; ++l) {
        const int pb = 1 + 3 * l;
        const bf16_t* wtin = WTIN + (size_t)l * DIN * DM; const bf16_t* wtout = WTOUT + (size_t)l * DM * DM;
        float* rss_in = ROWSS + (size_t)l * RSTR; float* rss_out = ROWSS + (size_t)(l + 1) * RSTR;
        Mix X; X.conv_a_w = conv_a_w + l * 4 * DLRU; X.conv_a_b = conv_a_b + l * DLRU; X.lru_br = lru_br + l * DLRU; X.lru_bi = lru_bi + l * DLRU; X.lru_lambda = lru_lambda + l * DLRU;
        X.conv_b_w = conv_b_w + l * 3 * DLRU; X.gw = GW + (size_t)l * 2 * 16 * 4096; X.U = U; X.Y = Y; X.AGG = AGG + (size_t)l * AGG_PER_LAYER;

        if (IN(pb)) for (int rep = 0; rep <= ((REP_MASK >> pb) & 1); ++rep) {
            LAUNDER();
            STAGGER();
            for (int mrep = 0; mrep <= ((REP_MASK >> 16) & 1); ++mrep)
            meta_gemm(XB + (size_t)META0 * DM, wtin, DIN / 16, lds, wid, lane, [&](int m, int n0, f32x4 s) {
                const float rs = rsqrtf(rss_in[META0 + m] * (1.0f / DM) + RMS_EPS);
                u32x2 w; w.x = pk2(s[0] * rs, s[1] * rs); w.y = pk2(s[2] * rs, s[3] * rs);
                *(u32x2*)(U + (size_t)(META0 + m) * DIN + in_col(n0)) = w; });
            pg8::Gemm g{XB, wtin, MROWS, DIN, DM}; pg8::StaticOrder S; S.init(MROWS, DIN, (int)gridDim.x, (int)blockIdx.x);
            if ((REP_MASK >> 17) & 1) { EpiUT<true> En{U, rss_in}; pg8::gemm_phase<EpiUT<true>, pg8::StaticOrder, false>(lds, g, S, En, nullptr); }
            if ((REP_MASK >> 15) & 1) { EpiNull En{ROWSS + (size_t)3 * RSTR}; pg8::gemm_phase<EpiNull, pg8::StaticOrder, false>(lds, g, S, En, nullptr); }
            EpiU E{U, rss_in};
            pg8::gemm_phase<EpiU, pg8::StaticOrder, false>(lds, g, S, E, nullptr);
        }
        SEAM(pb);
        if (IN(pb + 1)) for (int rep = 0; rep <= ((REP_MASK >> (pb + 1)) & 1); ++rep) {
            LAUNDER();
#pragma unroll 1
            for (int step = 0; step < 2; ++step) {
                if ((step == 0) == (wid < 4)) {
                    if (rep == 1 && ((REP_MASK >> 13) & 1)) continue;
#pragma unroll 1
                    for (int id = gw; id < N_ITEMS; id += NGW) { if (id < 16) mix_item<true>(X, id, lds + wid * 9216, lane); else mix_item<false>(X, id, lds + wid * 9216, lane); }
                } else { if (rep == 1 && ((REP_MASK >> 12) & 1)) continue; partb(X, tid); }
            }
            if (l == 0) {
                constexpr int I_IN = (DM / 64) * (DIN / 64), I_OUT = (DM / 64) * (DM / 64);
                LAS unsigned char* scr = lds + wid * 9216;
#pragma unroll 1
                for (int it = gw; it < I_IN + 2 * I_OUT; it += NGW) {
                    if (it < I_IN) tr_item<true>(w_in + (size_t)DM * DIN, DM, DIN, WTIN + (size_t)DIN * DM, norm_g + DM, scr, it, lane);
                    else { const int r = it - I_IN, lw = r / I_OUT; tr_item<false>(w_out + (size_t)lw * DM * DM, DM, DM, WTOUT + (size_t)lw * DM * DM, nullptr, scr, r % I_OUT, lane); }
                }
            }
        }
        SEAM(pb + 1);
        if (IN(pb + 2)) {
            LAUNDER();
            STAGGER();
            if (l == 0) {
                meta_gemm(Y + (size_t)META0 * DM, wtout, DM / 16, lds, wid, lane, [&](int m, int n0, f32x4 s) {
                    const f32x4 r = *(const f32x4*)(meta + (size_t)m * DM + n0); const f32x4 hh = r + s;
                    u32x2 w; w.x = pk2(hh[0], hh[1]); w.y = pk2(hh[2], hh[3]);
                    *(u32x2*)(XB + (size_t)(META0 + m) * DM + n0) = w;
                    unsafeAtomicAdd(rss_out + META0 + m, (hh[0] * hh[0] + hh[1] * hh[1]) + (hh[2] * hh[2] + hh[3] * hh[3])); });
            }
            pg8::Gemm g{Y, wtout, MROWS, DM, DM};
            if (l == 0) {
                pg8::StaticOrder S; S.init(MROWS, DM, (int)gridDim.x, (int)blockIdx.x);
                if ((REP_MASK >> 11) & 1) { EpiU Ed{U, rss_in}; pg8::gemm_phase<EpiU, pg8::StaticOrder, false>(lds, g, S, Ed, nullptr); }
                if ((REP_MASK >> 14) & 1) { EpiRes Ed{x, nullptr, XB, ROWSS + (size_t)3 * RSTR}; pg8::gemm_phase<EpiRes, pg8::StaticOrder, false>(lds, g, S, Ed, nullptr); }
                EpiRes E{x, nullptr, XB, rss_out};
                pg8::gemm_phase<EpiRes, pg8::StaticOrder, false>(lds, g, S, E, nullptr);
            } else {
                PanelOrder S; S.init((int)gridDim.x, (int)blockIdx.x);
                EpiResNorm E{XB, a.out, rss_out, (unsigned*)(ws + WS_PCNT), final_g};
                pg8::gemm_phase<EpiResNorm, PanelOrder, false>(lds, g, S, E, nullptr);
            }
        }
        SEAM(pb + 2);
    }

#undef IN
#undef SEAM
}

#ifndef MK_LAUNCH_PER_PHASE
#define MK_LAUNCH_PER_PHASE 0
#endif
extern "C" void kernel_launch(void* const* d_in, const int* in_sizes, int n_in, void* d_out, int out_size, void* d_ws, size_t ws_size, hipStream_t stream) {
    static int grid = 0;
    if (grid == 0) {
        if (n_in != 14 || in_sizes[0] != MROWS * DM || out_size != MROWS * DM || ws_size < WS_END) { fprintf(stderr, "kernel_launch: unexpected shapes (n_in %d, in0 %d, out %d, ws %zu)\n", n_in, n_in > 0 ? in_sizes[0] : -1, out_size, ws_size); grid = -1; return; }
        int dev = 0, cus = 0, per_cu = 0;
        hipGetDevice(&dev); hipDeviceGetAttribute(&cus, hipDeviceAttributeMultiprocessorCount, dev);
        if (hipFuncSetAttribute((const void*)hymba_fwd, hipFuncAttributeMaxDynamicSharedMemorySize, LDS_BYTES) != hipSuccess) { fprintf(stderr, "kernel_launch: hipFuncSetAttribute failed\n"); grid = -1; return; }
        if (hipOccupancyMaxActiveBlocksPerMultiprocessor(&per_cu, (const void*)hymba_fwd, 512, LDS_BYTES) != hipSuccess || per_cu < 1) { fprintf(stderr, "kernel_launch: occupancy query gave %d\n", per_cu); per_cu = 1; }
        (void)hipGetLastError();
        grid = cus * per_cu;
    }
    if (grid < 0) return;
    Args a{};
    for (int i = 0; i < 14; ++i) a.in[i] = (const float*)d_in[i];
    a.out = (float*)d_out; a.ws = (unsigned char*)d_ws;
#if MK_LAUNCH_PER_PHASE
    for (int p = 0; p < NPHASE; ++p) {
#ifdef DEBUG_NAIVE_MIX
        if (p == 2 || p == 6) { const int l = p / 4; unsigned char* ws = (unsigned char*)d_ws;
            Mix X; X.conv_a_w = a.in[4] + l * 4 * DLRU; X.conv_a_b = a.in[5] + l * DLRU; X.lru_br = a.in[7] + l * DLRU; X.lru_bi = a.in[9] + l * DLRU; X.lru_lambda = a.in[10] + l * DLRU;
            X.conv_b_w = a.in[11] + l * 3 * DLRU; X.gw = nullptr; X.U = (bf16_t*)(ws + WS_U); X.Y = (bf16_t*)(ws + WS_Y); X.HP = nullptr; X.AGG = nullptr;
#if DEBUG_NAIVE_MIX == 1
            hipLaunchKernelGGL(naive_mixA, dim3(64), dim3(64), 0, stream, X, a.in[6] + (size_t)l * 16 * 4096, a.in[8] + (size_t)l * 16 * 4096);
            a.flags = 1;
#else
            hipLaunchKernelGGL(naive_mixB, dim3(2048), dim3(256), 0, stream, X);
            a.flags = 2;
#endif
            }
        else a.flags = 0;
#if DEBUG_NAIVE_MIX == 1
        if (p == 3 || p == 7) continue;
#endif
#endif
        a.ph_lo = p; a.ph_hi = p + 1; hipLaunchKernelGGL(hymba_fwd, dim3(grid), dim3(512), LDS_BYTES, stream, a); }
#else
    a.ph_lo = 0; a.ph_hi = NPHASE;
    if (hipMemsetAsync((unsigned char*)d_ws + WS_BAR, 0, 16384 + 32768, stream) != hipSuccess) { fprintf(stderr, "kernel_launch: memset of barrier words failed\n"); return; }
    void* args[] = {&a};
    const hipError_t e = hipLaunchCooperativeKernel((const void*)hymba_fwd, dim3(grid), dim3(512), args, LDS_BYTES, stream);
    if (e != hipSuccess) fprintf(stderr, "kernel_launch: cooperative launch failed: %s (grid %d)\n", hipGetErrorString(e), grid);
#endif
}
```

```cpp
#include <hip/hip_runtime.h>
#include <hip/hip_cooperative_groups.h>
#include <cstdio>
namespace cg = cooperative_groups;
namespace pg8 {
#define PG8_LAS __attribute__((address_space(3)))
typedef unsigned short bf16_t;
typedef short bf16x8 __attribute__((ext_vector_type(8)));
typedef float f32x4 __attribute__((ext_vector_type(4)));
typedef unsigned u32x4 __attribute__((ext_vector_type(4)));
constexpr int BM = 256, BK = 64, HALF = 128, HTB = HALF * BK * 2  , STAGE_BYTES = 8 * HTB, NXCD = 8, WGM = 8;

__host__ __device__ __forceinline__ int lds_byte(int r, int c) { const int st = (r >> 4) * 2 + (c >> 5), rr = r & 15, cc = c & 31, ob = rr * 64 + cc * 2; return st * 1024 + (ob ^ (((ob >> 9) & 1) << 5)); }
__host__ __device__ __forceinline__ void stage_rc(int b, int& R, int& C) { const int st = b / 1024, sb = b % 1024, swz = sb ^ (((sb >> 9) & 1) << 5); R = (st >> 1) * 16 + swz / 64; C = (st & 1) * 32 + (swz % 64) / 2; }
__host__ __device__ __forceinline__ int perm32(int rho) { const int n = rho >> 4, i = rho & 15; return 8 * (i >> 2) + 4 * n + (i & 3); }

struct Unit { int pm, pn; };
struct Gemm { const bf16_t* A; const bf16_t* Bt; int M, N, K; };

struct StaticOrder {
    int nM, nN, nwg, G, c;
    __host__ __device__ void init(int M, int N, int G_, int c_) { nM = M / BM; nN = N / BM; nwg = nM * nN; G = G_; c = c_; }
    __host__ __device__ bool next(int i, Unit& u) const {
        const long L = (long)i * G + c; if (L >= nwg) return false;
        int wgid = (int)L; { const int q = nwg / NXCD, r = nwg % NXCD, xcd = wgid % NXCD, off = wgid / NXCD; wgid = (xcd < r ? xcd * (q + 1) : r * (q + 1) + (xcd - r) * q) + off; }
        const int nig = WGM * nN, gid = wgid / nig, fm = gid * WGM, gsz = (nM - fm) < WGM ? (nM - fm) : WGM;
        u.pm = fm + ((wgid % nig) % gsz); u.pn = (wgid % nig) / gsz; return true;
    }
    __device__ __forceinline__ void a_ready(const Unit&) const {}
    __device__ __forceinline__ void done(const Unit&) const {}
};
__device__ __forceinline__ unsigned cvt_pk_bf16(float lo, float hi) { unsigned r; asm volatile("v_cvt_pk_bf16_f32 %0, %1, %2" : "=v"(r) : "v"(lo), "v"(hi)); return r; }
template <class Epi, class Sched, bool STAMP = false>
__device__ __forceinline__ void gemm_phase(PG8_LAS unsigned char* lds, const Gemm g, const Sched& S, const Epi& E, unsigned long long* stamps) {
    int tid_l = threadIdx.x; asm volatile("" : "+v"(tid_l));
    const int tid = tid_l, wid = __builtin_amdgcn_readfirstlane(tid >> 6), lane = tid & 63, wr = wid >> 2, wc = wid & 3, fr = lane & 15, fq = lane >> 4;
    const int K = g.K, nt = K / BK;
    int ts_lo = 0, ts_hi = 0, nts = 0; const unsigned long long rt_entry = STAMP ? (unsigned long long)wall_clock64() : 0ull;
#define PG8_STAMP() do { if (STAMP && wid == 0 && nts < 64) { const unsigned long long _c = (unsigned long long)clock64(); \
        ts_lo = (lane == nts) ? (int)(unsigned)_c : ts_lo; ts_hi = (lane == nts) ? (int)(unsigned)(_c >> 32) : ts_hi; ++nts; } } while (0)
    PG8_STAMP();
    unsigned voffA[2], voffB[2];
#pragma unroll
    for (int i = 0; i < 2; ++i) { int R, C; stage_rc(tid * 16 + i * 8192, R, C); const int Rb = Epi::PERM ? ((R & ~31) + perm32(R & 31)) : R;
        voffA[i] = (unsigned)(R * K + C) * 2u; voffB[i] = (unsigned)(Rb * K + C) * 2u; }
    const size_t kstep = (size_t)(BK * 2);
    const size_t hstep = (size_t)HALF * K * 2;
    const size_t tstep = 2 * hstep;
    const unsigned ldsw = (unsigned)wid * 1024u;
    const int aoff = lds_byte(wr * 64 + fr, fq * 8), boff = lds_byte(wc * 32 + fr, fq * 8);
#define PG8_SA(b, h) (((b) * 2 + (h)) * HTB)
#define PG8_SB(b, h) ((4 + (b) * 2 + (h)) * HTB)
#define PG8_STAGE(bufoff, gbase, voff) do { _Pragma("unroll") for (int _i = 0; _i < 2; ++_i) \
        __builtin_amdgcn_global_load_lds((const unsigned*)((const char*)(gbase) + (voff)[_i]), (PG8_LAS unsigned*)(lds + (bufoff) + ldsw + _i * 8192), 16, 0, 0); } while (0)
#define PG8_LDA(dst, b, h) do { _Pragma("unroll") for (int m = 0; m < 4; ++m) _Pragma("unroll") for (int k = 0; k < 2; ++k) dst[m][k] = *(const PG8_LAS bf16x8*)(lds + PG8_SA(b, h) + aoff + m * 2048 + k * 1024); } while (0)
#define PG8_LDB(dst, b, h) do { _Pragma("unroll") for (int n = 0; n < 2; ++n) _Pragma("unroll") for (int k = 0; k < 2; ++k) dst[n][k] = *(const PG8_LAS bf16x8*)(lds + PG8_SB(b, h) + boff + n * 2048 + k * 1024); } while (0)
#define PG8_MMA(ai, bj, At, Bt) do { __builtin_amdgcn_s_setprio(1); _Pragma("unroll") for (int m = 0; m < 4; ++m) _Pragma("unroll") for (int n = 0; n < 2; ++n) _Pragma("unroll") for (int k = 0; k < 2; ++k) \
        acc[ai][bj][m][n] = __builtin_amdgcn_mfma_f32_16x16x32_bf16(Bt[n][k], At[m][k], acc[ai][bj][m][n], 0, 0, 0); __builtin_amdgcn_s_setprio(0); } while (0)
#define PG8_WAIT_V(n) asm volatile("s_waitcnt vmcnt(" #n ")" ::: "memory")
#define PG8_WAIT_L(n) asm volatile("s_waitcnt lgkmcnt(" #n ")" ::: "memory")
#define PG8_BAR __builtin_amdgcn_s_barrier()
#define PG8_SCHED __builtin_amdgcn_sched_barrier(0)
    Unit cur, nxt; int ui = 0;
    if (!S.next(0, cur)) return;
    f32x4 acc[2][2][4][2];
#pragma unroll
    for (int a = 0; a < 2; ++a)
#pragma unroll
        for (int b = 0; b < 2; ++b)
#pragma unroll
            for (int m = 0; m < 4; ++m)
#pragma unroll
                for (int n = 0; n < 2; ++n) acc[a][b][m][n] = (f32x4){0.f, 0.f, 0.f, 0.f};
    bf16x8 At[4][2], B0[2][2], B1[2][2];
    const char* cA = (const char*)g.A + (size_t)cur.pm * tstep; const char* cB = (const char*)g.Bt + (size_t)cur.pn * tstep;
    S.a_ready(cur);
    PG8_STAGE(PG8_SB(0, 0), cB, voffB); PG8_STAGE(PG8_SA(0, 0), cA, voffA); PG8_STAGE(PG8_SB(0, 1), cB + hstep, voffB); PG8_STAGE(PG8_SA(0, 1), cA + hstep, voffA);
    if (wr == 1) PG8_BAR;
    PG8_WAIT_V(4); PG8_BAR;
    PG8_STAGE(PG8_SB(1, 0), cB + kstep, voffB); PG8_STAGE(PG8_SA(1, 0), cA + kstep, voffA); PG8_STAGE(PG8_SB(1, 1), cB + hstep + kstep, voffB);
    PG8_WAIT_V(6); PG8_BAR;
    PG8_STAMP();
    for (;;) {
        const bool has_next = S.next(ui + 1, nxt);
        const char* nA = has_next ? (const char*)g.A + (size_t)nxt.pm * tstep : cA; const char* nB = has_next ? (const char*)g.Bt + (size_t)nxt.pn * tstep : cB;
        for (int t = 0; t < nt; t += 2) {
            const bool last = (t == nt - 2);
            const char* a1 = cA + (size_t)(t + 1) * kstep;
            const char* a2 = last ? nA : cA + (size_t)(t + 2) * kstep; const char* b2 = last ? nB : cB + (size_t)(t + 2) * kstep;
            const char* a3 = a2 + kstep; const char* b3 = b2 + kstep;
            if (last && has_next) S.a_ready(nxt);
            PG8_LDB(B0, 0, 0); PG8_SCHED; PG8_LDA(At, 0, 0); PG8_STAGE(PG8_SA(1, 1), a1 + hstep, voffA);
            PG8_WAIT_L(8); PG8_BAR; PG8_WAIT_L(0); PG8_MMA(0, 0, At, B0); PG8_BAR; PG8_SCHED;
            PG8_LDB(B1, 0, 1); PG8_STAGE(PG8_SB(0, 0), b2, voffB);
            PG8_BAR; PG8_WAIT_L(0); PG8_MMA(0, 1, At, B1); PG8_BAR;
            PG8_LDA(At, 0, 1); PG8_STAGE(PG8_SA(0, 0), a2, voffA);
            PG8_BAR; PG8_WAIT_L(0); PG8_MMA(1, 0, At, B0); PG8_BAR; PG8_SCHED;
            PG8_STAGE(PG8_SB(0, 1), b2 + hstep, voffB);
            PG8_WAIT_V(6); PG8_BAR; PG8_MMA(1, 1, At, B1); PG8_BAR;
            PG8_LDB(B0, 1, 0); PG8_SCHED; PG8_LDA(At, 1, 0); PG8_STAGE(PG8_SA(0, 1), a2 + hstep, voffA);
            PG8_WAIT_L(8); PG8_BAR; PG8_WAIT_L(0); PG8_MMA(0, 0, At, B0); PG8_BAR; PG8_SCHED;
            PG8_LDB(B1, 1, 1); PG8_STAGE(PG8_SB(1, 0), b3, voffB);
            PG8_BAR; PG8_WAIT_L(0); PG8_MMA(0, 1, At, B1); PG8_BAR;
            PG8_LDA(At, 1, 1); PG8_STAGE(PG8_SA(1, 0), a3, voffA);
            PG8_BAR; PG8_WAIT_L(0); PG8_MMA(1, 0, At, B0); PG8_BAR; PG8_SCHED;
            PG8_STAGE(PG8_SB(1, 1), b3 + hstep, voffB);
            PG8_WAIT_V(6); PG8_BAR; PG8_MMA(1, 1, At, B1); PG8_BAR;
        }
        PG8_STAMP();
        if constexpr (!Epi::AFTER_DRAIN) { if (wr == 0) PG8_BAR; E(acc, cur, wr, wc, fr, fq); S.done(cur); if (has_next) { if (wr == 1) PG8_BAR; } }
        PG8_STAMP();
        if (!has_next) break;
#pragma unroll
        for (int a = 0; a < 2; ++a)
#pragma unroll
            for (int b = 0; b < 2; ++b)
#pragma unroll
                for (int m = 0; m < 4; ++m)
#pragma unroll
                    for (int n = 0; n < 2; ++n) acc[a][b][m][n] = (f32x4){0.f, 0.f, 0.f, 0.f};
        cur = nxt; cA = nA; cB = nB; ++ui;
    }
    PG8_WAIT_V(0);
    if constexpr (Epi::AFTER_DRAIN) { if (wr == 0) PG8_BAR; }
    PG8_BAR;
    if constexpr (Epi::AFTER_DRAIN) { E.fused(acc, cur, wr, wc, fr, fq, lds, wid, lane); S.done(cur); }
    PG8_STAMP();
    if (STAMP && wid == 0) { stamps[lane] = lane < nts ? (((unsigned long long)(unsigned)ts_hi << 32) | (unsigned)ts_lo) : 0ull;
        if (lane == 62) stamps[62] = rt_entry; if (lane == 63) stamps[63] = (unsigned long long)wall_clock64(); }
#undef PG8_STAMP
#undef PG8_SA
#undef PG8_SB
#undef PG8_STAGE
#undef PG8_LDA
#undef PG8_LDB
#undef PG8_MMA
#undef PG8_WAIT_V
#undef PG8_WAIT_L
#undef PG8_BAR
#undef PG8_SCHED
}
}

#define LAS __attribute__((address_space(3)))
#define GAS __attribute__((address_space(1)))
typedef unsigned short bf16_t;
typedef short bf16x8 __attribute__((ext_vector_type(8)));
typedef float f32x4 __attribute__((ext_vector_type(4)));
typedef float f32x2 __attribute__((ext_vector_type(2)));
typedef float f32x16 __attribute__((ext_vector_type(16)));
typedef unsigned u32x4 __attribute__((ext_vector_type(4)));
typedef unsigned u32x2 __attribute__((ext_vector_type(2)));

constexpr int DM = 2048, NBATCH = 4, SEQ = 4096, MROWS = NBATCH * SEQ, NMETA = 16, DIN = 6144, DLRU = 1024, NHEAD = 16;
constexpr int META0 = MROWS;
constexpr int RSTR = MROWS + 64;
constexpr float RMS_EPS = 1e-6f;
constexpr int NPHASE = 7;
#ifndef REP_MASK
#define REP_MASK 0
#endif
constexpr int LDS_BYTES = 131072 + 256;

constexpr size_t MiB = 1u << 20;
constexpr size_t WS_WTIN = 0;
constexpr size_t WS_WTOUT = 48 * MiB;
constexpr size_t WS_GW = 64 * MiB;
constexpr size_t WS_ROWSS = 65 * MiB;
constexpr size_t WS_BAR = 65 * MiB + 512 * 1024;
constexpr size_t WS_PCNT = WS_BAR + 16384;
constexpr size_t WS_AGG = 66 * MiB;
constexpr size_t WS_XB = 71 * MiB;
constexpr size_t WS_Y = 136 * MiB;
constexpr size_t WS_U = 201 * MiB;
constexpr size_t WS_END = 396 * MiB;
constexpr int AGG_PER_LAYER = 257 * 1024;
static_assert(WS_U + (size_t)RSTR * DIN * 2 <= WS_END && WS_Y + (size_t)RSTR * DM * 2 <= WS_U && WS_XB + (size_t)RSTR * DM * 2 <= WS_Y, "ws map");
static_assert(WS_WTIN + (size_t)2 * DIN * DM * 2 <= WS_WTOUT && WS_WTOUT + (size_t)2 * DM * DM * 2 <= WS_GW && WS_AGG + (size_t)2 * AGG_PER_LAYER * 8 <= WS_XB && WS_ROWSS + (size_t)3 * RSTR * 4 <= WS_BAR, "ws map 2");

struct Args { const float* in[14]; float* out; unsigned char* ws; int ph_lo, ph_hi, flags, pad; };

__device__ __forceinline__ unsigned f2bf(float f) { unsigned u = __builtin_bit_cast(unsigned, f); return (u + 0x7fffu + ((u >> 16) & 1u)) >> 16; }
__device__ __forceinline__ unsigned pk2(float lo, float hi) { return f2bf(lo) | (f2bf(hi) << 16); }
__device__ __forceinline__ float bflo(unsigned w) { return __builtin_bit_cast(float, w << 16); }
__device__ __forceinline__ float bfhi(unsigned w) { return __builtin_bit_cast(float, w & 0xffff0000u); }
__device__ __forceinline__ float bf1(bf16_t v) { return __builtin_bit_cast(float, ((unsigned)v) << 16); }
__device__ __forceinline__ float sigmoidf_(float z) { return __builtin_amdgcn_rcpf(1.0f + __expf(-z)); }
__device__ __forceinline__ float wave_sum(float v) {
#pragma unroll
    for (int o = 1; o < 64; o <<= 1) v += __shfl_xor(v, o);
    return v;
}
#define LDS_WAIT() asm volatile("s_waitcnt lgkmcnt(0)" ::: "memory")

template <bool NORS> struct EpiUT {
    static constexpr bool PERM = true, AFTER_DRAIN = false;
    bf16_t* O; const float* rowss;
    __device__ __forceinline__ void operator()(const f32x4 (&acc)[2][2][4][2], const pg8::Unit& u, int wr, int wc, int fr, int fq) const {
        const int row0 = u.pm * 256 + wr * 64 + fr, col0 = u.pn * 256 + wc * 32 + 8 * fq;
        if (u.pn >= 8) {
            const int ch0 = 64 * (u.pn - 8) + 16 * wc + 4 * fq;
#pragma unroll
            for (int ai = 0; ai < 2; ++ai)
#pragma unroll
                for (int m = 0; m < 4; ++m) {
                    const int r = row0 + ai * 128 + m * 16;
                    const float rs = NORS ? 1.0f : rsqrtf(rowss[r] * (1.0f / DM) + RMS_EPS);
                    const f32x4 bv = acc[ai][0][m][0] * rs, cv = acc[ai][0][m][1] * rs, xv = acc[ai][1][m][0] * rs, gv = acc[ai][1][m][1] * rs;
                    u32x4 w;
#pragma unroll
                    for (int i = 0; i < 4; ++i) w[i] = pg8::cvt_pk_bf16(bv[i] * gv[i] * sigmoidf_(gv[i]), cv[i] * xv[i]);
                    *(u32x4*)(O + (size_t)r * DIN + 2048 + 2 * ch0) = w;
                }
            return;
        }
#pragma unroll
        for (int ai = 0; ai < 2; ++ai)
#pragma unroll
            for (int m = 0; m < 4; ++m) {
                const int r = row0 + ai * 128 + m * 16;
                const float rs = NORS ? 1.0f : rsqrtf(rowss[r] * (1.0f / DM) + RMS_EPS);
                bf16_t* rowp = O + (size_t)r * DIN + col0;
#pragma unroll
                for (int bj = 0; bj < 2; ++bj) {
                    const f32x4 v0 = acc[ai][bj][m][0] * rs, v1 = acc[ai][bj][m][1] * rs;
                    u32x4 w; w.x = pg8::cvt_pk_bf16(v0[0], v0[1]); w.y = pg8::cvt_pk_bf16(v0[2], v0[3]); w.z = pg8::cvt_pk_bf16(v1[0], v1[1]); w.w = pg8::cvt_pk_bf16(v1[2], v1[3]);
                    *(u32x4*)(rowp + bj * 128) = w;
                }
            }
    }
};
struct EpiNull {
    static constexpr bool PERM = true, AFTER_DRAIN = false;
    float* sink;
    __device__ __forceinline__ void operator()(const f32x4 (&acc)[2][2][4][2], const pg8::Unit& u, int wr, int wc, int fr, int fq) const {
        f32x4 s = {0.f, 0.f, 0.f, 0.f};
#pragma unroll
        for (int ai = 0; ai < 2; ++ai)
#pragma unroll
            for (int bj = 0; bj < 2; ++bj)
#pragma unroll
                for (int m = 0; m < 4; ++m) { s += acc[ai][bj][m][0]; s += acc[ai][bj][m][1]; }
        if (s[0] + s[1] + s[2] + s[3] == 1.2345678e33f) sink[u.pm] = s[0];
    }
};
typedef EpiUT<false> EpiU;
#ifndef EPI_MB
#define EPI_MB 2
#endif
struct EpiRes {
    static constexpr bool PERM = true, AFTER_DRAIN = false;
    const float* res; float* out; bf16_t* xb; float* rowss;
    __device__ __forceinline__ void operator()(const f32x4 (&acc)[2][2][4][2], const pg8::Unit& u, int wr, int wc, int fr, int fq) const {
        const int row0 = u.pm * 256 + wr * 64 + fr, col0 = u.pn * 256 + wc * 32 + 8 * fq;
#pragma unroll
        for (int ai = 0; ai < 2; ++ai) {
#pragma unroll
          for (int mh = 0; mh < 4; mh += EPI_MB) {
            f32x4 rv[4][2][2];
#pragma unroll
            for (int m = mh; m < mh + EPI_MB; ++m)
#pragma unroll
                for (int bj = 0; bj < 2; ++bj) { const float* p = res + (size_t)(row0 + ai * 128 + m * 16) * DM + col0 + bj * 128; rv[m][bj][0] = *(const f32x4*)p; rv[m][bj][1] = *(const f32x4*)(p + 4); }
            asm volatile("" ::: "memory");
#pragma unroll
            for (int m = mh; m < mh + EPI_MB; ++m) {
                const int r = row0 + ai * 128 + m * 16; const size_t off = (size_t)r * DM + col0; float ss = 0.f;
#pragma unroll
                for (int bj = 0; bj < 2; ++bj) {
                    const f32x4 h0 = rv[m][bj][0] + acc[ai][bj][m][0], h1 = rv[m][bj][1] + acc[ai][bj][m][1];
                    if (out) { *(f32x4*)(out + off + bj * 128) = h0; *(f32x4*)(out + off + bj * 128 + 4) = h1; }
                    if (xb) { u32x4 w; w.x = pg8::cvt_pk_bf16(h0[0], h0[1]); w.y = pg8::cvt_pk_bf16(h0[2], h0[3]); w.z = pg8::cvt_pk_bf16(h1[0], h1[1]); w.w = pg8::cvt_pk_bf16(h1[2], h1[3]);
                        *(u32x4*)(xb + off + bj * 128) = w; }
                    ss += (h0[0] * h0[0] + h0[1] * h0[1]) + (h0[2] * h0[2] + h0[3] * h0[3]) + (h1[0] * h1[0] + h1[1] * h1[1]) + (h1[2] * h1[2] + h1[3] * h1[3]);
                }
                ss += __shfl_xor(ss, 16); ss += __shfl_xor(ss, 32);
                if (fq == 0) unsafeAtomicAdd(rowss + r, ss);
            }
            asm volatile("" ::: "memory");
          }
        }
    }
};

struct EpiResNorm {
    static constexpr bool PERM = true, AFTER_DRAIN = false;
    const bf16_t* res; float* out; float* rowss; unsigned* cnt; const float* fg;
    __device__ __forceinline__ void operator()(f32x4 (&acc)[2][2][4][2], const pg8::Unit& u, int wr, int wc, int fr, int fq) const {
        const int row0 = u.pm * 256 + wr * 64 + fr, col0 = u.pn * 256 + wc * 32 + 8 * fq;
#pragma unroll
        for (int ai = 0; ai < 2; ++ai) {
#pragma unroll
          for (int mh = 0; mh < 4; mh += EPI_MB) {
            u32x4 rw[4][2];
#pragma unroll
            for (int m = mh; m < mh + EPI_MB; ++m)
#pragma unroll
                for (int bj = 0; bj < 2; ++bj) rw[m][bj] = *(const u32x4*)(res + (size_t)(row0 + ai * 128 + m * 16) * DM + col0 + bj * 128);
            asm volatile("" ::: "memory");
#pragma unroll
            for (int m = mh; m < mh + EPI_MB; ++m) {
                float ss = 0.f;
#pragma unroll
                for (int bj = 0; bj < 2; ++bj) {
                    const u32x4 w = rw[m][bj];
                    const f32x4 h0 = (f32x4){bflo(w.x), bfhi(w.x), bflo(w.y), bfhi(w.y)} + acc[ai][bj][m][0], h1 = (f32x4){bflo(w.z), bfhi(w.z), bflo(w.w), bfhi(w.w)} + acc[ai][bj][m][1];
                    acc[ai][bj][m][0] = h0; acc[ai][bj][m][1] = h1;
                    ss += (h0[0] * h0[0] + h0[1] * h0[1]) + (h0[2] * h0[2] + h0[3] * h0[3]) + (h1[0] * h1[0] + h1[1] * h1[1]) + (h1[2] * h1[2] + h1[3] * h1[3]);
                }
                ss += __shfl_xor(ss, 16); ss += __shfl_xor(ss, 32);
                if (fq == 0) unsafeAtomicAdd(rowss + row0 + ai * 128 + m * 16, ss);
            }
            asm volatile("" ::: "memory");
          }
        }
        asm volatile("s_waitcnt vmcnt(0)" ::: "memory");
        unsigned* cw = cnt + 64 * (2 * u.pm + wr);
        if (fr == 0 && fq == 0) __hip_atomic_fetch_add(cw, 1u, __ATOMIC_RELAXED, __HIP_MEMORY_SCOPE_AGENT);
        f32x4 gv[2][2];
#pragma unroll
        for (int bj = 0; bj < 2; ++bj) { gv[bj][0] = *(const f32x4*)(fg + col0 + bj * 128); gv[bj][1] = *(const f32x4*)(fg + col0 + bj * 128 + 4); }
        { unsigned sp = 0;
          while ((unsigned)__builtin_amdgcn_readfirstlane(__hip_atomic_load(cw, __ATOMIC_RELAXED, __HIP_MEMORY_SCOPE_AGENT)) < 32u) { __builtin_amdgcn_s_sleep(1); if (++sp > (1u << 16)) break; } }
        asm volatile("" ::: "memory");
#pragma unroll
        for (int ai = 0; ai < 2; ++ai)
#pragma unroll
            for (int m = 0; m < 4; ++m) {
                const int r = row0 + ai * 128 + m * 16;
                const float rs = rsqrtf(__hip_atomic_load(rowss + r, __ATOMIC_RELAXED, __HIP_MEMORY_SCOPE_AGENT) * (1.0f / DM) + RMS_EPS);
                float* op = out + (size_t)r * DM + col0;
#pragma unroll
                for (int bj = 0; bj < 2; ++bj) { *(f32x4*)(op + bj * 128) = acc[ai][bj][m][0] * rs * gv[bj][0]; *(f32x4*)(op + bj * 128 + 4) = acc[ai][bj][m][1] * rs * gv[bj][1]; }
            }
    }
};
struct PanelOrder {
    int Gp, v;
    __device__ void init(int G, int c) { Gp = G & ~7; v = c; if ((Gp & 63) == 0) v = (c & 7) * (Gp >> 3) + (c >> 3); if (c >= Gp) v = -1; }
    __device__ bool next(int i, pg8::Unit& u) const { if (v < 0) return false; const long L = (long)i * Gp + v; if (L >= 64 * 8) return false; u.pm = (int)(L >> 3); u.pn = (int)(L & 7); return true; }
    __device__ __forceinline__ void a_ready(const pg8::Unit&) const {}
    __device__ __forceinline__ void done(const pg8::Unit&) const {}
};

template <class F> __device__ __forceinline__ void meta_gemm(const bf16_t* A, const bf16_t* Bt, int ngroups, LAS unsigned char* lds, int wid, int lane, F epi) {
    const int fr = lane & 15, fq = lane >> 4, half = wid >> 2, wq = wid & 3;
    LAS f32x4* red = (LAS f32x4*)lds;
    for (int p = blockIdx.x; 2 * p < ngroups; p += gridDim.x) {
        const int g = 2 * p + half;
        f32x4 acc = {0.f, 0.f, 0.f, 0.f};
        if (g < ngroups) {
            const bf16_t* ap = A + (size_t)fr * DM + wq * 512 + fq * 8;
            const bf16_t* bp = Bt + (size_t)(g * 16 + fr) * DM + wq * 512 + fq * 8;
            bf16x8 av[16], bv[16];
#pragma unroll
            for (int s = 0; s < 16; ++s) { av[s] = *(const bf16x8*)(ap + 32 * s); bv[s] = *(const bf16x8*)(bp + 32 * s); }
#pragma unroll
            for (int s = 0; s < 16; ++s) acc = __builtin_amdgcn_mfma_f32_16x16x32_bf16(bv[s], av[s], acc, 0, 0, 0);
        }
        red[wid * 64 + lane] = acc;
        __syncthreads();
        if (wq == 0 && g < ngroups) {
            f32x4 s = red[wid * 64 + lane];
#pragma unroll
            for (int w = 1; w < 4; ++w) s += red[(wid + w) * 64 + lane];
            epi(fr, g * 16 + 4 * fq, s);
        }
        __syncthreads();
    }
}

__host__ __device__ __forceinline__ int in_col(int p) {
    if (p < 2048) return p;
    const int c = p & 255, j = (p >> 8) - 8, g = 2 * (c >> 7) + ((c >> 2) & 1), k = 16 * ((c >> 5) & 3) + 4 * ((c >> 3) & 3) + (c & 3);
    return 2048 + 1024 * g + 64 * j + k;
}
template <bool COLMAP> __device__ __forceinline__ void tr_item(const float* W, int K, int N, bf16_t* WT, const float* sc, LAS unsigned char* scr, int item, int lane) {
    const int nblk = N / 64, kb = item / nblk, nb = item % nblk, k0 = 64 * kb, n0 = 64 * nb;
    const int kr = lane >> 4, nc = (lane & 15) * 4;
    f32x4 v[16]; float g[16];
    { const float* p = W + (size_t)(k0 + kr) * N + (COLMAP ? in_col(n0 + nc) : n0 + nc);
#pragma unroll
      for (int i = 0; i < 16; ++i) { v[i] = *(const f32x4*)p; p += (size_t)4 * N; }
#pragma unroll
      for (int i = 0; i < 16; ++i) g[i] = sc ? sc[k0 + kr + 4 * i] : 1.0f; }
    asm volatile("" ::: "memory");
#pragma unroll
    for (int i = 0; i < 16; ++i) { const f32x4 s = v[i] * g[i]; u32x2 w; w.x = pg8::cvt_pk_bf16(s[0], s[1]); w.y = pg8::cvt_pk_bf16(s[2], s[3]);
        *(LAS u32x2*)(scr + (kr + 4 * i) * 136 + nc * 2) = w; }
    LDS_WAIT();
    const int c = lane & 7;
#pragma unroll
    for (int j = 0; j < 8; ++j) { const int n = (lane >> 3) + 8 * j; const LAS bf16_t* s = (const LAS bf16_t*)(scr + (8 * c) * 136 + n * 2);
        u32x4 o; o.x = (unsigned)s[0] | ((unsigned)s[68] << 16); o.y = (unsigned)s[2 * 68] | ((unsigned)s[3 * 68] << 16); o.z = (unsigned)s[4 * 68] | ((unsigned)s[5 * 68] << 16); o.w = (unsigned)s[6 * 68] | ((unsigned)s[7 * 68] << 16);
        *(u32x4*)(WT + (size_t)(n0 + n) * K + k0 + 8 * c) = o; }
    LDS_WAIT();
}
__device__ __forceinline__ void cvt_row(const float* src, bf16_t* dst, float* ss, int lane) {
    const f32x4* xr = (const f32x4*)src + lane; f32x4 v[8]; float s = 0.f;
#pragma unroll
    for (int j = 0; j < 8; ++j) { v[j] = xr[64 * j]; s += (v[j].x * v[j].x + v[j].y * v[j].y) + (v[j].z * v[j].z + v[j].w * v[j].w); }
    s = wave_sum(s);
    u32x2* o8 = (u32x2*)dst + lane;
#pragma unroll
    for (int j = 0; j < 8; ++j) { u32x2 w; w.x = pk2(v[j].x, v[j].y); w.y = pk2(v[j].z, v[j].w); o8[64 * j] = w; }
    if (lane == 0) *ss = s;
}

struct Mix {
    const float *conv_a_w, *conv_a_b, *lru_br, *lru_bi, *lru_lambda, *conv_b_w;
    const bf16_t* gw;
    bf16_t* U; bf16_t* Y; unsigned long long* AGG;
};
struct ItemId { int hd, b, c, row0, ntok, agg; bool meta; };
__device__ __forceinline__ ItemId decode_item(int id) {
    ItemId I;
    if (id < 16) { I.meta = true; I.hd = id; I.b = 0; I.c = 0; I.row0 = META0; I.ntok = 16; I.agg = 256; }
    else { const int j = id - 16; I.meta = false; I.hd = j & 15; I.c = (j >> 4) & 63; I.b = j >> 10; I.row0 = I.b * SEQ + I.c * 64; I.ntok = 64; I.agg = I.b * 64 + I.c; }
    return I;
}
constexpr int N_ITEMS = 16 + NBATCH * NHEAD * 64;

__device__ __forceinline__ bool agg_ok(unsigned long long v) { return (unsigned)v != 0u; }
template <bool META> __device__ __forceinline__ void mix_item(const Mix& X, int id, LAS unsigned char* xt, int lane) {
    constexpr int NT = META ? 16 : 64, NTB = META ? 1 : 2, NQ = META ? 2 : 4;
    constexpr float LOG2E = 1.4426950408889634f;
    const ItemId I = decode_item(id);
    const int ch = I.hd * 64 + lane;
    const float nls2 = -8.0f * LOG2E * log1pf(__expf(-X.lru_lambda[ch]));
    bf16_t raw[NT], rh0 = 0, rh1 = 0, rh2 = 0;
    const float w0 = X.conv_a_w[ch], w1 = X.conv_a_w[1024 + ch], w2 = X.conv_a_w[2048 + ch], w3 = X.conv_a_w[3072 + ch], cb = X.conv_a_b[ch];
    {
        const GAS bf16_t* sb = (const GAS bf16_t*)(X.U + (size_t)I.row0 * DIN + I.hd * 64);
        if (!META) { const GAS bf16_t* hp0 = (I.c == 0) ? (const GAS bf16_t*)(X.U + (size_t)(META0 + 13) * DIN + I.hd * 64) : sb - 3 * DIN; rh0 = hp0[lane]; rh1 = hp0[DIN + lane]; rh2 = hp0[2 * DIN + lane]; }
#pragma unroll
        for (int t = 0; t < NT; ++t) { raw[t] = sb[lane]; sb += DIN; asm volatile("" : "+s"(sb)); }
    }
    bf16x8 BfR0[4], BfR1[4], BfI0[4], BfI1[4];
    { const bf16_t* gr = X.gw + (size_t)(I.hd * 64 + (lane & 31)) * 64 + 8 * (lane >> 5); const bf16_t* gi = gr + 16 * 64 * 64;
#pragma unroll
      for (int s = 0; s < 4; ++s) { BfR0[s] = *(const bf16x8*)(gr + 16 * s); BfR1[s] = *(const bf16x8*)(gr + 32 * 64 + 16 * s); BfI0[s] = *(const bf16x8*)(gi + 16 * s); BfI1[s] = *(const bf16x8*)(gi + 32 * 64 + 16 * s); } }
    asm volatile("" ::: "memory");
    float xm3 = bf1(rh0), xm2 = bf1(rh1), xm1 = bf1(rh2);
#pragma unroll
    for (int t = 0; t < NT; ++t) { const float x0 = bf1(raw[t]); const float xc = cb + w0 * xm3 + w1 * xm2 + w2 * xm1 + w3 * x0; xm3 = xm2; xm2 = xm1; xm1 = x0;
        *(LAS bf16_t*)(xt + t * 144 + lane * 2) = (bf16_t)f2bf(xc); }
    const float brA = X.lru_br[I.hd * 64 + (lane & 31)], brB = X.lru_br[I.hd * 64 + 32 + (lane & 31)], biA = X.lru_bi[I.hd * 64 + (lane & 31)], biB = X.lru_bi[I.hd * 64 + 32 + (lane & 31)];
    float h = 0.f, P = 1.f;
    unsigned hp[NT];
#pragma unroll
    for (int tb = 0; tb < NTB; ++tb) {
        f32x16 aR0, aR1, aI0, aI1;
#pragma unroll
        for (int e = 0; e < 16; ++e) { aR0[e] = brA; aR1[e] = brB; aI0[e] = biA; aI1[e] = biB; }
#pragma unroll
        for (int s = 0; s < 4; ++s) {
            const bf16x8 af = *(const LAS bf16x8*)(xt + (tb * 32 + (lane & 31)) * 144 + (16 * s + 8 * (lane >> 5)) * 2);
            aR0 = __builtin_amdgcn_mfma_f32_32x32x16_bf16(af, BfR0[s], aR0, 0, 0, 0);
            aR1 = __builtin_amdgcn_mfma_f32_32x32x16_bf16(af, BfR1[s], aR1, 0, 0, 0);
            aI0 = __builtin_amdgcn_mfma_f32_32x32x16_bf16(af, BfI0[s], aI0, 0, 0, 0);
            aI1 = __builtin_amdgcn_mfma_f32_32x32x16_bf16(af, BfI1[s], aI1, 0, 0, 0);
        }
#pragma unroll
        for (int q = 0; q < NQ; ++q) {
            float Rv[2][4], Iv[2][4];
#pragma unroll
            for (int k = 0; k < 4; ++k) {
                const int reg = 4 * q + k;
                const float r0f = aR0[reg], r1f = aR1[reg], i0f = aI0[reg], i1f = aI1[reg];
                auto r = __builtin_amdgcn_permlane32_swap(__float_as_uint(r0f), __float_as_uint(r1f), false, false);
                Rv[0][k] = __uint_as_float(r[0]); Rv[1][k] = __uint_as_float(r[1]);
                auto i2 = __builtin_amdgcn_permlane32_swap(__float_as_uint(i0f), __float_as_uint(i1f), false, false);
                Iv[0][k] = __uint_as_float(i2[0]); Iv[1][k] = __uint_as_float(i2[1]);
            }
#pragma unroll
            for (int st = 0; st < 2; ++st)
#pragma unroll
                for (int p = 0; p < 2; ++p) {
                    const int t = tb * 32 + 8 * q + 4 * st + 2 * p;
                    f32x2 er = (f32x2){Rv[st][2 * p], Rv[st][2 * p + 1]} * (-LOG2E), ei = (f32x2){Iv[st][2 * p], Iv[st][2 * p + 1]} * (-LOG2E);
                    er.x = __builtin_amdgcn_exp2f(er.x); er.y = __builtin_amdgcn_exp2f(er.y); ei.x = __builtin_amdgcn_exp2f(ei.x); ei.y = __builtin_amdgcn_exp2f(ei.y);
                    er = er + 1.0f; ei = ei + 1.0f;
                    f32x2 rg, ig; rg.x = __builtin_amdgcn_rcpf(er.x); rg.y = __builtin_amdgcn_rcpf(er.y); ig.x = __builtin_amdgcn_rcpf(ei.x); ig.y = __builtin_amdgcn_rcpf(ei.y);
                    const f32x2 l2 = rg * nls2;
                    f32x2 a; a.x = __builtin_amdgcn_exp2f(l2.x); a.y = __builtin_amdgcn_exp2f(l2.y);
                    f32x2 om = 1.0f - a * a; om.x = fmaxf(om.x, 0.f); om.y = fmaxf(om.y, 0.f);
                    f32x2 mu; mu.x = __builtin_amdgcn_sqrtf(om.x); mu.y = __builtin_amdgcn_sqrtf(om.y);
                    const f32x2 xc = (f32x2){bf1(*(const LAS bf16_t*)(xt + t * 144 + lane * 2)), bf1(*(const LAS bf16_t*)(xt + (t + 1) * 144 + lane * 2))};
                    const f32x2 bb = mu * ig * xc;
                    h = a.x * h + bb.x; P = P * a.x; hp[t] = pg8::cvt_pk_bf16(h, P);
                    h = a.y * h + bb.y; P = P * a.y; hp[t + 1] = pg8::cvt_pk_bf16(h, P);
                }
        }
    }
    __hip_atomic_store(X.AGG + (size_t)I.agg * 1024 + ch, ((unsigned long long)__float_as_uint(h) << 32) | (unsigned long long)__float_as_uint(P), __ATOMIC_RELAXED, __HIP_MEMORY_SCOPE_AGENT);
    asm volatile("" ::: "memory");
    bf16_t graw[NT];
    { const GAS bf16_t* sb = (const GAS bf16_t*)(X.U + (size_t)I.row0 * DIN + 1024 + I.hd * 64);
#pragma unroll
      for (int t = 0; t < NT; ++t) { graw[t] = sb[lane]; sb += DIN; asm volatile("" : "+s"(sb)); } }
    float hin = 0.f;
    if (!META) {
        { const unsigned long long* mp = X.AGG + (size_t)256 * 1024 + ch; unsigned long long v;
          for (;;) { v = __hip_atomic_load(mp, __ATOMIC_RELAXED, __HIP_MEMORY_SCOPE_AGENT); if (!__any(!agg_ok(v))) break; __builtin_amdgcn_s_sleep(2); }
          hin = __uint_as_float((unsigned)(v >> 32)); }
        const unsigned long long* ap = X.AGG + (size_t)(I.b * 64) * 1024 + ch;
        for (int j0 = 0; j0 < I.c; j0 += 16) {
            unsigned long long v[16];
            for (;;) {
                bool bad = false;
#pragma unroll
                for (int k = 0; k < 16; ++k) { v[k] = (j0 + k < I.c) ? __hip_atomic_load(ap + (size_t)(j0 + k) * 1024, __ATOMIC_RELAXED, __HIP_MEMORY_SCOPE_AGENT) : 0x000000003f800000ull; }
#pragma unroll
                for (int k = 0; k < 16; ++k) bad |= !agg_ok(v[k]);
                if (!__any(bad)) break;
                __builtin_amdgcn_s_sleep(2);
            }
#pragma unroll
            for (int k = 0; k < 16; ++k) hin = __uint_as_float((unsigned)v[k]) * hin + __uint_as_float((unsigned)(v[k] >> 32));
        }
    }
    asm volatile("" ::: "memory");
    GAS bf16_t* yp = (GAS bf16_t*)(X.Y + (size_t)I.row0 * DM + I.hd * 64);
#pragma unroll
    for (int t0 = 0; t0 < NT; t0 += 16) {
        {
#pragma unroll
            for (int k = 0; k < 16; k += 2) {
                const unsigned w0 = hp[t0 + k], w1 = hp[t0 + k + 1];
                const f32x2 gg = (f32x2){bf1(graw[t0 + k]), bf1(graw[t0 + k + 1])};
                f32x2 e = gg * (-LOG2E); e.x = __builtin_amdgcn_exp2f(e.x); e.y = __builtin_amdgcn_exp2f(e.y); e = e + 1.0f;
                f32x2 sg; sg.x = __builtin_amdgcn_rcpf(e.x); sg.y = __builtin_amdgcn_rcpf(e.y);
                const f32x2 hv = (f32x2){bflo(w0), bflo(w1)} + (f32x2){bfhi(w0), bfhi(w1)} * hin;
                const f32x2 y = hv * gg * sg;
                const unsigned pk = pg8::cvt_pk_bf16(y.x, y.y);
                yp[lane] = (bf16_t)(pk & 0xffffu); yp[DM + lane] = (bf16_t)(pk >> 16); yp += 2 * DM; asm volatile("" : "+s"(yp));
            }
        }
    }
}

__device__ __forceinline__ void ld8(const bf16_t* p, float (&o)[8]) {
    const u32x4 w = *(const u32x4*)p;
    o[0] = bflo(w.x); o[1] = bfhi(w.x); o[2] = bflo(w.y); o[3] = bfhi(w.y); o[4] = bflo(w.z); o[5] = bfhi(w.z); o[6] = bflo(w.w); o[7] = bfhi(w.w);
}
__device__ __forceinline__ void partb(const Mix& X, int tid) {
    for (int it = blockIdx.x * 512 + tid; it < 1025 * 128; it += gridDim.x * 512) {
        const int c0 = (it & 127) * 8, run = it >> 7;
        float w0[8], w1[8], w2[8], cm2[8], cm1[8];
        { const f32x4* p = (const f32x4*)(X.conv_b_w + c0); const f32x4 a0 = p[0], a1 = p[1], b0 = p[256], b1 = p[257], d0 = p[512], d1 = p[513];
#pragma unroll
          for (int e = 0; e < 4; ++e) { w0[e] = a0[e]; w0[4 + e] = a1[e]; w1[e] = b0[e]; w1[4 + e] = b1[e]; w2[e] = d0[e]; w2[4 + e] = d1[e]; } }
        if (run == 1024) {
#pragma unroll
            for (int e = 0; e < 8; ++e) { cm2[e] = 0.f; cm1[e] = 0.f; }
            const bf16_t* up = X.U + (size_t)META0 * DIN + c0; bf16_t* yp = X.Y + (size_t)META0 * DM + 1024 + c0;
#pragma unroll 4
            for (int t = 0; t < 16; ++t) {
                float bv[8], cv[8], xv[8], gv[8];
                ld8(up + (size_t)t * DIN + 2048, bv); ld8(up + (size_t)t * DIN + 3072, cv); ld8(up + (size_t)t * DIN + 4096, xv); ld8(up + (size_t)t * DIN + 5120, gv);
                float o[8];
#pragma unroll
                for (int e = 0; e < 8; ++e) { const float cx = cv[e] * xv[e]; const float y = w0[e] * cm2[e] + w1[e] * cm1[e] + w2[e] * cx; o[e] = bv[e] * y * (gv[e] * sigmoidf_(gv[e])); cm2[e] = cm1[e]; cm1[e] = cx; }
                u32x4 w; w.x = pk2(o[0], o[1]); w.y = pk2(o[2], o[3]); w.z = pk2(o[4], o[5]); w.w = pk2(o[6], o[7]);
                *(u32x4*)(yp + (size_t)t * DM) = w;
            }
            continue;
        }
        const int row0 = run * 16;
        const bf16_t* vp = X.U + (size_t)row0 * DIN + 2048 + 2 * c0;
        bf16_t* yp = X.Y + (size_t)row0 * DM + 1024 + c0;
        u32x4 q[16][2];
#pragma unroll
        for (int t = 0; t < 16; ++t) { q[t][0] = *(const u32x4*)(vp + (size_t)t * DIN); q[t][1] = *(const u32x4*)(vp + (size_t)t * DIN + 8); }
        if ((row0 & (SEQ - 1)) == 0) {
            float c[8], x[8];
            ld8(X.U + (size_t)(META0 + 14) * DIN + 3072 + c0, c); ld8(X.U + (size_t)(META0 + 14) * DIN + 4096 + c0, x);
#pragma unroll
            for (int e = 0; e < 8; ++e) cm2[e] = c[e] * x[e];
            ld8(X.U + (size_t)(META0 + 15) * DIN + 3072 + c0, c); ld8(X.U + (size_t)(META0 + 15) * DIN + 4096 + c0, x);
#pragma unroll
            for (int e = 0; e < 8; ++e) cm1[e] = c[e] * x[e];
        } else {
            const u32x4* p2 = (const u32x4*)(X.U + (size_t)(row0 - 2) * DIN + 2048 + 2 * c0); const u32x4* p1 = (const u32x4*)(X.U + (size_t)(row0 - 1) * DIN + 2048 + 2 * c0);
            const u32x4 a0 = p2[0], a1 = p2[1], b0 = p1[0], b1 = p1[1];
#pragma unroll
            for (int e = 0; e < 4; ++e) { cm2[e] = bfhi(a0[e]); cm2[4 + e] = bfhi(a1[e]); cm1[e] = bfhi(b0[e]); cm1[4 + e] = bfhi(b1[e]); }
        }
#pragma unroll
        for (int t = 0; t < 16; ++t) {
            float o[8];
#pragma unroll
            for (int e = 0; e < 8; ++e) { const unsigned qq = e < 4 ? q[t][0][e & 3] : q[t][1][e & 3]; const float bg = bflo(qq), cx = bfhi(qq);
                o[e] = bg * (w0[e] * cm2[e] + w1[e] * cm1[e] + w2[e] * cx); cm2[e] = cm1[e]; cm1[e] = cx; }
            u32x4 w; w.x = pk2(o[0], o[1]); w.y = pk2(o[2], o[3]); w.z = pk2(o[4], o[5]); w.w = pk2(o[6], o[7]);
            *(u32x4*)(yp + (size_t)t * DM) = w;
        }
    }
}


#ifdef DEBUG_NAIVE_MIX
__global__ void __launch_bounds__(64) naive_mixA(Mix X, const float* wr, const float* wi) {
    const int b = blockIdx.x / 16, hd = blockIdx.x % 16, lane = threadIdx.x, ch = hd * 64 + lane;
    __shared__ float xs[64];
    const float w0 = X.conv_a_w[ch], w1 = X.conv_a_w[1024 + ch], w2 = X.conv_a_w[2048 + ch], w3 = X.conv_a_w[3072 + ch], cb = X.conv_a_b[ch];
    const float br = X.lru_br[ch], bi = X.lru_bi[ch];
    const float sp = log1pf(expf(-X.lru_lambda[ch]));
    const float* wrh = wr + (size_t)hd * 4096 + lane; const float* wih = wi + (size_t)hd * 4096 + lane;
    float h = 0.f, xm3 = 0.f, xm2 = 0.f, xm1 = 0.f;
    for (int p = 0; p < NMETA + SEQ; ++p) {
        const int row = p < NMETA ? META0 + p : b * SEQ + (p - NMETA);
        const float x0 = bf1(X.U[(size_t)row * DIN + ch]);
        const float xc = cb + w0 * xm3 + w1 * xm2 + w2 * xm1 + w3 * x0; xm3 = xm2; xm2 = xm1; xm1 = x0;
        xs[lane] = xc; __syncthreads();
        float rp = br, ip = bi;
#pragma unroll 4
        for (int i = 0; i < 64; ++i) { rp += xs[i] * wrh[i * 64]; ip += xs[i] * wih[i * 64]; }
        __syncthreads();
        const float r = 1.f / (1.f + expf(-rp)), ig = 1.f / (1.f + expf(-ip));
        const float la = -8.f * r * sp; const float a = expf(la); const float bb = sqrtf(-expm1f(2.f * la)) * (ig * xc);
        h = a * h + bb;
        const float g = bf1(X.U[(size_t)row * DIN + 1024 + ch]);
        const float y = h * g / (1.f + expf(-g));
        if (p >= NMETA || b == 0) X.Y[(size_t)row * DM + ch] = (bf16_t)f2bf(y);
    }
}
__global__ void naive_mixB(Mix X) {
    for (size_t idx = (size_t)blockIdx.x * blockDim.x + threadIdx.x; idx < (size_t)(MROWS + NMETA) * 1024; idx += (size_t)gridDim.x * blockDim.x) {
        const int row = (int)(idx >> 10), c = (int)(idx & 1023);
        int r1, r2;
        if (row >= META0) { const int p = row - META0; r1 = p >= 1 ? row - 1 : -1; r2 = p >= 2 ? row - 2 : -1; }
        else { const int t = row & (SEQ - 1); r1 = t >= 1 ? row - 1 : META0 + 15; r2 = t >= 2 ? row - 2 : META0 + 14 + t; }
        auto cx = [&](int r) -> float { return r < 0 ? 0.f : bf1(X.U[(size_t)r * DIN + 3072 + c]) * bf1(X.U[(size_t)r * DIN + 4096 + c]); };
        const float y = X.conv_b_w[c] * cx(r2) + X.conv_b_w[1024 + c] * cx(r1) + X.conv_b_w[2048 + c] * cx(row);
        const float bv = bf1(X.U[(size_t)row * DIN + 2048 + c]), g = bf1(X.U[(size_t)row * DIN + 5120 + c]);
        X.Y[(size_t)row * DM + 1024 + c] = (bf16_t)f2bf(bv * y * g / (1.f + expf(-g)));
    }
}
#endif
#define XB_TMO      128
#define XB_XCNT(j)  (256  + 64 * (j))
#define XB_XSUB(j)  (1280 + 64 * (j))
#define XB_XGEN(j)  (2304 + 64 * (j))
#define XB_TOP      3328
#define XB_TOPGEN   3392
#define XCD_BAR_WORDS 3456
#define XB_SPIN_CAP (1u << 18)

__device__ __forceinline__ unsigned xb_ld(unsigned* p)              { return __hip_atomic_load(p, __ATOMIC_RELAXED, __HIP_MEMORY_SCOPE_AGENT); }
__device__ __forceinline__ unsigned xb_add(unsigned* p, unsigned v) { return __hip_atomic_fetch_add(p, v, __ATOMIC_RELAXED, __HIP_MEMORY_SCOPE_AGENT); }
__device__ __forceinline__ unsigned xb_xcc_id() { return (unsigned)__builtin_amdgcn_s_getreg((3 << 11) | 20) & 0xFu; }
#define XB_SPIN(cond, bar) do { unsigned _sp = 0; while (cond) { __builtin_amdgcn_s_sleep(1); \
    if ((++_sp & 255u) == 0u) { if (xb_ld(&(bar)[XB_TMO])) break; if (_sp > XB_SPIN_CAP) { atomicAdd(&(bar)[XB_TMO], 1u); break; } } } } while (0)

struct XcdBarrier {
    unsigned* bar; unsigned x;
    volatile LAS unsigned* st;
};

__device__ __forceinline__ XcdBarrier xcd_barrier_post(unsigned* bar, volatile LAS unsigned* st) {
    XcdBarrier b; b.bar = bar; b.x = xb_xcc_id(); b.st = st;
    if (threadIdx.x == 0) (void)xb_add(&bar[XB_XCNT(b.x)], 1u);
    return b;
}
__device__ __forceinline__ void xcd_barrier_complete(unsigned* bar, unsigned x, unsigned& nloc, unsigned& nx) {
    const unsigned G = gridDim.x * gridDim.y * gridDim.z;
    unsigned sum, cnt, mine, sp = 0u;
    for (;;) {
        sum = 0u; cnt = 0u; mine = 0u;
#pragma unroll
        for (unsigned j = 0; j < 16; ++j) { const unsigned c = xb_ld(&bar[XB_XCNT(j)]); sum += c; cnt += (c > 0u) ? 1u : 0u; mine = (j == x) ? c : mine; }
        if (sum == G) break;
        __builtin_amdgcn_s_sleep(1);
        if ((++sp & 255u) == 0u) { if (xb_ld(&bar[XB_TMO])) break; if (sp > XB_SPIN_CAP) { atomicAdd(&bar[XB_TMO], 1u); break; } }
    }
    nloc = mine > 0u ? mine : 1u; nx = cnt > 0u ? cnt : 1u;
}

__device__ __forceinline__ void xcd_barrier(const XcdBarrier& b) {
    asm volatile("s_waitcnt vmcnt(0)" ::: "memory");
    __syncthreads();
    if (threadIdx.x == 0) {
        unsigned* bar = b.bar;
        __builtin_amdgcn_s_waitcnt(0);
        unsigned nloc = b.st[0], nx = b.st[1];
        if (nloc == 0u) { xcd_barrier_complete(bar, b.x, nloc, nx); b.st[0] = nloc; b.st[1] = nx; }
        const unsigned old = xb_add(&bar[XB_XSUB(b.x)], 1u);
        const unsigned gen = old / nloc;
        if (old + 1u == (gen + 1u) * nloc) {
            __builtin_amdgcn_fence(__ATOMIC_RELEASE, "agent");
            asm volatile("s_waitcnt vmcnt(0)" ::: "memory");
            const unsigned og = xb_add(&bar[XB_TOP], 1u);
            const unsigned tg = og / nx;
            if (og + 1u == (tg + 1u) * nx) xb_add(&bar[XB_TOPGEN], 1u);
            else XB_SPIN(xb_ld(&bar[XB_TOPGEN]) == tg, bar);
            __builtin_amdgcn_fence(__ATOMIC_ACQUIRE, "agent");
            xb_add(&bar[XB_XGEN(b.x)], 1u);
            asm volatile("s_waitcnt vmcnt(0)" ::: "memory");
        } else {
            XB_SPIN(xb_ld(&bar[XB_XGEN(b.x)]) == gen, bar);
            __builtin_amdgcn_fence(__ATOMIC_ACQUIRE, "agent");
            asm volatile("s_waitcnt vmcnt(0)" ::: "memory");
        }
    }
    __syncthreads();
}

__global__ void __launch_bounds__(512, 2) hymba_fwd(Args a) {
    extern __shared__ __attribute__((aligned(16))) unsigned char lds_raw[];
    LAS unsigned char* lds = (LAS unsigned char*)lds_raw;
    cg::grid_group grid = cg::this_grid();
    const int NGW = gridDim.x * 8;
    if (threadIdx.x < 64) ((LAS unsigned*)(lds + 131072))[threadIdx.x] = 0u;
    __syncthreads();
    XcdBarrier xbar; xbar.bar = (unsigned*)(a.ws + WS_BAR); xbar.x = 0; xbar.st = nullptr;
    if (a.ph_hi - a.ph_lo > 1) xbar = xcd_barrier_post((unsigned*)(a.ws + WS_BAR), (volatile LAS unsigned*)(lds + 131072));
    if (a.ph_lo < 0) grid.sync();
#define LAUNDER() int tid = threadIdx.x; asm volatile("" : "+v"(tid)); const int wid = __builtin_amdgcn_readfirstlane(tid >> 6), lane = tid & 63, gw = blockIdx.x * 8 + wid
    const int lo = a.ph_lo, hi = a.ph_hi;
#define IN(k) (lo <= (k) && (k) < hi)
#ifndef STAGGER_N
#define STAGGER_N 0
#endif
#define STAGGER() do { if (STAGGER_N) for (int _k = 0; _k < (int)(blockIdx.x & 7); ++_k) __builtin_amdgcn_s_sleep(STAGGER_N); } while (0)
#define SEAM(k) do { if (IN(k) && IN((k) + 1)) { xcd_barrier(xbar); if ((REP_MASK >> 10) & 1) { xcd_barrier(xbar); xcd_barrier(xbar); } } } while (0)
    const float* x = a.in[0]; const float* meta = a.in[1]; const float* norm_g = a.in[2]; const float* w_in = a.in[3];
    const float* conv_a_w = a.in[4]; const float* conv_a_b = a.in[5]; const float* lru_wr = a.in[6]; const float* lru_br = a.in[7];
    const float* lru_wi = a.in[8]; const float* lru_bi = a.in[9]; const float* lru_lambda = a.in[10]; const float* conv_b_w = a.in[11];
    const float* w_out = a.in[12]; const float* final_g = a.in[13];
    unsigned char* ws = a.ws;
    bf16_t* WTIN = (bf16_t*)(ws + WS_WTIN); bf16_t* WTOUT = (bf16_t*)(ws + WS_WTOUT); bf16_t* GW = (bf16_t*)(ws + WS_GW);
    float* ROWSS = (float*)(ws + WS_ROWSS); unsigned long long* AGG = (unsigned long long*)(ws + WS_AGG);
    bf16_t* XB = (bf16_t*)(ws + WS_XB); bf16_t* Y = (bf16_t*)(ws + WS_Y); bf16_t* U = (bf16_t*)(ws + WS_U);

    if (IN(0)) for (int rep = 0; rep <= ((REP_MASK >> 0) & 1); ++rep) {
        LAUNDER();
        LAS unsigned char* scr = lds + wid * 16384;
        constexpr int I_IN = (DM / 64) * (DIN / 64);
        constexpr int NIT = I_IN + 64;
        for (int it = gw; it < NIT; it += NGW) {
            int r = it;
            if (r < I_IN) { tr_item<true>(w_in, DM, DIN, WTIN, norm_g, scr, r, lane); continue; } r -= I_IN;
            { const int mtx = r, l = mtx >> 5, g = (mtx >> 4) & 1, hd = mtx & 15;
              const float* src = (g ? lru_wi : lru_wr) + (size_t)(l * 16 + hd) * 4096;
              tr_item<false>(src, 64, 64, GW + (size_t)mtx * 4096, nullptr, scr, 0, lane); }
        }
        for (int m = gw; m < MROWS + NMETA; m += NGW) {
            const float* src = m < MROWS ? x + (size_t)m * DM : meta + (size_t)(m - MROWS) * DM;
            cvt_row(src, XB + (size_t)m * DM, ROWSS + m, lane);
        }
        for (int i = blockIdx.x * 512 + tid; i < 2 * RSTR; i += gridDim.x * 512) ROWSS[RSTR + i] = 0.f;
        for (int i = blockIdx.x * 512 + tid; i < AGG_PER_LAYER; i += gridDim.x * 512) ((u32x4*)AGG)[i] = (u32x4){0u, 0u, 0u, 0u};
    }
    SEAM(0);

#pragma unroll 1
    for (int l = 0; l < 2; ++l) {
        const int pb = 1 + 3 * l;
        const bf16_t* wtin = WTIN + (size_t)l * DIN * DM; const bf16_t* wtout = WTOUT + (size_t)l * DM * DM;
        float* rss_in = ROWSS + (size_t)l * RSTR; float* rss_out = ROWSS + (size_t)(l + 1) * RSTR;
        Mix X; X.conv_a_w = conv_a_w + l * 4 * DLRU; X.conv_a_b = conv_a_b + l * DLRU; X.lru_br = lru_br + l * DLRU; X.lru_bi = lru_bi + l * DLRU; X.lru_lambda = lru_lambda + l * DLRU;
        X.conv_b_w = conv_b_w + l * 3 * DLRU; X.gw = GW + (size_t)l * 2 * 16 * 4096; X.U = U; X.Y = Y; X.AGG = AGG + (size_t)l * AGG_PER_LAYER;

        if (IN(pb)) for (int rep = 0; rep <= ((REP_MASK >> pb) & 1); ++rep) {
            LAUNDER();
            STAGGER();
            for (int mrep = 0; mrep <= ((REP_MASK >> 16) & 1); ++mrep)
            meta_gemm(XB + (size_t)META0 * DM, wtin, DIN / 16, lds, wid, lane, [&](int m, int n0, f32x4 s) {
                const float rs = rsqrtf(rss_in[META0 + m] * (1.0f / DM) + RMS_EPS);
                u32x2 w; w.x = pk2(s[0] * rs, s[1] * rs); w.y = pk2(s[2] * rs, s[3] * rs);
                *(u32x2*)(U + (size_t)(META0 + m) * DIN + in_col(n0)) = w; });
            pg8::Gemm g{XB, wtin, MROWS, DIN, DM}; pg8::StaticOrder S; S.init(MROWS, DIN, (int)gridDim.x, (int)blockIdx.x);
            if ((REP_MASK >> 17) & 1) { EpiUT<true> En{U, rss_in}; pg8::gemm_phase<EpiUT<true>, pg8::StaticOrder, false>(lds, g, S, En, nullptr); }
            if ((REP_MASK >> 15) & 1) { EpiNull En{ROWSS + (size_t)3 * RSTR}; pg8::gemm_phase<EpiNull, pg8::StaticOrder, false>(lds, g, S, En, nullptr); }
            EpiU E{U, rss_in};
            pg8::gemm_phase<EpiU, pg8::StaticOrder, false>(lds, g, S, E, nullptr);
        }
        SEAM(pb);
        if (IN(pb + 1)) for (int rep = 0; rep <= ((REP_MASK >> (pb + 1)) & 1); ++rep) {
            LAUNDER();
#pragma unroll 1
            for (int step = 0; step < 2; ++step) {
                if ((step == 0) == (wid < 4)) {
                    if (rep == 1 && ((REP_MASK >> 13) & 1)) continue;
#pragma unroll 1
                    for (int id = gw; id < N_ITEMS; id += NGW) { if (id < 16) mix_item<true>(X, id, lds + wid * 9216, lane); else mix_item<false>(X, id, lds + wid * 9216, lane); }
                } else { if (rep == 1 && ((REP_MASK >> 12) & 1)) continue; partb(X, tid); }
            }
            {
                constexpr int I_IN = (DM / 64) * (DIN / 64), I_OUT = (DM / 64) * (DM / 64);
                LAS unsigned char* scr = lds + wid * 9216;
                const int nit = (l == 0) ? I_IN + I_OUT : I_OUT;
#pragma unroll 1
                for (int it = gw; it < nit; it += NGW) {
                    if (l == 0 && it < I_IN) tr_item<true>(w_in + (size_t)DM * DIN, DM, DIN, WTIN + (size_t)DIN * DM, norm_g + DM, scr, it, lane);
                    else { const int r = (l == 0) ? it - I_IN : it; tr_item<false>(w_out + (size_t)l * DM * DM, DM, DM, WTOUT + (size_t)l * DM * DM, nullptr, scr, r, lane); }
                }
            }
        }
        SEAM(pb + 1);
        if (IN(pb + 2)) {
            LAUNDER();
            STAGGER();
            if (l == 0) {
                meta_gemm(Y + (size_t)META0 * DM, wtout, DM / 16, lds, wid, lane, [&](int m, int n0, f32x4 s) {
                    const f32x4 r = *(const f32x4*)(meta + (size_t)m * DM + n0); const f32x4 hh = r + s;
                    u32x2 w; w.x = pk2(hh[0], hh[1]); w.y = pk2(hh[2], hh[3]);
                    *(u32x2*)(XB + (size_t)(META0 + m) * DM + n0) = w;
                    unsafeAtomicAdd(rss_out + META0 + m, (hh[0] * hh[0] + hh[1] * hh[1]) + (hh[2] * hh[2] + hh[3] * hh[3])); });
            }
            pg8::Gemm g{Y, wtout, MROWS, DM, DM};
            if (l == 0) {
                pg8::StaticOrder S; S.init(MROWS, DM, (int)gridDim.x, (int)blockIdx.x);
                if ((REP_MASK >> 11) & 1) { EpiU Ed{U, rss_in}; pg8::gemm_phase<EpiU, pg8::StaticOrder, false>(lds, g, S, Ed, nullptr); }
                if ((REP_MASK >> 14) & 1) { EpiRes Ed{x, nullptr, XB, ROWSS + (size_t)3 * RSTR}; pg8::gemm_phase<EpiRes, pg8::StaticOrder, false>(lds, g, S, Ed, nullptr); }
                EpiRes E{x, nullptr, XB, rss_out};
                pg8::gemm_phase<EpiRes, pg8::StaticOrder, false>(lds, g, S, E, nullptr);
            } else {
                PanelOrder S; S.init((int)gridDim.x, (int)blockIdx.x);
                EpiResNorm E{XB, a.out, rss_out, (unsigned*)(ws + WS_PCNT), final_g};
                pg8::gemm_phase<EpiResNorm, PanelOrder, false>(lds, g, S, E, nullptr);
            }
        }
        SEAM(pb + 2);
    }

#undef IN
#undef SEAM
}

#ifndef MK_LAUNCH_PER_PHASE
#define MK_LAUNCH_PER_PHASE 0
#endif
extern "C" void kernel_launch(void* const* d_in, const int* in_sizes, int n_in, void* d_out, int out_size, void* d_ws, size_t ws_size, hipStream_t stream) {
    static int grid = 0;
    if (grid == 0) {
        if (n_in != 14 || in_sizes[0] != MROWS * DM || out_size != MROWS * DM || ws_size < WS_END) { fprintf(stderr, "kernel_launch: unexpected shapes (n_in %d, in0 %d, out %d, ws %zu)\n", n_in, n_in > 0 ? in_sizes[0] : -1, out_size, ws_size); grid = -1; return; }
        int dev = 0, cus = 0, per_cu = 0;
        hipGetDevice(&dev); hipDeviceGetAttribute(&cus, hipDeviceAttributeMultiprocessorCount, dev);
        if (hipFuncSetAttribute((const void*)hymba_fwd, hipFuncAttributeMaxDynamicSharedMemorySize, LDS_BYTES) != hipSuccess) { fprintf(stderr, "kernel_launch: hipFuncSetAttribute failed\n"); grid = -1; return; }
        if (hipOccupancyMaxActiveBlocksPerMultiprocessor(&per_cu, (const void*)hymba_fwd, 512, LDS_BYTES) != hipSuccess || per_cu < 1) { fprintf(stderr, "kernel_launch: occupancy query gave %d\n", per_cu); per_cu = 1; }
        (void)hipGetLastError();
        grid = cus * per_cu;
    }
    if (grid < 0) return;
    Args a{};
    for (int i = 0; i < 14; ++i) a.in[i] = (const float*)d_in[i];
    a.out = (float*)d_out; a.ws = (unsigned char*)d_ws;
#if MK_LAUNCH_PER_PHASE
    for (int p = 0; p < NPHASE; ++p) {
#ifdef DEBUG_NAIVE_MIX
        if (p == 2 || p == 6) { const int l = p / 4; unsigned char* ws = (unsigned char*)d_ws;
            Mix X; X.conv_a_w = a.in[4] + l * 4 * DLRU; X.conv_a_b = a.in[5] + l * DLRU; X.lru_br = a.in[7] + l * DLRU; X.lru_bi = a.in[9] + l * DLRU; X.lru_lambda = a.in[10] + l * DLRU;
            X.conv_b_w = a.in[11] + l * 3 * DLRU; X.gw = nullptr; X.U = (bf16_t*)(ws + WS_U); X.Y = (bf16_t*)(ws + WS_Y); X.HP = nullptr; X.AGG = nullptr;
#if DEBUG_NAIVE_MIX == 1
            hipLaunchKernelGGL(naive_mixA, dim3(64), dim3(64), 0, stream, X, a.in[6] + (size_t)l * 16 * 4096, a.in[8] + (size_t)l * 16 * 4096);
            a.flags = 1;
#else
            hipLaunchKernelGGL(naive_mixB, dim3(2048), dim3(256), 0, stream, X);
            a.flags = 2;
#endif
            }
        else a.flags = 0;
#if DEBUG_NAIVE_MIX == 1
        if (p == 3 || p == 7) continue;
#endif
#endif
        a.ph_lo = p; a.ph_hi = p + 1; hipLaunchKernelGGL(hymba_fwd, dim3(grid), dim3(512), LDS_BYTES, stream, a); }
#else
    a.ph_lo = 0; a.ph_hi = NPHASE;
    if (hipMemsetAsync((unsigned char*)d_ws + WS_BAR, 0, 16384 + 32768, stream) != hipSuccess) { fprintf(stderr, "kernel_launch: memset of barrier words failed\n"); return; }
    void* args[] = {&a};
    const hipError_t e = hipLaunchCooperativeKernel((const void*)hymba_fwd, dim3(grid), dim3(512), args, LDS_BYTES, stream);
    if (e != hipSuccess) fprintf(stderr, "kernel_launch: cooperative launch failed: %s (grid %d)\n", hipGetErrorString(e), grid);
#endif
}
```

```cpp
#include <hip/hip_runtime.h>
#include <hip/hip_cooperative_groups.h>
#include <cstdio>
namespace cg = cooperative_groups;
namespace pg8 {
#define PG8_LAS __attribute__((address_space(3)))
typedef unsigned short bf16_t;
typedef short bf16x8 __attribute__((ext_vector_type(8)));
typedef float f32x4 __attribute__((ext_vector_type(4)));
typedef unsigned u32x4 __attribute__((ext_vector_type(4)));
constexpr int BM = 256, BK = 64, HALF = 128, HTB = HALF * BK * 2  , STAGE_BYTES = 8 * HTB, NXCD = 8, WGM = 8;

__host__ __device__ __forceinline__ int lds_byte(int r, int c) { const int st = (r >> 4) * 2 + (c >> 5), rr = r & 15, cc = c & 31, ob = rr * 64 + cc * 2; return st * 1024 + (ob ^ (((ob >> 9) & 1) << 5)); }
__host__ __device__ __forceinline__ void stage_rc(int b, int& R, int& C) { const int st = b / 1024, sb = b % 1024, swz = sb ^ (((sb >> 9) & 1) << 5); R = (st >> 1) * 16 + swz / 64; C = (st & 1) * 32 + (swz % 64) / 2; }
__host__ __device__ __forceinline__ int perm32(int rho) { const int n = rho >> 4, i = rho & 15; return 8 * (i >> 2) + 4 * n + (i & 3); }

struct Unit { int pm, pn; };
struct Gemm { const bf16_t* A; const bf16_t* Bt; int M, N, K; };

struct StaticOrder {
    int nM, nN, nwg, G, c;
    __host__ __device__ void init(int M, int N, int G_, int c_) { nM = M / BM; nN = N / BM; nwg = nM * nN; G = G_; c = c_; }
    __host__ __device__ bool next(int i, Unit& u) const {
        const long L = (long)i * G + c; if (L >= nwg) return false;
        int wgid = (int)L; { const int q = nwg / NXCD, r = nwg % NXCD, xcd = wgid % NXCD, off = wgid / NXCD; wgid = (xcd < r ? xcd * (q + 1) : r * (q + 1) + (xcd - r) * q) + off; }
        const int nig = WGM * nN, gid = wgid / nig, fm = gid * WGM, gsz = (nM - fm) < WGM ? (nM - fm) : WGM;
        u.pm = fm + ((wgid % nig) % gsz); u.pn = (wgid % nig) / gsz; return true;
    }
    __device__ __forceinline__ void a_ready(const Unit&) const {}
    __device__ __forceinline__ void done(const Unit&) const {}
};
__device__ __forceinline__ unsigned cvt_pk_bf16(float lo, float hi) { unsigned r; asm volatile("v_cvt_pk_bf16_f32 %0, %1, %2" : "=v"(r) : "v"(lo), "v"(hi)); return r; }
template <class Epi, class Sched, bool STAMP = false>
__device__ __forceinline__ void gemm_phase(PG8_LAS unsigned char* lds, const Gemm g, const Sched& S, const Epi& E, unsigned long long* stamps) {
    int tid_l = threadIdx.x; asm volatile("" : "+v"(tid_l));
    const int tid = tid_l, wid = __builtin_amdgcn_readfirstlane(tid >> 6), lane = tid & 63, wr = wid >> 2, wc = wid & 3, fr = lane & 15, fq = lane >> 4;
    const int K = g.K, nt = K / BK;
    int ts_lo = 0, ts_hi = 0, nts = 0; const unsigned long long rt_entry = STAMP ? (unsigned long long)wall_clock64() : 0ull;
#define PG8_STAMP() do { if (STAMP && wid == 0 && nts < 64) { const unsigned long long _c = (unsigned long long)clock64(); \
        ts_lo = (lane == nts) ? (int)(unsigned)_c : ts_lo; ts_hi = (lane == nts) ? (int)(unsigned)(_c >> 32) : ts_hi; ++nts; } } while (0)
    PG8_STAMP();
    unsigned voffA[2], voffB[2];
#pragma unroll
    for (int i = 0; i < 2; ++i) { int R, C; stage_rc(tid * 16 + i * 8192, R, C); const int Rb = Epi::PERM ? ((R & ~31) + perm32(R & 31)) : R;
        voffA[i] = (unsigned)(R * K + C) * 2u; voffB[i] = (unsigned)(Rb * K + C) * 2u; }
    const size_t kstep = (size_t)(BK * 2);
    const size_t hstep = (size_t)HALF * K * 2;
    const size_t tstep = 2 * hstep;
    const unsigned ldsw = (unsigned)wid * 1024u;
    const int aoff = lds_byte(wr * 64 + fr, fq * 8), boff = lds_byte(wc * 32 + fr, fq * 8);
#define PG8_SA(b, h) (((b) * 2 + (h)) * HTB)
#define PG8_SB(b, h) ((4 + (b) * 2 + (h)) * HTB)
#define PG8_STAGE(bufoff, gbase, voff) do { _Pragma("unroll") for (int _i = 0; _i < 2; ++_i) \
        __builtin_amdgcn_global_load_lds((const unsigned*)((const char*)(gbase) + (voff)[_i]), (PG8_LAS unsigned*)(lds + (bufoff) + ldsw + _i * 8192), 16, 0, 0); } while (0)
#define PG8_LDA(dst, b, h) do { _Pragma("unroll") for (int m = 0; m < 4; ++m) _Pragma("unroll") for (int k = 0; k < 2; ++k) dst[m][k] = *(const PG8_LAS bf16x8*)(lds + PG8_SA(b, h) + aoff + m * 2048 + k * 1024); } while (0)
#define PG8_LDB(dst, b, h) do { _Pragma("unroll") for (int n = 0; n < 2; ++n) _Pragma("unroll") for (int k = 0; k < 2; ++k) dst[n][k] = *(const PG8_LAS bf16x8*)(lds + PG8_SB(b, h) + boff + n * 2048 + k * 1024); } while (0)
#define PG8_MMA(ai, bj, At, Bt) do { __builtin_amdgcn_s_setprio(1); _Pragma("unroll") for (int m = 0; m < 4; ++m) _Pragma("unroll") for (int n = 0; n < 2; ++n) _Pragma("unroll") for (int k = 0; k < 2; ++k) \
        acc[ai][bj][m][n] = __builtin_amdgcn_mfma_f32_16x16x32_bf16(Bt[n][k], At[m][k], acc[ai][bj][m][n], 0, 0, 0); __builtin_amdgcn_s_setprio(0); } while (0)
#define PG8_WAIT_V(n) asm volatile("s_waitcnt vmcnt(" #n ")" ::: "memory")
#define PG8_WAIT_L(n) asm volatile("s_waitcnt lgkmcnt(" #n ")" ::: "memory")
#define PG8_BAR __builtin_amdgcn_s_barrier()
#define PG8_SCHED __builtin_amdgcn_sched_barrier(0)
    Unit cur, nxt; int ui = 0;
    if (!S.next(0, cur)) return;
    f32x4 acc[2][2][4][2];
#pragma unroll
    for (int a = 0; a < 2; ++a)
#pragma unroll
        for (int b = 0; b < 2; ++b)
#pragma unroll
            for (int m = 0; m < 4; ++m)
#pragma unroll
                for (int n = 0; n < 2; ++n) acc[a][b][m][n] = (f32x4){0.f, 0.f, 0.f, 0.f};
    bf16x8 At[4][2], B0[2][2], B1[2][2];
    const char* cA = (const char*)g.A + (size_t)cur.pm * tstep; const char* cB = (const char*)g.Bt + (size_t)cur.pn * tstep;
    S.a_ready(cur);
    PG8_STAGE(PG8_SB(0, 0), cB, voffB); PG8_STAGE(PG8_SA(0, 0), cA, voffA); PG8_STAGE(PG8_SB(0, 1), cB + hstep, voffB); PG8_STAGE(PG8_SA(0, 1), cA + hstep, voffA);
    if (wr == 1) PG8_BAR;
    PG8_WAIT_V(4); PG8_BAR;
    PG8_STAGE(PG8_SB(1, 0), cB + kstep, voffB); PG8_STAGE(PG8_SA(1, 0), cA + kstep, voffA); PG8_STAGE(PG8_SB(1, 1), cB + hstep + kstep, voffB);
    PG8_WAIT_V(6); PG8_BAR;
    PG8_STAMP();
    for (;;) {
        const bool has_next = S.next(ui + 1, nxt);
        const char* nA = has_next ? (const char*)g.A + (size_t)nxt.pm * tstep : cA; const char* nB = has_next ? (const char*)g.Bt + (size_t)nxt.pn * tstep : cB;
        for (int t = 0; t < nt; t += 2) {
            const bool last = (t == nt - 2);
            const char* a1 = cA + (size_t)(t + 1) * kstep;
            const char* a2 = last ? nA : cA + (size_t)(t + 2) * kstep; const char* b2 = last ? nB : cB + (size_t)(t + 2) * kstep;
            const char* a3 = a2 + kstep; const char* b3 = b2 + kstep;
            if (last && has_next) S.a_ready(nxt);
            PG8_LDB(B0, 0, 0); PG8_SCHED; PG8_LDA(At, 0, 0); PG8_STAGE(PG8_SA(1, 1), a1 + hstep, voffA);
            PG8_WAIT_L(8); PG8_BAR; PG8_WAIT_L(0); PG8_MMA(0, 0, At, B0); PG8_BAR; PG8_SCHED;
            PG8_LDB(B1, 0, 1); PG8_STAGE(PG8_SB(0, 0), b2, voffB);
            PG8_BAR; PG8_WAIT_L(0); PG8_MMA(0, 1, At, B1); PG8_BAR;
            PG8_LDA(At, 0, 1); PG8_STAGE(PG8_SA(0, 0), a2, voffA);
            PG8_BAR; PG8_WAIT_L(0); PG8_MMA(1, 0, At, B0); PG8_BAR; PG8_SCHED;
            PG8_STAGE(PG8_SB(0, 1), b2 + hstep, voffB);
            PG8_WAIT_V(6); PG8_BAR; PG8_MMA(1, 1, At, B1); PG8_BAR;
            PG8_LDB(B0, 1, 0); PG8_SCHED; PG8_LDA(At, 1, 0); PG8_STAGE(PG8_SA(0, 1), a2 + hstep, voffA);
            PG8_WAIT_L(8); PG8_BAR; PG8_WAIT_L(0); PG8_MMA(0, 0, At, B0); PG8_BAR; PG8_SCHED;
            PG8_LDB(B1, 1, 1); PG8_STAGE(PG8_SB(1, 0), b3, voffB);
            PG8_BAR; PG8_WAIT_L(0); PG8_MMA(0, 1, At, B1); PG8_BAR;
            PG8_LDA(At, 1, 1); PG8_STAGE(PG8_SA(1, 0), a3, voffA);
            PG8_BAR; PG8_WAIT_L(0); PG8_MMA(1, 0, At, B0); PG8_BAR; PG8_SCHED;
            PG8_STAGE(PG8_SB(1, 1), b3 + hstep, voffB);
            PG8_WAIT_V(6); PG8_BAR; PG8_MMA(1, 1, At, B1); PG8_BAR;
        }
        PG8_STAMP();
        if constexpr (!Epi::AFTER_DRAIN) { if (wr == 0) PG8_BAR; E(acc, cur, wr, wc, fr, fq); S.done(cur); if (has_next) { if (wr == 1) PG8_BAR; } }
        PG8_STAMP();
        if (!has_next) break;
#pragma unroll
        for (int a = 0; a < 2; ++a)
#pragma unroll
            for (int b = 0; b < 2; ++b)
#pragma unroll
                for (int m = 0; m < 4; ++m)
#pragma unroll
                    for (int n = 0; n < 2; ++n) acc[a][b][m][n] = (f32x4){0.f, 0.f, 0.f, 0.f};
        cur = nxt; cA = nA; cB = nB; ++ui;
    }
    PG8_WAIT_V(0);
    if constexpr (Epi::AFTER_DRAIN) { if (wr == 0) PG8_BAR; }
    PG8_BAR;
    if constexpr (Epi::AFTER_DRAIN) { E.fused(acc, cur, wr, wc, fr, fq, lds, wid, lane); S.done(cur); }
    PG8_STAMP();
    if (STAMP && wid == 0) { stamps[lane] = lane < nts ? (((unsigned long long)(unsigned)ts_hi << 32) | (unsigned)ts_lo) : 0ull;
        if (lane == 62) stamps[62] = rt_entry; if (lane == 63) stamps[63] = (unsigned long long)wall_clock64(); }
#undef PG8_STAMP
#undef PG8_SA
#undef PG8_SB
#undef PG8_STAGE
#undef PG8_LDA
#undef PG8_LDB
#undef PG8_MMA
#undef PG8_WAIT_V
#undef PG8_WAIT_L
#undef PG8_BAR
#undef PG8_SCHED
}
}

#define LAS __attribute__((address_space(3)))
#define GAS __attribute__((address_space(1)))
typedef unsigned short bf16_t;
typedef short bf16x8 __attribute__((ext_vector_type(8)));
typedef float f32x4 __attribute__((ext_vector_type(4)));
typedef float f32x2 __attribute__((ext_vector_type(2)));
typedef float f32x16 __attribute__((ext_vector_type(16)));
typedef unsigned u32x4 __attribute__((ext_vector_type(4)));
typedef unsigned u32x2 __attribute__((ext_vector_type(2)));

constexpr int DM = 2048, NBATCH = 4, SEQ = 4096, MROWS = NBATCH * SEQ, NMETA = 16, DIN = 6144, DLRU = 1024, NHEAD = 16;
constexpr int META0 = MROWS;
constexpr int RSTR = MROWS + 64;
constexpr float RMS_EPS = 1e-6f;
constexpr int NPHASE = 7;
#ifndef REP_MASK
#define REP_MASK 0
#endif
constexpr int LDS_BYTES = 131072 + 256;

constexpr size_t MiB = 1u << 20;
constexpr size_t WS_WTIN = 0;
constexpr size_t WS_WTOUT = 48 * MiB;
constexpr size_t WS_GW = 64 * MiB;
constexpr size_t WS_ROWSS = 65 * MiB;
constexpr size_t WS_BAR = 65 * MiB + 512 * 1024;
constexpr size_t WS_PCNT = WS_BAR + 16384;
constexpr size_t WS_AGG = 66 * MiB;
constexpr size_t WS_XB = 71 * MiB;
constexpr size_t WS_Y = 136 * MiB;
constexpr size_t WS_U = 201 * MiB;
constexpr size_t WS_END = 396 * MiB;
constexpr int AGG_PER_LAYER = 257 * 1024;
static_assert(WS_U + (size_t)RSTR * DIN * 2 <= WS_END && WS_Y + (size_t)RSTR * DM * 2 <= WS_U && WS_XB + (size_t)RSTR * DM * 2 <= WS_Y, "ws map");
static_assert(WS_WTIN + (size_t)2 * DIN * DM * 2 <= WS_WTOUT && WS_WTOUT + (size_t)2 * DM * DM * 2 <= WS_GW && WS_AGG + (size_t)2 * AGG_PER_LAYER * 8 <= WS_XB && WS_ROWSS + (size_t)3 * RSTR * 4 <= WS_BAR, "ws map 2");

struct Args { const float* in[14]; float* out; unsigned char* ws; int ph_lo, ph_hi, flags, pad; };

__device__ __forceinline__ unsigned f2bf(float f) { unsigned u = __builtin_bit_cast(unsigned, f); return (u + 0x7fffu + ((u >> 16) & 1u)) >> 16; }
__device__ __forceinline__ unsigned pk2(float lo, float hi) { return f2bf(lo) | (f2bf(hi) << 16); }
__device__ __forceinline__ float bflo(unsigned w) { return __builtin_bit_cast(float, w << 16); }
__device__ __forceinline__ float bfhi(unsigned w) { return __builtin_bit_cast(float, w & 0xffff0000u); }
__device__ __forceinline__ float bf1(bf16_t v) { return __builtin_bit_cast(float, ((unsigned)v) << 16); }
__device__ __forceinline__ float sigmoidf_(float z) { return __builtin_amdgcn_rcpf(1.0f + __expf(-z)); }
__device__ __forceinline__ float wave_sum(float v) {
#pragma unroll
    for (int o = 1; o < 64; o <<= 1) v += __shfl_xor(v, o);
    return v;
}
#define LDS_WAIT() asm volatile("s_waitcnt lgkmcnt(0)" ::: "memory")

template <bool NORS> struct EpiUT {
    static constexpr bool PERM = true, AFTER_DRAIN = false;
    bf16_t* O; const float* rowss;
    __device__ __forceinline__ void operator()(const f32x4 (&acc)[2][2][4][2], const pg8::Unit& u, int wr, int wc, int fr, int fq) const {
        const int row0 = u.pm * 256 + wr * 64 + fr, col0 = u.pn * 256 + wc * 32 + 8 * fq;
        if (u.pn >= 8) {
            const int ch0 = 64 * (u.pn - 8) + 16 * wc + 4 * fq;
#pragma unroll
            for (int ai = 0; ai < 2; ++ai)
#pragma unroll
                for (int m = 0; m < 4; ++m) {
                    const int r = row0 + ai * 128 + m * 16;
                    const float rs = NORS ? 1.0f : rsqrtf(rowss[r] * (1.0f / DM) + RMS_EPS);
                    const f32x4 bv = acc[ai][0][m][0] * rs, cv = acc[ai][0][m][1] * rs, xv = acc[ai][1][m][0] * rs, gv = acc[ai][1][m][1] * rs;
                    u32x4 w;
#pragma unroll
                    for (int i = 0; i < 4; ++i) w[i] = pg8::cvt_pk_bf16(bv[i] * gv[i] * sigmoidf_(gv[i]), cv[i] * xv[i]);
                    *(u32x4*)(O + (size_t)r * DIN + 2048 + 2 * ch0) = w;
                }
            return;
        }
#pragma unroll
        for (int ai = 0; ai < 2; ++ai)
#pragma unroll
            for (int m = 0; m < 4; ++m) {
                const int r = row0 + ai * 128 + m * 16;
                const float rs = NORS ? 1.0f : rsqrtf(rowss[r] * (1.0f / DM) + RMS_EPS);
                bf16_t* rowp = O + (size_t)r * DIN + col0;
#pragma unroll
                for (int bj = 0; bj < 2; ++bj) {
                    const f32x4 v0 = acc[ai][bj][m][0] * rs, v1 = acc[ai][bj][m][1] * rs;
                    u32x4 w; w.x = pg8::cvt_pk_bf16(v0[0], v0[1]); w.y = pg8::cvt_pk_bf16(v0[2], v0[3]); w.z = pg8::cvt_pk_bf16(v1[0], v1[1]); w.w = pg8::cvt_pk_bf16(v1[2], v1[3]);
                    *(u32x4*)(rowp + bj * 128) = w;
                }
            }
    }
};
struct EpiNull {
    static constexpr bool PERM = true, AFTER_DRAIN = false;
    float* sink;
    __device__ __forceinline__ void operator()(const f32x4 (&acc)[2][2][4][2], const pg8::Unit& u, int wr, int wc, int fr, int fq) const {
        f32x4 s = {0.f, 0.f, 0.f, 0.f};
#pragma unroll
        for (int ai = 0; ai < 2; ++ai)
#pragma unroll
            for (int bj = 0; bj < 2; ++bj)
#pragma unroll
                for (int m = 0; m < 4; ++m) { s += acc[ai][bj][m][0]; s += acc[ai][bj][m][1]; }
        if (s[0] + s[1] + s[2] + s[3] == 1.2345678e33f) sink[u.pm] = s[0];
    }
};
typedef EpiUT<false> EpiU;
#ifndef EPI_MB
#define EPI_MB 2
#endif
struct EpiRes {
    static constexpr bool PERM = true, AFTER_DRAIN = false;
    const float* res; float* out; bf16_t* xb; float* rowss;
    __device__ __forceinline__ void operator()(const f32x4 (&acc)[2][2][4][2], const pg8::Unit& u, int wr, int wc, int fr, int fq) const {
        const int row0 = u.pm * 256 + wr * 64 + fr, col0 = u.pn * 256 + wc * 32 + 8 * fq;
#pragma unroll
        for (int ai = 0; ai < 2; ++ai) {
#pragma unroll
          for (int mh = 0; mh < 4; mh += EPI_MB) {
            f32x4 rv[4][2][2];
#pragma unroll
            for (int m = mh; m < mh + EPI_MB; ++m)
#pragma unroll
                for (int bj = 0; bj < 2; ++bj) { const float* p = res + (size_t)(row0 + ai * 128 + m * 16) * DM + col0 + bj * 128; rv[m][bj][0] = *(const f32x4*)p; rv[m][bj][1] = *(const f32x4*)(p + 4); }
            asm volatile("" ::: "memory");
#pragma unroll
            for (int m = mh; m < mh + EPI_MB; ++m) {
                const int r = row0 + ai * 128 + m * 16; const size_t off = (size_t)r * DM + col0; float ss = 0.f;
#pragma unroll
                for (int bj = 0; bj < 2; ++bj) {
                    const f32x4 h0 = rv[m][bj][0] + acc[ai][bj][m][0], h1 = rv[m][bj][1] + acc[ai][bj][m][1];
                    if (out) { *(f32x4*)(out + off + bj * 128) = h0; *(f32x4*)(out + off + bj * 128 + 4) = h1; }
                    if (xb) { u32x4 w; w.x = pg8::cvt_pk_bf16(h0[0], h0[1]); w.y = pg8::cvt_pk_bf16(h0[2], h0[3]); w.z = pg8::cvt_pk_bf16(h1[0], h1[1]); w.w = pg8::cvt_pk_bf16(h1[2], h1[3]);
                        *(u32x4*)(xb + off + bj * 128) = w; }
                    ss += (h0[0] * h0[0] + h0[1] * h0[1]) + (h0[2] * h0[2] + h0[3] * h0[3]) + (h1[0] * h1[0] + h1[1] * h1[1]) + (h1[2] * h1[2] + h1[3] * h1[3]);
                }
                ss += __shfl_xor(ss, 16); ss += __shfl_xor(ss, 32);
                if (fq == 0) unsafeAtomicAdd(rowss + r, ss);
            }
            asm volatile("" ::: "memory");
          }
        }
    }
};

struct EpiResNorm {
    static constexpr bool PERM = true, AFTER_DRAIN = false;
    const bf16_t* res; float* out; float* rowss; unsigned* cnt; const float* fg;
    __device__ __forceinline__ void operator()(f32x4 (&acc)[2][2][4][2], const pg8::Unit& u, int wr, int wc, int fr, int fq) const {
        const int row0 = u.pm * 256 + wr * 64 + fr, col0 = u.pn * 256 + wc * 32 + 8 * fq;
#pragma unroll
        for (int ai = 0; ai < 2; ++ai) {
#pragma unroll
          for (int mh = 0; mh < 4; mh += EPI_MB) {
            u32x4 rw[4][2];
#pragma unroll
            for (int m = mh; m < mh + EPI_MB; ++m)
#pragma unroll
                for (int bj = 0; bj < 2; ++bj) rw[m][bj] = *(const u32x4*)(res + (size_t)(row0 + ai * 128 + m * 16) * DM + col0 + bj * 128);
            asm volatile("" ::: "memory");
#pragma unroll
            for (int m = mh; m < mh + EPI_MB; ++m) {
                float ss = 0.f;
#pragma unroll
                for (int bj = 0; bj < 2; ++bj) {
                    const u32x4 w = rw[m][bj];
                    const f32x4 h0 = (f32x4){bflo(w.x), bfhi(w.x), bflo(w.y), bfhi(w.y)} + acc[ai][bj][m][0], h1 = (f32x4){bflo(w.z), bfhi(w.z), bflo(w.w), bfhi(w.w)} + acc[ai][bj][m][1];
                    acc[ai][bj][m][0] = h0; acc[ai][bj][m][1] = h1;
                    ss += (h0[0] * h0[0] + h0[1] * h0[1]) + (h0[2] * h0[2] + h0[3] * h0[3]) + (h1[0] * h1[0] + h1[1] * h1[1]) + (h1[2] * h1[2] + h1[3] * h1[3]);
                }
                ss += __shfl_xor(ss, 16); ss += __shfl_xor(ss, 32);
                if (fq == 0) unsafeAtomicAdd(rowss + row0 + ai * 128 + m * 16, ss);
            }
            asm volatile("" ::: "memory");
          }
        }
        asm volatile("s_waitcnt vmcnt(0)" ::: "memory");
        unsigned* cw = cnt + 64 * (2 * u.pm + wr);
        if (fr == 0 && fq == 0) __hip_atomic_fetch_add(cw, 1u, __ATOMIC_RELAXED, __HIP_MEMORY_SCOPE_AGENT);
        f32x4 gv[2][2];
#pragma unroll
        for (int bj = 0; bj < 2; ++bj) { gv[bj][0] = *(const f32x4*)(fg + col0 + bj * 128); gv[bj][1] = *(const f32x4*)(fg + col0 + bj * 128 + 4); }
        { unsigned sp = 0;
          while ((unsigned)__builtin_amdgcn_readfirstlane(__hip_atomic_load(cw, __ATOMIC_RELAXED, __HIP_MEMORY_SCOPE_AGENT)) < 32u) { __builtin_amdgcn_s_sleep(1); if (++sp > (1u << 16)) break; } }
        asm volatile("" ::: "memory");
#pragma unroll
        for (int ai = 0; ai < 2; ++ai)
#pragma unroll
            for (int m = 0; m < 4; ++m) {
                const int r = row0 + ai * 128 + m * 16;
                const float rs = rsqrtf(__hip_atomic_load(rowss + r, __ATOMIC_RELAXED, __HIP_MEMORY_SCOPE_AGENT) * (1.0f / DM) + RMS_EPS);
                float* op = out + (size_t)r * DM + col0;
#pragma unroll
                for (int bj = 0; bj < 2; ++bj) { *(f32x4*)(op + bj * 128) = acc[ai][bj][m][0] * rs * gv[bj][0]; *(f32x4*)(op + bj * 128 + 4) = acc[ai][bj][m][1] * rs * gv[bj][1]; }
            }
    }
};
struct PanelOrder {
    int Gp, v;
    __device__ void init(int G, int c) { Gp = G & ~7; v = c; if ((Gp & 63) == 0) v = (c & 7) * (Gp >> 3) + (c >> 3); if (c >= Gp) v = -1; }
    __device__ bool next(int i, pg8::Unit& u) const { if (v < 0) return false; const long L = (long)i * Gp + v; if (L >= 64 * 8) return false; u.pm = (int)(L >> 3); u.pn = (int)(L & 7); return true; }
    __device__ __forceinline__ void a_ready(const pg8::Unit&) const {}
    __device__ __forceinline__ void done(const pg8::Unit&) const {}
};

template <class F> __device__ __forceinline__ void meta_gemm(const bf16_t* A, const bf16_t* Bt, int ngroups, LAS unsigned char* lds, int wid, int lane, F epi) {
    const int fr = lane & 15, fq = lane >> 4, half = wid >> 2, wq = wid & 3;
    LAS f32x4* red = (LAS f32x4*)lds;
    for (int p = blockIdx.x; 2 * p < ngroups; p += gridDim.x) {
        const int g = 2 * p + half;
        f32x4 acc = {0.f, 0.f, 0.f, 0.f};
        if (g < ngroups) {
            const bf16_t* ap = A + (size_t)fr * DM + wq * 512 + fq * 8;
            const bf16_t* bp = Bt + (size_t)(g * 16 + fr) * DM + wq * 512 + fq * 8;
            bf16x8 av[16], bv[16];
#pragma unroll
            for (int s = 0; s < 16; ++s) { av[s] = *(const bf16x8*)(ap + 32 * s); bv[s] = *(const bf16x8*)(bp + 32 * s); }
#pragma unroll
            for (int s = 0; s < 16; ++s) acc = __builtin_amdgcn_mfma_f32_16x16x32_bf16(bv[s], av[s], acc, 0, 0, 0);
        }
        red[wid * 64 + lane] = acc;
        __syncthreads();
        if (wq == 0 && g < ngroups) {
            f32x4 s = red[wid * 64 + lane];
#pragma unroll
            for (int w = 1; w < 4; ++w) s += red[(wid + w) * 64 + lane];
            epi(fr, g * 16 + 4 * fq, s);
        }
        __syncthreads();
    }
}

__host__ __device__ __forceinline__ int in_col(int p) {
    if (p < 2048) return p;
    const int c = p & 255, j = (p >> 8) - 8, g = 2 * (c >> 7) + ((c >> 2) & 1), k = 16 * ((c >> 5) & 3) + 4 * ((c >> 3) & 3) + (c & 3);
    return 2048 + 1024 * g + 64 * j + k;
}
template <bool COLMAP> __device__ __forceinline__ void tr_item(const float* W, int K, int N, bf16_t* WT, const float* sc, LAS unsigned char* scr, int item, int lane) {
    const int nblk = N / 64, kb = item / nblk, nb = item % nblk, k0 = 64 * kb, n0 = 64 * nb;
    const int kr = lane >> 4, nc = (lane & 15) * 4;
    f32x4 v[16]; float g[16];
    { const float* p = W + (size_t)(k0 + kr) * N + (COLMAP ? in_col(n0 + nc) : n0 + nc);
#pragma unroll
      for (int i = 0; i < 16; ++i) { v[i] = *(const f32x4*)p; p += (size_t)4 * N; }
#pragma unroll
      for (int i = 0; i < 16; ++i) g[i] = sc ? sc[k0 + kr + 4 * i] : 1.0f; }
    asm volatile("" ::: "memory");
#pragma unroll
    for (int i = 0; i < 16; ++i) { const f32x4 s = v[i] * g[i]; u32x2 w; w.x = pg8::cvt_pk_bf16(s[0], s[1]); w.y = pg8::cvt_pk_bf16(s[2], s[3]);
        *(LAS u32x2*)(scr + (kr + 4 * i) * 136 + nc * 2) = w; }
    LDS_WAIT();
    const int c = lane & 7;
#pragma unroll
    for (int j = 0; j < 8; ++j) { const int n = (lane >> 3) + 8 * j; const LAS bf16_t* s = (const LAS bf16_t*)(scr + (8 * c) * 136 + n * 2);
        u32x4 o; o.x = (unsigned)s[0] | ((unsigned)s[68] << 16); o.y = (unsigned)s[2 * 68] | ((unsigned)s[3 * 68] << 16); o.z = (unsigned)s[4 * 68] | ((unsigned)s[5 * 68] << 16); o.w = (unsigned)s[6 * 68] | ((unsigned)s[7 * 68] << 16);
        *(u32x4*)(WT + (size_t)(n0 + n) * K + k0 + 8 * c) = o; }
    LDS_WAIT();
}
__device__ __forceinline__ void cvt_row(const float* src, bf16_t* dst, float* ss, int lane) {
    const f32x4* xr = (const f32x4*)src + lane; f32x4 v[8]; float s = 0.f;
#pragma unroll
    for (int j = 0; j < 8; ++j) { v[j] = xr[64 * j]; s += (v[j].x * v[j].x + v[j].y * v[j].y) + (v[j].z * v[j].z + v[j].w * v[j].w); }
    s = wave_sum(s);
    u32x2* o8 = (u32x2*)dst + lane;
#pragma unroll
    for (int j = 0; j < 8; ++j) { u32x2 w; w.x = pk2(v[j].x, v[j].y); w.y = pk2(v[j].z, v[j].w); o8[64 * j] = w; }
    if (lane == 0) *ss = s;
}

struct Mix {
    const float *conv_a_w, *conv_a_b, *lru_br, *lru_bi, *lru_lambda, *conv_b_w;
    const bf16_t* gw;
    bf16_t* U; bf16_t* Y; unsigned long long* AGG;
};
struct ItemId { int hd, b, c, row0, ntok, agg; bool meta; };
__device__ __forceinline__ ItemId decode_item(int id) {
    ItemId I;
    if (id < 16) { I.meta = true; I.hd = id; I.b = 0; I.c = 0; I.row0 = META0; I.ntok = 16; I.agg = 256; }
    else { const int j = id - 16; I.meta = false; I.hd = j & 15; I.c = (j >> 4) & 63; I.b = j >> 10; I.row0 = I.b * SEQ + I.c * 64; I.ntok = 64; I.agg = I.b * 64 + I.c; }
    return I;
}
constexpr int N_ITEMS = 16 + NBATCH * NHEAD * 64;

__device__ __forceinline__ bool agg_ok(unsigned long long v) { return (unsigned)v != 0u; }
template <bool META> __device__ __forceinline__ void mix_item(const Mix& X, int id, LAS unsigned char* xt, int lane) {
    constexpr int NT = META ? 16 : 64, NTB = META ? 1 : 2, NQ = META ? 2 : 4;
    constexpr float LOG2E = 1.4426950408889634f;
    const ItemId I = decode_item(id);
    const int ch = I.hd * 64 + lane;
    const float nls2 = -8.0f * LOG2E * log1pf(__expf(-X.lru_lambda[ch]));
    bf16_t raw[NT], rh0 = 0, rh1 = 0, rh2 = 0;
    const float w0 = X.conv_a_w[ch], w1 = X.conv_a_w[1024 + ch], w2 = X.conv_a_w[2048 + ch], w3 = X.conv_a_w[3072 + ch], cb = X.conv_a_b[ch];
    {
        const GAS bf16_t* sb = (const GAS bf16_t*)(X.U + (size_t)I.row0 * DIN + I.hd * 64);
        if (!META) { const GAS bf16_t* hp0 = (I.c == 0) ? (const GAS bf16_t*)(X.U + (size_t)(META0 + 13) * DIN + I.hd * 64) : sb - 3 * DIN; rh0 = hp0[lane]; rh1 = hp0[DIN + lane]; rh2 = hp0[2 * DIN + lane]; }
#pragma unroll
        for (int t = 0; t < NT; ++t) { raw[t] = sb[lane]; sb += DIN; asm volatile("" : "+s"(sb)); }
    }
    bf16x8 BfR0[4], BfR1[4], BfI0[4], BfI1[4];
    { const bf16_t* gr = X.gw + (size_t)(I.hd * 64 + (lane & 31)) * 64 + 8 * (lane >> 5); const bf16_t* gi = gr + 16 * 64 * 64;
#pragma unroll
      for (int s = 0; s < 4; ++s) { BfR0[s] = *(const bf16x8*)(gr + 16 * s); BfR1[s] = *(const bf16x8*)(gr + 32 * 64 + 16 * s); BfI0[s] = *(const bf16x8*)(gi + 16 * s); BfI1[s] = *(const bf16x8*)(gi + 32 * 64 + 16 * s); } }
    asm volatile("" ::: "memory");
    float xm3 = bf1(rh0), xm2 = bf1(rh1), xm1 = bf1(rh2);
#pragma unroll
    for (int t = 0; t < NT; ++t) { const float x0 = bf1(raw[t]); const float xc = cb + w0 * xm3 + w1 * xm2 + w2 * xm1 + w3 * x0; xm3 = xm2; xm2 = xm1; xm1 = x0;
        *(LAS bf16_t*)(xt + t * 144 + lane * 2) = (bf16_t)f2bf(xc); }
    const float brA = X.lru_br[I.hd * 64 + (lane & 31)], brB = X.lru_br[I.hd * 64 + 32 + (lane & 31)], biA = X.lru_bi[I.hd * 64 + (lane & 31)], biB = X.lru_bi[I.hd * 64 + 32 + (lane & 31)];
    float h = 0.f, P = 1.f;
    unsigned hp[NT];
#pragma unroll
    for (int tb = 0; tb < NTB; ++tb) {
        f32x16 aR0, aR1, aI0, aI1;
#pragma unroll
        for (int e = 0; e < 16; ++e) { aR0[e] = brA; aR1[e] = brB; aI0[e] = biA; aI1[e] = biB; }
#pragma unroll
        for (int s = 0; s < 4; ++s) {
            const bf16x8 af = *(const LAS bf16x8*)(xt + (tb * 32 + (lane & 31)) * 144 + (16 * s + 8 * (lane >> 5)) * 2);
            aR0 = __builtin_amdgcn_mfma_f32_32x32x16_bf16(af, BfR0[s], aR0, 0, 0, 0);
            aR1 = __builtin_amdgcn_mfma_f32_32x32x16_bf16(af, BfR1[s], aR1, 0, 0, 0);
            aI0 = __builtin_amdgcn_mfma_f32_32x32x16_bf16(af, BfI0[s], aI0, 0, 0, 0);
            aI1 = __builtin_amdgcn_mfma_f32_32x32x16_bf16(af, BfI1[s], aI1, 0, 0, 0);
        }
#pragma unroll
        for (int q = 0; q < NQ; ++q) {
            float Rv[2][4], Iv[2][4];
#pragma unroll
            for (int k = 0; k < 4; ++k) {
                const int reg = 4 * q + k;
                const float r0f = aR0[reg], r1f = aR1[reg], i0f = aI0[reg], i1f = aI1[reg];
                auto r = __builtin_amdgcn_permlane32_swap(__float_as_uint(r0f), __float_as_uint(r1f), false, false);
                Rv[0][k] = __uint_as_float(r[0]); Rv[1][k] = __uint_as_float(r[1]);
                auto i2 = __builtin_amdgcn_permlane32_swap(__float_as_uint(i0f), __float_as_uint(i1f), false, false);
                Iv[0][k] = __uint_as_float(i2[0]); Iv[1][k] = __uint_as_float(i2[1]);
            }
#pragma unroll
            for (int st = 0; st < 2; ++st)
#pragma unroll
                for (int p = 0; p < 2; ++p) {
                    const int t = tb * 32 + 8 * q + 4 * st + 2 * p;
                    f32x2 er = (f32x2){Rv[st][2 * p], Rv[st][2 * p + 1]} * (-LOG2E), ei = (f32x2){Iv[st][2 * p], Iv[st][2 * p + 1]} * (-LOG2E);
                    er.x = __builtin_amdgcn_exp2f(er.x); er.y = __builtin_amdgcn_exp2f(er.y); ei.x = __builtin_amdgcn_exp2f(ei.x); ei.y = __builtin_amdgcn_exp2f(ei.y);
                    er = er + 1.0f; ei = ei + 1.0f;
                    f32x2 rg, ig; rg.x = __builtin_amdgcn_rcpf(er.x); rg.y = __builtin_amdgcn_rcpf(er.y); ig.x = __builtin_amdgcn_rcpf(ei.x); ig.y = __builtin_amdgcn_rcpf(ei.y);
                    const f32x2 l2 = rg * nls2;
                    f32x2 a; a.x = __builtin_amdgcn_exp2f(l2.x); a.y = __builtin_amdgcn_exp2f(l2.y);
                    f32x2 om = 1.0f - a * a; om.x = fmaxf(om.x, 0.f); om.y = fmaxf(om.y, 0.f);
                    f32x2 mu; mu.x = __builtin_amdgcn_sqrtf(om.x); mu.y = __builtin_amdgcn_sqrtf(om.y);
                    const f32x2 xc = (f32x2){bf1(*(const LAS bf16_t*)(xt + t * 144 + lane * 2)), bf1(*(const LAS bf16_t*)(xt + (t + 1) * 144 + lane * 2))};
                    const f32x2 bb = mu * ig * xc;
                    h = a.x * h + bb.x; P = P * a.x; hp[t] = pg8::cvt_pk_bf16(h, P);
                    h = a.y * h + bb.y; P = P * a.y; hp[t + 1] = pg8::cvt_pk_bf16(h, P);
                }
        }
    }
    __hip_atomic_store(X.AGG + (size_t)I.agg * 1024 + ch, ((unsigned long long)__float_as_uint(h) << 32) | (unsigned long long)__float_as_uint(P), __ATOMIC_RELAXED, __HIP_MEMORY_SCOPE_AGENT);
    asm volatile("" ::: "memory");
    bf16_t graw[NT];
    { const GAS bf16_t* sb = (const GAS bf16_t*)(X.U + (size_t)I.row0 * DIN + 1024 + I.hd * 64);
#pragma unroll
      for (int t = 0; t < NT; ++t) { graw[t] = sb[lane]; sb += DIN; asm volatile("" : "+s"(sb)); } }
    float hin = 0.f;
    if (!META) {
        { const unsigned long long* mp = X.AGG + (size_t)256 * 1024 + ch; unsigned long long v;
          for (;;) { v = __hip_atomic_load(mp, __ATOMIC_RELAXED, __HIP_MEMORY_SCOPE_AGENT); if (!__any(!agg_ok(v))) break; __builtin_amdgcn_s_sleep(2); }
          hin = __uint_as_float((unsigned)(v >> 32)); }
        const unsigned long long* ap = X.AGG + (size_t)(I.b * 64) * 1024 + ch;
        for (int j0 = 0; j0 < I.c; j0 += 16) {
            unsigned long long v[16];
            for (;;) {
                bool bad = false;
#pragma unroll
                for (int k = 0; k < 16; ++k) { v[k] = (j0 + k < I.c) ? __hip_atomic_load(ap + (size_t)(j0 + k) * 1024, __ATOMIC_RELAXED, __HIP_MEMORY_SCOPE_AGENT) : 0x000000003f800000ull; }
#pragma unroll
                for (int k = 0; k < 16; ++k) bad |= !agg_ok(v[k]);
                if (!__any(bad)) break;
                __builtin_amdgcn_s_sleep(2);
            }
#pragma unroll
            for (int k = 0; k < 16; ++k) hin = __uint_as_float((unsigned)v[k]) * hin + __uint_as_float((unsigned)(v[k] >> 32));
        }
    }
    asm volatile("" ::: "memory");
    GAS bf16_t* yp = (GAS bf16_t*)(X.Y + (size_t)I.row0 * DM + I.hd * 64);
#pragma unroll
    for (int t0 = 0; t0 < NT; t0 += 16) {
        {
#pragma unroll
            for (int k = 0; k < 16; k += 2) {
                const unsigned w0 = hp[t0 + k], w1 = hp[t0 + k + 1];
                const f32x2 gg = (f32x2){bf1(graw[t0 + k]), bf1(graw[t0 + k + 1])};
                f32x2 e = gg * (-LOG2E); e.x = __builtin_amdgcn_exp2f(e.x); e.y = __builtin_amdgcn_exp2f(e.y); e = e + 1.0f;
                f32x2 sg; sg.x = __builtin_amdgcn_rcpf(e.x); sg.y = __builtin_amdgcn_rcpf(e.y);
                const f32x2 hv = (f32x2){bflo(w0), bflo(w1)} + (f32x2){bfhi(w0), bfhi(w1)} * hin;
                const f32x2 y = hv * gg * sg;
                const unsigned pk = pg8::cvt_pk_bf16(y.x, y.y);
                yp[lane] = (bf16_t)(pk & 0xffffu); yp[DM + lane] = (bf16_t)(pk >> 16); yp += 2 * DM; asm volatile("" : "+s"(yp));
            }
        }
    }
}

__device__ __forceinline__ void ld8(const bf16_t* p, float (&o)[8]) {
    const u32x4 w = *(const u32x4*)p;
    o[0] = bflo(w.x); o[1] = bfhi(w.x); o[2] = bflo(w.y); o[3] = bfhi(w.y); o[4] = bflo(w.z); o[5] = bfhi(w.z); o[6] = bflo(w.w); o[7] = bfhi(w.w);
}
__device__ __forceinline__ void partb(const Mix& X, int tid) {
    int itn = blockIdx.x * 512 + tid; bool meta_done = false;
    for (;;) {
        int it;
        if (itn < 1024 * 128) { it = itn; itn += gridDim.x * 512; }
        else if (!meta_done && gridDim.x >= 8 && blockIdx.x + 4 >= gridDim.x && tid < 128) { it = (1024 + (int)(gridDim.x - 1 - blockIdx.x)) * 128 + tid; meta_done = true; }
        else if (!meta_done && gridDim.x < 8 && blockIdx.x == 0 && tid < 128) { it = 1028 * 128 + tid; meta_done = true; }
        else break;
        const int c0 = (it & 127) * 8, run = it >> 7;
        float w0[8], w1[8], w2[8], cm2[8], cm1[8];
        { const f32x4* p = (const f32x4*)(X.conv_b_w + c0); const f32x4 a0 = p[0], a1 = p[1], b0 = p[256], b1 = p[257], d0 = p[512], d1 = p[513];
#pragma unroll
          for (int e = 0; e < 4; ++e) { w0[e] = a0[e]; w0[4 + e] = a1[e]; w1[e] = b0[e]; w1[4 + e] = b1[e]; w2[e] = d0[e]; w2[4 + e] = d1[e]; } }
        if (run >= 1024) {
            const int t0 = (run == 1028) ? 0 : 4 * (run - 1024), nt = (run == 1028) ? 16 : 4;
            const bf16_t* up = X.U + (size_t)META0 * DIN + c0; bf16_t* yp = X.Y + (size_t)META0 * DM + 1024 + c0;
#pragma unroll
            for (int e = 0; e < 8; ++e) { cm2[e] = 0.f; cm1[e] = 0.f; }
            if (t0 > 0) {
                float c[8], x[8];
                ld8(up + (size_t)(t0 - 2) * DIN + 3072, c); ld8(up + (size_t)(t0 - 2) * DIN + 4096, x);
#pragma unroll
                for (int e = 0; e < 8; ++e) cm2[e] = c[e] * x[e];
                ld8(up + (size_t)(t0 - 1) * DIN + 3072, c); ld8(up + (size_t)(t0 - 1) * DIN + 4096, x);
#pragma unroll
                for (int e = 0; e < 8; ++e) cm1[e] = c[e] * x[e];
            }
#pragma unroll 4
            for (int t = t0; t < t0 + nt; ++t) {
                float bv[8], cv[8], xv[8], gv[8];
                ld8(up + (size_t)t * DIN + 2048, bv); ld8(up + (size_t)t * DIN + 3072, cv); ld8(up + (size_t)t * DIN + 4096, xv); ld8(up + (size_t)t * DIN + 5120, gv);
                float o[8];
#pragma unroll
                for (int e = 0; e < 8; ++e) { const float cx = cv[e] * xv[e]; const float y = w0[e] * cm2[e] + w1[e] * cm1[e] + w2[e] * cx; o[e] = bv[e] * y * (gv[e] * sigmoidf_(gv[e])); cm2[e] = cm1[e]; cm1[e] = cx; }
                u32x4 w; w.x = pk2(o[0], o[1]); w.y = pk2(o[2], o[3]); w.z = pk2(o[4], o[5]); w.w = pk2(o[6], o[7]);
                *(u32x4*)(yp + (size_t)t * DM) = w;
            }
            continue;
        }
        const int row0 = run * 16;
        const bf16_t* vp = X.U + (size_t)row0 * DIN + 2048 + 2 * c0;
        bf16_t* yp = X.Y + (size_t)row0 * DM + 1024 + c0;
        u32x4 q[16][2];
#pragma unroll
        for (int t = 0; t < 16; ++t) { q[t][0] = *(const u32x4*)(vp + (size_t)t * DIN); q[t][1] = *(const u32x4*)(vp + (size_t)t * DIN + 8); }
        if ((row0 & (SEQ - 1)) == 0) {
            float c[8], x[8];
            ld8(X.U + (size_t)(META0 + 14) * DIN + 3072 + c0, c); ld8(X.U + (size_t)(META0 + 14) * DIN + 4096 + c0, x);
#pragma unroll
            for (int e = 0; e < 8; ++e) cm2[e] = c[e] * x[e];
            ld8(X.U + (size_t)(META0 + 15) * DIN + 3072 + c0, c); ld8(X.U + (size_t)(META0 + 15) * DIN + 4096 + c0, x);
#pragma unroll
            for (int e = 0; e < 8; ++e) cm1[e] = c[e] * x[e];
        } else {
            const u32x4* p2 = (const u32x4*)(X.U + (size_t)(row0 - 2) * DIN + 2048 + 2 * c0); const u32x4* p1 = (const u32x4*)(X.U + (size_t)(row0 - 1) * DIN + 2048 + 2 * c0);
            const u32x4 a0 = p2[0], a1 = p2[1], b0 = p1[0], b1 = p1[1];
#pragma unroll
            for (int e = 0; e < 4; ++e) { cm2[e] = bfhi(a0[e]); cm2[4 + e] = bfhi(a1[e]); cm1[e] = bfhi(b0[e]); cm1[4 + e] = bfhi(b1[e]); }
        }
#pragma unroll
        for (int t = 0; t < 16; ++t) {
            float o[8];
#pragma unroll
            for (int e = 0; e < 8; ++e) { const unsigned qq = e < 4 ? q[t][0][e & 3] : q[t][1][e & 3]; const float bg = bflo(qq), cx = bfhi(qq);
                o[e] = bg * (w0[e] * cm2[e] + w1[e] * cm1[e] + w2[e] * cx); cm2[e] = cm1[e]; cm1[e] = cx; }
            u32x4 w; w.x = pk2(o[0], o[1]); w.y = pk2(o[2], o[3]); w.z = pk2(o[4], o[5]); w.w = pk2(o[6], o[7]);
            *(u32x4*)(yp + (size_t)t * DM) = w;
        }
    }
}


#ifdef DEBUG_NAIVE_MIX
__global__ void __launch_bounds__(64) naive_mixA(Mix X, const float* wr, const float* wi) {
    const int b = blockIdx.x / 16, hd = blockIdx.x % 16, lane = threadIdx.x, ch = hd * 64 + lane;
    __shared__ float xs[64];
    const float w0 = X.conv_a_w[ch], w1 = X.conv_a_w[1024 + ch], w2 = X.conv_a_w[2048 + ch], w3 = X.conv_a_w[3072 + ch], cb = X.conv_a_b[ch];
    const float br = X.lru_br[ch], bi = X.lru_bi[ch];
    const float sp = log1pf(expf(-X.lru_lambda[ch]));
    const float* wrh = wr + (size_t)hd * 4096 + lane; const float* wih = wi + (size_t)hd * 4096 + lane;
    float h = 0.f, xm3 = 0.f, xm2 = 0.f, xm1 = 0.f;
    for (int p = 0; p < NMETA + SEQ; ++p) {
        const int row = p < NMETA ? META0 + p : b * SEQ + (p - NMETA);
        const float x0 = bf1(X.U[(size_t)row * DIN + ch]);
        const float xc = cb + w0 * xm3 + w1 * xm2 + w2 * xm1 + w3 * x0; xm3 = xm2; xm2 = xm1; xm1 = x0;
        xs[lane] = xc; __syncthreads();
        float rp = br, ip = bi;
#pragma unroll 4
        for (int i = 0; i < 64; ++i) { rp += xs[i] * wrh[i * 64]; ip += xs[i] * wih[i * 64]; }
        __syncthreads();
        const float r = 1.f / (1.f + expf(-rp)), ig = 1.f / (1.f + expf(-ip));
        const float la = -8.f * r * sp; const float a = expf(la); const float bb = sqrtf(-expm1f(2.f * la)) * (ig * xc);
        h = a * h + bb;
        const float g = bf1(X.U[(size_t)row * DIN + 1024 + ch]);
        const float y = h * g / (1.f + expf(-g));
        if (p >= NMETA || b == 0) X.Y[(size_t)row * DM + ch] = (bf16_t)f2bf(y);
    }
}
__global__ void naive_mixB(Mix X) {
    for (size_t idx = (size_t)blockIdx.x * blockDim.x + threadIdx.x; idx < (size_t)(MROWS + NMETA) * 1024; idx += (size_t)gridDim.x * blockDim.x) {
        const int row = (int)(idx >> 10), c = (int)(idx & 1023);
        int r1, r2;
        if (row >= META0) { const int p = row - META0; r1 = p >= 1 ? row - 1 : -1; r2 = p >= 2 ? row - 2 : -1; }
        else { const int t = row & (SEQ - 1); r1 = t >= 1 ? row - 1 : META0 + 15; r2 = t >= 2 ? row - 2 : META0 + 14 + t; }
        auto cx = [&](int r) -> float { return r < 0 ? 0.f : bf1(X.U[(size_t)r * DIN + 3072 + c]) * bf1(X.U[(size_t)r * DIN + 4096 + c]); };
        const float y = X.conv_b_w[c] * cx(r2) + X.conv_b_w[1024 + c] * cx(r1) + X.conv_b_w[2048 + c] * cx(row);
        const float bv = bf1(X.U[(size_t)row * DIN + 2048 + c]), g = bf1(X.U[(size_t)row * DIN + 5120 + c]);
        X.Y[(size_t)row * DM + 1024 + c] = (bf16_t)f2bf(bv * y * g / (1.f + expf(-g)));
    }
}
#endif
#define XB_TMO      128
#define XB_XCNT(j)  (256  + 64 * (j))
#define XB_XSUB(j)  (1280 + 64 * (j))
#define XB_XGEN(j)  (2304 + 64 * (j))
#define XB_TOP      3328
#define XB_TOPGEN   3392
#define XCD_BAR_WORDS 3456
#define XB_SPIN_CAP (1u << 18)

__device__ __forceinline__ unsigned xb_ld(unsigned* p)              { return __hip_atomic_load(p, __ATOMIC_RELAXED, __HIP_MEMORY_SCOPE_AGENT); }
__device__ __forceinline__ unsigned xb_add(unsigned* p, unsigned v) { return __hip_atomic_fetch_add(p, v, __ATOMIC_RELAXED, __HIP_MEMORY_SCOPE_AGENT); }
__device__ __forceinline__ unsigned xb_xcc_id() { return (unsigned)__builtin_amdgcn_s_getreg((3 << 11) | 20) & 0xFu; }
#define XB_SPIN(cond, bar) do { unsigned _sp = 0; while (cond) { __builtin_amdgcn_s_sleep(1); \
    if ((++_sp & 255u) == 0u) { if (xb_ld(&(bar)[XB_TMO])) break; if (_sp > XB_SPIN_CAP) { atomicAdd(&(bar)[XB_TMO], 1u); break; } } } } while (0)

struct XcdBarrier {
    unsigned* bar; unsigned x;
    volatile LAS unsigned* st;
};

__device__ __forceinline__ XcdBarrier xcd_barrier_post(unsigned* bar, volatile LAS unsigned* st) {
    XcdBarrier b; b.bar = bar; b.x = xb_xcc_id(); b.st = st;
    if (threadIdx.x == 0) (void)xb_add(&bar[XB_XCNT(b.x)], 1u);
    return b;
}
__device__ __forceinline__ void xcd_barrier_complete(unsigned* bar, unsigned x, unsigned& nloc, unsigned& nx) {
    const unsigned G = gridDim.x * gridDim.y * gridDim.z;
    unsigned sum, cnt, mine, sp = 0u;
    for (;;) {
        sum = 0u; cnt = 0u; mine = 0u;
#pragma unroll
        for (unsigned j = 0; j < 16; ++j) { const unsigned c = xb_ld(&bar[XB_XCNT(j)]); sum += c; cnt += (c > 0u) ? 1u : 0u; mine = (j == x) ? c : mine; }
        if (sum == G) break;
        __builtin_amdgcn_s_sleep(1);
        if ((++sp & 255u) == 0u) { if (xb_ld(&bar[XB_TMO])) break; if (sp > XB_SPIN_CAP) { atomicAdd(&bar[XB_TMO], 1u); break; } }
    }
    nloc = mine > 0u ? mine : 1u; nx = cnt > 0u ? cnt : 1u;
}

__device__ __forceinline__ void xcd_barrier(const XcdBarrier& b) {
    asm volatile("s_waitcnt vmcnt(0)" ::: "memory");
    __syncthreads();
    if (threadIdx.x == 0) {
        unsigned* bar = b.bar;
        __builtin_amdgcn_s_waitcnt(0);
        unsigned nloc = b.st[0], nx = b.st[1];
        if (nloc == 0u) { xcd_barrier_complete(bar, b.x, nloc, nx); b.st[0] = nloc; b.st[1] = nx; }
        const unsigned old = xb_add(&bar[XB_XSUB(b.x)], 1u);
        const unsigned gen = old / nloc;
        if (old + 1u == (gen + 1u) * nloc) {
            __builtin_amdgcn_fence(__ATOMIC_RELEASE, "agent");
            asm volatile("s_waitcnt vmcnt(0)" ::: "memory");
            const unsigned og = xb_add(&bar[XB_TOP], 1u);
            const unsigned tg = og / nx;
            if (og + 1u == (tg + 1u) * nx) xb_add(&bar[XB_TOPGEN], 1u);
            else XB_SPIN(xb_ld(&bar[XB_TOPGEN]) == tg, bar);
            __builtin_amdgcn_fence(__ATOMIC_ACQUIRE, "agent");
            xb_add(&bar[XB_XGEN(b.x)], 1u);
            asm volatile("s_waitcnt vmcnt(0)" ::: "memory");
        } else {
            XB_SPIN(xb_ld(&bar[XB_XGEN(b.x)]) == gen, bar);
            __builtin_amdgcn_fence(__ATOMIC_ACQUIRE, "agent");
            asm volatile("s_waitcnt vmcnt(0)" ::: "memory");
        }
    }
    __syncthreads();
}

__global__ void __launch_bounds__(512, 2) hymba_fwd(Args a) {
    extern __shared__ __attribute__((aligned(16))) unsigned char lds_raw[];
    LAS unsigned char* lds = (LAS unsigned char*)lds_raw;
    cg::grid_group grid = cg::this_grid();
    const int NGW = gridDim.x * 8;
    if (threadIdx.x < 64) ((LAS unsigned*)(lds + 131072))[threadIdx.x] = 0u;
    __syncthreads();
    XcdBarrier xbar; xbar.bar = (unsigned*)(a.ws + WS_BAR); xbar.x = 0; xbar.st = nullptr;
    if (a.ph_hi - a.ph_lo > 1) xbar = xcd_barrier_post((unsigned*)(a.ws + WS_BAR), (volatile LAS unsigned*)(lds + 131072));
    if (a.ph_lo < 0) grid.sync();
#define LAUNDER() int tid = threadIdx.x; asm volatile("" : "+v"(tid)); const int wid = __builtin_amdgcn_readfirstlane(tid >> 6), lane = tid & 63, gw = blockIdx.x * 8 + wid
    const int lo = a.ph_lo, hi = a.ph_hi;
#define IN(k) (lo <= (k) && (k) < hi)
#ifndef STAGGER_N
#define STAGGER_N 0
#endif
#define STAGGER() do { if (STAGGER_N) for (int _k = 0; _k < (int)(blockIdx.x & 7); ++_k) __builtin_amdgcn_s_sleep(STAGGER_N); } while (0)
#define SEAM(k) do { if (IN(k) && IN((k) + 1)) { xcd_barrier(xbar); if ((REP_MASK >> 10) & 1) { xcd_barrier(xbar); xcd_barrier(xbar); } } } while (0)
    const float* x = a.in[0]; const float* meta = a.in[1]; const float* norm_g = a.in[2]; const float* w_in = a.in[3];
    const float* conv_a_w = a.in[4]; const float* conv_a_b = a.in[5]; const float* lru_wr = a.in[6]; const float* lru_br = a.in[7];
    const float* lru_wi = a.in[8]; const float* lru_bi = a.in[9]; const float* lru_lambda = a.in[10]; const float* conv_b_w = a.in[11];
    const float* w_out = a.in[12]; const float* final_g = a.in[13];
    unsigned char* ws = a.ws;
    bf16_t* WTIN = (bf16_t*)(ws + WS_WTIN); bf16_t* WTOUT = (bf16_t*)(ws + WS_WTOUT); bf16_t* GW = (bf16_t*)(ws + WS_GW);
    float* ROWSS = (float*)(ws + WS_ROWSS); unsigned long long* AGG = (unsigned long long*)(ws + WS_AGG);
    bf16_t* XB = (bf16_t*)(ws + WS_XB); bf16_t* Y = (bf16_t*)(ws + WS_Y); bf16_t* U = (bf16_t*)(ws + WS_U);

    if (IN(0)) for (int rep = 0; rep <= ((REP_MASK >> 0) & 1); ++rep) {
        LAUNDER();
        LAS unsigned char* scr = lds + wid * 16384;
        constexpr int I_IN = (DM / 64) * (DIN / 64);
        constexpr int NIT = I_IN + 64;
        for (int it = gw; it < NIT; it += NGW) {
            int r = it;
            if (r < I_IN) { tr_item<true>(w_in, DM, DIN, WTIN, norm_g, scr, r, lane); continue; } r -= I_IN;
            { const int mtx = r, l = mtx >> 5, g = (mtx >> 4) & 1, hd = mtx & 15;
              const float* src = (g ? lru_wi : lru_wr) + (size_t)(l * 16 + hd) * 4096;
              tr_item<false>(src, 64, 64, GW + (size_t)mtx * 4096, nullptr, scr, 0, lane); }
        }
        for (int m = gw; m < MROWS + NMETA; m += NGW) {
            const float* src = m < MROWS ? x + (size_t)m * DM : meta + (size_t)(m - MROWS) * DM;
            cvt_row(src, XB + (size_t)m * DM, ROWSS + m, lane);
        }
        for (int i = blockIdx.x * 512 + tid; i < 2 * RSTR; i += gridDim.x * 512) ROWSS[RSTR + i] = 0.f;
        for (int i = blockIdx.x * 512 + tid; i < AGG_PER_LAYER; i += gridDim.x * 512) ((u32x4*)AGG)[i] = (u32x4){0u, 0u, 0u, 0u};
    }
    SEAM(0);

#pragma unroll 1
    for (int l = 0; l < 2; ++l) {
        const int pb = 1 + 3 * l;
        const bf16_t* wtin = WTIN + (size_t)l * DIN * DM; const bf16_t* wtout = WTOUT + (size_t)l * DM * DM;
        float* rss_in = ROWSS + (size_t)l * RSTR; float* rss_out = ROWSS + (size_t)(l + 1) * RSTR;
        Mix X; X.conv_a_w = conv_a_w + l * 4 * DLRU; X.conv_a_b = conv_a_b + l * DLRU; X.lru_br = lru_br + l * DLRU; X.lru_bi = lru_bi + l * DLRU; X.lru_lambda = lru_lambda + l * DLRU;
        X.conv_b_w = conv_b_w + l * 3 * DLRU; X.gw = GW + (size_t)l * 2 * 16 * 4096; X.U = U; X.Y = Y; X.AGG = AGG + (size_t)l * AGG_PER_LAYER;

        if (IN(pb)) for (int rep = 0; rep <= ((REP_MASK >> pb) & 1); ++rep) {
            LAUNDER();
            STAGGER();
            for (int mrep = 0; mrep <= ((REP_MASK >> 16) & 1); ++mrep)
            meta_gemm(XB + (size_t)META0 * DM, wtin, DIN / 16, lds, wid, lane, [&](int m, int n0, f32x4 s) {
                const float rs = rsqrtf(rss_in[META0 + m] * (1.0f / DM) + RMS_EPS);
                u32x2 w; w.x = pk2(s[0] * rs, s[1] * rs); w.y = pk2(s[2] * rs, s[3] * rs);
                *(u32x2*)(U + (size_t)(META0 + m) * DIN + in_col(n0)) = w; });
            pg8::Gemm g{XB, wtin, MROWS, DIN, DM}; pg8::StaticOrder S; S.init(MROWS, DIN, (int)gridDim.x, (int)blockIdx.x);
            if ((REP_MASK >> 17) & 1) { EpiUT<true> En{U, rss_in}; pg8::gemm_phase<EpiUT<true>, pg8::StaticOrder, false>(lds, g, S, En, nullptr); }
            if ((REP_MASK >> 15) & 1) { EpiNull En{ROWSS + (size_t)3 * RSTR}; pg8::gemm_phase<EpiNull, pg8::StaticOrder, false>(lds, g, S, En, nullptr); }
            EpiU E{U, rss_in};
            pg8::gemm_phase<EpiU, pg8::StaticOrder, false>(lds, g, S, E, nullptr);
        }
        SEAM(pb);
        if (IN(pb + 1)) for (int rep = 0; rep <= ((REP_MASK >> (pb + 1)) & 1); ++rep) {
            LAUNDER();
#pragma unroll 1
            for (int step = 0; step < 2; ++step) {
                if ((step == 0) == (wid < 4)) {
                    if (rep == 1 && ((REP_MASK >> 13) & 1)) continue;
#pragma unroll 1
                    for (int id = gw; id < N_ITEMS; id += NGW) { if (id < 16) mix_item<true>(X, id, lds + wid * 9216, lane); else mix_item<false>(X, id, lds + wid * 9216, lane); }
                } else { if (rep == 1 && ((REP_MASK >> 12) & 1)) continue; partb(X, tid); }
            }
            {
                constexpr int I_IN = (DM / 64) * (DIN / 64), I_OUT = (DM / 64) * (DM / 64);
                LAS unsigned char* scr = lds + wid * 9216;
                const int nit = (l == 0) ? I_IN + I_OUT : I_OUT;
#pragma unroll 1
                for (int it = gw; it < nit; it += NGW) {
                    if (l == 0 && it < I_IN) tr_item<true>(w_in + (size_t)DM * DIN, DM, DIN, WTIN + (size_t)DIN * DM, norm_g + DM, scr, it, lane);
                    else { const int r = (l == 0) ? it - I_IN : it; tr_item<false>(w_out + (size_t)l * DM * DM, DM, DM, WTOUT + (size_t)l * DM * DM, nullptr, scr, r, lane); }
                }
            }
        }
        SEAM(pb + 1);
        if (IN(pb + 2)) {
            LAUNDER();
            STAGGER();
            if (l == 0) {
                meta_gemm(Y + (size_t)META0 * DM, wtout, DM / 16, lds, wid, lane, [&](int m, int n0, f32x4 s) {
                    const f32x4 r = *(const f32x4*)(meta + (size_t)m * DM + n0); const f32x4 hh = r + s;
                    u32x2 w; w.x = pk2(hh[0], hh[1]); w.y = pk2(hh[2], hh[3]);
                    *(u32x2*)(XB + (size_t)(META0 + m) * DM + n0) = w;
                    unsafeAtomicAdd(rss_out + META0 + m, (hh[0] * hh[0] + hh[1] * hh[1]) + (hh[2] * hh[2] + hh[3] * hh[3])); });
            }
            pg8::Gemm g{Y, wtout, MROWS, DM, DM};
            if (l == 0) {
                pg8::StaticOrder S; S.init(MROWS, DM, (int)gridDim.x, (int)blockIdx.x);
                if ((REP_MASK >> 11) & 1) { EpiU Ed{U, rss_in}; pg8::gemm_phase<EpiU, pg8::StaticOrder, false>(lds, g, S, Ed, nullptr); }
                if ((REP_MASK >> 14) & 1) { EpiRes Ed{x, nullptr, XB, ROWSS + (size_t)3 * RSTR}; pg8::gemm_phase<EpiRes, pg8::StaticOrder, false>(lds, g, S, Ed, nullptr); }
                EpiRes E{x, nullptr, XB, rss_out};
                pg8::gemm_phase<EpiRes, pg8::StaticOrder, false>(lds, g, S, E, nullptr);
            } else {
                PanelOrder S; S.init((int)gridDim.x, (int)blockIdx.x);
                EpiResNorm E{XB, a.out, rss_out, (unsigned*)(ws + WS_PCNT), final_g};
                pg8::gemm_phase<EpiResNorm, PanelOrder, false>(lds, g, S, E, nullptr);
            }
        }
        SEAM(pb + 2);
    }

#undef IN
#undef SEAM
}

#ifndef MK_LAUNCH_PER_PHASE
#define MK_LAUNCH_PER_PHASE 0
#endif
extern "C" void kernel_launch(void* const* d_in, const int* in_sizes, int n_in, void* d_out, int out_size, void* d_ws, size_t ws_size, hipStream_t stream) {
    static int grid = 0;
    if (grid == 0) {
        if (n_in != 14 || in_sizes[0] != MROWS * DM || out_size != MROWS * DM || ws_size < WS_END) { fprintf(stderr, "kernel_launch: unexpected shapes (n_in %d, in0 %d, out %d, ws %zu)\n", n_in, n_in > 0 ? in_sizes[0] : -1, out_size, ws_size); grid = -1; return; }
        int dev = 0, cus = 0, per_cu = 0;
        hipGetDevice(&dev); hipDeviceGetAttribute(&cus, hipDeviceAttributeMultiprocessorCount, dev);
        if (hipFuncSetAttribute((const void*)hymba_fwd, hipFuncAttributeMaxDynamicSharedMemorySize, LDS_BYTES) != hipSuccess) { fprintf(stderr, "kernel_launch: hipFuncSetAttribute failed\n"); grid = -1; return; }
        if (hipOccupancyMaxActiveBlocksPerMultiprocessor(&per_cu, (const void*)hymba_fwd, 512, LDS_BYTES) != hipSuccess || per_cu < 1) { fprintf(stderr, "kernel_launch: occupancy query gave %d\n", per_cu); per_cu = 1; }
        (void)hipGetLastError();
        grid = cus * per_cu;
    }
    if (grid < 0) return;
    Args a{};
    for (int i = 0; i < 14; ++i) a.in[i] = (const float*)d_in[i];
    a.out = (float*)d_out; a.ws = (unsigned char*)d_ws;
#if MK_LAUNCH_PER_PHASE
    for (int p = 0; p < NPHASE; ++p) {
#ifdef DEBUG_NAIVE_MIX
        if (p == 2 || p == 6) { const int l = p / 4; unsigned char* ws = (unsigned char*)d_ws;
            Mix X; X.conv_a_w = a.in[4] + l * 4 * DLRU; X.conv_a_b = a.in[5] + l * DLRU; X.lru_br = a.in[7] + l * DLRU; X.lru_bi = a.in[9] + l * DLRU; X.lru_lambda = a.in[10] + l * DLRU;
            X.conv_b_w = a.in[11] + l * 3 * DLRU; X.gw = nullptr; X.U = (bf16_t*)(ws + WS_U); X.Y = (bf16_t*)(ws + WS_Y); X.HP = nullptr; X.AGG = nullptr;
#if DEBUG_NAIVE_MIX == 1
            hipLaunchKernelGGL(naive_mixA, dim3(64), dim3(64), 0, stream, X, a.in[6] + (size_t)l * 16 * 4096, a.in[8] + (size_t)l * 16 * 4096);
            a.flags = 1;
#else
            hipLaunchKernelGGL(naive_mixB, dim3(2048), dim3(256), 0, stream, X);
            a.flags = 2;
#endif
            }
        else a.flags = 0;
#if DEBUG_NAIVE_MIX == 1
        if (p == 3 || p == 7) continue;
#endif
#endif
        a.ph_lo = p; a.ph_hi = p + 1; hipLaunchKernelGGL(hymba_fwd, dim3(grid), dim3(512), LDS_BYTES, stream, a); }
#else
    a.ph_lo = 0; a.ph_hi = NPHASE;
    if (hipMemsetAsync((unsigned char*)d_ws + WS_BAR, 0, 16384 + 32768, stream) != hipSuccess) { fprintf(stderr, "kernel_launch: memset of barrier words failed\n"); return; }
    void* args[] = {&a};
    const hipError_t e = hipLaunchCooperativeKernel((const void*)hymba_fwd, dim3(grid), dim3(512), args, LDS_BYTES, stream);
    if (e != hipSuccess) fprintf(stderr, "kernel_launch: cooperative launch failed: %s (grid %d)\n", hipGetErrorString(e), grid);
#endif
}
```

```cpp
#include <hip/hip_runtime.h>
#include <hip/hip_cooperative_groups.h>
#include <cstdio>
namespace cg = cooperative_groups;
namespace pg8 {
#define PG8_LAS __attribute__((address_space(3)))
typedef unsigned short bf16_t;
typedef short bf16x8 __attribute__((ext_vector_type(8)));
typedef float f32x4 __attribute__((ext_vector_type(4)));
typedef unsigned u32x4 __attribute__((ext_vector_type(4)));
constexpr int BM = 256, BK = 64, HALF = 128, HTB = HALF * BK * 2  , STAGE_BYTES = 8 * HTB, NXCD = 8, WGM = 4;

__host__ __device__ __forceinline__ int lds_byte(int r, int c) { const int st = (r >> 4) * 2 + (c >> 5), rr = r & 15, cc = c & 31, ob = rr * 64 + cc * 2; return st * 1024 + (ob ^ (((ob >> 9) & 1) << 5)); }
__host__ __device__ __forceinline__ void stage_rc(int b, int& R, int& C) { const int st = b / 1024, sb = b % 1024, swz = sb ^ (((sb >> 9) & 1) << 5); R = (st >> 1) * 16 + swz / 64; C = (st & 1) * 32 + (swz % 64) / 2; }
__host__ __device__ __forceinline__ int perm32(int rho) { const int n = rho >> 4, i = rho & 15; return 8 * (i >> 2) + 4 * n + (i & 3); }

struct Unit { int pm, pn; };
struct Gemm { const bf16_t* A; const bf16_t* Bt; int M, N, K; };

struct StaticOrder {
    int nM, nN, nwg, G, c;
    __host__ __device__ void init(int M, int N, int G_, int c_) { nM = M / BM; nN = N / BM; nwg = nM * nN; G = G_; c = c_; }
    __host__ __device__ bool next(int i, Unit& u) const {
        const long L = (long)i * G + c; if (L >= nwg) return false;
        int wgid = (int)L; { const int q = nwg / NXCD, r = nwg % NXCD, xcd = wgid % NXCD, off = wgid / NXCD; wgid = (xcd < r ? xcd * (q + 1) : r * (q + 1) + (xcd - r) * q) + off; }
        const int nig = WGM * nN, gid = wgid / nig, fm = gid * WGM, gsz = (nM - fm) < WGM ? (nM - fm) : WGM;
        u.pm = fm + ((wgid % nig) % gsz); u.pn = (wgid % nig) / gsz; return true;
    }
    __device__ __forceinline__ void a_ready(const Unit&) const {}
    __device__ __forceinline__ void done(const Unit&) const {}
};
__device__ __forceinline__ unsigned cvt_pk_bf16(float lo, float hi) { unsigned r; asm volatile("v_cvt_pk_bf16_f32 %0, %1, %2" : "=v"(r) : "v"(lo), "v"(hi)); return r; }
template <class Epi, class Sched, bool STAMP = false>
__device__ __forceinline__ void gemm_phase(PG8_LAS unsigned char* lds, const Gemm g, const Sched& S, const Epi& E, unsigned long long* stamps) {
    int tid_l = threadIdx.x; asm volatile("" : "+v"(tid_l));
    const int tid = tid_l, wid = __builtin_amdgcn_readfirstlane(tid >> 6), lane = tid & 63, wr = wid >> 2, wc = wid & 3, fr = lane & 15, fq = lane >> 4;
    const int K = g.K, nt = K / BK;
    int ts_lo = 0, ts_hi = 0, nts = 0; const unsigned long long rt_entry = STAMP ? (unsigned long long)wall_clock64() : 0ull;
#define PG8_STAMP() do { if (STAMP && wid == 0 && nts < 64) { const unsigned long long _c = (unsigned long long)clock64(); \
        ts_lo = (lane == nts) ? (int)(unsigned)_c : ts_lo; ts_hi = (lane == nts) ? (int)(unsigned)(_c >> 32) : ts_hi; ++nts; } } while (0)
    PG8_STAMP();
    unsigned voffA[2], voffB[2];
#pragma unroll
    for (int i = 0; i < 2; ++i) { int R, C; stage_rc(tid * 16 + i * 8192, R, C); const int Rb = Epi::PERM ? ((R & ~31) + perm32(R & 31)) : R;
        voffA[i] = (unsigned)(R * K + C) * 2u; voffB[i] = (unsigned)(Rb * K + C) * 2u; }
    const size_t kstep = (size_t)(BK * 2);
    const size_t hstep = (size_t)HALF * K * 2;
    const size_t tstep = 2 * hstep;
    const unsigned ldsw = (unsigned)wid * 1024u;
    const int aoff = lds_byte(wr * 64 + fr, fq * 8), boff = lds_byte(wc * 32 + fr, fq * 8);
#define PG8_SA(b, h) (((b) * 2 + (h)) * HTB)
#define PG8_SB(b, h) ((4 + (b) * 2 + (h)) * HTB)
#define PG8_STAGE(bufoff, gbase, voff) do { _Pragma("unroll") for (int _i = 0; _i < 2; ++_i) \
        __builtin_amdgcn_global_load_lds((const unsigned*)((const char*)(gbase) + (voff)[_i]), (PG8_LAS unsigned*)(lds + (bufoff) + ldsw + _i * 8192), 16, 0, 0); } while (0)
#define PG8_LDA(dst, b, h) do { _Pragma("unroll") for (int m = 0; m < 4; ++m) _Pragma("unroll") for (int k = 0; k < 2; ++k) dst[m][k] = *(const PG8_LAS bf16x8*)(lds + PG8_SA(b, h) + aoff + m * 2048 + k * 1024); } while (0)
#define PG8_LDB(dst, b, h) do { _Pragma("unroll") for (int n = 0; n < 2; ++n) _Pragma("unroll") for (int k = 0; k < 2; ++k) dst[n][k] = *(const PG8_LAS bf16x8*)(lds + PG8_SB(b, h) + boff + n * 2048 + k * 1024); } while (0)
#define PG8_MMA(ai, bj, At, Bt) do { __builtin_amdgcn_s_setprio(1); _Pragma("unroll") for (int m = 0; m < 4; ++m) _Pragma("unroll") for (int n = 0; n < 2; ++n) _Pragma("unroll") for (int k = 0; k < 2; ++k) \
        acc[ai][bj][m][n] = __builtin_amdgcn_mfma_f32_16x16x32_bf16(Bt[n][k], At[m][k], acc[ai][bj][m][n], 0, 0, 0); __builtin_amdgcn_s_setprio(0); } while (0)
#define PG8_WAIT_V(n) asm volatile("s_waitcnt vmcnt(" #n ")" ::: "memory")
#define PG8_WAIT_L(n) asm volatile("s_waitcnt lgkmcnt(" #n ")" ::: "memory")
#define PG8_BAR __builtin_amdgcn_s_barrier()
#define PG8_SCHED __builtin_amdgcn_sched_barrier(0)
    Unit cur, nxt; int ui = 0;
    if (!S.next(0, cur)) return;
    f32x4 acc[2][2][4][2];
#pragma unroll
    for (int a = 0; a < 2; ++a)
#pragma unroll
        for (int b = 0; b < 2; ++b)
#pragma unroll
            for (int m = 0; m < 4; ++m)
#pragma unroll
                for (int n = 0; n < 2; ++n) acc[a][b][m][n] = (f32x4){0.f, 0.f, 0.f, 0.f};
    bf16x8 At[4][2], B0[2][2], B1[2][2];
    const char* cA = (const char*)g.A + (size_t)cur.pm * tstep; const char* cB = (const char*)g.Bt + (size_t)cur.pn * tstep;
    S.a_ready(cur);
    PG8_STAGE(PG8_SB(0, 0), cB, voffB); PG8_STAGE(PG8_SA(0, 0), cA, voffA); PG8_STAGE(PG8_SB(0, 1), cB + hstep, voffB); PG8_STAGE(PG8_SA(0, 1), cA + hstep, voffA);
    if (wr == 1) PG8_BAR;
    PG8_WAIT_V(4); PG8_BAR;
    PG8_STAGE(PG8_SB(1, 0), cB + kstep, voffB); PG8_STAGE(PG8_SA(1, 0), cA + kstep, voffA); PG8_STAGE(PG8_SB(1, 1), cB + hstep + kstep, voffB);
    PG8_WAIT_V(6); PG8_BAR;
    PG8_STAMP();
    for (;;) {
        const bool has_next = S.next(ui + 1, nxt);
        const char* nA = has_next ? (const char*)g.A + (size_t)nxt.pm * tstep : cA; const char* nB = has_next ? (const char*)g.Bt + (size_t)nxt.pn * tstep : cB;
        for (int t = 0; t < nt; t += 2) {
            const bool last = (t == nt - 2);
            const char* a1 = cA + (size_t)(t + 1) * kstep;
            const char* a2 = last ? nA : cA + (size_t)(t + 2) * kstep; const char* b2 = last ? nB : cB + (size_t)(t + 2) * kstep;
            const char* a3 = a2 + kstep; const char* b3 = b2 + kstep;
            if (last && has_next) S.a_ready(nxt);
            PG8_LDB(B0, 0, 0); PG8_SCHED; PG8_LDA(At, 0, 0); PG8_STAGE(PG8_SA(1, 1), a1 + hstep, voffA);
            PG8_WAIT_L(8); PG8_BAR; PG8_WAIT_L(0); PG8_MMA(0, 0, At, B0); PG8_BAR; PG8_SCHED;
            PG8_LDB(B1, 0, 1); PG8_STAGE(PG8_SB(0, 0), b2, voffB);
            PG8_BAR; PG8_WAIT_L(0); PG8_MMA(0, 1, At, B1); PG8_BAR;
            PG8_LDA(At, 0, 1); PG8_STAGE(PG8_SA(0, 0), a2, voffA);
            PG8_BAR; PG8_WAIT_L(0); PG8_MMA(1, 0, At, B0); PG8_BAR; PG8_SCHED;
            PG8_STAGE(PG8_SB(0, 1), b2 + hstep, voffB);
            PG8_WAIT_V(6); PG8_BAR; PG8_MMA(1, 1, At, B1); PG8_BAR;
            PG8_LDB(B0, 1, 0); PG8_SCHED; PG8_LDA(At, 1, 0); PG8_STAGE(PG8_SA(0, 1), a2 + hstep, voffA);
            PG8_WAIT_L(8); PG8_BAR; PG8_WAIT_L(0); PG8_MMA(0, 0, At, B0); PG8_BAR; PG8_SCHED;
            PG8_LDB(B1, 1, 1); PG8_STAGE(PG8_SB(1, 0), b3, voffB);
            PG8_BAR; PG8_WAIT_L(0); PG8_MMA(0, 1, At, B1); PG8_BAR;
            PG8_LDA(At, 1, 1); PG8_STAGE(PG8_SA(1, 0), a3, voffA);
            PG8_BAR; PG8_WAIT_L(0); PG8_MMA(1, 0, At, B0); PG8_BAR; PG8_SCHED;
            PG8_STAGE(PG8_SB(1, 1), b3 + hstep, voffB);
            PG8_WAIT_V(6); PG8_BAR; PG8_MMA(1, 1, At, B1); PG8_BAR;
        }
        PG8_STAMP();
        if constexpr (!Epi::AFTER_DRAIN) { if (wr == 0) PG8_BAR; E(acc, cur, wr, wc, fr, fq); S.done(cur); if (has_next) { if (wr == 1) PG8_BAR; } }
        PG8_STAMP();
        if (!has_next) break;
#pragma unroll
        for (int a = 0; a < 2; ++a)
#pragma unroll
            for (int b = 0; b < 2; ++b)
#pragma unroll
                for (int m = 0; m < 4; ++m)
#pragma unroll
                    for (int n = 0; n < 2; ++n) acc[a][b][m][n] = (f32x4){0.f, 0.f, 0.f, 0.f};
        cur = nxt; cA = nA; cB = nB; ++ui;
    }
    PG8_WAIT_V(0);
    if constexpr (Epi::AFTER_DRAIN) { if (wr == 0) PG8_BAR; }
    PG8_BAR;
    if constexpr (Epi::AFTER_DRAIN) { E.fused(acc, cur, wr, wc, fr, fq, lds, wid, lane); S.done(cur); }
    PG8_STAMP();
    if (STAMP && wid == 0) { stamps[lane] = lane < nts ? (((unsigned long long)(unsigned)ts_hi << 32) | (unsigned)ts_lo) : 0ull;
        if (lane == 62) stamps[62] = rt_entry; if (lane == 63) stamps[63] = (unsigned long long)wall_clock64(); }
#undef PG8_STAMP
#undef PG8_SA
#undef PG8_SB
#undef PG8_STAGE
#undef PG8_LDA
#undef PG8_LDB
#undef PG8_MMA
#undef PG8_WAIT_V
#undef PG8_WAIT_L
#undef PG8_BAR
#undef PG8_SCHED
}
}

#define LAS __attribute__((address_space(3)))
#define GAS __attribute__((address_space(1)))
typedef unsigned short bf16_t;
typedef short bf16x8 __attribute__((ext_vector_type(8)));
typedef float f32x4 __attribute__((ext_vector_type(4)));
typedef float f32x2 __attribute__((ext_vector_type(2)));
typedef float f32x16 __attribute__((ext_vector_type(16)));
typedef unsigned u32x4 __attribute__((ext_vector_type(4)));
typedef unsigned u32x2 __attribute__((ext_vector_type(2)));

constexpr int DM = 2048, NBATCH = 4, SEQ = 4096, MROWS = NBATCH * SEQ, NMETA = 16, DIN = 6144, DLRU = 1024, NHEAD = 16;
constexpr int META0 = MROWS;
constexpr int RSTR = MROWS + 64;
constexpr float RMS_EPS = 1e-6f;
constexpr int NPHASE = 7;
#ifndef REP_MASK
#define REP_MASK 0
#endif
constexpr int LDS_BYTES = 131072 + 256;

constexpr size_t MiB = 1u << 20;
constexpr size_t WS_WTIN = 0;
constexpr size_t WS_WTOUT = 48 * MiB;
constexpr size_t WS_GW = 64 * MiB;
constexpr size_t WS_ROWSS = 65 * MiB;
constexpr size_t WS_BAR = 65 * MiB + 512 * 1024;
constexpr size_t WS_PCNT = WS_BAR + 16384;
constexpr size_t WS_AGG = 66 * MiB;
constexpr size_t WS_XB = 71 * MiB;
constexpr size_t WS_Y = 136 * MiB;
constexpr size_t WS_U = 201 * MiB;
constexpr size_t WS_END = 396 * MiB;
constexpr int AGG_PER_LAYER = 257 * 1024;
static_assert(WS_U + (size_t)RSTR * DIN * 2 <= WS_END && WS_Y + (size_t)RSTR * DM * 2 <= WS_U && WS_XB + (size_t)RSTR * DM * 2 <= WS_Y, "ws map");
static_assert(WS_WTIN + (size_t)2 * DIN * DM * 2 <= WS_WTOUT && WS_WTOUT + (size_t)2 * DM * DM * 2 <= WS_GW && WS_AGG + (size_t)2 * AGG_PER_LAYER * 8 <= WS_XB && WS_ROWSS + (size_t)3 * RSTR * 4 <= WS_BAR, "ws map 2");

struct Args { const float* in[14]; float* out; unsigned char* ws; int ph_lo, ph_hi, flags, pad; };

__device__ __forceinline__ unsigned f2bf(float f) { unsigned u = __builtin_bit_cast(unsigned, f); return (u + 0x7fffu + ((u >> 16) & 1u)) >> 16; }
__device__ __forceinline__ unsigned pk2(float lo, float hi) { return f2bf(lo) | (f2bf(hi) << 16); }
__device__ __forceinline__ float bflo(unsigned w) { return __builtin_bit_cast(float, w << 16); }
__device__ __forceinline__ float bfhi(unsigned w) { return __builtin_bit_cast(float, w & 0xffff0000u); }
__device__ __forceinline__ float bf1(bf16_t v) { return __builtin_bit_cast(float, ((unsigned)v) << 16); }
__device__ __forceinline__ float sigmoidf_(float z) { return __builtin_amdgcn_rcpf(1.0f + __expf(-z)); }
__device__ __forceinline__ float wave_sum(float v) {
#pragma unroll
    for (int o = 1; o < 64; o <<= 1) v += __shfl_xor(v, o);
    return v;
}
#define LDS_WAIT() asm volatile("s_waitcnt lgkmcnt(0)" ::: "memory")

template <bool NORS> struct EpiUT {
    static constexpr bool PERM = true, AFTER_DRAIN = false;
    bf16_t* O; const float* rowss;
    __device__ __forceinline__ void operator()(const f32x4 (&acc)[2][2][4][2], const pg8::Unit& u, int wr, int wc, int fr, int fq) const {
        const int row0 = u.pm * 256 + wr * 64 + fr, col0 = u.pn * 256 + wc * 32 + 8 * fq;
        if (u.pn >= 8) {
            const int ch0 = 64 * (u.pn - 8) + 16 * wc + 4 * fq;
#pragma unroll
            for (int ai = 0; ai < 2; ++ai)
#pragma unroll
                for (int m = 0; m < 4; ++m) {
                    const int r = row0 + ai * 128 + m * 16;
                    const float rs = NORS ? 1.0f : rsqrtf(rowss[r] * (1.0f / DM) + RMS_EPS);
                    const f32x4 bv = acc[ai][0][m][0] * rs, cv = acc[ai][0][m][1] * rs, xv = acc[ai][1][m][0] * rs, gv = acc[ai][1][m][1] * rs;
                    u32x4 w;
#pragma unroll
                    for (int i = 0; i < 4; ++i) w[i] = pg8::cvt_pk_bf16(bv[i] * gv[i] * sigmoidf_(gv[i]), cv[i] * xv[i]);
                    *(u32x4*)(O + (size_t)r * DIN + 2048 + 2 * ch0) = w;
                }
            return;
        }
#pragma unroll
        for (int ai = 0; ai < 2; ++ai)
#pragma unroll
            for (int m = 0; m < 4; ++m) {
                const int r = row0 + ai * 128 + m * 16;
                const float rs = NORS ? 1.0f : rsqrtf(rowss[r] * (1.0f / DM) + RMS_EPS);
                bf16_t* rowp = O + (size_t)r * DIN + col0;
#pragma unroll
                for (int bj = 0; bj < 2; ++bj) {
                    const f32x4 v0 = acc[ai][bj][m][0] * rs, v1 = acc[ai][bj][m][1] * rs;
                    u32x4 w; w.x = pg8::cvt_pk_bf16(v0[0], v0[1]); w.y = pg8::cvt_pk_bf16(v0[2], v0[3]); w.z = pg8::cvt_pk_bf16(v1[0], v1[1]); w.w = pg8::cvt_pk_bf16(v1[2], v1[3]);
                    *(u32x4*)(rowp + bj * 128) = w;
                }
            }
    }
};
struct EpiNull {
    static constexpr bool PERM = true, AFTER_DRAIN = false;
    float* sink;
    __device__ __forceinline__ void operator()(const f32x4 (&acc)[2][2][4][2], const pg8::Unit& u, int wr, int wc, int fr, int fq) const {
        f32x4 s = {0.f, 0.f, 0.f, 0.f};
#pragma unroll
        for (int ai = 0; ai < 2; ++ai)
#pragma unroll
            for (int bj = 0; bj < 2; ++bj)
#pragma unroll
                for (int m = 0; m < 4; ++m) { s += acc[ai][bj][m][0]; s += acc[ai][bj][m][1]; }
        if (s[0] + s[1] + s[2] + s[3] == 1.2345678e33f) sink[u.pm] = s[0];
    }
};
typedef EpiUT<false> EpiU;
#ifndef EPI_MB
#define EPI_MB 2
#endif
struct EpiRes {
    static constexpr bool PERM = true, AFTER_DRAIN = false;
    const float* res; float* out; bf16_t* xb; float* rowss;
    __device__ __forceinline__ void operator()(const f32x4 (&acc)[2][2][4][2], const pg8::Unit& u, int wr, int wc, int fr, int fq) const {
        const int row0 = u.pm * 256 + wr * 64 + fr, col0 = u.pn * 256 + wc * 32 + 8 * fq;
#pragma unroll
        for (int ai = 0; ai < 2; ++ai) {
#pragma unroll
          for (int mh = 0; mh < 4; mh += EPI_MB) {
            f32x4 rv[4][2][2];
#pragma unroll
            for (int m = mh; m < mh + EPI_MB; ++m)
#pragma unroll
                for (int bj = 0; bj < 2; ++bj) { const float* p = res + (size_t)(row0 + ai * 128 + m * 16) * DM + col0 + bj * 128; rv[m][bj][0] = *(const f32x4*)p; rv[m][bj][1] = *(const f32x4*)(p + 4); }
            asm volatile("" ::: "memory");
#pragma unroll
            for (int m = mh; m < mh + EPI_MB; ++m) {
                const int r = row0 + ai * 128 + m * 16; const size_t off = (size_t)r * DM + col0; float ss = 0.f;
#pragma unroll
                for (int bj = 0; bj < 2; ++bj) {
                    const f32x4 h0 = rv[m][bj][0] + acc[ai][bj][m][0], h1 = rv[m][bj][1] + acc[ai][bj][m][1];
                    if (out) { *(f32x4*)(out + off + bj * 128) = h0; *(f32x4*)(out + off + bj * 128 + 4) = h1; }
                    if (xb) { u32x4 w; w.x = pg8::cvt_pk_bf16(h0[0], h0[1]); w.y = pg8::cvt_pk_bf16(h0[2], h0[3]); w.z = pg8::cvt_pk_bf16(h1[0], h1[1]); w.w = pg8::cvt_pk_bf16(h1[2], h1[3]);
                        *(u32x4*)(xb + off + bj * 128) = w; }
                    ss += (h0[0] * h0[0] + h0[1] * h0[1]) + (h0[2] * h0[2] + h0[3] * h0[3]) + (h1[0] * h1[0] + h1[1] * h1[1]) + (h1[2] * h1[2] + h1[3] * h1[3]);
                }
                ss += __shfl_xor(ss, 16); ss += __shfl_xor(ss, 32);
                if (fq == 0) unsafeAtomicAdd(rowss + r, ss);
            }
            asm volatile("" ::: "memory");
          }
        }
    }
};

struct EpiResNorm {
    static constexpr bool PERM = true, AFTER_DRAIN = false;
    const bf16_t* res; float* out; float* rowss; unsigned* cnt; const float* fg;
    __device__ __forceinline__ void operator()(f32x4 (&acc)[2][2][4][2], const pg8::Unit& u, int wr, int wc, int fr, int fq) const {
        const int row0 = u.pm * 256 + wr * 64 + fr, col0 = u.pn * 256 + wc * 32 + 8 * fq;
#pragma unroll
        for (int ai = 0; ai < 2; ++ai) {
#pragma unroll
          for (int mh = 0; mh < 4; mh += EPI_MB) {
            u32x4 rw[4][2];
#pragma unroll
            for (int m = mh; m < mh + EPI_MB; ++m)
#pragma unroll
                for (int bj = 0; bj < 2; ++bj) rw[m][bj] = *(const u32x4*)(res + (size_t)(row0 + ai * 128 + m * 16) * DM + col0 + bj * 128);
            asm volatile("" ::: "memory");
#pragma unroll
            for (int m = mh; m < mh + EPI_MB; ++m) {
                float ss = 0.f;
#pragma unroll
                for (int bj = 0; bj < 2; ++bj) {
                    const u32x4 w = rw[m][bj];
                    const f32x4 h0 = (f32x4){bflo(w.x), bfhi(w.x), bflo(w.y), bfhi(w.y)} + acc[ai][bj][m][0], h1 = (f32x4){bflo(w.z), bfhi(w.z), bflo(w.w), bfhi(w.w)} + acc[ai][bj][m][1];
                    acc[ai][bj][m][0] = h0; acc[ai][bj][m][1] = h1;
                    ss += (h0[0] * h0[0] + h0[1] * h0[1]) + (h0[2] * h0[2] + h0[3] * h0[3]) + (h1[0] * h1[0] + h1[1] * h1[1]) + (h1[2] * h1[2] + h1[3] * h1[3]);
                }
                ss += __shfl_xor(ss, 16); ss += __shfl_xor(ss, 32);
                if (fq == 0) unsafeAtomicAdd(rowss + row0 + ai * 128 + m * 16, ss);
            }
            asm volatile("" ::: "memory");
          }
        }
        asm volatile("s_waitcnt vmcnt(0)" ::: "memory");
        unsigned* cw = cnt + 64 * (2 * u.pm + wr);
        if (fr == 0 && fq == 0) __hip_atomic_fetch_add(cw, 1u, __ATOMIC_RELAXED, __HIP_MEMORY_SCOPE_AGENT);
        f32x4 gv[2][2];
#pragma unroll
        for (int bj = 0; bj < 2; ++bj) { gv[bj][0] = *(const f32x4*)(fg + col0 + bj * 128); gv[bj][1] = *(const f32x4*)(fg + col0 + bj * 128 + 4); }
        { unsigned sp = 0;
          while ((unsigned)__builtin_amdgcn_readfirstlane(__hip_atomic_load(cw, __ATOMIC_RELAXED, __HIP_MEMORY_SCOPE_AGENT)) < 32u) { __builtin_amdgcn_s_sleep(1); if (++sp > (1u << 16)) break; } }
        asm volatile("" ::: "memory");
#pragma unroll
        for (int ai = 0; ai < 2; ++ai)
#pragma unroll
            for (int m = 0; m < 4; ++m) {
                const int r = row0 + ai * 128 + m * 16;
                const float rs = rsqrtf(__hip_atomic_load(rowss + r, __ATOMIC_RELAXED, __HIP_MEMORY_SCOPE_AGENT) * (1.0f / DM) + RMS_EPS);
                float* op = out + (size_t)r * DM + col0;
#pragma unroll
                for (int bj = 0; bj < 2; ++bj) { *(f32x4*)(op + bj * 128) = acc[ai][bj][m][0] * rs * gv[bj][0]; *(f32x4*)(op + bj * 128 + 4) = acc[ai][bj][m][1] * rs * gv[bj][1]; }
            }
    }
};
struct PanelOrder {
    int Gp, v;
    __device__ void init(int G, int c) { Gp = G & ~7; v = c; if ((Gp & 63) == 0) v = (c & 7) * (Gp >> 3) + (c >> 3); if (c >= Gp) v = -1; }
    __device__ bool next(int i, pg8::Unit& u) const { if (v < 0) return false; const long L = (long)i * Gp + v; if (L >= 64 * 8) return false; u.pm = (int)(L >> 3); u.pn = (int)(L & 7); return true; }
    __device__ __forceinline__ void a_ready(const pg8::Unit&) const {}
    __device__ __forceinline__ void done(const pg8::Unit&) const {}
};

template <class F> __device__ __forceinline__ void meta_gemm(const bf16_t* A, const bf16_t* Bt, int ngroups, LAS unsigned char* lds, int wid, int lane, F epi) {
    const int fr = lane & 15, fq = lane >> 4, half = wid >> 2, wq = wid & 3;
    LAS f32x4* red = (LAS f32x4*)lds;
    for (int p = blockIdx.x; 2 * p < ngroups; p += gridDim.x) {
        const int g = 2 * p + half;
        f32x4 acc = {0.f, 0.f, 0.f, 0.f};
        if (g < ngroups) {
            const bf16_t* ap = A + (size_t)fr * DM + wq * 512 + fq * 8;
            const bf16_t* bp = Bt + (size_t)(g * 16 + fr) * DM + wq * 512 + fq * 8;
            bf16x8 av[16], bv[16];
#pragma unroll
            for (int s = 0; s < 16; ++s) { av[s] = *(const bf16x8*)(ap + 32 * s); bv[s] = *(const bf16x8*)(bp + 32 * s); }
#pragma unroll
            for (int s = 0; s < 16; ++s) acc = __builtin_amdgcn_mfma_f32_16x16x32_bf16(bv[s], av[s], acc, 0, 0, 0);
        }
        red[wid * 64 + lane] = acc;
        __syncthreads();
        if (wq == 0 && g < ngroups) {
            f32x4 s = red[wid * 64 + lane];
#pragma unroll
            for (int w = 1; w < 4; ++w) s += red[(wid + w) * 64 + lane];
            epi(fr, g * 16 + 4 * fq, s);
        }
        __syncthreads();
    }
}

__host__ __device__ __forceinline__ int in_col(int p) {
    if (p < 2048) return p;
    const int c = p & 255, j = (p >> 8) - 8, g = 2 * (c >> 7) + ((c >> 2) & 1), k = 16 * ((c >> 5) & 3) + 4 * ((c >> 3) & 3) + (c & 3);
    return 2048 + 1024 * g + 64 * j + k;
}
template <bool COLMAP> __device__ __forceinline__ void tr_item(const float* W, int K, int N, bf16_t* WT, const float* sc, LAS unsigned char* scr, int item, int lane) {
    const int nblk = N / 64, kb = item / nblk, nb = item % nblk, k0 = 64 * kb, n0 = 64 * nb;
    const int kr = lane >> 4, nc = (lane & 15) * 4;
    f32x4 v[16]; float g[16];
    { const float* p = W + (size_t)(k0 + kr) * N + (COLMAP ? in_col(n0 + nc) : n0 + nc);
#pragma unroll
      for (int i = 0; i < 16; ++i) { v[i] = *(const f32x4*)p; p += (size_t)4 * N; }
#pragma unroll
      for (int i = 0; i < 16; ++i) g[i] = sc ? sc[k0 + kr + 4 * i] : 1.0f; }
    asm volatile("" ::: "memory");
#pragma unroll
    for (int i = 0; i < 16; ++i) { const f32x4 s = v[i] * g[i]; u32x2 w; w.x = pg8::cvt_pk_bf16(s[0], s[1]); w.y = pg8::cvt_pk_bf16(s[2], s[3]);
        *(LAS u32x2*)(scr + (kr + 4 * i) * 136 + nc * 2) = w; }
    LDS_WAIT();
    const int c = lane & 7;
#pragma unroll
    for (int j = 0; j < 8; ++j) { const int n = (lane >> 3) + 8 * j; const LAS bf16_t* s = (const LAS bf16_t*)(scr + (8 * c) * 136 + n * 2);
        u32x4 o; o.x = (unsigned)s[0] | ((unsigned)s[68] << 16); o.y = (unsigned)s[2 * 68] | ((unsigned)s[3 * 68] << 16); o.z = (unsigned)s[4 * 68] | ((unsigned)s[5 * 68] << 16); o.w = (unsigned)s[6 * 68] | ((unsigned)s[7 * 68] << 16);
        *(u32x4*)(WT + (size_t)(n0 + n) * K + k0 + 8 * c) = o; }
    LDS_WAIT();
}
__device__ __forceinline__ void cvt_row(const float* src, bf16_t* dst, float* ss, int lane) {
    const f32x4* xr = (const f32x4*)src + lane; f32x4 v[8]; float s = 0.f;
#pragma unroll
    for (int j = 0; j < 8; ++j) { v[j] = xr[64 * j]; s += (v[j].x * v[j].x + v[j].y * v[j].y) + (v[j].z * v[j].z + v[j].w * v[j].w); }
    s = wave_sum(s);
    u32x2* o8 = (u32x2*)dst + lane;
#pragma unroll
    for (int j = 0; j < 8; ++j) { u32x2 w; w.x = pk2(v[j].x, v[j].y); w.y = pk2(v[j].z, v[j].w); o8[64 * j] = w; }
    if (lane == 0) *ss = s;
}

struct Mix {
    const float *conv_a_w, *conv_a_b, *lru_br, *lru_bi, *lru_lambda, *conv_b_w;
    const bf16_t* gw;
    bf16_t* U; bf16_t* Y; unsigned long long* AGG;
};
struct ItemId { int hd, b, c, row0, ntok, agg; bool meta; };
__device__ __forceinline__ ItemId decode_item(int id) {
    ItemId I;
    if (id < 16) { I.meta = true; I.hd = id; I.b = 0; I.c = 0; I.row0 = META0; I.ntok = 16; I.agg = 256; }
    else { const int j = id - 16; I.meta = false; I.hd = j & 15; I.c = (j >> 4) & 63; I.b = j >> 10; I.row0 = I.b * SEQ + I.c * 64; I.ntok = 64; I.agg = I.b * 64 + I.c; }
    return I;
}
constexpr int N_ITEMS = 16 + NBATCH * NHEAD * 64;

__device__ __forceinline__ bool agg_ok(unsigned long long v) { return (unsigned)v != 0u; }
template <bool META> __device__ __forceinline__ void mix_item(const Mix& X, int id, LAS unsigned char* xt, int lane) {
    constexpr int NT = META ? 16 : 64, NTB = META ? 1 : 2, NQ = META ? 2 : 4;
    constexpr float LOG2E = 1.4426950408889634f;
    const ItemId I = decode_item(id);
    const int ch = I.hd * 64 + lane;
    const float nls2 = -8.0f * LOG2E * log1pf(__expf(-X.lru_lambda[ch]));
    bf16_t raw[NT], rh0 = 0, rh1 = 0, rh2 = 0;
    const float w0 = X.conv_a_w[ch], w1 = X.conv_a_w[1024 + ch], w2 = X.conv_a_w[2048 + ch], w3 = X.conv_a_w[3072 + ch], cb = X.conv_a_b[ch];
    {
        const GAS bf16_t* sb = (const GAS bf16_t*)(X.U + (size_t)I.row0 * DIN + I.hd * 64);
        if (!META) { const GAS bf16_t* hp0 = (I.c == 0) ? (const GAS bf16_t*)(X.U + (size_t)(META0 + 13) * DIN + I.hd * 64) : sb - 3 * DIN; rh0 = hp0[lane]; rh1 = hp0[DIN + lane]; rh2 = hp0[2 * DIN + lane]; }
#pragma unroll
        for (int t = 0; t < NT; ++t) { raw[t] = sb[lane]; sb += DIN; asm volatile("" : "+s"(sb)); }
    }
    bf16x8 BfR0[4], BfR1[4], BfI0[4], BfI1[4];
    { const bf16_t* gr = X.gw + (size_t)(I.hd * 64 + (lane & 31)) * 64 + 8 * (lane >> 5); const bf16_t* gi = gr + 16 * 64 * 64;
#pragma unroll
      for (int s = 0; s < 4; ++s) { BfR0[s] = *(const bf16x8*)(gr + 16 * s); BfR1[s] = *(const bf16x8*)(gr + 32 * 64 + 16 * s); BfI0[s] = *(const bf16x8*)(gi + 16 * s); BfI1[s] = *(const bf16x8*)(gi + 32 * 64 + 16 * s); } }
    asm volatile("" ::: "memory");
    float xm3 = bf1(rh0), xm2 = bf1(rh1), xm1 = bf1(rh2);
#pragma unroll
    for (int t = 0; t < NT; ++t) { const float x0 = bf1(raw[t]); const float xc = cb + w0 * xm3 + w1 * xm2 + w2 * xm1 + w3 * x0; xm3 = xm2; xm2 = xm1; xm1 = x0;
        *(LAS bf16_t*)(xt + t * 144 + lane * 2) = (bf16_t)f2bf(xc); }
    const float brA = X.lru_br[I.hd * 64 + (lane & 31)], brB = X.lru_br[I.hd * 64 + 32 + (lane & 31)], biA = X.lru_bi[I.hd * 64 + (lane & 31)], biB = X.lru_bi[I.hd * 64 + 32 + (lane & 31)];
    float h = 0.f, P = 1.f;
    unsigned hp[NT];
#pragma unroll
    for (int tb = 0; tb < NTB; ++tb) {
        f32x16 aR0, aR1, aI0, aI1;
#pragma unroll
        for (int e = 0; e < 16; ++e) { aR0[e] = brA; aR1[e] = brB; aI0[e] = biA; aI1[e] = biB; }
#pragma unroll
        for (int s = 0; s < 4; ++s) {
            const bf16x8 af = *(const LAS bf16x8*)(xt + (tb * 32 + (lane & 31)) * 144 + (16 * s + 8 * (lane >> 5)) * 2);
            aR0 = __builtin_amdgcn_mfma_f32_32x32x16_bf16(af, BfR0[s], aR0, 0, 0, 0);
            aR1 = __builtin_amdgcn_mfma_f32_32x32x16_bf16(af, BfR1[s], aR1, 0, 0, 0);
            aI0 = __builtin_amdgcn_mfma_f32_32x32x16_bf16(af, BfI0[s], aI0, 0, 0, 0);
            aI1 = __builtin_amdgcn_mfma_f32_32x32x16_bf16(af, BfI1[s], aI1, 0, 0, 0);
        }
#pragma unroll
        for (int q = 0; q < NQ; ++q) {
            float Rv[2][4], Iv[2][4];
#pragma unroll
            for (int k = 0; k < 4; ++k) {
                const int reg = 4 * q + k;
                const float r0f = aR0[reg], r1f = aR1[reg], i0f = aI0[reg], i1f = aI1[reg];
                auto r = __builtin_amdgcn_permlane32_swap(__float_as_uint(r0f), __float_as_uint(r1f), false, false);
                Rv[0][k] = __uint_as_float(r[0]); Rv[1][k] = __uint_as_float(r[1]);
                auto i2 = __builtin_amdgcn_permlane32_swap(__float_as_uint(i0f), __float_as_uint(i1f), false, false);
                Iv[0][k] = __uint_as_float(i2[0]); Iv[1][k] = __uint_as_float(i2[1]);
            }
#pragma unroll
            for (int st = 0; st < 2; ++st)
#pragma unroll
                for (int p = 0; p < 2; ++p) {
                    const int t = tb * 32 + 8 * q + 4 * st + 2 * p;
                    f32x2 er = (f32x2){Rv[st][2 * p], Rv[st][2 * p + 1]} * (-LOG2E), ei = (f32x2){Iv[st][2 * p], Iv[st][2 * p + 1]} * (-LOG2E);
                    er.x = __builtin_amdgcn_exp2f(er.x); er.y = __builtin_amdgcn_exp2f(er.y); ei.x = __builtin_amdgcn_exp2f(ei.x); ei.y = __builtin_amdgcn_exp2f(ei.y);
                    er = er + 1.0f; ei = ei + 1.0f;
                    f32x2 rg, ig; rg.x = __builtin_amdgcn_rcpf(er.x); rg.y = __builtin_amdgcn_rcpf(er.y); ig.x = __builtin_amdgcn_rcpf(ei.x); ig.y = __builtin_amdgcn_rcpf(ei.y);
                    const f32x2 l2 = rg * nls2;
                    f32x2 a; a.x = __builtin_amdgcn_exp2f(l2.x); a.y = __builtin_amdgcn_exp2f(l2.y);
                    f32x2 om = 1.0f - a * a; om.x = fmaxf(om.x, 0.f); om.y = fmaxf(om.y, 0.f);
                    f32x2 mu; mu.x = __builtin_amdgcn_sqrtf(om.x); mu.y = __builtin_amdgcn_sqrtf(om.y);
                    const f32x2 xc = (f32x2){bf1(*(const LAS bf16_t*)(xt + t * 144 + lane * 2)), bf1(*(const LAS bf16_t*)(xt + (t + 1) * 144 + lane * 2))};
                    const f32x2 bb = mu * ig * xc;
                    h = a.x * h + bb.x; P = P * a.x; hp[t] = pg8::cvt_pk_bf16(h, P);
                    h = a.y * h + bb.y; P = P * a.y; hp[t + 1] = pg8::cvt_pk_bf16(h, P);
                }
        }
    }
    __hip_atomic_store(X.AGG + (size_t)I.agg * 1024 + ch, ((unsigned long long)__float_as_uint(h) << 32) | (unsigned long long)__float_as_uint(P), __ATOMIC_RELAXED, __HIP_MEMORY_SCOPE_AGENT);
    asm volatile("" ::: "memory");
    bf16_t graw[NT];
    { const GAS bf16_t* sb = (const GAS bf16_t*)(X.U + (size_t)I.row0 * DIN + 1024 + I.hd * 64);
#pragma unroll
      for (int t = 0; t < NT; ++t) { graw[t] = sb[lane]; sb += DIN; asm volatile("" : "+s"(sb)); } }
    float hin = 0.f;
    if (!META) {
        { const unsigned long long* mp = X.AGG + (size_t)256 * 1024 + ch; unsigned long long v;
          for (;;) { v = __hip_atomic_load(mp, __ATOMIC_RELAXED, __HIP_MEMORY_SCOPE_AGENT); if (!__any(!agg_ok(v))) break; __builtin_amdgcn_s_sleep(2); }
          hin = __uint_as_float((unsigned)(v >> 32)); }
        const unsigned long long* ap = X.AGG + (size_t)(I.b * 64) * 1024 + ch;
        for (int j0 = 0; j0 < I.c; j0 += 16) {
            unsigned long long v[16];
            for (;;) {
                bool bad = false;
#pragma unroll
                for (int k = 0; k < 16; ++k) { v[k] = (j0 + k < I.c) ? __hip_atomic_load(ap + (size_t)(j0 + k) * 1024, __ATOMIC_RELAXED, __HIP_MEMORY_SCOPE_AGENT) : 0x000000003f800000ull; }
#pragma unroll
                for (int k = 0; k < 16; ++k) bad |= !agg_ok(v[k]);
                if (!__any(bad)) break;
                __builtin_amdgcn_s_sleep(2);
            }
#pragma unroll
            for (int k = 0; k < 16; ++k) hin = __uint_as_float((unsigned)v[k]) * hin + __uint_as_float((unsigned)(v[k] >> 32));
        }
    }
    asm volatile("" ::: "memory");
    GAS bf16_t* yp = (GAS bf16_t*)(X.Y + (size_t)I.row0 * DM + I.hd * 64);
#pragma unroll
    for (int t0 = 0; t0 < NT; t0 += 16) {
        {
#pragma unroll
            for (int k = 0; k < 16; k += 2) {
                const unsigned w0 = hp[t0 + k], w1 = hp[t0 + k + 1];
                const f32x2 gg = (f32x2){bf1(graw[t0 + k]), bf1(graw[t0 + k + 1])};
                f32x2 e = gg * (-LOG2E); e.x = __builtin_amdgcn_exp2f(e.x); e.y = __builtin_amdgcn_exp2f(e.y); e = e + 1.0f;
                f32x2 sg; sg.x = __builtin_amdgcn_rcpf(e.x); sg.y = __builtin_amdgcn_rcpf(e.y);
                const f32x2 hv = (f32x2){bflo(w0), bflo(w1)} + (f32x2){bfhi(w0), bfhi(w1)} * hin;
                const f32x2 y = hv * gg * sg;
                const unsigned pk = pg8::cvt_pk_bf16(y.x, y.y);
                yp[lane] = (bf16_t)(pk & 0xffffu); yp[DM + lane] = (bf16_t)(pk >> 16); yp += 2 * DM; asm volatile("" : "+s"(yp));
            }
        }
    }
}

__device__ __forceinline__ void ld8(const bf16_t* p, float (&o)[8]) {
    const u32x4 w = *(const u32x4*)p;
    o[0] = bflo(w.x); o[1] = bfhi(w.x); o[2] = bflo(w.y); o[3] = bfhi(w.y); o[4] = bflo(w.z); o[5] = bfhi(w.z); o[6] = bflo(w.w); o[7] = bfhi(w.w);
}
__device__ __forceinline__ void partb(const Mix& X, int tid) {
    int itn = blockIdx.x * 512 + tid; bool meta_done = false;
    for (;;) {
        int it;
        if (itn < 1024 * 128) { it = itn; itn += gridDim.x * 512; }
        else if (!meta_done && gridDim.x >= 8 && blockIdx.x + 4 >= gridDim.x && tid < 128) { it = (1024 + (int)(gridDim.x - 1 - blockIdx.x)) * 128 + tid; meta_done = true; }
        else if (!meta_done && gridDim.x < 8 && blockIdx.x == 0 && tid < 128) { it = 1028 * 128 + tid; meta_done = true; }
        else break;
        const int c0 = (it & 127) * 8, run = it >> 7;
        float w0[8], w1[8], w2[8], cm2[8], cm1[8];
        { const f32x4* p = (const f32x4*)(X.conv_b_w + c0); const f32x4 a0 = p[0], a1 = p[1], b0 = p[256], b1 = p[257], d0 = p[512], d1 = p[513];
#pragma unroll
          for (int e = 0; e < 4; ++e) { w0[e] = a0[e]; w0[4 + e] = a1[e]; w1[e] = b0[e]; w1[4 + e] = b1[e]; w2[e] = d0[e]; w2[4 + e] = d1[e]; } }
        if (run >= 1024) {
            const int t0 = (run == 1028) ? 0 : 4 * (run - 1024), nt = (run == 1028) ? 16 : 4;
            const bf16_t* up = X.U + (size_t)META0 * DIN + c0; bf16_t* yp = X.Y + (size_t)META0 * DM + 1024 + c0;
#pragma unroll
            for (int e = 0; e < 8; ++e) { cm2[e] = 0.f; cm1[e] = 0.f; }
            if (t0 > 0) {
                float c[8], x[8];
                ld8(up + (size_t)(t0 - 2) * DIN + 3072, c); ld8(up + (size_t)(t0 - 2) * DIN + 4096, x);
#pragma unroll
                for (int e = 0; e < 8; ++e) cm2[e] = c[e] * x[e];
                ld8(up + (size_t)(t0 - 1) * DIN + 3072, c); ld8(up + (size_t)(t0 - 1) * DIN + 4096, x);
#pragma unroll
                for (int e = 0; e < 8; ++e) cm1[e] = c[e] * x[e];
            }
#pragma unroll 4
            for (int t = t0; t < t0 + nt; ++t) {
                float bv[8], cv[8], xv[8], gv[8];
                ld8(up + (size_t)t * DIN + 2048, bv); ld8(up + (size_t)t * DIN + 3072, cv); ld8(up + (size_t)t * DIN + 4096, xv); ld8(up + (size_t)t * DIN + 5120, gv);
                float o[8];
#pragma unroll
                for (int e = 0; e < 8; ++e) { const float cx = cv[e] * xv[e]; const float y = w0[e] * cm2[e] + w1[e] * cm1[e] + w2[e] * cx; o[e] = bv[e] * y * (gv[e] * sigmoidf_(gv[e])); cm2[e] = cm1[e]; cm1[e] = cx; }
                u32x4 w; w.x = pk2(o[0], o[1]); w.y = pk2(o[2], o[3]); w.z = pk2(o[4], o[5]); w.w = pk2(o[6], o[7]);
                *(u32x4*)(yp + (size_t)t * DM) = w;
            }
            continue;
        }
        const int row0 = run * 16;
        const bf16_t* vp = X.U + (size_t)row0 * DIN + 2048 + 2 * c0;
        bf16_t* yp = X.Y + (size_t)row0 * DM + 1024 + c0;
        u32x4 q[16][2];
#pragma unroll
        for (int t = 0; t < 16; ++t) { q[t][0] = *(const u32x4*)(vp + (size_t)t * DIN); q[t][1] = *(const u32x4*)(vp + (size_t)t * DIN + 8); }
        if ((row0 & (SEQ - 1)) == 0) {
            float c[8], x[8];
            ld8(X.U + (size_t)(META0 + 14) * DIN + 3072 + c0, c); ld8(X.U + (size_t)(META0 + 14) * DIN + 4096 + c0, x);
#pragma unroll
            for (int e = 0; e < 8; ++e) cm2[e] = c[e] * x[e];
            ld8(X.U + (size_t)(META0 + 15) * DIN + 3072 + c0, c); ld8(X.U + (size_t)(META0 + 15) * DIN + 4096 + c0, x);
#pragma unroll
            for (int e = 0; e < 8; ++e) cm1[e] = c[e] * x[e];
        } else {
            const u32x4* p2 = (const u32x4*)(X.U + (size_t)(row0 - 2) * DIN + 2048 + 2 * c0); const u32x4* p1 = (const u32x4*)(X.U + (size_t)(row0 - 1) * DIN + 2048 + 2 * c0);
            const u32x4 a0 = p2[0], a1 = p2[1], b0 = p1[0], b1 = p1[1];
#pragma unroll
            for (int e = 0; e < 4; ++e) { cm2[e] = bfhi(a0[e]); cm2[4 + e] = bfhi(a1[e]); cm1[e] = bfhi(b0[e]); cm1[4 + e] = bfhi(b1[e]); }
        }
#pragma unroll
        for (int t = 0; t < 16; ++t) {
            float o[8];
#pragma unroll
            for (int e = 0; e < 8; ++e) { const unsigned qq = e < 4 ? q[t][0][e & 3] : q[t][1][e & 3]; const float bg = bflo(qq), cx = bfhi(qq);
                o[e] = bg * (w0[e] * cm2[e] + w1[e] * cm1[e] + w2[e] * cx); cm2[e] = cm1[e]; cm1[e] = cx; }
            u32x4 w; w.x = pk2(o[0], o[1]); w.y = pk2(o[2], o[3]); w.z = pk2(o[4], o[5]); w.w = pk2(o[6], o[7]);
            *(u32x4*)(yp + (size_t)t * DM) = w;
        }
    }
}


#ifdef DEBUG_NAIVE_MIX
__global__ void __launch_bounds__(64) naive_mixA(Mix X, const float* wr, const float* wi) {
    const int b = blockIdx.x / 16, hd = blockIdx.x % 16, lane = threadIdx.x, ch = hd * 64 + lane;
    __shared__ float xs[64];
    const float w0 = X.conv_a_w[ch], w1 = X.conv_a_w[1024 + ch], w2 = X.conv_a_w[2048 + ch], w3 = X.conv_a_w[3072 + ch], cb = X.conv_a_b[ch];
    const float br = X.lru_br[ch], bi = X.lru_bi[ch];
    const float sp = log1pf(expf(-X.lru_lambda[ch]));
    const float* wrh = wr + (size_t)hd * 4096 + lane; const float* wih = wi + (size_t)hd * 4096 + lane;
    float h = 0.f, xm3 = 0.f, xm2 = 0.f, xm1 = 0.f;
    for (int p = 0; p < NMETA + SEQ; ++p) {
        const int row = p < NMETA ? META0 + p : b * SEQ + (p - NMETA);
        const float x0 = bf1(X.U[(size_t)row * DIN + ch]);
        const float xc = cb + w0 * xm3 + w1 * xm2 + w2 * xm1 + w3 * x0; xm3 = xm2; xm2 = xm1; xm1 = x0;
        xs[lane] = xc; __syncthreads();
        float rp = br, ip = bi;
#pragma unroll 4
        for (int i = 0; i < 64; ++i) { rp += xs[i] * wrh[i * 64]; ip += xs[i] * wih[i * 64]; }
        __syncthreads();
        const float r = 1.f / (1.f + expf(-rp)), ig = 1.f / (1.f + expf(-ip));
        const float la = -8.f * r * sp; const float a = expf(la); const float bb = sqrtf(-expm1f(2.f * la)) * (ig * xc);
        h = a * h + bb;
        const float g = bf1(X.U[(size_t)row * DIN + 1024 + ch]);
        const float y = h * g / (1.f + expf(-g));
        if (p >= NMETA || b == 0) X.Y[(size_t)row * DM + ch] = (bf16_t)f2bf(y);
    }
}
__global__ void naive_mixB(Mix X) {
    for (size_t idx = (size_t)blockIdx.x * blockDim.x + threadIdx.x; idx < (size_t)(MROWS + NMETA) * 1024; idx += (size_t)gridDim.x * blockDim.x) {
        const int row = (int)(idx >> 10), c = (int)(idx & 1023);
        int r1, r2;
        if (row >= META0) { const int p = row - META0; r1 = p >= 1 ? row - 1 : -1; r2 = p >= 2 ? row - 2 : -1; }
        else { const int t = row & (SEQ - 1); r1 = t >= 1 ? row - 1 : META0 + 15; r2 = t >= 2 ? row - 2 : META0 + 14 + t; }
        auto cx = [&](int r) -> float { return r < 0 ? 0.f : bf1(X.U[(size_t)r * DIN + 3072 + c]) * bf1(X.U[(size_t)r * DIN + 4096 + c]); };
        const float y = X.conv_b_w[c] * cx(r2) + X.conv_b_w[1024 + c] * cx(r1) + X.conv_b_w[2048 + c] * cx(row);
        const float bv = bf1(X.U[(size_t)row * DIN + 2048 + c]), g = bf1(X.U[(size_t)row * DIN + 5120 + c]);
        X.Y[(size_t)row * DM + 1024 + c] = (bf16_t)f2bf(bv * y * g / (1.f + expf(-g)));
    }
}
#endif
#define XB_TMO      128
#define XB_XCNT(j)  (256  + 64 * (j))
#define XB_XSUB(j)  (1280 + 64 * (j))
#define XB_XGEN(j)  (2304 + 64 * (j))
#define XB_TOP      3328
#define XB_TOPGEN   3392
#define XCD_BAR_WORDS 3456
#define XB_SPIN_CAP (1u << 18)

__device__ __forceinline__ unsigned xb_ld(unsigned* p)              { return __hip_atomic_load(p, __ATOMIC_RELAXED, __HIP_MEMORY_SCOPE_AGENT); }
__device__ __forceinline__ unsigned xb_add(unsigned* p, unsigned v) { return __hip_atomic_fetch_add(p, v, __ATOMIC_RELAXED, __HIP_MEMORY_SCOPE_AGENT); }
__device__ __forceinline__ unsigned xb_xcc_id() { return (unsigned)__builtin_amdgcn_s_getreg((3 << 11) | 20) & 0xFu; }
#define XB_SPIN(cond, bar) do { unsigned _sp = 0; while (cond) { __builtin_amdgcn_s_sleep(1); \
    if ((++_sp & 255u) == 0u) { if (xb_ld(&(bar)[XB_TMO])) break; if (_sp > XB_SPIN_CAP) { atomicAdd(&(bar)[XB_TMO], 1u); break; } } } } while (0)

struct XcdBarrier {
    unsigned* bar; unsigned x;
    volatile LAS unsigned* st;
};

__device__ __forceinline__ XcdBarrier xcd_barrier_post(unsigned* bar, volatile LAS unsigned* st) {
    XcdBarrier b; b.bar = bar; b.x = xb_xcc_id(); b.st = st;
    if (threadIdx.x == 0) (void)xb_add(&bar[XB_XCNT(b.x)], 1u);
    return b;
}
__device__ __forceinline__ void xcd_barrier_complete(unsigned* bar, unsigned x, unsigned& nloc, unsigned& nx) {
    const unsigned G = gridDim.x * gridDim.y * gridDim.z;
    unsigned sum, cnt, mine, sp = 0u;
    for (;;) {
        sum = 0u; cnt = 0u; mine = 0u;
#pragma unroll
        for (unsigned j = 0; j < 16; ++j) { const unsigned c = xb_ld(&bar[XB_XCNT(j)]); sum += c; cnt += (c > 0u) ? 1u : 0u; mine = (j == x) ? c : mine; }
        if (sum == G) break;
        __builtin_amdgcn_s_sleep(1);
        if ((++sp & 255u) == 0u) { if (xb_ld(&bar[XB_TMO])) break; if (sp > XB_SPIN_CAP) { atomicAdd(&bar[XB_TMO], 1u); break; } }
    }
    nloc = mine > 0u ? mine : 1u; nx = cnt > 0u ? cnt : 1u;
}

__device__ __forceinline__ void xcd_barrier(const XcdBarrier& b) {
    asm volatile("s_waitcnt vmcnt(0)" ::: "memory");
    __syncthreads();
    if (threadIdx.x == 0) {
        unsigned* bar = b.bar;
        __builtin_amdgcn_s_waitcnt(0);
        unsigned nloc = b.st[0], nx = b.st[1];
        if (nloc == 0u) { xcd_barrier_complete(bar, b.x, nloc, nx); b.st[0] = nloc; b.st[1] = nx; }
        const unsigned old = xb_add(&bar[XB_XSUB(b.x)], 1u);
        const unsigned gen = old / nloc;
        if (old + 1u == (gen + 1u) * nloc) {
            __builtin_amdgcn_fence(__ATOMIC_RELEASE, "agent");
            asm volatile("s_waitcnt vmcnt(0)" ::: "memory");
            const unsigned og = xb_add(&bar[XB_TOP], 1u);
            const unsigned tg = og / nx;
            if (og + 1u == (tg + 1u) * nx) xb_add(&bar[XB_TOPGEN], 1u);
            else XB_SPIN(xb_ld(&bar[XB_TOPGEN]) == tg, bar);
            __builtin_amdgcn_fence(__ATOMIC_ACQUIRE, "agent");
            xb_add(&bar[XB_XGEN(b.x)], 1u);
            asm volatile("s_waitcnt vmcnt(0)" ::: "memory");
        } else {
            XB_SPIN(xb_ld(&bar[XB_XGEN(b.x)]) == gen, bar);
            __builtin_amdgcn_fence(__ATOMIC_ACQUIRE, "agent");
            asm volatile("s_waitcnt vmcnt(0)" ::: "memory");
        }
    }
    __syncthreads();
}

__global__ void __launch_bounds__(512, 2) hymba_fwd(Args a) {
    extern __shared__ __attribute__((aligned(16))) unsigned char lds_raw[];
    LAS unsigned char* lds = (LAS unsigned char*)lds_raw;
    cg::grid_group grid = cg::this_grid();
    const int NGW = gridDim.x * 8;
    if (threadIdx.x < 64) ((LAS unsigned*)(lds + 131072))[threadIdx.x] = 0u;
    __syncthreads();
    XcdBarrier xbar; xbar.bar = (unsigned*)(a.ws + WS_BAR); xbar.x = 0; xbar.st = nullptr;
    if (a.ph_hi - a.ph_lo > 1) xbar = xcd_barrier_post((unsigned*)(a.ws + WS_BAR), (volatile LAS unsigned*)(lds + 131072));
    if (a.ph_lo < 0) grid.sync();
#define LAUNDER() int tid = threadIdx.x; asm volatile("" : "+v"(tid)); const int wid = __builtin_amdgcn_readfirstlane(tid >> 6), lane = tid & 63, gw = blockIdx.x * 8 + wid
    const int lo = a.ph_lo, hi = a.ph_hi;
#define IN(k) (lo <= (k) && (k) < hi)
#ifndef STAGGER_N
#define STAGGER_N 0
#endif
#define STAGGER() do { if (STAGGER_N) for (int _k = 0; _k < (int)(blockIdx.x & 7); ++_k) __builtin_amdgcn_s_sleep(STAGGER_N); } while (0)
#define SEAM(k) do { if (IN(k) && IN((k) + 1)) { xcd_barrier(xbar); if ((REP_MASK >> 10) & 1) { xcd_barrier(xbar); xcd_barrier(xbar); } } } while (0)
    const float* x = a.in[0]; const float* meta = a.in[1]; const float* norm_g = a.in[2]; const float* w_in = a.in[3];
    const float* conv_a_w = a.in[4]; const float* conv_a_b = a.in[5]; const float* lru_wr = a.in[6]; const float* lru_br = a.in[7];
    const float* lru_wi = a.in[8]; const float* lru_bi = a.in[9]; const float* lru_lambda = a.in[10]; const float* conv_b_w = a.in[11];
    const float* w_out = a.in[12]; const float* final_g = a.in[13];
    unsigned char* ws = a.ws;
    bf16_t* WTIN = (bf16_t*)(ws + WS_WTIN); bf16_t* WTOUT = (bf16_t*)(ws + WS_WTOUT); bf16_t* GW = (bf16_t*)(ws + WS_GW);
    float* ROWSS = (float*)(ws + WS_ROWSS); unsigned long long* AGG = (unsigned long long*)(ws + WS_AGG);
    bf16_t* XB = (bf16_t*)(ws + WS_XB); bf16_t* Y = (bf16_t*)(ws + WS_Y); bf16_t* U = (bf16_t*)(ws + WS_U);

    if (IN(0)) for (int rep = 0; rep <= ((REP_MASK >> 0) & 1); ++rep) {
        LAUNDER();
        LAS unsigned char* scr = lds + wid * 16384;
        constexpr int I_IN = (DM / 64) * (DIN / 64);
        constexpr int NIT = I_IN + 64;
        for (int it = gw; it < NIT; it += NGW) {
            int r = it;
            if (r < I_IN) { tr_item<true>(w_in, DM, DIN, WTIN, norm_g, scr, r, lane); continue; } r -= I_IN;
            { const int mtx = r, l = mtx >> 5, g = (mtx >> 4) & 1, hd = mtx & 15;
              const float* src = (g ? lru_wi : lru_wr) + (size_t)(l * 16 + hd) * 4096;
              tr_item<false>(src, 64, 64, GW + (size_t)mtx * 4096, nullptr, scr, 0, lane); }
        }
        for (int m = gw; m < MROWS + NMETA; m += NGW) {
            const float* src = m < MROWS ? x + (size_t)m * DM : meta + (size_t)(m - MROWS) * DM;
            cvt_row(src, XB + (size_t)m * DM, ROWSS + m, lane);
        }
        for (int i = blockIdx.x * 512 + tid; i < 2 * RSTR; i += gridDim.x * 512) ROWSS[RSTR + i] = 0.f;
        for (int i = blockIdx.x * 512 + tid; i < AGG_PER_LAYER; i += gridDim.x * 512) ((u32x4*)AGG)[i] = (u32x4){0u, 0u, 0u, 0u};
    }
    SEAM(0);

#pragma unroll 1
    for (int l = 0; l < 2; ++l) {
        const int pb = 1 + 3 * l;
        const bf16_t* wtin = WTIN + (size_t)l * DIN * DM; const bf16_t* wtout = WTOUT + (size_t)l * DM * DM;
        float* rss_in = ROWSS + (size_t)l * RSTR; float* rss_out = ROWSS + (size_t)(l + 1) * RSTR;
        Mix X; X.conv_a_w = conv_a_w + l * 4 * DLRU; X.conv_a_b = conv_a_b + l * DLRU; X.lru_br = lru_br + l * DLRU; X.lru_bi = lru_bi + l * DLRU; X.lru_lambda = lru_lambda + l * DLRU;
        X.conv_b_w = conv_b_w + l * 3 * DLRU; X.gw = GW + (size_t)l * 2 * 16 * 4096; X.U = U; X.Y = Y; X.AGG = AGG + (size_t)l * AGG_PER_LAYER;

        if (IN(pb)) for (int rep = 0; rep <= ((REP_MASK >> pb) & 1); ++rep) {
            LAUNDER();
            STAGGER();
            for (int mrep = 0; mrep <= ((REP_MASK >> 16) & 1); ++mrep)
            meta_gemm(XB + (size_t)META0 * DM, wtin, DIN / 16, lds, wid, lane, [&](int m, int n0, f32x4 s) {
                const float rs = rsqrtf(rss_in[META0 + m] * (1.0f / DM) + RMS_EPS);
                u32x2 w; w.x = pk2(s[0] * rs, s[1] * rs); w.y = pk2(s[2] * rs, s[3] * rs);
                *(u32x2*)(U + (size_t)(META0 + m) * DIN + in_col(n0)) = w; });
            pg8::Gemm g{XB, wtin, MROWS, DIN, DM}; pg8::StaticOrder S; S.init(MROWS, DIN, (int)gridDim.x, (int)blockIdx.x);
            if ((REP_MASK >> 17) & 1) { EpiUT<true> En{U, rss_in}; pg8::gemm_phase<EpiUT<true>, pg8::StaticOrder, false>(lds, g, S, En, nullptr); }
            if ((REP_MASK >> 15) & 1) { EpiNull En{ROWSS + (size_t)3 * RSTR}; pg8::gemm_phase<EpiNull, pg8::StaticOrder, false>(lds, g, S, En, nullptr); }
            EpiU E{U, rss_in};
            pg8::gemm_phase<EpiU, pg8::StaticOrder, false>(lds, g, S, E, nullptr);
        }
        SEAM(pb);
        if (IN(pb + 1)) for (int rep = 0; rep <= ((REP_MASK >> (pb + 1)) & 1); ++rep) {
            LAUNDER();
#pragma unroll 1
            for (int step = 0; step < 2; ++step) {
                if ((step == 0) == (wid < 4)) {
                    if (rep == 1 && ((REP_MASK >> 13) & 1)) continue;
#pragma unroll 1
                    for (int id = gw; id < N_ITEMS; id += NGW) { if (id < 16) mix_item<true>(X, id, lds + wid * 9216, lane); else mix_item<false>(X, id, lds + wid * 9216, lane); }
                } else { if (rep == 1 && ((REP_MASK >> 12) & 1)) continue; partb(X, tid); }
            }
            {
                constexpr int I_IN = (DM / 64) * (DIN / 64), I_OUT = (DM / 64) * (DM / 64);
                LAS unsigned char* scr = lds + wid * 9216;
                const int nit = (l == 0) ? I_IN + I_OUT : I_OUT;
#pragma unroll 1
                for (int it = gw; it < nit; it += NGW) {
                    if (l == 0 && it < I_IN) tr_item<true>(w_in + (size_t)DM * DIN, DM, DIN, WTIN + (size_t)DIN * DM, norm_g + DM, scr, it, lane);
                    else { const int r = (l == 0) ? it - I_IN : it; tr_item<false>(w_out + (size_t)l * DM * DM, DM, DM, WTOUT + (size_t)l * DM * DM, nullptr, scr, r, lane); }
                }
            }
        }
        SEAM(pb + 1);
        if (IN(pb + 2)) {
            LAUNDER();
            STAGGER();
            if (l == 0) {
                meta_gemm(Y + (size_t)META0 * DM, wtout, DM / 16, lds, wid, lane, [&](int m, int n0, f32x4 s) {
                    const f32x4 r = *(const f32x4*)(meta + (size_t)m * DM + n0); const f32x4 hh = r + s;
                    u32x2 w; w.x = pk2(hh[0], hh[1]); w.y = pk2(hh[2], hh[3]);
                    *(u32x2*)(XB + (size_t)(META0 + m) * DM + n0) = w;
                    unsafeAtomicAdd(rss_out + META0 + m, (hh[0] * hh[0] + hh[1] * hh[1]) + (hh[2] * hh[2] + hh[3] * hh[3])); });
            }
            pg8::Gemm g{Y, wtout, MROWS, DM, DM};
            if (l == 0) {
                pg8::StaticOrder S; S.init(MROWS, DM, (int)gridDim.x, (int)blockIdx.x);
                if ((REP_MASK >> 11) & 1) { EpiU Ed{U, rss_in}; pg8::gemm_phase<EpiU, pg8::StaticOrder, false>(lds, g, S, Ed, nullptr); }
                if ((REP_MASK >> 14) & 1) { EpiRes Ed{x, nullptr, XB, ROWSS + (size_t)3 * RSTR}; pg8::gemm_phase<EpiRes, pg8::StaticOrder, false>(lds, g, S, Ed, nullptr); }
                EpiRes E{x, nullptr, XB, rss_out};
                pg8::gemm_phase<EpiRes, pg8::StaticOrder, false>(lds, g, S, E, nullptr);
            } else {
                PanelOrder S; S.init((int)gridDim.x, (int)blockIdx.x);
                EpiResNorm E{XB, a.out, rss_out, (unsigned*)(ws + WS_PCNT), final_g};
                pg8::gemm_phase<EpiResNorm, PanelOrder, false>(lds, g, S, E, nullptr);
            }
        }
        SEAM(pb + 2);
    }

#undef IN
#undef SEAM
}

#ifndef MK_LAUNCH_PER_PHASE
#define MK_LAUNCH_PER_PHASE 0
#endif
extern "C" void kernel_launch(void* const* d_in, const int* in_sizes, int n_in, void* d_out, int out_size, void* d_ws, size_t ws_size, hipStream_t stream) {
    static int grid = 0;
    if (grid == 0) {
        if (n_in != 14 || in_sizes[0] != MROWS * DM || out_size != MROWS * DM || ws_size < WS_END) { fprintf(stderr, "kernel_launch: unexpected shapes (n_in %d, in0 %d, out %d, ws %zu)\n", n_in, n_in > 0 ? in_sizes[0] : -1, out_size, ws_size); grid = -1; return; }
        int dev = 0, cus = 0, per_cu = 0;
        hipGetDevice(&dev); hipDeviceGetAttribute(&cus, hipDeviceAttributeMultiprocessorCount, dev);
        if (hipFuncSetAttribute((const void*)hymba_fwd, hipFuncAttributeMaxDynamicSharedMemorySize, LDS_BYTES) != hipSuccess) { fprintf(stderr, "kernel_launch: hipFuncSetAttribute failed\n"); grid = -1; return; }
        if (hipOccupancyMaxActiveBlocksPerMultiprocessor(&per_cu, (const void*)hymba_fwd, 512, LDS_BYTES) != hipSuccess || per_cu < 1) { fprintf(stderr, "kernel_launch: occupancy query gave %d\n", per_cu); per_cu = 1; }
        (void)hipGetLastError();
        grid = cus * per_cu;
    }
    if (grid < 0) return;
    Args a{};
    for (int i = 0; i < 14; ++i) a.in[i] = (const float*)d_in[i];
    a.out = (float*)d_out; a.ws = (unsigned char*)d_ws;
#if MK_LAUNCH_PER_PHASE
    for (int p = 0; p < NPHASE; ++p) {
#ifdef DEBUG_NAIVE_MIX
        if (p == 2 || p == 6) { const int l = p / 4; unsigned char* ws = (unsigned char*)d_ws;
            Mix X; X.conv_a_w = a.in[4] + l * 4 * DLRU; X.conv_a_b = a.in[5] + l * DLRU; X.lru_br = a.in[7] + l * DLRU; X.lru_bi = a.in[9] + l * DLRU; X.lru_lambda = a.in[10] + l * DLRU;
            X.conv_b_w = a.in[11] + l * 3 * DLRU; X.gw = nullptr; X.U = (bf16_t*)(ws + WS_U); X.Y = (bf16_t*)(ws + WS_Y); X.HP = nullptr; X.AGG = nullptr;
#if DEBUG_NAIVE_MIX == 1
            hipLaunchKernelGGL(naive_mixA, dim3(64), dim3(64), 0, stream, X, a.in[6] + (size_t)l * 16 * 4096, a.in[8] + (size_t)l * 16 * 4096);
            a.flags = 1;
#else
            hipLaunchKernelGGL(naive_mixB, dim3(2048), dim3(256), 0, stream, X);
            a.flags = 2;
#endif
            }
        else a.flags = 0;
#if DEBUG_NAIVE_MIX == 1
        if (p == 3 || p == 7) continue;
#endif
#endif
        a.ph_lo = p; a.ph_hi = p + 1; hipLaunchKernelGGL(hymba_fwd, dim3(grid), dim3(512), LDS_BYTES, stream, a); }
#else
    a.ph_lo = 0; a.ph_hi = NPHASE;
    if (hipMemsetAsync((unsigned char*)d_ws + WS_BAR, 0, 16384 + 32768, stream) != hipSuccess) { fprintf(stderr, "kernel_launch: memset of barrier words failed\n"); return; }
    void* args[] = {&a};
    const hipError_t e = hipLaunchCooperativeKernel((const void*)hymba_fwd, dim3(grid), dim3(512), args, LDS_BYTES, stream);
    if (e != hipSuccess) fprintf(stderr, "kernel_launch: cooperative launch failed: %s (grid %d)\n", hipGetErrorString(e), grid);
#endif
}
```

```cpp
#include <hip/hip_runtime.h>
#include <hip/hip_cooperative_groups.h>
#include <cstdio>
namespace cg = cooperative_groups;
namespace pg8 {
#define PG8_LAS __attribute__((address_space(3)))
typedef unsigned short bf16_t;
typedef short bf16x8 __attribute__((ext_vector_type(8)));
typedef float f32x4 __attribute__((ext_vector_type(4)));
typedef unsigned u32x4 __attribute__((ext_vector_type(4)));
constexpr int BM = 256, BK = 64, HALF = 128, HTB = HALF * BK * 2  , STAGE_BYTES = 8 * HTB, NXCD = 8, WGM = 4;

__host__ __device__ __forceinline__ int lds_byte(int r, int c) { const int st = (r >> 4) * 2 + (c >> 5), rr = r & 15, cc = c & 31, ob = rr * 64 + cc * 2; return st * 1024 + (ob ^ (((ob >> 9) & 1) << 5)); }
__host__ __device__ __forceinline__ void stage_rc(int b, int& R, int& C) { const int st = b / 1024, sb = b % 1024, swz = sb ^ (((sb >> 9) & 1) << 5); R = (st >> 1) * 16 + swz / 64; C = (st & 1) * 32 + (swz % 64) / 2; }
__host__ __device__ __forceinline__ int perm32(int rho) { const int n = rho >> 4, i = rho & 15; return 8 * (i >> 2) + 4 * n + (i & 3); }

struct Unit { int pm, pn; };
struct Gemm { const bf16_t* A; const bf16_t* Bt; int M, N, K; };

struct StaticOrder {
    int nM, nN, nwg, G, c;
    __host__ __device__ void init(int M, int N, int G_, int c_) { nM = M / BM; nN = N / BM; nwg = nM * nN; G = G_; c = c_; }
    __host__ __device__ bool next(int i, Unit& u) const {
        const long L = (long)i * G + c; if (L >= nwg) return false;
        int wgid = (int)L; { const int q = nwg / NXCD, r = nwg % NXCD, xcd = wgid % NXCD, off = wgid / NXCD; wgid = (xcd < r ? xcd * (q + 1) : r * (q + 1) + (xcd - r) * q) + off; }
        const int nig = WGM * nN, gid = wgid / nig, fm = gid * WGM, gsz = (nM - fm) < WGM ? (nM - fm) : WGM;
        u.pm = fm + ((wgid % nig) % gsz); u.pn = (wgid % nig) / gsz; return true;
    }
    __device__ __forceinline__ void a_ready(const Unit&) const {}
    __device__ __forceinline__ void done(const Unit&) const {}
};
__device__ __forceinline__ unsigned cvt_pk_bf16(float lo, float hi) { unsigned r; asm volatile("v_cvt_pk_bf16_f32 %0, %1, %2" : "=v"(r) : "v"(lo), "v"(hi)); return r; }
template <class Epi, class Sched, bool STAMP = false>
__device__ __forceinline__ void gemm_phase(PG8_LAS unsigned char* lds, const Gemm g, const Sched& S, const Epi& E, unsigned long long* stamps) {
    int tid_l = threadIdx.x; asm volatile("" : "+v"(tid_l));
    const int tid = tid_l, wid = __builtin_amdgcn_readfirstlane(tid >> 6), lane = tid & 63, wr = wid >> 2, wc = wid & 3, fr = lane & 15, fq = lane >> 4;
    const int K = g.K, nt = K / BK;
    int ts_lo = 0, ts_hi = 0, nts = 0; const unsigned long long rt_entry = STAMP ? (unsigned long long)wall_clock64() : 0ull;
#define PG8_STAMP() do { if (STAMP && wid == 0 && nts < 64) { const unsigned long long _c = (unsigned long long)clock64(); \
        ts_lo = (lane == nts) ? (int)(unsigned)_c : ts_lo; ts_hi = (lane == nts) ? (int)(unsigned)(_c >> 32) : ts_hi; ++nts; } } while (0)
    PG8_STAMP();
    unsigned voffA[2], voffB[2];
#pragma unroll
    for (int i = 0; i < 2; ++i) { int R, C; stage_rc(tid * 16 + i * 8192, R, C); const int Rb = Epi::PERM ? ((R & ~31) + perm32(R & 31)) : R;
        voffA[i] = (unsigned)(R * K + C) * 2u; voffB[i] = (unsigned)(Rb * K + C) * 2u; }
    const size_t kstep = (size_t)(BK * 2);
    const size_t hstep = (size_t)HALF * K * 2;
    const size_t tstep = 2 * hstep;
    const unsigned ldsw = (unsigned)wid * 1024u;
    const int aoff = lds_byte(wr * 64 + fr, fq * 8), boff = lds_byte(wc * 32 + fr, fq * 8);
#define PG8_SA(b, h) (((b) * 2 + (h)) * HTB)
#define PG8_SB(b, h) ((4 + (b) * 2 + (h)) * HTB)
#define PG8_STAGE(bufoff, gbase, voff) do { _Pragma("unroll") for (int _i = 0; _i < 2; ++_i) \
        __builtin_amdgcn_global_load_lds((const unsigned*)((const char*)(gbase) + (voff)[_i]), (PG8_LAS unsigned*)(lds + (bufoff) + ldsw + _i * 8192), 16, 0, 0); } while (0)
#define PG8_LDA(dst, b, h) do { _Pragma("unroll") for (int m = 0; m < 4; ++m) _Pragma("unroll") for (int k = 0; k < 2; ++k) dst[m][k] = *(const PG8_LAS bf16x8*)(lds + PG8_SA(b, h) + aoff + m * 2048 + k * 1024); } while (0)
#define PG8_LDB(dst, b, h) do { _Pragma("unroll") for (int n = 0; n < 2; ++n) _Pragma("unroll") for (int k = 0; k < 2; ++k) dst[n][k] = *(const PG8_LAS bf16x8*)(lds + PG8_SB(b, h) + boff + n * 2048 + k * 1024); } while (0)
#define PG8_MMA(ai, bj, At, Bt) do { __builtin_amdgcn_s_setprio(1); _Pragma("unroll") for (int m = 0; m < 4; ++m) _Pragma("unroll") for (int n = 0; n < 2; ++n) _Pragma("unroll") for (int k = 0; k < 2; ++k) \
        acc[ai][bj][m][n] = __builtin_amdgcn_mfma_f32_16x16x32_bf16(Bt[n][k], At[m][k], acc[ai][bj][m][n], 0, 0, 0); __builtin_amdgcn_s_setprio(0); } while (0)
#define PG8_WAIT_V(n) asm volatile("s_waitcnt vmcnt(" #n ")" ::: "memory")
#define PG8_WAIT_L(n) asm volatile("s_waitcnt lgkmcnt(" #n ")" ::: "memory")
#define PG8_BAR __builtin_amdgcn_s_barrier()
#define PG8_SCHED __builtin_amdgcn_sched_barrier(0)
    Unit cur, nxt; int ui = 0;
    if (!S.next(0, cur)) return;
    f32x4 acc[2][2][4][2];
#pragma unroll
    for (int a = 0; a < 2; ++a)
#pragma unroll
        for (int b = 0; b < 2; ++b)
#pragma unroll
            for (int m = 0; m < 4; ++m)
#pragma unroll
                for (int n = 0; n < 2; ++n) acc[a][b][m][n] = (f32x4){0.f, 0.f, 0.f, 0.f};
    bf16x8 At[4][2], B0[2][2], B1[2][2];
    const char* cA = (const char*)g.A + (size_t)cur.pm * tstep; const char* cB = (const char*)g.Bt + (size_t)cur.pn * tstep;
    S.a_ready(cur);
    PG8_STAGE(PG8_SB(0, 0), cB, voffB); PG8_STAGE(PG8_SA(0, 0), cA, voffA); PG8_STAGE(PG8_SB(0, 1), cB + hstep, voffB); PG8_STAGE(PG8_SA(0, 1), cA + hstep, voffA);
    if (wr == 1) PG8_BAR;
    PG8_WAIT_V(4); PG8_BAR;
    PG8_STAGE(PG8_SB(1, 0), cB + kstep, voffB); PG8_STAGE(PG8_SA(1, 0), cA + kstep, voffA); PG8_STAGE(PG8_SB(1, 1), cB + hstep + kstep, voffB);
    PG8_WAIT_V(6); PG8_BAR;
    PG8_STAMP();
    for (;;) {
        const bool has_next = S.next(ui + 1, nxt);
        const char* nA = has_next ? (const char*)g.A + (size_t)nxt.pm * tstep : cA; const char* nB = has_next ? (const char*)g.Bt + (size_t)nxt.pn * tstep : cB;
        for (int t = 0; t < nt; t += 2) {
            const bool last = (t == nt - 2);
            const char* a1 = cA + (size_t)(t + 1) * kstep;
            const char* a2 = last ? nA : cA + (size_t)(t + 2) * kstep; const char* b2 = last ? nB : cB + (size_t)(t + 2) * kstep;
            const char* a3 = a2 + kstep; const char* b3 = b2 + kstep;
            if (last && has_next) S.a_ready(nxt);
            PG8_LDB(B0, 0, 0); PG8_SCHED; PG8_LDA(At, 0, 0); PG8_STAGE(PG8_SA(1, 1), a1 + hstep, voffA);
            PG8_WAIT_L(8); PG8_BAR; PG8_WAIT_L(0); PG8_MMA(0, 0, At, B0); PG8_BAR; PG8_SCHED;
            PG8_LDB(B1, 0, 1); PG8_STAGE(PG8_SB(0, 0), b2, voffB);
            PG8_BAR; PG8_WAIT_L(0); PG8_MMA(0, 1, At, B1); PG8_BAR;
            PG8_LDA(At, 0, 1); PG8_STAGE(PG8_SA(0, 0), a2, voffA);
            PG8_BAR; PG8_WAIT_L(0); PG8_MMA(1, 0, At, B0); PG8_BAR; PG8_SCHED;
            PG8_STAGE(PG8_SB(0, 1), b2 + hstep, voffB);
            PG8_WAIT_V(6); PG8_BAR; PG8_MMA(1, 1, At, B1); PG8_BAR;
            PG8_LDB(B0, 1, 0); PG8_SCHED; PG8_LDA(At, 1, 0); PG8_STAGE(PG8_SA(0, 1), a2 + hstep, voffA);
            PG8_WAIT_L(8); PG8_BAR; PG8_WAIT_L(0); PG8_MMA(0, 0, At, B0); PG8_BAR; PG8_SCHED;
            PG8_LDB(B1, 1, 1); PG8_STAGE(PG8_SB(1, 0), b3, voffB);
            PG8_BAR; PG8_WAIT_L(0); PG8_MMA(0, 1, At, B1); PG8_BAR;
            PG8_LDA(At, 1, 1); PG8_STAGE(PG8_SA(1, 0), a3, voffA);
            PG8_BAR; PG8_WAIT_L(0); PG8_MMA(1, 0, At, B0); PG8_BAR; PG8_SCHED;
            PG8_STAGE(PG8_SB(1, 1), b3 + hstep, voffB);
            PG8_WAIT_V(6); PG8_BAR; PG8_MMA(1, 1, At, B1); PG8_BAR;
        }
        PG8_STAMP();
        if constexpr (!Epi::AFTER_DRAIN) { if (wr == 0) PG8_BAR; E(acc, cur, wr, wc, fr, fq); S.done(cur); if (has_next) { if (wr == 1) PG8_BAR; } }
        PG8_STAMP();
        if (!has_next) break;
#pragma unroll
        for (int a = 0; a < 2; ++a)
#pragma unroll
            for (int b = 0; b < 2; ++b)
#pragma unroll
                for (int m = 0; m < 4; ++m)
#pragma unroll
                    for (int n = 0; n < 2; ++n) acc[a][b][m][n] = (f32x4){0.f, 0.f, 0.f, 0.f};
        cur = nxt; cA = nA; cB = nB; ++ui;
    }
    PG8_WAIT_V(0);
    if constexpr (Epi::AFTER_DRAIN) { if (wr == 0) PG8_BAR; }
    PG8_BAR;
    if constexpr (Epi::AFTER_DRAIN) { E.fused(acc, cur, wr, wc, fr, fq, lds, wid, lane); S.done(cur); }
    PG8_STAMP();
    if (STAMP && wid == 0) { stamps[lane] = lane < nts ? (((unsigned long long)(unsigned)ts_hi << 32) | (unsigned)ts_lo) : 0ull;
        if (lane == 62) stamps[62] = rt_entry; if (lane == 63) stamps[63] = (unsigned long long)wall_clock64(); }
#undef PG8_STAMP
#undef PG8_SA
#undef PG8_SB
#undef PG8_STAGE
#undef PG8_LDA
#undef PG8_LDB
#undef PG8_MMA
#undef PG8_WAIT_V
#undef PG8_WAIT_L
#undef PG8_BAR
#undef PG8_SCHED
}
}

#define LAS __attribute__((address_space(3)))
#define GAS __attribute__((address_space(1)))
typedef unsigned short bf16_t;
typedef short bf16x8 __attribute__((ext_vector_type(8)));
typedef float f32x4 __attribute__((ext_vector_type(4)));
typedef float f32x2 __attribute__((ext_vector_type(2)));
typedef float f32x16 __attribute__((ext_vector_type(16)));
typedef unsigned u32x4 __attribute__((ext_vector_type(4)));
typedef unsigned u32x2 __attribute__((ext_vector_type(2)));

constexpr int DM = 2048, NBATCH = 4, SEQ = 4096, MROWS = NBATCH * SEQ, NMETA = 16, DIN = 6144, DLRU = 1024, NHEAD = 16;
constexpr int META0 = MROWS;
constexpr int RSTR = MROWS + 64;
constexpr float RMS_EPS = 1e-6f;
constexpr int NPHASE = 7;
#ifndef REP_MASK
#define REP_MASK 0
#endif
constexpr int LDS_BYTES = 131072 + 256;

constexpr size_t MiB = 1u << 20;
constexpr size_t WS_WTIN = 0;
constexpr size_t WS_WTOUT = 48 * MiB;
constexpr size_t WS_GW = 64 * MiB;
constexpr size_t WS_ROWSS = 65 * MiB;
constexpr size_t WS_BAR = 65 * MiB + 512 * 1024;
constexpr size_t WS_PCNT = WS_BAR + 16384;
constexpr size_t WS_AGG = 66 * MiB;
constexpr size_t WS_XB = 71 * MiB;
constexpr size_t WS_Y = 136 * MiB;
constexpr size_t WS_U = 201 * MiB;
constexpr size_t WS_END = 396 * MiB;
constexpr int AGG_PER_LAYER = 257 * 1024;
static_assert(WS_U + (size_t)RSTR * DIN * 2 <= WS_END && WS_Y + (size_t)RSTR * DM * 2 <= WS_U && WS_XB + (size_t)RSTR * DM * 2 <= WS_Y, "ws map");
static_assert(WS_WTIN + (size_t)2 * DIN * DM * 2 <= WS_WTOUT && WS_WTOUT + (size_t)2 * DM * DM * 2 <= WS_GW && WS_AGG + (size_t)2 * AGG_PER_LAYER * 8 <= WS_XB && WS_ROWSS + (size_t)3 * RSTR * 4 <= WS_BAR, "ws map 2");

struct Args { const float* in[14]; float* out; unsigned char* ws; int ph_lo, ph_hi, flags, pad; };

__device__ __forceinline__ unsigned f2bf(float f) { unsigned u = __builtin_bit_cast(unsigned, f); return (u + 0x7fffu + ((u >> 16) & 1u)) >> 16; }
__device__ __forceinline__ unsigned pk2(float lo, float hi) { return f2bf(lo) | (f2bf(hi) << 16); }
__device__ __forceinline__ float bflo(unsigned w) { return __builtin_bit_cast(float, w << 16); }
__device__ __forceinline__ float bfhi(unsigned w) { return __builtin_bit_cast(float, w & 0xffff0000u); }
__device__ __forceinline__ float bf1(bf16_t v) { return __builtin_bit_cast(float, ((unsigned)v) << 16); }
__device__ __forceinline__ float sigmoidf_(float z) { return __builtin_amdgcn_rcpf(1.0f + __expf(-z)); }
__device__ __forceinline__ float wave_sum(float v) {
#pragma unroll
    for (int o = 1; o < 64; o <<= 1) v += __shfl_xor(v, o);
    return v;
}
#define LDS_WAIT() asm volatile("s_waitcnt lgkmcnt(0)" ::: "memory")

template <bool NORS> struct EpiUT {
    static constexpr bool PERM = true, AFTER_DRAIN = false;
    bf16_t* O; const float* rowss;
    __device__ __forceinline__ void operator()(const f32x4 (&acc)[2][2][4][2], const pg8::Unit& u, int wr, int wc, int fr, int fq) const {
        const int row0 = u.pm * 256 + wr * 64 + fr, col0 = u.pn * 256 + wc * 32 + 8 * fq;
        if (u.pn >= 8) {
            const int ch0 = 64 * (u.pn - 8) + 16 * wc + 4 * fq;
#pragma unroll
            for (int ai = 0; ai < 2; ++ai)
#pragma unroll
                for (int m = 0; m < 4; ++m) {
                    const int r = row0 + ai * 128 + m * 16;
                    const float rs = NORS ? 1.0f : rsqrtf(rowss[r] * (1.0f / DM) + RMS_EPS);
                    const f32x4 bv = acc[ai][0][m][0] * rs, cv = acc[ai][0][m][1] * rs, xv = acc[ai][1][m][0] * rs, gv = acc[ai][1][m][1] * rs;
                    u32x4 w;
#pragma unroll
                    for (int i = 0; i < 4; ++i) w[i] = pg8::cvt_pk_bf16(bv[i] * gv[i] * sigmoidf_(gv[i]), cv[i] * xv[i]);
                    *(u32x4*)(O + (size_t)r * DIN + 2048 + 2 * ch0) = w;
                }
            return;
        }
#pragma unroll
        for (int ai = 0; ai < 2; ++ai)
#pragma unroll
            for (int m = 0; m < 4; ++m) {
                const int r = row0 + ai * 128 + m * 16;
                const float rs = NORS ? 1.0f : rsqrtf(rowss[r] * (1.0f / DM) + RMS_EPS);
                bf16_t* rowp = O + (size_t)r * DIN + col0;
#pragma unroll
                for (int bj = 0; bj < 2; ++bj) {
                    const f32x4 v0 = acc[ai][bj][m][0] * rs, v1 = acc[ai][bj][m][1] * rs;
                    u32x4 w; w.x = pg8::cvt_pk_bf16(v0[0], v0[1]); w.y = pg8::cvt_pk_bf16(v0[2], v0[3]); w.z = pg8::cvt_pk_bf16(v1[0], v1[1]); w.w = pg8::cvt_pk_bf16(v1[2], v1[3]);
                    *(u32x4*)(rowp + bj * 128) = w;
                }
            }
    }
};
struct EpiNull {
    static constexpr bool PERM = true, AFTER_DRAIN = false;
    float* sink;
    __device__ __forceinline__ void operator()(const f32x4 (&acc)[2][2][4][2], const pg8::Unit& u, int wr, int wc, int fr, int fq) const {
        f32x4 s = {0.f, 0.f, 0.f, 0.f};
#pragma unroll
        for (int ai = 0; ai < 2; ++ai)
#pragma unroll
            for (int bj = 0; bj < 2; ++bj)
#pragma unroll
                for (int m = 0; m < 4; ++m) { s += acc[ai][bj][m][0]; s += acc[ai][bj][m][1]; }
        if (s[0] + s[1] + s[2] + s[3] == 1.2345678e33f) sink[u.pm] = s[0];
    }
};
typedef EpiUT<false> EpiU;
#ifndef EPI_MB
#define EPI_MB 2
#endif
struct EpiRes {
    static constexpr bool PERM = true, AFTER_DRAIN = false;
    const float* res; float* out; bf16_t* xb; float* rowss;
    __device__ __forceinline__ void operator()(const f32x4 (&acc)[2][2][4][2], const pg8::Unit& u, int wr, int wc, int fr, int fq) const {
        const int row0 = u.pm * 256 + wr * 64 + fr, col0 = u.pn * 256 + wc * 32 + 8 * fq;
#pragma unroll
        for (int ai = 0; ai < 2; ++ai) {
#pragma unroll
          for (int mh = 0; mh < 4; mh += EPI_MB) {
            f32x4 rv[4][2][2];
#pragma unroll
            for (int m = mh; m < mh + EPI_MB; ++m)
#pragma unroll
                for (int bj = 0; bj < 2; ++bj) { const float* p = res + (size_t)(row0 + ai * 128 + m * 16) * DM + col0 + bj * 128; rv[m][bj][0] = *(const f32x4*)p; rv[m][bj][1] = *(const f32x4*)(p + 4); }
            asm volatile("" ::: "memory");
#pragma unroll
            for (int m = mh; m < mh + EPI_MB; ++m) {
                const int r = row0 + ai * 128 + m * 16; const size_t off = (size_t)r * DM + col0; float ss = 0.f;
#pragma unroll
                for (int bj = 0; bj < 2; ++bj) {
                    const f32x4 h0 = rv[m][bj][0] + acc[ai][bj][m][0], h1 = rv[m][bj][1] + acc[ai][bj][m][1];
                    if (out) { *(f32x4*)(out + off + bj * 128) = h0; *(f32x4*)(out + off + bj * 128 + 4) = h1; }
                    if (xb) { u32x4 w; w.x = pg8::cvt_pk_bf16(h0[0], h0[1]); w.y = pg8::cvt_pk_bf16(h0[2], h0[3]); w.z = pg8::cvt_pk_bf16(h1[0], h1[1]); w.w = pg8::cvt_pk_bf16(h1[2], h1[3]);
                        *(u32x4*)(xb + off + bj * 128) = w; }
                    ss += (h0[0] * h0[0] + h0[1] * h0[1]) + (h0[2] * h0[2] + h0[3] * h0[3]) + (h1[0] * h1[0] + h1[1] * h1[1]) + (h1[2] * h1[2] + h1[3] * h1[3]);
                }
                ss += __shfl_xor(ss, 16); ss += __shfl_xor(ss, 32);
                if (fq == 0) unsafeAtomicAdd(rowss + r, ss);
            }
            asm volatile("" ::: "memory");
          }
        }
    }
};

struct EpiResNorm {
    static constexpr bool PERM = true, AFTER_DRAIN = false;
    const bf16_t* res; float* out; float* rowss; unsigned* cnt; const float* fg;
    __device__ __forceinline__ void operator()(f32x4 (&acc)[2][2][4][2], const pg8::Unit& u, int wr, int wc, int fr, int fq) const {
        const int row0 = u.pm * 256 + wr * 64 + fr, col0 = u.pn * 256 + wc * 32 + 8 * fq;
#pragma unroll
        for (int ai = 0; ai < 2; ++ai) {
#pragma unroll
          for (int mh = 0; mh < 4; mh += EPI_MB) {
            u32x4 rw[4][2];
#pragma unroll
            for (int m = mh; m < mh + EPI_MB; ++m)
#pragma unroll
                for (int bj = 0; bj < 2; ++bj) rw[m][bj] = *(const u32x4*)(res + (size_t)(row0 + ai * 128 + m * 16) * DM + col0 + bj * 128);
            asm volatile("" ::: "memory");
#pragma unroll
            for (int m = mh; m < mh + EPI_MB; ++m) {
                float ss = 0.f;
#pragma unroll
                for (int bj = 0; bj < 2; ++bj) {
                    const u32x4 w = rw[m][bj];
                    const f32x4 h0 = (f32x4){bflo(w.x), bfhi(w.x), bflo(w.y), bfhi(w.y)} + acc[ai][bj][m][0], h1 = (f32x4){bflo(w.z), bfhi(w.z), bflo(w.w), bfhi(w.w)} + acc[ai][bj][m][1];
                    acc[ai][bj][m][0] = h0; acc[ai][bj][m][1] = h1;
                    ss += (h0[0] * h0[0] + h0[1] * h0[1]) + (h0[2] * h0[2] + h0[3] * h0[3]) + (h1[0] * h1[0] + h1[1] * h1[1]) + (h1[2] * h1[2] + h1[3] * h1[3]);
                }
                ss += __shfl_xor(ss, 16); ss += __shfl_xor(ss, 32);
                if (fq == 0) unsafeAtomicAdd(rowss + row0 + ai * 128 + m * 16, ss);
            }
            asm volatile("" ::: "memory");
          }
        }
        asm volatile("s_waitcnt vmcnt(0)" ::: "memory");
        unsigned* cw = cnt + 64 * (2 * u.pm + wr);
        if (fr == 0 && fq == 0) __hip_atomic_fetch_add(cw, 1u, __ATOMIC_RELAXED, __HIP_MEMORY_SCOPE_AGENT);
        f32x4 gv[2][2];
#pragma unroll
        for (int bj = 0; bj < 2; ++bj) { gv[bj][0] = *(const f32x4*)(fg + col0 + bj * 128); gv[bj][1] = *(const f32x4*)(fg + col0 + bj * 128 + 4); }
        { unsigned sp = 0;
          while ((unsigned)__builtin_amdgcn_readfirstlane(__hip_atomic_load(cw, __ATOMIC_RELAXED, __HIP_MEMORY_SCOPE_AGENT)) < 32u) { __builtin_amdgcn_s_sleep(1); if (++sp > (1u << 16)) break; } }
        asm volatile("" ::: "memory");
#pragma unroll
        for (int ai = 0; ai < 2; ++ai)
#pragma unroll
            for (int m = 0; m < 4; ++m) {
                const int r = row0 + ai * 128 + m * 16;
                const float rs = rsqrtf(__hip_atomic_load(rowss + r, __ATOMIC_RELAXED, __HIP_MEMORY_SCOPE_AGENT) * (1.0f / DM) + RMS_EPS);
                float* op = out + (size_t)r * DM + col0;
#pragma unroll
                for (int bj = 0; bj < 2; ++bj) { *(f32x4*)(op + bj * 128) = acc[ai][bj][m][0] * rs * gv[bj][0]; *(f32x4*)(op + bj * 128 + 4) = acc[ai][bj][m][1] * rs * gv[bj][1]; }
            }
    }
};
struct PanelOrder {
    int Gp, v;
    __device__ void init(int G, int c) { Gp = G & ~7; v = c; if ((Gp & 63) == 0) v = (c & 7) * (Gp >> 3) + (c >> 3); if (c >= Gp) v = -1; }
    __device__ bool next(int i, pg8::Unit& u) const { if (v < 0) return false; const long L = (long)i * Gp + v; if (L >= 64 * 8) return false; u.pm = (int)(L >> 3); u.pn = (int)(L & 7); return true; }
    __device__ __forceinline__ void a_ready(const pg8::Unit&) const {}
    __device__ __forceinline__ void done(const pg8::Unit&) const {}
};

template <class F> __device__ __forceinline__ void meta_gemm(const bf16_t* A, const bf16_t* Bt, int ngroups, LAS unsigned char* lds, int wid, int lane, F epi) {
    const int fr = lane & 15, fq = lane >> 4, half = wid >> 2, wq = wid & 3;
    LAS f32x4* red = (LAS f32x4*)lds;
    for (int p = blockIdx.x; 2 * p < ngroups; p += gridDim.x) {
        const int g = 2 * p + half;
        f32x4 acc = {0.f, 0.f, 0.f, 0.f};
        if (g < ngroups) {
            const bf16_t* ap = A + (size_t)fr * DM + wq * 512 + fq * 8;
            const bf16_t* bp = Bt + (size_t)(g * 16 + fr) * DM + wq * 512 + fq * 8;
            bf16x8 av[16], bv[16];
#pragma unroll
            for (int s = 0; s < 16; ++s) { av[s] = *(const bf16x8*)(ap + 32 * s); bv[s] = *(const bf16x8*)(bp + 32 * s); }
#pragma unroll
            for (int s = 0; s < 16; ++s) acc = __builtin_amdgcn_mfma_f32_16x16x32_bf16(bv[s], av[s], acc, 0, 0, 0);
        }
        red[wid * 64 + lane] = acc;
        __syncthreads();
        if (wq == 0 && g < ngroups) {
            f32x4 s = red[wid * 64 + lane];
#pragma unroll
            for (int w = 1; w < 4; ++w) s += red[(wid + w) * 64 + lane];
            epi(fr, g * 16 + 4 * fq, s);
        }
        __syncthreads();
    }
}

__host__ __device__ __forceinline__ int in_col(int p) {
    if (p < 2048) return p;
    const int c = p & 255, j = (p >> 8) - 8, g = 2 * (c >> 7) + ((c >> 2) & 1), k = 16 * ((c >> 5) & 3) + 4 * ((c >> 3) & 3) + (c & 3);
    return 2048 + 1024 * g + 64 * j + k;
}
template <bool COLMAP> __device__ __forceinline__ void tr_item(const float* W, int K, int N, bf16_t* WT, const float* sc, LAS unsigned char* scr, int item, int lane) {
    const int nblk = N / 64, kb = item / nblk, nb = item % nblk, k0 = 64 * kb, n0 = 64 * nb;
    const int kr = lane >> 4, nc = (lane & 15) * 4;
    f32x4 v[16]; float g[16];
    { const float* p = W + (size_t)(k0 + kr) * N + (COLMAP ? in_col(n0 + nc) : n0 + nc);
#pragma unroll
      for (int i = 0; i < 16; ++i) { v[i] = *(const f32x4*)p; p += (size_t)4 * N; }
#pragma unroll
      for (int i = 0; i < 16; ++i) g[i] = sc ? sc[k0 + kr + 4 * i] : 1.0f; }
    asm volatile("" ::: "memory");
#pragma unroll
    for (int i = 0; i < 16; ++i) { const f32x4 s = v[i] * g[i]; u32x2 w; w.x = pg8::cvt_pk_bf16(s[0], s[1]); w.y = pg8::cvt_pk_bf16(s[2], s[3]);
        *(LAS u32x2*)(scr + (kr + 4 * i) * 136 + nc * 2) = w; }
    LDS_WAIT();
    const int c = lane & 7;
#pragma unroll
    for (int j = 0; j < 8; ++j) { const int n = (lane >> 3) + 8 * j; const LAS bf16_t* s = (const LAS bf16_t*)(scr + (8 * c) * 136 + n * 2);
        u32x4 o; o.x = (unsigned)s[0] | ((unsigned)s[68] << 16); o.y = (unsigned)s[2 * 68] | ((unsigned)s[3 * 68] << 16); o.z = (unsigned)s[4 * 68] | ((unsigned)s[5 * 68] << 16); o.w = (unsigned)s[6 * 68] | ((unsigned)s[7 * 68] << 16);
        *(u32x4*)(WT + (size_t)(n0 + n) * K + k0 + 8 * c) = o; }
    LDS_WAIT();
}
__device__ __forceinline__ void cvt_row(const float* src, bf16_t* dst, float* ss, int lane) {
    const f32x4* xr = (const f32x4*)src + lane; f32x4 v[8]; float s = 0.f;
#pragma unroll
    for (int j = 0; j < 8; ++j) { v[j] = xr[64 * j]; s += (v[j].x * v[j].x + v[j].y * v[j].y) + (v[j].z * v[j].z + v[j].w * v[j].w); }
    s = wave_sum(s);
    u32x2* o8 = (u32x2*)dst + lane;
#pragma unroll
    for (int j = 0; j < 8; ++j) { u32x2 w; w.x = pk2(v[j].x, v[j].y); w.y = pk2(v[j].z, v[j].w); o8[64 * j] = w; }
    if (lane == 0) *ss = s;
}

struct Mix {
    const float *conv_a_w, *conv_a_b, *lru_br, *lru_bi, *lru_lambda, *conv_b_w;
    const bf16_t* gw;
    bf16_t* U; bf16_t* Y; unsigned long long* AGG;
};
struct ItemId { int hd, b, c, row0, ntok, agg; bool meta; };
__device__ __forceinline__ ItemId decode_item(int id) {
    ItemId I;
    if (id < 16) { I.meta = true; I.hd = id; I.b = 0; I.c = 0; I.row0 = META0; I.ntok = 16; I.agg = 256; }
    else { const int j = id - 16; I.meta = false; I.hd = j & 15; I.c = (j >> 4) & 63; I.b = j >> 10; I.row0 = I.b * SEQ + I.c * 64; I.ntok = 64; I.agg = I.b * 64 + I.c; }
    return I;
}
constexpr int N_ITEMS = 16 + NBATCH * NHEAD * 64;

__device__ __forceinline__ bool agg_ok(unsigned long long v) { return (unsigned)v != 0u; }
template <bool META> __device__ __forceinline__ void mix_item(const Mix& X, int id, LAS unsigned char* xt, int lane) {
    constexpr int NT = META ? 16 : 64, NTB = META ? 1 : 2, NQ = META ? 2 : 4;
    constexpr float LOG2E = 1.4426950408889634f;
    const ItemId I = decode_item(id);
    const int ch = I.hd * 64 + lane;
    const float nls2 = -8.0f * LOG2E * log1pf(__expf(-X.lru_lambda[ch]));
    bf16_t raw[NT], rh0 = 0, rh1 = 0, rh2 = 0;
    const float w0 = X.conv_a_w[ch], w1 = X.conv_a_w[1024 + ch], w2 = X.conv_a_w[2048 + ch], w3 = X.conv_a_w[3072 + ch], cb = X.conv_a_b[ch];
    {
        const GAS bf16_t* sb = (const GAS bf16_t*)(X.U + (size_t)I.row0 * DIN + I.hd * 64);
        if (!META) { const GAS bf16_t* hp0 = (I.c == 0) ? (const GAS bf16_t*)(X.U + (size_t)(META0 + 13) * DIN + I.hd * 64) : sb - 3 * DIN; rh0 = hp0[lane]; rh1 = hp0[DIN + lane]; rh2 = hp0[2 * DIN + lane]; }
#pragma unroll
        for (int t = 0; t < NT; ++t) { raw[t] = sb[lane]; sb += DIN; asm volatile("" : "+s"(sb)); }
    }
    bf16x8 BfR0[4], BfR1[4], BfI0[4], BfI1[4];
    { const bf16_t* gr = X.gw + (size_t)(I.hd * 64 + (lane & 31)) * 64 + 8 * (lane >> 5); const bf16_t* gi = gr + 16 * 64 * 64;
#pragma unroll
      for (int s = 0; s < 4; ++s) { BfR0[s] = *(const bf16x8*)(gr + 16 * s); BfR1[s] = *(const bf16x8*)(gr + 32 * 64 + 16 * s); BfI0[s] = *(const bf16x8*)(gi + 16 * s); BfI1[s] = *(const bf16x8*)(gi + 32 * 64 + 16 * s); } }
    asm volatile("" ::: "memory");
    float xm3 = bf1(rh0), xm2 = bf1(rh1), xm1 = bf1(rh2);
#pragma unroll
    for (int t = 0; t < NT; ++t) { const float x0 = bf1(raw[t]); const float xc = cb + w0 * xm3 + w1 * xm2 + w2 * xm1 + w3 * x0; xm3 = xm2; xm2 = xm1; xm1 = x0;
        *(LAS bf16_t*)(xt + t * 144 + lane * 2) = (bf16_t)f2bf(xc); }
    const float brA = X.lru_br[I.hd * 64 + (lane & 31)], brB = X.lru_br[I.hd * 64 + 32 + (lane & 31)], biA = X.lru_bi[I.hd * 64 + (lane & 31)], biB = X.lru_bi[I.hd * 64 + 32 + (lane & 31)];
    float h = 0.f, P = 1.f;
    unsigned hp[NT];
#pragma unroll
    for (int tb = 0; tb < NTB; ++tb) {
        f32x16 aR0, aR1, aI0, aI1;
#pragma unroll
        for (int e = 0; e < 16; ++e) { aR0[e] = brA; aR1[e] = brB; aI0[e] = biA; aI1[e] = biB; }
#pragma unroll
        for (int s = 0; s < 4; ++s) {
            const bf16x8 af = *(const LAS bf16x8*)(xt + (tb * 32 + (lane & 31)) * 144 + (16 * s + 8 * (lane >> 5)) * 2);
            aR0 = __builtin_amdgcn_mfma_f32_32x32x16_bf16(af, BfR0[s], aR0, 0, 0, 0);
            aR1 = __builtin_amdgcn_mfma_f32_32x32x16_bf16(af, BfR1[s], aR1, 0, 0, 0);
            aI0 = __builtin_amdgcn_mfma_f32_32x32x16_bf16(af, BfI0[s], aI0, 0, 0, 0);
            aI1 = __builtin_amdgcn_mfma_f32_32x32x16_bf16(af, BfI1[s], aI1, 0, 0, 0);
        }
#pragma unroll
        for (int q = 0; q < NQ; ++q) {
            float Rv[2][4], Iv[2][4];
#pragma unroll
            for (int k = 0; k < 4; ++k) {
                const int reg = 4 * q + k;
                const float r0f = aR0[reg], r1f = aR1[reg], i0f = aI0[reg], i1f = aI1[reg];
                auto r = __builtin_amdgcn_permlane32_swap(__float_as_uint(r0f), __float_as_uint(r1f), false, false);
                Rv[0][k] = __uint_as_float(r[0]); Rv[1][k] = __uint_as_float(r[1]);
                auto i2 = __builtin_amdgcn_permlane32_swap(__float_as_uint(i0f), __float_as_uint(i1f), false, false);
                Iv[0][k] = __uint_as_float(i2[0]); Iv[1][k] = __uint_as_float(i2[1]);
            }
#pragma unroll
            for (int st = 0; st < 2; ++st)
#pragma unroll
                for (int p = 0; p < 2; ++p) {
                    const int t = tb * 32 + 8 * q + 4 * st + 2 * p;
                    f32x2 er = (f32x2){Rv[st][2 * p], Rv[st][2 * p + 1]} * (-LOG2E), ei = (f32x2){Iv[st][2 * p], Iv[st][2 * p + 1]} * (-LOG2E);
                    er.x = __builtin_amdgcn_exp2f(er.x); er.y = __builtin_amdgcn_exp2f(er.y); ei.x = __builtin_amdgcn_exp2f(ei.x); ei.y = __builtin_amdgcn_exp2f(ei.y);
                    er = er + 1.0f; ei = ei + 1.0f;
                    f32x2 rg, ig; rg.x = __builtin_amdgcn_rcpf(er.x); rg.y = __builtin_amdgcn_rcpf(er.y); ig.x = __builtin_amdgcn_rcpf(ei.x); ig.y = __builtin_amdgcn_rcpf(ei.y);
                    const f32x2 l2 = rg * nls2;
                    f32x2 a; a.x = __builtin_amdgcn_exp2f(l2.x); a.y = __builtin_amdgcn_exp2f(l2.y);
                    f32x2 om = 1.0f - a * a; om.x = fmaxf(om.x, 0.f); om.y = fmaxf(om.y, 0.f);
                    f32x2 mu; mu.x = __builtin_amdgcn_sqrtf(om.x); mu.y = __builtin_amdgcn_sqrtf(om.y);
                    const f32x2 xc = (f32x2){bf1(*(const LAS bf16_t*)(xt + t * 144 + lane * 2)), bf1(*(const LAS bf16_t*)(xt + (t + 1) * 144 + lane * 2))};
                    const f32x2 bb = mu * ig * xc;
                    h = a.x * h + bb.x; P = P * a.x; hp[t] = pg8::cvt_pk_bf16(h, P);
                    h = a.y * h + bb.y; P = P * a.y; hp[t + 1] = pg8::cvt_pk_bf16(h, P);
                }
        }
    }
    __hip_atomic_store(X.AGG + (size_t)I.agg * 1024 + ch, ((unsigned long long)__float_as_uint(h) << 32) | (unsigned long long)__float_as_uint(P), __ATOMIC_RELAXED, __HIP_MEMORY_SCOPE_AGENT);
    asm volatile("" ::: "memory");
    bf16_t graw[NT];
    { const GAS bf16_t* sb = (const GAS bf16_t*)(X.U + (size_t)I.row0 * DIN + 1024 + I.hd * 64);
#pragma unroll
      for (int t = 0; t < NT; ++t) { graw[t] = sb[lane]; sb += DIN; asm volatile("" : "+s"(sb)); } }
    float hin = 0.f;
    if (!META) {
        { const unsigned long long* mp = X.AGG + (size_t)256 * 1024 + ch; unsigned long long v;
          for (;;) { v = __hip_atomic_load(mp, __ATOMIC_RELAXED, __HIP_MEMORY_SCOPE_AGENT); if (!__any(!agg_ok(v))) break; __builtin_amdgcn_s_sleep(2); }
          hin = __uint_as_float((unsigned)(v >> 32)); }
        const unsigned long long* ap = X.AGG + (size_t)(I.b * 64) * 1024 + ch;
        for (int j0 = 0; j0 < I.c; j0 += 16) {
            unsigned long long v[16];
            for (;;) {
                bool bad = false;
#pragma unroll
                for (int k = 0; k < 16; ++k) { v[k] = (j0 + k < I.c) ? __hip_atomic_load(ap + (size_t)(j0 + k) * 1024, __ATOMIC_RELAXED, __HIP_MEMORY_SCOPE_AGENT) : 0x000000003f800000ull; }
#pragma unroll
                for (int k = 0; k < 16; ++k) bad |= !agg_ok(v[k]);
                if (!__any(bad)) break;
                __builtin_amdgcn_s_sleep(2);
            }
#pragma unroll
            for (int k = 0; k < 16; ++k) hin = __uint_as_float((unsigned)v[k]) * hin + __uint_as_float((unsigned)(v[k] >> 32));
        }
    }
    asm volatile("" ::: "memory");
    GAS bf16_t* yp = (GAS bf16_t*)(X.Y + (size_t)I.row0 * DM + I.hd * 64);
#pragma unroll
    for (int t0 = 0; t0 < NT; t0 += 16) {
        {
#pragma unroll
            for (int k = 0; k < 16; k += 2) {
                const unsigned w0 = hp[t0 + k], w1 = hp[t0 + k + 1];
                const f32x2 gg = (f32x2){bf1(graw[t0 + k]), bf1(graw[t0 + k + 1])};
                f32x2 e = gg * (-LOG2E); e.x = __builtin_amdgcn_exp2f(e.x); e.y = __builtin_amdgcn_exp2f(e.y); e = e + 1.0f;
                f32x2 sg; sg.x = __builtin_amdgcn_rcpf(e.x); sg.y = __builtin_amdgcn_rcpf(e.y);
                const f32x2 hv = (f32x2){bflo(w0), bflo(w1)} + (f32x2){bfhi(w0), bfhi(w1)} * hin;
                const f32x2 y = hv * gg * sg;
                const unsigned pk = pg8::cvt_pk_bf16(y.x, y.y);
                yp[lane] = (bf16_t)(pk & 0xffffu); yp[DM + lane] = (bf16_t)(pk >> 16); yp += 2 * DM; asm volatile("" : "+s"(yp));
            }
        }
    }
}

__device__ __forceinline__ void ld8(const bf16_t* p, float (&o)[8]) {
    const u32x4 w = *(const u32x4*)p;
    o[0] = bflo(w.x); o[1] = bfhi(w.x); o[2] = bflo(w.y); o[3] = bfhi(w.y); o[4] = bflo(w.z); o[5] = bfhi(w.z); o[6] = bflo(w.w); o[7] = bfhi(w.w);
}
__device__ __forceinline__ void partb(const Mix& X, int tid) {
    int itn = blockIdx.x * 512 + tid; bool meta_done = false;
    for (;;) {
        int it;
        if (itn < 1024 * 128) { it = itn; itn += gridDim.x * 512; }
        else if (!meta_done && gridDim.x >= 8 && blockIdx.x + 4 >= gridDim.x && tid < 128) { it = (1024 + (int)(gridDim.x - 1 - blockIdx.x)) * 128 + tid; meta_done = true; }
        else if (!meta_done && gridDim.x < 8 && blockIdx.x == 0 && tid < 128) { it = 1028 * 128 + tid; meta_done = true; }
        else break;
        const int c0 = (it & 127) * 8, run = it >> 7;
        float w0[8], w1[8], w2[8], cm2[8], cm1[8];
        { const f32x4* p = (const f32x4*)(X.conv_b_w + c0); const f32x4 a0 = p[0], a1 = p[1], b0 = p[256], b1 = p[257], d0 = p[512], d1 = p[513];
#pragma unroll
          for (int e = 0; e < 4; ++e) { w0[e] = a0[e]; w0[4 + e] = a1[e]; w1[e] = b0[e]; w1[4 + e] = b1[e]; w2[e] = d0[e]; w2[4 + e] = d1[e]; } }
        if (run >= 1024) {
            const int t0 = (run == 1028) ? 0 : 4 * (run - 1024), nt = (run == 1028) ? 16 : 4;
            const bf16_t* up = X.U + (size_t)META0 * DIN + c0; bf16_t* yp = X.Y + (size_t)META0 * DM + 1024 + c0;
#pragma unroll
            for (int e = 0; e < 8; ++e) { cm2[e] = 0.f; cm1[e] = 0.f; }
            if (t0 > 0) {
                float c[8], x[8];
                ld8(up + (size_t)(t0 - 2) * DIN + 3072, c); ld8(up + (size_t)(t0 - 2) * DIN + 4096, x);
#pragma unroll
                for (int e = 0; e < 8; ++e) cm2[e] = c[e] * x[e];
                ld8(up + (size_t)(t0 - 1) * DIN + 3072, c); ld8(up + (size_t)(t0 - 1) * DIN + 4096, x);
#pragma unroll
                for (int e = 0; e < 8; ++e) cm1[e] = c[e] * x[e];
            }
#pragma unroll 4
            for (int t = t0; t < t0 + nt; ++t) {
                float bv[8], cv[8], xv[8], gv[8];
                ld8(up + (size_t)t * DIN + 2048, bv); ld8(up + (size_t)t * DIN + 3072, cv); ld8(up + (size_t)t * DIN + 4096, xv); ld8(up + (size_t)t * DIN + 5120, gv);
                float o[8];
#pragma unroll
                for (int e = 0; e < 8; ++e) { const float cx = cv[e] * xv[e]; const float y = w0[e] * cm2[e] + w1[e] * cm1[e] + w2[e] * cx; o[e] = bv[e] * y * (gv[e] * sigmoidf_(gv[e])); cm2[e] = cm1[e]; cm1[e] = cx; }
                u32x4 w; w.x = pk2(o[0], o[1]); w.y = pk2(o[2], o[3]); w.z = pk2(o[4], o[5]); w.w = pk2(o[6], o[7]);
                *(u32x4*)(yp + (size_t)t * DM) = w;
            }
            continue;
        }
        const int row0 = run * 16;
        const bf16_t* vp = X.U + (size_t)row0 * DIN + 2048 + 2 * c0;
        bf16_t* yp = X.Y + (size_t)row0 * DM + 1024 + c0;
        u32x4 q[16][2];
#pragma unroll
        for (int t = 0; t < 16; ++t) { q[t][0] = *(const u32x4*)(vp + (size_t)t * DIN); q[t][1] = *(const u32x4*)(vp + (size_t)t * DIN + 8); }
        if ((row0 & (SEQ - 1)) == 0) {
            float c[8], x[8];
            ld8(X.U + (size_t)(META0 + 14) * DIN + 3072 + c0, c); ld8(X.U + (size_t)(META0 + 14) * DIN + 4096 + c0, x);
#pragma unroll
            for (int e = 0; e < 8; ++e) cm2[e] = c[e] * x[e];
            ld8(X.U + (size_t)(META0 + 15) * DIN + 3072 + c0, c); ld8(X.U + (size_t)(META0 + 15) * DIN + 4096 + c0, x);
#pragma unroll
            for (int e = 0; e < 8; ++e) cm1[e] = c[e] * x[e];
        } else {
            const u32x4* p2 = (const u32x4*)(X.U + (size_t)(row0 - 2) * DIN + 2048 + 2 * c0); const u32x4* p1 = (const u32x4*)(X.U + (size_t)(row0 - 1) * DIN + 2048 + 2 * c0);
            const u32x4 a0 = p2[0], a1 = p2[1], b0 = p1[0], b1 = p1[1];
#pragma unroll
            for (int e = 0; e < 4; ++e) { cm2[e] = bfhi(a0[e]); cm2[4 + e] = bfhi(a1[e]); cm1[e] = bfhi(b0[e]); cm1[4 + e] = bfhi(b1[e]); }
        }
#pragma unroll
        for (int t = 0; t < 16; ++t) {
            float o[8];
#pragma unroll
            for (int e = 0; e < 8; ++e) { const unsigned qq = e < 4 ? q[t][0][e & 3] : q[t][1][e & 3]; const float bg = bflo(qq), cx = bfhi(qq);
                o[e] = bg * (w0[e] * cm2[e] + w1[e] * cm1[e] + w2[e] * cx); cm2[e] = cm1[e]; cm1[e] = cx; }
            u32x4 w; w.x = pk2(o[0], o[1]); w.y = pk2(o[2], o[3]); w.z = pk2(o[4], o[5]); w.w = pk2(o[6], o[7]);
            *(u32x4*)(yp + (size_t)t * DM) = w;
        }
    }
}


#ifdef DEBUG_NAIVE_MIX
__global__ void __launch_bounds__(64) naive_mixA(Mix X, const float* wr, const float* wi) {
    const int b = blockIdx.x / 16, hd = blockIdx.x % 16, lane = threadIdx.x, ch = hd * 64 + lane;
    __shared__ float xs[64];
    const float w0 = X.conv_a_w[ch], w1 = X.conv_a_w[1024 + ch], w2 = X.conv_a_w[2048 + ch], w3 = X.conv_a_w[3072 + ch], cb = X.conv_a_b[ch];
    const float br = X.lru_br[ch], bi = X.lru_bi[ch];
    const float sp = log1pf(expf(-X.lru_lambda[ch]));
    const float* wrh = wr + (size_t)hd * 4096 + lane; const float* wih = wi + (size_t)hd * 4096 + lane;
    float h = 0.f, xm3 = 0.f, xm2 = 0.f, xm1 = 0.f;
    for (int p = 0; p < NMETA + SEQ; ++p) {
        const int row = p < NMETA ? META0 + p : b * SEQ + (p - NMETA);
        const float x0 = bf1(X.U[(size_t)row * DIN + ch]);
        const float xc = cb + w0 * xm3 + w1 * xm2 + w2 * xm1 + w3 * x0; xm3 = xm2; xm2 = xm1; xm1 = x0;
        xs[lane] = xc; __syncthreads();
        float rp = br, ip = bi;
#pragma unroll 4
        for (int i = 0; i < 64; ++i) { rp += xs[i] * wrh[i * 64]; ip += xs[i] * wih[i * 64]; }
        __syncthreads();
        const float r = 1.f / (1.f + expf(-rp)), ig = 1.f / (1.f + expf(-ip));
        const float la = -8.f * r * sp; const float a = expf(la); const float bb = sqrtf(-expm1f(2.f * la)) * (ig * xc);
        h = a * h + bb;
        const float g = bf1(X.U[(size_t)row * DIN + 1024 + ch]);
        const float y = h * g / (1.f + expf(-g));
        if (p >= NMETA || b == 0) X.Y[(size_t)row * DM + ch] = (bf16_t)f2bf(y);
    }
}
__global__ void naive_mixB(Mix X) {
    for (size_t idx = (size_t)blockIdx.x * blockDim.x + threadIdx.x; idx < (size_t)(MROWS + NMETA) * 1024; idx += (size_t)gridDim.x * blockDim.x) {
        const int row = (int)(idx >> 10), c = (int)(idx & 1023);
        int r1, r2;
        if (row >= META0) { const int p = row - META0; r1 = p >= 1 ? row - 1 : -1; r2 = p >= 2 ? row - 2 : -1; }
        else { const int t = row & (SEQ - 1); r1 = t >= 1 ? row - 1 : META0 + 15; r2 = t >= 2 ? row - 2 : META0 + 14 + t; }
        auto cx = [&](int r) -> float { return r < 0 ? 0.f : bf1(X.U[(size_t)r * DIN + 3072 + c]) * bf1(X.U[(size_t)r * DIN + 4096 + c]); };
        const float y = X.conv_b_w[c] * cx(r2) + X.conv_b_w[1024 + c] * cx(r1) + X.conv_b_w[2048 + c] * cx(row);
        const float bv = bf1(X.U[(size_t)row * DIN + 2048 + c]), g = bf1(X.U[(size_t)row * DIN + 5120 + c]);
        X.Y[(size_t)row * DM + 1024 + c] = (bf16_t)f2bf(bv * y * g / (1.f + expf(-g)));
    }
}
#endif
#define XB_TMO      128
#define XB_XCNT(j)  (256  + 64 * (j))
#define XB_XSUB(j)  (1280 + 64 * (j))
#define XB_XGEN(j)  (2304 + 64 * (j))
#define XB_TOP      3328
#define XB_TOPGEN   3392
#define XCD_BAR_WORDS 3456
#define XB_SPIN_CAP (1u << 18)

__device__ __forceinline__ unsigned xb_ld(unsigned* p)              { return __hip_atomic_load(p, __ATOMIC_RELAXED, __HIP_MEMORY_SCOPE_AGENT); }
__device__ __forceinline__ unsigned xb_add(unsigned* p, unsigned v) { return __hip_atomic_fetch_add(p, v, __ATOMIC_RELAXED, __HIP_MEMORY_SCOPE_AGENT); }
__device__ __forceinline__ unsigned xb_xcc_id() { return (unsigned)__builtin_amdgcn_s_getreg((3 << 11) | 20) & 0xFu; }
#define XB_SPIN(cond, bar) do { unsigned _sp = 0; while (cond) { __builtin_amdgcn_s_sleep(1); \
    if ((++_sp & 255u) == 0u) { if (xb_ld(&(bar)[XB_TMO])) break; if (_sp > XB_SPIN_CAP) { atomicAdd(&(bar)[XB_TMO], 1u); break; } } } } while (0)

struct XcdBarrier {
    unsigned* bar; unsigned x;
    volatile LAS unsigned* st;
};

__device__ __forceinline__ XcdBarrier xcd_barrier_post(unsigned* bar, volatile LAS unsigned* st) {
    XcdBarrier b; b.bar = bar; b.x = xb_xcc_id(); b.st = st;
    if (threadIdx.x == 0) (void)xb_add(&bar[XB_XCNT(b.x)], 1u);
    return b;
}
__device__ __forceinline__ void xcd_barrier_complete(unsigned* bar, unsigned x, unsigned& nloc, unsigned& nx) {
    const unsigned G = gridDim.x * gridDim.y * gridDim.z;
    unsigned sum, cnt, mine, sp = 0u;
    for (;;) {
        sum = 0u; cnt = 0u; mine = 0u;
#pragma unroll
        for (unsigned j = 0; j < 16; ++j) { const unsigned c = xb_ld(&bar[XB_XCNT(j)]); sum += c; cnt += (c > 0u) ? 1u : 0u; mine = (j == x) ? c : mine; }
        if (sum == G) break;
        __builtin_amdgcn_s_sleep(1);
        if ((++sp & 255u) == 0u) { if (xb_ld(&bar[XB_TMO])) break; if (sp > XB_SPIN_CAP) { atomicAdd(&bar[XB_TMO], 1u); break; } }
    }
    nloc = mine > 0u ? mine : 1u; nx = cnt > 0u ? cnt : 1u;
}

__device__ __forceinline__ void xcd_barrier(const XcdBarrier& b) {
    asm volatile("s_waitcnt vmcnt(0)" ::: "memory");
    __syncthreads();
    if (threadIdx.x == 0) {
        unsigned* bar = b.bar;
        __builtin_amdgcn_s_waitcnt(0);
        unsigned nloc = b.st[0], nx = b.st[1];
        if (nloc == 0u) { xcd_barrier_complete(bar, b.x, nloc, nx); b.st[0] = nloc; b.st[1] = nx; }
        const unsigned old = xb_add(&bar[XB_XSUB(b.x)], 1u);
        const unsigned gen = old / nloc;
        if (old + 1u == (gen + 1u) * nloc) {
            __builtin_amdgcn_fence(__ATOMIC_RELEASE, "agent");
            asm volatile("s_waitcnt vmcnt(0)" ::: "memory");
            const unsigned og = xb_add(&bar[XB_TOP], 1u);
            const unsigned tg = og / nx;
            if (og + 1u == (tg + 1u) * nx) xb_add(&bar[XB_TOPGEN], 1u);
            else XB_SPIN(xb_ld(&bar[XB_TOPGEN]) == tg, bar);
            __builtin_amdgcn_fence(__ATOMIC_ACQUIRE, "agent");
            xb_add(&bar[XB_XGEN(b.x)], 1u);
            asm volatile("s_waitcnt vmcnt(0)" ::: "memory");
        } else {
            XB_SPIN(xb_ld(&bar[XB_XGEN(b.x)]) == gen, bar);
            __builtin_amdgcn_fence(__ATOMIC_ACQUIRE, "agent");
            asm volatile("s_waitcnt vmcnt(0)" ::: "memory");
        }
    }
    __syncthreads();
}

__global__ void __launch_bounds__(512, 2) hymba_fwd(Args a) {
    extern __shared__ __attribute__((aligned(16))) unsigned char lds_raw[];
    LAS unsigned char* lds = (LAS unsigned char*)lds_raw;
    cg::grid_group grid = cg::this_grid();
    const int NGW = gridDim.x * 8;
    if (threadIdx.x < 64) ((LAS unsigned*)(lds + 131072))[threadIdx.x] = 0u;
    __syncthreads();
    XcdBarrier xbar; xbar.bar = (unsigned*)(a.ws + WS_BAR); xbar.x = 0; xbar.st = nullptr;
    if (a.ph_hi - a.ph_lo > 1) xbar = xcd_barrier_post((unsigned*)(a.ws + WS_BAR), (volatile LAS unsigned*)(lds + 131072));
    if (a.ph_lo < 0) grid.sync();
#define LAUNDER() int tid = threadIdx.x; asm volatile("" : "+v"(tid)); const int wid = __builtin_amdgcn_readfirstlane(tid >> 6), lane = tid & 63, gw = blockIdx.x * 8 + wid
    const int lo = a.ph_lo, hi = a.ph_hi;
#define IN(k) (lo <= (k) && (k) < hi)
#ifndef STAGGER_N
#define STAGGER_N 0
#endif
#define STAGGER() do { if (STAGGER_N) for (int _k = 0; _k < (int)(blockIdx.x & 7); ++_k) __builtin_amdgcn_s_sleep(STAGGER_N); } while (0)
#define SEAM(k) do { if (IN(k) && IN((k) + 1)) { xcd_barrier(xbar); if ((REP_MASK >> 10) & 1) { xcd_barrier(xbar); xcd_barrier(xbar); } } } while (0)
    const float* x = a.in[0]; const float* meta = a.in[1]; const float* norm_g = a.in[2]; const float* w_in = a.in[3];
    const float* conv_a_w = a.in[4]; const float* conv_a_b = a.in[5]; const float* lru_wr = a.in[6]; const float* lru_br = a.in[7];
    const float* lru_wi = a.in[8]; const float* lru_bi = a.in[9]; const float* lru_lambda = a.in[10]; const float* conv_b_w = a.in[11];
    const float* w_out = a.in[12]; const float* final_g = a.in[13];
    unsigned char* ws = a.ws;
    bf16_t* WTIN = (bf16_t*)(ws + WS_WTIN); bf16_t* WTOUT = (bf16_t*)(ws + WS_WTOUT); bf16_t* GW = (bf16_t*)(ws + WS_GW);
    float* ROWSS = (float*)(ws + WS_ROWSS); unsigned long long* AGG = (unsigned long long*)(ws + WS_AGG);
    bf16_t* XB = (bf16_t*)(ws + WS_XB); bf16_t* Y = (bf16_t*)(ws + WS_Y); bf16_t* U = (bf16_t*)(ws + WS_U);

    if (IN(0)) for (int rep = 0; rep <= ((REP_MASK >> 0) & 1); ++rep) {
        LAUNDER();
        LAS unsigned char* scr = lds + wid * 16384;
        constexpr int I_IN = (DM / 64) * (DIN / 64);
        constexpr int NIT = I_IN + 64;
        for (int it = gw; it < NIT; it += NGW) {
            int r = it;
            if (r < I_IN) { tr_item<true>(w_in, DM, DIN, WTIN, norm_g, scr, r, lane); continue; } r -= I_IN;
            { const int mtx = r, l = mtx >> 5, g = (mtx >> 4) & 1, hd = mtx & 15;
              const float* src = (g ? lru_wi : lru_wr) + (size_t)(l * 16 + hd) * 4096;
              tr_item<false>(src, 64, 64, GW + (size_t)mtx * 4096, nullptr, scr, 0, lane); }
        }
        for (int m = gw; m < MROWS + NMETA; m += NGW) {
            const float* src = m < MROWS ? x + (size_t)m * DM : meta + (size_t)(m - MROWS) * DM;
            cvt_row(src, XB + (size_t)m * DM, ROWSS + m, lane);
        }
        for (int i = blockIdx.x * 512 + tid; i < 2 * RSTR; i += gridDim.x * 512) ROWSS[RSTR + i] = 0.f;
        for (int i = blockIdx.x * 512 + tid; i < AGG_PER_LAYER; i += gridDim.x * 512) ((u32x4*)AGG)[i] = (u32x4){0u, 0u, 0u, 0u};
    }
    SEAM(0);

#pragma unroll 1
    for (int l = 0; l < 2; ++l) {
        const int pb = 1 + 3 * l;
        const bf16_t* wtin = WTIN + (size_t)l * DIN * DM; const bf16_t* wtout = WTOUT + (size_t)l * DM * DM;
        float* rss_in = ROWSS + (size_t)l * RSTR; float* rss_out = ROWSS + (size_t)(l + 1) * RSTR;
        Mix X; X.conv_a_w = conv_a_w + l * 4 * DLRU; X.conv_a_b = conv_a_b + l * DLRU; X.lru_br = lru_br + l * DLRU; X.lru_bi = lru_bi + l * DLRU; X.lru_lambda = lru_lambda + l * DLRU;
        X.conv_b_w = conv_b_w + l * 3 * DLRU; X.gw = GW + (size_t)l * 2 * 16 * 4096; X.U = U; X.Y = Y; X.AGG = AGG + (size_t)l * AGG_PER_LAYER;

        if (IN(pb)) for (int rep = 0; rep <= ((REP_MASK >> pb) & 1); ++rep) {
            LAUNDER();
            STAGGER();
            for (int mrep = 0; mrep <= ((REP_MASK >> 16) & 1); ++mrep)
            meta_gemm(XB + (size_t)META0 * DM, wtin, DIN / 16, lds, wid, lane, [&](int m, int n0, f32x4 s) {
                const float rs = rsqrtf(rss_in[META0 + m] * (1.0f / DM) + RMS_EPS);
                u32x2 w; w.x = pk2(s[0] * rs, s[1] * rs); w.y = pk2(s[2] * rs, s[3] * rs);
                *(u32x2*)(U + (size_t)(META0 + m) * DIN + in_col(n0)) = w; });
            pg8::Gemm g{XB, wtin, MROWS, DIN, DM}; pg8::StaticOrder S; S.init(MROWS, DIN, (int)gridDim.x, (int)blockIdx.x);
            if ((REP_MASK >> 17) & 1) { EpiUT<true> En{U, rss_in}; pg8::gemm_phase<EpiUT<true>, pg8::StaticOrder, false>(lds, g, S, En, nullptr); }
            if ((REP_MASK >> 15) & 1) { EpiNull En{ROWSS + (size_t)3 * RSTR}; pg8::gemm_phase<EpiNull, pg8::StaticOrder, false>(lds, g, S, En, nullptr); }
            EpiU E{U, rss_in};
            pg8::gemm_phase<EpiU, pg8::StaticOrder, false>(lds, g, S, E, nullptr);
        }
        SEAM(pb);
        if (IN(pb + 1)) for (int rep = 0; rep <= ((REP_MASK >> (pb + 1)) & 1); ++rep) {
            LAUNDER();
#pragma unroll 1
            for (int step = 0; step < 2; ++step) {
                if ((step == 0) == (wid < 4)) {
                    if (rep == 1 && ((REP_MASK >> 13) & 1)) continue;
#pragma unroll 1
                    for (int id = gw; id < N_ITEMS; id += NGW) { if (id < 16) mix_item<true>(X, id, lds + wid * 9216, lane); else mix_item<false>(X, id, lds + wid * 9216, lane); }
                } else { if (rep == 1 && ((REP_MASK >> 12) & 1)) continue; partb(X, tid); }
            }
            if (l == 0) {
                constexpr int I_OUT = (DM / 64) * (DM / 64);
                LAS unsigned char* scr = lds + wid * 9216;
#pragma unroll 1
                for (int it = gw; it < I_OUT; it += NGW) tr_item<false>(w_out, DM, DM, WTOUT, nullptr, scr, it, lane);
            }
        }
        SEAM(pb + 1);
        if (IN(pb + 2)) {
            LAUNDER();
            STAGGER();
            const bool early_copies = ((blockIdx.x >> 3) & 1) != 0;
#define COHORT_COPIES() do { constexpr int I_IN = (DM / 64) * (DIN / 64), I_OUT = (DM / 64) * (DM / 64); LAS unsigned char* scr = lds + wid * 9216; \
                for (int it = gw; it < I_IN + I_OUT; it += NGW) { \
                    if (it < I_IN) tr_item<true>(w_in + (size_t)DM * DIN, DM, DIN, WTIN + (size_t)DIN * DM, norm_g + DM, scr, it, lane); \
                    else tr_item<false>(w_out + (size_t)DM * DM, DM, DM, WTOUT + (size_t)DM * DM, nullptr, scr, it - I_IN, lane); } } while (0)
            if (l == 0 && early_copies) { COHORT_COPIES(); __syncthreads(); }
            if (l == 0) {
                meta_gemm(Y + (size_t)META0 * DM, wtout, DM / 16, lds, wid, lane, [&](int m, int n0, f32x4 s) {
                    const f32x4 r = *(const f32x4*)(meta + (size_t)m * DM + n0); const f32x4 hh = r + s;
                    u32x2 w; w.x = pk2(hh[0], hh[1]); w.y = pk2(hh[2], hh[3]);
                    *(u32x2*)(XB + (size_t)(META0 + m) * DM + n0) = w;
                    unsafeAtomicAdd(rss_out + META0 + m, (hh[0] * hh[0] + hh[1] * hh[1]) + (hh[2] * hh[2] + hh[3] * hh[3])); });
            }
            pg8::Gemm g{Y, wtout, MROWS, DM, DM};
            if (l == 0) {
                pg8::StaticOrder S; S.init(MROWS, DM, (int)gridDim.x, (int)blockIdx.x);
                if ((REP_MASK >> 11) & 1) { EpiU Ed{U, rss_in}; pg8::gemm_phase<EpiU, pg8::StaticOrder, false>(lds, g, S, Ed, nullptr); }
                if ((REP_MASK >> 14) & 1) { EpiRes Ed{x, nullptr, XB, ROWSS + (size_t)3 * RSTR}; pg8::gemm_phase<EpiRes, pg8::StaticOrder, false>(lds, g, S, Ed, nullptr); }
                EpiRes E{x, nullptr, XB, rss_out};
                pg8::gemm_phase<EpiRes, pg8::StaticOrder, false>(lds, g, S, E, nullptr);
                if (!early_copies) COHORT_COPIES();
            } else {
                PanelOrder S; S.init((int)gridDim.x, (int)blockIdx.x);
                EpiResNorm E{XB, a.out, rss_out, (unsigned*)(ws + WS_PCNT), final_g};
                pg8::gemm_phase<EpiResNorm, PanelOrder, false>(lds, g, S, E, nullptr);
            }
        }
        SEAM(pb + 2);
    }

#undef IN
#undef SEAM
}

#ifndef MK_LAUNCH_PER_PHASE
#define MK_LAUNCH_PER_PHASE 0
#endif
extern "C" void kernel_launch(void* const* d_in, const int* in_sizes, int n_in, void* d_out, int out_size, void* d_ws, size_t ws_size, hipStream_t stream) {
    static int grid = 0;
    if (grid == 0) {
        if (n_in != 14 || in_sizes[0] != MROWS * DM || out_size != MROWS * DM || ws_size < WS_END) { fprintf(stderr, "kernel_launch: unexpected shapes (n_in %d, in0 %d, out %d, ws %zu)\n", n_in, n_in > 0 ? in_sizes[0] : -1, out_size, ws_size); grid = -1; return; }
        int dev = 0, cus = 0, per_cu = 0;
        hipGetDevice(&dev); hipDeviceGetAttribute(&cus, hipDeviceAttributeMultiprocessorCount, dev);
        if (hipFuncSetAttribute((const void*)hymba_fwd, hipFuncAttributeMaxDynamicSharedMemorySize, LDS_BYTES) != hipSuccess) { fprintf(stderr, "kernel_launch: hipFuncSetAttribute failed\n"); grid = -1; return; }
        if (hipOccupancyMaxActiveBlocksPerMultiprocessor(&per_cu, (const void*)hymba_fwd, 512, LDS_BYTES) != hipSuccess || per_cu < 1) { fprintf(stderr, "kernel_launch: occupancy query gave %d\n", per_cu); per_cu = 1; }
        (void)hipGetLastError();
        grid = cus * per_cu;
    }
    if (grid < 0) return;
    Args a{};
    for (int i = 0; i < 14; ++i) a.in[i] = (const float*)d_in[i];
    a.out = (float*)d_out; a.ws = (unsigned char*)d_ws;
#if MK_LAUNCH_PER_PHASE
    for (int p = 0; p < NPHASE; ++p) {
#ifdef DEBUG_NAIVE_MIX
        if (p == 2 || p == 6) { const int l = p / 4; unsigned char* ws = (unsigned char*)d_ws;
            Mix X; X.conv_a_w = a.in[4] + l * 4 * DLRU; X.conv_a_b = a.in[5] + l * DLRU; X.lru_br = a.in[7] + l * DLRU; X.lru_bi = a.in[9] + l * DLRU; X.lru_lambda = a.in[10] + l * DLRU;
            X.conv_b_w = a.in[11] + l * 3 * DLRU; X.gw = nullptr; X.U = (bf16_t*)(ws + WS_U); X.Y = (bf16_t*)(ws + WS_Y); X.HP = nullptr; X.AGG = nullptr;
#if DEBUG_NAIVE_MIX == 1
            hipLaunchKernelGGL(naive_mixA, dim3(64), dim3(64), 0, stream, X, a.in[6] + (size_t)l * 16 * 4096, a.in[8] + (size_t)l * 16 * 4096);
            a.flags = 1;
#else
            hipLaunchKernelGGL(naive_mixB, dim3(2048), dim3(256), 0, stream, X);
            a.flags = 2;
#endif
            }
        else a.flags = 0;
#if DEBUG_NAIVE_MIX == 1
        if (p == 3 || p == 7) continue;
#endif
#endif
        a.ph_lo = p; a.ph_hi = p + 1; hipLaunchKernelGGL(hymba_fwd, dim3(grid), dim3(512), LDS_BYTES, stream, a); }
#else
    a.ph_lo = 0; a.ph_hi = NPHASE;
    if (hipMemsetAsync((unsigned char*)d_ws + WS_BAR, 0, 16384 + 32768, stream) != hipSuccess) { fprintf(stderr, "kernel_launch: memset of barrier words failed\n"); return; }
    void* args[] = {&a};
    const hipError_t e = hipLaunchCooperativeKernel((const void*)hymba_fwd, dim3(grid), dim3(512), args, LDS_BYTES, stream);
    if (e != hipSuccess) fprintf(stderr, "kernel_launch: cooperative launch failed: %s (grid %d)\n", hipGetErrorString(e), grid);
#endif
}
```

```cpp
#include <hip/hip_runtime.h>
#include <hip/hip_cooperative_groups.h>
#include <cstdio>
namespace cg = cooperative_groups;
namespace pg8 {
#define PG8_LAS __attribute__((address_space(3)))
typedef unsigned short bf16_t;
typedef short bf16x8 __attribute__((ext_vector_type(8)));
typedef float f32x4 __attribute__((ext_vector_type(4)));
typedef unsigned u32x4 __attribute__((ext_vector_type(4)));
constexpr int BM = 256, BK = 64, HALF = 128, HTB = HALF * BK * 2  , STAGE_BYTES = 8 * HTB, NXCD = 8, WGM = 4;

__host__ __device__ __forceinline__ int lds_byte(int r, int c) { const int st = (r >> 4) * 2 + (c >> 5), rr = r & 15, cc = c & 31, ob = rr * 64 + cc * 2; return st * 1024 + (ob ^ (((ob >> 9) & 1) << 5)); }
__host__ __device__ __forceinline__ void stage_rc(int b, int& R, int& C) { const int st = b / 1024, sb = b % 1024, swz = sb ^ (((sb >> 9) & 1) << 5); R = (st >> 1) * 16 + swz / 64; C = (st & 1) * 32 + (swz % 64) / 2; }
__host__ __device__ __forceinline__ int perm32(int rho) { const int n = rho >> 4, i = rho & 15; return 8 * (i >> 2) + 4 * n + (i & 3); }

struct Unit { int pm, pn; };
struct Gemm { const bf16_t* A; const bf16_t* Bt; int M, N, K; };

struct StaticOrder {
    int nM, nN, nwg, G, c;
    __host__ __device__ void init(int M, int N, int G_, int c_) { nM = M / BM; nN = N / BM; nwg = nM * nN; G = G_; c = c_; }
    __host__ __device__ bool next(int i, Unit& u) const {
        const long L = (long)i * G + c; if (L >= nwg) return false;
        int wgid = (int)L; { const int q = nwg / NXCD, r = nwg % NXCD, xcd = wgid % NXCD, off = wgid / NXCD; wgid = (xcd < r ? xcd * (q + 1) : r * (q + 1) + (xcd - r) * q) + off; }
        const int nig = WGM * nN, gid = wgid / nig, fm = gid * WGM, gsz = (nM - fm) < WGM ? (nM - fm) : WGM;
        u.pm = fm + ((wgid % nig) % gsz); u.pn = (wgid % nig) / gsz; return true;
    }
    __device__ __forceinline__ void a_ready(const Unit&) const {}
    __device__ __forceinline__ void done(const Unit&) const {}
};
__device__ __forceinline__ unsigned cvt_pk_bf16(float lo, float hi) { unsigned r; asm volatile("v_cvt_pk_bf16_f32 %0, %1, %2" : "=v"(r) : "v"(lo), "v"(hi)); return r; }
template <class Epi, class Sched, bool STAMP = false>
__device__ __forceinline__ void gemm_phase(PG8_LAS unsigned char* lds, const Gemm g, const Sched& S, const Epi& E, unsigned long long* stamps) {
    int tid_l = threadIdx.x; asm volatile("" : "+v"(tid_l));
    const int tid = tid_l, wid = __builtin_amdgcn_readfirstlane(tid >> 6), lane = tid & 63, wr = wid >> 2, wc = wid & 3, fr = lane & 15, fq = lane >> 4;
    const int K = g.K, nt = K / BK;
    int ts_lo = 0, ts_hi = 0, nts = 0; const unsigned long long rt_entry = STAMP ? (unsigned long long)wall_clock64() : 0ull;
#define PG8_STAMP() do { if (STAMP && wid == 0 && nts < 64) { const unsigned long long _c = (unsigned long long)clock64(); \
        ts_lo = (lane == nts) ? (int)(unsigned)_c : ts_lo; ts_hi = (lane == nts) ? (int)(unsigned)(_c >> 32) : ts_hi; ++nts; } } while (0)
    PG8_STAMP();
    unsigned voffA[2], voffB[2];
#pragma unroll
    for (int i = 0; i < 2; ++i) { int R, C; stage_rc(tid * 16 + i * 8192, R, C); const int Rb = Epi::PERM ? ((R & ~31) + perm32(R & 31)) : R;
        voffA[i] = (unsigned)(R * K + C) * 2u; voffB[i] = (unsigned)(Rb * K + C) * 2u; }
    const size_t kstep = (size_t)(BK * 2);
    const size_t hstep = (size_t)HALF * K * 2;
    const size_t tstep = 2 * hstep;
    const unsigned ldsw = (unsigned)wid * 1024u;
    const int aoff = lds_byte(wr * 64 + fr, fq * 8), boff = lds_byte(wc * 32 + fr, fq * 8);
#define PG8_SA(b, h) (((b) * 2 + (h)) * HTB)
#define PG8_SB(b, h) ((4 + (b) * 2 + (h)) * HTB)
#define PG8_STAGE(bufoff, gbase, voff) do { _Pragma("unroll") for (int _i = 0; _i < 2; ++_i) \
        __builtin_amdgcn_global_load_lds((const unsigned*)((const char*)(gbase) + (voff)[_i]), (PG8_LAS unsigned*)(lds + (bufoff) + ldsw + _i * 8192), 16, 0, 0); } while (0)
#define PG8_LDA(dst, b, h) do { _Pragma("unroll") for (int m = 0; m < 4; ++m) _Pragma("unroll") for (int k = 0; k < 2; ++k) dst[m][k] = *(const PG8_LAS bf16x8*)(lds + PG8_SA(b, h) + aoff + m * 2048 + k * 1024); } while (0)
#define PG8_LDB(dst, b, h) do { _Pragma("unroll") for (int n = 0; n < 2; ++n) _Pragma("unroll") for (int k = 0; k < 2; ++k) dst[n][k] = *(const PG8_LAS bf16x8*)(lds + PG8_SB(b, h) + boff + n * 2048 + k * 1024); } while (0)
#define PG8_MMA(ai, bj, At, Bt) do { __builtin_amdgcn_s_setprio(1); _Pragma("unroll") for (int m = 0; m < 4; ++m) _Pragma("unroll") for (int n = 0; n < 2; ++n) _Pragma("unroll") for (int k = 0; k < 2; ++k) \
        acc[ai][bj][m][n] = __builtin_amdgcn_mfma_f32_16x16x32_bf16(Bt[n][k], At[m][k], acc[ai][bj][m][n], 0, 0, 0); __builtin_amdgcn_s_setprio(0); } while (0)
#define PG8_WAIT_V(n) asm volatile("s_waitcnt vmcnt(" #n ")" ::: "memory")
#define PG8_WAIT_L(n) asm volatile("s_waitcnt lgkmcnt(" #n ")" ::: "memory")
#define PG8_BAR __builtin_amdgcn_s_barrier()
#define PG8_SCHED __builtin_amdgcn_sched_barrier(0)
    Unit cur, nxt; int ui = 0;
    if (!S.next(0, cur)) return;
    f32x4 acc[2][2][4][2];
#pragma unroll
    for (int a = 0; a < 2; ++a)
#pragma unroll
        for (int b = 0; b < 2; ++b)
#pragma unroll
            for (int m = 0; m < 4; ++m)
#pragma unroll
                for (int n = 0; n < 2; ++n) acc[a][b][m][n] = (f32x4){0.f, 0.f, 0.f, 0.f};
    bf16x8 At[4][2], B0[2][2], B1[2][2];
    const char* cA = (const char*)g.A + (size_t)cur.pm * tstep; const char* cB = (const char*)g.Bt + (size_t)cur.pn * tstep;
    S.a_ready(cur);
    PG8_STAGE(PG8_SB(0, 0), cB, voffB); PG8_STAGE(PG8_SA(0, 0), cA, voffA); PG8_STAGE(PG8_SB(0, 1), cB + hstep, voffB); PG8_STAGE(PG8_SA(0, 1), cA + hstep, voffA);
    if (wr == 1) PG8_BAR;
    PG8_WAIT_V(4); PG8_BAR;
    PG8_STAGE(PG8_SB(1, 0), cB + kstep, voffB); PG8_STAGE(PG8_SA(1, 0), cA + kstep, voffA); PG8_STAGE(PG8_SB(1, 1), cB + hstep + kstep, voffB);
    PG8_WAIT_V(6); PG8_BAR;
    PG8_STAMP();
    for (;;) {
        const bool has_next = S.next(ui + 1, nxt);
        const char* nA = has_next ? (const char*)g.A + (size_t)nxt.pm * tstep : cA; const char* nB = has_next ? (const char*)g.Bt + (size_t)nxt.pn * tstep : cB;
        for (int t = 0; t < nt; t += 2) {
            const bool last = (t == nt - 2);
            const char* a1 = cA + (size_t)(t + 1) * kstep;
            const char* a2 = last ? nA : cA + (size_t)(t + 2) * kstep; const char* b2 = last ? nB : cB + (size_t)(t + 2) * kstep;
            const char* a3 = a2 + kstep; const char* b3 = b2 + kstep;
            if (last && has_next) S.a_ready(nxt);
            PG8_LDB(B0, 0, 0); PG8_SCHED; PG8_LDA(At, 0, 0); PG8_STAGE(PG8_SA(1, 1), a1 + hstep, voffA);
            PG8_WAIT_L(8); PG8_BAR; PG8_WAIT_L(0); PG8_MMA(0, 0, At, B0); PG8_BAR; PG8_SCHED;
            PG8_LDB(B1, 0, 1); PG8_STAGE(PG8_SB(0, 0), b2, voffB);
            PG8_BAR; PG8_WAIT_L(0); PG8_MMA(0, 1, At, B1); PG8_BAR;
            PG8_LDA(At, 0, 1); PG8_STAGE(PG8_SA(0, 0), a2, voffA);
            PG8_BAR; PG8_WAIT_L(0); PG8_MMA(1, 0, At, B0); PG8_BAR; PG8_SCHED;
            PG8_STAGE(PG8_SB(0, 1), b2 + hstep, voffB);
            PG8_WAIT_V(6); PG8_BAR; PG8_MMA(1, 1, At, B1); PG8_BAR;
            PG8_LDB(B0, 1, 0); PG8_SCHED; PG8_LDA(At, 1, 0); PG8_STAGE(PG8_SA(0, 1), a2 + hstep, voffA);
            PG8_WAIT_L(8); PG8_BAR; PG8_WAIT_L(0); PG8_MMA(0, 0, At, B0); PG8_BAR; PG8_SCHED;
            PG8_LDB(B1, 1, 1); PG8_STAGE(PG8_SB(1, 0), b3, voffB);
            PG8_BAR; PG8_WAIT_L(0); PG8_MMA(0, 1, At, B1); PG8_BAR;
            PG8_LDA(At, 1, 1); PG8_STAGE(PG8_SA(1, 0), a3, voffA);
            PG8_BAR; PG8_WAIT_L(0); PG8_MMA(1, 0, At, B0); PG8_BAR; PG8_SCHED;
            PG8_STAGE(PG8_SB(1, 1), b3 + hstep, voffB);
            PG8_WAIT_V(6); PG8_BAR; PG8_MMA(1, 1, At, B1); PG8_BAR;
        }
        PG8_STAMP();
        if constexpr (!Epi::AFTER_DRAIN) { if (wr == 0) PG8_BAR; E(acc, cur, wr, wc, fr, fq); S.done(cur); if (has_next) { if (wr == 1) PG8_BAR; } }
        PG8_STAMP();
        if (!has_next) break;
#pragma unroll
        for (int a = 0; a < 2; ++a)
#pragma unroll
            for (int b = 0; b < 2; ++b)
#pragma unroll
                for (int m = 0; m < 4; ++m)
#pragma unroll
                    for (int n = 0; n < 2; ++n) acc[a][b][m][n] = (f32x4){0.f, 0.f, 0.f, 0.f};
        cur = nxt; cA = nA; cB = nB; ++ui;
    }
    PG8_WAIT_V(0);
    if constexpr (Epi::AFTER_DRAIN) { if (wr == 0) PG8_BAR; }
    PG8_BAR;
    if constexpr (Epi::AFTER_DRAIN) { E.fused(acc, cur, wr, wc, fr, fq, lds, wid, lane); S.done(cur); }
    PG8_STAMP();
    if (STAMP && wid == 0) { stamps[lane] = lane < nts ? (((unsigned long long)(unsigned)ts_hi << 32) | (unsigned)ts_lo) : 0ull;
        if (lane == 62) stamps[62] = rt_entry; if (lane == 63) stamps[63] = (unsigned long long)wall_clock64(); }
#undef PG8_STAMP
#undef PG8_SA
#undef PG8_SB
#undef PG8_STAGE
#undef PG8_LDA
#undef PG8_LDB
#undef PG8_MMA
#undef PG8_WAIT_V
#undef PG8_WAIT_L
#undef PG8_BAR
#undef PG8_SCHED
}
}

#define LAS __attribute__((address_space(3)))
#define GAS __attribute__((address_space(1)))
typedef unsigned short bf16_t;
typedef short bf16x8 __attribute__((ext_vector_type(8)));
typedef float f32x4 __attribute__((ext_vector_type(4)));
typedef float f32x2 __attribute__((ext_vector_type(2)));
typedef float f32x16 __attribute__((ext_vector_type(16)));
typedef unsigned u32x4 __attribute__((ext_vector_type(4)));
typedef unsigned u32x2 __attribute__((ext_vector_type(2)));

constexpr int DM = 2048, NBATCH = 4, SEQ = 4096, MROWS = NBATCH * SEQ, NMETA = 16, DIN = 6144, DLRU = 1024, NHEAD = 16;
constexpr int META0 = MROWS;
constexpr int RSTR = MROWS + 64;
constexpr float RMS_EPS = 1e-6f;
constexpr int NPHASE = 7;
#ifndef REP_MASK
#define REP_MASK 0
#endif
constexpr int LDS_BYTES = 131072 + 256;

constexpr size_t MiB = 1u << 20;
constexpr size_t WS_WTIN = 0;
constexpr size_t WS_WTOUT = 48 * MiB;
constexpr size_t WS_GW = 64 * MiB;
constexpr size_t WS_ROWSS = 65 * MiB;
constexpr size_t WS_BAR = 65 * MiB + 512 * 1024;
constexpr size_t WS_PCNT = WS_BAR + 16384;
constexpr size_t WS_AGG = 66 * MiB;
constexpr size_t WS_XB = 71 * MiB;
constexpr size_t WS_Y = 136 * MiB;
constexpr size_t WS_U = 201 * MiB;
constexpr size_t WS_END = 396 * MiB;
constexpr int AGG_PER_LAYER = 257 * 1024;
static_assert(WS_U + (size_t)RSTR * DIN * 2 <= WS_END && WS_Y + (size_t)RSTR * DM * 2 <= WS_U && WS_XB + (size_t)RSTR * DM * 2 <= WS_Y, "ws map");
static_assert(WS_WTIN + (size_t)2 * DIN * DM * 2 <= WS_WTOUT && WS_WTOUT + (size_t)2 * DM * DM * 2 <= WS_GW && WS_AGG + (size_t)2 * AGG_PER_LAYER * 8 <= WS_XB && WS_ROWSS + (size_t)3 * RSTR * 4 <= WS_BAR, "ws map 2");

struct Args { const float* in[14]; float* out; unsigned char* ws; int ph_lo, ph_hi, flags, pad; };

__device__ __forceinline__ unsigned f2bf(float f) { unsigned u = __builtin_bit_cast(unsigned, f); return (u + 0x7fffu + ((u >> 16) & 1u)) >> 16; }
__device__ __forceinline__ unsigned pk2(float lo, float hi) { return f2bf(lo) | (f2bf(hi) << 16); }
__device__ __forceinline__ float bflo(unsigned w) { return __builtin_bit_cast(float, w << 16); }
__device__ __forceinline__ float bfhi(unsigned w) { return __builtin_bit_cast(float, w & 0xffff0000u); }
__device__ __forceinline__ float bf1(bf16_t v) { return __builtin_bit_cast(float, ((unsigned)v) << 16); }
__device__ __forceinline__ float sigmoidf_(float z) { return __builtin_amdgcn_rcpf(1.0f + __expf(-z)); }
__device__ __forceinline__ float wave_sum(float v) {
#pragma unroll
    for (int o = 1; o < 64; o <<= 1) v += __shfl_xor(v, o);
    return v;
}
#define LDS_WAIT() asm volatile("s_waitcnt lgkmcnt(0)" ::: "memory")

template <bool NORS> struct EpiUT {
    static constexpr bool PERM = true, AFTER_DRAIN = false;
    bf16_t* O; const float* rowss;
    __device__ __forceinline__ void operator()(const f32x4 (&acc)[2][2][4][2], const pg8::Unit& u, int wr, int wc, int fr, int fq) const {
        const int row0 = u.pm * 256 + wr * 64 + fr, col0 = u.pn * 256 + wc * 32 + 8 * fq;
        if (u.pn >= 8) {
            const int ch0 = 64 * (u.pn - 8) + 16 * wc + 4 * fq;
#pragma unroll
            for (int ai = 0; ai < 2; ++ai)
#pragma unroll
                for (int m = 0; m < 4; ++m) {
                    const int r = row0 + ai * 128 + m * 16;
                    const float rs = NORS ? 1.0f : rsqrtf(rowss[r] * (1.0f / DM) + RMS_EPS);
                    const f32x4 bv = acc[ai][0][m][0] * rs, cv = acc[ai][0][m][1] * rs, xv = acc[ai][1][m][0] * rs, gv = acc[ai][1][m][1] * rs;
                    u32x4 w;
#pragma unroll
                    for (int i = 0; i < 4; ++i) w[i] = pg8::cvt_pk_bf16(bv[i] * gv[i] * sigmoidf_(gv[i]), cv[i] * xv[i]);
                    *(u32x4*)(O + (size_t)r * DIN + 2048 + 2 * ch0) = w;
                }
            return;
        }
#pragma unroll
        for (int ai = 0; ai < 2; ++ai)
#pragma unroll
            for (int m = 0; m < 4; ++m) {
                const int r = row0 + ai * 128 + m * 16;
                const float rs = NORS ? 1.0f : rsqrtf(rowss[r] * (1.0f / DM) + RMS_EPS);
                bf16_t* rowp = O + (size_t)r * DIN + col0;
#pragma unroll
                for (int bj = 0; bj < 2; ++bj) {
                    const f32x4 v0 = acc[ai][bj][m][0] * rs, v1 = acc[ai][bj][m][1] * rs;
                    u32x4 w; w.x = pg8::cvt_pk_bf16(v0[0], v0[1]); w.y = pg8::cvt_pk_bf16(v0[2], v0[3]); w.z = pg8::cvt_pk_bf16(v1[0], v1[1]); w.w = pg8::cvt_pk_bf16(v1[2], v1[3]);
                    *(u32x4*)(rowp + bj * 128) = w;
                }
            }
    }
};
struct EpiNull {
    static constexpr bool PERM = true, AFTER_DRAIN = false;
    float* sink;
    __device__ __forceinline__ void operator()(const f32x4 (&acc)[2][2][4][2], const pg8::Unit& u, int wr, int wc, int fr, int fq) const {
        f32x4 s = {0.f, 0.f, 0.f, 0.f};
#pragma unroll
        for (int ai = 0; ai < 2; ++ai)
#pragma unroll
            for (int bj = 0; bj < 2; ++bj)
#pragma unroll
                for (int m = 0; m < 4; ++m) { s += acc[ai][bj][m][0]; s += acc[ai][bj][m][1]; }
        if (s[0] + s[1] + s[2] + s[3] == 1.2345678e33f) sink[u.pm] = s[0];
    }
};
typedef EpiUT<false> EpiU;
#ifndef EPI_MB
#define EPI_MB 2
#endif
struct EpiRes {
    static constexpr bool PERM = true, AFTER_DRAIN = false;
    const float* res; float* out; bf16_t* xb; float* rowss;
    __device__ __forceinline__ void operator()(const f32x4 (&acc)[2][2][4][2], const pg8::Unit& u, int wr, int wc, int fr, int fq) const {
        const int row0 = u.pm * 256 + wr * 64 + fr, col0 = u.pn * 256 + wc * 32 + 8 * fq;
#pragma unroll
        for (int ai = 0; ai < 2; ++ai) {
#pragma unroll
          for (int mh = 0; mh < 4; mh += EPI_MB) {
            f32x4 rv[4][2][2];
#pragma unroll
            for (int m = mh; m < mh + EPI_MB; ++m)
#pragma unroll
                for (int bj = 0; bj < 2; ++bj) {
                    if (res) { const float* p = res + (size_t)(row0 + ai * 128 + m * 16) * DM + col0 + bj * 128; rv[m][bj][0] = *(const f32x4*)p; rv[m][bj][1] = *(const f32x4*)(p + 4); }
                    else { const u32x4 q = *(const u32x4*)(xb + (size_t)(row0 + ai * 128 + m * 16) * DM + col0 + bj * 128);
                        rv[m][bj][0] = (f32x4){bflo(q.x), bfhi(q.x), bflo(q.y), bfhi(q.y)}; rv[m][bj][1] = (f32x4){bflo(q.z), bfhi(q.z), bflo(q.w), bfhi(q.w)}; } }
            asm volatile("" ::: "memory");
#pragma unroll
            for (int m = mh; m < mh + EPI_MB; ++m) {
                const int r = row0 + ai * 128 + m * 16; const size_t off = (size_t)r * DM + col0; float ss = 0.f;
#pragma unroll
                for (int bj = 0; bj < 2; ++bj) {
                    const f32x4 h0 = rv[m][bj][0] + acc[ai][bj][m][0], h1 = rv[m][bj][1] + acc[ai][bj][m][1];
                    if (out) { *(f32x4*)(out + off + bj * 128) = h0; *(f32x4*)(out + off + bj * 128 + 4) = h1; }
                    if (xb) { u32x4 w; w.x = pg8::cvt_pk_bf16(h0[0], h0[1]); w.y = pg8::cvt_pk_bf16(h0[2], h0[3]); w.z = pg8::cvt_pk_bf16(h1[0], h1[1]); w.w = pg8::cvt_pk_bf16(h1[2], h1[3]);
                        *(u32x4*)(xb + off + bj * 128) = w; }
                    ss += (h0[0] * h0[0] + h0[1] * h0[1]) + (h0[2] * h0[2] + h0[3] * h0[3]) + (h1[0] * h1[0] + h1[1] * h1[1]) + (h1[2] * h1[2] + h1[3] * h1[3]);
                }
                ss += __shfl_xor(ss, 16); ss += __shfl_xor(ss, 32);
                if (fq == 0) unsafeAtomicAdd(rowss + r, ss);
            }
            asm volatile("" ::: "memory");
          }
        }
    }
};

struct EpiResNorm {
    static constexpr bool PERM = true, AFTER_DRAIN = false;
    const bf16_t* res; float* out; float* rowss; unsigned* cnt; const float* fg;
    __device__ __forceinline__ void operator()(f32x4 (&acc)[2][2][4][2], const pg8::Unit& u, int wr, int wc, int fr, int fq) const {
        const int row0 = u.pm * 256 + wr * 64 + fr, col0 = u.pn * 256 + wc * 32 + 8 * fq;
#pragma unroll
        for (int ai = 0; ai < 2; ++ai) {
#pragma unroll
          for (int mh = 0; mh < 4; mh += EPI_MB) {
            u32x4 rw[4][2];
#pragma unroll
            for (int m = mh; m < mh + EPI_MB; ++m)
#pragma unroll
                for (int bj = 0; bj < 2; ++bj) rw[m][bj] = *(const u32x4*)(res + (size_t)(row0 + ai * 128 + m * 16) * DM + col0 + bj * 128);
            asm volatile("" ::: "memory");
#pragma unroll
            for (int m = mh; m < mh + EPI_MB; ++m) {
                float ss = 0.f;
#pragma unroll
                for (int bj = 0; bj < 2; ++bj) {
                    const u32x4 w = rw[m][bj];
                    const f32x4 h0 = (f32x4){bflo(w.x), bfhi(w.x), bflo(w.y), bfhi(w.y)} + acc[ai][bj][m][0], h1 = (f32x4){bflo(w.z), bfhi(w.z), bflo(w.w), bfhi(w.w)} + acc[ai][bj][m][1];
                    acc[ai][bj][m][0] = h0; acc[ai][bj][m][1] = h1;
                    ss += (h0[0] * h0[0] + h0[1] * h0[1]) + (h0[2] * h0[2] + h0[3] * h0[3]) + (h1[0] * h1[0] + h1[1] * h1[1]) + (h1[2] * h1[2] + h1[3] * h1[3]);
                }
                ss += __shfl_xor(ss, 16); ss += __shfl_xor(ss, 32);
                if (fq == 0) unsafeAtomicAdd(rowss + row0 + ai * 128 + m * 16, ss);
            }
            asm volatile("" ::: "memory");
          }
        }
        asm volatile("s_waitcnt vmcnt(0)" ::: "memory");
        unsigned* cw = cnt + 64 * (2 * u.pm + wr);
        if (fr == 0 && fq == 0) __hip_atomic_fetch_add(cw, 1u, __ATOMIC_RELAXED, __HIP_MEMORY_SCOPE_AGENT);
        f32x4 gv[2][2];
#pragma unroll
        for (int bj = 0; bj < 2; ++bj) { gv[bj][0] = *(const f32x4*)(fg + col0 + bj * 128); gv[bj][1] = *(const f32x4*)(fg + col0 + bj * 128 + 4); }
        { unsigned sp = 0;
          while ((unsigned)__builtin_amdgcn_readfirstlane(__hip_atomic_load(cw, __ATOMIC_RELAXED, __HIP_MEMORY_SCOPE_AGENT)) < 32u) { __builtin_amdgcn_s_sleep(1); if (++sp > (1u << 16)) break; } }
        asm volatile("" ::: "memory");
#pragma unroll
        for (int ai = 0; ai < 2; ++ai)
#pragma unroll
            for (int m = 0; m < 4; ++m) {
                const int r = row0 + ai * 128 + m * 16;
                const float rs = rsqrtf(__hip_atomic_load(rowss + r, __ATOMIC_RELAXED, __HIP_MEMORY_SCOPE_AGENT) * (1.0f / DM) + RMS_EPS);
                float* op = out + (size_t)r * DM + col0;
#pragma unroll
                for (int bj = 0; bj < 2; ++bj) { *(f32x4*)(op + bj * 128) = acc[ai][bj][m][0] * rs * gv[bj][0]; *(f32x4*)(op + bj * 128 + 4) = acc[ai][bj][m][1] * rs * gv[bj][1]; }
            }
    }
};
struct PanelOrder {
    int Gp, v;
    __device__ void init(int G, int c) { Gp = G & ~7; v = c; if ((Gp & 63) == 0) v = (c & 7) * (Gp >> 3) + (c >> 3); if (c >= Gp) v = -1; }
    __device__ bool next(int i, pg8::Unit& u) const { if (v < 0) return false; const long L = (long)i * Gp + v; if (L >= 64 * 8) return false; u.pm = (int)(L >> 3); u.pn = (int)(L & 7); return true; }
    __device__ __forceinline__ void a_ready(const pg8::Unit&) const {}
    __device__ __forceinline__ void done(const pg8::Unit&) const {}
};

template <class F> __device__ __forceinline__ void meta_gemm(const bf16_t* A, const bf16_t* Bt, int ngroups, LAS unsigned char* lds, int wid, int lane, F epi) {
    const int fr = lane & 15, fq = lane >> 4, half = wid >> 2, wq = wid & 3;
    LAS f32x4* red = (LAS f32x4*)lds;
    for (int p = blockIdx.x; 2 * p < ngroups; p += gridDim.x) {
        const int g = 2 * p + half;
        f32x4 acc = {0.f, 0.f, 0.f, 0.f};
        if (g < ngroups) {
            const bf16_t* ap = A + (size_t)fr * DM + wq * 512 + fq * 8;
            const bf16_t* bp = Bt + (size_t)(g * 16 + fr) * DM + wq * 512 + fq * 8;
            bf16x8 av[16], bv[16];
#pragma unroll
            for (int s = 0; s < 16; ++s) { av[s] = *(const bf16x8*)(ap + 32 * s); bv[s] = *(const bf16x8*)(bp + 32 * s); }
#pragma unroll
            for (int s = 0; s < 16; ++s) acc = __builtin_amdgcn_mfma_f32_16x16x32_bf16(bv[s], av[s], acc, 0, 0, 0);
        }
        red[wid * 64 + lane] = acc;
        __syncthreads();
        if (wq == 0 && g < ngroups) {
            f32x4 s = red[wid * 64 + lane];
#pragma unroll
            for (int w = 1; w < 4; ++w) s += red[(wid + w) * 64 + lane];
            epi(fr, g * 16 + 4 * fq, s);
        }
        __syncthreads();
    }
}

__host__ __device__ __forceinline__ int in_col(int p) {
    if (p < 2048) return p;
    const int c = p & 255, j = (p >> 8) - 8, g = 2 * (c >> 7) + ((c >> 2) & 1), k = 16 * ((c >> 5) & 3) + 4 * ((c >> 3) & 3) + (c & 3);
    return 2048 + 1024 * g + 64 * j + k;
}
template <bool COLMAP> __device__ __forceinline__ void tr_item(const float* W, int K, int N, bf16_t* WT, const float* sc, LAS unsigned char* scr, int item, int lane) {
    const int nblk = N / 64, kb = item / nblk, nb = item % nblk, k0 = 64 * kb, n0 = 64 * nb;
    const int kr = lane >> 4, nc = (lane & 15) * 4;
    f32x4 v[16]; float g[16];
    { const float* p = W + (size_t)(k0 + kr) * N + (COLMAP ? in_col(n0 + nc) : n0 + nc);
#pragma unroll
      for (int i = 0; i < 16; ++i) { v[i] = *(const f32x4*)p; p += (size_t)4 * N; }
#pragma unroll
      for (int i = 0; i < 16; ++i) g[i] = sc ? sc[k0 + kr + 4 * i] : 1.0f; }
    asm volatile("" ::: "memory");
#pragma unroll
    for (int i = 0; i < 16; ++i) { const f32x4 s = v[i] * g[i]; u32x2 w; w.x = pg8::cvt_pk_bf16(s[0], s[1]); w.y = pg8::cvt_pk_bf16(s[2], s[3]);
        *(LAS u32x2*)(scr + (kr + 4 * i) * 136 + nc * 2) = w; }
    LDS_WAIT();
    const int c = lane & 7;
#pragma unroll
    for (int j = 0; j < 8; ++j) { const int n = (lane >> 3) + 8 * j; const LAS bf16_t* s = (const LAS bf16_t*)(scr + (8 * c) * 136 + n * 2);
        u32x4 o; o.x = (unsigned)s[0] | ((unsigned)s[68] << 16); o.y = (unsigned)s[2 * 68] | ((unsigned)s[3 * 68] << 16); o.z = (unsigned)s[4 * 68] | ((unsigned)s[5 * 68] << 16); o.w = (unsigned)s[6 * 68] | ((unsigned)s[7 * 68] << 16);
        *(u32x4*)(WT + (size_t)(n0 + n) * K + k0 + 8 * c) = o; }
    LDS_WAIT();
}
__device__ __forceinline__ void cvt_row(const float* src, bf16_t* dst, float* ss, int lane) {
    const f32x4* xr = (const f32x4*)src + lane; f32x4 v[8]; float s = 0.f;
#pragma unroll
    for (int j = 0; j < 8; ++j) { v[j] = xr[64 * j]; s += (v[j].x * v[j].x + v[j].y * v[j].y) + (v[j].z * v[j].z + v[j].w * v[j].w); }
    s = wave_sum(s);
    u32x2* o8 = (u32x2*)dst + lane;
#pragma unroll
    for (int j = 0; j < 8; ++j) { u32x2 w; w.x = pk2(v[j].x, v[j].y); w.y = pk2(v[j].z, v[j].w); o8[64 * j] = w; }
    if (lane == 0) *ss = s;
}

struct Mix {
    const float *conv_a_w, *conv_a_b, *lru_br, *lru_bi, *lru_lambda, *conv_b_w;
    const bf16_t* gw;
    bf16_t* U; bf16_t* Y; unsigned long long* AGG;
};
struct ItemId { int hd, b, c, row0, ntok, agg; bool meta; };
__device__ __forceinline__ ItemId decode_item(int id) {
    ItemId I;
    if (id < 16) { I.meta = true; I.hd = id; I.b = 0; I.c = 0; I.row0 = META0; I.ntok = 16; I.agg = 256; }
    else { const int j = id - 16; I.meta = false; I.hd = j & 15; I.c = (j >> 4) & 63; I.b = j >> 10; I.row0 = I.b * SEQ + I.c * 64; I.ntok = 64; I.agg = I.b * 64 + I.c; }
    return I;
}
constexpr int N_ITEMS = 16 + NBATCH * NHEAD * 64;

__device__ __forceinline__ bool agg_ok(unsigned long long v) { return (unsigned)v != 0u; }
template <bool META> __device__ __forceinline__ void mix_item(const Mix& X, int id, LAS unsigned char* xt, int lane) {
    constexpr int NT = META ? 16 : 64, NTB = META ? 1 : 2, NQ = META ? 2 : 4;
    constexpr float LOG2E = 1.4426950408889634f;
    const ItemId I = decode_item(id);
    const int ch = I.hd * 64 + lane;
    const float nls2 = -8.0f * LOG2E * log1pf(__expf(-X.lru_lambda[ch]));
    bf16_t raw[NT], rh0 = 0, rh1 = 0, rh2 = 0;
    const float w0 = X.conv_a_w[ch], w1 = X.conv_a_w[1024 + ch], w2 = X.conv_a_w[2048 + ch], w3 = X.conv_a_w[3072 + ch], cb = X.conv_a_b[ch];
    {
        const GAS bf16_t* sb = (const GAS bf16_t*)(X.U + (size_t)I.row0 * DIN + I.hd * 64);
        if (!META) { const GAS bf16_t* hp0 = (I.c == 0) ? (const GAS bf16_t*)(X.U + (size_t)(META0 + 13) * DIN + I.hd * 64) : sb - 3 * DIN; rh0 = hp0[lane]; rh1 = hp0[DIN + lane]; rh2 = hp0[2 * DIN + lane]; }
#pragma unroll
        for (int t = 0; t < NT; ++t) { raw[t] = sb[lane]; sb += DIN; asm volatile("" : "+s"(sb)); }
    }
    bf16x8 BfR0[4], BfR1[4], BfI0[4], BfI1[4];
    { const bf16_t* gr = X.gw + (size_t)(I.hd * 64 + (lane & 31)) * 64 + 8 * (lane >> 5); const bf16_t* gi = gr + 16 * 64 * 64;
#pragma unroll
      for (int s = 0; s < 4; ++s) { BfR0[s] = *(const bf16x8*)(gr + 16 * s); BfR1[s] = *(const bf16x8*)(gr + 32 * 64 + 16 * s); BfI0[s] = *(const bf16x8*)(gi + 16 * s); BfI1[s] = *(const bf16x8*)(gi + 32 * 64 + 16 * s); } }
    asm volatile("" ::: "memory");
    float xm3 = bf1(rh0), xm2 = bf1(rh1), xm1 = bf1(rh2);
#pragma unroll
    for (int t = 0; t < NT; ++t) { const float x0 = bf1(raw[t]); const float xc = cb + w0 * xm3 + w1 * xm2 + w2 * xm1 + w3 * x0; xm3 = xm2; xm2 = xm1; xm1 = x0;
        *(LAS bf16_t*)(xt + t * 144 + lane * 2) = (bf16_t)f2bf(xc); }
    const float brA = X.lru_br[I.hd * 64 + (lane & 31)], brB = X.lru_br[I.hd * 64 + 32 + (lane & 31)], biA = X.lru_bi[I.hd * 64 + (lane & 31)], biB = X.lru_bi[I.hd * 64 + 32 + (lane & 31)];
    float h = 0.f, P = 1.f;
    unsigned hp[NT];
#pragma unroll
    for (int tb = 0; tb < NTB; ++tb) {
        f32x16 aR0, aR1, aI0, aI1;
#pragma unroll
        for (int e = 0; e < 16; ++e) { aR0[e] = brA; aR1[e] = brB; aI0[e] = biA; aI1[e] = biB; }
#pragma unroll
        for (int s = 0; s < 4; ++s) {
            const bf16x8 af = *(const LAS bf16x8*)(xt + (tb * 32 + (lane & 31)) * 144 + (16 * s + 8 * (lane >> 5)) * 2);
            aR0 = __builtin_amdgcn_mfma_f32_32x32x16_bf16(af, BfR0[s], aR0, 0, 0, 0);
            aR1 = __builtin_amdgcn_mfma_f32_32x32x16_bf16(af, BfR1[s], aR1, 0, 0, 0);
            aI0 = __builtin_amdgcn_mfma_f32_32x32x16_bf16(af, BfI0[s], aI0, 0, 0, 0);
            aI1 = __builtin_amdgcn_mfma_f32_32x32x16_bf16(af, BfI1[s], aI1, 0, 0, 0);
        }
#pragma unroll
        for (int q = 0; q < NQ; ++q) {
            float Rv[2][4], Iv[2][4];
#pragma unroll
            for (int k = 0; k < 4; ++k) {
                const int reg = 4 * q + k;
                const float r0f = aR0[reg], r1f = aR1[reg], i0f = aI0[reg], i1f = aI1[reg];
                auto r = __builtin_amdgcn_permlane32_swap(__float_as_uint(r0f), __float_as_uint(r1f), false, false);
                Rv[0][k] = __uint_as_float(r[0]); Rv[1][k] = __uint_as_float(r[1]);
                auto i2 = __builtin_amdgcn_permlane32_swap(__float_as_uint(i0f), __float_as_uint(i1f), false, false);
                Iv[0][k] = __uint_as_float(i2[0]); Iv[1][k] = __uint_as_float(i2[1]);
            }
#pragma unroll
            for (int st = 0; st < 2; ++st)
#pragma unroll
                for (int p = 0; p < 2; ++p) {
                    const int t = tb * 32 + 8 * q + 4 * st + 2 * p;
                    f32x2 er = (f32x2){Rv[st][2 * p], Rv[st][2 * p + 1]} * (-LOG2E), ei = (f32x2){Iv[st][2 * p], Iv[st][2 * p + 1]} * (-LOG2E);
                    er.x = __builtin_amdgcn_exp2f(er.x); er.y = __builtin_amdgcn_exp2f(er.y); ei.x = __builtin_amdgcn_exp2f(ei.x); ei.y = __builtin_amdgcn_exp2f(ei.y);
                    er = er + 1.0f; ei = ei + 1.0f;
                    f32x2 rg, ig; rg.x = __builtin_amdgcn_rcpf(er.x); rg.y = __builtin_amdgcn_rcpf(er.y); ig.x = __builtin_amdgcn_rcpf(ei.x); ig.y = __builtin_amdgcn_rcpf(ei.y);
                    const f32x2 l2 = rg * nls2;
                    f32x2 a; a.x = __builtin_amdgcn_exp2f(l2.x); a.y = __builtin_amdgcn_exp2f(l2.y);
                    f32x2 om = 1.0f - a * a; om.x = fmaxf(om.x, 0.f); om.y = fmaxf(om.y, 0.f);
                    f32x2 mu; mu.x = __builtin_amdgcn_sqrtf(om.x); mu.y = __builtin_amdgcn_sqrtf(om.y);
                    const f32x2 xc = (f32x2){bf1(*(const LAS bf16_t*)(xt + t * 144 + lane * 2)), bf1(*(const LAS bf16_t*)(xt + (t + 1) * 144 + lane * 2))};
                    const f32x2 bb = mu * ig * xc;
                    h = a.x * h + bb.x; P = P * a.x; hp[t] = pg8::cvt_pk_bf16(h, P);
                    h = a.y * h + bb.y; P = P * a.y; hp[t + 1] = pg8::cvt_pk_bf16(h, P);
                }
        }
    }
    __hip_atomic_store(X.AGG + (size_t)I.agg * 1024 + ch, ((unsigned long long)__float_as_uint(h) << 32) | (unsigned long long)__float_as_uint(P), __ATOMIC_RELAXED, __HIP_MEMORY_SCOPE_AGENT);
    asm volatile("" ::: "memory");
    bf16_t graw[NT];
    { const GAS bf16_t* sb = (const GAS bf16_t*)(X.U + (size_t)I.row0 * DIN + 1024 + I.hd * 64);
#pragma unroll
      for (int t = 0; t < NT; ++t) { graw[t] = sb[lane]; sb += DIN; asm volatile("" : "+s"(sb)); } }
    float hin = 0.f;
    if (!META) {
        { const unsigned long long* mp = X.AGG + (size_t)256 * 1024 + ch; unsigned long long v;
          for (;;) { v = __hip_atomic_load(mp, __ATOMIC_RELAXED, __HIP_MEMORY_SCOPE_AGENT); if (!__any(!agg_ok(v))) break; __builtin_amdgcn_s_sleep(2); }
          hin = __uint_as_float((unsigned)(v >> 32)); }
        const unsigned long long* ap = X.AGG + (size_t)(I.b * 64) * 1024 + ch;
        for (int j0 = 0; j0 < I.c; j0 += 16) {
            unsigned long long v[16];
            for (;;) {
                bool bad = false;
#pragma unroll
                for (int k = 0; k < 16; ++k) { v[k] = (j0 + k < I.c) ? __hip_atomic_load(ap + (size_t)(j0 + k) * 1024, __ATOMIC_RELAXED, __HIP_MEMORY_SCOPE_AGENT) : 0x000000003f800000ull; }
#pragma unroll
                for (int k = 0; k < 16; ++k) bad |= !agg_ok(v[k]);
                if (!__any(bad)) break;
                __builtin_amdgcn_s_sleep(2);
            }
#pragma unroll
            for (int k = 0; k < 16; ++k) hin = __uint_as_float((unsigned)v[k]) * hin + __uint_as_float((unsigned)(v[k] >> 32));
        }
    }
    asm volatile("" ::: "memory");
    GAS bf16_t* yp = (GAS bf16_t*)(X.Y + (size_t)I.row0 * DM + I.hd * 64);
#pragma unroll
    for (int t0 = 0; t0 < NT; t0 += 16) {
        {
#pragma unroll
            for (int k = 0; k < 16; k += 2) {
                const unsigned w0 = hp[t0 + k], w1 = hp[t0 + k + 1];
                const f32x2 gg = (f32x2){bf1(graw[t0 + k]), bf1(graw[t0 + k + 1])};
                f32x2 e = gg * (-LOG2E); e.x = __builtin_amdgcn_exp2f(e.x); e.y = __builtin_amdgcn_exp2f(e.y); e = e + 1.0f;
                f32x2 sg; sg.x = __builtin_amdgcn_rcpf(e.x); sg.y = __builtin_amdgcn_rcpf(e.y);
                const f32x2 hv = (f32x2){bflo(w0), bflo(w1)} + (f32x2){bfhi(w0), bfhi(w1)} * hin;
                const f32x2 y = hv * gg * sg;
                const unsigned pk = pg8::cvt_pk_bf16(y.x, y.y);
                yp[lane] = (bf16_t)(pk & 0xffffu); yp[DM + lane] = (bf16_t)(pk >> 16); yp += 2 * DM; asm volatile("" : "+s"(yp));
            }
        }
    }
}

__device__ __forceinline__ void ld8(const bf16_t* p, float (&o)[8]) {
    const u32x4 w = *(const u32x4*)p;
    o[0] = bflo(w.x); o[1] = bfhi(w.x); o[2] = bflo(w.y); o[3] = bfhi(w.y); o[4] = bflo(w.z); o[5] = bfhi(w.z); o[6] = bflo(w.w); o[7] = bfhi(w.w);
}
__device__ __forceinline__ void partb(const Mix& X, int tid) {
    int itn = blockIdx.x * 512 + tid; bool meta_done = false;
    for (;;) {
        int it;
        if (itn < 1024 * 128) { it = itn; itn += gridDim.x * 512; }
        else if (!meta_done && gridDim.x >= 8 && blockIdx.x + 4 >= gridDim.x && tid < 128) { it = (1024 + (int)(gridDim.x - 1 - blockIdx.x)) * 128 + tid; meta_done = true; }
        else if (!meta_done && gridDim.x < 8 && blockIdx.x == 0 && tid < 128) { it = 1028 * 128 + tid; meta_done = true; }
        else break;
        const int c0 = (it & 127) * 8, run = it >> 7;
        float w0[8], w1[8], w2[8], cm2[8], cm1[8];
        { const f32x4* p = (const f32x4*)(X.conv_b_w + c0); const f32x4 a0 = p[0], a1 = p[1], b0 = p[256], b1 = p[257], d0 = p[512], d1 = p[513];
#pragma unroll
          for (int e = 0; e < 4; ++e) { w0[e] = a0[e]; w0[4 + e] = a1[e]; w1[e] = b0[e]; w1[4 + e] = b1[e]; w2[e] = d0[e]; w2[4 + e] = d1[e]; } }
        if (run >= 1024) {
            const int t0 = (run == 1028) ? 0 : 4 * (run - 1024), nt = (run == 1028) ? 16 : 4;
            const bf16_t* up = X.U + (size_t)META0 * DIN + c0; bf16_t* yp = X.Y + (size_t)META0 * DM + 1024 + c0;
#pragma unroll
            for (int e = 0; e < 8; ++e) { cm2[e] = 0.f; cm1[e] = 0.f; }
            if (t0 > 0) {
                float c[8], x[8];
                ld8(up + (size_t)(t0 - 2) * DIN + 3072, c); ld8(up + (size_t)(t0 - 2) * DIN + 4096, x);
#pragma unroll
                for (int e = 0; e < 8; ++e) cm2[e] = c[e] * x[e];
                ld8(up + (size_t)(t0 - 1) * DIN + 3072, c); ld8(up + (size_t)(t0 - 1) * DIN + 4096, x);
#pragma unroll
                for (int e = 0; e < 8; ++e) cm1[e] = c[e] * x[e];
            }
#pragma unroll 4
            for (int t = t0; t < t0 + nt; ++t) {
                float bv[8], cv[8], xv[8], gv[8];
                ld8(up + (size_t)t * DIN + 2048, bv); ld8(up + (size_t)t * DIN + 3072, cv); ld8(up + (size_t)t * DIN + 4096, xv); ld8(up + (size_t)t * DIN + 5120, gv);
                float o[8];
#pragma unroll
                for (int e = 0; e < 8; ++e) { const float cx = cv[e] * xv[e]; const float y = w0[e] * cm2[e] + w1[e] * cm1[e] + w2[e] * cx; o[e] = bv[e] * y * (gv[e] * sigmoidf_(gv[e])); cm2[e] = cm1[e]; cm1[e] = cx; }
                u32x4 w; w.x = pk2(o[0], o[1]); w.y = pk2(o[2], o[3]); w.z = pk2(o[4], o[5]); w.w = pk2(o[6], o[7]);
                *(u32x4*)(yp + (size_t)t * DM) = w;
            }
            continue;
        }
        const int row0 = run * 16;
        const bf16_t* vp = X.U + (size_t)row0 * DIN + 2048 + 2 * c0;
        bf16_t* yp = X.Y + (size_t)row0 * DM + 1024 + c0;
        u32x4 q[16][2];
#pragma unroll
        for (int t = 0; t < 16; ++t) { q[t][0] = *(const u32x4*)(vp + (size_t)t * DIN); q[t][1] = *(const u32x4*)(vp + (size_t)t * DIN + 8); }
        if ((row0 & (SEQ - 1)) == 0) {
            float c[8], x[8];
            ld8(X.U + (size_t)(META0 + 14) * DIN + 3072 + c0, c); ld8(X.U + (size_t)(META0 + 14) * DIN + 4096 + c0, x);
#pragma unroll
            for (int e = 0; e < 8; ++e) cm2[e] = c[e] * x[e];
            ld8(X.U + (size_t)(META0 + 15) * DIN + 3072 + c0, c); ld8(X.U + (size_t)(META0 + 15) * DIN + 4096 + c0, x);
#pragma unroll
            for (int e = 0; e < 8; ++e) cm1[e] = c[e] * x[e];
        } else {
            const u32x4* p2 = (const u32x4*)(X.U + (size_t)(row0 - 2) * DIN + 2048 + 2 * c0); const u32x4* p1 = (const u32x4*)(X.U + (size_t)(row0 - 1) * DIN + 2048 + 2 * c0);
            const u32x4 a0 = p2[0], a1 = p2[1], b0 = p1[0], b1 = p1[1];
#pragma unroll
            for (int e = 0; e < 4; ++e) { cm2[e] = bfhi(a0[e]); cm2[4 + e] = bfhi(a1[e]); cm1[e] = bfhi(b0[e]); cm1[4 + e] = bfhi(b1[e]); }
        }
#pragma unroll
        for (int t = 0; t < 16; ++t) {
            float o[8];
#pragma unroll
            for (int e = 0; e < 8; ++e) { const unsigned qq = e < 4 ? q[t][0][e & 3] : q[t][1][e & 3]; const float bg = bflo(qq), cx = bfhi(qq);
                o[e] = bg * (w0[e] * cm2[e] + w1[e] * cm1[e] + w2[e] * cx); cm2[e] = cm1[e]; cm1[e] = cx; }
            u32x4 w; w.x = pk2(o[0], o[1]); w.y = pk2(o[2], o[3]); w.z = pk2(o[4], o[5]); w.w = pk2(o[6], o[7]);
            *(u32x4*)(yp + (size_t)t * DM) = w;
        }
    }
}


#ifdef DEBUG_NAIVE_MIX
__global__ void __launch_bounds__(64) naive_mixA(Mix X, const float* wr, const float* wi) {
    const int b = blockIdx.x / 16, hd = blockIdx.x % 16, lane = threadIdx.x, ch = hd * 64 + lane;
    __shared__ float xs[64];
    const float w0 = X.conv_a_w[ch], w1 = X.conv_a_w[1024 + ch], w2 = X.conv_a_w[2048 + ch], w3 = X.conv_a_w[3072 + ch], cb = X.conv_a_b[ch];
    const float br = X.lru_br[ch], bi = X.lru_bi[ch];
    const float sp = log1pf(expf(-X.lru_lambda[ch]));
    const float* wrh = wr + (size_t)hd * 4096 + lane; const float* wih = wi + (size_t)hd * 4096 + lane;
    float h = 0.f, xm3 = 0.f, xm2 = 0.f, xm1 = 0.f;
    for (int p = 0; p < NMETA + SEQ; ++p) {
        const int row = p < NMETA ? META0 + p : b * SEQ + (p - NMETA);
        const float x0 = bf1(X.U[(size_t)row * DIN + ch]);
        const float xc = cb + w0 * xm3 + w1 * xm2 + w2 * xm1 + w3 * x0; xm3 = xm2; xm2 = xm1; xm1 = x0;
        xs[lane] = xc; __syncthreads();
        float rp = br, ip = bi;
#pragma unroll 4
        for (int i = 0; i < 64; ++i) { rp += xs[i] * wrh[i * 64]; ip += xs[i] * wih[i * 64]; }
        __syncthreads();
        const float r = 1.f / (1.f + expf(-rp)), ig = 1.f / (1.f + expf(-ip));
        const float la = -8.f * r * sp; const float a = expf(la); const float bb = sqrtf(-expm1f(2.f * la)) * (ig * xc);
        h = a * h + bb;
        const float g = bf1(X.U[(size_t)row * DIN + 1024 + ch]);
        const float y = h * g / (1.f + expf(-g));
        if (p >= NMETA || b == 0) X.Y[(size_t)row * DM + ch] = (bf16_t)f2bf(y);
    }
}
__global__ void naive_mixB(Mix X) {
    for (size_t idx = (size_t)blockIdx.x * blockDim.x + threadIdx.x; idx < (size_t)(MROWS + NMETA) * 1024; idx += (size_t)gridDim.x * blockDim.x) {
        const int row = (int)(idx >> 10), c = (int)(idx & 1023);
        int r1, r2;
        if (row >= META0) { const int p = row - META0; r1 = p >= 1 ? row - 1 : -1; r2 = p >= 2 ? row - 2 : -1; }
        else { const int t = row & (SEQ - 1); r1 = t >= 1 ? row - 1 : META0 + 15; r2 = t >= 2 ? row - 2 : META0 + 14 + t; }
        auto cx = [&](int r) -> float { return r < 0 ? 0.f : bf1(X.U[(size_t)r * DIN + 3072 + c]) * bf1(X.U[(size_t)r * DIN + 4096 + c]); };
        const float y = X.conv_b_w[c] * cx(r2) + X.conv_b_w[1024 + c] * cx(r1) + X.conv_b_w[2048 + c] * cx(row);
        const float bv = bf1(X.U[(size_t)row * DIN + 2048 + c]), g = bf1(X.U[(size_t)row * DIN + 5120 + c]);
        X.Y[(size_t)row * DM + 1024 + c] = (bf16_t)f2bf(bv * y * g / (1.f + expf(-g)));
    }
}
#endif
#define XB_TMO      128
#define XB_XCNT(j)  (256  + 64 * (j))
#define XB_XSUB(j)  (1280 + 64 * (j))
#define XB_XGEN(j)  (2304 + 64 * (j))
#define XB_TOP      3328
#define XB_TOPGEN   3392
#define XCD_BAR_WORDS 3456
#define XB_SPIN_CAP (1u << 18)

__device__ __forceinline__ unsigned xb_ld(unsigned* p)              { return __hip_atomic_load(p, __ATOMIC_RELAXED, __HIP_MEMORY_SCOPE_AGENT); }
__device__ __forceinline__ unsigned xb_add(unsigned* p, unsigned v) { return __hip_atomic_fetch_add(p, v, __ATOMIC_RELAXED, __HIP_MEMORY_SCOPE_AGENT); }
__device__ __forceinline__ unsigned xb_xcc_id() { return (unsigned)__builtin_amdgcn_s_getreg((3 << 11) | 20) & 0xFu; }
#define XB_SPIN(cond, bar) do { unsigned _sp = 0; while (cond) { __builtin_amdgcn_s_sleep(1); \
    if ((++_sp & 255u) == 0u) { if (xb_ld(&(bar)[XB_TMO])) break; if (_sp > XB_SPIN_CAP) { atomicAdd(&(bar)[XB_TMO], 1u); break; } } } } while (0)

struct XcdBarrier {
    unsigned* bar; unsigned x;
    volatile LAS unsigned* st;
};

__device__ __forceinline__ XcdBarrier xcd_barrier_post(unsigned* bar, volatile LAS unsigned* st) {
    XcdBarrier b; b.bar = bar; b.x = xb_xcc_id(); b.st = st;
    if (threadIdx.x == 0) (void)xb_add(&bar[XB_XCNT(b.x)], 1u);
    return b;
}
__device__ __forceinline__ void xcd_barrier_complete(unsigned* bar, unsigned x, unsigned& nloc, unsigned& nx) {
    const unsigned G = gridDim.x * gridDim.y * gridDim.z;
    unsigned sum, cnt, mine, sp = 0u;
    for (;;) {
        sum = 0u; cnt = 0u; mine = 0u;
#pragma unroll
        for (unsigned j = 0; j < 16; ++j) { const unsigned c = xb_ld(&bar[XB_XCNT(j)]); sum += c; cnt += (c > 0u) ? 1u : 0u; mine = (j == x) ? c : mine; }
        if (sum == G) break;
        __builtin_amdgcn_s_sleep(1);
        if ((++sp & 255u) == 0u) { if (xb_ld(&bar[XB_TMO])) break; if (sp > XB_SPIN_CAP) { atomicAdd(&bar[XB_TMO], 1u); break; } }
    }
    nloc = mine > 0u ? mine : 1u; nx = cnt > 0u ? cnt : 1u;
}

__device__ __forceinline__ void xcd_barrier(const XcdBarrier& b) {
    asm volatile("s_waitcnt vmcnt(0)" ::: "memory");
    __syncthreads();
    if (threadIdx.x == 0) {
        unsigned* bar = b.bar;
        __builtin_amdgcn_s_waitcnt(0);
        unsigned nloc = b.st[0], nx = b.st[1];
        if (nloc == 0u) { xcd_barrier_complete(bar, b.x, nloc, nx); b.st[0] = nloc; b.st[1] = nx; }
        const unsigned old = xb_add(&bar[XB_XSUB(b.x)], 1u);
        const unsigned gen = old / nloc;
        if (old + 1u == (gen + 1u) * nloc) {
            __builtin_amdgcn_fence(__ATOMIC_RELEASE, "agent");
            asm volatile("s_waitcnt vmcnt(0)" ::: "memory");
            const unsigned og = xb_add(&bar[XB_TOP], 1u);
            const unsigned tg = og / nx;
            if (og + 1u == (tg + 1u) * nx) xb_add(&bar[XB_TOPGEN], 1u);
            else XB_SPIN(xb_ld(&bar[XB_TOPGEN]) == tg, bar);
            __builtin_amdgcn_fence(__ATOMIC_ACQUIRE, "agent");
            xb_add(&bar[XB_XGEN(b.x)], 1u);
            asm volatile("s_waitcnt vmcnt(0)" ::: "memory");
        } else {
            XB_SPIN(xb_ld(&bar[XB_XGEN(b.x)]) == gen, bar);
            __builtin_amdgcn_fence(__ATOMIC_ACQUIRE, "agent");
            asm volatile("s_waitcnt vmcnt(0)" ::: "memory");
        }
    }
    __syncthreads();
}

__global__ void __launch_bounds__(512, 2) hymba_fwd(Args a) {
    extern __shared__ __attribute__((aligned(16))) unsigned char lds_raw[];
    LAS unsigned char* lds = (LAS unsigned char*)lds_raw;
    cg::grid_group grid = cg::this_grid();
    const int NGW = gridDim.x * 8;
    if (threadIdx.x < 64) ((LAS unsigned*)(lds + 131072))[threadIdx.x] = 0u;
    __syncthreads();
    XcdBarrier xbar; xbar.bar = (unsigned*)(a.ws + WS_BAR); xbar.x = 0; xbar.st = nullptr;
    if (a.ph_hi - a.ph_lo > 1) xbar = xcd_barrier_post((unsigned*)(a.ws + WS_BAR), (volatile LAS unsigned*)(lds + 131072));
    if (a.ph_lo < 0) grid.sync();
#define LAUNDER() int tid = threadIdx.x; asm volatile("" : "+v"(tid)); const int wid = __builtin_amdgcn_readfirstlane(tid >> 6), lane = tid & 63, gw = blockIdx.x * 8 + wid
    const int lo = a.ph_lo, hi = a.ph_hi;
#define IN(k) (lo <= (k) && (k) < hi)
#ifndef STAGGER_N
#define STAGGER_N 0
#endif
#define STAGGER() do { if (STAGGER_N) for (int _k = 0; _k < (int)(blockIdx.x & 7); ++_k) __builtin_amdgcn_s_sleep(STAGGER_N); } while (0)
#define SEAM(k) do { if (IN(k) && IN((k) + 1)) { xcd_barrier(xbar); if ((REP_MASK >> 10) & 1) { xcd_barrier(xbar); xcd_barrier(xbar); } } } while (0)
    const float* x = a.in[0]; const float* meta = a.in[1]; const float* norm_g = a.in[2]; const float* w_in = a.in[3];
    const float* conv_a_w = a.in[4]; const float* conv_a_b = a.in[5]; const float* lru_wr = a.in[6]; const float* lru_br = a.in[7];
    const float* lru_wi = a.in[8]; const float* lru_bi = a.in[9]; const float* lru_lambda = a.in[10]; const float* conv_b_w = a.in[11];
    const float* w_out = a.in[12]; const float* final_g = a.in[13];
    unsigned char* ws = a.ws;
    bf16_t* WTIN = (bf16_t*)(ws + WS_WTIN); bf16_t* WTOUT = (bf16_t*)(ws + WS_WTOUT); bf16_t* GW = (bf16_t*)(ws + WS_GW);
    float* ROWSS = (float*)(ws + WS_ROWSS); unsigned long long* AGG = (unsigned long long*)(ws + WS_AGG);
    bf16_t* XB = (bf16_t*)(ws + WS_XB); bf16_t* Y = (bf16_t*)(ws + WS_Y); bf16_t* U = (bf16_t*)(ws + WS_U);

    if (IN(0)) for (int rep = 0; rep <= ((REP_MASK >> 0) & 1); ++rep) {
        LAUNDER();
        LAS unsigned char* scr = lds + wid * 16384;
        constexpr int I_IN = (DM / 64) * (DIN / 64);
        constexpr int NIT = I_IN + 64;
        for (int it = gw; it < NIT; it += NGW) {
            int r = it;
            if (r < I_IN) { tr_item<true>(w_in, DM, DIN, WTIN, norm_g, scr, r, lane); continue; } r -= I_IN;
            { const int mtx = r, l = mtx >> 5, g = (mtx >> 4) & 1, hd = mtx & 15;
              const float* src = (g ? lru_wi : lru_wr) + (size_t)(l * 16 + hd) * 4096;
              tr_item<false>(src, 64, 64, GW + (size_t)mtx * 4096, nullptr, scr, 0, lane); }
        }
        for (int m = gw; m < MROWS + NMETA; m += NGW) {
            const float* src = m < MROWS ? x + (size_t)m * DM : meta + (size_t)(m - MROWS) * DM;
            cvt_row(src, XB + (size_t)m * DM, ROWSS + m, lane);
        }
        for (int i = blockIdx.x * 512 + tid; i < 2 * RSTR; i += gridDim.x * 512) ROWSS[RSTR + i] = 0.f;
        for (int i = blockIdx.x * 512 + tid; i < AGG_PER_LAYER; i += gridDim.x * 512) ((u32x4*)AGG)[i] = (u32x4){0u, 0u, 0u, 0u};
    }
    SEAM(0);

#pragma unroll 1
    for (int l = 0; l < 2; ++l) {
        const int pb = 1 + 3 * l;
        const bf16_t* wtin = WTIN + (size_t)l * DIN * DM; const bf16_t* wtout = WTOUT + (size_t)l * DM * DM;
        float* rss_in = ROWSS + (size_t)l * RSTR; float* rss_out = ROWSS + (size_t)(l + 1) * RSTR;
        Mix X; X.conv_a_w = conv_a_w + l * 4 * DLRU; X.conv_a_b = conv_a_b + l * DLRU; X.lru_br = lru_br + l * DLRU; X.lru_bi = lru_bi + l * DLRU; X.lru_lambda = lru_lambda + l * DLRU;
        X.conv_b_w = conv_b_w + l * 3 * DLRU; X.gw = GW + (size_t)l * 2 * 16 * 4096; X.U = U; X.Y = Y; X.AGG = AGG + (size_t)l * AGG_PER_LAYER;

        if (IN(pb)) for (int rep = 0; rep <= ((REP_MASK >> pb) & 1); ++rep) {
            LAUNDER();
            STAGGER();
            for (int mrep = 0; mrep <= ((REP_MASK >> 16) & 1); ++mrep)
            meta_gemm(XB + (size_t)META0 * DM, wtin, DIN / 16, lds, wid, lane, [&](int m, int n0, f32x4 s) {
                const float rs = rsqrtf(rss_in[META0 + m] * (1.0f / DM) + RMS_EPS);
                u32x2 w; w.x = pk2(s[0] * rs, s[1] * rs); w.y = pk2(s[2] * rs, s[3] * rs);
                *(u32x2*)(U + (size_t)(META0 + m) * DIN + in_col(n0)) = w; });
            pg8::Gemm g{XB, wtin, MROWS, DIN, DM}; pg8::StaticOrder S; S.init(MROWS, DIN, (int)gridDim.x, (int)blockIdx.x);
            if ((REP_MASK >> 17) & 1) { EpiUT<true> En{U, rss_in}; pg8::gemm_phase<EpiUT<true>, pg8::StaticOrder, false>(lds, g, S, En, nullptr); }
            if ((REP_MASK >> 15) & 1) { EpiNull En{ROWSS + (size_t)3 * RSTR}; pg8::gemm_phase<EpiNull, pg8::StaticOrder, false>(lds, g, S, En, nullptr); }
            EpiU E{U, rss_in};
            pg8::gemm_phase<EpiU, pg8::StaticOrder, false>(lds, g, S, E, nullptr);
        }
        SEAM(pb);
        if (IN(pb + 1)) for (int rep = 0; rep <= ((REP_MASK >> (pb + 1)) & 1); ++rep) {
            LAUNDER();
#pragma unroll 1
            for (int step = 0; step < 2; ++step) {
                if ((step == 0) == (wid < 4)) {
                    if (rep == 1 && ((REP_MASK >> 13) & 1)) continue;
#pragma unroll 1
                    for (int id = gw; id < N_ITEMS; id += NGW) { if (id < 16) mix_item<true>(X, id, lds + wid * 9216, lane); else mix_item<false>(X, id, lds + wid * 9216, lane); }
                } else { if (rep == 1 && ((REP_MASK >> 12) & 1)) continue; partb(X, tid); }
            }
            if (l == 0) {
                constexpr int I_OUT = (DM / 64) * (DM / 64);
                LAS unsigned char* scr = lds + wid * 9216;
#pragma unroll 1
                for (int it = gw; it < I_OUT; it += NGW) tr_item<false>(w_out, DM, DM, WTOUT, nullptr, scr, it, lane);
            }
        }
        SEAM(pb + 1);
        if (IN(pb + 2)) {
            LAUNDER();
            STAGGER();
            const bool early_copies = ((blockIdx.x >> 3) & 1) != 0;
#define COHORT_COPIES() do { constexpr int I_IN = (DM / 64) * (DIN / 64), I_OUT = (DM / 64) * (DM / 64); LAS unsigned char* scr = lds + wid * 9216; \
                for (int it = gw; it < I_IN + I_OUT; it += NGW) { \
                    if (it < I_IN) tr_item<true>(w_in + (size_t)DM * DIN, DM, DIN, WTIN + (size_t)DIN * DM, norm_g + DM, scr, it, lane); \
                    else tr_item<false>(w_out + (size_t)DM * DM, DM, DM, WTOUT + (size_t)DM * DM, nullptr, scr, it - I_IN, lane); } } while (0)
            if (l == 0 && early_copies) { COHORT_COPIES(); __syncthreads(); }
            if (l == 0) {
                meta_gemm(Y + (size_t)META0 * DM, wtout, DM / 16, lds, wid, lane, [&](int m, int n0, f32x4 s) {
                    const f32x4 r = *(const f32x4*)(meta + (size_t)m * DM + n0); const f32x4 hh = r + s;
                    u32x2 w; w.x = pk2(hh[0], hh[1]); w.y = pk2(hh[2], hh[3]);
                    *(u32x2*)(XB + (size_t)(META0 + m) * DM + n0) = w;
                    unsafeAtomicAdd(rss_out + META0 + m, (hh[0] * hh[0] + hh[1] * hh[1]) + (hh[2] * hh[2] + hh[3] * hh[3])); });
            }
            pg8::Gemm g{Y, wtout, MROWS, DM, DM};
            if (l == 0) {
                pg8::StaticOrder S; S.init(MROWS, DM, (int)gridDim.x, (int)blockIdx.x);
                if ((REP_MASK >> 11) & 1) { EpiU Ed{U, rss_in}; pg8::gemm_phase<EpiU, pg8::StaticOrder, false>(lds, g, S, Ed, nullptr); }
                if ((REP_MASK >> 14) & 1) { EpiRes Ed{x, nullptr, XB, ROWSS + (size_t)3 * RSTR}; pg8::gemm_phase<EpiRes, pg8::StaticOrder, false>(lds, g, S, Ed, nullptr); }
                EpiRes E{nullptr, nullptr, XB, rss_out};
                pg8::gemm_phase<EpiRes, pg8::StaticOrder, false>(lds, g, S, E, nullptr);
                if (!early_copies) COHORT_COPIES();
            } else {
                PanelOrder S; S.init((int)gridDim.x, (int)blockIdx.x);
                EpiResNorm E{XB, a.out, rss_out, (unsigned*)(ws + WS_PCNT), final_g};
                pg8::gemm_phase<EpiResNorm, PanelOrder, false>(lds, g, S, E, nullptr);
            }
        }
        SEAM(pb + 2);
    }

#undef IN
#undef SEAM
}

#ifndef MK_LAUNCH_PER_PHASE
#define MK_LAUNCH_PER_PHASE 0
#endif
extern "C" void kernel_launch(void* const* d_in, const int* in_sizes, int n_in, void* d_out, int out_size, void* d_ws, size_t ws_size, hipStream_t stream) {
    static int grid = 0;
    if (grid == 0) {
        if (n_in != 14 || in_sizes[0] != MROWS * DM || out_size != MROWS * DM || ws_size < WS_END) { fprintf(stderr, "kernel_launch: unexpected shapes (n_in %d, in0 %d, out %d, ws %zu)\n", n_in, n_in > 0 ? in_sizes[0] : -1, out_size, ws_size); grid = -1; return; }
        int dev = 0, cus = 0, per_cu = 0;
        hipGetDevice(&dev); hipDeviceGetAttribute(&cus, hipDeviceAttributeMultiprocessorCount, dev);
        if (hipFuncSetAttribute((const void*)hymba_fwd, hipFuncAttributeMaxDynamicSharedMemorySize, LDS_BYTES) != hipSuccess) { fprintf(stderr, "kernel_launch: hipFuncSetAttribute failed\n"); grid = -1; return; }
        if (hipOccupancyMaxActiveBlocksPerMultiprocessor(&per_cu, (const void*)hymba_fwd, 512, LDS_BYTES) != hipSuccess || per_cu < 1) { fprintf(stderr, "kernel_launch: occupancy query gave %d\n", per_cu); per_cu = 1; }
        (void)hipGetLastError();
        grid = cus * per_cu;
    }
    if (grid < 0) return;
    Args a{};
    for (int i = 0; i < 14; ++i) a.in[i] = (const float*)d_in[i];
    a.out = (float*)d_out; a.ws = (unsigned char*)d_ws;
#if MK_LAUNCH_PER_PHASE
    for (int p = 0; p < NPHASE; ++p) {
#ifdef DEBUG_NAIVE_MIX
        if (p == 2 || p == 6) { const int l = p / 4; unsigned char* ws = (unsigned char*)d_ws;
            Mix X; X.conv_a_w = a.in[4] + l * 4 * DLRU; X.conv_a_b = a.in[5] + l * DLRU; X.lru_br = a.in[7] + l * DLRU; X.lru_bi = a.in[9] + l * DLRU; X.lru_lambda = a.in[10] + l * DLRU;
            X.conv_b_w = a.in[11] + l * 3 * DLRU; X.gw = nullptr; X.U = (bf16_t*)(ws + WS_U); X.Y = (bf16_t*)(ws + WS_Y); X.HP = nullptr; X.AGG = nullptr;
#if DEBUG_NAIVE_MIX == 1
            hipLaunchKernelGGL(naive_mixA, dim3(64), dim3(64), 0, stream, X, a.in[6] + (size_t)l * 16 * 4096, a.in[8] + (size_t)l * 16 * 4096);
            a.flags = 1;
#else
            hipLaunchKernelGGL(naive_mixB, dim3(2048), dim3(256), 0, stream, X);
            a.flags = 2;
#endif
            }
        else a.flags = 0;
#if DEBUG_NAIVE_MIX == 1
        if (p == 3 || p == 7) continue;
#endif
#endif
        a.ph_lo = p; a.ph_hi = p + 1; hipLaunchKernelGGL(hymba_fwd, dim3(grid), dim3(512), LDS_BYTES, stream, a); }
#else
    a.ph_lo = 0; a.ph_hi = NPHASE;
    if (hipMemsetAsync((unsigned char*)d_ws + WS_BAR, 0, 16384 + 32768, stream) != hipSuccess) { fprintf(stderr, "kernel_launch: memset of barrier words failed\n"); return; }
    void* args[] = {&a};
    const hipError_t e = hipLaunchCooperativeKernel((const void*)hymba_fwd, dim3(grid), dim3(512), args, LDS_BYTES, stream);
    if (e != hipSuccess) fprintf(stderr, "kernel_launch: cooperative launch failed: %s (grid %d)\n", hipGetErrorString(e), grid);
#endif
}
```

```cpp
#include <hip/hip_runtime.h>
#include <hip/hip_cooperative_groups.h>
#include <cstdio>
namespace cg = cooperative_groups;
namespace pg8 {
#define PG8_LAS __attribute__((address_space(3)))
typedef unsigned short bf16_t;
typedef short bf16x8 __attribute__((ext_vector_type(8)));
typedef float f32x4 __attribute__((ext_vector_type(4)));
typedef unsigned u32x4 __attribute__((ext_vector_type(4)));
constexpr int BM = 256, BK = 64, HALF = 128, HTB = HALF * BK * 2  , STAGE_BYTES = 8 * HTB, NXCD = 8, WGM = 4;

__host__ __device__ __forceinline__ int lds_byte(int r, int c) { const int st = (r >> 4) * 2 + (c >> 5), rr = r & 15, cc = c & 31, ob = rr * 64 + cc * 2; return st * 1024 + (ob ^ (((ob >> 9) & 1) << 5)); }
__host__ __device__ __forceinline__ void stage_rc(int b, int& R, int& C) { const int st = b / 1024, sb = b % 1024, swz = sb ^ (((sb >> 9) & 1) << 5); R = (st >> 1) * 16 + swz / 64; C = (st & 1) * 32 + (swz % 64) / 2; }
__host__ __device__ __forceinline__ int perm32(int rho) { const int n = rho >> 4, i = rho & 15; return 8 * (i >> 2) + 4 * n + (i & 3); }

struct Unit { int pm, pn; };
struct Gemm { const bf16_t* A; const bf16_t* Bt; int M, N, K; };

struct StaticOrder {
    int nM, nN, nwg, G, c;
    __host__ __device__ void init(int M, int N, int G_, int c_) { nM = M / BM; nN = N / BM; nwg = nM * nN; G = G_; c = c_; }
    __host__ __device__ bool next(int i, Unit& u) const {
        const long L = (long)i * G + c; if (L >= nwg) return false;
        int wgid = (int)L; { const int q = nwg / NXCD, r = nwg % NXCD, xcd = wgid % NXCD, off = wgid / NXCD; wgid = (xcd < r ? xcd * (q + 1) : r * (q + 1) + (xcd - r) * q) + off; }
        const int nig = WGM * nN, gid = wgid / nig, fm = gid * WGM, gsz = (nM - fm) < WGM ? (nM - fm) : WGM;
        u.pm = fm + ((wgid % nig) % gsz); u.pn = (wgid % nig) / gsz; return true;
    }
    __device__ __forceinline__ void a_ready(const Unit&) const {}
    __device__ __forceinline__ void done(const Unit&) const {}
};
__device__ __forceinline__ unsigned cvt_pk_bf16(float lo, float hi) { unsigned r; asm volatile("v_cvt_pk_bf16_f32 %0, %1, %2" : "=v"(r) : "v"(lo), "v"(hi)); return r; }
template <class Epi, class Sched, bool STAMP = false>
__device__ __forceinline__ void gemm_phase(PG8_LAS unsigned char* lds, const Gemm g, const Sched& S, const Epi& E, unsigned long long* stamps) {
    int tid_l = threadIdx.x; asm volatile("" : "+v"(tid_l));
    const int tid = tid_l, wid = __builtin_amdgcn_readfirstlane(tid >> 6), lane = tid & 63, wr = wid >> 2, wc = wid & 3, fr = lane & 15, fq = lane >> 4;
    const int K = g.K, nt = K / BK;
    int ts_lo = 0, ts_hi = 0, nts = 0; const unsigned long long rt_entry = STAMP ? (unsigned long long)wall_clock64() : 0ull;
#define PG8_STAMP() do { if (STAMP && wid == 0 && nts < 64) { const unsigned long long _c = (unsigned long long)clock64(); \
        ts_lo = (lane == nts) ? (int)(unsigned)_c : ts_lo; ts_hi = (lane == nts) ? (int)(unsigned)(_c >> 32) : ts_hi; ++nts; } } while (0)
    PG8_STAMP();
    unsigned voffA[2], voffB[2];
#pragma unroll
    for (int i = 0; i < 2; ++i) { int R, C; stage_rc(tid * 16 + i * 8192, R, C); const int Rb = Epi::PERM ? ((R & ~31) + perm32(R & 31)) : R;
        voffA[i] = (unsigned)(R * K + C) * 2u; voffB[i] = (unsigned)(Rb * K + C) * 2u; }
    const size_t kstep = (size_t)(BK * 2);
    const size_t hstep = (size_t)HALF * K * 2;
    const size_t tstep = 2 * hstep;
    const unsigned ldsw = (unsigned)wid * 1024u;
    const int aoff = lds_byte(wr * 64 + fr, fq * 8), boff = lds_byte(wc * 32 + fr, fq * 8);
#define PG8_SA(b, h) (((b) * 2 + (h)) * HTB)
#define PG8_SB(b, h) ((4 + (b) * 2 + (h)) * HTB)
#define PG8_STAGE(bufoff, gbase, voff) do { _Pragma("unroll") for (int _i = 0; _i < 2; ++_i) \
        __builtin_amdgcn_global_load_lds((const unsigned*)((const char*)(gbase) + (voff)[_i]), (PG8_LAS unsigned*)(lds + (bufoff) + ldsw + _i * 8192), 16, 0, 0); } while (0)
#define PG8_LDA(dst, b, h) do { _Pragma("unroll") for (int m = 0; m < 4; ++m) _Pragma("unroll") for (int k = 0; k < 2; ++k) dst[m][k] = *(const PG8_LAS bf16x8*)(lds + PG8_SA(b, h) + aoff + m * 2048 + k * 1024); } while (0)
#define PG8_LDB(dst, b, h) do { _Pragma("unroll") for (int n = 0; n < 2; ++n) _Pragma("unroll") for (int k = 0; k < 2; ++k) dst[n][k] = *(const PG8_LAS bf16x8*)(lds + PG8_SB(b, h) + boff + n * 2048 + k * 1024); } while (0)
#define PG8_MMA(ai, bj, At, Bt) do { __builtin_amdgcn_s_setprio(1); _Pragma("unroll") for (int m = 0; m < 4; ++m) _Pragma("unroll") for (int n = 0; n < 2; ++n) _Pragma("unroll") for (int k = 0; k < 2; ++k) \
        acc[ai][bj][m][n] = __builtin_amdgcn_mfma_f32_16x16x32_bf16(Bt[n][k], At[m][k], acc[ai][bj][m][n], 0, 0, 0); __builtin_amdgcn_s_setprio(0); } while (0)
#define PG8_WAIT_V(n) asm volatile("s_waitcnt vmcnt(" #n ")" ::: "memory")
#define PG8_WAIT_L(n) asm volatile("s_waitcnt lgkmcnt(" #n ")" ::: "memory")
#define PG8_BAR __builtin_amdgcn_s_barrier()
#define PG8_SCHED __builtin_amdgcn_sched_barrier(0)
    Unit cur, nxt; int ui = 0;
    if (!S.next(0, cur)) return;
    f32x4 acc[2][2][4][2];
#pragma unroll
    for (int a = 0; a < 2; ++a)
#pragma unroll
        for (int b = 0; b < 2; ++b)
#pragma unroll
            for (int m = 0; m < 4; ++m)
#pragma unroll
                for (int n = 0; n < 2; ++n) acc[a][b][m][n] = (f32x4){0.f, 0.f, 0.f, 0.f};
    bf16x8 At[4][2], B0[2][2], B1[2][2];
    const char* cA = (const char*)g.A + (size_t)cur.pm * tstep; const char* cB = (const char*)g.Bt + (size_t)cur.pn * tstep;
    S.a_ready(cur);
    PG8_STAGE(PG8_SB(0, 0), cB, voffB); PG8_STAGE(PG8_SA(0, 0), cA, voffA); PG8_STAGE(PG8_SB(0, 1), cB + hstep, voffB); PG8_STAGE(PG8_SA(0, 1), cA + hstep, voffA);
    if (wr == 1) PG8_BAR;
    PG8_WAIT_V(4); PG8_BAR;
    PG8_STAGE(PG8_SB(1, 0), cB + kstep, voffB); PG8_STAGE(PG8_SA(1, 0), cA + kstep, voffA); PG8_STAGE(PG8_SB(1, 1), cB + hstep + kstep, voffB);
    PG8_WAIT_V(6); PG8_BAR;
    PG8_STAMP();
    for (;;) {
        const bool has_next = S.next(ui + 1, nxt);
        const char* nA = has_next ? (const char*)g.A + (size_t)nxt.pm * tstep : cA; const char* nB = has_next ? (const char*)g.Bt + (size_t)nxt.pn * tstep : cB;
        for (int t = 0; t < nt; t += 2) {
            const bool last = (t == nt - 2);
            const char* a1 = cA + (size_t)(t + 1) * kstep;
            const char* a2 = last ? nA : cA + (size_t)(t + 2) * kstep; const char* b2 = last ? nB : cB + (size_t)(t + 2) * kstep;
            const char* a3 = a2 + kstep; const char* b3 = b2 + kstep;
            if (last && has_next) S.a_ready(nxt);
            PG8_LDB(B0, 0, 0); PG8_SCHED; PG8_LDA(At, 0, 0); PG8_STAGE(PG8_SA(1, 1), a1 + hstep, voffA);
            PG8_WAIT_L(8); PG8_BAR; PG8_WAIT_L(0); PG8_MMA(0, 0, At, B0); PG8_BAR; PG8_SCHED;
            PG8_LDB(B1, 0, 1); PG8_STAGE(PG8_SB(0, 0), b2, voffB);
            PG8_BAR; PG8_WAIT_L(0); PG8_MMA(0, 1, At, B1); PG8_BAR;
            PG8_LDA(At, 0, 1); PG8_STAGE(PG8_SA(0, 0), a2, voffA);
            PG8_BAR; PG8_WAIT_L(0); PG8_MMA(1, 0, At, B0); PG8_BAR; PG8_SCHED;
            PG8_STAGE(PG8_SB(0, 1), b2 + hstep, voffB);
            PG8_WAIT_V(6); PG8_BAR; PG8_MMA(1, 1, At, B1); PG8_BAR;
            PG8_LDB(B0, 1, 0); PG8_SCHED; PG8_LDA(At, 1, 0); PG8_STAGE(PG8_SA(0, 1), a2 + hstep, voffA);
            PG8_WAIT_L(8); PG8_BAR; PG8_WAIT_L(0); PG8_MMA(0, 0, At, B0); PG8_BAR; PG8_SCHED;
            PG8_LDB(B1, 1, 1); PG8_STAGE(PG8_SB(1, 0), b3, voffB);
            PG8_BAR; PG8_WAIT_L(0); PG8_MMA(0, 1, At, B1); PG8_BAR;
            PG8_LDA(At, 1, 1); PG8_STAGE(PG8_SA(1, 0), a3, voffA);
            PG8_BAR; PG8_WAIT_L(0); PG8_MMA(1, 0, At, B0); PG8_BAR; PG8_SCHED;
            PG8_STAGE(PG8_SB(1, 1), b3 + hstep, voffB);
            PG8_WAIT_V(6); PG8_BAR; PG8_MMA(1, 1, At, B1); PG8_BAR;
        }
        PG8_STAMP();
        if constexpr (!Epi::AFTER_DRAIN) { if (wr == 0) PG8_BAR; E(acc, cur, wr, wc, fr, fq); S.done(cur); if (has_next) { if (wr == 1) PG8_BAR; } }
        PG8_STAMP();
        if (!has_next) break;
#pragma unroll
        for (int a = 0; a < 2; ++a)
#pragma unroll
            for (int b = 0; b < 2; ++b)
#pragma unroll
                for (int m = 0; m < 4; ++m)
#pragma unroll
                    for (int n = 0; n < 2; ++n) acc[a][b][m][n] = (f32x4){0.f, 0.f, 0.f, 0.f};
        cur = nxt; cA = nA; cB = nB; ++ui;
    }
    PG8_WAIT_V(0);
    if constexpr (Epi::AFTER_DRAIN) { if (wr == 0) PG8_BAR; }
    PG8_BAR;
    if constexpr (Epi::AFTER_DRAIN) { E.fused(acc, cur, wr, wc, fr, fq, lds, wid, lane); S.done(cur); }
    PG8_STAMP();
    if (STAMP && wid == 0) { stamps[lane] = lane < nts ? (((unsigned long long)(unsigned)ts_hi << 32) | (unsigned)ts_lo) : 0ull;
        if (lane == 62) stamps[62] = rt_entry; if (lane == 63) stamps[63] = (unsigned long long)wall_clock64(); }
#undef PG8_STAMP
#undef PG8_SA
#undef PG8_SB
#undef PG8_STAGE
#undef PG8_LDA
#undef PG8_LDB
#undef PG8_MMA
#undef PG8_WAIT_V
#undef PG8_WAIT_L
#undef PG8_BAR
#undef PG8_SCHED
}
}

#define LAS __attribute__((address_space(3)))
#define GAS __attribute__((address_space(1)))
typedef unsigned short bf16_t;
typedef short bf16x8 __attribute__((ext_vector_type(8)));
typedef float f32x4 __attribute__((ext_vector_type(4)));
typedef float f32x2 __attribute__((ext_vector_type(2)));
typedef float f32x16 __attribute__((ext_vector_type(16)));
typedef unsigned u32x4 __attribute__((ext_vector_type(4)));
typedef unsigned u32x2 __attribute__((ext_vector_type(2)));

constexpr int DM = 2048, NBATCH = 4, SEQ = 4096, MROWS = NBATCH * SEQ, NMETA = 16, DIN = 6144, DLRU = 1024, NHEAD = 16;
constexpr int META0 = MROWS;
constexpr int RSTR = MROWS + 64;
constexpr float RMS_EPS = 1e-6f;
constexpr int NPHASE = 7;
#ifndef REP_MASK
#define REP_MASK 0
#endif
constexpr int LDS_BYTES = 131072 + 256;

constexpr size_t MiB = 1u << 20;
constexpr size_t WS_WTIN = 0;
constexpr size_t WS_WTOUT = 48 * MiB;
constexpr size_t WS_GW = 64 * MiB;
constexpr size_t WS_ROWSS = 65 * MiB;
constexpr size_t WS_BAR = 65 * MiB + 512 * 1024;
constexpr size_t WS_PCNT = WS_BAR + 16384;
constexpr size_t WS_AGG = 66 * MiB;
constexpr size_t WS_XB = 71 * MiB;
constexpr size_t WS_Y = 136 * MiB;
constexpr size_t WS_U = 201 * MiB;
constexpr size_t WS_END = 396 * MiB;
constexpr int AGG_PER_LAYER = 257 * 1024;
static_assert(WS_U + (size_t)RSTR * DIN * 2 <= WS_END && WS_Y + (size_t)RSTR * DM * 2 <= WS_U && WS_XB + (size_t)RSTR * DM * 2 <= WS_Y, "ws map");
static_assert(WS_WTIN + (size_t)2 * DIN * DM * 2 <= WS_WTOUT && WS_WTOUT + (size_t)2 * DM * DM * 2 <= WS_GW && WS_AGG + (size_t)2 * AGG_PER_LAYER * 8 <= WS_XB && WS_ROWSS + (size_t)3 * RSTR * 4 <= WS_BAR, "ws map 2");

struct Args { const float* in[14]; float* out; unsigned char* ws; int ph_lo, ph_hi, flags, pad; };

__device__ __forceinline__ unsigned f2bf(float f) { unsigned u = __builtin_bit_cast(unsigned, f); return (u + 0x7fffu + ((u >> 16) & 1u)) >> 16; }
__device__ __forceinline__ unsigned pk2(float lo, float hi) { return f2bf(lo) | (f2bf(hi) << 16); }
__device__ __forceinline__ float bflo(unsigned w) { return __builtin_bit_cast(float, w << 16); }
__device__ __forceinline__ float bfhi(unsigned w) { return __builtin_bit_cast(float, w & 0xffff0000u); }
__device__ __forceinline__ float bf1(bf16_t v) { return __builtin_bit_cast(float, ((unsigned)v) << 16); }
__device__ __forceinline__ float sigmoidf_(float z) { return __builtin_amdgcn_rcpf(1.0f + __expf(-z)); }
__device__ __forceinline__ float wave_sum(float v) {
#pragma unroll
    for (int o = 1; o < 64; o <<= 1) v += __shfl_xor(v, o);
    return v;
}
#define LDS_WAIT() asm volatile("s_waitcnt lgkmcnt(0)" ::: "memory")

template <bool NORS> struct EpiUT {
    static constexpr bool PERM = true, AFTER_DRAIN = false;
    bf16_t* O; const float* rowss;
    mutable float rsc[8]; mutable int cpm;
    __device__ __forceinline__ void operator()(const f32x4 (&acc)[2][2][4][2], const pg8::Unit& u, int wr, int wc, int fr, int fq) const {
        const int row0 = u.pm * 256 + wr * 64 + fr, col0 = u.pn * 256 + wc * 32 + 8 * fq;
        if (u.pm != cpm) {
#pragma unroll
            for (int q = 0; q < 8; ++q) rsc[q] = NORS ? 1.0f : rsqrtf(rowss[row0 + (q >> 2) * 128 + (q & 3) * 16] * (1.0f / DM) + RMS_EPS);
            cpm = u.pm;
        }
        if (u.pn >= 8) {
            const int ch0 = 64 * (u.pn - 8) + 16 * wc + 4 * fq;
#pragma unroll
            for (int ai = 0; ai < 2; ++ai)
#pragma unroll
                for (int m = 0; m < 4; ++m) {
                    const int r = row0 + ai * 128 + m * 16;
                    const float rs = rsc[ai * 4 + m];
                    const f32x4 bv = acc[ai][0][m][0] * rs, cv = acc[ai][0][m][1] * rs, xv = acc[ai][1][m][0] * rs, gv = acc[ai][1][m][1] * rs;
                    u32x4 w;
#pragma unroll
                    for (int i = 0; i < 4; ++i) w[i] = pg8::cvt_pk_bf16(bv[i] * gv[i] * sigmoidf_(gv[i]), cv[i] * xv[i]);
                    *(u32x4*)(O + (size_t)r * DIN + 2048 + 2 * ch0) = w;
                }
            return;
        }
#pragma unroll
        for (int ai = 0; ai < 2; ++ai)
#pragma unroll
            for (int m = 0; m < 4; ++m) {
                const int r = row0 + ai * 128 + m * 16;
                const float rs = rsc[ai * 4 + m];
                bf16_t* rowp = O + (size_t)r * DIN + col0;
#pragma unroll
                for (int bj = 0; bj < 2; ++bj) {
                    const f32x4 v0 = acc[ai][bj][m][0] * rs, v1 = acc[ai][bj][m][1] * rs;
                    u32x4 w; w.x = pg8::cvt_pk_bf16(v0[0], v0[1]); w.y = pg8::cvt_pk_bf16(v0[2], v0[3]); w.z = pg8::cvt_pk_bf16(v1[0], v1[1]); w.w = pg8::cvt_pk_bf16(v1[2], v1[3]);
                    *(u32x4*)(rowp + bj * 128) = w;
                }
            }
    }
};
struct EpiNull {
    static constexpr bool PERM = true, AFTER_DRAIN = false;
    float* sink;
    __device__ __forceinline__ void operator()(const f32x4 (&acc)[2][2][4][2], const pg8::Unit& u, int wr, int wc, int fr, int fq) const {
        f32x4 s = {0.f, 0.f, 0.f, 0.f};
#pragma unroll
        for (int ai = 0; ai < 2; ++ai)
#pragma unroll
            for (int bj = 0; bj < 2; ++bj)
#pragma unroll
                for (int m = 0; m < 4; ++m) { s += acc[ai][bj][m][0]; s += acc[ai][bj][m][1]; }
        if (s[0] + s[1] + s[2] + s[3] == 1.2345678e33f) sink[u.pm] = s[0];
    }
};
typedef EpiUT<false> EpiU;
#ifndef EPI_MB
#define EPI_MB 2
#endif
struct EpiRes {
    static constexpr bool PERM = true, AFTER_DRAIN = false;
    const float* res; float* out; bf16_t* xb; float* rowss;
    __device__ __forceinline__ void operator()(const f32x4 (&acc)[2][2][4][2], const pg8::Unit& u, int wr, int wc, int fr, int fq) const {
        const int row0 = u.pm * 256 + wr * 64 + fr, col0 = u.pn * 256 + wc * 32 + 8 * fq;
#pragma unroll
        for (int ai = 0; ai < 2; ++ai) {
#pragma unroll
          for (int mh = 0; mh < 4; mh += EPI_MB) {
            f32x4 rv[4][2][2];
#pragma unroll
            for (int m = mh; m < mh + EPI_MB; ++m)
#pragma unroll
                for (int bj = 0; bj < 2; ++bj) {
                    if (res) { const float* p = res + (size_t)(row0 + ai * 128 + m * 16) * DM + col0 + bj * 128; rv[m][bj][0] = *(const f32x4*)p; rv[m][bj][1] = *(const f32x4*)(p + 4); }
                    else { const u32x4 q = *(const u32x4*)(xb + (size_t)(row0 + ai * 128 + m * 16) * DM + col0 + bj * 128);
                        rv[m][bj][0] = (f32x4){bflo(q.x), bfhi(q.x), bflo(q.y), bfhi(q.y)}; rv[m][bj][1] = (f32x4){bflo(q.z), bfhi(q.z), bflo(q.w), bfhi(q.w)}; } }
            asm volatile("" ::: "memory");
#pragma unroll
            for (int m = mh; m < mh + EPI_MB; ++m) {
                const int r = row0 + ai * 128 + m * 16; const size_t off = (size_t)r * DM + col0; float ss = 0.f;
#pragma unroll
                for (int bj = 0; bj < 2; ++bj) {
                    const f32x4 h0 = rv[m][bj][0] + acc[ai][bj][m][0], h1 = rv[m][bj][1] + acc[ai][bj][m][1];
                    if (out) { *(f32x4*)(out + off + bj * 128) = h0; *(f32x4*)(out + off + bj * 128 + 4) = h1; }
                    if (xb) { u32x4 w; w.x = pg8::cvt_pk_bf16(h0[0], h0[1]); w.y = pg8::cvt_pk_bf16(h0[2], h0[3]); w.z = pg8::cvt_pk_bf16(h1[0], h1[1]); w.w = pg8::cvt_pk_bf16(h1[2], h1[3]);
                        *(u32x4*)(xb + off + bj * 128) = w; }
                    ss += (h0[0] * h0[0] + h0[1] * h0[1]) + (h0[2] * h0[2] + h0[3] * h0[3]) + (h1[0] * h1[0] + h1[1] * h1[1]) + (h1[2] * h1[2] + h1[3] * h1[3]);
                }
                ss += __shfl_xor(ss, 16); ss += __shfl_xor(ss, 32);
                if (fq == 0) unsafeAtomicAdd(rowss + r, ss);
            }
            asm volatile("" ::: "memory");
          }
        }
    }
};

struct EpiResNorm {
    static constexpr bool PERM = true, AFTER_DRAIN = false;
    const bf16_t* res; float* out; float* rowss; unsigned* cnt; const float* fg;
    __device__ __forceinline__ void operator()(f32x4 (&acc)[2][2][4][2], const pg8::Unit& u, int wr, int wc, int fr, int fq) const {
        const int row0 = u.pm * 256 + wr * 64 + fr, col0 = u.pn * 256 + wc * 32 + 8 * fq;
#pragma unroll
        for (int ai = 0; ai < 2; ++ai) {
#pragma unroll
          for (int mh = 0; mh < 4; mh += EPI_MB) {
            u32x4 rw[4][2];
#pragma unroll
            for (int m = mh; m < mh + EPI_MB; ++m)
#pragma unroll
                for (int bj = 0; bj < 2; ++bj) rw[m][bj] = *(const u32x4*)(res + (size_t)(row0 + ai * 128 + m * 16) * DM + col0 + bj * 128);
            asm volatile("" ::: "memory");
#pragma unroll
            for (int m = mh; m < mh + EPI_MB; ++m) {
                float ss = 0.f;
#pragma unroll
                for (int bj = 0; bj < 2; ++bj) {
                    const u32x4 w = rw[m][bj];
                    const f32x4 h0 = (f32x4){bflo(w.x), bfhi(w.x), bflo(w.y), bfhi(w.y)} + acc[ai][bj][m][0], h1 = (f32x4){bflo(w.z), bfhi(w.z), bflo(w.w), bfhi(w.w)} + acc[ai][bj][m][1];
                    acc[ai][bj][m][0] = h0; acc[ai][bj][m][1] = h1;
                    ss += (h0[0] * h0[0] + h0[1] * h0[1]) + (h0[2] * h0[2] + h0[3] * h0[3]) + (h1[0] * h1[0] + h1[1] * h1[1]) + (h1[2] * h1[2] + h1[3] * h1[3]);
                }
                ss += __shfl_xor(ss, 16); ss += __shfl_xor(ss, 32);
                if (fq == 0) unsafeAtomicAdd(rowss + row0 + ai * 128 + m * 16, ss);
            }
            asm volatile("" ::: "memory");
          }
        }
        asm volatile("s_waitcnt vmcnt(0)" ::: "memory");
        unsigned* cw = cnt + 64 * (2 * u.pm + wr);
        if (fr == 0 && fq == 0) __hip_atomic_fetch_add(cw, 1u, __ATOMIC_RELAXED, __HIP_MEMORY_SCOPE_AGENT);
        f32x4 gv[2][2];
#pragma unroll
        for (int bj = 0; bj < 2; ++bj) { gv[bj][0] = *(const f32x4*)(fg + col0 + bj * 128); gv[bj][1] = *(const f32x4*)(fg + col0 + bj * 128 + 4); }
        { unsigned sp = 0;
          while ((unsigned)__builtin_amdgcn_readfirstlane(__hip_atomic_load(cw, __ATOMIC_RELAXED, __HIP_MEMORY_SCOPE_AGENT)) < 32u) { __builtin_amdgcn_s_sleep(1); if (++sp > (1u << 16)) break; } }
        asm volatile("" ::: "memory");
#pragma unroll
        for (int ai = 0; ai < 2; ++ai)
#pragma unroll
            for (int m = 0; m < 4; ++m) {
                const int r = row0 + ai * 128 + m * 16;
                const float rs = rsqrtf(__hip_atomic_load(rowss + r, __ATOMIC_RELAXED, __HIP_MEMORY_SCOPE_AGENT) * (1.0f / DM) + RMS_EPS);
                float* op = out + (size_t)r * DM + col0;
#pragma unroll
                for (int bj = 0; bj < 2; ++bj) { *(f32x4*)(op + bj * 128) = acc[ai][bj][m][0] * rs * gv[bj][0]; *(f32x4*)(op + bj * 128 + 4) = acc[ai][bj][m][1] * rs * gv[bj][1]; }
            }
    }
};
struct PanelOrder {
    int Gp, v;
    __device__ void init(int G, int c) { Gp = G & ~7; v = c; if ((Gp & 63) == 0) v = (c & 7) * (Gp >> 3) + (c >> 3); if (c >= Gp) v = -1; }
    __device__ bool next(int i, pg8::Unit& u) const { if (v < 0) return false; const long L = (long)i * Gp + v; if (L >= 64 * 8) return false; u.pm = (int)(L >> 3); u.pn = (int)(L & 7); return true; }
    __device__ __forceinline__ void a_ready(const pg8::Unit&) const {}
    __device__ __forceinline__ void done(const pg8::Unit&) const {}
};

template <class F> __device__ __forceinline__ void meta_gemm(const bf16_t* A, const bf16_t* Bt, int ngroups, LAS unsigned char* lds, int wid, int lane, F epi) {
    const int fr = lane & 15, fq = lane >> 4, half = wid >> 2, wq = wid & 3;
    LAS f32x4* red = (LAS f32x4*)lds;
    for (int p = blockIdx.x; 2 * p < ngroups; p += gridDim.x) {
        const int g = 2 * p + half;
        f32x4 acc = {0.f, 0.f, 0.f, 0.f};
        if (g < ngroups) {
            const bf16_t* ap = A + (size_t)fr * DM + wq * 512 + fq * 8;
            const bf16_t* bp = Bt + (size_t)(g * 16 + fr) * DM + wq * 512 + fq * 8;
            bf16x8 av[16], bv[16];
#pragma unroll
            for (int s = 0; s < 16; ++s) { av[s] = *(const bf16x8*)(ap + 32 * s); bv[s] = *(const bf16x8*)(bp + 32 * s); }
#pragma unroll
            for (int s = 0; s < 16; ++s) acc = __builtin_amdgcn_mfma_f32_16x16x32_bf16(bv[s], av[s], acc, 0, 0, 0);
        }
        red[wid * 64 + lane] = acc;
        __syncthreads();
        if (wq == 0 && g < ngroups) {
            f32x4 s = red[wid * 64 + lane];
#pragma unroll
            for (int w = 1; w < 4; ++w) s += red[(wid + w) * 64 + lane];
            epi(fr, g * 16 + 4 * fq, s);
        }
        __syncthreads();
    }
}

__host__ __device__ __forceinline__ int in_col(int p) {
    if (p < 2048) return p;
    const int c = p & 255, j = (p >> 8) - 8, g = 2 * (c >> 7) + ((c >> 2) & 1), k = 16 * ((c >> 5) & 3) + 4 * ((c >> 3) & 3) + (c & 3);
    return 2048 + 1024 * g + 64 * j + k;
}
template <bool COLMAP> __device__ __forceinline__ void tr_item(const float* W, int K, int N, bf16_t* WT, const float* sc, LAS unsigned char* scr, int item, int lane) {
    const int nblk = N / 64, kb = item / nblk, nb = item % nblk, k0 = 64 * kb, n0 = 64 * nb;
    const int kr = lane >> 4, nc = (lane & 15) * 4;
    f32x4 v[16]; float g[16];
    { const float* p = W + (size_t)(k0 + kr) * N + (COLMAP ? in_col(n0 + nc) : n0 + nc);
#pragma unroll
      for (int i = 0; i < 16; ++i) { v[i] = *(const f32x4*)p; p += (size_t)4 * N; }
#pragma unroll
      for (int i = 0; i < 16; ++i) g[i] = sc ? sc[k0 + kr + 4 * i] : 1.0f; }
    asm volatile("" ::: "memory");
#pragma unroll
    for (int i = 0; i < 16; ++i) { const f32x4 s = v[i] * g[i]; u32x2 w; w.x = pg8::cvt_pk_bf16(s[0], s[1]); w.y = pg8::cvt_pk_bf16(s[2], s[3]);
        *(LAS u32x2*)(scr + (kr + 4 * i) * 136 + nc * 2) = w; }
    LDS_WAIT();
    const int c = lane & 7;
#pragma unroll
    for (int j = 0; j < 8; ++j) { const int n = (lane >> 3) + 8 * j; const LAS bf16_t* s = (const LAS bf16_t*)(scr + (8 * c) * 136 + n * 2);
        u32x4 o; o.x = (unsigned)s[0] | ((unsigned)s[68] << 16); o.y = (unsigned)s[2 * 68] | ((unsigned)s[3 * 68] << 16); o.z = (unsigned)s[4 * 68] | ((unsigned)s[5 * 68] << 16); o.w = (unsigned)s[6 * 68] | ((unsigned)s[7 * 68] << 16);
        *(u32x4*)(WT + (size_t)(n0 + n) * K + k0 + 8 * c) = o; }
    LDS_WAIT();
}
__device__ __forceinline__ void cvt_row(const float* src, bf16_t* dst, float* ss, int lane) {
    const f32x4* xr = (const f32x4*)src + lane; f32x4 v[8]; float s = 0.f;
#pragma unroll
    for (int j = 0; j < 8; ++j) { v[j] = xr[64 * j]; s += (v[j].x * v[j].x + v[j].y * v[j].y) + (v[j].z * v[j].z + v[j].w * v[j].w); }
    s = wave_sum(s);
    u32x2* o8 = (u32x2*)dst + lane;
#pragma unroll
    for (int j = 0; j < 8; ++j) { u32x2 w; w.x = pk2(v[j].x, v[j].y); w.y = pk2(v[j].z, v[j].w); o8[64 * j] = w; }
    if (lane == 0) *ss = s;
}

struct Mix {
    const float *conv_a_w, *conv_a_b, *lru_br, *lru_bi, *lru_lambda, *conv_b_w;
    const bf16_t* gw;
    bf16_t* U; bf16_t* Y; unsigned long long* AGG;
};
struct ItemId { int hd, b, c, row0, ntok, agg; bool meta; };
__device__ __forceinline__ ItemId decode_item(int id) {
    ItemId I;
    if (id < 16) { I.meta = true; I.hd = id; I.b = 0; I.c = 0; I.row0 = META0; I.ntok = 16; I.agg = 256; }
    else { const int j = id - 16; I.meta = false; I.hd = j & 15; I.c = (j >> 4) & 63; I.b = j >> 10; I.row0 = I.b * SEQ + I.c * 64; I.ntok = 64; I.agg = I.b * 64 + I.c; }
    return I;
}
constexpr int N_ITEMS = 16 + NBATCH * NHEAD * 64;

__device__ __forceinline__ bool agg_ok(unsigned long long v) { return (unsigned)v != 0u; }
template <bool META> __device__ __forceinline__ void mix_item(const Mix& X, int id, LAS unsigned char* xt, int lane) {
    constexpr int NT = META ? 16 : 64, NTB = META ? 1 : 2, NQ = META ? 2 : 4;
    constexpr float LOG2E = 1.4426950408889634f;
    const ItemId I = decode_item(id);
    const int ch = I.hd * 64 + lane;
    const float nls2 = -8.0f * LOG2E * log1pf(__expf(-X.lru_lambda[ch]));
    bf16_t raw[NT], rh0 = 0, rh1 = 0, rh2 = 0;
    const float w0 = X.conv_a_w[ch], w1 = X.conv_a_w[1024 + ch], w2 = X.conv_a_w[2048 + ch], w3 = X.conv_a_w[3072 + ch], cb = X.conv_a_b[ch];
    {
        const GAS bf16_t* sb = (const GAS bf16_t*)(X.U + (size_t)I.row0 * DIN + I.hd * 64);
        if (!META) { const GAS bf16_t* hp0 = (I.c == 0) ? (const GAS bf16_t*)(X.U + (size_t)(META0 + 13) * DIN + I.hd * 64) : sb - 3 * DIN; rh0 = hp0[lane]; rh1 = hp0[DIN + lane]; rh2 = hp0[2 * DIN + lane]; }
#pragma unroll
        for (int t = 0; t < NT; ++t) { raw[t] = sb[lane]; sb += DIN; asm volatile("" : "+s"(sb)); }
    }
    bf16x8 BfR0[4], BfR1[4], BfI0[4], BfI1[4];
    { const bf16_t* gr = X.gw + (size_t)(I.hd * 64 + (lane & 31)) * 64 + 8 * (lane >> 5); const bf16_t* gi = gr + 16 * 64 * 64;
#pragma unroll
      for (int s = 0; s < 4; ++s) { BfR0[s] = *(const bf16x8*)(gr + 16 * s); BfR1[s] = *(const bf16x8*)(gr + 32 * 64 + 16 * s); BfI0[s] = *(const bf16x8*)(gi + 16 * s); BfI1[s] = *(const bf16x8*)(gi + 32 * 64 + 16 * s); } }
    asm volatile("" ::: "memory");
    float xm3 = bf1(rh0), xm2 = bf1(rh1), xm1 = bf1(rh2);
#pragma unroll
    for (int t = 0; t < NT; ++t) { const float x0 = bf1(raw[t]); const float xc = cb + w0 * xm3 + w1 * xm2 + w2 * xm1 + w3 * x0; xm3 = xm2; xm2 = xm1; xm1 = x0;
        *(LAS bf16_t*)(xt + t * 144 + lane * 2) = (bf16_t)f2bf(xc); }
    const float brA = X.lru_br[I.hd * 64 + (lane & 31)], brB = X.lru_br[I.hd * 64 + 32 + (lane & 31)], biA = X.lru_bi[I.hd * 64 + (lane & 31)], biB = X.lru_bi[I.hd * 64 + 32 + (lane & 31)];
    float h = 0.f, P = 1.f;
    unsigned hp[NT];
#pragma unroll
    for (int tb = 0; tb < NTB; ++tb) {
        f32x16 aR0, aR1, aI0, aI1;
#pragma unroll
        for (int e = 0; e < 16; ++e) { aR0[e] = brA; aR1[e] = brB; aI0[e] = biA; aI1[e] = biB; }
#pragma unroll
        for (int s = 0; s < 4; ++s) {
            const bf16x8 af = *(const LAS bf16x8*)(xt + (tb * 32 + (lane & 31)) * 144 + (16 * s + 8 * (lane >> 5)) * 2);
            aR0 = __builtin_amdgcn_mfma_f32_32x32x16_bf16(af, BfR0[s], aR0, 0, 0, 0);
            aR1 = __builtin_amdgcn_mfma_f32_32x32x16_bf16(af, BfR1[s], aR1, 0, 0, 0);
            aI0 = __builtin_amdgcn_mfma_f32_32x32x16_bf16(af, BfI0[s], aI0, 0, 0, 0);
            aI1 = __builtin_amdgcn_mfma_f32_32x32x16_bf16(af, BfI1[s], aI1, 0, 0, 0);
        }
#pragma unroll
        for (int q = 0; q < NQ; ++q) {
            float Rv[2][4], Iv[2][4];
#pragma unroll
            for (int k = 0; k < 4; ++k) {
                const int reg = 4 * q + k;
                const float r0f = aR0[reg], r1f = aR1[reg], i0f = aI0[reg], i1f = aI1[reg];
                auto r = __builtin_amdgcn_permlane32_swap(__float_as_uint(r0f), __float_as_uint(r1f), false, false);
                Rv[0][k] = __uint_as_float(r[0]); Rv[1][k] = __uint_as_float(r[1]);
                auto i2 = __builtin_amdgcn_permlane32_swap(__float_as_uint(i0f), __float_as_uint(i1f), false, false);
                Iv[0][k] = __uint_as_float(i2[0]); Iv[1][k] = __uint_as_float(i2[1]);
            }
#pragma unroll
            for (int st = 0; st < 2; ++st)
#pragma unroll
                for (int p = 0; p < 2; ++p) {
                    const int t = tb * 32 + 8 * q + 4 * st + 2 * p;
                    f32x2 er = (f32x2){Rv[st][2 * p], Rv[st][2 * p + 1]} * (-LOG2E), ei = (f32x2){Iv[st][2 * p], Iv[st][2 * p + 1]} * (-LOG2E);
                    er.x = __builtin_amdgcn_exp2f(er.x); er.y = __builtin_amdgcn_exp2f(er.y); ei.x = __builtin_amdgcn_exp2f(ei.x); ei.y = __builtin_amdgcn_exp2f(ei.y);
                    er = er + 1.0f; ei = ei + 1.0f;
                    f32x2 rg, ig; rg.x = __builtin_amdgcn_rcpf(er.x); rg.y = __builtin_amdgcn_rcpf(er.y); ig.x = __builtin_amdgcn_rcpf(ei.x); ig.y = __builtin_amdgcn_rcpf(ei.y);
                    const f32x2 l2 = rg * nls2;
                    f32x2 a; a.x = __builtin_amdgcn_exp2f(l2.x); a.y = __builtin_amdgcn_exp2f(l2.y);
                    f32x2 om = 1.0f - a * a; om.x = fmaxf(om.x, 0.f); om.y = fmaxf(om.y, 0.f);
                    f32x2 mu; mu.x = __builtin_amdgcn_sqrtf(om.x); mu.y = __builtin_amdgcn_sqrtf(om.y);
                    const f32x2 xc = (f32x2){bf1(*(const LAS bf16_t*)(xt + t * 144 + lane * 2)), bf1(*(const LAS bf16_t*)(xt + (t + 1) * 144 + lane * 2))};
                    const f32x2 bb = mu * ig * xc;
                    h = a.x * h + bb.x; P = P * a.x; hp[t] = pg8::cvt_pk_bf16(h, P);
                    h = a.y * h + bb.y; P = P * a.y; hp[t + 1] = pg8::cvt_pk_bf16(h, P);
                }
        }
    }
    __hip_atomic_store(X.AGG + (size_t)I.agg * 1024 + ch, ((unsigned long long)__float_as_uint(h) << 32) | (unsigned long long)__float_as_uint(P), __ATOMIC_RELAXED, __HIP_MEMORY_SCOPE_AGENT);
    asm volatile("" ::: "memory");
    bf16_t graw[NT];
    { const GAS bf16_t* sb = (const GAS bf16_t*)(X.U + (size_t)I.row0 * DIN + 1024 + I.hd * 64);
#pragma unroll
      for (int t = 0; t < NT; ++t) { graw[t] = sb[lane]; sb += DIN; asm volatile("" : "+s"(sb)); } }
    float hin = 0.f;
    if (!META) {
        { const unsigned long long* mp = X.AGG + (size_t)256 * 1024 + ch; unsigned long long v;
          for (;;) { v = __hip_atomic_load(mp, __ATOMIC_RELAXED, __HIP_MEMORY_SCOPE_AGENT); if (!__any(!agg_ok(v))) break; __builtin_amdgcn_s_sleep(2); }
          hin = __uint_as_float((unsigned)(v >> 32)); }
        const unsigned long long* ap = X.AGG + (size_t)(I.b * 64) * 1024 + ch;
        for (int j0 = 0; j0 < I.c; j0 += 16) {
            unsigned long long v[16];
            for (;;) {
                bool bad = false;
#pragma unroll
                for (int k = 0; k < 16; ++k) { v[k] = (j0 + k < I.c) ? __hip_atomic_load(ap + (size_t)(j0 + k) * 1024, __ATOMIC_RELAXED, __HIP_MEMORY_SCOPE_AGENT) : 0x000000003f800000ull; }
#pragma unroll
                for (int k = 0; k < 16; ++k) bad |= !agg_ok(v[k]);
                if (!__any(bad)) break;
                __builtin_amdgcn_s_sleep(2);
            }
#pragma unroll
            for (int k = 0; k < 16; ++k) hin = __uint_as_float((unsigned)v[k]) * hin + __uint_as_float((unsigned)(v[k] >> 32));
        }
    }
    asm volatile("" ::: "memory");
    GAS bf16_t* yp = (GAS bf16_t*)(X.Y + (size_t)I.row0 * DM + I.hd * 64);
#pragma unroll
    for (int t0 = 0; t0 < NT; t0 += 16) {
        {
#pragma unroll
            for (int k = 0; k < 16; k += 2) {
                const unsigned w0 = hp[t0 + k], w1 = hp[t0 + k + 1];
                const f32x2 gg = (f32x2){bf1(graw[t0 + k]), bf1(graw[t0 + k + 1])};
                f32x2 e = gg * (-LOG2E); e.x = __builtin_amdgcn_exp2f(e.x); e.y = __builtin_amdgcn_exp2f(e.y); e = e + 1.0f;
                f32x2 sg; sg.x = __builtin_amdgcn_rcpf(e.x); sg.y = __builtin_amdgcn_rcpf(e.y);
                const f32x2 hv = (f32x2){bflo(w0), bflo(w1)} + (f32x2){bfhi(w0), bfhi(w1)} * hin;
                const f32x2 y = hv * gg * sg;
                const unsigned pk = pg8::cvt_pk_bf16(y.x, y.y);
                yp[lane] = (bf16_t)(pk & 0xffffu); yp[DM + lane] = (bf16_t)(pk >> 16); yp += 2 * DM; asm volatile("" : "+s"(yp));
            }
        }
    }
}

__device__ __forceinline__ void ld8(const bf16_t* p, float (&o)[8]) {
    const u32x4 w = *(const u32x4*)p;
    o[0] = bflo(w.x); o[1] = bfhi(w.x); o[2] = bflo(w.y); o[3] = bfhi(w.y); o[4] = bflo(w.z); o[5] = bfhi(w.z); o[6] = bflo(w.w); o[7] = bfhi(w.w);
}
__device__ __forceinline__ void partb(const Mix& X, int tid) {
    int itn = blockIdx.x * 512 + tid; bool meta_done = false;
    for (;;) {
        int it;
        if (itn < 1024 * 128) { it = itn; itn += gridDim.x * 512; }
        else if (!meta_done && gridDim.x >= 8 && blockIdx.x + 4 >= gridDim.x && tid < 128) { it = (1024 + (int)(gridDim.x - 1 - blockIdx.x)) * 128 + tid; meta_done = true; }
        else if (!meta_done && gridDim.x < 8 && blockIdx.x == 0 && tid < 128) { it = 1028 * 128 + tid; meta_done = true; }
        else break;
        const int c0 = (it & 127) * 8, run = it >> 7;
        float w0[8], w1[8], w2[8], cm2[8], cm1[8];
        { const f32x4* p = (const f32x4*)(X.conv_b_w + c0); const f32x4 a0 = p[0], a1 = p[1], b0 = p[256], b1 = p[257], d0 = p[512], d1 = p[513];
#pragma unroll
          for (int e = 0; e < 4; ++e) { w0[e] = a0[e]; w0[4 + e] = a1[e]; w1[e] = b0[e]; w1[4 + e] = b1[e]; w2[e] = d0[e]; w2[4 + e] = d1[e]; } }
        if (run >= 1024) {
            const int t0 = (run == 1028) ? 0 : 4 * (run - 1024), nt = (run == 1028) ? 16 : 4;
            const bf16_t* up = X.U + (size_t)META0 * DIN + c0; bf16_t* yp = X.Y + (size_t)META0 * DM + 1024 + c0;
#pragma unroll
            for (int e = 0; e < 8; ++e) { cm2[e] = 0.f; cm1[e] = 0.f; }
            if (t0 > 0) {
                float c[8], x[8];
                ld8(up + (size_t)(t0 - 2) * DIN + 3072, c); ld8(up + (size_t)(t0 - 2) * DIN + 4096, x);
#pragma unroll
                for (int e = 0; e < 8; ++e) cm2[e] = c[e] * x[e];
                ld8(up + (size_t)(t0 - 1) * DIN + 3072, c); ld8(up + (size_t)(t0 - 1) * DIN + 4096, x);
#pragma unroll
                for (int e = 0; e < 8; ++e) cm1[e] = c[e] * x[e];
            }
#pragma unroll 4
            for (int t = t0; t < t0 + nt; ++t) {
                float bv[8], cv[8], xv[8], gv[8];
                ld8(up + (size_t)t * DIN + 2048, bv); ld8(up + (size_t)t * DIN + 3072, cv); ld8(up + (size_t)t * DIN + 4096, xv); ld8(up + (size_t)t * DIN + 5120, gv);
                float o[8];
#pragma unroll
                for (int e = 0; e < 8; ++e) { const float cx = cv[e] * xv[e]; const float y = w0[e] * cm2[e] + w1[e] * cm1[e] + w2[e] * cx; o[e] = bv[e] * y * (gv[e] * sigmoidf_(gv[e])); cm2[e] = cm1[e]; cm1[e] = cx; }
                u32x4 w; w.x = pk2(o[0], o[1]); w.y = pk2(o[2], o[3]); w.z = pk2(o[4], o[5]); w.w = pk2(o[6], o[7]);
                *(u32x4*)(yp + (size_t)t * DM) = w;
            }
            continue;
        }
        const int row0 = run * 16;
        const bf16_t* vp = X.U + (size_t)row0 * DIN + 2048 + 2 * c0;
        bf16_t* yp = X.Y + (size_t)row0 * DM + 1024 + c0;
        u32x4 q[16][2];
#pragma unroll
        for (int t = 0; t < 16; ++t) { q[t][0] = *(const u32x4*)(vp + (size_t)t * DIN); q[t][1] = *(const u32x4*)(vp + (size_t)t * DIN + 8); }
        if ((row0 & (SEQ - 1)) == 0) {
            float c[8], x[8];
            ld8(X.U + (size_t)(META0 + 14) * DIN + 3072 + c0, c); ld8(X.U + (size_t)(META0 + 14) * DIN + 4096 + c0, x);
#pragma unroll
            for (int e = 0; e < 8; ++e) cm2[e] = c[e] * x[e];
            ld8(X.U + (size_t)(META0 + 15) * DIN + 3072 + c0, c); ld8(X.U + (size_t)(META0 + 15) * DIN + 4096 + c0, x);
#pragma unroll
            for (int e = 0; e < 8; ++e) cm1[e] = c[e] * x[e];
        } else {
            const u32x4* p2 = (const u32x4*)(X.U + (size_t)(row0 - 2) * DIN + 2048 + 2 * c0); const u32x4* p1 = (const u32x4*)(X.U + (size_t)(row0 - 1) * DIN + 2048 + 2 * c0);
            const u32x4 a0 = p2[0], a1 = p2[1], b0 = p1[0], b1 = p1[1];
#pragma unroll
            for (int e = 0; e < 4; ++e) { cm2[e] = bfhi(a0[e]); cm2[4 + e] = bfhi(a1[e]); cm1[e] = bfhi(b0[e]); cm1[4 + e] = bfhi(b1[e]); }
        }
#pragma unroll
        for (int t = 0; t < 16; ++t) {
            float o[8];
#pragma unroll
            for (int e = 0; e < 8; ++e) { const unsigned qq = e < 4 ? q[t][0][e & 3] : q[t][1][e & 3]; const float bg = bflo(qq), cx = bfhi(qq);
                o[e] = bg * (w0[e] * cm2[e] + w1[e] * cm1[e] + w2[e] * cx); cm2[e] = cm1[e]; cm1[e] = cx; }
            u32x4 w; w.x = pk2(o[0], o[1]); w.y = pk2(o[2], o[3]); w.z = pk2(o[4], o[5]); w.w = pk2(o[6], o[7]);
            *(u32x4*)(yp + (size_t)t * DM) = w;
        }
    }
}


#ifdef DEBUG_NAIVE_MIX
__global__ void __launch_bounds__(64) naive_mixA(Mix X, const float* wr, const float* wi) {
    const int b = blockIdx.x / 16, hd = blockIdx.x % 16, lane = threadIdx.x, ch = hd * 64 + lane;
    __shared__ float xs[64];
    const float w0 = X.conv_a_w[ch], w1 = X.conv_a_w[1024 + ch], w2 = X.conv_a_w[2048 + ch], w3 = X.conv_a_w[3072 + ch], cb = X.conv_a_b[ch];
    const float br = X.lru_br[ch], bi = X.lru_bi[ch];
    const float sp = log1pf(expf(-X.lru_lambda[ch]));
    const float* wrh = wr + (size_t)hd * 4096 + lane; const float* wih = wi + (size_t)hd * 4096 + lane;
    float h = 0.f, xm3 = 0.f, xm2 = 0.f, xm1 = 0.f;
    for (int p = 0; p < NMETA + SEQ; ++p) {
        const int row = p < NMETA ? META0 + p : b * SEQ + (p - NMETA);
        const float x0 = bf1(X.U[(size_t)row * DIN + ch]);
        const float xc = cb + w0 * xm3 + w1 * xm2 + w2 * xm1 + w3 * x0; xm3 = xm2; xm2 = xm1; xm1 = x0;
        xs[lane] = xc; __syncthreads();
        float rp = br, ip = bi;
#pragma unroll 4
        for (int i = 0; i < 64; ++i) { rp += xs[i] * wrh[i * 64]; ip += xs[i] * wih[i * 64]; }
        __syncthreads();
        const float r = 1.f / (1.f + expf(-rp)), ig = 1.f / (1.f + expf(-ip));
        const float la = -8.f * r * sp; const float a = expf(la); const float bb = sqrtf(-expm1f(2.f * la)) * (ig * xc);
        h = a * h + bb;
        const float g = bf1(X.U[(size_t)row * DIN + 1024 + ch]);
        const float y = h * g / (1.f + expf(-g));
        if (p >= NMETA || b == 0) X.Y[(size_t)row * DM + ch] = (bf16_t)f2bf(y);
    }
}
__global__ void naive_mixB(Mix X) {
    for (size_t idx = (size_t)blockIdx.x * blockDim.x + threadIdx.x; idx < (size_t)(MROWS + NMETA) * 1024; idx += (size_t)gridDim.x * blockDim.x) {
        const int row = (int)(idx >> 10), c = (int)(idx & 1023);
        int r1, r2;
        if (row >= META0) { const int p = row - META0; r1 = p >= 1 ? row - 1 : -1; r2 = p >= 2 ? row - 2 : -1; }
        else { const int t = row & (SEQ - 1); r1 = t >= 1 ? row - 1 : META0 + 15; r2 = t >= 2 ? row - 2 : META0 + 14 + t; }
        auto cx = [&](int r) -> float { return r < 0 ? 0.f : bf1(X.U[(size_t)r * DIN + 3072 + c]) * bf1(X.U[(size_t)r * DIN + 4096 + c]); };
        const float y = X.conv_b_w[c] * cx(r2) + X.conv_b_w[1024 + c] * cx(r1) + X.conv_b_w[2048 + c] * cx(row);
        const float bv = bf1(X.U[(size_t)row * DIN + 2048 + c]), g = bf1(X.U[(size_t)row * DIN + 5120 + c]);
        X.Y[(size_t)row * DM + 1024 + c] = (bf16_t)f2bf(bv * y * g / (1.f + expf(-g)));
    }
}
#endif
#define XB_TMO      128
#define XB_XCNT(j)  (256  + 64 * (j))
#define XB_XSUB(j)  (1280 + 64 * (j))
#define XB_XGEN(j)  (2304 + 64 * (j))
#define XB_TOP      3328
#define XB_TOPGEN   3392
#define XCD_BAR_WORDS 3456
#define XB_SPIN_CAP (1u << 18)

__device__ __forceinline__ unsigned xb_ld(unsigned* p)              { return __hip_atomic_load(p, __ATOMIC_RELAXED, __HIP_MEMORY_SCOPE_AGENT); }
__device__ __forceinline__ unsigned xb_add(unsigned* p, unsigned v) { return __hip_atomic_fetch_add(p, v, __ATOMIC_RELAXED, __HIP_MEMORY_SCOPE_AGENT); }
__device__ __forceinline__ unsigned xb_xcc_id() { return (unsigned)__builtin_amdgcn_s_getreg((3 << 11) | 20) & 0xFu; }
#define XB_SPIN(cond, bar) do { unsigned _sp = 0; while (cond) { __builtin_amdgcn_s_sleep(1); \
    if ((++_sp & 255u) == 0u) { if (xb_ld(&(bar)[XB_TMO])) break; if (_sp > XB_SPIN_CAP) { atomicAdd(&(bar)[XB_TMO], 1u); break; } } } } while (0)

struct XcdBarrier {
    unsigned* bar; unsigned x;
    volatile LAS unsigned* st;
};

__device__ __forceinline__ XcdBarrier xcd_barrier_post(unsigned* bar, volatile LAS unsigned* st) {
    XcdBarrier b; b.bar = bar; b.x = xb_xcc_id(); b.st = st;
    if (threadIdx.x == 0) (void)xb_add(&bar[XB_XCNT(b.x)], 1u);
    return b;
}
__device__ __forceinline__ void xcd_barrier_complete(unsigned* bar, unsigned x, unsigned& nloc, unsigned& nx) {
    const unsigned G = gridDim.x * gridDim.y * gridDim.z;
    unsigned sum, cnt, mine, sp = 0u;
    for (;;) {
        sum = 0u; cnt = 0u; mine = 0u;
#pragma unroll
        for (unsigned j = 0; j < 16; ++j) { const unsigned c = xb_ld(&bar[XB_XCNT(j)]); sum += c; cnt += (c > 0u) ? 1u : 0u; mine = (j == x) ? c : mine; }
        if (sum == G) break;
        __builtin_amdgcn_s_sleep(1);
        if ((++sp & 255u) == 0u) { if (xb_ld(&bar[XB_TMO])) break; if (sp > XB_SPIN_CAP) { atomicAdd(&bar[XB_TMO], 1u); break; } }
    }
    nloc = mine > 0u ? mine : 1u; nx = cnt > 0u ? cnt : 1u;
}

__device__ __forceinline__ void xcd_barrier(const XcdBarrier& b) {
    asm volatile("s_waitcnt vmcnt(0)" ::: "memory");
    __syncthreads();
    if (threadIdx.x == 0) {
        unsigned* bar = b.bar;
        __builtin_amdgcn_s_waitcnt(0);
        unsigned nloc = b.st[0], nx = b.st[1];
        if (nloc == 0u) { xcd_barrier_complete(bar, b.x, nloc, nx); b.st[0] = nloc; b.st[1] = nx; }
        const unsigned old = xb_add(&bar[XB_XSUB(b.x)], 1u);
        const unsigned gen = old / nloc;
        if (old + 1u == (gen + 1u) * nloc) {
            __builtin_amdgcn_fence(__ATOMIC_RELEASE, "agent");
            asm volatile("s_waitcnt vmcnt(0)" ::: "memory");
            const unsigned og = xb_add(&bar[XB_TOP], 1u);
            const unsigned tg = og / nx;
            if (og + 1u == (tg + 1u) * nx) xb_add(&bar[XB_TOPGEN], 1u);
            else XB_SPIN(xb_ld(&bar[XB_TOPGEN]) == tg, bar);
            __builtin_amdgcn_fence(__ATOMIC_ACQUIRE, "agent");
            xb_add(&bar[XB_XGEN(b.x)], 1u);
            asm volatile("s_waitcnt vmcnt(0)" ::: "memory");
        } else {
            XB_SPIN(xb_ld(&bar[XB_XGEN(b.x)]) == gen, bar);
            __builtin_amdgcn_fence(__ATOMIC_ACQUIRE, "agent");
            asm volatile("s_waitcnt vmcnt(0)" ::: "memory");
        }
    }
    __syncthreads();
}

__global__ void __launch_bounds__(512, 2) hymba_fwd(Args a) {
    extern __shared__ __attribute__((aligned(16))) unsigned char lds_raw[];
    LAS unsigned char* lds = (LAS unsigned char*)lds_raw;
    cg::grid_group grid = cg::this_grid();
    const int NGW = gridDim.x * 8;
    if (threadIdx.x < 64) ((LAS unsigned*)(lds + 131072))[threadIdx.x] = 0u;
    __syncthreads();
    XcdBarrier xbar; xbar.bar = (unsigned*)(a.ws + WS_BAR); xbar.x = 0; xbar.st = nullptr;
    if (a.ph_hi - a.ph_lo > 1) xbar = xcd_barrier_post((unsigned*)(a.ws + WS_BAR), (volatile LAS unsigned*)(lds + 131072));
    if (a.ph_lo < 0) grid.sync();
#define LAUNDER() int tid = threadIdx.x; asm volatile("" : "+v"(tid)); const int wid = __builtin_amdgcn_readfirstlane(tid >> 6), lane = tid & 63, gw = blockIdx.x * 8 + wid
    const int lo = a.ph_lo, hi = a.ph_hi;
#define IN(k) (lo <= (k) && (k) < hi)
#ifndef STAGGER_N
#define STAGGER_N 0
#endif
#define STAGGER() do { if (STAGGER_N) for (int _k = 0; _k < (int)(blockIdx.x & 7); ++_k) __builtin_amdgcn_s_sleep(STAGGER_N); } while (0)
#define SEAM(k) do { if (IN(k) && IN((k) + 1)) { xcd_barrier(xbar); if ((REP_MASK >> 10) & 1) { xcd_barrier(xbar); xcd_barrier(xbar); } } } while (0)
    const float* x = a.in[0]; const float* meta = a.in[1]; const float* norm_g = a.in[2]; const float* w_in = a.in[3];
    const float* conv_a_w = a.in[4]; const float* conv_a_b = a.in[5]; const float* lru_wr = a.in[6]; const float* lru_br = a.in[7];
    const float* lru_wi = a.in[8]; const float* lru_bi = a.in[9]; const float* lru_lambda = a.in[10]; const float* conv_b_w = a.in[11];
    const float* w_out = a.in[12]; const float* final_g = a.in[13];
    unsigned char* ws = a.ws;
    bf16_t* WTIN = (bf16_t*)(ws + WS_WTIN); bf16_t* WTOUT = (bf16_t*)(ws + WS_WTOUT); bf16_t* GW = (bf16_t*)(ws + WS_GW);
    float* ROWSS = (float*)(ws + WS_ROWSS); unsigned long long* AGG = (unsigned long long*)(ws + WS_AGG);
    bf16_t* XB = (bf16_t*)(ws + WS_XB); bf16_t* Y = (bf16_t*)(ws + WS_Y); bf16_t* U = (bf16_t*)(ws + WS_U);

    if (IN(0)) for (int rep = 0; rep <= ((REP_MASK >> 0) & 1); ++rep) {
        LAUNDER();
        LAS unsigned char* scr = lds + wid * 16384;
        constexpr int I_IN = (DM / 64) * (DIN / 64);
        constexpr int NIT = I_IN + 64;
        for (int it = gw; it < NIT; it += NGW) {
            int r = it;
            if (r < I_IN) { tr_item<true>(w_in, DM, DIN, WTIN, norm_g, scr, r, lane); continue; } r -= I_IN;
            { const int mtx = r, l = mtx >> 5, g = (mtx >> 4) & 1, hd = mtx & 15;
              const float* src = (g ? lru_wi : lru_wr) + (size_t)(l * 16 + hd) * 4096;
              tr_item<false>(src, 64, 64, GW + (size_t)mtx * 4096, nullptr, scr, 0, lane); }
        }
        for (int m = gw; m < MROWS + NMETA; m += NGW) {
            const float* src = m < MROWS ? x + (size_t)m * DM : meta + (size_t)(m - MROWS) * DM;
            cvt_row(src, XB + (size_t)m * DM, ROWSS + m, lane);
        }
        for (int i = blockIdx.x * 512 + tid; i < 2 * RSTR; i += gridDim.x * 512) ROWSS[RSTR + i] = 0.f;
        for (int i = blockIdx.x * 512 + tid; i < AGG_PER_LAYER; i += gridDim.x * 512) ((u32x4*)AGG)[i] = (u32x4){0u, 0u, 0u, 0u};
    }
    SEAM(0);

#pragma unroll 1
    for (int l = 0; l < 2; ++l) {
        const int pb = 1 + 3 * l;
        const bf16_t* wtin = WTIN + (size_t)l * DIN * DM; const bf16_t* wtout = WTOUT + (size_t)l * DM * DM;
        float* rss_in = ROWSS + (size_t)l * RSTR; float* rss_out = ROWSS + (size_t)(l + 1) * RSTR;
        Mix X; X.conv_a_w = conv_a_w + l * 4 * DLRU; X.conv_a_b = conv_a_b + l * DLRU; X.lru_br = lru_br + l * DLRU; X.lru_bi = lru_bi + l * DLRU; X.lru_lambda = lru_lambda + l * DLRU;
        X.conv_b_w = conv_b_w + l * 3 * DLRU; X.gw = GW + (size_t)l * 2 * 16 * 4096; X.U = U; X.Y = Y; X.AGG = AGG + (size_t)l * AGG_PER_LAYER;

        if (IN(pb)) for (int rep = 0; rep <= ((REP_MASK >> pb) & 1); ++rep) {
            LAUNDER();
            STAGGER();
            for (int mrep = 0; mrep <= ((REP_MASK >> 16) & 1); ++mrep)
            meta_gemm(XB + (size_t)META0 * DM, wtin, DIN / 16, lds, wid, lane, [&](int m, int n0, f32x4 s) {
                const float rs = rsqrtf(rss_in[META0 + m] * (1.0f / DM) + RMS_EPS);
                u32x2 w; w.x = pk2(s[0] * rs, s[1] * rs); w.y = pk2(s[2] * rs, s[3] * rs);
                *(u32x2*)(U + (size_t)(META0 + m) * DIN + in_col(n0)) = w; });
            pg8::Gemm g{XB, wtin, MROWS, DIN, DM}; pg8::StaticOrder S; S.init(MROWS, DIN, (int)gridDim.x, (int)blockIdx.x);
            if ((REP_MASK >> 17) & 1) { EpiUT<true> En{U, rss_in, {}, -1}; pg8::gemm_phase<EpiUT<true>, pg8::StaticOrder, false>(lds, g, S, En, nullptr); }
            if ((REP_MASK >> 15) & 1) { EpiNull En{ROWSS + (size_t)3 * RSTR}; pg8::gemm_phase<EpiNull, pg8::StaticOrder, false>(lds, g, S, En, nullptr); }
            EpiU E{U, rss_in, {}, -1};
            pg8::gemm_phase<EpiU, pg8::StaticOrder, false>(lds, g, S, E, nullptr);
        }
        SEAM(pb);
        if (IN(pb + 1)) for (int rep = 0; rep <= ((REP_MASK >> (pb + 1)) & 1); ++rep) {
            LAUNDER();
#pragma unroll 1
            for (int step = 0; step < 2; ++step) {
                if ((step == 0) == (wid < 4)) {
                    if (rep == 1 && ((REP_MASK >> 13) & 1)) continue;
#pragma unroll 1
                    for (int id = gw; id < N_ITEMS; id += NGW) { if (id < 16) mix_item<true>(X, id, lds + wid * 9216, lane); else mix_item<false>(X, id, lds + wid * 9216, lane); }
                } else { if (rep == 1 && ((REP_MASK >> 12) & 1)) continue; partb(X, tid); }
            }
            if (l == 0) {
                constexpr int I_OUT = (DM / 64) * (DM / 64);
                LAS unsigned char* scr = lds + wid * 9216;
#pragma unroll 1
                for (int it = gw; it < I_OUT; it += NGW) tr_item<false>(w_out, DM, DM, WTOUT, nullptr, scr, it, lane);
            }
        }
        SEAM(pb + 1);
        if (IN(pb + 2)) {
            LAUNDER();
            STAGGER();
            const bool early_copies = ((blockIdx.x >> 3) & 1) != 0;
#define COHORT_COPIES() do { constexpr int I_IN = (DM / 64) * (DIN / 64), I_OUT = (DM / 64) * (DM / 64); LAS unsigned char* scr = lds + wid * 9216; \
                for (int it = gw; it < I_IN + I_OUT; it += NGW) { \
                    if (it < I_IN) tr_item<true>(w_in + (size_t)DM * DIN, DM, DIN, WTIN + (size_t)DIN * DM, norm_g + DM, scr, it, lane); \
                    else tr_item<false>(w_out + (size_t)DM * DM, DM, DM, WTOUT + (size_t)DM * DM, nullptr, scr, it - I_IN, lane); } } while (0)
            if (l == 0 && early_copies) { COHORT_COPIES(); __syncthreads(); }
            if (l == 0) {
                meta_gemm(Y + (size_t)META0 * DM, wtout, DM / 16, lds, wid, lane, [&](int m, int n0, f32x4 s) {
                    const f32x4 r = *(const f32x4*)(meta + (size_t)m * DM + n0); const f32x4 hh = r + s;
                    u32x2 w; w.x = pk2(hh[0], hh[1]); w.y = pk2(hh[2], hh[3]);
                    *(u32x2*)(XB + (size_t)(META0 + m) * DM + n0) = w;
                    unsafeAtomicAdd(rss_out + META0 + m, (hh[0] * hh[0] + hh[1] * hh[1]) + (hh[2] * hh[2] + hh[3] * hh[3])); });
            }
            pg8::Gemm g{Y, wtout, MROWS, DM, DM};
            if (l == 0) {
                pg8::StaticOrder S; S.init(MROWS, DM, (int)gridDim.x, (int)blockIdx.x);
                if ((REP_MASK >> 11) & 1) { EpiU Ed{U, rss_in, {}, -1}; pg8::gemm_phase<EpiU, pg8::StaticOrder, false>(lds, g, S, Ed, nullptr); }
                if ((REP_MASK >> 14) & 1) { EpiRes Ed{x, nullptr, XB, ROWSS + (size_t)3 * RSTR}; pg8::gemm_phase<EpiRes, pg8::StaticOrder, false>(lds, g, S, Ed, nullptr); }
                EpiRes E{nullptr, nullptr, XB, rss_out};
                pg8::gemm_phase<EpiRes, pg8::StaticOrder, false>(lds, g, S, E, nullptr);
                if (!early_copies) COHORT_COPIES();
            } else {
                PanelOrder S; S.init((int)gridDim.x, (int)blockIdx.x);
                EpiResNorm E{XB, a.out, rss_out, (unsigned*)(ws + WS_PCNT), final_g};
                pg8::gemm_phase<EpiResNorm, PanelOrder, false>(lds, g, S, E, nullptr);
            }
        }
        SEAM(pb + 2);
    }

#undef IN
#undef SEAM
}

#ifndef MK_LAUNCH_PER_PHASE
#define MK_LAUNCH_PER_PHASE 0
#endif
extern "C" void kernel_launch(void* const* d_in, const int* in_sizes, int n_in, void* d_out, int out_size, void* d_ws, size_t ws_size, hipStream_t stream) {
    static int grid = 0;
    if (grid == 0) {
        if (n_in != 14 || in_sizes[0] != MROWS * DM || out_size != MROWS * DM || ws_size < WS_END) { fprintf(stderr, "kernel_launch: unexpected shapes (n_in %d, in0 %d, out %d, ws %zu)\n", n_in, n_in > 0 ? in_sizes[0] : -1, out_size, ws_size); grid = -1; return; }
        int dev = 0, cus = 0, per_cu = 0;
        hipGetDevice(&dev); hipDeviceGetAttribute(&cus, hipDeviceAttributeMultiprocessorCount, dev);
        if (hipFuncSetAttribute((const void*)hymba_fwd, hipFuncAttributeMaxDynamicSharedMemorySize, LDS_BYTES) != hipSuccess) { fprintf(stderr, "kernel_launch: hipFuncSetAttribute failed\n"); grid = -1; return; }
        if (hipOccupancyMaxActiveBlocksPerMultiprocessor(&per_cu, (const void*)hymba_fwd, 512, LDS_BYTES) != hipSuccess || per_cu < 1) { fprintf(stderr, "kernel_launch: occupancy query gave %d\n", per_cu); per_cu = 1; }
        (void)hipGetLastError();
        grid = cus * per_cu;
    }
    if (grid < 0) return;
    Args a{};
    for (int i = 0; i < 14; ++i) a.in[i] = (const float*)d_in[i];
    a.out = (float*)d_out; a.ws = (unsigned char*)d_ws;
#if MK_LAUNCH_PER_PHASE
    for (int p = 0; p < NPHASE; ++p) {
#ifdef DEBUG_NAIVE_MIX
        if (p == 2 || p == 6) { const int l = p / 4; unsigned char* ws = (unsigned char*)d_ws;
            Mix X; X.conv_a_w = a.in[4] + l * 4 * DLRU; X.conv_a_b = a.in[5] + l * DLRU; X.lru_br = a.in[7] + l * DLRU; X.lru_bi = a.in[9] + l * DLRU; X.lru_lambda = a.in[10] + l * DLRU;
            X.conv_b_w = a.in[11] + l * 3 * DLRU; X.gw = nullptr; X.U = (bf16_t*)(ws + WS_U); X.Y = (bf16_t*)(ws + WS_Y); X.HP = nullptr; X.AGG = nullptr;
#if DEBUG_NAIVE_MIX == 1
            hipLaunchKernelGGL(naive_mixA, dim3(64), dim3(64), 0, stream, X, a.in[6] + (size_t)l * 16 * 4096, a.in[8] + (size_t)l * 16 * 4096);
            a.flags = 1;
#else
            hipLaunchKernelGGL(naive_mixB, dim3(2048), dim3(256), 0, stream, X);
            a.flags = 2;
#endif
            }
        else a.flags = 0;
#if DEBUG_NAIVE_MIX == 1
        if (p == 3 || p == 7) continue;
#endif
#endif
        a.ph_lo = p; a.ph_hi = p + 1; hipLaunchKernelGGL(hymba_fwd, dim3(grid), dim3(512), LDS_BYTES, stream, a); }
#else
    a.ph_lo = 0; a.ph_hi = NPHASE;
    if (hipMemsetAsync((unsigned char*)d_ws + WS_BAR, 0, 16384 + 32768, stream) != hipSuccess) { fprintf(stderr, "kernel_launch: memset of barrier words failed\n"); return; }
    void* args[] = {&a};
    const hipError_t e = hipLaunchCooperativeKernel((const void*)hymba_fwd, dim3(grid), dim3(512), args, LDS_BYTES, stream);
    if (e != hipSuccess) fprintf(stderr, "kernel_launch: cooperative launch failed: %s (grid %d)\n", hipGetErrorString(e), grid);
#endif
}
```
